# Optimizing an MI355X kernel written in HIP

```python
import jax, jax.numpy as jnp
from jax import lax
import numpy as np

D_MODEL = 1024
BATCH = 4
SEQ = 4096
DEPTH = 4

CHUNK = 64
Q_BLOCK = 128
N_MIXERS = 3
EPS = 1e-6

RET_HEADS = 4
RET_DK = D_MODEL
RET_DV = 2 * D_MODEL
RET_HK = RET_DK // RET_HEADS
RET_HV = RET_DV // RET_HEADS
RET_IN = 2 * RET_DK + 2 * RET_DV
ROPE_BASE = 10000.0

FOX_HEADS = 16
FOX_HD = 64
FOX_W = FOX_HEADS * FOX_HD
FOX_IN = 4 * FOX_W + FOX_HEADS
FOX_FORGET_BIAS = 2.0

GLA_HEADS = 4
GLA_DK = D_MODEL // 2
GLA_DV = D_MODEL
GLA_HK = GLA_DK // GLA_HEADS
GLA_HV = GLA_DV // GLA_HEADS
GLA_RANK = 16
GLA_TAU = 16.0
GLA_IN = 2 * GLA_DK + 2 * GLA_DV + GLA_RANK

MAX_POS_OFFSET = 100000

kernel_name = "hybrid_retention_fox_gla_adaln_trunk"


def _rms_norm(x, gain=None):
    xf = x.astype(jnp.float32)
    y = xf * lax.rsqrt(jnp.mean(xf * xf, axis=-1, keepdims=True) + EPS)
    if gain is not None:
        y = y * gain.astype(jnp.float32)
    return y.astype(x.dtype)


def _layer_norm(x):
    xf = x.astype(jnp.float32)
    mu = jnp.mean(xf, axis=-1, keepdims=True)
    var = jnp.mean(jnp.square(xf - mu), axis=-1, keepdims=True)
    return ((xf - mu) * lax.rsqrt(var + EPS)).astype(x.dtype)


def _rope(x, positions):
    half = x.shape[-1] // 2
    inv = ROPE_BASE ** (-jnp.arange(half, dtype=jnp.float32) / half)
    ang = positions.astype(jnp.float32)[..., None, None] * inv
    cos, sin = jnp.cos(ang), jnp.sin(ang)
    x1, x2 = x[..., :half], x[..., half:]
    return jnp.concatenate([x1 * cos - x2 * sin, x1 * sin + x2 * cos], axis=-1)


def _to_chunks(t):
    b, s, h, d = t.shape
    return t.reshape(b, s // CHUNK, CHUNK, h, d).transpose(0, 3, 1, 2, 4)


def _from_chunks(t):
    b, h, n, c, d = t.shape
    return t.transpose(0, 2, 3, 1, 4).reshape(b, n * c, h, d)


def _chunk_state_scan(q_in, k_in, v, state_decay):
    b, h, _, _, dk = q_in.shape
    dv = v.shape[-1]

    def step(state, inp):
        qi, ki, vi, di = inp
        out = jnp.einsum('bhcd,bhde->bhce', qi, state)
        state = di[..., None] * state + jnp.einsum('bhcd,bhce->bhde', ki, vi)
        return state, out

    xs = (jnp.moveaxis(q_in, 2, 0), jnp.moveaxis(k_in, 2, 0), jnp.moveaxis(v, 2, 0),
          jnp.moveaxis(state_decay, 2, 0))
    init = jnp.zeros((b, h, dk, dv), q_in.dtype)
    _, outs = lax.scan(step, init, xs)
    return jnp.moveaxis(outs, 0, 2)


def _retention(h, positions, w_in, w_out):
    b, s, _ = h.shape
    n = s // CHUNK
    q, k, v, g = jnp.split(h @ w_in, [RET_DK, 2 * RET_DK, 2 * RET_DK + RET_DV], axis=-1)
    q = _rope(q.astype(jnp.float32).reshape(b, s, RET_HEADS, RET_HK), positions) * (RET_HK ** -0.5)
    k = _rope(k.astype(jnp.float32).reshape(b, s, RET_HEADS, RET_HK), positions)
    qc, kc = _to_chunks(q), _to_chunks(k)
    vc = _to_chunks(v.astype(jnp.float32).reshape(b, s, RET_HEADS, RET_HV))
    log_gamma = jnp.log1p(-jnp.exp2(-5.0 - jnp.arange(RET_HEADS, dtype=jnp.float32)))
    pos = jnp.arange(CHUNK, dtype=jnp.float32)
    dist = jnp.abs(pos[:, None] - pos[None, :])
    intra_decay = jnp.exp(log_gamma[:, None, None] * dist)
    scores = jnp.einsum('bhncd,bhnmd->bhncm', qc, kc) * intra_decay[:, None]
    o = jnp.einsum('bhncm,bhnme->bhnce', scores, vc)
    q_in = qc * jnp.exp(log_gamma[:, None] * (pos + 1.0))[:, None, :, None]
    k_in = kc * jnp.exp(log_gamma[:, None] * (CHUNK - 1.0 - pos))[:, None, :, None]
    state_decay = jnp.broadcast_to(jnp.exp(log_gamma * CHUNK)[None, :, None, None], (b, RET_HEADS, n, RET_HK))
    o = o + _chunk_state_scan(q_in, k_in, vc, state_decay)
    o = _layer_norm(_from_chunks(o)).reshape(b, s, RET_DV)
    return (o.astype(h.dtype) * jax.nn.silu(g)) @ w_out


def _forgetting_attention(h, w_in, b_f, q_gain, k_gain, w_out):
    b, s, _ = h.shape
    q, k, v, g, f = jnp.split(h @ w_in, [FOX_W, 2 * FOX_W, 3 * FOX_W, 4 * FOX_W], axis=-1)
    q = _rms_norm(q.astype(jnp.float32).reshape(b, s, FOX_HEADS, FOX_HD), q_gain).transpose(0, 2, 1, 3) * (FOX_HD ** -0.5)
    k = _rms_norm(k.astype(jnp.float32).reshape(b, s, FOX_HEADS, FOX_HD), k_gain).transpose(0, 2, 1, 3)
    v = v.astype(jnp.float32).reshape(b, s, FOX_HEADS, FOX_HD).transpose(0, 2, 1, 3)
    log_f = jax.nn.log_sigmoid(f.astype(jnp.float32) + b_f.astype(jnp.float32))
    cum = jnp.cumsum(log_f, axis=1).transpose(0, 2, 1)
    outs = []
    for qs in range(0, s, Q_BLOCK):
        qe = qs + Q_BLOCK
        logits = (jnp.einsum('bhqd,bhkd->bhqk', q[:, :, qs:qe], k[:, :, :qe])
                  + cum[:, :, qs:qe, None] - cum[:, :, None, :qe])
        causal = jnp.arange(qs, qe)[:, None] >= jnp.arange(qe)[None, :]
        p = jax.nn.softmax(jnp.where(causal, logits, -jnp.inf), axis=-1)
        outs.append(jnp.einsum('bhqk,bhkd->bhqd', p, v[:, :, :qe]))
    o = jnp.concatenate(outs, axis=2).transpose(0, 2, 1, 3).reshape(b, s, FOX_W)
    return (o.astype(h.dtype) * jax.nn.silu(g)) @ w_out


def _gated_linear_attention(h, w_in, w_gate2, b_gate, w_out):
    b, s, _ = h.shape
    q, k, v, g, r = jnp.split(h @ w_in, [GLA_DK, 2 * GLA_DK, 2 * GLA_DK + GLA_DV, 2 * GLA_DK + 2 * GLA_DV], axis=-1)
    log_a = jax.nn.log_sigmoid((r @ w_gate2 + b_gate).astype(jnp.float32)) / GLA_TAU
    qc = _to_chunks(q.astype(jnp.float32).reshape(b, s, GLA_HEADS, GLA_HK)) * (GLA_HK ** -0.5)
    kc = _to_chunks(k.astype(jnp.float32).reshape(b, s, GLA_HEADS, GLA_HK))
    vc = _to_chunks(v.astype(jnp.float32).reshape(b, s, GLA_HEADS, GLA_HV))
    cb = jnp.cumsum(_to_chunks(log_a.reshape(b, s, GLA_HEADS, GLA_HK)), axis=3)
    cb_last = cb[:, :, :, -1:, :]
    eb, enb = jnp.exp(cb), jnp.exp(-cb)
    a_causal = jnp.einsum('bhncd,bhnmd->bhncm', qc * eb, kc * enb)
    a_anti = jnp.einsum('bhncd,bhnmd->bhncm', qc * enb, kc * eb)
    idx = jnp.arange(CHUNK)
    attn = jnp.where(idx[:, None] >= idx[None, :], a_causal, a_anti)
    o = jnp.einsum('bhncm,bhnme->bhnce', attn, vc)
    o = o + _chunk_state_scan(qc * eb, kc * jnp.exp(cb_last - cb), vc, jnp.exp(cb_last[:, :, :, 0, :]))
    o = _rms_norm(_from_chunks(o)).reshape(b, s, GLA_DV)
    return (o.astype(h.dtype) * jax.nn.silu(g)) @ w_out


def setup_inputs(seed: int = 0) -> dict:
    key = jax.random.key(seed)
    ks = jax.random.split(key, 20)
    f32 = jnp.float32
    n_a = len(range(0, DEPTH, N_MIXERS))
    n_b = len(range(1, DEPTH, N_MIXERS))
    n_c = len(range(2, DEPTH, N_MIXERS))

    def w(k, shape, fan_in):
        return jax.random.normal(k, shape, f32) * (fan_in ** -0.5)

    x = jax.random.normal(ks[0], (BATCH, SEQ, D_MODEL), f32)
    c = jax.random.normal(ks[1], (BATCH, D_MODEL), f32)
    offs = jax.random.randint(ks[2], (BATCH, 1), 0, MAX_POS_OFFSET, dtype=jnp.int32)
    positions = (offs + jnp.arange(SEQ, dtype=jnp.int32)[None, :]).astype(jnp.int32)
    return {
        "x": x,
        "c": c,
        "positions": positions,
        "mod_w": w(ks[3], (DEPTH, D_MODEL, 3 * D_MODEL), D_MODEL),
        "mod_b": 0.01 * jax.random.normal(ks[4], (DEPTH, 3 * D_MODEL), f32),
        "norm_g": 1.0 + 0.01 * jax.random.normal(ks[5], (DEPTH, D_MODEL), f32),
        "ret_w_in": w(ks[6], (n_a, D_MODEL, RET_IN), D_MODEL),
        "ret_w_out": w(ks[7], (n_a, RET_DV, D_MODEL), RET_DV),
        "fox_w_in": w(ks[8], (n_b, D_MODEL, FOX_IN), D_MODEL),
        "fox_b_f": FOX_FORGET_BIAS + 0.1 * jax.random.normal(ks[9], (n_b, FOX_HEADS), f32),
        "fox_q_gain": 1.0 + 0.01 * jax.random.normal(ks[10], (n_b, FOX_HD), f32),
        "fox_k_gain": 1.0 + 0.01 * jax.random.normal(ks[11], (n_b, FOX_HD), f32),
        "fox_w_out": w(ks[12], (n_b, FOX_W, D_MODEL), FOX_W),
        "gla_w_in": w(ks[13], (n_c, D_MODEL, GLA_IN), D_MODEL),
        "gla_w_gate2": w(ks[14], (n_c, GLA_RANK, GLA_DK), GLA_RANK),
        "gla_b_gate": 0.01 * jax.random.normal(ks[15], (n_c, GLA_DK), f32),
        "gla_w_out": w(ks[16], (n_c, GLA_DV, D_MODEL), GLA_DV),
        "final_g": 1.0 + 0.01 * jax.random.normal(ks[17], (D_MODEL,), f32),
    }


def reference(x, c, positions, mod_w, mod_b, norm_g, ret_w_in, ret_w_out, fox_w_in, fox_b_f,
              fox_q_gain, fox_k_gain, fox_w_out, gla_w_in, gla_w_gate2, gla_b_gate, gla_w_out, final_g):
    c_act = jax.nn.silu(c)
    for i in range(DEPTH):
        shift, scale, gate = jnp.split(c_act @ mod_w[i] + mod_b[i], 3, axis=-1)
        h = _rms_norm(x, norm_g[i]) * (1.0 + scale[:, None, :]) + shift[:, None, :]
        j = i // N_MIXERS
        kind = i % N_MIXERS
        if kind == 0:
            y = _retention(h, positions, ret_w_in[j], ret_w_out[j])
        elif kind == 1:
            y = _forgetting_attention(h, fox_w_in[j], fox_b_f[j], fox_q_gain[j], fox_k_gain[j], fox_w_out[j])
        else:
            y = _gated_linear_attention(h, gla_w_in[j], gla_w_gate2[j], gla_b_gate[j], gla_w_out[j])
        x = x + gate[:, None, :] * y
    return _rms_norm(x, final_g)
```

```cpp
#include <hip/hip_runtime.h>
#include <hip/hip_cooperative_groups.h>
#include <cstdio>
#include <cstdint>
#include <cmath>
namespace cg = cooperative_groups;

#define LAS __attribute__((address_space(3)))
typedef unsigned short bf16_t;
typedef short bf16x8 __attribute__((ext_vector_type(8)));
typedef float f32x4 __attribute__((ext_vector_type(4)));
typedef float f32x2 __attribute__((ext_vector_type(2)));
typedef unsigned u32x4 __attribute__((ext_vector_type(4)));
typedef unsigned u32x2 __attribute__((ext_vector_type(2)));

constexpr int DM = 1024, NB = 4, SEQ = 4096, MT = NB * SEQ;
constexpr float EPS = 1e-6f;
constexpr int RET_IN = 6144, FOX_IN = 4112, GLA_IN = 3088;
constexpr float LOG2E = 1.4426950408889634f;

constexpr size_t MiB = 1u << 20;
constexpr size_t WS_MOD = 1 * MiB;
constexpr size_t WS_S16 = 2 * MiB;
constexpr size_t WS_CUM = 3 * MiB;
constexpr size_t WS_ROPE = 4 * MiB;
constexpr size_t WS_W = 12 * MiB;
constexpr size_t WS_WOUT = WS_W + 12 * MiB;
constexpr size_t WS_WGLA = 164 * MiB;
constexpr size_t WS_XN = 28 * MiB;
constexpr size_t WS_ACT = 60 * MiB;
constexpr size_t WS_END = 252 * MiB;

__device__ __forceinline__ unsigned f2bf(float f) { unsigned u = __builtin_bit_cast(unsigned, f); return (u + 0x7fffu + ((u >> 16) & 1u)) >> 16; }
typedef float f32x2_hw __attribute__((ext_vector_type(2))); typedef __bf16 bf16x2_hw __attribute__((ext_vector_type(2)));
__device__ __forceinline__ unsigned pk2(float lo, float hi) { f32x2_hw v = {lo, hi}; bf16x2_hw b = __builtin_convertvector(v, bf16x2_hw); return __builtin_bit_cast(unsigned, b); }
__device__ __forceinline__ float bf2f(unsigned h) { return __builtin_bit_cast(float, h << 16); }
__device__ __forceinline__ u32x2 pk4(f32x4 v) { u32x2 r; r.x = pk2(v[0], v[1]); r.y = pk2(v[2], v[3]); return r; }
__device__ __forceinline__ f32x4 unpk4(u32x2 w) { f32x4 r; r[0] = bf2f(w.x & 0xffffu); r[1] = bf2f(w.x >> 16); r[2] = bf2f(w.y & 0xffffu); r[3] = bf2f(w.y >> 16); return r; }
__device__ __forceinline__ float silu_f(float v) { return v * __builtin_amdgcn_rcpf(1.0f + __expf(-v)); }
__device__ __forceinline__ float logsig_f(float v) { return fminf(v, 0.0f) - __logf(1.0f + __expf(-fabsf(v))); }
__device__ __forceinline__ float wave_sum(float v) {
#pragma unroll
    for (int o = 1; o < 64; o <<= 1) v += __shfl_xor(v, o);
    return v;
}
#define LDS_WAIT() asm volatile("s_waitcnt lgkmcnt(0)" ::: "memory")

__device__ __forceinline__ f32x4 mma_rc(f32x4 acc, bf16x8 a_rows, bf16x8 b_cols) { return __builtin_amdgcn_mfma_f32_16x16x32_bf16(b_cols, a_rows, acc, 0, 0, 0); }
__device__ __forceinline__ f32x4 mma_cr(f32x4 acc, bf16x8 a_rows, bf16x8 b_cols) { return __builtin_amdgcn_mfma_f32_16x16x32_bf16(a_rows, b_cols, acc, 0, 0, 0); }
__device__ __forceinline__ bf16x8 gfrag(const bf16_t* base, int pitch, int lane) { return *(const bf16x8*)(base + (size_t)(lane & 15) * pitch + 8 * (lane >> 4)); }
__device__ __forceinline__ bf16x8 lfrag(const LAS bf16_t* base, int pitch, int lane) { return *(const LAS bf16x8*)(base + (lane & 15) * pitch + 8 * (lane >> 4)); }

namespace pg8 {
#define PG8_LAS __attribute__((address_space(3)))
constexpr int BM = 256, BK = 64, HALF = 128, HTB = HALF * BK * 2, STAGE_BYTES = 8 * HTB, NXCD = 8, WGM = 8;
__host__ __device__ __forceinline__ int lds_byte(int r, int c) { const int st = (r >> 4) * 2 + (c >> 5), rr = r & 15, cc = c & 31, ob = rr * 64 + cc * 2; return st * 1024 + (ob ^ (((ob >> 9) & 1) << 5)); }
__host__ __device__ __forceinline__ void stage_rc(int b, int& R, int& C) { const int st = b / 1024, sb = b % 1024, swz = sb ^ (((sb >> 9) & 1) << 5); R = (st >> 1) * 16 + swz / 64; C = (st & 1) * 32 + (swz % 64) / 2; }
__host__ __device__ __forceinline__ int perm32(int rho) { const int n = rho >> 4, i = rho & 15; return 8 * (i >> 2) + 4 * n + (i & 3); }

struct Unit { int pm, pn; };
struct Gemm { const bf16_t* A; const bf16_t* Bt; int M, N, K; };
struct StaticOrder {
    int nM, nN, nwg, G, c;
    __host__ __device__ void init(int M, int N, int G_, int c_) { nM = M / BM; nN = N / BM; nwg = nM * nN; G = G_; c = c_; }
    __host__ __device__ bool next(int i, Unit& u) const {
        const long L = (long)i * G + c; if (L >= nwg) return false;
        int wgid = (int)L; { const int q = nwg / NXCD, r = nwg % NXCD, xcd = wgid % NXCD, off = wgid / NXCD; wgid = (xcd < r ? xcd * (q + 1) : r * (q + 1) + (xcd - r) * q) + off; }
        const int nig = WGM * nN, gid = wgid / nig, fm = gid * WGM, gsz = (nM - fm) < WGM ? (nM - fm) : WGM;
        u.pm = fm + ((wgid % nig) % gsz); u.pn = (wgid % nig) / gsz; return true;
    }
    __device__ __forceinline__ void a_ready(const Unit&) const {}
    __device__ __forceinline__ void done(const Unit&) const {}
};

struct PairOrder {
    int G, c;
    __device__ __forceinline__ bool next(int i, Unit& u) const { const int pair = (i >> 1) * G + c; if (pair >= 256) return false; u.pm = pair >> 2; u.pn = 2 * (pair & 3) + (i & 1); return true; }
    __device__ __forceinline__ void a_ready(const Unit&) const {}
    __device__ __forceinline__ void done(const Unit&) const {}
};
template <class Epi, class Sched, bool ALIGN_EPI = false, bool SP2 = false>
__device__ __forceinline__ void gemm_phase(PG8_LAS unsigned char* lds, const Gemm g, const Sched& S, const Epi& E, int tid) {
    const int wid = __builtin_amdgcn_readfirstlane(tid >> 6), lane = tid & 63, wr = wid >> 2, wc = wid & 3, fr = lane & 15, fq = lane >> 4;
    const int K = g.K, nt = K / BK;
    unsigned voffA[2], voffB[2];
#pragma unroll
    for (int i = 0; i < 2; ++i) { int R, C; stage_rc(tid * 16 + i * 8192, R, C); const int Rb = Epi::PERM ? ((R & ~31) + perm32(R & 31)) : R;
        voffA[i] = (unsigned)(R * K + C) * 2u; voffB[i] = (unsigned)(Rb * K + C) * 2u; }
    const size_t kstep = (size_t)(BK * 2);
    const size_t hstep = (size_t)HALF * K * 2;
    const size_t tstep = 2 * hstep;
    const unsigned ldsw = (unsigned)wid * 1024u;
    const int aoff = lds_byte(wr * 64 + fr, fq * 8), boff = lds_byte(wc * 32 + fr, fq * 8);
#define PG8_SA(b, h) (((b) * 2 + (h)) * HTB)
#define PG8_SB(b, h) ((4 + (b) * 2 + (h)) * HTB)
#define PG8_STAGE(bufoff, gbase, voff) do { _Pragma("unroll") for (int _i = 0; _i < 2; ++_i) \
        __builtin_amdgcn_global_load_lds((const unsigned*)((const char*)(gbase) + (voff)[_i]), (PG8_LAS unsigned*)(lds + (bufoff) + ldsw + _i * 8192), 16, 0, 0); } while (0)
#define PG8_LDA(dst, b, h) do { _Pragma("unroll") for (int m = 0; m < 4; ++m) _Pragma("unroll") for (int k = 0; k < 2; ++k) dst[m][k] = *(const PG8_LAS bf16x8*)(lds + PG8_SA(b, h) + aoff + m * 2048 + k * 1024); } while (0)
#define PG8_LDB(dst, b, h) do { _Pragma("unroll") for (int n = 0; n < 2; ++n) _Pragma("unroll") for (int k = 0; k < 2; ++k) dst[n][k] = *(const PG8_LAS bf16x8*)(lds + PG8_SB(b, h) + boff + n * 2048 + k * 1024); } while (0)
#define PG8_MMA(ai, bj, At, Bt) do { __builtin_amdgcn_s_setprio(1); _Pragma("unroll") for (int m = 0; m < 4; ++m) _Pragma("unroll") for (int n = 0; n < 2; ++n) _Pragma("unroll") for (int k = 0; k < 2; ++k) \
        acc[ai][bj][m][n] = __builtin_amdgcn_mfma_f32_16x16x32_bf16(Bt[n][k], At[m][k], acc[ai][bj][m][n], 0, 0, 0); __builtin_amdgcn_s_setprio(0); } while (0)
#define PG8_WAIT_V(n) asm volatile("s_waitcnt vmcnt(" #n ")" ::: "memory")
#define PG8_WAIT_L(n) asm volatile("s_waitcnt lgkmcnt(" #n ")" ::: "memory")
#define PG8_BAR __builtin_amdgcn_s_barrier()
#define PG8_SCHED __builtin_amdgcn_sched_barrier(0)
    Unit cur, nxt; int ui = 0;
    if (!S.next(0, cur)) return;
    f32x4 acc[2][2][4][2];
#pragma unroll
    for (int a = 0; a < 2; ++a)
#pragma unroll
        for (int b = 0; b < 2; ++b)
#pragma unroll
            for (int m = 0; m < 4; ++m)
#pragma unroll
                for (int n = 0; n < 2; ++n) acc[a][b][m][n] = (f32x4){0.f, 0.f, 0.f, 0.f};
    bf16x8 At[4][2], B0[2][2], B1[2][2];
    const char* cA = (const char*)g.A + (size_t)cur.pm * tstep; const char* cB = (const char*)g.Bt + (size_t)cur.pn * tstep;
    S.a_ready(cur);
    if constexpr (SP2) {
        PG8_STAGE(PG8_SB(0, 0), cB, voffB); PG8_STAGE(PG8_SB(0, 1), cB + hstep, voffB); PG8_STAGE(PG8_SA(0, 0), cA, voffA); PG8_STAGE(PG8_SA(0, 1), cA + hstep, voffA);
        if (wr == 1) PG8_BAR;
        PG8_WAIT_V(2); PG8_BAR;
        PG8_STAGE(PG8_SB(1, 0), cB + kstep, voffB); PG8_STAGE(PG8_SA(1, 0), cA + kstep, voffA); PG8_STAGE(PG8_SB(1, 1), cB + hstep + kstep, voffB);
        PG8_WAIT_V(6); PG8_BAR;
    } else {
        PG8_STAGE(PG8_SB(0, 0), cB, voffB); PG8_STAGE(PG8_SA(0, 0), cA, voffA); PG8_STAGE(PG8_SB(0, 1), cB + hstep, voffB); PG8_STAGE(PG8_SA(0, 1), cA + hstep, voffA);
        if (wr == 1) PG8_BAR;
        PG8_WAIT_V(4); PG8_BAR;
        PG8_STAGE(PG8_SB(1, 0), cB + kstep, voffB); PG8_STAGE(PG8_SA(1, 0), cA + kstep, voffA); PG8_STAGE(PG8_SB(1, 1), cB + hstep + kstep, voffB);
        PG8_WAIT_V(6); PG8_BAR;
    }
    for (;;) {
        const bool has_next = S.next(ui + 1, nxt);
        const char* nA = has_next ? (const char*)g.A + (size_t)nxt.pm * tstep : cA; const char* nB = has_next ? (const char*)g.Bt + (size_t)nxt.pn * tstep : cB;
        for (int t = 0; t < nt; t += 2) {
            const bool last = (t == nt - 2);
            const char* a1 = cA + (size_t)(t + 1) * kstep;
            const char* a2 = last ? nA : cA + (size_t)(t + 2) * kstep; const char* b2 = last ? nB : cB + (size_t)(t + 2) * kstep;
            const char* a3 = a2 + kstep; const char* b3 = b2 + kstep;
            if (last && has_next) S.a_ready(nxt);
            if constexpr (SP2) {
            PG8_LDB(B0, 0, 0); PG8_LDB(B1, 0, 1); PG8_SCHED; PG8_LDA(At, 0, 0); PG8_STAGE(PG8_SA(1, 1), a1 + hstep, voffA);
            PG8_WAIT_V(8); PG8_WAIT_L(0); PG8_BAR; PG8_MMA(0, 0, At, B0); PG8_MMA(0, 1, At, B1); PG8_BAR; PG8_SCHED;
            PG8_LDA(At, 0, 1); PG8_STAGE(PG8_SB(0, 0), b2, voffB); PG8_STAGE(PG8_SB(0, 1), b2 + hstep, voffB); PG8_STAGE(PG8_SA(0, 0), a2, voffA);
            PG8_WAIT_V(8); PG8_WAIT_L(0); PG8_BAR; PG8_MMA(1, 0, At, B0); PG8_MMA(1, 1, At, B1); PG8_BAR; PG8_SCHED;
            PG8_LDB(B0, 1, 0); PG8_LDB(B1, 1, 1); PG8_SCHED; PG8_LDA(At, 1, 0); PG8_STAGE(PG8_SA(0, 1), a2 + hstep, voffA);
            PG8_WAIT_V(8); PG8_WAIT_L(0); PG8_BAR; PG8_MMA(0, 0, At, B0); PG8_MMA(0, 1, At, B1); PG8_BAR; PG8_SCHED;
            PG8_LDA(At, 1, 1); PG8_STAGE(PG8_SB(1, 0), b3, voffB); PG8_STAGE(PG8_SB(1, 1), b3 + hstep, voffB); PG8_STAGE(PG8_SA(1, 0), a3, voffA);
            PG8_WAIT_V(8); PG8_WAIT_L(0); PG8_BAR; PG8_MMA(1, 0, At, B0); PG8_MMA(1, 1, At, B1); PG8_BAR; PG8_SCHED;
            } else {
            PG8_LDB(B0, 0, 0); PG8_SCHED; PG8_LDA(At, 0, 0); PG8_STAGE(PG8_SA(1, 1), a1 + hstep, voffA);
            PG8_WAIT_L(8); PG8_BAR; PG8_WAIT_L(0); PG8_MMA(0, 0, At, B0); PG8_BAR; PG8_SCHED;
            PG8_LDB(B1, 0, 1); PG8_STAGE(PG8_SB(0, 0), b2, voffB);
            PG8_BAR; PG8_WAIT_L(0); PG8_MMA(0, 1, At, B1); PG8_BAR;
            PG8_LDA(At, 0, 1); PG8_STAGE(PG8_SA(0, 0), a2, voffA);
            PG8_BAR; PG8_WAIT_L(0); PG8_MMA(1, 0, At, B0); PG8_BAR; PG8_SCHED;
            PG8_STAGE(PG8_SB(0, 1), b2 + hstep, voffB);
            PG8_WAIT_V(6); PG8_BAR; PG8_MMA(1, 1, At, B1); PG8_BAR;
            PG8_LDB(B0, 1, 0); PG8_SCHED; PG8_LDA(At, 1, 0); PG8_STAGE(PG8_SA(0, 1), a2 + hstep, voffA);
            PG8_WAIT_L(8); PG8_BAR; PG8_WAIT_L(0); PG8_MMA(0, 0, At, B0); PG8_BAR; PG8_SCHED;
            PG8_LDB(B1, 1, 1); PG8_STAGE(PG8_SB(1, 0), b3, voffB);
            PG8_BAR; PG8_WAIT_L(0); PG8_MMA(0, 1, At, B1); PG8_BAR;
            PG8_LDA(At, 1, 1); PG8_STAGE(PG8_SA(1, 0), a3, voffA);
            PG8_BAR; PG8_WAIT_L(0); PG8_MMA(1, 0, At, B0); PG8_BAR; PG8_SCHED;
            PG8_STAGE(PG8_SB(1, 1), b3 + hstep, voffB);
            PG8_WAIT_V(6); PG8_BAR; PG8_MMA(1, 1, At, B1); PG8_BAR;
            }
        }
        if constexpr (ALIGN_EPI) { if (wr == 0) PG8_BAR; }
        E(acc, cur, wr, wc, fr, fq); S.done(cur);
        if (!has_next) break;
#pragma unroll
        for (int a = 0; a < 2; ++a)
#pragma unroll
            for (int b = 0; b < 2; ++b)
#pragma unroll
                for (int m = 0; m < 4; ++m)
#pragma unroll
                    for (int n = 0; n < 2; ++n) acc[a][b][m][n] = (f32x4){0.f, 0.f, 0.f, 0.f};
        cur = nxt; cA = nA; cB = nB; ++ui;
        if constexpr (ALIGN_EPI) { if (wr == 1) PG8_BAR; }
    }
    PG8_WAIT_V(0);
    if constexpr (!ALIGN_EPI) { if (wr == 0) PG8_BAR; }
    PG8_BAR;
#undef PG8_SA
#undef PG8_SB
#undef PG8_STAGE
#undef PG8_LDA
#undef PG8_LDB
#undef PG8_MMA
#undef PG8_WAIT_V
#undef PG8_WAIT_L
#undef PG8_BAR
#undef PG8_SCHED
}
}

struct Params {
    const float* x; const float* c; const int* pos; const float* mod_w; const float* mod_b; const float* norm_g;
    const float* ret_w_in; const float* ret_w_out; const float* fox_w_in; const float* fox_b_f; const float* fox_q_gain; const float* fox_k_gain; const float* fox_w_out;
    const float* gla_w_in; const float* gla_w_gate2; const float* gla_b_gate; const float* gla_w_out; const float* final_g;
    float* out; unsigned char* ws;
};

struct EpiRetIn {
    static constexpr bool PERM = false;
    bf16_t* Q; bf16_t* Kb; bf16_t* V; const unsigned* rope;
    __device__ __forceinline__ void operator()(const f32x4 (&acc)[2][2][4][2], const pg8::Unit& u, int wr, int wc, int fr, int fq) const {
        const int pn = u.pn;
        if (pn < 8) {
            bf16_t* dst = (pn < 4) ? Q : Kb; const int head = pn & 3; const float sc = (pn < 4) ? 0.0625f : 1.0f;
#pragma unroll
            for (int ai = 0; ai < 2; ++ai) {
                u32x4 cs[4][2];
#pragma unroll
                for (int m = 0; m < 4; ++m)
#pragma unroll
                    for (int n = 0; n < 2; ++n) cs[m][n] = *(const u32x4*)(rope + (size_t)(u.pm * 256 + ai * 128 + wr * 64 + m * 16 + fr) * 128 + wc * 32 + n * 16 + fq * 4);
                asm volatile("" ::: "memory");
#pragma unroll
                for (int m = 0; m < 4; ++m) {
                    const int row = u.pm * 256 + ai * 128 + wr * 64 + m * 16 + fr;
#pragma unroll
                    for (int n = 0; n < 2; ++n) {
                        const int d1 = wc * 32 + n * 16 + fq * 4;
                        const f32x4 x1 = acc[ai][0][m][n], x2 = acc[ai][1][m][n]; f32x4 o1, o2;
#pragma unroll
                        for (int j = 0; j < 4; ++j) {
                            const unsigned w = cs[m][n][j];
                            const float co = (float)__builtin_bit_cast(_Float16, (unsigned short)(w & 0xffffu)), si = (float)__builtin_bit_cast(_Float16, (unsigned short)(w >> 16));
                            o1[j] = (x1[j] * co - x2[j] * si) * sc; o2[j] = (x1[j] * si + x2[j] * co) * sc;
                        }
                        bf16_t* p = dst + (size_t)row * 1024 + head * 256 + d1;
                        *(u32x2*)p = pk4(o1); *(u32x2*)(p + 128) = pk4(o2);
                    }
                }
            }
        } else {
            const int cbase = (pn - 8) * 256;
#pragma unroll
            for (int ai = 0; ai < 2; ++ai)
#pragma unroll
                for (int m = 0; m < 4; ++m) {
                    const int row = u.pm * 256 + ai * 128 + wr * 64 + m * 16 + fr;
#pragma unroll
                    for (int bj = 0; bj < 2; ++bj)
#pragma unroll
                        for (int n = 0; n < 2; ++n) *(u32x2*)(V + (size_t)row * 2048 + cbase + bj * 128 + wc * 32 + n * 16 + fq * 4) = pk4(acc[ai][bj][m][n]);
                }
        }
    }
};
struct EpiSplit {
    static constexpr bool PERM = false;
    bf16_t* dst; int tpg; size_t gstride; int ldc; int silu_grp;
    __device__ __forceinline__ void operator()(const f32x4 (&acc)[2][2][4][2], const pg8::Unit& u, int wr, int wc, int fr, int fq) const {
        const int t = u.pn / tpg; bf16_t* base = dst + (size_t)t * gstride; const int cb = (u.pn - t * tpg) * 256; const bool act = (t == silu_grp);
#pragma unroll
        for (int ai = 0; ai < 2; ++ai)
#pragma unroll
            for (int m = 0; m < 4; ++m) {
                const int row = u.pm * 256 + ai * 128 + wr * 64 + m * 16 + fr;
#pragma unroll
                for (int bj = 0; bj < 2; ++bj)
#pragma unroll
                    for (int n = 0; n < 2; ++n) {
                        f32x4 a = acc[ai][bj][m][n];
                        if (act) {
#pragma unroll
                            for (int j = 0; j < 4; ++j) a[j] = silu_f(a[j]);
                        }
                        *(u32x2*)(base + (size_t)row * ldc + cb + bj * 128 + wc * 32 + n * 16 + fq * 4) = pk4(a);
                    }
            }
    }
};
struct EpiFoxIn {
    static constexpr bool PERM = false;
    bf16_t* dst; const float* qgain; const float* kgain; LAS float* tbl;
    __device__ __forceinline__ void operator()(const f32x4 (&acc)[2][2][4][2], const pg8::Unit& u, int wr, int wc, int fr, int fq) const {
        const int t = u.pn >> 2; bf16_t* base = dst + (size_t)t * ((size_t)16 * MiB); const int cb = (u.pn & 3) * 256;
        if (t < 2) {
#pragma unroll
            for (int ai = 0; ai < 2; ++ai)
#pragma unroll
                for (int m = 0; m < 4; ++m)
#pragma unroll
                    for (int bj = 0; bj < 2; ++bj) {
                        float sq = 0.f;
#pragma unroll
                        for (int n = 0; n < 2; ++n) { const f32x4 a = acc[ai][bj][m][n]; sq += (a[0] * a[0] + a[1] * a[1]) + (a[2] * a[2] + a[3] * a[3]); }
                        sq += __shfl_xor(sq, 16); sq += __shfl_xor(sq, 32);
                        if (fq == 0) tbl[(((ai * 128 + wr * 64 + m * 16 + fr) * 4) + bj * 2 + (wc >> 1)) * 2 + (wc & 1)] = sq;
                    }
            asm volatile("s_waitcnt lgkmcnt(0)" ::: "memory"); __builtin_amdgcn_s_barrier(); asm volatile("" ::: "memory");
            const float* gn = (t == 0) ? qgain : kgain; const float sc = (t == 0) ? (0.125f * LOG2E) : 1.0f;
            f32x4 gv[2];
#pragma unroll
            for (int n = 0; n < 2; ++n) gv[n] = *(const f32x4*)(gn + (wc & 1) * 32 + n * 16 + fq * 4) * sc;
#pragma unroll
            for (int ai = 0; ai < 2; ++ai)
#pragma unroll
                for (int m = 0; m < 4; ++m) {
                    const int rl = ai * 128 + wr * 64 + m * 16 + fr; const int row = u.pm * 256 + rl;
#pragma unroll
                    for (int bj = 0; bj < 2; ++bj) {
                        const f32x2 pr = *(const LAS f32x2*)(tbl + ((rl * 4) + bj * 2 + (wc >> 1)) * 2);
                        const float rstd = __builtin_amdgcn_rsqf((pr.x + pr.y) * (1.0f / 64.0f) + EPS);
#pragma unroll
                        for (int n = 0; n < 2; ++n) *(u32x2*)(base + (size_t)row * 1024 + cb + bj * 128 + wc * 32 + n * 16 + fq * 4) = pk4(acc[ai][bj][m][n] * rstd * gv[n]);
                    }
                }
        } else {
            const bool act = (t == 3);
#pragma unroll
            for (int ai = 0; ai < 2; ++ai)
#pragma unroll
                for (int m = 0; m < 4; ++m) {
                    const int row = u.pm * 256 + ai * 128 + wr * 64 + m * 16 + fr;
#pragma unroll
                    for (int bj = 0; bj < 2; ++bj)
#pragma unroll
                        for (int n = 0; n < 2; ++n) {
                            f32x4 a = acc[ai][bj][m][n];
                            if (act) {
#pragma unroll
                                for (int j = 0; j < 4; ++j) a[j] = silu_f(a[j]);
                            }
                            *(u32x2*)(base + (size_t)row * 1024 + cb + bj * 128 + wc * 32 + n * 16 + fq * 4) = pk4(a);
                        }
                }
        }
    }
};
struct EpiGlaIn {
    static constexpr bool PERM = false;
    bf16_t *QE, *QN, *KE, *KN, *V, *G; const float* CB;
    __device__ __forceinline__ void operator()(const f32x4 (&acc)[2][2][4][2], const pg8::Unit& u, int wr, int wc, int fr, int fq) const {
        const int pn = u.pn;
        if (pn < 4) {
            const float s = (pn < 2) ? 0.08838834764831845f : 1.0f;
            bf16_t* De = (pn < 2 ? QE : KE); bf16_t* Dn = (pn < 2 ? QN : KN);
#pragma unroll
            for (int ai = 0; ai < 2; ++ai)
#pragma unroll
            for (int mh = 0; mh < 2; ++mh) {
                f32x4 cb[2][2][2];
#pragma unroll
                for (int mm = 0; mm < 2; ++mm)
#pragma unroll
                    for (int bj = 0; bj < 2; ++bj)
#pragma unroll
                        for (int n = 0; n < 2; ++n) cb[mm][bj][n] = *(const f32x4*)(CB + (size_t)(u.pm * 256 + ai * 128 + wr * 64 + (2 * mh + mm) * 16 + fr) * 512 + (pn & 1) * 256 + bj * 128 + wc * 32 + n * 16 + fq * 4);
                asm volatile("" ::: "memory");
#pragma unroll
                for (int mm = 0; mm < 2; ++mm) {
                    const int m = 2 * mh + mm; const int row = u.pm * 256 + ai * 128 + wr * 64 + m * 16 + fr;
#pragma unroll
                    for (int bj = 0; bj < 2; ++bj)
#pragma unroll
                        for (int n = 0; n < 2; ++n) {
                            const int col = (pn & 1) * 256 + bj * 128 + wc * 32 + n * 16 + fq * 4;
                            const f32x4 a = acc[ai][bj][m][n]; f32x4 e, en;
#pragma unroll
                            for (int j = 0; j < 4; ++j) { const float ee = __expf(cb[mm][bj][n][j]); e[j] = a[j] * s * ee; en[j] = a[j] * s * __builtin_amdgcn_rcpf(ee); }
                            *(u32x2*)(De + (size_t)row * 512 + col) = pk4(e); *(u32x2*)(Dn + (size_t)row * 512 + col) = pk4(en);
                        }
                }
                asm volatile("" ::: "memory");
            }
        } else {
#pragma unroll
            for (int ai = 0; ai < 2; ++ai)
#pragma unroll
                for (int m = 0; m < 4; ++m) {
                    const int row = u.pm * 256 + ai * 128 + wr * 64 + m * 16 + fr;
#pragma unroll
                    for (int bj = 0; bj < 2; ++bj)
#pragma unroll
                        for (int n = 0; n < 2; ++n) *(u32x2*)(V + (size_t)row * 1024 + (pn - 4) * 256 + bj * 128 + wc * 32 + n * 16 + fq * 4) = pk4(acc[ai][bj][m][n]);
                }
        }
    }
};
struct EpiNone {
    static constexpr bool PERM = false; float* sink;
    __device__ __forceinline__ void operator()(const f32x4 (&acc)[2][2][4][2], const pg8::Unit& u, int wr, int wc, int fr, int fq) const {
        f32x4 t = acc[0][0][0][0];
#pragma unroll
        for (int ai = 0; ai < 2; ++ai)
#pragma unroll
            for (int bj = 0; bj < 2; ++bj)
#pragma unroll
                for (int m = 0; m < 4; ++m)
#pragma unroll
                    for (int n = 0; n < 2; ++n) t += acc[ai][bj][m][n];
        if (t[0] + t[1] + t[2] + t[3] == 12345.678f) sink[0] = t[0];
    }
};
struct EpiOut {
    static constexpr bool PERM = false;
    const float* xold; float* xnew; const float* gate;
    __device__ __forceinline__ void operator()(const f32x4 (&acc)[2][2][4][2], const pg8::Unit& u, int wr, int wc, int fr, int fq) const {
        const int b = (u.pm * 256) >> 12;
        f32x4 gv[2][2];
#pragma unroll
        for (int bj = 0; bj < 2; ++bj)
#pragma unroll
            for (int n = 0; n < 2; ++n) gv[bj][n] = *(const f32x4*)(gate + (size_t)b * 3072 + u.pn * 256 + bj * 128 + wc * 32 + n * 16 + fq * 4);
#pragma unroll
        for (int ai = 0; ai < 2; ++ai)
#pragma unroll
            for (int mh = 0; mh < 2; ++mh) {
                f32x4 xo[2][2][2];
#pragma unroll
                for (int mm = 0; mm < 2; ++mm)
#pragma unroll
                    for (int bj = 0; bj < 2; ++bj)
#pragma unroll
                        for (int n = 0; n < 2; ++n) xo[mm][bj][n] = *(const f32x4*)(xold + (size_t)(u.pm * 256 + ai * 128 + wr * 64 + (2 * mh + mm) * 16 + fr) * 1024 + u.pn * 256 + bj * 128 + wc * 32 + n * 16 + fq * 4);
                asm volatile("" ::: "memory");
#pragma unroll
                for (int mm = 0; mm < 2; ++mm)
#pragma unroll
                    for (int bj = 0; bj < 2; ++bj)
#pragma unroll
                        for (int n = 0; n < 2; ++n)
                            *(f32x4*)(xnew + (size_t)(u.pm * 256 + ai * 128 + wr * 64 + (2 * mh + mm) * 16 + fr) * 1024 + u.pn * 256 + bj * 128 + wc * 32 + n * 16 + fq * 4) = xo[mm][bj][n] + gv[bj][n] * acc[ai][bj][2 * mh + mm][n];
                asm volatile("" ::: "memory");
            }
    }
};

__device__ __forceinline__ void transpose_item(const float* W, int ldw, int K, int nblk, bf16_t* WT, LAS float* scr, int item, int lane) {
    const int kb = item / nblk, nb = item % nblk, k0 = 64 * kb, n0 = 32 * nb;
#pragma unroll 8
    for (int i = 0; i < 32; ++i) { const int kk = 2 * i + (lane >> 5); scr[kk * 33 + (lane & 31)] = W[(size_t)(k0 + kk) * ldw + n0 + (lane & 31)]; }
    LDS_WAIT(); asm volatile("" ::: "memory");
    const int c = lane & 7;
#pragma unroll
    for (int j = 0; j < 4; ++j) { const int n = (lane >> 3) + 8 * j; const LAS float* s = scr + (8 * c) * 33 + n;
        u32x4 o; o.x = pk2(s[0 * 33], s[1 * 33]); o.y = pk2(s[2 * 33], s[3 * 33]); o.z = pk2(s[4 * 33], s[5 * 33]); o.w = pk2(s[6 * 33], s[7 * 33]);
        *(u32x4*)(WT + (size_t)(n0 + n) * K + k0 + 8 * c) = o; }
    LDS_WAIT(); asm volatile("" ::: "memory");
}
__device__ __forceinline__ void conv_weights(const float* w_in, int ld_in, int n_in, const float* w_out, int k_out, unsigned char* wdst, LAS unsigned char* lds, int tid, int bid, int G) {
    const int lane = tid & 63, wave = tid >> 6;
    LAS float* scr = (LAS float*)(lds + wave * 16384);
    const int gw = bid * 8 + wave, NGW = G * 8;
    const int I_in = (1024 / 64) * (n_in / 32), I_out = (k_out / 64) * (1024 / 32);
    bf16_t* WinT = (bf16_t*)wdst; bf16_t* WoutT = (bf16_t*)(wdst + 12 * MiB);
    for (int it = gw; it < I_in + I_out; it += NGW) {
        if (it < I_in) transpose_item(w_in, ld_in, 1024, n_in / 32, WinT, scr, it, lane);
        else transpose_item(w_out, 1024, k_out, 32, WoutT, scr, it - I_in, lane);
    }
}
__device__ __forceinline__ void p0_mod(const Params& P, LAS unsigned char* lds, int tid, int bid, int G) {
    LAS float* sc = (LAS float*)lds;
    LAS float* red = sc + 4096;
    const int lane = tid & 63, wave = tid >> 6;
    float* MOD = (float*)(P.ws + WS_MOD);
    for (int i = tid; i < 4096; i += 512) sc[i] = silu_f(P.c[i]);
    __syncthreads();
    for (int it = bid; it < 192; it += G) {
        const int l = it / 48, cb = it % 48, n = cb * 64 + lane;
        const float* W = P.mod_w + (size_t)l * 1024 * 3072 + n;
        float a0 = 0.f, a1 = 0.f, a2 = 0.f, a3 = 0.f;
        const int k0 = wave * 128;
#pragma unroll 8
        for (int k = k0; k < k0 + 128; ++k) { const float w = W[(size_t)k * 3072]; a0 += sc[k] * w; a1 += sc[1024 + k] * w; a2 += sc[2048 + k] * w; a3 += sc[3072 + k] * w; }
        red[(wave * 4 + 0) * 64 + lane] = a0; red[(wave * 4 + 1) * 64 + lane] = a1; red[(wave * 4 + 2) * 64 + lane] = a2; red[(wave * 4 + 3) * 64 + lane] = a3;
        __syncthreads();
        if (wave < 4) { float s = 0.f;
#pragma unroll
            for (int w = 0; w < 8; ++w) s += red[(w * 4 + wave) * 64 + lane];
            MOD[(size_t)(l * 4 + wave) * 3072 + n] = s + P.mod_b[l * 3072 + n]; }
        __syncthreads();
    }
}
__device__ __forceinline__ void p0_rope(const Params& P, int tid, int bid, int G) {
    unsigned* rope = (unsigned*)(P.ws + WS_ROPE);
    const int gt = bid * 512 + tid, NT = G * 512;
    for (int idx = gt; idx < MT * 128; idx += NT) {
        const int row = idx >> 7, d = idx & 127;
        const float inv = powf(10000.0f, -(float)d * (1.0f / 128.0f));
        const float ang = (float)P.pos[row] * inv;
        double t = (double)ang * 0.15915494309189535; t -= rint(t);
        const float fr = (float)t;
        const float co = __builtin_amdgcn_cosf(fr), si = __builtin_amdgcn_sinf(fr);
        const unsigned lo = __builtin_bit_cast(unsigned short, (_Float16)co), hi = __builtin_bit_cast(unsigned short, (_Float16)si);
        rope[idx] = lo | (hi << 16);
    }
}

template <int KIND>
__device__ __forceinline__ void h_phase(const Params& P, int layer, const float* xin, LAS unsigned char* lds, int tid, int bid, int G) {
    const int lane = tid & 63, wave = tid >> 6;
    LAS float* WxT = (LAS float*)lds;
    LAS float* W2 = (LAS float*)(lds + 65536);
    LAS float* TOT = (LAS float*)(lds + 98304);
    const float* MOD = (const float*)(P.ws + WS_MOD);
    bf16_t* XN = (bf16_t*)(P.ws + WS_XN);
    if (KIND > 0) {
        const float* wsrc = (KIND == 1) ? (P.fox_w_in + 4096) : (P.gla_w_in + 3072); const int ldw = (KIND == 1) ? FOX_IN : GLA_IN;
        {
            float wv[32];
#pragma unroll
            for (int it = 0; it < 32; ++it) { const int idx = tid + 512 * it; wv[it] = wsrc[(size_t)(idx >> 4) * ldw + (idx & 15)]; }
#pragma unroll
            for (int it = 0; it < 32; ++it) { const int idx = tid + 512 * it; WxT[(idx & 15) * 1024 + (idx >> 4)] = wv[it]; }
        }
        if (KIND == 2) {
            float w2v[16];
#pragma unroll
            for (int it = 0; it < 16; ++it) w2v[it] = P.gla_w_gate2[tid + 512 * it];
#pragma unroll
            for (int it = 0; it < 16; ++it) W2[tid + 512 * it] = w2v[it];
        }
        __syncthreads();
    }
    for (int ci = bid; ci < MT / 64; ci += G) {
        const int b = ci >> 6;
        if (KIND != 1) ((float*)(P.ws + WS_S16))[ci * 512 + tid] = 0.f;
        const float* mod = MOD + (size_t)(layer * 4 + b) * 3072;
        f32x4 ga[4], sh[4];
#pragma unroll
        for (int j = 0; j < 4; ++j) { const int col = 4 * lane + 256 * j;
            const f32x4 g4 = *(const f32x4*)(P.norm_g + layer * 1024 + col), s4 = *(const f32x4*)(mod + 1024 + col);
            ga[j] = g4 * (s4 + 1.0f); sh[j] = *(const f32x4*)(mod + col); }
        float run[8]; f32x4 cbv[8][2];
        if (KIND == 2) {
#pragma unroll
            for (int c = 0; c < 8; ++c) run[c] = 0.f;
        }
        if constexpr (KIND == 1) {
        constexpr int BS = (KIND == 2) ? 2 : 4;
#pragma unroll (KIND == 2 ? 8 / BS : 1)
        for (int rb = 0; rb < 8; rb += BS) {
            asm volatile("" ::: "memory");
            f32x4 xv[BS][4];
#pragma unroll
            for (int bb = 0; bb < BS; ++bb) { const f32x4* xr = (const f32x4*)(xin + (size_t)(ci * 64 + wave * 8 + rb + bb) * 1024) + lane;
#pragma unroll
                for (int j = 0; j < 4; ++j) xv[bb][j] = xr[64 * j]; }
#pragma unroll
        for (int bb = 0; bb < BS; ++bb) {
            const int rr = rb + bb;
            asm volatile("" ::: "memory");
            const int row = ci * 64 + wave * 8 + rr;
            f32x4 v[4]; float ss = 0.f;
#pragma unroll
            for (int j = 0; j < 4; ++j) { v[j] = xv[bb][j]; ss += (v[j][0] * v[j][0] + v[j][1] * v[j][1]) + (v[j][2] * v[j][2] + v[j][3] * v[j][3]); }
            const float rstd = rsqrtf(wave_sum(ss) * (1.0f / 1024.0f) + EPS);
#pragma unroll
            for (int j = 0; j < 4; ++j) { v[j] = (v[j] * rstd) * ga[j] + sh[j]; *(u32x2*)(XN + (size_t)row * 1024 + 4 * lane + 256 * j) = pk4(v[j]); }
            if (KIND > 0) {
                float r[16];
#pragma unroll
                for (int i = 0; i < 16; ++i) { float a = 0.f;
#pragma unroll
                    for (int j = 0; j < 4; ++j) { const f32x4 w = *(const LAS f32x4*)(WxT + i * 1024 + 4 * lane + 256 * j); a += (v[j][0] * w[0] + v[j][1] * w[1]) + (v[j][2] * w[2] + v[j][3] * w[3]); }
                    r[i] = a; }
                if (KIND == 1) {
                    float b8[8], c4[4], d2[2], e1;
                    { const bool hi = (lane & 32) != 0;
#pragma unroll
                      for (int i = 0; i < 8; ++i) { const float snd = hi ? r[i] : r[i + 8], kp = hi ? r[i + 8] : r[i]; b8[i] = kp + __shfl_xor(snd, 32); } }
                    { const bool hi = (lane & 16) != 0;
#pragma unroll
                      for (int i = 0; i < 4; ++i) { const float snd = hi ? b8[i] : b8[i + 4], kp = hi ? b8[i + 4] : b8[i]; c4[i] = kp + __shfl_xor(snd, 16); } }
                    { const bool hi = (lane & 8) != 0;
#pragma unroll
                      for (int i = 0; i < 2; ++i) { const float snd = hi ? c4[i] : c4[i + 2], kp = hi ? c4[i + 2] : c4[i]; d2[i] = kp + __shfl_xor(snd, 8); } }
                    { const bool hi = (lane & 4) != 0; const float snd = hi ? d2[0] : d2[1], kp = hi ? d2[1] : d2[0]; e1 = kp + __shfl_xor(snd, 4); }
                    e1 += __shfl_xor(e1, 2); e1 += __shfl_xor(e1, 1);
                    const int idx = ((lane >> 5) & 1) * 8 + ((lane >> 4) & 1) * 4 + ((lane >> 3) & 1) * 2 + ((lane >> 2) & 1);
                    if ((lane & 3) == 0) ((float*)(P.ws + WS_S16))[(size_t)row * 16 + idx] = logsig_f(e1 + P.fox_b_f[idx]);
                } else {
                    f32x4 z0 = *(const f32x4*)(P.gla_b_gate + 8 * lane), z1 = *(const f32x4*)(P.gla_b_gate + 8 * lane + 4);
#pragma unroll
                    for (int i = 0; i < 16; ++i) { const f32x4 w0 = *(const LAS f32x4*)(W2 + i * 512 + 8 * lane), w1 = *(const LAS f32x4*)(W2 + i * 512 + 8 * lane + 4); z0 += w0 * r[i]; z1 += w1 * r[i]; }
#pragma unroll
                    for (int c = 0; c < 4; ++c) { run[c] += logsig_f(z0[c]) * 0.0625f; run[4 + c] += logsig_f(z1[c]) * 0.0625f; }
                    cbv[rr][0] = (f32x4){run[0], run[1], run[2], run[3]}; cbv[rr][1] = (f32x4){run[4], run[5], run[6], run[7]};
                }
            }
        }
        }
        } else {
        constexpr int BS = (KIND == 0) ? 4 : 2;
#pragma unroll (KIND == 2 ? 4 : 1)
        for (int rb = 0; rb < 8; rb += BS) {
            asm volatile("" ::: "memory");
            f32x4 v[BS][4];
#pragma unroll
            for (int bb = 0; bb < BS; ++bb) { const f32x4* xr = (const f32x4*)(xin + (size_t)(ci * 64 + wave * 8 + rb + bb) * 1024) + lane;
#pragma unroll
                for (int j = 0; j < 4; ++j) v[bb][j] = xr[64 * j]; }
#pragma unroll
            for (int bb = 0; bb < BS; ++bb) {
                const int row = ci * 64 + wave * 8 + rb + bb; float ss = 0.f;
#pragma unroll
                for (int j = 0; j < 4; ++j) ss += (v[bb][j][0] * v[bb][j][0] + v[bb][j][1] * v[bb][j][1]) + (v[bb][j][2] * v[bb][j][2] + v[bb][j][3] * v[bb][j][3]);
                const float rstd = rsqrtf(wave_sum(ss) * (1.0f / 1024.0f) + EPS);
#pragma unroll
                for (int j = 0; j < 4; ++j) { v[bb][j] = (v[bb][j] * rstd) * ga[j] + sh[j]; *(u32x2*)(XN + (size_t)row * 1024 + 4 * lane + 256 * j) = pk4(v[bb][j]); }
            }
            if (KIND > 0) {
                float acc[BS][16];
#pragma unroll
                for (int i = 0; i < 16; ++i) {
                    f32x4 w[4];
#pragma unroll
                    for (int j = 0; j < 4; ++j) w[j] = *(const LAS f32x4*)(WxT + i * 1024 + 4 * lane + 256 * j);
#pragma unroll
                    for (int bb = 0; bb < BS; ++bb) { float a = 0.f;
#pragma unroll
                        for (int j = 0; j < 4; ++j) a += (v[bb][j][0] * w[j][0] + v[bb][j][1] * w[j][1]) + (v[bb][j][2] * w[j][2] + v[bb][j][3] * w[j][3]);
                        acc[bb][i] = a; }
                    if (i & 1) { __builtin_amdgcn_sched_barrier(0); asm volatile("" ::: "memory"); }
                }
#pragma unroll
                for (int bb = 0; bb < BS; ++bb) {
                    const int rr = rb + bb, row = ci * 64 + wave * 8 + rr;
                    asm volatile("" ::: "memory");
                    float b8[8], c4[4], d2[2], e1;
                    { const bool hi = (lane & 32) != 0;
#pragma unroll
                      for (int i = 0; i < 8; ++i) { const float snd = hi ? acc[bb][i] : acc[bb][i + 8], kp = hi ? acc[bb][i + 8] : acc[bb][i]; b8[i] = kp + __shfl_xor(snd, 32); } }
                    { const bool hi = (lane & 16) != 0;
#pragma unroll
                      for (int i = 0; i < 4; ++i) { const float snd = hi ? b8[i] : b8[i + 4], kp = hi ? b8[i + 4] : b8[i]; c4[i] = kp + __shfl_xor(snd, 16); } }
                    { const bool hi = (lane & 8) != 0;
#pragma unroll
                      for (int i = 0; i < 2; ++i) { const float snd = hi ? c4[i] : c4[i + 2], kp = hi ? c4[i + 2] : c4[i]; d2[i] = kp + __shfl_xor(snd, 8); } }
                    { const bool hi = (lane & 4) != 0; const float snd = hi ? d2[0] : d2[1], kp = hi ? d2[1] : d2[0]; e1 = kp + __shfl_xor(snd, 4); }
                    e1 += __shfl_xor(e1, 2); e1 += __shfl_xor(e1, 1);
                    if (KIND == 1) {
                        const int idx = ((lane >> 5) & 1) * 8 + ((lane >> 4) & 1) * 4 + ((lane >> 3) & 1) * 2 + ((lane >> 2) & 1);
                        if ((lane & 3) == 0) ((float*)(P.ws + WS_S16))[(size_t)row * 16 + idx] = logsig_f(e1 + P.fox_b_f[idx]);
                    } else {
                        float r[16];
#pragma unroll
                        for (int i = 0; i < 16; ++i) r[i] = __builtin_bit_cast(float, __builtin_amdgcn_readlane(__builtin_bit_cast(int, e1), ((i >> 3) & 1) * 32 + ((i >> 2) & 1) * 16 + ((i >> 1) & 1) * 8 + (i & 1) * 4));
                        f32x4 z0 = *(const f32x4*)(P.gla_b_gate + 8 * lane), z1 = *(const f32x4*)(P.gla_b_gate + 8 * lane + 4);
#pragma unroll
                        for (int i = 0; i < 16; ++i) { const f32x4 w0 = *(const LAS f32x4*)(W2 + i * 512 + 8 * lane), w1 = *(const LAS f32x4*)(W2 + i * 512 + 8 * lane + 4); z0 += w0 * r[i]; z1 += w1 * r[i]; }
#pragma unroll
                        for (int c = 0; c < 4; ++c) { run[c] += logsig_f(z0[c]) * 0.0625f; run[4 + c] += logsig_f(z1[c]) * 0.0625f; }
                        cbv[rr][0] = (f32x4){run[0], run[1], run[2], run[3]}; cbv[rr][1] = (f32x4){run[4], run[5], run[6], run[7]};
                    }
                }
            }
        }
        }
        if (KIND == 2) {
            float* CB = (float*)(P.ws + WS_ACT + 160 * MiB);
            *(LAS f32x4*)(TOT + wave * 512 + 8 * lane) = (f32x4){run[0], run[1], run[2], run[3]};
            *(LAS f32x4*)(TOT + wave * 512 + 8 * lane + 4) = (f32x4){run[4], run[5], run[6], run[7]};
            __syncthreads();
            f32x4 o0 = (f32x4){0.f, 0.f, 0.f, 0.f}, o1 = o0;
            for (int w = 0; w < wave; ++w) { o0 += *(const LAS f32x4*)(TOT + w * 512 + 8 * lane); o1 += *(const LAS f32x4*)(TOT + w * 512 + 8 * lane + 4); }
#pragma unroll
            for (int rr = 0; rr < 8; ++rr) { const int row = ci * 64 + wave * 8 + rr;
                *(f32x4*)(CB + (size_t)row * 512 + 8 * lane) = cbv[rr][0] + o0; *(f32x4*)(CB + (size_t)row * 512 + 8 * lane + 4) = cbv[rr][1] + o1; }
            __syncthreads();
        }
    }
}

template <int KIND> struct LinCfg {
    static constexpr int DK = KIND == 0 ? 256 : 128, QP = KIND == 0 ? 1024 : 512, VP = KIND == 0 ? 2048 : 1024, HV = KIND == 0 ? 512 : 256;
    static constexpr int NSL = HV / 32, NITEM = 16 * NSL, NKF = DK / 32, RW = DK / 8, NDT = RW / 16, KPITCH = DK * 2 + 32, STP = DK + 8, KCH = DK / 64;
    static constexpr int LDS_ST = 0, LDS_K = 2 * 32 * STP * 2, LDS_P = LDS_K + 2 * 64 * KPITCH, LDS_V = LDS_P + 2 * 8192, LDS_END = LDS_V + 2 * 2 * 4096;
};
__device__ __forceinline__ float ret_log2g(int h) { return (h == 0) ? -0.045803689613124796f : (h == 1) ? -0.02272007650008353f : (h == 2) ? -0.011315313227834146f : -0.005646563141142062f; }

template <int KIND>
__device__ __forceinline__ void lin_pphase(const bf16_t* Qa, const bf16_t* Ka, const bf16_t* Qb, const bf16_t* Kb2, bf16_t* Pimg, int tid, int bid, int G) {
    typedef LinCfg<KIND> C;
    const int lane = tid & 63, wave = __builtin_amdgcn_readfirstlane(tid >> 6);
    for (int hw = bid * 8 + wave; hw < 2048; hw += G * 8) {
        const int item = hw >> 1, half = hw & 1;
        const int bh = item >> 6, n = item & 63, b = bh >> 2, h = bh & 3;
        const size_t t0 = (size_t)b * SEQ + (size_t)n * 64;
        f32x4 pa[2][4], pb[2][4];
#pragma unroll
        for (int r = 0; r < 2; ++r)
#pragma unroll
            for (int c = 0; c < 4; ++c) { pa[r][c] = (f32x4){0.f, 0.f, 0.f, 0.f}; pb[r][c] = (f32x4){0.f, 0.f, 0.f, 0.f}; }
        const bf16_t* qa = Qa + (t0 + 32 * half) * C::QP + h * C::DK; const bf16_t* ka = Ka + t0 * C::QP + h * C::DK;
        const bf16_t* qb = Qb + (t0 + 32 * half) * C::QP + h * C::DK; const bf16_t* kb = Kb2 + t0 * C::QP + h * C::DK;
#pragma unroll 2
        for (int k = 0; k < C::NKF; ++k) {
            bf16x8 af[2], bfr[4];
#pragma unroll
            for (int r = 0; r < 2; ++r) af[r] = gfrag(qa + (size_t)(16 * r) * C::QP + 32 * k, C::QP, lane);
#pragma unroll
            for (int c = 0; c < 4; ++c) bfr[c] = gfrag(ka + (size_t)(16 * c) * C::QP + 32 * k, C::QP, lane);
#pragma unroll
            for (int r = 0; r < 2; ++r)
#pragma unroll
                for (int c = 0; c < 4; ++c) pa[r][c] = mma_rc(pa[r][c], af[r], bfr[c]);
            if (KIND == 1) {
#pragma unroll
                for (int r = 0; r < 2; ++r) af[r] = gfrag(qb + (size_t)(16 * r) * C::QP + 32 * k, C::QP, lane);
#pragma unroll
                for (int c = 0; c < 4; ++c) bfr[c] = gfrag(kb + (size_t)(16 * c) * C::QP + 32 * k, C::QP, lane);
#pragma unroll
                for (int r = 0; r < 2; ++r)
#pragma unroll
                    for (int c = 0; c < 4; ++c) pb[r][c] = mma_rc(pb[r][c], af[r], bfr[c]);
            }
        }
        const int g4 = lane >> 4;
        const float l2g = (KIND == 0) ? ret_log2g(h) : 0.f;
#pragma unroll
        for (int r = 0; r < 2; ++r) {
            const int c = 32 * half + 16 * r + (lane & 15);
#pragma unroll
            for (int ct = 0; ct < 4; ++ct) {
                f32x4 p;
#pragma unroll
                for (int e = 0; e < 4; ++e) { const int mm = 16 * ct + 4 * g4 + e;
                    if (KIND == 0) { const int dd = c > mm ? c - mm : mm - c; p[e] = pa[r][ct][e] * exp2f(l2g * (float)dd); }
                    else p[e] = (c >= mm) ? pa[r][ct][e] : pb[r][ct][e]; }
                const int ks = ct >> 1, gg = 2 * (ct & 1) + (g4 & 1);
                const int off = c * 128 + (((4 * ks + gg) ^ (c & 7)) << 4) + 8 * (g4 >> 1);
                *(u32x2*)((char*)Pimg + (size_t)item * 8192 + off) = pk4(p);
            }
        }
    }
}

typedef short v4i16_t __attribute__((ext_vector_type(4)));
__device__ __forceinline__ bf16x8 trfrag2(const LAS char* p0, int second_off) {
    const v4i16_t a = __builtin_amdgcn_ds_read_tr16_b64_v4i16((LAS v4i16_t*)p0);
    const v4i16_t b = __builtin_amdgcn_ds_read_tr16_b64_v4i16((LAS v4i16_t*)(p0 + second_off));
    return (bf16x8){a[0], a[1], a[2], a[3], b[0], b[1], b[2], b[3]};
}

#ifndef STATS_ATOMIC
#define STATS_ATOMIC 0
#endif
template <int KIND> struct LsStage { bf16x8 q[LinCfg<KIND>::NKF]; u32x4 k[LinCfg<KIND>::KCH]; u32x4 p; u32x4 v; f32x4 dec; };

template <int KIND, int VAR = 0>
__device__ __forceinline__ void lin_scan(const bf16_t* Qg, const bf16_t* Kg, const bf16_t* Vg, const bf16_t* Pimg, const float* CB, bf16_t* O, float* STATS, LAS unsigned char* lds, int tid, int bid, int G) {
    typedef LinCfg<KIND> C;
    const int lane = tid & 63, wave = __builtin_amdgcn_readfirstlane(tid >> 6);
    const int g4 = lane >> 4, i16 = lane & 15, q4 = i16 >> 2, p4 = i16 & 3;
    const int nit = (G == 256) ? 1 : (C::NITEM + G - 1) / G;
    for (int it = 0; it < nit; ++it) {
        int item;
        if (G == 256) { const int x = bid & 7, j = bid >> 3; if (KIND == 0) item = x * 32 + j; else { if (j >= 16) break; item = x * 16 + j; } }
        else { item = it * G + bid; if (item >= C::NITEM) break; }
        const int bh = item / C::NSL, dvs = item % C::NSL, b = bh >> 2, h = bh & 3;
        const size_t t0 = (size_t)b * SEQ;
        const int rt = wave & 3; const bool rdw = wave < 4;
        const float l2g = (KIND == 0) ? ret_log2g(h) : 0.f;
        const float qsc = (KIND == 0) ? exp2f(l2g * (float)(16 * rt + i16 + 1)) : 1.0f;
        const float sdec = (KIND == 0) ? exp2f(l2g * 64.0f) : 1.0f;
        const int vm = (tid >> 2) & 63, vpart = tid & 3;
        const float vsc = (KIND == 0) ? exp2f(l2g * (float)(63 - vm)) : 1.0f;
        const bool vthread = tid < 256;
        const bf16_t* qbase = Qg + (t0 + 16 * rt + i16) * C::QP + h * C::DK + 8 * g4;
        const bf16_t* vbase = Vg + (t0 + vm) * C::VP + h * C::HV + 32 * dvs + 8 * vpart;
        const bf16_t* pbase = Pimg + ((size_t)bh * 64) * 4096 + (size_t)tid * 8;
        LAS bf16_t* ST = (LAS bf16_t*)(lds + C::LDS_ST);
        LAS char* KI = (LAS char*)(lds + C::LDS_K);
        LAS char* PI = (LAS char*)(lds + C::LDS_P);
        LAS char* VI = (LAS char*)(lds + C::LDS_V);
        const int trow = 16 * (g4 >> 1) + 4 * (g4 & 1) + q4;
        const int koff = trow * C::KPITCH + (C::RW * wave + 4 * p4) * 2;
        const int voff = trow * 32 + 8 * p4;
        const int poff_row = (16 * rt + i16) * 128, psw = (16 * rt + i16) & 7;

        LsStage<KIND> A, B;
#define LS_LOAD(S, nn) do { const int n_ = (nn) < 64 ? (nn) : 63; \
            if (rdw && !((VAR & 1) && (nn) >= 2)) { _Pragma("unroll") for (int k_ = 0; k_ < C::NKF; ++k_) S.q[k_] = (VAR & 32) ? *(const bf16x8*)(Qg + (t0 + (size_t)n_ * 64 + 16 * rt + 2 * k_ + (lane >> 5)) * C::QP + h * C::DK + 8 * (lane & 31)) : *(const bf16x8*)(qbase + (size_t)n_ * 64 * C::QP + 32 * k_); } \
            if (!((VAR & 2) && (nn) >= 2)) _Pragma("unroll") for (int i_ = 0; i_ < C::KCH; ++i_) { const int id_ = tid + 512 * i_, tk_ = id_ / (C::DK / 8), ch_ = id_ % (C::DK / 8); \
                S.k[i_] = *(const u32x4*)(Kg + (t0 + (size_t)n_ * 64 + tk_) * C::QP + h * C::DK + 8 * ch_); } \
            S.p = *(const u32x4*)(pbase + (size_t)n_ * 4096); \
            if (vthread) S.v = *(const u32x4*)(vbase + (size_t)n_ * 64 * C::VP); \
            if (KIND == 1) S.dec = *(const f32x4*)(CB + (t0 + (size_t)n_ * 64 + 63) * 512 + h * 128 + 16 * wave + 4 * g4); } while (0)
#define LS_WRITE(S, img) do { \
            if (!(VAR & 8)) _Pragma("unroll") for (int i_ = 0; i_ < C::KCH; ++i_) { const int id_ = tid + 512 * i_, tk_ = id_ / (C::DK / 8), ch_ = id_ % (C::DK / 8); \
                *(LAS u32x4*)(KI + (img) * 64 * C::KPITCH + tk_ * C::KPITCH + ch_ * 16) = S.k[i_]; } \
            *(LAS u32x4*)(PI + (img) * 8192 + tid * 16) = S.p; \
            if (vthread) { LAS char* vd_ = VI + (img) * 8192 + (vpart >> 1) * 2048 + vm * 32 + (vpart & 1) * 16; *(LAS u32x4*)vd_ = S.v; \
                if (KIND == 0) { u32x4 w_; _Pragma("unroll") for (int j_ = 0; j_ < 4; ++j_) w_[j_] = pk2(bf2f(S.v[j_] & 0xffffu) * vsc, bf2f(S.v[j_] >> 16) * vsc); *(LAS u32x4*)(vd_ + 4096) = w_; } } } while (0)

        for (int i = tid; i < 32 * C::STP / 2; i += 512) ((LAS unsigned*)ST)[i] = 0u;
        f32x4 s[C::NDT][2];
#pragma unroll
        for (int a = 0; a < C::NDT; ++a)
#pragma unroll
            for (int e = 0; e < 2; ++e) s[a][e] = (f32x4){0.f, 0.f, 0.f, 0.f};
        LS_LOAD(A, 0); LS_LOAD(B, 1);
        LS_WRITE(A, 0);
        __syncthreads();

#define LS_STEP(n, SC, SN) do { const int img_ = (n) & 1; \
            const f32x4 dcur_ = SC.dec; \
              \
            if (rdw && !(VAR & 16)) { \
                const LAS bf16_t* STc_ = ST + img_ * 32 * C::STP; \
                const size_t row_ = t0 + (size_t)(n) * 64 + 16 * rt + i16; \
                  \
                _Pragma("unroll") for (int ct_ = 0; ct_ < 2; ++ct_) { \
                    constexpr int HB_ = C::NKF / 2; bf16x8 sb_[HB_], pf_[2], vf_[2]; \
                    f32x4 o0_ = (f32x4){0.f, 0.f, 0.f, 0.f}, o1_ = o0_; \
                    _Pragma("unroll") for (int k_ = 0; k_ < HB_; ++k_) sb_[k_] = lfrag(STc_ + 16 * ct_ * C::STP + 32 * k_, C::STP, lane); \
                    __builtin_amdgcn_sched_barrier(0); \
                    _Pragma("unroll") for (int k_ = 0; k_ < HB_; k_ += 2) { o0_ = mma_rc(o0_, SC.q[k_], sb_[k_]); o1_ = mma_rc(o1_, SC.q[k_ + 1], sb_[k_ + 1]); } \
                    __builtin_amdgcn_sched_barrier(0); \
                    _Pragma("unroll") for (int k_ = 0; k_ < HB_; ++k_) sb_[k_] = lfrag(STc_ + 16 * ct_ * C::STP + 32 * (HB_ + k_), C::STP, lane); \
                    _Pragma("unroll") for (int ks_ = 0; ks_ < 2; ++ks_) { \
                        pf_[ks_] = *(const LAS bf16x8*)(PI + img_ * 8192 + poff_row + (((4 * ks_ + g4) ^ psw) << 4)); \
                        vf_[ks_] = trfrag2(VI + img_ * 8192 + ct_ * 2048 + ks_ * 1024 + voff, 256); } \
                    __builtin_amdgcn_sched_barrier(0); \
                    _Pragma("unroll") for (int k_ = 0; k_ < HB_; k_ += 2) { o0_ = mma_rc(o0_, SC.q[HB_ + k_], sb_[k_]); o1_ = mma_rc(o1_, SC.q[HB_ + k_ + 1], sb_[k_ + 1]); } \
                    f32x4 oa_ = (o0_ + o1_) * qsc; \
                    _Pragma("unroll") for (int ks_ = 0; ks_ < 2; ++ks_) oa_ = mma_rc(oa_, pf_[ks_], vf_[ks_]); \
                    *(u32x2*)(O + row_ * C::VP + h * C::HV + 32 * dvs + 16 * ct_ + 4 * g4) = pk4(oa_); \
                    __builtin_amdgcn_sched_barrier(0); } } \
              \
            LS_LOAD(SC, (n) + 2); \
              \
            if (KIND == 0) { _Pragma("unroll") for (int a_ = 0; a_ < C::NDT; ++a_) _Pragma("unroll") for (int e_ = 0; e_ < 2; ++e_) s[a_][e_] = s[a_][e_] * sdec; } \
            if (!(VAR & 4)) _Pragma("unroll") for (int ks_ = 0; ks_ < 2; ++ks_) { bf16x8 kf_[C::NDT], vf_[2]; \
                _Pragma("unroll") for (int a_ = 0; a_ < C::NDT; ++a_) kf_[a_] = trfrag2(KI + img_ * 64 * C::KPITCH + ks_ * 32 * C::KPITCH + a_ * 32 + koff, 8 * C::KPITCH); \
                _Pragma("unroll") for (int e_ = 0; e_ < 2; ++e_) vf_[e_] = trfrag2(VI + img_ * 8192 + (KIND == 0 ? 4096 : 0) + e_ * 2048 + ks_ * 1024 + voff, 256); \
                _Pragma("unroll") for (int a_ = 0; a_ < C::NDT; ++a_) _Pragma("unroll") for (int e_ = 0; e_ < 2; ++e_) s[a_][e_] = mma_cr(s[a_][e_], kf_[a_], vf_[e_]); } \
            if (KIND == 1) { f32x4 dc_; _Pragma("unroll") for (int r_ = 0; r_ < 4; ++r_) dc_[r_] = __expf(dcur_[r_]); \
                _Pragma("unroll") for (int e_ = 0; e_ < 2; ++e_) s[0][e_] = s[0][e_] * dc_; } \
              \
            { LAS bf16_t* STn_ = ST + (img_ ^ 1) * 32 * C::STP; \
              _Pragma("unroll") for (int a_ = 0; a_ < C::NDT; ++a_) _Pragma("unroll") for (int e_ = 0; e_ < 2; ++e_) \
                  *(LAS u32x2*)(STn_ + (16 * e_ + i16) * C::STP + C::RW * wave + 16 * a_ + 4 * g4) = pk4(s[a_][e_]); } \
              \
            LS_WRITE(SN, img_ ^ 1); \
            asm volatile("s_waitcnt lgkmcnt(0)" ::: "memory"); __builtin_amdgcn_s_barrier(); asm volatile("" ::: "memory"); } while (0)

        for (int n = 0; n < 64; n += 2) { LS_STEP(n, A, B); LS_STEP(n + 1, B, A); }
#undef LS_LOAD
#undef LS_WRITE
#undef LS_STEP
    }
}


template <int KIND>
__device__ __forceinline__ void lin_stats(const bf16_t* O, float* STATS, int tid, int bid, int G) {
    const int lane = tid & 63, wave = tid >> 6;
    const int gw = bid * 8 + wave, NGW = G * 8;
    constexpr int NJ = KIND == 0 ? 4 : 2, PITCH = KIND == 0 ? 2048 : 1024, RB = 4;
    for (int row0 = gw; row0 < MT; row0 += RB * NGW) {
        u32x4 w[RB][NJ];
#pragma unroll
        for (int rb = 0; rb < RB; ++rb) { const int row = row0 + rb * NGW < MT ? row0 + rb * NGW : row0;
#pragma unroll
            for (int j = 0; j < NJ; ++j) w[rb][j] = *(const u32x4*)(O + (size_t)row * PITCH + 512 * j + 8 * lane); }
#pragma unroll
        for (int rb = 0; rb < RB; ++rb) { const int row = row0 + rb * NGW; if (row >= MT) break;
#pragma unroll
            for (int j = 0; j < NJ; ++j) {
                float sm = 0.f, sq = 0.f;
#pragma unroll
                for (int i = 0; i < 4; ++i) { const float a = bf2f(w[rb][j][i] & 0xffffu), b = bf2f(w[rb][j][i] >> 16); sm += a + b; sq += a * a + b * b; }
                if (KIND == 0) { sm = wave_sum(sm); sq = wave_sum(sq); if (lane == 0) *(f32x2*)(STATS + (size_t)row * 8 + 2 * j) = (f32x2){sm, sq}; }
                else {
#pragma unroll
                    for (int o = 1; o < 32; o <<= 1) sq += __shfl_xor(sq, o);
                    if ((lane & 31) == 0) *(f32x2*)(STATS + (size_t)row * 8 + 2 * (2 * j + (lane >> 5))) = (f32x2){0.f, sq}; }
            }
        }
    }
}

template <int KIND> struct EpiGateNorm {
    static constexpr bool PERM = false;
    bf16_t* O; const float* STATS; LAS float* tbl;
    __device__ __forceinline__ void operator()(const f32x4 (&acc)[2][2][4][2], const pg8::Unit& u, int wr, int wc, int fr, int fq) const {
        constexpr int N = KIND == 0 ? 2048 : 1024; constexpr float INV = KIND == 0 ? 1.0f / 512.0f : 1.0f / 256.0f;
        const int head = KIND == 0 ? (u.pn >> 1) : u.pn;
        if (KIND == 0) {
            if ((u.pn & 1) == 0) {
                LAS f32x2* tb2 = (LAS f32x2*)tbl;
#pragma unroll
                for (int ai = 0; ai < 2; ++ai)
#pragma unroll
                    for (int m = 0; m < 4; ++m) { const int rl = ai * 128 + wr * 64 + m * 16 + fr; const int row = u.pm * 256 + rl; float sm = 0.f, sq = 0.f;
                        const bf16_t* prow = O + (size_t)row * N + u.pn * 256 + wc * 32 + fq * 4;
#pragma unroll
                        for (int tt = 0; tt < 2; ++tt) {
                            const u32x2 w0 = *(const u32x2*)(prow + tt * 256), w1 = *(const u32x2*)(prow + tt * 256 + 16), w2 = *(const u32x2*)(prow + tt * 256 + 128), w3 = *(const u32x2*)(prow + tt * 256 + 144);
                            const f32x4 o0 = unpk4(w0), o1 = unpk4(w1), o2 = unpk4(w2), o3 = unpk4(w3);
                            const f32x4 ss = (o0 + o1) + (o2 + o3), qq = (o0 * o0 + o1 * o1) + (o2 * o2 + o3 * o3);
                            sm += (ss[0] + ss[1]) + (ss[2] + ss[3]); sq += (qq[0] + qq[1]) + (qq[2] + qq[3]);
                            asm volatile("" ::: "memory"); }
                        sm += __shfl_xor(sm, 16); sm += __shfl_xor(sm, 32); sq += __shfl_xor(sq, 16); sq += __shfl_xor(sq, 32);
                        if (fq == 0) tb2[rl * 4 + wc] = (f32x2){sm, sq};
                        asm volatile("" ::: "memory"); }
                asm volatile("s_waitcnt lgkmcnt(0)" ::: "memory"); __builtin_amdgcn_s_barrier(); asm volatile("" ::: "memory");
            }
#pragma unroll
            for (int ai = 0; ai < 2; ++ai)
#pragma unroll
            for (int mh = 0; mh < 2; ++mh) {
                u32x2 ov[2][2][2];
#pragma unroll
                for (int mm = 0; mm < 2; ++mm) { const int row = u.pm * 256 + ai * 128 + wr * 64 + (2 * mh + mm) * 16 + fr;
#pragma unroll
                    for (int bj = 0; bj < 2; ++bj)
#pragma unroll
                        for (int n = 0; n < 2; ++n) ov[mm][bj][n] = *(const u32x2*)(O + (size_t)row * N + u.pn * 256 + bj * 128 + wc * 32 + n * 16 + fq * 4); }
                asm volatile("" ::: "memory");
#pragma unroll
                for (int mm = 0; mm < 2; ++mm) { const int m = 2 * mh + mm; const int rl = ai * 128 + wr * 64 + m * 16 + fr; const int row = u.pm * 256 + rl;
                    const LAS f32x2* tb2 = (const LAS f32x2*)tbl + rl * 4;
                    const f32x2 p0 = tb2[0], p1 = tb2[1], p2 = tb2[2], p3 = tb2[3];
                    const float mean = ((p0.x + p1.x) + (p2.x + p3.x)) * INV, rstd = __builtin_amdgcn_rsqf(fmaxf(((p0.y + p1.y) + (p2.y + p3.y)) * INV - mean * mean, 0.f) + EPS);
#pragma unroll
                    for (int bj = 0; bj < 2; ++bj)
#pragma unroll
                        for (int n = 0; n < 2; ++n) {
                            const f32x4 o = unpk4(ov[mm][bj][n]), a = acc[ai][bj][m][n]; f32x4 r;
#pragma unroll
                            for (int j = 0; j < 4; ++j) r[j] = (o[j] - mean) * rstd * silu_f(a[j]);
                            *(u32x2*)(O + (size_t)row * N + u.pn * 256 + bj * 128 + wc * 32 + n * 16 + fq * 4) = pk4(r);
                        }
                }
                asm volatile("" ::: "memory");
            }
        } else {
#pragma unroll
            for (int ai = 0; ai < 2; ++ai)
#pragma unroll
                for (int m = 0; m < 4; ++m) { const int rl = ai * 128 + wr * 64 + m * 16 + fr; const int row = u.pm * 256 + rl; float sq = 0.f;
#pragma unroll
                    for (int bj = 0; bj < 2; ++bj)
#pragma unroll
                        for (int n = 0; n < 2; ++n) { const f32x4 o = unpk4(*(const u32x2*)(O + (size_t)row * N + u.pn * 256 + bj * 128 + wc * 32 + n * 16 + fq * 4)); sq += (o[0] * o[0] + o[1] * o[1]) + (o[2] * o[2] + o[3] * o[3]); }
                    sq += __shfl_xor(sq, 16); sq += __shfl_xor(sq, 32);
                    if (fq == 0) tbl[rl * 4 + wc] = sq; }
            asm volatile("s_waitcnt lgkmcnt(0)" ::: "memory"); __builtin_amdgcn_s_barrier(); asm volatile("" ::: "memory");
#pragma unroll
            for (int ai = 0; ai < 2; ++ai) {
                u32x2 ov[4][2][2];
#pragma unroll
                for (int m = 0; m < 4; ++m) { const int row = u.pm * 256 + ai * 128 + wr * 64 + m * 16 + fr;
#pragma unroll
                    for (int bj = 0; bj < 2; ++bj)
#pragma unroll
                        for (int n = 0; n < 2; ++n) ov[m][bj][n] = *(const u32x2*)(O + (size_t)row * N + u.pn * 256 + bj * 128 + wc * 32 + n * 16 + fq * 4); }
                asm volatile("" ::: "memory");
#pragma unroll
                for (int m = 0; m < 4; ++m) { const int rl = ai * 128 + wr * 64 + m * 16 + fr; const int row = u.pm * 256 + rl;
                    const f32x4 pr = *(const LAS f32x4*)(tbl + rl * 4);
                    const float rstd = __builtin_amdgcn_rsqf(((pr[0] + pr[1]) + (pr[2] + pr[3])) * INV + EPS);
#pragma unroll
                    for (int bj = 0; bj < 2; ++bj)
#pragma unroll
                        for (int n = 0; n < 2; ++n) {
                            const f32x4 o = unpk4(ov[m][bj][n]), a = acc[ai][bj][m][n]; f32x4 r;
#pragma unroll
                            for (int j = 0; j < 4; ++j) r[j] = o[j] * rstd * silu_f(a[j]);
                            *(u32x2*)(O + (size_t)row * N + u.pn * 256 + bj * 128 + wc * 32 + n * 16 + fq * 4) = pk4(r);
                        }
                }
                asm volatile("" ::: "memory");
            }
        }
    }
};

namespace attn_body {
using bf16=unsigned short;
using bf16x8=__attribute__((ext_vector_type(8)))short;
using s16x4=__attribute__((ext_vector_type(4)))short;
using f32x16=__attribute__((ext_vector_type(16)))float;
using u32x4=__attribute__((ext_vector_type(4)))unsigned;
constexpr int BATCH=4,NHEAD=16,SEQ=4096,D=64,DM=NHEAD*D;
constexpr int NW=8,QBLK=32,QB=QBLK*NW,KVBLK=64,NQB=SEQ/QB;
constexpr int ATTN_PITCH=DM, ATTN_UNIT_ROWS=QB;
__device__ __forceinline__ int crow(int r,int hi){return (r&3)+8*(r>>2)+4*hi;}
#define SBAR() __builtin_amdgcn_sched_barrier(0)
__device__ __forceinline__ void cmask(f32x16&p0,f32x16&p1,int jb,int qrel,int hi){
  const float NEG=-INFINITY; int kb=64*jb+4*hi;
  #pragma unroll
  for(int r=0;r<16;++r){int kv=kb+(r&3)+8*(r>>2); if(kv>qrel)p0[r]=NEG; if(kv+32>qrel)p1[r]=NEG;}
}

constexpr int NSLOT=3, SLOTB=8192;
constexpr int LDS_K=0, LDS_V=NSLOT*SLOTB, LDS_WS=2*NSLOT*SLOTB, LDS_OST=LDS_WS+NW*64*4, LDS_NC=LDS_OST+NW*4096, LDS_FT=LDS_NC+SEQ*4, LDS_RE=LDS_FT+256, LDS_BYTES=LDS_RE+256;
constexpr float C2=0.125f*1.4426950408889634f;
__device__ __forceinline__ void glds16(const void*gsrc,unsigned lds_dst){unsigned keep;
  asm volatile("s_mov_b32 %0, m0\n\ts_mov_b32 m0, %2\n\ts_nop 0\n\tglobal_load_lds_dwordx4 %1, off\n\ts_mov_b32 m0, %0":"=&s"(keep):"v"(gsrc),"s"(lds_dst):"memory");}
__device__ __forceinline__ float max3f(float a,float b,float c){float r;asm("v_max3_f32 %0, %1, %2, %3":"=v"(r):"v"(a),"v"(b),"v"(c));return r;}
__device__ __forceinline__ float max2f(float a,float b){float r;asm("v_max_f32_e32 %0, %1, %2":"=v"(r):"v"(a),"v"(b));return r;}
__device__ __forceinline__ float fadd_s(float a,float b){float r;asm("v_add_f32_e32 %0, %1, %2":"=v"(r):"v"(a),"v"(b));return r;}
__device__ __forceinline__ float fsub_s(float a,float b){float r;asm("v_sub_f32_e32 %0, %1, %2":"=v"(r):"v"(a),"v"(b));return r;}
typedef float f32x2_t __attribute__((ext_vector_type(2))); typedef __bf16 bf16x2_t __attribute__((ext_vector_type(2)));
__device__ __forceinline__ unsigned cvtpk_s(float lo,float hi){f32x2_t v={lo,hi};bf16x2_t b=__builtin_convertvector(v,bf16x2_t);return __builtin_bit_cast(unsigned,b);}
#define WAIT_BAR(N) asm volatile("s_waitcnt vmcnt(" #N ") lgkmcnt(0)\n\ts_barrier":::"memory")

__device__ __forceinline__ void qkt(f32x16&p0,f32x16&p1,const char*Kslot,const bf16x8*qr,const f32x16&negm,int r32,int hi){
  const char*kb=Kslot+hi*1024+r32*16;
  #pragma unroll
  for(int d0=0;d0<4;++d0){
    const bf16x8 b0=*reinterpret_cast<const bf16x8*>(kb+d0*2048);
    const bf16x8 b1=*reinterpret_cast<const bf16x8*>(kb+d0*2048+512);
    if(d0==0){p0=__builtin_amdgcn_mfma_f32_32x32x16_bf16(b0,qr[0],negm,0,0,0);p1=__builtin_amdgcn_mfma_f32_32x32x16_bf16(b1,qr[0],negm,0,0,0);}
    else{p0=__builtin_amdgcn_mfma_f32_32x32x16_bf16(b0,qr[d0],p0,0,0,0);p1=__builtin_amdgcn_mfma_f32_32x32x16_bf16(b1,qr[d0],p1,0,0,0);}}
}
typedef __attribute__((address_space(3))) const char* lds_cptr;
typedef short v4i16_t __attribute__((ext_vector_type(4)));
__device__ __forceinline__ void kload8(bf16x8*kf,lds_cptr kp){
  kf[0]=*(const __attribute__((address_space(3))) bf16x8*)(kp);      kf[1]=*(const __attribute__((address_space(3))) bf16x8*)(kp+512);
  kf[2]=*(const __attribute__((address_space(3))) bf16x8*)(kp+2048); kf[3]=*(const __attribute__((address_space(3))) bf16x8*)(kp+2560);
  kf[4]=*(const __attribute__((address_space(3))) bf16x8*)(kp+4096); kf[5]=*(const __attribute__((address_space(3))) bf16x8*)(kp+4608);
  kf[6]=*(const __attribute__((address_space(3))) bf16x8*)(kp+6144); kf[7]=*(const __attribute__((address_space(3))) bf16x8*)(kp+6656);
}
__device__ __forceinline__ void kload2(bf16x8*kf,lds_cptr kp,int j){ kf[2*j]=*(const __attribute__((address_space(3))) bf16x8*)(kp+j*2048); kf[2*j+1]=*(const __attribute__((address_space(3))) bf16x8*)(kp+j*2048+512); }
__device__ __forceinline__ s16x4 vtr(lds_cptr p){ return __builtin_bit_cast(s16x4,__builtin_amdgcn_ds_read_tr16_b64_v4i16((__attribute__((address_space(3))) v4i16_t*)p)); }
__device__ __forceinline__ float rowmax(const f32x16&p0,const f32x16&p1){
  float a=max3f(p0[0],p0[1],p1[0]),b=max3f(p0[2],p0[3],p1[1]);a=max3f(a,p1[2],p1[3]);
  #pragma unroll
  for(int r=4;r<16;r+=4){a=max3f(a,p0[r],p0[r+1]);b=max3f(b,p0[r+2],p0[r+3]);a=max3f(a,p1[r],p1[r+1]);b=max3f(b,p1[r+2],p1[r+3]);}
  const float m=max2f(a,b);
  auto rr=__builtin_amdgcn_permlane32_swap(__float_as_uint(m),__float_as_uint(m),false,false);
  return max2f(__uint_as_float(rr[0]),__uint_as_float(rr[1]));
}
__device__ __forceinline__ void pv(f32x16*o,int vb,bf16x8 pa0,bf16x8 pa1,bf16x8 pa2,bf16x8 pa3){
  #pragma unroll
  for(int d0=0;d0<2;++d0){s16x4 lo[4],hi[4];
    #pragma unroll
    for(int ks=0;ks<4;++ks){
      asm volatile("ds_read_b64_tr_b16 %0,%1 offset:%c2":"=&v"(lo[ks]):"v"(vb),"i"(d0*4096+ks*1024):"memory");
      asm volatile("ds_read_b64_tr_b16 %0,%1 offset:%c2":"=&v"(hi[ks]):"v"(vb),"i"(d0*4096+ks*1024+512):"memory");}
    asm volatile("s_waitcnt lgkmcnt(0)":::"memory");SBAR();
    #define PK(k) (bf16x8){lo[k][0],lo[k][1],lo[k][2],lo[k][3],hi[k][0],hi[k][1],hi[k][2],hi[k][3]}
    o[d0]=__builtin_amdgcn_mfma_f32_32x32x16_bf16(pa0,PK(0),o[d0],0,0,0);
    o[d0]=__builtin_amdgcn_mfma_f32_32x32x16_bf16(pa1,PK(1),o[d0],0,0,0);
    o[d0]=__builtin_amdgcn_mfma_f32_32x32x16_bf16(pa2,PK(2),o[d0],0,0,0);
    o[d0]=__builtin_amdgcn_mfma_f32_32x32x16_bf16(pa3,PK(3),o[d0],0,0,0);
    #undef PK
  }
}

#ifndef ATTN_STORE16
#define ATTN_STORE16(p,v) (*(u32x4*)(p)=(v))
#endif
template<int THRL> __device__ __forceinline__ void attn_unit(int b,int h,int qb,int ts,const bf16*Q,const bf16*__restrict__ K,const bf16*__restrict__ V,const bf16*__restrict__ Gt,bf16*O,char*shm,int tid){
  const int lane=tid&63,r32=lane&31,hi=lane>>5; const int wid=__builtin_amdgcn_readfirstlane(tid>>6);
  const long rowbase=(long)b*SEQ; const int q0=qb*QB;
  typedef __attribute__((address_space(3))) const float* lds_fptr; typedef float f32x4b __attribute__((ext_vector_type(4)));
  const lds_fptr ncum=(lds_fptr)((__attribute__((address_space(3))) const char*)shm+LDS_NC)+64*ts+4*hi;
  const lds_fptr ftp=(lds_fptr)((__attribute__((address_space(3))) const char*)shm+LDS_FT)+ts;
  const bf16*Qw=Q+(rowbase+q0+wid*QBLK)*DM+h*D;
  const bf16*Kh=K+(rowbase+(long)ts*KVBLK)*DM+h*D,*Vh=V+(rowbase+(long)ts*KVBLK)*DM+h*D;
  const unsigned lds0=(unsigned)(uintptr_t)shm;
  float*wsf=(float*)(shm+LDS_WS)+wid*64;
  const bf16*ksrc=Kh+(long)lane*DM+wid*8;
  const bf16*vsrc=Vh+(long)(16*(wid&3)+(lane>>2))*DM+(wid>>2)*32+(lane&3)*8;
  const unsigned kdst=lds0+LDS_K+wid*1024, vdst=lds0+LDS_V+wid*1024;
  #define DMA_K(t,slot) glds16(ksrc+(long)(t)*KVBLK*DM,(unsigned)__builtin_amdgcn_readfirstlane(kdst+(slot)))
  #define DMA_V(t,slot) glds16(vsrc+(long)(t)*KVBLK*DM,(unsigned)__builtin_amdgcn_readfirstlane(vdst+(slot)))
  const int vb0=(int)(lds0+LDS_V)+((lane>>4)&1)*32+(lane&3)*8+(4*hi+((lane&15)>>2))*64;
  const char*Kbase=shm+LDS_K; bf16x8 kf[8];
  const lds_cptr shm3=(lds_cptr)shm; const lds_cptr kp0=shm3+LDS_K+hi*1024+r32*16; const lds_cptr vp0=shm3+LDS_V+((lane>>4)&1)*32+(lane&3)*8+(4*hi+((lane&15)>>2))*64;
  const int NT=(q0+QB)/KVBLK-ts;
  DMA_K(0,0);DMA_V(0,0);DMA_K(1,SLOTB);
  bf16x8 qr[4];
  #pragma unroll
  for(int d0=0;d0<4;++d0)qr[d0]=*reinterpret_cast<const bf16x8*>(&Qw[(long)r32*DM+d0*16+hi*8]);
  float l_reg=0.f,fcur=1.f;f32x16 o[2];o[0]=f32x16{};o[1]=f32x16{};const f32x16 negm=f32x16{};
  const int qrel=wid*QBLK+r32;
  #define CMASK(P0,P1,t) do{int jb_=(t)-(NT-4); if(jb_>=0)cmask(P0,P1,jb_,qrel,hi);}while(0)
  #define LDSF4(p) (*(const __attribute__((address_space(3))) f32x4b*)(p))
  #define BIAS(P0,P1,t) do{ const lds_fptr nb_=ncum+64*(t); \
      { const f32x4b a0_=LDSF4(nb_), a1_=LDSF4(nb_+8), a2_=LDSF4(nb_+16), a3_=LDSF4(nb_+24); \
        _Pragma("unroll") for(int j_=0;j_<4;++j_){ P0[j_]+=a0_[j_]; P0[4+j_]+=a1_[j_]; P0[8+j_]+=a2_[j_]; P0[12+j_]+=a3_[j_]; } } SBAR(); \
      { const f32x4b b0_=LDSF4(nb_+32), b1_=LDSF4(nb_+40), b2_=LDSF4(nb_+48), b3_=LDSF4(nb_+56); \
        _Pragma("unroll") for(int j_=0;j_<4;++j_){ P1[j_]+=b0_[j_]; P1[4+j_]+=b1_[j_]; P1[8+j_]+=b2_[j_]; P1[12+j_]+=b3_[j_]; } } SBAR(); }while(0)
  #define START(P0,P1) do{ _Pragma("unroll") for(int r=0;r<16;++r)P0[r]=__builtin_amdgcn_exp2f(P0[r]); }while(0)
  #define RESC() do{ _Pragma("unroll") for(int d_=0;d_<2;++d_) _Pragma("unroll") for(int r=0;r<16;++r)o[d_][r]*=fcur; }while(0)
  f32x16 pA0,pA1,pB0,pB1;
  int sl_prev=0,sl_cur=0,sl_next=SLOTB;
  #define ROT() do{sl_prev=sl_cur;sl_cur=sl_next;sl_next=(sl_next==(NSLOT-1)*SLOTB)?0:sl_next+SLOTB;}while(0)
  DMA_K(2,2*SLOTB);
  WAIT_BAR(3);
  qkt(pA0,pA1,Kbase,qr,negm,r32,hi);asm volatile("s_nop 15\n\ts_nop 7":"+v"(pA0),"+v"(pA1));BIAS(pA0,pA1,0);CMASK(pA0,pA1,0);
  START(pA0,pA1);
  _Pragma("unroll") for(int r=0;r<16;++r)pA1[r]=__builtin_amdgcn_exp2f(pA1[r]);
  WAIT_BAR(0);
  DMA_K(3,0);DMA_V(1,SLOTB);
  ROT();
  kload8(kf,kp0+sl_cur);
  WAIT_BAR(2);
  s16x4 vlo[8],vhi[8]; u32x4 pw0,pw1,pw2,pw3;
  #define PKW(P,B) cvtpk_s(P[B],P[B+1])
  #define PAF(k) __builtin_bit_cast(bf16x8,pw##k)
  #define VFR(i) (bf16x8){vlo[i][0],vlo[i][1],vlo[i][2],vlo[i][3],vhi[i][0],vhi[i][1],vhi[i][2],vhi[i][3]}
  #define PIN(x) asm volatile("":"+v"(x))
  #define MX3(a,b,c) __builtin_fmaxf(__builtin_fmaxf((a),(b)),(c))
  #define GAPA(MF,A0,A1,A2,A3,W0,W1,PW) do{ MF; sacc+=A0; sacc+=A1; sacc+=A2; sacc+=A3; PIN(sacc); W0; W1; PIN(PW); SBAR(); }while(0)
  #define EX(v) __builtin_amdgcn_exp2f(v)
  #define GAPB(MF,X,B) do{ MF; X[B]=EX(X[B]); X[B+1]=EX(X[B+1]); X[B+2]=EX(X[B+2]); X[B+3]=EX(X[B+3]); PIN(X); SBAR(); }while(0)
  #define VRD(i) do{ vlo[i]=vtr(vp_+(((i)>>2)*4096+((i)&3)*1024)); vhi[i]=vtr(vp_+(((i)>>2)*4096+((i)&3)*1024+512)); }while(0)
  #define KRD(G,j) do{ if(G){ kload2(kf,kp0+sl_next,j); SBAR(); } }while(0)
  #define STEP(C0,C1,P0,P1,t,GK,GV,GL) do{ SBAR(); \
    const lds_cptr vp_=vp0+sl_prev; \
    VRD(0); SBAR(); float sacc=(P0[0]+P0[1]); \
    GAPA(C0=__builtin_amdgcn_mfma_f32_32x32x16_bf16(kf[0],qr[0],negm,0,0,0), P0[2],P0[3],P0[4],P0[5],     pw0[0]=PKW(P0,0), pw0[1]=PKW(P0,2), pw0); \
    VRD(4); SBAR(); GAPA(C1=__builtin_amdgcn_mfma_f32_32x32x16_bf16(kf[1],qr[0],negm,0,0,0), P0[6],P0[7],P0[8],P0[9],     pw0[2]=PKW(P0,4), pw0[3]=PKW(P0,6), pw0); \
    VRD(1); SBAR(); GAPA(C0=__builtin_amdgcn_mfma_f32_32x32x16_bf16(kf[2],qr[1],C0,0,0,0),   P0[10],P0[11],P0[12],P0[13], pw1[0]=PKW(P0,8), pw1[1]=PKW(P0,10), pw1); \
    VRD(5); SBAR(); GAPA(C1=__builtin_amdgcn_mfma_f32_32x32x16_bf16(kf[3],qr[1],C1,0,0,0),   P0[14],P0[15],P1[0],P1[1],   pw1[2]=PKW(P0,12),pw1[3]=PKW(P0,14), pw1); \
    VRD(2); SBAR(); GAPA(C0=__builtin_amdgcn_mfma_f32_32x32x16_bf16(kf[4],qr[2],C0,0,0,0),   P1[2],P1[3],P1[4],P1[5],     pw2[0]=PKW(P1,0), pw2[1]=PKW(P1,2), pw2); \
    VRD(6); SBAR(); GAPA(C1=__builtin_amdgcn_mfma_f32_32x32x16_bf16(kf[5],qr[2],C1,0,0,0),   P1[6],P1[7],P1[8],P1[9],     pw2[2]=PKW(P1,4), pw2[3]=PKW(P1,6), pw2); \
    VRD(3); SBAR(); GAPA(C0=__builtin_amdgcn_mfma_f32_32x32x16_bf16(kf[6],qr[3],C0,0,0,0),   P1[10],P1[11],P1[12],P1[13], pw3[0]=PKW(P1,8), pw3[1]=PKW(P1,10), pw3); \
    VRD(7); SBAR(); GAPA(C1=__builtin_amdgcn_mfma_f32_32x32x16_bf16(kf[7],qr[3],C1,0,0,0),   P1[14],P1[15],0.f,0.f,       pw3[2]=PKW(P1,12),pw3[3]=PKW(P1,14), pw3); \
    l_reg+=sacc; \
    if(GK){DMA_K((t)+3,sl_cur);} if(GV){DMA_V((t)+1,sl_next);} \
    BIAS(C0,C1,t); CMASK(C0,C1,t); \
    { const int jb2_=2*((t)-(NT-4)); fcur=(jb2_>wid)?1.0f:ftp[(t)]; l_reg*=fcur; } \
    SBAR(); \
    GAPB(o[0]=__builtin_amdgcn_mfma_f32_32x32x16_bf16(PAF(0),VFR(0),o[0],0,0,0), C0,0); \
    GAPB(o[1]=__builtin_amdgcn_mfma_f32_32x32x16_bf16(PAF(0),VFR(4),o[1],0,0,0), C0,4); \
    KRD(GL,0); GAPB(o[0]=__builtin_amdgcn_mfma_f32_32x32x16_bf16(PAF(1),VFR(1),o[0],0,0,0), C0,8); \
    KRD(GL,1); GAPB(o[1]=__builtin_amdgcn_mfma_f32_32x32x16_bf16(PAF(1),VFR(5),o[1],0,0,0), C0,12); \
    KRD(GL,2); GAPB(o[0]=__builtin_amdgcn_mfma_f32_32x32x16_bf16(PAF(2),VFR(2),o[0],0,0,0), C1,0); \
    KRD(GL,3); GAPB(o[1]=__builtin_amdgcn_mfma_f32_32x32x16_bf16(PAF(2),VFR(6),o[1],0,0,0), C1,4); \
    GAPB(o[0]=__builtin_amdgcn_mfma_f32_32x32x16_bf16(PAF(3),VFR(3),o[0],0,0,0), C1,8); \
    GAPB(o[1]=__builtin_amdgcn_mfma_f32_32x32x16_bf16(PAF(3),VFR(7),o[1],0,0,0), C1,12); \
    }while(0)
  int t=1;
  #undef CMASK
  #define CMASK(P0,P1,t) do{}while(0)
  for(;t+5<NT;t+=2){
    STEP(pB0,pB1,pA0,pA1,t,true,true,true);     WAIT_BAR(2); RESC(); ROT();
    STEP(pA0,pA1,pB0,pB1,t+1,true,true,true);   WAIT_BAR(2); RESC(); ROT();
  }
  #undef CMASK
  int qrel_m=qrel,hi_m=hi; asm volatile("":"+v"(qrel_m),"+v"(hi_m));
  #define CMASK(P0,P1,t) do{int jb_=(t)-(NT-4); if(jb_>=0)cmask(P0,P1,jb_,qrel_m,hi_m);}while(0)
  #define ENDW(tt) do{ if((tt)+3<NT){WAIT_BAR(2);} else if((tt)+2<NT){WAIT_BAR(1);} else {WAIT_BAR(0);} }while(0)
  for(;t+1<NT;t+=2){
    STEP(pB0,pB1,pA0,pA1,t,(t+3<NT),(t+1<NT),(t+1<NT));       ENDW(t);   RESC(); ROT();
    STEP(pA0,pA1,pB0,pB1,t+1,(t+4<NT),(t+2<NT),(t+2<NT));     ENDW(t+1); RESC(); ROT();
  }
  STEP(pB0,pB1,pA0,pA1,NT-1,false,false,false); RESC();
  { float sacc=pB0[0]+pB0[1]; _Pragma("unroll") for(int r=2;r<16;++r)sacc+=pB0[r]; _Pragma("unroll") for(int r=0;r<16;++r)sacc+=pB1[r]; l_reg+=sacc;
    pw0=(u32x4){PKW(pB0,0),PKW(pB0,2),PKW(pB0,4),PKW(pB0,6)};pw1=(u32x4){PKW(pB0,8),PKW(pB0,10),PKW(pB0,12),PKW(pB0,14)};pw2=(u32x4){PKW(pB1,0),PKW(pB1,2),PKW(pB1,4),PKW(pB1,6)};pw3=(u32x4){PKW(pB1,8),PKW(pB1,10),PKW(pB1,12),PKW(pB1,14)};
    SBAR(); pv(o,vb0+sl_cur,PAF(0),PAF(1),PAF(2),PAF(3)); }
  #undef PKW
  #undef PAF
  #undef VFR
  #undef PIN
  #undef MX3
  #undef GAPA
  #undef GAPB
  #undef EX
  #undef VRD
  #undef KRD
  #undef STEP
  #undef ENDW
  {auto rr=__builtin_amdgcn_permlane32_swap(__float_as_uint(l_reg),__float_as_uint(l_reg),false,false);l_reg=__uint_as_float(rr[0])+__uint_as_float(rr[1]);}
  if(hi==0)wsf[32+r32]=l_reg;asm volatile("s_waitcnt lgkmcnt(0)":::"memory");
  float rli[16];
  #pragma unroll
  for(int r=0;r<16;++r)rli[r]=__builtin_amdgcn_rcpf(wsf[32+crow(r,hi)]);
  bf16*Ow=O+(rowbase+q0+wid*QBLK)*DM+h*D;
  { bf16*stg=(bf16*)(shm+LDS_OST)+wid*2048;
    #pragma unroll
    for(int r=0;r<16;++r){const int orow=crow(r,hi);
      #pragma unroll
      for(int d0=0;d0<2;++d0){const float gv=__uint_as_float((unsigned)Gt[(rowbase+q0+wid*QBLK+orow)*DM+h*D+d0*32+r32]<<16); const float ov=o[d0][r]*rli[r]*gv; unsigned ub=__float_as_uint(ov); ub=(ub+0x7fffu+((ub>>16)&1u))>>16; stg[orow*64+d0*32+r32]=(bf16)ub;}}
    asm volatile("s_waitcnt lgkmcnt(0)":::"memory");
    #pragma unroll
    for(int i=0;i<4;++i){const int row=i*8+(lane>>3),ch=lane&7; const u32x4 v=*(const u32x4*)(stg+row*64+ch*8); ATTN_STORE16(Ow+(long)row*DM+ch*8,v);} }
  asm volatile("s_waitcnt lgkmcnt(0)\n\ts_barrier":::"memory");
  #undef DMA_K
  #undef DMA_V
  #undef CMASK
  #undef BIAS
  #undef LDSF4
  #undef START
  #undef RESC
  #undef ROT
}
constexpr int ATTN_LDS_BYTES=LDS_BYTES;
#undef SBAR
#undef WAIT_BAR
}

__device__ __forceinline__ void fox_attn2(const Params& P, char* shm, int tid, int bid, int G, unsigned short* Odst) {
    const int lane = tid & 63;
    unsigned short* Q = (unsigned short*)(P.ws + WS_ACT); const unsigned short* Kb = (const unsigned short*)(P.ws + WS_ACT + 32 * MiB); const unsigned short* V = (const unsigned short*)(P.ws + WS_ACT + 64 * MiB);
    const unsigned short* Gt = (const unsigned short*)(P.ws + WS_ACT + 96 * MiB);
    LAS float* nc = (LAS float*)((LAS char*)shm + attn_body::LDS_NC);
    LAS float* ft = (LAS float*)((LAS char*)shm + attn_body::LDS_FT);
    LAS float* re = (LAS float*)((LAS char*)shm + attn_body::LDS_RE);
    float gq = fabsf(P.fox_q_gain[lane]), gk = fabsf(P.fox_k_gain[lane]);
#pragma unroll
    for (int o = 1; o < 64; o <<= 1) { gq = fmaxf(gq, __shfl_xor(gq, o)); gk = fmaxf(gk, __shfl_xor(gk, o)); }
    const float Smax = 1.02f * (64.0f * gq * gk * 0.125f * LOG2E);
    const float T = 2.0f * Smax + 40.0f;
    const int vcu = (G % 8 == 0) ? (bid % 8) * (G / 8) + bid / 8 : bid;
    int last_bh = -1;
    for (int i = 0;; ++i) {
        int bh, qb;
        if (G == 256) { if (i >= 4) break; bh = vcu >> 2; const int s = vcu & 3; qb = (i == 0) ? s : (i == 1) ? 7 - s : (i == 2) ? 8 + s : 15 - s; }
        else { const int ui = i * G + bid; if (ui >= 1024) break; bh = ui >> 4; qb = ui & 15; }
        if (bh != last_bh) {
            const float* LF = (const float*)(P.ws + WS_S16) + ((size_t)(bh >> 4) * SEQ + 8 * tid) * 16 + (bh & 15);
            float v8[8]; float run = 0.f;
#pragma unroll
            for (int i2 = 0; i2 < 8; ++i2) { run += LF[(size_t)i2 * 16]; v8[i2] = run; }
            float inc = run;
#pragma unroll
            for (int o = 1; o < 64; o <<= 1) { const float tt = __shfl_up(inc, o); if (lane >= o) inc += tt; }
            if (lane == 63) ft[tid >> 6] = inc;
            __syncthreads();
            float pre = inc - run;
            for (int w = 0; w < (tid >> 6); ++w) pre += ft[w];
            __syncthreads();
#pragma unroll
            for (int i2 = 0; i2 < 8; ++i2) nc[8 * tid + i2] = -(pre + v8[i2]) * LOG2E;
            __syncthreads();
            if (tid < 64) { const float e = nc[64 * tid + 63]; re[tid] = e; const float ep = (tid > 0) ? nc[64 * tid - 1] : e; ft[tid] = exp2f(ep - e); }
            __syncthreads();
#pragma unroll
            for (int i2 = 0; i2 < 8; ++i2) nc[8 * tid + i2] += -re[tid >> 3] - Smax + 40.0f;
            __syncthreads(); last_bh = bh;
        }
        const int ntf = 4 * qb + 4;
        const float thr = (qb > 0 ? re[4 * qb - 1] : 0.0f) - T;
        const bool pred = (lane < ntf) && (re[lane] < thr);
        int ts = __builtin_popcountll(__ballot(pred)) & ~1; ts = ts > ntf - 4 ? ntf - 4 : ts; ts = __builtin_amdgcn_readfirstlane(ts);
        int tid_u = tid; asm volatile("" : "+v"(tid_u));
        attn_body::attn_unit<8>(bh >> 4, bh & 15, qb, ts, Q, Kb, V, Gt, Odst ? Odst : Q, shm, tid_u);
    }
}

__device__ __forceinline__ void final_norm(const Params& P, int tid, int bid, int G) {
    const int lane = tid & 63, wave = tid >> 6;
    const int gw = bid * 8 + wave, NGW = G * 8;
    f32x4 g[4];
#pragma unroll
    for (int j = 0; j < 4; ++j) g[j] = *(const f32x4*)(P.final_g + 4 * lane + 256 * j);
    constexpr int RB = 4;
    for (int row0 = gw; row0 < MT; row0 += RB * NGW) {
        f32x4 v[RB][4];
#pragma unroll
        for (int rb = 0; rb < RB; ++rb) { const int row = row0 + rb * NGW < MT ? row0 + rb * NGW : row0; const f32x4* xr = (const f32x4*)(P.out + (size_t)row * 1024) + lane;
#pragma unroll
            for (int j = 0; j < 4; ++j) v[rb][j] = xr[64 * j]; }
#pragma unroll
        for (int rb = 0; rb < RB; ++rb) { const int row = row0 + rb * NGW; if (row >= MT) break;
            float ss = 0.f;
#pragma unroll
            for (int j = 0; j < 4; ++j) ss += (v[rb][j][0] * v[rb][j][0] + v[rb][j][1] * v[rb][j][1]) + (v[rb][j][2] * v[rb][j][2] + v[rb][j][3] * v[rb][j][3]);
            const float rstd = rsqrtf(wave_sum(ss) * (1.0f / 1024.0f) + EPS);
            f32x4* xw = (f32x4*)(P.out + (size_t)row * 1024) + lane;
#pragma unroll
            for (int j = 0; j < 4; ++j) xw[64 * j] = (v[rb][j] * rstd) * g[j];
        }
    }
}

#define XB_TMO      128
#define XB_XCNT(j)  (256  + 64 * (j))
#define XB_XSUB(j)  (1280 + 64 * (j))
#define XB_XGEN(j)  (2304 + 64 * (j))
#define XB_TOP      3328
#define XB_TOPGEN   3392
#define XCD_BAR_WORDS 3456
#define XB_SPIN_CAP (1u << 20)
__device__ __forceinline__ unsigned xb_ld(unsigned* p)              { return __hip_atomic_load(p, __ATOMIC_RELAXED, __HIP_MEMORY_SCOPE_AGENT); }
__device__ __forceinline__ unsigned xb_add(unsigned* p, unsigned v) { return __hip_atomic_fetch_add(p, v, __ATOMIC_RELAXED, __HIP_MEMORY_SCOPE_AGENT); }
__device__ __forceinline__ unsigned xb_xcc_id() { return (unsigned)__builtin_amdgcn_s_getreg((3 << 11) | 20) & 0xFu; }
#define XB_SPIN(cond, bar) do { unsigned _sp = 0; while (cond) { __builtin_amdgcn_s_sleep(1); \
    if ((++_sp & 255u) == 0u) { if (xb_ld(&(bar)[XB_TMO])) break; if (_sp > XB_SPIN_CAP) { atomicAdd(&(bar)[XB_TMO], 1u); break; } } } } while (0)
struct XcdBarrier { unsigned* bar; unsigned x; volatile LAS unsigned* st; int wave_s; };
__device__ __forceinline__ int lane_id() { return (int)__builtin_amdgcn_mbcnt_hi(~0u, __builtin_amdgcn_mbcnt_lo(~0u, 0u)); }
__device__ __forceinline__ XcdBarrier xcd_barrier_post(unsigned* bar, volatile LAS unsigned* st, int wave_s) {
    XcdBarrier b; b.bar = bar; b.x = xb_xcc_id(); b.st = st; b.wave_s = wave_s;
    if (threadIdx.x == 0) (void)xb_add(&bar[XB_XCNT(b.x)], 1u);
    return b;
}
__device__ __forceinline__ void xcd_barrier_complete(unsigned* bar, unsigned x, unsigned& nloc, unsigned& nx) {
    const unsigned G = gridDim.x * gridDim.y * gridDim.z;
    asm volatile("" : "+s"(x));
    unsigned sum, cnt, mine, sp = 0u;
    for (;;) {
        sum = 0u; cnt = 0u; mine = 0u;
#pragma unroll
        for (unsigned j = 0; j < 16; ++j) { const unsigned c = xb_ld(&bar[XB_XCNT(j)]); sum += c; cnt += (c > 0u) ? 1u : 0u; mine = (j == x) ? c : mine; }
        if (sum == G) break;
        __builtin_amdgcn_s_sleep(1);
        if ((++sp & 255u) == 0u) { if (xb_ld(&bar[XB_TMO])) break; if (sp > XB_SPIN_CAP) { atomicAdd(&bar[XB_TMO], 1u); break; } }
    }
    nloc = mine > 0u ? mine : 1u; nx = cnt > 0u ? cnt : 1u;
}
__device__ __forceinline__ void xcd_barrier(const XcdBarrier& b) {
    asm volatile("s_waitcnt vmcnt(0)" ::: "memory");
    __syncthreads();
    if (threadIdx.x == 0) {
        unsigned* bar = b.bar;
        __builtin_amdgcn_s_waitcnt(0);
        unsigned nloc = b.st[0], nx = b.st[1];
        if (nloc == 0u) { xcd_barrier_complete(bar, b.x, nloc, nx); b.st[0] = nloc; b.st[1] = nx; }
        const unsigned old = xb_add(&bar[XB_XSUB(b.x)], 1u);
        const unsigned gen = old / nloc;
        if (old + 1u == (gen + 1u) * nloc) {
            __builtin_amdgcn_fence(__ATOMIC_RELEASE, "agent");
            asm volatile("s_waitcnt vmcnt(0)" ::: "memory");
            const unsigned og = xb_add(&bar[XB_TOP], 1u);
            const unsigned tg = og / nx;
            if (og + 1u == (tg + 1u) * nx) xb_add(&bar[XB_TOPGEN], 1u);
            else XB_SPIN(xb_ld(&bar[XB_TOPGEN]) == tg, bar);
            xb_add(&bar[XB_XGEN(b.x)], 1u);
            __builtin_amdgcn_fence(__ATOMIC_ACQUIRE, "agent");
            asm volatile("s_waitcnt vmcnt(0)" ::: "memory");
        } else {
            XB_SPIN(xb_ld(&bar[XB_XGEN(b.x)]) == gen, bar);
            __builtin_amdgcn_fence(__ATOMIC_ACQUIRE, "agent");
            asm volatile("s_waitcnt vmcnt(0)" ::: "memory");
        }
    }
    __syncthreads();
}

constexpr int LDS_BYTES = 147456;
#ifndef PROBE
#define PROBE 0
#endif
#define FRESH() int tid = threadIdx.x, bid = blockIdx.x; asm volatile("" : "+v"(tid)); asm volatile("" : "+s"(bid));
__global__ void __launch_bounds__(512, 2) trunk_fwd(Params P) {
    extern __shared__ __attribute__((aligned(16))) unsigned char lds_raw[];
    LAS unsigned char* lds = (LAS unsigned char*)lds_raw;
    cg::grid_group grid = cg::this_grid();
    const int G = gridDim.x;
    volatile LAS unsigned* MISC = (volatile LAS unsigned*)(lds + LDS_BYTES - 128);
    const int wave_s = __builtin_amdgcn_readfirstlane((int)threadIdx.x >> 6);
    if (threadIdx.x < 32) MISC[threadIdx.x] = 0u;
    __syncthreads();
    XcdBarrier xbar = xcd_barrier_post((unsigned*)P.ws, MISC + 8, wave_s);
    unsigned char* ws = P.ws;
    const float* MOD = (const float*)(ws + WS_MOD);
    bf16_t* XN = (bf16_t*)(ws + WS_XN);
    bf16_t* ACT = (bf16_t*)(ws + WS_ACT);
#define GSYNC() xcd_barrier(xbar)
    if (PROBE == 30) { { FRESH(); p0_mod(P, lds, tid, bid, G); } { FRESH(); p0_rope(P, tid, bid, G); } __syncthreads(); }
    if (PROBE == 31) { FRESH(); conv_weights(P.ret_w_in, RET_IN, 6144, P.ret_w_out, 2048, ws + WS_W, lds, tid, bid, G); __syncthreads(); }
    { FRESH(); p0_mod(P, lds, tid, bid, G); }
    { FRESH(); p0_rope(P, tid, bid, G); }
    { FRESH(); conv_weights(P.ret_w_in, RET_IN, 6144, P.ret_w_out, 2048, ws + WS_W, lds, tid, bid, G); }
    grid.sync();
#pragma unroll 1
    for (int layer = 0; layer < 4; ++layer) {
        const int kind = layer % 3, j = layer / 3;
        unsigned char* wbase = ws + ((kind == 2) ? WS_WGLA : WS_W);
        bf16_t* WinT = (bf16_t*)wbase; bf16_t* WoutT = (bf16_t*)(wbase + 12 * MiB);
        const float* xin = (layer == 0) ? P.x : P.out;
        if (layer > 0) {
            FRESH();
            if (kind == 0) { if (G != 256) conv_weights(P.ret_w_in + (size_t)j * 1024 * RET_IN, RET_IN, 6144, P.ret_w_out + (size_t)j * 2048 * 1024, 2048, ws + WS_W, lds, tid, bid, G); }
            else if (kind == 1) conv_weights(P.fox_w_in, FOX_IN, 4096, P.fox_w_out, 1024, ws + WS_W, lds, tid, bid, G);
            else conv_weights(P.gla_w_in, GLA_IN, 3072, P.gla_w_out, 1024, ws + WS_WGLA, lds, tid, bid, G);
            __syncthreads();
        }
        if (PROBE == 5 || (PROBE >= 50 && PROBE <= 53 && layer == PROBE - 50)) {
            if (kind == 0) { FRESH(); h_phase<0>(P, layer, xin, lds, tid, bid, G); }
            else if (kind == 1) { FRESH(); h_phase<1>(P, layer, xin, lds, tid, bid, G); }
            else { FRESH(); h_phase<2>(P, layer, xin, lds, tid, bid, G); }
            __syncthreads();
        }
        if (kind == 0) { FRESH(); h_phase<0>(P, layer, xin, lds, tid, bid, G); }
        else if (kind == 1) { FRESH(); h_phase<1>(P, layer, xin, lds, tid, bid, G); }
        else { FRESH(); h_phase<2>(P, layer, xin, lds, tid, bid, G); }
        GSYNC();
        const float* gate = MOD + (size_t)(layer * 4) * 3072 + 2048;
        if (kind == 0) {
            bf16_t* rQ = ACT; bf16_t* rK = (bf16_t*)(ws + WS_ACT + 32 * MiB); bf16_t* rV = (bf16_t*)(ws + WS_ACT + 64 * MiB); bf16_t* rO = (bf16_t*)(ws + WS_ACT + 128 * MiB);
            bf16_t* rP = WinT;
            float* STATS = (float*)(ws + WS_S16);
            {
                FRESH();
                pg8::Gemm g{XN, WinT, MT, 4096, 1024}; pg8::StaticOrder S; S.init(MT, 4096, G, bid);
                EpiRetIn E{rQ, rK, rV, (const unsigned*)(ws + WS_ROPE)};
                pg8::gemm_phase<EpiRetIn, pg8::StaticOrder, true, true>(lds, g, S, E, tid);
            }
            GSYNC();
            if (PROBE == 40) { FRESH();
                pg8::Gemm g{XN, WinT, MT, 4096, 1024}; pg8::StaticOrder S; S.init(MT, 4096, G, bid);
                EpiRetIn E{rQ, rK, rV, (const unsigned*)(ws + WS_ROPE)};
                pg8::gemm_phase<EpiRetIn, pg8::StaticOrder, true, true>(lds, g, S, E, tid); GSYNC(); }
            if (PROBE == 6) { FRESH();
                pg8::Gemm g{XN, WinT + (size_t)4096 * 1024, MT, 2048, 1024}; pg8::StaticOrder S; S.init(MT, 2048, G, bid);
                EpiSplit E{(bf16_t*)P.out, 8, 0, 2048, -1};
                if (layer == 0) { pg8::gemm_phase<EpiSplit, pg8::StaticOrder, true, true>(lds, g, S, E, tid); GSYNC(); } }
            if (PROBE == 62 && layer == 0) { FRESH();
                pg8::Gemm g{XN, WinT, MT, 4096, 1024}; pg8::StaticOrder S; S.init(MT, 4096, G, bid);
                EpiNone E{P.out};
                pg8::gemm_phase<EpiNone, pg8::StaticOrder, true, true>(lds, g, S, E, tid); GSYNC(); }
            if (PROBE == 60 && layer == 0) { FRESH();
                pg8::Gemm g{XN, WinT + (size_t)4096 * 1024, MT, 2048, 1024}; pg8::StaticOrder S; S.init(MT, 2048, G, bid);
                EpiNone E{P.out};
                pg8::gemm_phase<EpiNone, pg8::StaticOrder, true, true>(lds, g, S, E, tid); GSYNC(); }
            if (PROBE == 8) { FRESH(); lin_pphase<0>(rQ, rK, rQ, rK, rP, tid, bid, G); GSYNC(); }
            { FRESH(); lin_pphase<0>(rQ, rK, rQ, rK, rP, tid, bid, G); }
            GSYNC();
            if (PROBE == 2) { FRESH(); lin_scan<0>(rQ, rK, rV, rP, nullptr, rO, STATS, lds, tid, bid, G); GSYNC(); }
            if (PROBE == 20 && layer == 0) { FRESH(); lin_scan<0, 1>(rQ, rK, rV, rP, nullptr, (bf16_t*)P.out, STATS, lds, tid, bid, G); GSYNC(); }
            if (PROBE == 21 && layer == 0) { FRESH(); lin_scan<0, 3>(rQ, rK, rV, rP, nullptr, (bf16_t*)P.out, STATS, lds, tid, bid, G); GSYNC(); }
            if (PROBE == 23 && layer == 0) { FRESH(); lin_scan<0, 4>(rQ, rK, rV, rP, nullptr, (bf16_t*)P.out, STATS, lds, tid, bid, G); GSYNC(); }
            if (PROBE == 24 && layer == 0) { FRESH(); lin_scan<0, 8>(rQ, rK, rV, rP, nullptr, (bf16_t*)P.out, STATS, lds, tid, bid, G); GSYNC(); }
            if (PROBE == 25 && layer == 0) { FRESH(); lin_scan<0, 16>(rQ, rK, rV, rP, nullptr, (bf16_t*)P.out, STATS, lds, tid, bid, G); GSYNC(); }
            if (PROBE == 26 && layer == 0) { FRESH(); lin_scan<0, 31>(rQ, rK, rV, rP, nullptr, (bf16_t*)P.out, STATS, lds, tid, bid, G); GSYNC(); }
            if (PROBE == 27 && layer == 0) { FRESH(); lin_scan<0, 32>(rQ, rK, rV, rP, nullptr, (bf16_t*)P.out, STATS, lds, tid, bid, G); GSYNC(); }
            if (PROBE == 22 && layer == 0) { FRESH(); lin_scan<0, 0>(rQ, rK, rV, rP, nullptr, (bf16_t*)P.out, STATS, lds, tid, bid, G); GSYNC(); }
            { FRESH(); lin_scan<0>(rQ, rK, rV, rP, nullptr, rO, STATS, lds, tid, bid, G); }
            GSYNC();
            {
                FRESH();
                pg8::Gemm g{XN, WinT + (size_t)4096 * 1024, MT, 2048, 1024}; pg8::PairOrder S{G, (G % 8 == 0) ? (bid % 8) * (G / 8) + bid / 8 : bid};
                EpiGateNorm<0> E{rO, STATS, (LAS float*)(lds + 131072)};
                pg8::gemm_phase<EpiGateNorm<0>, pg8::PairOrder, true, true>(lds, g, S, E, tid);
            }
            GSYNC();
            if (PROBE == 42 && layer == 0) { FRESH();
                pg8::Gemm g{rO, WoutT, MT, 1024, 2048}; pg8::StaticOrder S; S.init(MT, 1024, G, bid);
                EpiOut E{xin, P.out, gate};
                pg8::gemm_phase<EpiOut, pg8::StaticOrder, true, true>(lds, g, S, E, tid); GSYNC(); }
            {
                FRESH();
                pg8::Gemm g{rO, WoutT, MT, 1024, 2048}; pg8::StaticOrder S; S.init(MT, 1024, G, bid);
                EpiOut E{xin, P.out, gate};
                pg8::gemm_phase<EpiOut, pg8::StaticOrder, true, true>(lds, g, S, E, tid);
            }
            GSYNC();
        } else if (kind == 1) {
            {
                FRESH();
                pg8::Gemm g{XN, WinT, MT, 4096, 1024}; pg8::StaticOrder S; S.init(MT, 4096, G, bid);
                EpiFoxIn E{ACT, P.fox_q_gain, P.fox_k_gain, (LAS float*)(lds + 131072)};
                pg8::gemm_phase<EpiFoxIn, pg8::StaticOrder, true, true>(lds, g, S, E, tid);
            }
            GSYNC();
            if (PROBE == 41) { FRESH();
                pg8::Gemm g{XN, WinT, MT, 4096, 1024}; pg8::StaticOrder S; S.init(MT, 4096, G, bid);
                EpiFoxIn E{ACT, P.fox_q_gain, P.fox_k_gain, (LAS float*)(lds + 131072)};
                pg8::gemm_phase<EpiFoxIn, pg8::StaticOrder, true, true>(lds, g, S, E, tid); GSYNC(); }
            if (PROBE == 1) { FRESH(); fox_attn2(P, (char*)lds_raw, tid, bid, G, XN); GSYNC(); }
            { FRESH(); fox_attn2(P, (char*)lds_raw, tid, bid, G, nullptr); }
            GSYNC();
            {
                FRESH();
                pg8::Gemm g{ACT, WoutT, MT, 1024, 1024}; pg8::StaticOrder S; S.init(MT, 1024, G, bid);
                EpiOut E{xin, P.out, gate};
                pg8::gemm_phase<EpiOut, pg8::StaticOrder, true, true>(lds, g, S, E, tid);
            }
            GSYNC();
        } else {
            bf16_t* gQE = ACT; bf16_t* gQN = (bf16_t*)(ws + WS_ACT + 16 * MiB); bf16_t* gKE = (bf16_t*)(ws + WS_ACT + 32 * MiB); bf16_t* gKN = (bf16_t*)(ws + WS_ACT + 48 * MiB);
            bf16_t* gV = (bf16_t*)(ws + WS_ACT + 64 * MiB); bf16_t* gP = (bf16_t*)(ws + WS_ACT + 96 * MiB); bf16_t* gO = (bf16_t*)(ws + WS_ACT + 128 * MiB);
            const float* gCB = (const float*)(ws + WS_ACT + 160 * MiB);
            float* STATS = (float*)(ws + WS_S16);
            {
                FRESH();
                pg8::Gemm g{XN, WinT, MT, 2048, 1024}; pg8::StaticOrder S; S.init(MT, 2048, G, bid);
                EpiGlaIn E{gQE, gQN, gKE, gKN, gV, nullptr, gCB};
                pg8::gemm_phase<EpiGlaIn, pg8::StaticOrder, true, true>(lds, g, S, E, tid);
            }
            GSYNC();
            { FRESH(); lin_pphase<1>(gQE, gKN, gQN, gKE, gP, tid, bid, G); }
            GSYNC();
            if (PROBE == 3) { FRESH(); lin_scan<1>(gQE, gKN, gV, gP, gCB, gO, STATS, lds, tid, bid, G); GSYNC(); }
            if (G == 256 && ((int)blockIdx.x >> 3) >= 16) {
                FRESH(); const int sub = (bid & 7) * 16 + ((bid >> 3) - 16);
                conv_weights(P.ret_w_in + (size_t)1 * 1024 * RET_IN, RET_IN, 6144, P.ret_w_out + (size_t)1 * 2048 * 1024, 2048, ws + WS_W, lds, tid, sub, 128);
            } else { FRESH(); lin_scan<1>(gQE, gKN, gV, gP, gCB, gO, STATS, lds, tid, bid, G); }
            GSYNC();
            {
                FRESH();
                pg8::Gemm g{XN, WinT + (size_t)2048 * 1024, MT, 1024, 1024}; pg8::StaticOrder S; S.init(MT, 1024, G, bid);
                EpiGateNorm<1> E{gO, STATS, (LAS float*)(lds + 131072)};
                pg8::gemm_phase<EpiGateNorm<1>, pg8::StaticOrder, true, true>(lds, g, S, E, tid);
            }
            GSYNC();
            {
                FRESH();
                pg8::Gemm g{gO, WoutT, MT, 1024, 1024}; pg8::StaticOrder S; S.init(MT, 1024, G, bid);
                EpiOut E{xin, P.out, gate};
                pg8::gemm_phase<EpiOut, pg8::StaticOrder, true, true>(lds, g, S, E, tid);
            }
            GSYNC();
        }
    }
    if (PROBE == 70) { for (int i = 0; i < 10; ++i) GSYNC(); }
    { FRESH(); final_norm(P, tid, bid, G); }
}

extern "C" void kernel_launch(void* const* d_in, const int* in_sizes, int n_in, void* d_out, int out_size, void* d_ws, size_t ws_size, hipStream_t stream) {
    static int grid = 0;
    if (grid == 0) {
        if (n_in != 18 || out_size != MT * DM || ws_size < WS_END) { fprintf(stderr, "kernel_launch: unexpected shapes (n_in %d out %d ws %zu)\n", n_in, out_size, ws_size); grid = -1; return; }
        int dev = 0, cus = 0, per_cu = 0;
        hipGetDevice(&dev);
        hipDeviceGetAttribute(&cus, hipDeviceAttributeMultiprocessorCount, dev);
        hipFuncSetAttribute((const void*)trunk_fwd, hipFuncAttributeMaxDynamicSharedMemorySize, LDS_BYTES);
        hipOccupancyMaxActiveBlocksPerMultiprocessor(&per_cu, (const void*)trunk_fwd, 512, LDS_BYTES);
        if (per_cu < 1) { fprintf(stderr, "kernel_launch: occupancy query says %d blocks per CU\n", per_cu); per_cu = 1; }
        (void)hipGetLastError();
        grid = cus;
    }
    if (grid < 0) return;
    Params p{};
    p.x = (const float*)d_in[0]; p.c = (const float*)d_in[1]; p.pos = (const int*)d_in[2]; p.mod_w = (const float*)d_in[3]; p.mod_b = (const float*)d_in[4]; p.norm_g = (const float*)d_in[5];
    p.ret_w_in = (const float*)d_in[6]; p.ret_w_out = (const float*)d_in[7]; p.fox_w_in = (const float*)d_in[8]; p.fox_b_f = (const float*)d_in[9]; p.fox_q_gain = (const float*)d_in[10]; p.fox_k_gain = (const float*)d_in[11];
    p.fox_w_out = (const float*)d_in[12]; p.gla_w_in = (const float*)d_in[13]; p.gla_w_gate2 = (const float*)d_in[14]; p.gla_b_gate = (const float*)d_in[15]; p.gla_w_out = (const float*)d_in[16]; p.final_g = (const float*)d_in[17];
    p.out = (float*)d_out; p.ws = (unsigned char*)d_ws;
    if (hipMemsetAsync(d_ws, 0, 16384, stream) != hipSuccess) { fprintf(stderr, "kernel_launch: memset failed\n"); return; }
    void* args[] = {&p};
    hipError_t e = hipLaunchCooperativeKernel((const void*)trunk_fwd, dim3(grid), dim3(512), args, LDS_BYTES, stream);
    if (e != hipSuccess) fprintf(stderr, "cooperative launch failed: %s (grid %d)\n", hipGetErrorString(e), grid);
}
```

```cpp
#include <hip/hip_runtime.h>
#include <hip/hip_cooperative_groups.h>
#include <cstdio>
#include <cstdint>
#include <cmath>
namespace cg = cooperative_groups;

#define LAS __attribute__((address_space(3)))
typedef unsigned short bf16_t;
typedef short bf16x8 __attribute__((ext_vector_type(8)));
typedef float f32x4 __attribute__((ext_vector_type(4)));
typedef float f32x2 __attribute__((ext_vector_type(2)));
typedef unsigned u32x4 __attribute__((ext_vector_type(4)));
typedef unsigned u32x2 __attribute__((ext_vector_type(2)));

constexpr int DM = 1024, NB = 4, SEQ = 4096, MT = NB * SEQ;
constexpr float EPS = 1e-6f;
constexpr int RET_IN = 6144, FOX_IN = 4112, GLA_IN = 3088;
constexpr float LOG2E = 1.4426950408889634f;

constexpr size_t MiB = 1u << 20;
constexpr size_t WS_MOD = 1 * MiB;
constexpr size_t WS_S16 = 2 * MiB;
constexpr size_t WS_CUM = 3 * MiB;
constexpr size_t WS_ROPE = 4 * MiB;
constexpr size_t WS_W = 12 * MiB;
constexpr size_t WS_WOUT = WS_W + 12 * MiB;
constexpr size_t WS_WGLA = 164 * MiB;
constexpr size_t WS_XN = 28 * MiB;
constexpr size_t WS_ACT = 60 * MiB;
constexpr size_t WS_END = 252 * MiB;

__device__ __forceinline__ unsigned f2bf(float f) { unsigned u = __builtin_bit_cast(unsigned, f); return (u + 0x7fffu + ((u >> 16) & 1u)) >> 16; }
typedef float f32x2_hw __attribute__((ext_vector_type(2))); typedef __bf16 bf16x2_hw __attribute__((ext_vector_type(2)));
__device__ __forceinline__ unsigned pk2(float lo, float hi) { f32x2_hw v = {lo, hi}; bf16x2_hw b = __builtin_convertvector(v, bf16x2_hw); return __builtin_bit_cast(unsigned, b); }
__device__ __forceinline__ float bf2f(unsigned h) { return __builtin_bit_cast(float, h << 16); }
__device__ __forceinline__ u32x2 pk4(f32x4 v) { u32x2 r; r.x = pk2(v[0], v[1]); r.y = pk2(v[2], v[3]); return r; }
__device__ __forceinline__ f32x4 unpk4(u32x2 w) { f32x4 r; r[0] = bf2f(w.x & 0xffffu); r[1] = bf2f(w.x >> 16); r[2] = bf2f(w.y & 0xffffu); r[3] = bf2f(w.y >> 16); return r; }
__device__ __forceinline__ float silu_f(float v) { return v * __builtin_amdgcn_rcpf(1.0f + __expf(-v)); }
__device__ __forceinline__ float logsig_f(float v) { return fminf(v, 0.0f) - __logf(1.0f + __expf(-fabsf(v))); }
template <int CTRL> __device__ __forceinline__ float dpp_mov(float v) { return __builtin_bit_cast(float, __builtin_amdgcn_update_dpp(0, __builtin_bit_cast(int, v), CTRL, 0xf, 0xf, true)); }
__device__ __forceinline__ float swap32_sum(float x, float y) { auto r = __builtin_amdgcn_permlane32_swap(__builtin_bit_cast(unsigned, x), __builtin_bit_cast(unsigned, y), false, false); const unsigned r0 = r[0], r1 = r[1]; return __builtin_bit_cast(float, r0) + __builtin_bit_cast(float, r1); }
__device__ __forceinline__ float swap16_sum(float x, float y) { auto r = __builtin_amdgcn_permlane16_swap(__builtin_bit_cast(unsigned, x), __builtin_bit_cast(unsigned, y), false, false); const unsigned r0 = r[0], r1 = r[1]; return __builtin_bit_cast(float, r0) + __builtin_bit_cast(float, r1); }
__device__ __forceinline__ float row_sum16(float v) {
    v += dpp_mov<0xB1>(v);
    v += dpp_mov<0x4E>(v);
    v += dpp_mov<0x141>(v);
    v += dpp_mov<0x140>(v);
    return v;
}
__device__ __forceinline__ float xsum_16_32(float v) { v = swap16_sum(v, v); return swap32_sum(v, v); }
__device__ __forceinline__ float wave_sum(float v) { return xsum_16_32(row_sum16(v)); }
__device__ __forceinline__ float reduce_scatter16(const float (&a)[16], int lane) {
    float b8[8], c4[4], d2[2], e1;
#pragma unroll
    for (int i = 0; i < 8; ++i) b8[i] = swap32_sum(a[i], a[i + 8]);
#pragma unroll
    for (int i = 0; i < 4; ++i) c4[i] = swap16_sum(b8[i], b8[i + 4]);
    { const bool hi = (lane & 8) != 0;
#pragma unroll
      for (int i = 0; i < 2; ++i) { const float snd = hi ? c4[i] : c4[i + 2], kp = hi ? c4[i + 2] : c4[i]; d2[i] = kp + dpp_mov<0x128>(snd); } }
    { const bool hi = (lane & 4) != 0; const float snd = hi ? d2[0] : d2[1], kp = hi ? d2[1] : d2[0]; e1 = kp + dpp_mov<0x1B>(dpp_mov<0x141>(snd)); }
    e1 += dpp_mov<0x4E>(e1); e1 += dpp_mov<0xB1>(e1);
    return e1;
}
#define LDS_WAIT() asm volatile("s_waitcnt lgkmcnt(0)" ::: "memory")

__device__ __forceinline__ f32x4 mma_rc(f32x4 acc, bf16x8 a_rows, bf16x8 b_cols) { return __builtin_amdgcn_mfma_f32_16x16x32_bf16(b_cols, a_rows, acc, 0, 0, 0); }
__device__ __forceinline__ f32x4 mma_cr(f32x4 acc, bf16x8 a_rows, bf16x8 b_cols) { return __builtin_amdgcn_mfma_f32_16x16x32_bf16(a_rows, b_cols, acc, 0, 0, 0); }
__device__ __forceinline__ bf16x8 gfrag(const bf16_t* base, int pitch, int lane) { return *(const bf16x8*)(base + (size_t)(lane & 15) * pitch + 8 * (lane >> 4)); }
__device__ __forceinline__ bf16x8 lfrag(const LAS bf16_t* base, int pitch, int lane) { return *(const LAS bf16x8*)(base + (lane & 15) * pitch + 8 * (lane >> 4)); }

namespace pg8 {
#define PG8_LAS __attribute__((address_space(3)))
constexpr int BM = 256, BK = 64, HALF = 128, HTB = HALF * BK * 2, STAGE_BYTES = 8 * HTB, NXCD = 8, WGM = 8;
__host__ __device__ __forceinline__ int lds_byte(int r, int c) { const int st = (r >> 4) * 2 + (c >> 5), rr = r & 15, cc = c & 31, ob = rr * 64 + cc * 2; return st * 1024 + (ob ^ (((ob >> 9) & 1) << 5)); }
__host__ __device__ __forceinline__ void stage_rc(int b, int& R, int& C) { const int st = b / 1024, sb = b % 1024, swz = sb ^ (((sb >> 9) & 1) << 5); R = (st >> 1) * 16 + swz / 64; C = (st & 1) * 32 + (swz % 64) / 2; }
__host__ __device__ __forceinline__ int perm32(int rho) { const int n = rho >> 4, i = rho & 15; return 8 * (i >> 2) + 4 * n + (i & 3); }

struct Unit { int pm, pn; };
struct Gemm { const bf16_t* A; const bf16_t* Bt; int M, N, K; };
struct StaticOrder {
    int nM, nN, nwg, G, c;
    __host__ __device__ void init(int M, int N, int G_, int c_) { nM = M / BM; nN = N / BM; nwg = nM * nN; G = G_; c = c_; }
    __host__ __device__ bool next(int i, Unit& u) const {
        const long L = (long)i * G + c; if (L >= nwg) return false;
        int wgid = (int)L; { const int q = nwg / NXCD, r = nwg % NXCD, xcd = wgid % NXCD, off = wgid / NXCD; wgid = (xcd < r ? xcd * (q + 1) : r * (q + 1) + (xcd - r) * q) + off; }
        const int nig = WGM * nN, gid = wgid / nig, fm = gid * WGM, gsz = (nM - fm) < WGM ? (nM - fm) : WGM;
        u.pm = fm + ((wgid % nig) % gsz); u.pn = (wgid % nig) / gsz; return true;
    }
    __device__ __forceinline__ void a_ready(const Unit&) const {}
    __device__ __forceinline__ void done(const Unit&) const {}
};

struct PairOrder {
    int G, c;
    __device__ __forceinline__ bool next(int i, Unit& u) const { const int pair = (i >> 1) * G + c; if (pair >= 256) return false; u.pm = pair >> 2; u.pn = 2 * (pair & 3) + (i & 1); return true; }
    __device__ __forceinline__ void a_ready(const Unit&) const {}
    __device__ __forceinline__ void done(const Unit&) const {}
};
template <class Epi, class Sched, bool ALIGN_EPI = false, bool SP2 = false>
__device__ __forceinline__ void gemm_phase(PG8_LAS unsigned char* lds, const Gemm g, const Sched& S, const Epi& E, int tid) {
    const int wid = __builtin_amdgcn_readfirstlane(tid >> 6), lane = tid & 63, wr = wid >> 2, wc = wid & 3, fr = lane & 15, fq = lane >> 4;
    const int K = g.K, nt = K / BK;
    unsigned voffA[2], voffB[2];
#pragma unroll
    for (int i = 0; i < 2; ++i) { int R, C; stage_rc(tid * 16 + i * 8192, R, C); const int Rb = Epi::PERM ? ((R & ~31) + perm32(R & 31)) : R;
        voffA[i] = (unsigned)(R * K + C) * 2u; voffB[i] = (unsigned)(Rb * K + C) * 2u; }
    const size_t kstep = (size_t)(BK * 2);
    const size_t hstep = (size_t)HALF * K * 2;
    const size_t tstep = 2 * hstep;
    const unsigned ldsw = (unsigned)wid * 1024u;
    const int aoff = lds_byte(wr * 64 + fr, fq * 8), boff = lds_byte(wc * 32 + fr, fq * 8);
#define PG8_SA(b, h) (((b) * 2 + (h)) * HTB)
#define PG8_SB(b, h) ((4 + (b) * 2 + (h)) * HTB)
#define PG8_STAGE(bufoff, gbase, voff) do { _Pragma("unroll") for (int _i = 0; _i < 2; ++_i) \
        __builtin_amdgcn_global_load_lds((const unsigned*)((const char*)(gbase) + (voff)[_i]), (PG8_LAS unsigned*)(lds + (bufoff) + ldsw + _i * 8192), 16, 0, 0); } while (0)
#define PG8_LDA(dst, b, h) do { _Pragma("unroll") for (int m = 0; m < 4; ++m) _Pragma("unroll") for (int k = 0; k < 2; ++k) dst[m][k] = *(const PG8_LAS bf16x8*)(lds + PG8_SA(b, h) + aoff + m * 2048 + k * 1024); } while (0)
#define PG8_LDB(dst, b, h) do { _Pragma("unroll") for (int n = 0; n < 2; ++n) _Pragma("unroll") for (int k = 0; k < 2; ++k) dst[n][k] = *(const PG8_LAS bf16x8*)(lds + PG8_SB(b, h) + boff + n * 2048 + k * 1024); } while (0)
#define PG8_MMA(ai, bj, At, Bt) do { __builtin_amdgcn_s_setprio(1); _Pragma("unroll") for (int m = 0; m < 4; ++m) _Pragma("unroll") for (int n = 0; n < 2; ++n) _Pragma("unroll") for (int k = 0; k < 2; ++k) \
        acc[ai][bj][m][n] = __builtin_amdgcn_mfma_f32_16x16x32_bf16(Bt[n][k], At[m][k], acc[ai][bj][m][n], 0, 0, 0); __builtin_amdgcn_s_setprio(0); } while (0)
#define PG8_WAIT_V(n) asm volatile("s_waitcnt vmcnt(" #n ")" ::: "memory")
#define PG8_WAIT_L(n) asm volatile("s_waitcnt lgkmcnt(" #n ")" ::: "memory")
#define PG8_BAR __builtin_amdgcn_s_barrier()
#define PG8_SCHED __builtin_amdgcn_sched_barrier(0)
    Unit cur, nxt; int ui = 0;
    if (!S.next(0, cur)) return;
    f32x4 acc[2][2][4][2];
#pragma unroll
    for (int a = 0; a < 2; ++a)
#pragma unroll
        for (int b = 0; b < 2; ++b)
#pragma unroll
            for (int m = 0; m < 4; ++m)
#pragma unroll
                for (int n = 0; n < 2; ++n) acc[a][b][m][n] = (f32x4){0.f, 0.f, 0.f, 0.f};
    bf16x8 At[4][2], B0[2][2], B1[2][2];
    const char* cA = (const char*)g.A + (size_t)cur.pm * tstep; const char* cB = (const char*)g.Bt + (size_t)cur.pn * tstep;
    S.a_ready(cur);
    if constexpr (SP2) {
        PG8_STAGE(PG8_SB(0, 0), cB, voffB); PG8_STAGE(PG8_SB(0, 1), cB + hstep, voffB); PG8_STAGE(PG8_SA(0, 0), cA, voffA); PG8_STAGE(PG8_SA(0, 1), cA + hstep, voffA);
        if (wr == 1) PG8_BAR;
        PG8_WAIT_V(2); PG8_BAR;
        PG8_STAGE(PG8_SB(1, 0), cB + kstep, voffB); PG8_STAGE(PG8_SA(1, 0), cA + kstep, voffA); PG8_STAGE(PG8_SB(1, 1), cB + hstep + kstep, voffB);
        PG8_WAIT_V(6); PG8_BAR;
    } else {
        PG8_STAGE(PG8_SB(0, 0), cB, voffB); PG8_STAGE(PG8_SA(0, 0), cA, voffA); PG8_STAGE(PG8_SB(0, 1), cB + hstep, voffB); PG8_STAGE(PG8_SA(0, 1), cA + hstep, voffA);
        if (wr == 1) PG8_BAR;
        PG8_WAIT_V(4); PG8_BAR;
        PG8_STAGE(PG8_SB(1, 0), cB + kstep, voffB); PG8_STAGE(PG8_SA(1, 0), cA + kstep, voffA); PG8_STAGE(PG8_SB(1, 1), cB + hstep + kstep, voffB);
        PG8_WAIT_V(6); PG8_BAR;
    }
    for (;;) {
        const bool has_next = S.next(ui + 1, nxt);
        const char* nA = has_next ? (const char*)g.A + (size_t)nxt.pm * tstep : cA; const char* nB = has_next ? (const char*)g.Bt + (size_t)nxt.pn * tstep : cB;
        for (int t = 0; t < nt; t += 2) {
            const bool last = (t == nt - 2);
            const char* a1 = cA + (size_t)(t + 1) * kstep;
            const char* a2 = last ? nA : cA + (size_t)(t + 2) * kstep; const char* b2 = last ? nB : cB + (size_t)(t + 2) * kstep;
            const char* a3 = a2 + kstep; const char* b3 = b2 + kstep;
            if (last && has_next) S.a_ready(nxt);
            if constexpr (SP2) {
            PG8_LDB(B0, 0, 0); PG8_LDB(B1, 0, 1); PG8_SCHED; PG8_LDA(At, 0, 0); PG8_STAGE(PG8_SA(1, 1), a1 + hstep, voffA);
            PG8_WAIT_V(8); PG8_WAIT_L(0); PG8_BAR; PG8_MMA(0, 0, At, B0); PG8_MMA(0, 1, At, B1); PG8_BAR; PG8_SCHED;
            PG8_LDA(At, 0, 1); PG8_STAGE(PG8_SB(0, 0), b2, voffB); PG8_STAGE(PG8_SB(0, 1), b2 + hstep, voffB); PG8_STAGE(PG8_SA(0, 0), a2, voffA);
            PG8_WAIT_V(8); PG8_WAIT_L(0); PG8_BAR; PG8_MMA(1, 0, At, B0); PG8_MMA(1, 1, At, B1); PG8_BAR; PG8_SCHED;
            PG8_LDB(B0, 1, 0); PG8_LDB(B1, 1, 1); PG8_SCHED; PG8_LDA(At, 1, 0); PG8_STAGE(PG8_SA(0, 1), a2 + hstep, voffA);
            PG8_WAIT_V(8); PG8_WAIT_L(0); PG8_BAR; PG8_MMA(0, 0, At, B0); PG8_MMA(0, 1, At, B1); PG8_BAR; PG8_SCHED;
            PG8_LDA(At, 1, 1); PG8_STAGE(PG8_SB(1, 0), b3, voffB); PG8_STAGE(PG8_SB(1, 1), b3 + hstep, voffB); PG8_STAGE(PG8_SA(1, 0), a3, voffA);
            PG8_WAIT_V(8); PG8_WAIT_L(0); PG8_BAR; PG8_MMA(1, 0, At, B0); PG8_MMA(1, 1, At, B1); PG8_BAR; PG8_SCHED;
            } else {
            PG8_LDB(B0, 0, 0); PG8_SCHED; PG8_LDA(At, 0, 0); PG8_STAGE(PG8_SA(1, 1), a1 + hstep, voffA);
            PG8_WAIT_L(8); PG8_BAR; PG8_WAIT_L(0); PG8_MMA(0, 0, At, B0); PG8_BAR; PG8_SCHED;
            PG8_LDB(B1, 0, 1); PG8_STAGE(PG8_SB(0, 0), b2, voffB);
            PG8_BAR; PG8_WAIT_L(0); PG8_MMA(0, 1, At, B1); PG8_BAR;
            PG8_LDA(At, 0, 1); PG8_STAGE(PG8_SA(0, 0), a2, voffA);
            PG8_BAR; PG8_WAIT_L(0); PG8_MMA(1, 0, At, B0); PG8_BAR; PG8_SCHED;
            PG8_STAGE(PG8_SB(0, 1), b2 + hstep, voffB);
            PG8_WAIT_V(6); PG8_BAR; PG8_MMA(1, 1, At, B1); PG8_BAR;
            PG8_LDB(B0, 1, 0); PG8_SCHED; PG8_LDA(At, 1, 0); PG8_STAGE(PG8_SA(0, 1), a2 + hstep, voffA);
            PG8_WAIT_L(8); PG8_BAR; PG8_WAIT_L(0); PG8_MMA(0, 0, At, B0); PG8_BAR; PG8_SCHED;
            PG8_LDB(B1, 1, 1); PG8_STAGE(PG8_SB(1, 0), b3, voffB);
            PG8_BAR; PG8_WAIT_L(0); PG8_MMA(0, 1, At, B1); PG8_BAR;
            PG8_LDA(At, 1, 1); PG8_STAGE(PG8_SA(1, 0), a3, voffA);
            PG8_BAR; PG8_WAIT_L(0); PG8_MMA(1, 0, At, B0); PG8_BAR; PG8_SCHED;
            PG8_STAGE(PG8_SB(1, 1), b3 + hstep, voffB);
            PG8_WAIT_V(6); PG8_BAR; PG8_MMA(1, 1, At, B1); PG8_BAR;
            }
        }
        if constexpr (ALIGN_EPI) { if (wr == 0) PG8_BAR; }
        E(acc, cur, wr, wc, fr, fq); S.done(cur);
        if (!has_next) break;
#pragma unroll
        for (int a = 0; a < 2; ++a)
#pragma unroll
            for (int b = 0; b < 2; ++b)
#pragma unroll
                for (int m = 0; m < 4; ++m)
#pragma unroll
                    for (int n = 0; n < 2; ++n) acc[a][b][m][n] = (f32x4){0.f, 0.f, 0.f, 0.f};
        cur = nxt; cA = nA; cB = nB; ++ui;
        if constexpr (ALIGN_EPI) { if (wr == 1) PG8_BAR; }
    }
    PG8_WAIT_V(0);
    if constexpr (!ALIGN_EPI) { if (wr == 0) PG8_BAR; }
    PG8_BAR;
#undef PG8_SA
#undef PG8_SB
#undef PG8_STAGE
#undef PG8_LDA
#undef PG8_LDB
#undef PG8_MMA
#undef PG8_WAIT_V
#undef PG8_WAIT_L
#undef PG8_BAR
#undef PG8_SCHED
}
}

struct Params {
    const float* x; const float* c; const int* pos; const float* mod_w; const float* mod_b; const float* norm_g;
    const float* ret_w_in; const float* ret_w_out; const float* fox_w_in; const float* fox_b_f; const float* fox_q_gain; const float* fox_k_gain; const float* fox_w_out;
    const float* gla_w_in; const float* gla_w_gate2; const float* gla_b_gate; const float* gla_w_out; const float* final_g;
    float* out; unsigned char* ws;
};

struct EpiRetIn {
    static constexpr bool PERM = false;
    bf16_t* Q; bf16_t* Kb; bf16_t* V; const unsigned* rope;
    __device__ __forceinline__ void operator()(const f32x4 (&acc)[2][2][4][2], const pg8::Unit& u, int wr, int wc, int fr, int fq) const {
        const int pn = u.pn;
        if (pn < 8) {
            bf16_t* dst = (pn < 4) ? Q : Kb; const int head = pn & 3; const float sc = (pn < 4) ? 0.0625f : 1.0f;
#pragma unroll
            for (int ai = 0; ai < 2; ++ai) {
                u32x4 cs[4][2];
#pragma unroll
                for (int m = 0; m < 4; ++m)
#pragma unroll
                    for (int n = 0; n < 2; ++n) cs[m][n] = *(const u32x4*)(rope + (size_t)(u.pm * 256 + ai * 128 + wr * 64 + m * 16 + fr) * 128 + wc * 32 + n * 16 + fq * 4);
                asm volatile("" ::: "memory");
#pragma unroll
                for (int m = 0; m < 4; ++m) {
                    const int row = u.pm * 256 + ai * 128 + wr * 64 + m * 16 + fr;
#pragma unroll
                    for (int n = 0; n < 2; ++n) {
                        const int d1 = wc * 32 + n * 16 + fq * 4;
                        const f32x4 x1 = acc[ai][0][m][n], x2 = acc[ai][1][m][n]; f32x4 o1, o2;
#pragma unroll
                        for (int j = 0; j < 4; ++j) {
                            const unsigned w = cs[m][n][j];
                            const float co = (float)__builtin_bit_cast(_Float16, (unsigned short)(w & 0xffffu)), si = (float)__builtin_bit_cast(_Float16, (unsigned short)(w >> 16));
                            o1[j] = (x1[j] * co - x2[j] * si) * sc; o2[j] = (x1[j] * si + x2[j] * co) * sc;
                        }
                        bf16_t* p = dst + (size_t)row * 1024 + head * 256 + d1;
                        *(u32x2*)p = pk4(o1); *(u32x2*)(p + 128) = pk4(o2);
                    }
                }
            }
        } else {
            const int cbase = (pn - 8) * 256;
#pragma unroll
            for (int ai = 0; ai < 2; ++ai)
#pragma unroll
                for (int m = 0; m < 4; ++m) {
                    const int row = u.pm * 256 + ai * 128 + wr * 64 + m * 16 + fr;
#pragma unroll
                    for (int bj = 0; bj < 2; ++bj)
#pragma unroll
                        for (int n = 0; n < 2; ++n) *(u32x2*)(V + (size_t)row * 2048 + cbase + bj * 128 + wc * 32 + n * 16 + fq * 4) = pk4(acc[ai][bj][m][n]);
                }
        }
    }
};
struct EpiSplit {
    static constexpr bool PERM = false;
    bf16_t* dst; int tpg; size_t gstride; int ldc; int silu_grp;
    __device__ __forceinline__ void operator()(const f32x4 (&acc)[2][2][4][2], const pg8::Unit& u, int wr, int wc, int fr, int fq) const {
        const int t = u.pn / tpg; bf16_t* base = dst + (size_t)t * gstride; const int cb = (u.pn - t * tpg) * 256; const bool act = (t == silu_grp);
#pragma unroll
        for (int ai = 0; ai < 2; ++ai)
#pragma unroll
            for (int m = 0; m < 4; ++m) {
                const int row = u.pm * 256 + ai * 128 + wr * 64 + m * 16 + fr;
#pragma unroll
                for (int bj = 0; bj < 2; ++bj)
#pragma unroll
                    for (int n = 0; n < 2; ++n) {
                        f32x4 a = acc[ai][bj][m][n];
                        if (act) {
#pragma unroll
                            for (int j = 0; j < 4; ++j) a[j] = silu_f(a[j]);
                        }
                        *(u32x2*)(base + (size_t)row * ldc + cb + bj * 128 + wc * 32 + n * 16 + fq * 4) = pk4(a);
                    }
            }
    }
};
struct EpiFoxIn {
    static constexpr bool PERM = false;
    bf16_t* dst; const float* qgain; const float* kgain; LAS float* tbl;
    __device__ __forceinline__ void operator()(const f32x4 (&acc)[2][2][4][2], const pg8::Unit& u, int wr, int wc, int fr, int fq) const {
        const int t = u.pn >> 2; bf16_t* base = dst + (size_t)t * ((size_t)16 * MiB); const int cb = (u.pn & 3) * 256;
        if (t < 2) {
#pragma unroll
            for (int ai = 0; ai < 2; ++ai)
#pragma unroll
                for (int m = 0; m < 4; ++m)
#pragma unroll
                    for (int bj = 0; bj < 2; ++bj) {
                        float sq = 0.f;
#pragma unroll
                        for (int n = 0; n < 2; ++n) { const f32x4 a = acc[ai][bj][m][n]; sq += (a[0] * a[0] + a[1] * a[1]) + (a[2] * a[2] + a[3] * a[3]); }
                        sq = xsum_16_32(sq);
                        if (fq == 0) tbl[(((ai * 128 + wr * 64 + m * 16 + fr) * 4) + bj * 2 + (wc >> 1)) * 2 + (wc & 1)] = sq;
                    }
            asm volatile("s_waitcnt lgkmcnt(0)" ::: "memory"); __builtin_amdgcn_s_barrier(); asm volatile("" ::: "memory");
            const float* gn = (t == 0) ? qgain : kgain; const float sc = (t == 0) ? (0.125f * LOG2E) : 1.0f;
            f32x4 gv[2];
#pragma unroll
            for (int n = 0; n < 2; ++n) gv[n] = *(const f32x4*)(gn + (wc & 1) * 32 + n * 16 + fq * 4) * sc;
#pragma unroll
            for (int ai = 0; ai < 2; ++ai)
#pragma unroll
                for (int m = 0; m < 4; ++m) {
                    const int rl = ai * 128 + wr * 64 + m * 16 + fr; const int row = u.pm * 256 + rl;
#pragma unroll
                    for (int bj = 0; bj < 2; ++bj) {
                        const f32x2 pr = *(const LAS f32x2*)(tbl + ((rl * 4) + bj * 2 + (wc >> 1)) * 2);
                        const float rstd = __builtin_amdgcn_rsqf((pr.x + pr.y) * (1.0f / 64.0f) + EPS);
#pragma unroll
                        for (int n = 0; n < 2; ++n) *(u32x2*)(base + (size_t)row * 1024 + cb + bj * 128 + wc * 32 + n * 16 + fq * 4) = pk4(acc[ai][bj][m][n] * rstd * gv[n]);
                    }
                }
        } else {
            const bool act = (t == 3);
#pragma unroll
            for (int ai = 0; ai < 2; ++ai)
#pragma unroll
                for (int m = 0; m < 4; ++m) {
                    const int row = u.pm * 256 + ai * 128 + wr * 64 + m * 16 + fr;
#pragma unroll
                    for (int bj = 0; bj < 2; ++bj)
#pragma unroll
                        for (int n = 0; n < 2; ++n) {
                            f32x4 a = acc[ai][bj][m][n];
                            if (act) {
#pragma unroll
                                for (int j = 0; j < 4; ++j) a[j] = silu_f(a[j]);
                            }
                            *(u32x2*)(base + (size_t)row * 1024 + cb + bj * 128 + wc * 32 + n * 16 + fq * 4) = pk4(a);
                        }
                }
        }
    }
};
struct EpiGlaIn {
    static constexpr bool PERM = false;
    bf16_t *QE, *QN, *KE, *KN, *V, *G; const float* CB;
    __device__ __forceinline__ void operator()(const f32x4 (&acc)[2][2][4][2], const pg8::Unit& u, int wr, int wc, int fr, int fq) const {
        const int pn = u.pn;
        if (pn < 4) {
            const float s = (pn < 2) ? 0.08838834764831845f : 1.0f;
            bf16_t* De = (pn < 2 ? QE : KE); bf16_t* Dn = (pn < 2 ? QN : KN);
#pragma unroll
            for (int ai = 0; ai < 2; ++ai)
#pragma unroll
            for (int mh = 0; mh < 2; ++mh) {
                f32x4 cb[2][2][2];
#pragma unroll
                for (int mm = 0; mm < 2; ++mm)
#pragma unroll
                    for (int bj = 0; bj < 2; ++bj)
#pragma unroll
                        for (int n = 0; n < 2; ++n) cb[mm][bj][n] = *(const f32x4*)(CB + (size_t)(u.pm * 256 + ai * 128 + wr * 64 + (2 * mh + mm) * 16 + fr) * 512 + (pn & 1) * 256 + bj * 128 + wc * 32 + n * 16 + fq * 4);
                asm volatile("" ::: "memory");
#pragma unroll
                for (int mm = 0; mm < 2; ++mm) {
                    const int m = 2 * mh + mm; const int row = u.pm * 256 + ai * 128 + wr * 64 + m * 16 + fr;
#pragma unroll
                    for (int bj = 0; bj < 2; ++bj)
#pragma unroll
                        for (int n = 0; n < 2; ++n) {
                            const int col = (pn & 1) * 256 + bj * 128 + wc * 32 + n * 16 + fq * 4;
                            const f32x4 a = acc[ai][bj][m][n]; f32x4 e, en;
#pragma unroll
                            for (int j = 0; j < 4; ++j) { const float ee = __expf(cb[mm][bj][n][j]); e[j] = a[j] * s * ee; en[j] = a[j] * s * __builtin_amdgcn_rcpf(ee); }
                            *(u32x2*)(De + (size_t)row * 512 + col) = pk4(e); *(u32x2*)(Dn + (size_t)row * 512 + col) = pk4(en);
                        }
                }
                asm volatile("" ::: "memory");
            }
        } else {
#pragma unroll
            for (int ai = 0; ai < 2; ++ai)
#pragma unroll
                for (int m = 0; m < 4; ++m) {
                    const int row = u.pm * 256 + ai * 128 + wr * 64 + m * 16 + fr;
#pragma unroll
                    for (int bj = 0; bj < 2; ++bj)
#pragma unroll
                        for (int n = 0; n < 2; ++n) *(u32x2*)(V + (size_t)row * 1024 + (pn - 4) * 256 + bj * 128 + wc * 32 + n * 16 + fq * 4) = pk4(acc[ai][bj][m][n]);
                }
        }
    }
};
struct EpiNone {
    static constexpr bool PERM = false; float* sink;
    __device__ __forceinline__ void operator()(const f32x4 (&acc)[2][2][4][2], const pg8::Unit& u, int wr, int wc, int fr, int fq) const {
        f32x4 t = acc[0][0][0][0];
#pragma unroll
        for (int ai = 0; ai < 2; ++ai)
#pragma unroll
            for (int bj = 0; bj < 2; ++bj)
#pragma unroll
                for (int m = 0; m < 4; ++m)
#pragma unroll
                    for (int n = 0; n < 2; ++n) t += acc[ai][bj][m][n];
        if (t[0] + t[1] + t[2] + t[3] == 12345.678f) sink[0] = t[0];
    }
};
struct EpiOut {
    static constexpr bool PERM = false;
    const float* xold; float* xnew; const float* gate;
    __device__ __forceinline__ void operator()(const f32x4 (&acc)[2][2][4][2], const pg8::Unit& u, int wr, int wc, int fr, int fq) const {
        const int b = (u.pm * 256) >> 12;
        f32x4 gv[2][2];
#pragma unroll
        for (int bj = 0; bj < 2; ++bj)
#pragma unroll
            for (int n = 0; n < 2; ++n) gv[bj][n] = *(const f32x4*)(gate + (size_t)b * 3072 + u.pn * 256 + bj * 128 + wc * 32 + n * 16 + fq * 4);
#pragma unroll
        for (int ai = 0; ai < 2; ++ai)
#pragma unroll
            for (int mh = 0; mh < 2; ++mh) {
                f32x4 xo[2][2][2];
#pragma unroll
                for (int mm = 0; mm < 2; ++mm)
#pragma unroll
                    for (int bj = 0; bj < 2; ++bj)
#pragma unroll
                        for (int n = 0; n < 2; ++n) xo[mm][bj][n] = *(const f32x4*)(xold + (size_t)(u.pm * 256 + ai * 128 + wr * 64 + (2 * mh + mm) * 16 + fr) * 1024 + u.pn * 256 + bj * 128 + wc * 32 + n * 16 + fq * 4);
                asm volatile("" ::: "memory");
#pragma unroll
                for (int mm = 0; mm < 2; ++mm)
#pragma unroll
                    for (int bj = 0; bj < 2; ++bj)
#pragma unroll
                        for (int n = 0; n < 2; ++n)
                            *(f32x4*)(xnew + (size_t)(u.pm * 256 + ai * 128 + wr * 64 + (2 * mh + mm) * 16 + fr) * 1024 + u.pn * 256 + bj * 128 + wc * 32 + n * 16 + fq * 4) = xo[mm][bj][n] + gv[bj][n] * acc[ai][bj][2 * mh + mm][n];
                asm volatile("" ::: "memory");
            }
    }
};

__device__ __forceinline__ void transpose_item(const float* W, int ldw, int K, int nblk, bf16_t* WT, LAS float* scr, int item, int lane) {
    const int kb = item / nblk, nb = item % nblk, k0 = 64 * kb, n0 = 32 * nb;
#pragma unroll 8
    for (int i = 0; i < 32; ++i) { const int kk = 2 * i + (lane >> 5); scr[kk * 33 + (lane & 31)] = W[(size_t)(k0 + kk) * ldw + n0 + (lane & 31)]; }
    LDS_WAIT(); asm volatile("" ::: "memory");
    const int c = lane & 7;
#pragma unroll
    for (int j = 0; j < 4; ++j) { const int n = (lane >> 3) + 8 * j; const LAS float* s = scr + (8 * c) * 33 + n;
        u32x4 o; o.x = pk2(s[0 * 33], s[1 * 33]); o.y = pk2(s[2 * 33], s[3 * 33]); o.z = pk2(s[4 * 33], s[5 * 33]); o.w = pk2(s[6 * 33], s[7 * 33]);
        *(u32x4*)(WT + (size_t)(n0 + n) * K + k0 + 8 * c) = o; }
    LDS_WAIT(); asm volatile("" ::: "memory");
}
__device__ __forceinline__ void conv_weights(const float* w_in, int ld_in, int n_in, const float* w_out, int k_out, unsigned char* wdst, LAS unsigned char* lds, int tid, int bid, int G) {
    const int lane = tid & 63, wave = tid >> 6;
    LAS float* scr = (LAS float*)(lds + wave * 16384);
    const int gw = bid * 8 + wave, NGW = G * 8;
    const int I_in = (1024 / 64) * (n_in / 32), I_out = (k_out / 64) * (1024 / 32);
    bf16_t* WinT = (bf16_t*)wdst; bf16_t* WoutT = (bf16_t*)(wdst + 12 * MiB);
    for (int it = gw; it < I_in + I_out; it += NGW) {
        if (it < I_in) transpose_item(w_in, ld_in, 1024, n_in / 32, WinT, scr, it, lane);
        else transpose_item(w_out, 1024, k_out, 32, WoutT, scr, it - I_in, lane);
    }
}
__device__ __forceinline__ void p0_mod(const Params& P, LAS unsigned char* lds, int tid, int bid, int G) {
    LAS float* sc = (LAS float*)lds;
    LAS float* red = sc + 4096;
    const int lane = tid & 63, wave = tid >> 6;
    float* MOD = (float*)(P.ws + WS_MOD);
    for (int i = tid; i < 4096; i += 512) sc[i] = silu_f(P.c[i]);
    __syncthreads();
    for (int it = bid; it < 192; it += G) {
        const int l = it / 48, cb = it % 48, n = cb * 64 + lane;
        const float* W = P.mod_w + (size_t)l * 1024 * 3072 + n;
        float a0 = 0.f, a1 = 0.f, a2 = 0.f, a3 = 0.f;
        const int k0 = wave * 128;
#pragma unroll 8
        for (int k = k0; k < k0 + 128; ++k) { const float w = W[(size_t)k * 3072]; a0 += sc[k] * w; a1 += sc[1024 + k] * w; a2 += sc[2048 + k] * w; a3 += sc[3072 + k] * w; }
        red[(wave * 4 + 0) * 64 + lane] = a0; red[(wave * 4 + 1) * 64 + lane] = a1; red[(wave * 4 + 2) * 64 + lane] = a2; red[(wave * 4 + 3) * 64 + lane] = a3;
        __syncthreads();
        if (wave < 4) { float s = 0.f;
#pragma unroll
            for (int w = 0; w < 8; ++w) s += red[(w * 4 + wave) * 64 + lane];
            MOD[(size_t)(l * 4 + wave) * 3072 + n] = s + P.mod_b[l * 3072 + n]; }
        __syncthreads();
    }
}
__device__ __forceinline__ void p0_rope(const Params& P, int tid, int bid, int G) {
    unsigned* rope = (unsigned*)(P.ws + WS_ROPE);
    const int gt = bid * 512 + tid, NT = G * 512;
    for (int idx = gt; idx < MT * 128; idx += NT) {
        const int row = idx >> 7, d = idx & 127;
        const float inv = powf(10000.0f, -(float)d * (1.0f / 128.0f));
        const float ang = (float)P.pos[row] * inv;
        double t = (double)ang * 0.15915494309189535; t -= rint(t);
        const float fr = (float)t;
        const float co = __builtin_amdgcn_cosf(fr), si = __builtin_amdgcn_sinf(fr);
        const unsigned lo = __builtin_bit_cast(unsigned short, (_Float16)co), hi = __builtin_bit_cast(unsigned short, (_Float16)si);
        rope[idx] = lo | (hi << 16);
    }
}

template <int KIND>
__device__ __forceinline__ void h_phase(const Params& P, int layer, const float* xin, LAS unsigned char* lds, int tid, int bid, int G) {
    const int lane = tid & 63, wave = tid >> 6;
    LAS float* WxT = (LAS float*)lds;
    LAS float* W2 = (LAS float*)(lds + 65536);
    LAS float* TOT = (LAS float*)(lds + 98304);
    const float* MOD = (const float*)(P.ws + WS_MOD);
    bf16_t* XN = (bf16_t*)(P.ws + WS_XN);
    if (KIND > 0) {
        const float* wsrc = (KIND == 1) ? (P.fox_w_in + 4096) : (P.gla_w_in + 3072); const int ldw = (KIND == 1) ? FOX_IN : GLA_IN;
        {
            float wv[32];
#pragma unroll
            for (int it = 0; it < 32; ++it) { const int idx = tid + 512 * it; wv[it] = wsrc[(size_t)(idx >> 4) * ldw + (idx & 15)]; }
#pragma unroll
            for (int it = 0; it < 32; ++it) { const int idx = tid + 512 * it; WxT[(idx & 15) * 1024 + (idx >> 4)] = wv[it]; }
        }
        if (KIND == 2) {
            float w2v[16];
#pragma unroll
            for (int it = 0; it < 16; ++it) w2v[it] = P.gla_w_gate2[tid + 512 * it];
#pragma unroll
            for (int it = 0; it < 16; ++it) W2[tid + 512 * it] = w2v[it];
        }
        __syncthreads();
    }
    for (int ci = bid; ci < MT / 64; ci += G) {
        const int b = ci >> 6;
        if (KIND != 1) ((float*)(P.ws + WS_S16))[ci * 512 + tid] = 0.f;
        const float* mod = MOD + (size_t)(layer * 4 + b) * 3072;
        f32x4 ga[4], sh[4];
#pragma unroll
        for (int j = 0; j < 4; ++j) { const int col = 4 * lane + 256 * j;
            const f32x4 g4 = *(const f32x4*)(P.norm_g + layer * 1024 + col), s4 = *(const f32x4*)(mod + 1024 + col);
            ga[j] = g4 * (s4 + 1.0f); sh[j] = *(const f32x4*)(mod + col); }
        float run[8]; f32x4 cbv[8][2];
        if (KIND == 2) {
#pragma unroll
            for (int c = 0; c < 8; ++c) run[c] = 0.f;
        }
        if constexpr (false) {
        constexpr int BS = (KIND == 2) ? 2 : 4;
#pragma unroll (KIND == 2 ? 8 / BS : 1)
        for (int rb = 0; rb < 8; rb += BS) {
            asm volatile("" ::: "memory");
            f32x4 xv[BS][4];
#pragma unroll
            for (int bb = 0; bb < BS; ++bb) { const f32x4* xr = (const f32x4*)(xin + (size_t)(ci * 64 + wave * 8 + rb + bb) * 1024) + lane;
#pragma unroll
                for (int j = 0; j < 4; ++j) xv[bb][j] = xr[64 * j]; }
#pragma unroll
        for (int bb = 0; bb < BS; ++bb) {
            const int rr = rb + bb;
            asm volatile("" ::: "memory");
            const int row = ci * 64 + wave * 8 + rr;
            f32x4 v[4]; float ss = 0.f;
#pragma unroll
            for (int j = 0; j < 4; ++j) { v[j] = xv[bb][j]; ss += (v[j][0] * v[j][0] + v[j][1] * v[j][1]) + (v[j][2] * v[j][2] + v[j][3] * v[j][3]); }
            const float rstd = rsqrtf(wave_sum(ss) * (1.0f / 1024.0f) + EPS);
#pragma unroll
            for (int j = 0; j < 4; ++j) { v[j] = (v[j] * rstd) * ga[j] + sh[j]; *(u32x2*)(XN + (size_t)row * 1024 + 4 * lane + 256 * j) = pk4(v[j]); }
            if (KIND > 0) {
                float r[16];
#pragma unroll
                for (int i = 0; i < 16; ++i) { float a = 0.f;
#pragma unroll
                    for (int j = 0; j < 4; ++j) { const f32x4 w = *(const LAS f32x4*)(WxT + i * 1024 + 4 * lane + 256 * j); a += (v[j][0] * w[0] + v[j][1] * w[1]) + (v[j][2] * w[2] + v[j][3] * w[3]); }
                    r[i] = a; }
                if (KIND == 1) {
                    const float e1 = reduce_scatter16(r, lane);
                    const int idx = ((lane >> 5) & 1) * 8 + ((lane >> 4) & 1) * 4 + ((lane >> 3) & 1) * 2 + ((lane >> 2) & 1);
                    if ((lane & 3) == 0) ((float*)(P.ws + WS_S16))[(size_t)row * 16 + idx] = logsig_f(e1 + P.fox_b_f[idx]);
                } else {
                    f32x4 z0 = *(const f32x4*)(P.gla_b_gate + 8 * lane), z1 = *(const f32x4*)(P.gla_b_gate + 8 * lane + 4);
#pragma unroll
                    for (int i = 0; i < 16; ++i) { const f32x4 w0 = *(const LAS f32x4*)(W2 + i * 512 + 8 * lane), w1 = *(const LAS f32x4*)(W2 + i * 512 + 8 * lane + 4); z0 += w0 * r[i]; z1 += w1 * r[i]; }
#pragma unroll
                    for (int c = 0; c < 4; ++c) { run[c] += logsig_f(z0[c]) * 0.0625f; run[4 + c] += logsig_f(z1[c]) * 0.0625f; }
                    cbv[rr][0] = (f32x4){run[0], run[1], run[2], run[3]}; cbv[rr][1] = (f32x4){run[4], run[5], run[6], run[7]};
                }
            }
        }
        }
        } else {
        constexpr int BS = (KIND == 2) ? 2 : 4;
#pragma unroll (KIND != 0 ? 8 / BS : 1)
        for (int rb = 0; rb < 8; rb += BS) {
            asm volatile("" ::: "memory");
            f32x4 v[BS][4];
#pragma unroll
            for (int bb = 0; bb < BS; ++bb) { const f32x4* xr = (const f32x4*)(xin + (size_t)(ci * 64 + wave * 8 + rb + bb) * 1024) + lane;
#pragma unroll
                for (int j = 0; j < 4; ++j) v[bb][j] = xr[64 * j]; }
#pragma unroll
            for (int bb = 0; bb < BS; ++bb) {
                const int row = ci * 64 + wave * 8 + rb + bb; float ss = 0.f;
#pragma unroll
                for (int j = 0; j < 4; ++j) ss += (v[bb][j][0] * v[bb][j][0] + v[bb][j][1] * v[bb][j][1]) + (v[bb][j][2] * v[bb][j][2] + v[bb][j][3] * v[bb][j][3]);
                const float rstd = rsqrtf(wave_sum(ss) * (1.0f / 1024.0f) + EPS);
#pragma unroll
                for (int j = 0; j < 4; ++j) { v[bb][j] = (v[bb][j] * rstd) * ga[j] + sh[j]; *(u32x2*)(XN + (size_t)row * 1024 + 4 * lane + 256 * j) = pk4(v[bb][j]); }
            }
            if (KIND > 0) {
                float acc[BS][16];
#pragma unroll
                for (int i = 0; i < 16; ++i) {
                    f32x4 w[4];
#pragma unroll
                    for (int j = 0; j < 4; ++j) w[j] = *(const LAS f32x4*)(WxT + i * 1024 + 4 * lane + 256 * j);
#pragma unroll
                    for (int bb = 0; bb < BS; ++bb) { float a = 0.f;
#pragma unroll
                        for (int j = 0; j < 4; ++j) a += (v[bb][j][0] * w[j][0] + v[bb][j][1] * w[j][1]) + (v[bb][j][2] * w[j][2] + v[bb][j][3] * w[j][3]);
                        acc[bb][i] = a; }
                    if (i & 1) { __builtin_amdgcn_sched_barrier(0); asm volatile("" ::: "memory"); }
                }
#pragma unroll
                for (int bb = 0; bb < BS; ++bb) {
                    const int rr = rb + bb, row = ci * 64 + wave * 8 + rr;
                    asm volatile("" ::: "memory");
                    const float e1 = reduce_scatter16(acc[bb], lane);
                    if (KIND == 1) {
                        const int idx = ((lane >> 5) & 1) * 8 + ((lane >> 4) & 1) * 4 + ((lane >> 3) & 1) * 2 + ((lane >> 2) & 1);
                        ((float*)(P.ws + WS_S16))[(size_t)row * 16 + idx] = logsig_f(e1 + P.fox_b_f[idx]);
                    } else {
                        float r[16];
#pragma unroll
                        for (int i = 0; i < 16; ++i) r[i] = __builtin_bit_cast(float, __builtin_amdgcn_readlane(__builtin_bit_cast(int, e1), ((i >> 3) & 1) * 32 + ((i >> 2) & 1) * 16 + ((i >> 1) & 1) * 8 + (i & 1) * 4));
                        f32x4 z0 = *(const f32x4*)(P.gla_b_gate + 8 * lane), z1 = *(const f32x4*)(P.gla_b_gate + 8 * lane + 4);
#pragma unroll
                        for (int i = 0; i < 16; ++i) { const f32x4 w0 = *(const LAS f32x4*)(W2 + i * 512 + 8 * lane), w1 = *(const LAS f32x4*)(W2 + i * 512 + 8 * lane + 4); z0 += w0 * r[i]; z1 += w1 * r[i]; }
#pragma unroll
                        for (int c = 0; c < 4; ++c) { run[c] += logsig_f(z0[c]) * 0.0625f; run[4 + c] += logsig_f(z1[c]) * 0.0625f; }
                        cbv[rr][0] = (f32x4){run[0], run[1], run[2], run[3]}; cbv[rr][1] = (f32x4){run[4], run[5], run[6], run[7]};
                    }
                }
            }
        }
        }
        if (KIND == 2) {
            float* CB = (float*)(P.ws + WS_ACT + 160 * MiB);
            *(LAS f32x4*)(TOT + wave * 512 + 8 * lane) = (f32x4){run[0], run[1], run[2], run[3]};
            *(LAS f32x4*)(TOT + wave * 512 + 8 * lane + 4) = (f32x4){run[4], run[5], run[6], run[7]};
            __syncthreads();
            f32x4 o0 = (f32x4){0.f, 0.f, 0.f, 0.f}, o1 = o0;
            for (int w = 0; w < wave; ++w) { o0 += *(const LAS f32x4*)(TOT + w * 512 + 8 * lane); o1 += *(const LAS f32x4*)(TOT + w * 512 + 8 * lane + 4); }
#pragma unroll
            for (int rr = 0; rr < 8; ++rr) { const int row = ci * 64 + wave * 8 + rr;
                *(f32x4*)(CB + (size_t)row * 512 + 8 * lane) = cbv[rr][0] + o0; *(f32x4*)(CB + (size_t)row * 512 + 8 * lane + 4) = cbv[rr][1] + o1; }
            __syncthreads();
        }
    }
}

template <int KIND> struct LinCfg {
    static constexpr int DK = KIND == 0 ? 256 : 128, QP = KIND == 0 ? 1024 : 512, VP = KIND == 0 ? 2048 : 1024, HV = KIND == 0 ? 512 : 256;
    static constexpr int NSL = HV / 32, NITEM = 16 * NSL, NKF = DK / 32, RW = DK / 8, NDT = RW / 16, KPITCH = DK * 2 + 32, STP = DK + 8, KCH = DK / 64;
    static constexpr int LDS_ST = 0, LDS_K = 2 * 32 * STP * 2, LDS_P = LDS_K + 2 * 64 * KPITCH, LDS_V = LDS_P + 2 * 8192, LDS_END = LDS_V + 2 * 2 * 4096;
};
__device__ __forceinline__ float ret_log2g(int h) { return (h == 0) ? -0.045803689613124796f : (h == 1) ? -0.02272007650008353f : (h == 2) ? -0.011315313227834146f : -0.005646563141142062f; }

template <int KIND>
__device__ __forceinline__ void lin_pphase(const bf16_t* Qa, const bf16_t* Ka, const bf16_t* Qb, const bf16_t* Kb2, bf16_t* Pimg, int tid, int bid, int G) {
    typedef LinCfg<KIND> C;
    const int lane = tid & 63, wave = __builtin_amdgcn_readfirstlane(tid >> 6);
    for (int hw = bid * 8 + wave; hw < 2048; hw += G * 8) {
        const int item = hw >> 1, half = hw & 1;
        const int bh = item >> 6, n = item & 63, b = bh >> 2, h = bh & 3;
        const size_t t0 = (size_t)b * SEQ + (size_t)n * 64;
        f32x4 pa[2][4], pb[2][4];
#pragma unroll
        for (int r = 0; r < 2; ++r)
#pragma unroll
            for (int c = 0; c < 4; ++c) { pa[r][c] = (f32x4){0.f, 0.f, 0.f, 0.f}; pb[r][c] = (f32x4){0.f, 0.f, 0.f, 0.f}; }
        const bf16_t* qa = Qa + (t0 + 32 * half) * C::QP + h * C::DK; const bf16_t* ka = Ka + t0 * C::QP + h * C::DK;
        const bf16_t* qb = Qb + (t0 + 32 * half) * C::QP + h * C::DK; const bf16_t* kb = Kb2 + t0 * C::QP + h * C::DK;
#pragma unroll 2
        for (int k = 0; k < C::NKF; ++k) {
            bf16x8 af[2], bfr[4];
#pragma unroll
            for (int r = 0; r < 2; ++r) af[r] = gfrag(qa + (size_t)(16 * r) * C::QP + 32 * k, C::QP, lane);
#pragma unroll
            for (int c = 0; c < 4; ++c) bfr[c] = gfrag(ka + (size_t)(16 * c) * C::QP + 32 * k, C::QP, lane);
#pragma unroll
            for (int r = 0; r < 2; ++r)
#pragma unroll
                for (int c = 0; c < 4; ++c) pa[r][c] = mma_rc(pa[r][c], af[r], bfr[c]);
            if (KIND == 1) {
#pragma unroll
                for (int r = 0; r < 2; ++r) af[r] = gfrag(qb + (size_t)(16 * r) * C::QP + 32 * k, C::QP, lane);
#pragma unroll
                for (int c = 0; c < 4; ++c) bfr[c] = gfrag(kb + (size_t)(16 * c) * C::QP + 32 * k, C::QP, lane);
#pragma unroll
                for (int r = 0; r < 2; ++r)
#pragma unroll
                    for (int c = 0; c < 4; ++c) pb[r][c] = mma_rc(pb[r][c], af[r], bfr[c]);
            }
        }
        const int g4 = lane >> 4;
        const float l2g = (KIND == 0) ? ret_log2g(h) : 0.f;
#pragma unroll
        for (int r = 0; r < 2; ++r) {
            const int c = 32 * half + 16 * r + (lane & 15);
#pragma unroll
            for (int ct = 0; ct < 4; ++ct) {
                f32x4 p;
#pragma unroll
                for (int e = 0; e < 4; ++e) { const int mm = 16 * ct + 4 * g4 + e;
                    if (KIND == 0) { const int dd = c > mm ? c - mm : mm - c; p[e] = pa[r][ct][e] * exp2f(l2g * (float)dd); }
                    else p[e] = (c >= mm) ? pa[r][ct][e] : pb[r][ct][e]; }
                const int ks = ct >> 1, gg = 2 * (ct & 1) + (g4 & 1);
                const int off = c * 128 + (((4 * ks + gg) ^ (c & 7)) << 4) + 8 * (g4 >> 1);
                *(u32x2*)((char*)Pimg + (size_t)item * 8192 + off) = pk4(p);
            }
        }
    }
}

typedef short v4i16_t __attribute__((ext_vector_type(4)));
__device__ __forceinline__ bf16x8 trfrag2(const LAS char* p0, int second_off) {
    const v4i16_t a = __builtin_amdgcn_ds_read_tr16_b64_v4i16((LAS v4i16_t*)p0);
    const v4i16_t b = __builtin_amdgcn_ds_read_tr16_b64_v4i16((LAS v4i16_t*)(p0 + second_off));
    return (bf16x8){a[0], a[1], a[2], a[3], b[0], b[1], b[2], b[3]};
}

#ifndef STATS_ATOMIC
#define STATS_ATOMIC 0
#endif
template <int KIND> struct LsStage { bf16x8 q[LinCfg<KIND>::NKF]; u32x4 k[LinCfg<KIND>::KCH]; u32x4 p; u32x4 v; f32x4 dec; };

template <int KIND, int VAR = 0>
__device__ __forceinline__ void lin_scan(const bf16_t* Qg, const bf16_t* Kg, const bf16_t* Vg, const bf16_t* Pimg, const float* CB, bf16_t* O, float* STATS, LAS unsigned char* lds, int tid, int bid, int G) {
    typedef LinCfg<KIND> C;
    const int lane = tid & 63, wave = __builtin_amdgcn_readfirstlane(tid >> 6);
    const int g4 = lane >> 4, i16 = lane & 15, q4 = i16 >> 2, p4 = i16 & 3;
    const int nit = (G == 256) ? 1 : (C::NITEM + G - 1) / G;
    for (int it = 0; it < nit; ++it) {
        int item;
        if (G == 256) { const int x = bid & 7, j = bid >> 3; if (KIND == 0) item = x * 32 + j; else { if (j >= 16) break; item = x * 16 + j; } }
        else { item = it * G + bid; if (item >= C::NITEM) break; }
        const int bh = item / C::NSL, dvs = item % C::NSL, b = bh >> 2, h = bh & 3;
        const size_t t0 = (size_t)b * SEQ;
        const int rt = wave & 3; const bool rdw = wave < 4;
        const float l2g = (KIND == 0) ? ret_log2g(h) : 0.f;
        const float qsc = (KIND == 0) ? exp2f(l2g * (float)(16 * rt + i16 + 1)) : 1.0f;
        const float sdec = (KIND == 0) ? exp2f(l2g * 64.0f) : 1.0f;
        const int vm = (tid >> 2) & 63, vpart = tid & 3;
        const float vsc = (KIND == 0) ? exp2f(l2g * (float)(63 - vm)) : 1.0f;
        const bool vthread = tid < 256;
        const bf16_t* qbase = Qg + (t0 + 16 * rt + i16) * C::QP + h * C::DK + 8 * g4;
        const bf16_t* vbase = Vg + (t0 + vm) * C::VP + h * C::HV + 32 * dvs + 8 * vpart;
        const bf16_t* pbase = Pimg + ((size_t)bh * 64) * 4096 + (size_t)tid * 8;
        LAS bf16_t* ST = (LAS bf16_t*)(lds + C::LDS_ST);
        LAS char* KI = (LAS char*)(lds + C::LDS_K);
        LAS char* PI = (LAS char*)(lds + C::LDS_P);
        LAS char* VI = (LAS char*)(lds + C::LDS_V);
        const int trow = 16 * (g4 >> 1) + 4 * (g4 & 1) + q4;
        const int koff = trow * C::KPITCH + (C::RW * wave + 4 * p4) * 2;
        const int voff = trow * 32 + 8 * p4;
        const int poff_row = (16 * rt + i16) * 128, psw = (16 * rt + i16) & 7;

        LsStage<KIND> A, B;
#define LS_LOAD(S, nn) do { const int n_ = (nn) < 64 ? (nn) : 63; \
            if (rdw && !((VAR & 1) && (nn) >= 2)) { _Pragma("unroll") for (int k_ = 0; k_ < C::NKF; ++k_) S.q[k_] = (VAR & 32) ? *(const bf16x8*)(Qg + (t0 + (size_t)n_ * 64 + 16 * rt + 2 * k_ + (lane >> 5)) * C::QP + h * C::DK + 8 * (lane & 31)) : *(const bf16x8*)(qbase + (size_t)n_ * 64 * C::QP + 32 * k_); } \
            if (!((VAR & 2) && (nn) >= 2)) _Pragma("unroll") for (int i_ = 0; i_ < C::KCH; ++i_) { const int id_ = tid + 512 * i_, tk_ = id_ / (C::DK / 8), ch_ = id_ % (C::DK / 8); \
                S.k[i_] = *(const u32x4*)(Kg + (t0 + (size_t)n_ * 64 + tk_) * C::QP + h * C::DK + 8 * ch_); } \
            S.p = *(const u32x4*)(pbase + (size_t)n_ * 4096); \
            if (vthread) S.v = *(const u32x4*)(vbase + (size_t)n_ * 64 * C::VP); \
            if (KIND == 1) S.dec = *(const f32x4*)(CB + (t0 + (size_t)n_ * 64 + 63) * 512 + h * 128 + 16 * wave + 4 * g4); } while (0)
#define LS_WRITE(S, img) do { \
            if (!(VAR & 8)) _Pragma("unroll") for (int i_ = 0; i_ < C::KCH; ++i_) { const int id_ = tid + 512 * i_, tk_ = id_ / (C::DK / 8), ch_ = id_ % (C::DK / 8); \
                *(LAS u32x4*)(KI + (img) * 64 * C::KPITCH + tk_ * C::KPITCH + ch_ * 16) = S.k[i_]; } \
            *(LAS u32x4*)(PI + (img) * 8192 + tid * 16) = S.p; \
            if (vthread) { LAS char* vd_ = VI + (img) * 8192 + (vpart >> 1) * 2048 + vm * 32 + (vpart & 1) * 16; *(LAS u32x4*)vd_ = S.v; \
                if (KIND == 0) { u32x4 w_; _Pragma("unroll") for (int j_ = 0; j_ < 4; ++j_) w_[j_] = pk2(bf2f(S.v[j_] & 0xffffu) * vsc, bf2f(S.v[j_] >> 16) * vsc); *(LAS u32x4*)(vd_ + 4096) = w_; } } } while (0)

        for (int i = tid; i < 32 * C::STP / 2; i += 512) ((LAS unsigned*)ST)[i] = 0u;
        f32x4 s[C::NDT][2];
#pragma unroll
        for (int a = 0; a < C::NDT; ++a)
#pragma unroll
            for (int e = 0; e < 2; ++e) s[a][e] = (f32x4){0.f, 0.f, 0.f, 0.f};
        LS_LOAD(A, 0); LS_LOAD(B, 1);
        LS_WRITE(A, 0);
        __syncthreads();

#define LS_STEP(n, SC, SN) do { const int img_ = (n) & 1; \
            const f32x4 dcur_ = SC.dec; \
              \
            if (rdw && !(VAR & 16)) { \
                const LAS bf16_t* STc_ = ST + img_ * 32 * C::STP; \
                const size_t row_ = t0 + (size_t)(n) * 64 + 16 * rt + i16; \
                  \
                _Pragma("unroll") for (int ct_ = 0; ct_ < 2; ++ct_) { \
                    constexpr int HB_ = C::NKF / 2; bf16x8 sb_[HB_], pf_[2], vf_[2]; \
                    f32x4 o0_ = (f32x4){0.f, 0.f, 0.f, 0.f}, o1_ = o0_; \
                    _Pragma("unroll") for (int k_ = 0; k_ < HB_; ++k_) sb_[k_] = lfrag(STc_ + 16 * ct_ * C::STP + 32 * k_, C::STP, lane); \
                    __builtin_amdgcn_sched_barrier(0); \
                    _Pragma("unroll") for (int k_ = 0; k_ < HB_; k_ += 2) { o0_ = mma_rc(o0_, SC.q[k_], sb_[k_]); o1_ = mma_rc(o1_, SC.q[k_ + 1], sb_[k_ + 1]); } \
                    __builtin_amdgcn_sched_barrier(0); \
                    _Pragma("unroll") for (int k_ = 0; k_ < HB_; ++k_) sb_[k_] = lfrag(STc_ + 16 * ct_ * C::STP + 32 * (HB_ + k_), C::STP, lane); \
                    _Pragma("unroll") for (int ks_ = 0; ks_ < 2; ++ks_) { \
                        pf_[ks_] = *(const LAS bf16x8*)(PI + img_ * 8192 + poff_row + (((4 * ks_ + g4) ^ psw) << 4)); \
                        vf_[ks_] = trfrag2(VI + img_ * 8192 + ct_ * 2048 + ks_ * 1024 + voff, 256); } \
                    __builtin_amdgcn_sched_barrier(0); \
                    _Pragma("unroll") for (int k_ = 0; k_ < HB_; k_ += 2) { o0_ = mma_rc(o0_, SC.q[HB_ + k_], sb_[k_]); o1_ = mma_rc(o1_, SC.q[HB_ + k_ + 1], sb_[k_ + 1]); } \
                    f32x4 oa_ = (o0_ + o1_) * qsc; \
                    _Pragma("unroll") for (int ks_ = 0; ks_ < 2; ++ks_) oa_ = mma_rc(oa_, pf_[ks_], vf_[ks_]); \
                    *(u32x2*)(O + row_ * C::VP + h * C::HV + 32 * dvs + 16 * ct_ + 4 * g4) = pk4(oa_); \
                    __builtin_amdgcn_sched_barrier(0); } } \
              \
            LS_LOAD(SC, (n) + 2); \
              \
            if (KIND == 0) { _Pragma("unroll") for (int a_ = 0; a_ < C::NDT; ++a_) _Pragma("unroll") for (int e_ = 0; e_ < 2; ++e_) s[a_][e_] = s[a_][e_] * sdec; } \
            if (!(VAR & 4)) _Pragma("unroll") for (int ks_ = 0; ks_ < 2; ++ks_) { bf16x8 kf_[C::NDT], vf_[2]; \
                _Pragma("unroll") for (int a_ = 0; a_ < C::NDT; ++a_) kf_[a_] = trfrag2(KI + img_ * 64 * C::KPITCH + ks_ * 32 * C::KPITCH + a_ * 32 + koff, 8 * C::KPITCH); \
                _Pragma("unroll") for (int e_ = 0; e_ < 2; ++e_) vf_[e_] = trfrag2(VI + img_ * 8192 + (KIND == 0 ? 4096 : 0) + e_ * 2048 + ks_ * 1024 + voff, 256); \
                _Pragma("unroll") for (int a_ = 0; a_ < C::NDT; ++a_) _Pragma("unroll") for (int e_ = 0; e_ < 2; ++e_) s[a_][e_] = mma_cr(s[a_][e_], kf_[a_], vf_[e_]); } \
            if (KIND == 1) { f32x4 dc_; _Pragma("unroll") for (int r_ = 0; r_ < 4; ++r_) dc_[r_] = __expf(dcur_[r_]); \
                _Pragma("unroll") for (int e_ = 0; e_ < 2; ++e_) s[0][e_] = s[0][e_] * dc_; } \
              \
            { LAS bf16_t* STn_ = ST + (img_ ^ 1) * 32 * C::STP; \
              _Pragma("unroll") for (int a_ = 0; a_ < C::NDT; ++a_) _Pragma("unroll") for (int e_ = 0; e_ < 2; ++e_) \
                  *(LAS u32x2*)(STn_ + (16 * e_ + i16) * C::STP + C::RW * wave + 16 * a_ + 4 * g4) = pk4(s[a_][e_]); } \
              \
            LS_WRITE(SN, img_ ^ 1); \
            asm volatile("s_waitcnt lgkmcnt(0)" ::: "memory"); __builtin_amdgcn_s_barrier(); asm volatile("" ::: "memory"); } while (0)

        for (int n = 0; n < 64; n += 2) { LS_STEP(n, A, B); LS_STEP(n + 1, B, A); }
#undef LS_LOAD
#undef LS_WRITE
#undef LS_STEP
    }
}


template <int KIND>
__device__ __forceinline__ void lin_stats(const bf16_t* O, float* STATS, int tid, int bid, int G) {
    const int lane = tid & 63, wave = tid >> 6;
    const int gw = bid * 8 + wave, NGW = G * 8;
    constexpr int NJ = KIND == 0 ? 4 : 2, PITCH = KIND == 0 ? 2048 : 1024, RB = 4;
    for (int row0 = gw; row0 < MT; row0 += RB * NGW) {
        u32x4 w[RB][NJ];
#pragma unroll
        for (int rb = 0; rb < RB; ++rb) { const int row = row0 + rb * NGW < MT ? row0 + rb * NGW : row0;
#pragma unroll
            for (int j = 0; j < NJ; ++j) w[rb][j] = *(const u32x4*)(O + (size_t)row * PITCH + 512 * j + 8 * lane); }
#pragma unroll
        for (int rb = 0; rb < RB; ++rb) { const int row = row0 + rb * NGW; if (row >= MT) break;
#pragma unroll
            for (int j = 0; j < NJ; ++j) {
                float sm = 0.f, sq = 0.f;
#pragma unroll
                for (int i = 0; i < 4; ++i) { const float a = bf2f(w[rb][j][i] & 0xffffu), b = bf2f(w[rb][j][i] >> 16); sm += a + b; sq += a * a + b * b; }
                if (KIND == 0) { sm = wave_sum(sm); sq = wave_sum(sq); if (lane == 0) *(f32x2*)(STATS + (size_t)row * 8 + 2 * j) = (f32x2){sm, sq}; }
                else {
#pragma unroll
                    for (int o = 1; o < 32; o <<= 1) sq += __shfl_xor(sq, o);
                    if ((lane & 31) == 0) *(f32x2*)(STATS + (size_t)row * 8 + 2 * (2 * j + (lane >> 5))) = (f32x2){0.f, sq}; }
            }
        }
    }
}

template <int KIND> struct EpiGateNorm {
    static constexpr bool PERM = false;
    bf16_t* O; const float* STATS; LAS float* tbl;
    __device__ __forceinline__ void operator()(const f32x4 (&acc)[2][2][4][2], const pg8::Unit& u, int wr, int wc, int fr, int fq) const {
        constexpr int N = KIND == 0 ? 2048 : 1024; constexpr float INV = KIND == 0 ? 1.0f / 512.0f : 1.0f / 256.0f;
        const int head = KIND == 0 ? (u.pn >> 1) : u.pn;
        if (KIND == 0) {
            if ((u.pn & 1) == 0) {
                LAS f32x2* tb2 = (LAS f32x2*)tbl;
#pragma unroll
                for (int ai = 0; ai < 2; ++ai)
#pragma unroll
                    for (int m = 0; m < 4; ++m) { const int rl = ai * 128 + wr * 64 + m * 16 + fr; const int row = u.pm * 256 + rl; float sm = 0.f, sq = 0.f;
                        const bf16_t* prow = O + (size_t)row * N + u.pn * 256 + wc * 32 + fq * 4;
#pragma unroll
                        for (int tt = 0; tt < 2; ++tt) {
                            const u32x2 w0 = *(const u32x2*)(prow + tt * 256), w1 = *(const u32x2*)(prow + tt * 256 + 16), w2 = *(const u32x2*)(prow + tt * 256 + 128), w3 = *(const u32x2*)(prow + tt * 256 + 144);
                            const f32x4 o0 = unpk4(w0), o1 = unpk4(w1), o2 = unpk4(w2), o3 = unpk4(w3);
                            const f32x4 ss = (o0 + o1) + (o2 + o3), qq = (o0 * o0 + o1 * o1) + (o2 * o2 + o3 * o3);
                            sm += (ss[0] + ss[1]) + (ss[2] + ss[3]); sq += (qq[0] + qq[1]) + (qq[2] + qq[3]);
                            asm volatile("" ::: "memory"); }
                        sm = xsum_16_32(sm); sq = xsum_16_32(sq);
                        if (fq == 0) tb2[rl * 4 + wc] = (f32x2){sm, sq};
                        asm volatile("" ::: "memory"); }
                asm volatile("s_waitcnt lgkmcnt(0)" ::: "memory"); __builtin_amdgcn_s_barrier(); asm volatile("" ::: "memory");
            }
#pragma unroll
            for (int ai = 0; ai < 2; ++ai)
#pragma unroll
            for (int mh = 0; mh < 2; ++mh) {
                u32x2 ov[2][2][2];
#pragma unroll
                for (int mm = 0; mm < 2; ++mm) { const int row = u.pm * 256 + ai * 128 + wr * 64 + (2 * mh + mm) * 16 + fr;
#pragma unroll
                    for (int bj = 0; bj < 2; ++bj)
#pragma unroll
                        for (int n = 0; n < 2; ++n) ov[mm][bj][n] = *(const u32x2*)(O + (size_t)row * N + u.pn * 256 + bj * 128 + wc * 32 + n * 16 + fq * 4); }
                asm volatile("" ::: "memory");
#pragma unroll
                for (int mm = 0; mm < 2; ++mm) { const int m = 2 * mh + mm; const int rl = ai * 128 + wr * 64 + m * 16 + fr; const int row = u.pm * 256 + rl;
                    const LAS f32x2* tb2 = (const LAS f32x2*)tbl + rl * 4;
                    const f32x2 p0 = tb2[0], p1 = tb2[1], p2 = tb2[2], p3 = tb2[3];
                    const float mean = ((p0.x + p1.x) + (p2.x + p3.x)) * INV, rstd = __builtin_amdgcn_rsqf(fmaxf(((p0.y + p1.y) + (p2.y + p3.y)) * INV - mean * mean, 0.f) + EPS);
#pragma unroll
                    for (int bj = 0; bj < 2; ++bj)
#pragma unroll
                        for (int n = 0; n < 2; ++n) {
                            const f32x4 o = unpk4(ov[mm][bj][n]), a = acc[ai][bj][m][n]; f32x4 r;
#pragma unroll
                            for (int j = 0; j < 4; ++j) r[j] = (o[j] - mean) * rstd * silu_f(a[j]);
                            *(u32x2*)(O + (size_t)row * N + u.pn * 256 + bj * 128 + wc * 32 + n * 16 + fq * 4) = pk4(r);
                        }
                }
                asm volatile("" ::: "memory");
            }
        } else {
#pragma unroll
            for (int ai = 0; ai < 2; ++ai)
#pragma unroll
                for (int m = 0; m < 4; ++m) { const int rl = ai * 128 + wr * 64 + m * 16 + fr; const int row = u.pm * 256 + rl; float sq = 0.f;
#pragma unroll
                    for (int bj = 0; bj < 2; ++bj)
#pragma unroll
                        for (int n = 0; n < 2; ++n) { const f32x4 o = unpk4(*(const u32x2*)(O + (size_t)row * N + u.pn * 256 + bj * 128 + wc * 32 + n * 16 + fq * 4)); sq += (o[0] * o[0] + o[1] * o[1]) + (o[2] * o[2] + o[3] * o[3]); }
                    sq = xsum_16_32(sq);
                    if (fq == 0) tbl[rl * 4 + wc] = sq; }
            asm volatile("s_waitcnt lgkmcnt(0)" ::: "memory"); __builtin_amdgcn_s_barrier(); asm volatile("" ::: "memory");
#pragma unroll
            for (int ai = 0; ai < 2; ++ai) {
                u32x2 ov[4][2][2];
#pragma unroll
                for (int m = 0; m < 4; ++m) { const int row = u.pm * 256 + ai * 128 + wr * 64 + m * 16 + fr;
#pragma unroll
                    for (int bj = 0; bj < 2; ++bj)
#pragma unroll
                        for (int n = 0; n < 2; ++n) ov[m][bj][n] = *(const u32x2*)(O + (size_t)row * N + u.pn * 256 + bj * 128 + wc * 32 + n * 16 + fq * 4); }
                asm volatile("" ::: "memory");
#pragma unroll
                for (int m = 0; m < 4; ++m) { const int rl = ai * 128 + wr * 64 + m * 16 + fr; const int row = u.pm * 256 + rl;
                    const f32x4 pr = *(const LAS f32x4*)(tbl + rl * 4);
                    const float rstd = __builtin_amdgcn_rsqf(((pr[0] + pr[1]) + (pr[2] + pr[3])) * INV + EPS);
#pragma unroll
                    for (int bj = 0; bj < 2; ++bj)
#pragma unroll
                        for (int n = 0; n < 2; ++n) {
                            const f32x4 o = unpk4(ov[m][bj][n]), a = acc[ai][bj][m][n]; f32x4 r;
#pragma unroll
                            for (int j = 0; j < 4; ++j) r[j] = o[j] * rstd * silu_f(a[j]);
                            *(u32x2*)(O + (size_t)row * N + u.pn * 256 + bj * 128 + wc * 32 + n * 16 + fq * 4) = pk4(r);
                        }
                }
                asm volatile("" ::: "memory");
            }
        }
    }
};

namespace attn_body {
using bf16=unsigned short;
using bf16x8=__attribute__((ext_vector_type(8)))short;
using s16x4=__attribute__((ext_vector_type(4)))short;
using f32x16=__attribute__((ext_vector_type(16)))float;
using u32x4=__attribute__((ext_vector_type(4)))unsigned;
constexpr int BATCH=4,NHEAD=16,SEQ=4096,D=64,DM=NHEAD*D;
constexpr int NW=8,QBLK=32,QB=QBLK*NW,KVBLK=64,NQB=SEQ/QB;
constexpr int ATTN_PITCH=DM, ATTN_UNIT_ROWS=QB;
__device__ __forceinline__ int crow(int r,int hi){return (r&3)+8*(r>>2)+4*hi;}
#define SBAR() __builtin_amdgcn_sched_barrier(0)
__device__ __forceinline__ void cmask(f32x16&p0,f32x16&p1,int jb,int qrel,int hi){
  const float NEG=-INFINITY; int kb=64*jb+4*hi;
  #pragma unroll
  for(int r=0;r<16;++r){int kv=kb+(r&3)+8*(r>>2); if(kv>qrel)p0[r]=NEG; if(kv+32>qrel)p1[r]=NEG;}
}

constexpr int NSLOT=3, SLOTB=8192;
constexpr int LDS_K=0, LDS_V=NSLOT*SLOTB, LDS_WS=2*NSLOT*SLOTB, LDS_OST=LDS_WS+NW*64*4, LDS_NC=LDS_OST+NW*4096, LDS_FT=LDS_NC+SEQ*4, LDS_RE=LDS_FT+256, LDS_BYTES=LDS_RE+256;
constexpr float C2=0.125f*1.4426950408889634f;
__device__ __forceinline__ void glds16(const void*gsrc,unsigned lds_dst){unsigned keep;
  asm volatile("s_mov_b32 %0, m0\n\ts_mov_b32 m0, %2\n\ts_nop 0\n\tglobal_load_lds_dwordx4 %1, off\n\ts_mov_b32 m0, %0":"=&s"(keep):"v"(gsrc),"s"(lds_dst):"memory");}
__device__ __forceinline__ float max3f(float a,float b,float c){float r;asm("v_max3_f32 %0, %1, %2, %3":"=v"(r):"v"(a),"v"(b),"v"(c));return r;}
__device__ __forceinline__ float max2f(float a,float b){float r;asm("v_max_f32_e32 %0, %1, %2":"=v"(r):"v"(a),"v"(b));return r;}
__device__ __forceinline__ float fadd_s(float a,float b){float r;asm("v_add_f32_e32 %0, %1, %2":"=v"(r):"v"(a),"v"(b));return r;}
__device__ __forceinline__ float fsub_s(float a,float b){float r;asm("v_sub_f32_e32 %0, %1, %2":"=v"(r):"v"(a),"v"(b));return r;}
typedef float f32x2_t __attribute__((ext_vector_type(2))); typedef __bf16 bf16x2_t __attribute__((ext_vector_type(2)));
__device__ __forceinline__ unsigned cvtpk_s(float lo,float hi){f32x2_t v={lo,hi};bf16x2_t b=__builtin_convertvector(v,bf16x2_t);return __builtin_bit_cast(unsigned,b);}
#define WAIT_BAR(N) asm volatile("s_waitcnt vmcnt(" #N ") lgkmcnt(0)\n\ts_barrier":::"memory")

__device__ __forceinline__ void qkt(f32x16&p0,f32x16&p1,const char*Kslot,const bf16x8*qr,const f32x16&negm,int r32,int hi){
  const char*kb=Kslot+hi*1024+r32*16;
  #pragma unroll
  for(int d0=0;d0<4;++d0){
    const bf16x8 b0=*reinterpret_cast<const bf16x8*>(kb+d0*2048);
    const bf16x8 b1=*reinterpret_cast<const bf16x8*>(kb+d0*2048+512);
    if(d0==0){p0=__builtin_amdgcn_mfma_f32_32x32x16_bf16(b0,qr[0],negm,0,0,0);p1=__builtin_amdgcn_mfma_f32_32x32x16_bf16(b1,qr[0],negm,0,0,0);}
    else{p0=__builtin_amdgcn_mfma_f32_32x32x16_bf16(b0,qr[d0],p0,0,0,0);p1=__builtin_amdgcn_mfma_f32_32x32x16_bf16(b1,qr[d0],p1,0,0,0);}}
}
typedef __attribute__((address_space(3))) const char* lds_cptr;
typedef short v4i16_t __attribute__((ext_vector_type(4)));
__device__ __forceinline__ void kload8(bf16x8*kf,lds_cptr kp){
  kf[0]=*(const __attribute__((address_space(3))) bf16x8*)(kp);      kf[1]=*(const __attribute__((address_space(3))) bf16x8*)(kp+512);
  kf[2]=*(const __attribute__((address_space(3))) bf16x8*)(kp+2048); kf[3]=*(const __attribute__((address_space(3))) bf16x8*)(kp+2560);
  kf[4]=*(const __attribute__((address_space(3))) bf16x8*)(kp+4096); kf[5]=*(const __attribute__((address_space(3))) bf16x8*)(kp+4608);
  kf[6]=*(const __attribute__((address_space(3))) bf16x8*)(kp+6144); kf[7]=*(const __attribute__((address_space(3))) bf16x8*)(kp+6656);
}
__device__ __forceinline__ void kload2(bf16x8*kf,lds_cptr kp,int j){ kf[2*j]=*(const __attribute__((address_space(3))) bf16x8*)(kp+j*2048); kf[2*j+1]=*(const __attribute__((address_space(3))) bf16x8*)(kp+j*2048+512); }
__device__ __forceinline__ s16x4 vtr(lds_cptr p){ return __builtin_bit_cast(s16x4,__builtin_amdgcn_ds_read_tr16_b64_v4i16((__attribute__((address_space(3))) v4i16_t*)p)); }
__device__ __forceinline__ float rowmax(const f32x16&p0,const f32x16&p1){
  float a=max3f(p0[0],p0[1],p1[0]),b=max3f(p0[2],p0[3],p1[1]);a=max3f(a,p1[2],p1[3]);
  #pragma unroll
  for(int r=4;r<16;r+=4){a=max3f(a,p0[r],p0[r+1]);b=max3f(b,p0[r+2],p0[r+3]);a=max3f(a,p1[r],p1[r+1]);b=max3f(b,p1[r+2],p1[r+3]);}
  const float m=max2f(a,b);
  auto rr=__builtin_amdgcn_permlane32_swap(__float_as_uint(m),__float_as_uint(m),false,false);
  return max2f(__uint_as_float(rr[0]),__uint_as_float(rr[1]));
}
__device__ __forceinline__ void pv(f32x16*o,int vb,bf16x8 pa0,bf16x8 pa1,bf16x8 pa2,bf16x8 pa3){
  #pragma unroll
  for(int d0=0;d0<2;++d0){s16x4 lo[4],hi[4];
    #pragma unroll
    for(int ks=0;ks<4;++ks){
      asm volatile("ds_read_b64_tr_b16 %0,%1 offset:%c2":"=&v"(lo[ks]):"v"(vb),"i"(d0*4096+ks*1024):"memory");
      asm volatile("ds_read_b64_tr_b16 %0,%1 offset:%c2":"=&v"(hi[ks]):"v"(vb),"i"(d0*4096+ks*1024+512):"memory");}
    asm volatile("s_waitcnt lgkmcnt(0)":::"memory");SBAR();
    #define PK(k) (bf16x8){lo[k][0],lo[k][1],lo[k][2],lo[k][3],hi[k][0],hi[k][1],hi[k][2],hi[k][3]}
    o[d0]=__builtin_amdgcn_mfma_f32_32x32x16_bf16(pa0,PK(0),o[d0],0,0,0);
    o[d0]=__builtin_amdgcn_mfma_f32_32x32x16_bf16(pa1,PK(1),o[d0],0,0,0);
    o[d0]=__builtin_amdgcn_mfma_f32_32x32x16_bf16(pa2,PK(2),o[d0],0,0,0);
    o[d0]=__builtin_amdgcn_mfma_f32_32x32x16_bf16(pa3,PK(3),o[d0],0,0,0);
    #undef PK
  }
}

#ifndef ATTN_STORE16
#define ATTN_STORE16(p,v) (*(u32x4*)(p)=(v))
#endif
template<int THRL> __device__ __forceinline__ void attn_unit(int b,int h,int qb,int ts,const bf16*Q,const bf16*__restrict__ K,const bf16*__restrict__ V,const bf16*__restrict__ Gt,bf16*O,char*shm,int tid){
  const int lane=tid&63,r32=lane&31,hi=lane>>5; const int wid=__builtin_amdgcn_readfirstlane(tid>>6);
  const long rowbase=(long)b*SEQ; const int q0=qb*QB;
  typedef __attribute__((address_space(3))) const float* lds_fptr; typedef float f32x4b __attribute__((ext_vector_type(4)));
  const lds_fptr ncum=(lds_fptr)((__attribute__((address_space(3))) const char*)shm+LDS_NC)+64*ts+4*hi;
  const lds_fptr ftp=(lds_fptr)((__attribute__((address_space(3))) const char*)shm+LDS_FT)+ts;
  const bf16*Qw=Q+(rowbase+q0+wid*QBLK)*DM+h*D;
  const bf16*Kh=K+(rowbase+(long)ts*KVBLK)*DM+h*D,*Vh=V+(rowbase+(long)ts*KVBLK)*DM+h*D;
  const unsigned lds0=(unsigned)(uintptr_t)shm;
  float*wsf=(float*)(shm+LDS_WS)+wid*64;
  const bf16*ksrc=Kh+(long)lane*DM+wid*8;
  const bf16*vsrc=Vh+(long)(16*(wid&3)+(lane>>2))*DM+(wid>>2)*32+(lane&3)*8;
  const unsigned kdst=lds0+LDS_K+wid*1024, vdst=lds0+LDS_V+wid*1024;
  #define DMA_K(t,slot) glds16(ksrc+(long)(t)*KVBLK*DM,(unsigned)__builtin_amdgcn_readfirstlane(kdst+(slot)))
  #define DMA_V(t,slot) glds16(vsrc+(long)(t)*KVBLK*DM,(unsigned)__builtin_amdgcn_readfirstlane(vdst+(slot)))
  const int vb0=(int)(lds0+LDS_V)+((lane>>4)&1)*32+(lane&3)*8+(4*hi+((lane&15)>>2))*64;
  const char*Kbase=shm+LDS_K; bf16x8 kf[8];
  const lds_cptr shm3=(lds_cptr)shm; const lds_cptr kp0=shm3+LDS_K+hi*1024+r32*16; const lds_cptr vp0=shm3+LDS_V+((lane>>4)&1)*32+(lane&3)*8+(4*hi+((lane&15)>>2))*64;
  const int NT=(q0+QB)/KVBLK-ts;
  DMA_K(0,0);DMA_V(0,0);DMA_K(1,SLOTB);
  bf16x8 qr[4];
  #pragma unroll
  for(int d0=0;d0<4;++d0)qr[d0]=*reinterpret_cast<const bf16x8*>(&Qw[(long)r32*DM+d0*16+hi*8]);
  float l_reg=0.f,fcur=1.f;f32x16 o[2];o[0]=f32x16{};o[1]=f32x16{};const f32x16 negm=f32x16{};
  const int qrel=wid*QBLK+r32;
  #define CMASK(P0,P1,t) do{int jb_=(t)-(NT-4); if(jb_>=0)cmask(P0,P1,jb_,qrel,hi);}while(0)
  #define LDSF4(p) (*(const __attribute__((address_space(3))) f32x4b*)(p))
  #define BIAS(P0,P1,t) do{ const lds_fptr nb_=ncum+64*(t); \
      { const f32x4b a0_=LDSF4(nb_), a1_=LDSF4(nb_+8), a2_=LDSF4(nb_+16), a3_=LDSF4(nb_+24); \
        _Pragma("unroll") for(int j_=0;j_<4;++j_){ P0[j_]+=a0_[j_]; P0[4+j_]+=a1_[j_]; P0[8+j_]+=a2_[j_]; P0[12+j_]+=a3_[j_]; } } SBAR(); \
      { const f32x4b b0_=LDSF4(nb_+32), b1_=LDSF4(nb_+40), b2_=LDSF4(nb_+48), b3_=LDSF4(nb_+56); \
        _Pragma("unroll") for(int j_=0;j_<4;++j_){ P1[j_]+=b0_[j_]; P1[4+j_]+=b1_[j_]; P1[8+j_]+=b2_[j_]; P1[12+j_]+=b3_[j_]; } } SBAR(); }while(0)
  #define START(P0,P1) do{ _Pragma("unroll") for(int r=0;r<16;++r)P0[r]=__builtin_amdgcn_exp2f(P0[r]); }while(0)
  #define RESC() do{ _Pragma("unroll") for(int d_=0;d_<2;++d_) _Pragma("unroll") for(int r=0;r<16;++r)o[d_][r]*=fcur; }while(0)
  f32x16 pA0,pA1,pB0,pB1;
  int sl_prev=0,sl_cur=0,sl_next=SLOTB;
  #define ROT() do{sl_prev=sl_cur;sl_cur=sl_next;sl_next=(sl_next==(NSLOT-1)*SLOTB)?0:sl_next+SLOTB;}while(0)
  DMA_K(2,2*SLOTB);
  WAIT_BAR(3);
  qkt(pA0,pA1,Kbase,qr,negm,r32,hi);asm volatile("s_nop 15\n\ts_nop 7":"+v"(pA0),"+v"(pA1));BIAS(pA0,pA1,0);CMASK(pA0,pA1,0);
  START(pA0,pA1);
  _Pragma("unroll") for(int r=0;r<16;++r)pA1[r]=__builtin_amdgcn_exp2f(pA1[r]);
  WAIT_BAR(0);
  DMA_K(3,0);DMA_V(1,SLOTB);
  ROT();
  kload8(kf,kp0+sl_cur);
  WAIT_BAR(2);
  s16x4 vlo[8],vhi[8]; u32x4 pw0,pw1,pw2,pw3;
  #define PKW(P,B) cvtpk_s(P[B],P[B+1])
  #define PAF(k) __builtin_bit_cast(bf16x8,pw##k)
  #define VFR(i) (bf16x8){vlo[i][0],vlo[i][1],vlo[i][2],vlo[i][3],vhi[i][0],vhi[i][1],vhi[i][2],vhi[i][3]}
  #define PIN(x) asm volatile("":"+v"(x))
  #define MX3(a,b,c) __builtin_fmaxf(__builtin_fmaxf((a),(b)),(c))
  #define GAPA(MF,A0,A1,A2,A3,W0,W1,PW) do{ MF; sacc+=A0; sacc+=A1; sacc+=A2; sacc+=A3; PIN(sacc); W0; W1; PIN(PW); SBAR(); }while(0)
  #define EX(v) __builtin_amdgcn_exp2f(v)
  #define GAPB(MF,X,B) do{ MF; X[B]=EX(X[B]); X[B+1]=EX(X[B+1]); X[B+2]=EX(X[B+2]); X[B+3]=EX(X[B+3]); PIN(X); SBAR(); }while(0)
  #define VRD(i) do{ vlo[i]=vtr(vp_+(((i)>>2)*4096+((i)&3)*1024)); vhi[i]=vtr(vp_+(((i)>>2)*4096+((i)&3)*1024+512)); }while(0)
  #define KRD(G,j) do{ if(G){ kload2(kf,kp0+sl_next,j); SBAR(); } }while(0)
  #define STEP(C0,C1,P0,P1,t,GK,GV,GL) do{ SBAR(); \
    const lds_cptr vp_=vp0+sl_prev; \
    VRD(0); SBAR(); float sacc=(P0[0]+P0[1]); \
    GAPA(C0=__builtin_amdgcn_mfma_f32_32x32x16_bf16(kf[0],qr[0],negm,0,0,0), P0[2],P0[3],P0[4],P0[5],     pw0[0]=PKW(P0,0), pw0[1]=PKW(P0,2), pw0); \
    VRD(4); SBAR(); GAPA(C1=__builtin_amdgcn_mfma_f32_32x32x16_bf16(kf[1],qr[0],negm,0,0,0), P0[6],P0[7],P0[8],P0[9],     pw0[2]=PKW(P0,4), pw0[3]=PKW(P0,6), pw0); \
    VRD(1); SBAR(); GAPA(C0=__builtin_amdgcn_mfma_f32_32x32x16_bf16(kf[2],qr[1],C0,0,0,0),   P0[10],P0[11],P0[12],P0[13], pw1[0]=PKW(P0,8), pw1[1]=PKW(P0,10), pw1); \
    VRD(5); SBAR(); GAPA(C1=__builtin_amdgcn_mfma_f32_32x32x16_bf16(kf[3],qr[1],C1,0,0,0),   P0[14],P0[15],P1[0],P1[1],   pw1[2]=PKW(P0,12),pw1[3]=PKW(P0,14), pw1); \
    VRD(2); SBAR(); GAPA(C0=__builtin_amdgcn_mfma_f32_32x32x16_bf16(kf[4],qr[2],C0,0,0,0),   P1[2],P1[3],P1[4],P1[5],     pw2[0]=PKW(P1,0), pw2[1]=PKW(P1,2), pw2); \
    VRD(6); SBAR(); GAPA(C1=__builtin_amdgcn_mfma_f32_32x32x16_bf16(kf[5],qr[2],C1,0,0,0),   P1[6],P1[7],P1[8],P1[9],     pw2[2]=PKW(P1,4), pw2[3]=PKW(P1,6), pw2); \
    VRD(3); SBAR(); GAPA(C0=__builtin_amdgcn_mfma_f32_32x32x16_bf16(kf[6],qr[3],C0,0,0,0),   P1[10],P1[11],P1[12],P1[13], pw3[0]=PKW(P1,8), pw3[1]=PKW(P1,10), pw3); \
    VRD(7); SBAR(); GAPA(C1=__builtin_amdgcn_mfma_f32_32x32x16_bf16(kf[7],qr[3],C1,0,0,0),   P1[14],P1[15],0.f,0.f,       pw3[2]=PKW(P1,12),pw3[3]=PKW(P1,14), pw3); \
    l_reg+=sacc; \
    if(GK){DMA_K((t)+3,sl_cur);} if(GV){DMA_V((t)+1,sl_next);} \
    BIAS(C0,C1,t); CMASK(C0,C1,t); \
    { const int jb2_=2*((t)-(NT-4)); fcur=(jb2_>wid)?1.0f:ftp[(t)]; l_reg*=fcur; } \
    SBAR(); \
    GAPB(o[0]=__builtin_amdgcn_mfma_f32_32x32x16_bf16(PAF(0),VFR(0),o[0],0,0,0), C0,0); \
    GAPB(o[1]=__builtin_amdgcn_mfma_f32_32x32x16_bf16(PAF(0),VFR(4),o[1],0,0,0), C0,4); \
    KRD(GL,0); GAPB(o[0]=__builtin_amdgcn_mfma_f32_32x32x16_bf16(PAF(1),VFR(1),o[0],0,0,0), C0,8); \
    KRD(GL,1); GAPB(o[1]=__builtin_amdgcn_mfma_f32_32x32x16_bf16(PAF(1),VFR(5),o[1],0,0,0), C0,12); \
    KRD(GL,2); GAPB(o[0]=__builtin_amdgcn_mfma_f32_32x32x16_bf16(PAF(2),VFR(2),o[0],0,0,0), C1,0); \
    KRD(GL,3); GAPB(o[1]=__builtin_amdgcn_mfma_f32_32x32x16_bf16(PAF(2),VFR(6),o[1],0,0,0), C1,4); \
    GAPB(o[0]=__builtin_amdgcn_mfma_f32_32x32x16_bf16(PAF(3),VFR(3),o[0],0,0,0), C1,8); \
    GAPB(o[1]=__builtin_amdgcn_mfma_f32_32x32x16_bf16(PAF(3),VFR(7),o[1],0,0,0), C1,12); \
    }while(0)
  int t=1;
  #undef CMASK
  #define CMASK(P0,P1,t) do{}while(0)
  for(;t+5<NT;t+=2){
    STEP(pB0,pB1,pA0,pA1,t,true,true,true);     WAIT_BAR(2); RESC(); ROT();
    STEP(pA0,pA1,pB0,pB1,t+1,true,true,true);   WAIT_BAR(2); RESC(); ROT();
  }
  #undef CMASK
  int qrel_m=qrel,hi_m=hi; asm volatile("":"+v"(qrel_m),"+v"(hi_m));
  #define CMASK(P0,P1,t) do{int jb_=(t)-(NT-4); if(jb_>=0)cmask(P0,P1,jb_,qrel_m,hi_m);}while(0)
  #define ENDW(tt) do{ if((tt)+3<NT){WAIT_BAR(2);} else if((tt)+2<NT){WAIT_BAR(1);} else {WAIT_BAR(0);} }while(0)
  for(;t+1<NT;t+=2){
    STEP(pB0,pB1,pA0,pA1,t,(t+3<NT),(t+1<NT),(t+1<NT));       ENDW(t);   RESC(); ROT();
    STEP(pA0,pA1,pB0,pB1,t+1,(t+4<NT),(t+2<NT),(t+2<NT));     ENDW(t+1); RESC(); ROT();
  }
  STEP(pB0,pB1,pA0,pA1,NT-1,false,false,false); RESC();
  { float sacc=pB0[0]+pB0[1]; _Pragma("unroll") for(int r=2;r<16;++r)sacc+=pB0[r]; _Pragma("unroll") for(int r=0;r<16;++r)sacc+=pB1[r]; l_reg+=sacc;
    pw0=(u32x4){PKW(pB0,0),PKW(pB0,2),PKW(pB0,4),PKW(pB0,6)};pw1=(u32x4){PKW(pB0,8),PKW(pB0,10),PKW(pB0,12),PKW(pB0,14)};pw2=(u32x4){PKW(pB1,0),PKW(pB1,2),PKW(pB1,4),PKW(pB1,6)};pw3=(u32x4){PKW(pB1,8),PKW(pB1,10),PKW(pB1,12),PKW(pB1,14)};
    SBAR(); pv(o,vb0+sl_cur,PAF(0),PAF(1),PAF(2),PAF(3)); }
  #undef PKW
  #undef PAF
  #undef VFR
  #undef PIN
  #undef MX3
  #undef GAPA
  #undef GAPB
  #undef EX
  #undef VRD
  #undef KRD
  #undef STEP
  #undef ENDW
  {auto rr=__builtin_amdgcn_permlane32_swap(__float_as_uint(l_reg),__float_as_uint(l_reg),false,false);l_reg=__uint_as_float(rr[0])+__uint_as_float(rr[1]);}
  if(hi==0)wsf[32+r32]=l_reg;asm volatile("s_waitcnt lgkmcnt(0)":::"memory");
  float rli[16];
  #pragma unroll
  for(int r=0;r<16;++r)rli[r]=__builtin_amdgcn_rcpf(wsf[32+crow(r,hi)]);
  bf16*Ow=O+(rowbase+q0+wid*QBLK)*DM+h*D;
  { bf16*stg=(bf16*)(shm+LDS_OST)+wid*2048;
    #pragma unroll
    for(int r=0;r<16;++r){const int orow=crow(r,hi);
      #pragma unroll
      for(int d0=0;d0<2;++d0){const float gv=__uint_as_float((unsigned)Gt[(rowbase+q0+wid*QBLK+orow)*DM+h*D+d0*32+r32]<<16); const float ov=o[d0][r]*rli[r]*gv; unsigned ub=__float_as_uint(ov); ub=(ub+0x7fffu+((ub>>16)&1u))>>16; stg[orow*64+d0*32+r32]=(bf16)ub;}}
    asm volatile("s_waitcnt lgkmcnt(0)":::"memory");
    #pragma unroll
    for(int i=0;i<4;++i){const int row=i*8+(lane>>3),ch=lane&7; const u32x4 v=*(const u32x4*)(stg+row*64+ch*8); ATTN_STORE16(Ow+(long)row*DM+ch*8,v);} }
  asm volatile("s_waitcnt lgkmcnt(0)\n\ts_barrier":::"memory");
  #undef DMA_K
  #undef DMA_V
  #undef CMASK
  #undef BIAS
  #undef LDSF4
  #undef START
  #undef RESC
  #undef ROT
}
constexpr int ATTN_LDS_BYTES=LDS_BYTES;
#undef SBAR
#undef WAIT_BAR
}

__device__ __forceinline__ void fox_attn2(const Params& P, char* shm, int tid, int bid, int G, unsigned short* Odst) {
    const int lane = tid & 63;
    unsigned short* Q = (unsigned short*)(P.ws + WS_ACT); const unsigned short* Kb = (const unsigned short*)(P.ws + WS_ACT + 32 * MiB); const unsigned short* V = (const unsigned short*)(P.ws + WS_ACT + 64 * MiB);
    const unsigned short* Gt = (const unsigned short*)(P.ws + WS_ACT + 96 * MiB);
    LAS float* nc = (LAS float*)((LAS char*)shm + attn_body::LDS_NC);
    LAS float* ft = (LAS float*)((LAS char*)shm + attn_body::LDS_FT);
    LAS float* re = (LAS float*)((LAS char*)shm + attn_body::LDS_RE);
    float gq = fabsf(P.fox_q_gain[lane]), gk = fabsf(P.fox_k_gain[lane]);
#pragma unroll
    for (int o = 1; o < 64; o <<= 1) { gq = fmaxf(gq, __shfl_xor(gq, o)); gk = fmaxf(gk, __shfl_xor(gk, o)); }
    const float Smax = 1.02f * (64.0f * gq * gk * 0.125f * LOG2E);
    const float T = 2.0f * Smax + 40.0f;
    const int vcu = (G % 8 == 0) ? (bid % 8) * (G / 8) + bid / 8 : bid;
    int last_bh = -1;
    for (int i = 0;; ++i) {
        int bh, qb;
        if (G == 256) { if (i >= 4) break; bh = vcu >> 2; const int s = vcu & 3; qb = (i == 0) ? s : (i == 1) ? 7 - s : (i == 2) ? 8 + s : 15 - s; }
        else { const int ui = i * G + bid; if (ui >= 1024) break; bh = ui >> 4; qb = ui & 15; }
        if (bh != last_bh) {
            const float* LF = (const float*)(P.ws + WS_S16) + ((size_t)(bh >> 4) * SEQ + 8 * tid) * 16 + (bh & 15);
            float v8[8]; float run = 0.f;
#pragma unroll
            for (int i2 = 0; i2 < 8; ++i2) { run += LF[(size_t)i2 * 16]; v8[i2] = run; }
            float inc = run;
#pragma unroll
            for (int o = 1; o < 64; o <<= 1) { const float tt = __shfl_up(inc, o); if (lane >= o) inc += tt; }
            if (lane == 63) ft[tid >> 6] = inc;
            __syncthreads();
            float pre = inc - run;
            for (int w = 0; w < (tid >> 6); ++w) pre += ft[w];
            __syncthreads();
#pragma unroll
            for (int i2 = 0; i2 < 8; ++i2) nc[8 * tid + i2] = -(pre + v8[i2]) * LOG2E;
            __syncthreads();
            if (tid < 64) { const float e = nc[64 * tid + 63]; re[tid] = e; const float ep = (tid > 0) ? nc[64 * tid - 1] : e; ft[tid] = exp2f(ep - e); }
            __syncthreads();
#pragma unroll
            for (int i2 = 0; i2 < 8; ++i2) nc[8 * tid + i2] += -re[tid >> 3] - Smax + 40.0f;
            __syncthreads(); last_bh = bh;
        }
        const int ntf = 4 * qb + 4;
        const float thr = (qb > 0 ? re[4 * qb - 1] : 0.0f) - T;
        const bool pred = (lane < ntf) && (re[lane] < thr);
        int ts = __builtin_popcountll(__ballot(pred)) & ~1; ts = ts > ntf - 4 ? ntf - 4 : ts; ts = __builtin_amdgcn_readfirstlane(ts);
        int tid_u = tid; asm volatile("" : "+v"(tid_u));
        attn_body::attn_unit<8>(bh >> 4, bh & 15, qb, ts, Q, Kb, V, Gt, Odst ? Odst : Q, shm, tid_u);
    }
}

__device__ __forceinline__ void final_norm(const Params& P, int tid, int bid, int G) {
    const int lane = tid & 63, wave = tid >> 6;
    const int gw = bid * 8 + wave, NGW = G * 8;
    f32x4 g[4];
#pragma unroll
    for (int j = 0; j < 4; ++j) g[j] = *(const f32x4*)(P.final_g + 4 * lane + 256 * j);
    constexpr int RB = 4;
    for (int row0 = gw; row0 < MT; row0 += RB * NGW) {
        f32x4 v[RB][4];
#pragma unroll
        for (int rb = 0; rb < RB; ++rb) { const int row = row0 + rb * NGW < MT ? row0 + rb * NGW : row0; const f32x4* xr = (const f32x4*)(P.out + (size_t)row * 1024) + lane;
#pragma unroll
            for (int j = 0; j < 4; ++j) v[rb][j] = xr[64 * j]; }
#pragma unroll
        for (int rb = 0; rb < RB; ++rb) { const int row = row0 + rb * NGW; if (row >= MT) break;
            float ss = 0.f;
#pragma unroll
            for (int j = 0; j < 4; ++j) ss += (v[rb][j][0] * v[rb][j][0] + v[rb][j][1] * v[rb][j][1]) + (v[rb][j][2] * v[rb][j][2] + v[rb][j][3] * v[rb][j][3]);
            const float rstd = rsqrtf(wave_sum(ss) * (1.0f / 1024.0f) + EPS);
            f32x4* xw = (f32x4*)(P.out + (size_t)row * 1024) + lane;
#pragma unroll
            for (int j = 0; j < 4; ++j) xw[64 * j] = (v[rb][j] * rstd) * g[j];
        }
    }
}

#define XB_TMO      128
#define XB_XCNT(j)  (256  + 64 * (j))
#define XB_XSUB(j)  (1280 + 64 * (j))
#define XB_XGEN(j)  (2304 + 64 * (j))
#define XB_TOP      3328
#define XB_TOPGEN   3392
#define XCD_BAR_WORDS 3456
#define XB_SPIN_CAP (1u << 20)
__device__ __forceinline__ unsigned xb_ld(unsigned* p)              { return __hip_atomic_load(p, __ATOMIC_RELAXED, __HIP_MEMORY_SCOPE_AGENT); }
__device__ __forceinline__ unsigned xb_add(unsigned* p, unsigned v) { return __hip_atomic_fetch_add(p, v, __ATOMIC_RELAXED, __HIP_MEMORY_SCOPE_AGENT); }
__device__ __forceinline__ unsigned xb_xcc_id() { return (unsigned)__builtin_amdgcn_s_getreg((3 << 11) | 20) & 0xFu; }
#define XB_SPIN(cond, bar) do { unsigned _sp = 0; while (cond) { __builtin_amdgcn_s_sleep(1); \
    if ((++_sp & 255u) == 0u) { if (xb_ld(&(bar)[XB_TMO])) break; if (_sp > XB_SPIN_CAP) { atomicAdd(&(bar)[XB_TMO], 1u); break; } } } } while (0)
struct XcdBarrier { unsigned* bar; unsigned x; volatile LAS unsigned* st; int wave_s; };
__device__ __forceinline__ int lane_id() { return (int)__builtin_amdgcn_mbcnt_hi(~0u, __builtin_amdgcn_mbcnt_lo(~0u, 0u)); }
__device__ __forceinline__ XcdBarrier xcd_barrier_post(unsigned* bar, volatile LAS unsigned* st, int wave_s) {
    XcdBarrier b; b.bar = bar; b.x = xb_xcc_id(); b.st = st; b.wave_s = wave_s;
    if (threadIdx.x == 0) (void)xb_add(&bar[XB_XCNT(b.x)], 1u);
    return b;
}
__device__ __forceinline__ void xcd_barrier_complete(unsigned* bar, unsigned x, unsigned& nloc, unsigned& nx) {
    const unsigned G = gridDim.x * gridDim.y * gridDim.z;
    asm volatile("" : "+s"(x));
    unsigned sum, cnt, mine, sp = 0u;
    for (;;) {
        sum = 0u; cnt = 0u; mine = 0u;
#pragma unroll
        for (unsigned j = 0; j < 16; ++j) { const unsigned c = xb_ld(&bar[XB_XCNT(j)]); sum += c; cnt += (c > 0u) ? 1u : 0u; mine = (j == x) ? c : mine; }
        if (sum == G) break;
        __builtin_amdgcn_s_sleep(1);
        if ((++sp & 255u) == 0u) { if (xb_ld(&bar[XB_TMO])) break; if (sp > XB_SPIN_CAP) { atomicAdd(&bar[XB_TMO], 1u); break; } }
    }
    nloc = mine > 0u ? mine : 1u; nx = cnt > 0u ? cnt : 1u;
}
__device__ __forceinline__ void xcd_barrier(const XcdBarrier& b) {
    asm volatile("s_waitcnt vmcnt(0)" ::: "memory");
    __syncthreads();
    if (threadIdx.x == 0) {
        unsigned* bar = b.bar;
        __builtin_amdgcn_s_waitcnt(0);
        unsigned nloc = b.st[0], nx = b.st[1];
        if (nloc == 0u) { xcd_barrier_complete(bar, b.x, nloc, nx); b.st[0] = nloc; b.st[1] = nx; }
        const unsigned old = xb_add(&bar[XB_XSUB(b.x)], 1u);
        const unsigned gen = old / nloc;
        if (old + 1u == (gen + 1u) * nloc) {
            __builtin_amdgcn_fence(__ATOMIC_RELEASE, "agent");
            asm volatile("s_waitcnt vmcnt(0)" ::: "memory");
            const unsigned og = xb_add(&bar[XB_TOP], 1u);
            const unsigned tg = og / nx;
            if (og + 1u == (tg + 1u) * nx) xb_add(&bar[XB_TOPGEN], 1u);
            else XB_SPIN(xb_ld(&bar[XB_TOPGEN]) == tg, bar);
            xb_add(&bar[XB_XGEN(b.x)], 1u);
            __builtin_amdgcn_fence(__ATOMIC_ACQUIRE, "agent");
            asm volatile("s_waitcnt vmcnt(0)" ::: "memory");
        } else {
            XB_SPIN(xb_ld(&bar[XB_XGEN(b.x)]) == gen, bar);
            __builtin_amdgcn_fence(__ATOMIC_ACQUIRE, "agent");
            asm volatile("s_waitcnt vmcnt(0)" ::: "memory");
        }
    }
    __syncthreads();
}

constexpr int LDS_BYTES = 147456;
#ifndef PROBE
#define PROBE 0
#endif
#define FRESH() int tid = threadIdx.x, bid = blockIdx.x; asm volatile("" : "+v"(tid)); asm volatile("" : "+s"(bid));
__global__ void __launch_bounds__(512, 2) trunk_fwd(Params P) {
    extern __shared__ __attribute__((aligned(16))) unsigned char lds_raw[];
    LAS unsigned char* lds = (LAS unsigned char*)lds_raw;
    cg::grid_group grid = cg::this_grid();
    const int G = gridDim.x;
    volatile LAS unsigned* MISC = (volatile LAS unsigned*)(lds + LDS_BYTES - 128);
    const int wave_s = __builtin_amdgcn_readfirstlane((int)threadIdx.x >> 6);
    if (threadIdx.x < 32) MISC[threadIdx.x] = 0u;
    __syncthreads();
    XcdBarrier xbar = xcd_barrier_post((unsigned*)P.ws, MISC + 8, wave_s);
    unsigned char* ws = P.ws;
    const float* MOD = (const float*)(ws + WS_MOD);
    bf16_t* XN = (bf16_t*)(ws + WS_XN);
    bf16_t* ACT = (bf16_t*)(ws + WS_ACT);
#define GSYNC() xcd_barrier(xbar)
    if (PROBE == 30) { { FRESH(); p0_mod(P, lds, tid, bid, G); } { FRESH(); p0_rope(P, tid, bid, G); } __syncthreads(); }
    if (PROBE == 31) { FRESH(); conv_weights(P.ret_w_in, RET_IN, 6144, P.ret_w_out, 2048, ws + WS_W, lds, tid, bid, G); __syncthreads(); }
    { FRESH(); p0_mod(P, lds, tid, bid, G); }
    { FRESH(); p0_rope(P, tid, bid, G); }
    { FRESH(); conv_weights(P.ret_w_in, RET_IN, 6144, P.ret_w_out, 2048, ws + WS_W, lds, tid, bid, G); }
    grid.sync();
#pragma unroll 1
    for (int layer = 0; layer < 4; ++layer) {
        const int kind = layer % 3, j = layer / 3;
        unsigned char* wbase = ws + ((kind == 2) ? WS_WGLA : WS_W);
        bf16_t* WinT = (bf16_t*)wbase; bf16_t* WoutT = (bf16_t*)(wbase + 12 * MiB);
        const float* xin = (layer == 0) ? P.x : P.out;
        if (layer > 0) {
            FRESH();
            if (kind == 0) { if (G != 256) conv_weights(P.ret_w_in + (size_t)j * 1024 * RET_IN, RET_IN, 6144, P.ret_w_out + (size_t)j * 2048 * 1024, 2048, ws + WS_W, lds, tid, bid, G); }
            else if (kind == 1) conv_weights(P.fox_w_in, FOX_IN, 4096, P.fox_w_out, 1024, ws + WS_W, lds, tid, bid, G);
            else conv_weights(P.gla_w_in, GLA_IN, 3072, P.gla_w_out, 1024, ws + WS_WGLA, lds, tid, bid, G);
            __syncthreads();
        }
        if (PROBE == 5 || (PROBE >= 50 && PROBE <= 53 && layer == PROBE - 50)) {
            if (kind == 0) { FRESH(); h_phase<0>(P, layer, xin, lds, tid, bid, G); }
            else if (kind == 1) { FRESH(); h_phase<1>(P, layer, xin, lds, tid, bid, G); }
            else { FRESH(); h_phase<2>(P, layer, xin, lds, tid, bid, G); }
            __syncthreads();
        }
        if (kind == 0) { FRESH(); h_phase<0>(P, layer, xin, lds, tid, bid, G); }
        else if (kind == 1) { FRESH(); h_phase<1>(P, layer, xin, lds, tid, bid, G); }
        else { FRESH(); h_phase<2>(P, layer, xin, lds, tid, bid, G); }
        GSYNC();
        const float* gate = MOD + (size_t)(layer * 4) * 3072 + 2048;
        if (kind == 0) {
            bf16_t* rQ = ACT; bf16_t* rK = (bf16_t*)(ws + WS_ACT + 32 * MiB); bf16_t* rV = (bf16_t*)(ws + WS_ACT + 64 * MiB); bf16_t* rO = (bf16_t*)(ws + WS_ACT + 128 * MiB);
            bf16_t* rP = WinT;
            float* STATS = (float*)(ws + WS_S16);
            {
                FRESH();
                pg8::Gemm g{XN, WinT, MT, 4096, 1024}; pg8::StaticOrder S; S.init(MT, 4096, G, bid);
                EpiRetIn E{rQ, rK, rV, (const unsigned*)(ws + WS_ROPE)};
                pg8::gemm_phase<EpiRetIn, pg8::StaticOrder, true, true>(lds, g, S, E, tid);
            }
            GSYNC();
            if (PROBE == 40) { FRESH();
                pg8::Gemm g{XN, WinT, MT, 4096, 1024}; pg8::StaticOrder S; S.init(MT, 4096, G, bid);
                EpiRetIn E{rQ, rK, rV, (const unsigned*)(ws + WS_ROPE)};
                pg8::gemm_phase<EpiRetIn, pg8::StaticOrder, true, true>(lds, g, S, E, tid); GSYNC(); }
            if (PROBE == 6) { FRESH();
                pg8::Gemm g{XN, WinT + (size_t)4096 * 1024, MT, 2048, 1024}; pg8::StaticOrder S; S.init(MT, 2048, G, bid);
                EpiSplit E{(bf16_t*)P.out, 8, 0, 2048, -1};
                if (layer == 0) { pg8::gemm_phase<EpiSplit, pg8::StaticOrder, true, true>(lds, g, S, E, tid); GSYNC(); } }
            if (PROBE == 62 && layer == 0) { FRESH();
                pg8::Gemm g{XN, WinT, MT, 4096, 1024}; pg8::StaticOrder S; S.init(MT, 4096, G, bid);
                EpiNone E{P.out};
                pg8::gemm_phase<EpiNone, pg8::StaticOrder, true, true>(lds, g, S, E, tid); GSYNC(); }
            if (PROBE == 60 && layer == 0) { FRESH();
                pg8::Gemm g{XN, WinT + (size_t)4096 * 1024, MT, 2048, 1024}; pg8::StaticOrder S; S.init(MT, 2048, G, bid);
                EpiNone E{P.out};
                pg8::gemm_phase<EpiNone, pg8::StaticOrder, true, true>(lds, g, S, E, tid); GSYNC(); }
            if (PROBE == 8) { FRESH(); lin_pphase<0>(rQ, rK, rQ, rK, rP, tid, bid, G); GSYNC(); }
            { FRESH(); lin_pphase<0>(rQ, rK, rQ, rK, rP, tid, bid, G); }
            GSYNC();
            if (PROBE == 2) { FRESH(); lin_scan<0>(rQ, rK, rV, rP, nullptr, rO, STATS, lds, tid, bid, G); GSYNC(); }
            if (PROBE == 20 && layer == 0) { FRESH(); lin_scan<0, 1>(rQ, rK, rV, rP, nullptr, (bf16_t*)P.out, STATS, lds, tid, bid, G); GSYNC(); }
            if (PROBE == 21 && layer == 0) { FRESH(); lin_scan<0, 3>(rQ, rK, rV, rP, nullptr, (bf16_t*)P.out, STATS, lds, tid, bid, G); GSYNC(); }
            if (PROBE == 23 && layer == 0) { FRESH(); lin_scan<0, 4>(rQ, rK, rV, rP, nullptr, (bf16_t*)P.out, STATS, lds, tid, bid, G); GSYNC(); }
            if (PROBE == 24 && layer == 0) { FRESH(); lin_scan<0, 8>(rQ, rK, rV, rP, nullptr, (bf16_t*)P.out, STATS, lds, tid, bid, G); GSYNC(); }
            if (PROBE == 25 && layer == 0) { FRESH(); lin_scan<0, 16>(rQ, rK, rV, rP, nullptr, (bf16_t*)P.out, STATS, lds, tid, bid, G); GSYNC(); }
            if (PROBE == 26 && layer == 0) { FRESH(); lin_scan<0, 31>(rQ, rK, rV, rP, nullptr, (bf16_t*)P.out, STATS, lds, tid, bid, G); GSYNC(); }
            if (PROBE == 27 && layer == 0) { FRESH(); lin_scan<0, 32>(rQ, rK, rV, rP, nullptr, (bf16_t*)P.out, STATS, lds, tid, bid, G); GSYNC(); }
            if (PROBE == 22 && layer == 0) { FRESH(); lin_scan<0, 0>(rQ, rK, rV, rP, nullptr, (bf16_t*)P.out, STATS, lds, tid, bid, G); GSYNC(); }
            { FRESH(); lin_scan<0>(rQ, rK, rV, rP, nullptr, rO, STATS, lds, tid, bid, G); }
            GSYNC();
            {
                FRESH();
                pg8::Gemm g{XN, WinT + (size_t)4096 * 1024, MT, 2048, 1024}; pg8::PairOrder S{G, (G % 8 == 0) ? (bid % 8) * (G / 8) + bid / 8 : bid};
                EpiGateNorm<0> E{rO, STATS, (LAS float*)(lds + 131072)};
                pg8::gemm_phase<EpiGateNorm<0>, pg8::PairOrder, true, true>(lds, g, S, E, tid);
            }
            GSYNC();
            if (PROBE == 42 && layer == 0) { FRESH();
                pg8::Gemm g{rO, WoutT, MT, 1024, 2048}; pg8::StaticOrder S; S.init(MT, 1024, G, bid);
                EpiOut E{xin, P.out, gate};
                pg8::gemm_phase<EpiOut, pg8::StaticOrder, true, true>(lds, g, S, E, tid); GSYNC(); }
            {
                FRESH();
                pg8::Gemm g{rO, WoutT, MT, 1024, 2048}; pg8::StaticOrder S; S.init(MT, 1024, G, bid);
                EpiOut E{xin, P.out, gate};
                pg8::gemm_phase<EpiOut, pg8::StaticOrder, true, true>(lds, g, S, E, tid);
            }
            GSYNC();
        } else if (kind == 1) {
            {
                FRESH();
                pg8::Gemm g{XN, WinT, MT, 4096, 1024}; pg8::StaticOrder S; S.init(MT, 4096, G, bid);
                EpiFoxIn E{ACT, P.fox_q_gain, P.fox_k_gain, (LAS float*)(lds + 131072)};
                pg8::gemm_phase<EpiFoxIn, pg8::StaticOrder, true, true>(lds, g, S, E, tid);
            }
            GSYNC();
            if (PROBE == 41) { FRESH();
                pg8::Gemm g{XN, WinT, MT, 4096, 1024}; pg8::StaticOrder S; S.init(MT, 4096, G, bid);
                EpiFoxIn E{ACT, P.fox_q_gain, P.fox_k_gain, (LAS float*)(lds + 131072)};
                pg8::gemm_phase<EpiFoxIn, pg8::StaticOrder, true, true>(lds, g, S, E, tid); GSYNC(); }
            if (PROBE == 1) { FRESH(); fox_attn2(P, (char*)lds_raw, tid, bid, G, XN); GSYNC(); }
            { FRESH(); fox_attn2(P, (char*)lds_raw, tid, bid, G, nullptr); }
            GSYNC();
            {
                FRESH();
                pg8::Gemm g{ACT, WoutT, MT, 1024, 1024}; pg8::StaticOrder S; S.init(MT, 1024, G, bid);
                EpiOut E{xin, P.out, gate};
                pg8::gemm_phase<EpiOut, pg8::StaticOrder, true, true>(lds, g, S, E, tid);
            }
            GSYNC();
        } else {
            bf16_t* gQE = ACT; bf16_t* gQN = (bf16_t*)(ws + WS_ACT + 16 * MiB); bf16_t* gKE = (bf16_t*)(ws + WS_ACT + 32 * MiB); bf16_t* gKN = (bf16_t*)(ws + WS_ACT + 48 * MiB);
            bf16_t* gV = (bf16_t*)(ws + WS_ACT + 64 * MiB); bf16_t* gP = (bf16_t*)(ws + WS_ACT + 96 * MiB); bf16_t* gO = (bf16_t*)(ws + WS_ACT + 128 * MiB);
            const float* gCB = (const float*)(ws + WS_ACT + 160 * MiB);
            float* STATS = (float*)(ws + WS_S16);
            {
                FRESH();
                pg8::Gemm g{XN, WinT, MT, 2048, 1024}; pg8::StaticOrder S; S.init(MT, 2048, G, bid);
                EpiGlaIn E{gQE, gQN, gKE, gKN, gV, nullptr, gCB};
                pg8::gemm_phase<EpiGlaIn, pg8::StaticOrder, true, true>(lds, g, S, E, tid);
            }
            GSYNC();
            { FRESH(); lin_pphase<1>(gQE, gKN, gQN, gKE, gP, tid, bid, G); }
            GSYNC();
            if (PROBE == 3) { FRESH(); lin_scan<1>(gQE, gKN, gV, gP, gCB, gO, STATS, lds, tid, bid, G); GSYNC(); }
            if (G == 256 && ((int)blockIdx.x >> 3) >= 16) {
                FRESH(); const int sub = (bid & 7) * 16 + ((bid >> 3) - 16);
                conv_weights(P.ret_w_in + (size_t)1 * 1024 * RET_IN, RET_IN, 6144, P.ret_w_out + (size_t)1 * 2048 * 1024, 2048, ws + WS_W, lds, tid, sub, 128);
            } else { FRESH(); lin_scan<1>(gQE, gKN, gV, gP, gCB, gO, STATS, lds, tid, bid, G); }
            GSYNC();
            {
                FRESH();
                pg8::Gemm g{XN, WinT + (size_t)2048 * 1024, MT, 1024, 1024}; pg8::StaticOrder S; S.init(MT, 1024, G, bid);
                EpiGateNorm<1> E{gO, STATS, (LAS float*)(lds + 131072)};
                pg8::gemm_phase<EpiGateNorm<1>, pg8::StaticOrder, true, true>(lds, g, S, E, tid);
            }
            GSYNC();
            {
                FRESH();
                pg8::Gemm g{gO, WoutT, MT, 1024, 1024}; pg8::StaticOrder S; S.init(MT, 1024, G, bid);
                EpiOut E{xin, P.out, gate};
                pg8::gemm_phase<EpiOut, pg8::StaticOrder, true, true>(lds, g, S, E, tid);
            }
            GSYNC();
        }
    }
    if (PROBE == 70) { for (int i = 0; i < 10; ++i) GSYNC(); }
    { FRESH(); final_norm(P, tid, bid, G); }
}

extern "C" void kernel_launch(void* const* d_in, const int* in_sizes, int n_in, void* d_out, int out_size, void* d_ws, size_t ws_size, hipStream_t stream) {
    static int grid = 0;
    if (grid == 0) {
        if (n_in != 18 || out_size != MT * DM || ws_size < WS_END) { fprintf(stderr, "kernel_launch: unexpected shapes (n_in %d out %d ws %zu)\n", n_in, out_size, ws_size); grid = -1; return; }
        int dev = 0, cus = 0, per_cu = 0;
        hipGetDevice(&dev);
        hipDeviceGetAttribute(&cus, hipDeviceAttributeMultiprocessorCount, dev);
        hipFuncSetAttribute((const void*)trunk_fwd, hipFuncAttributeMaxDynamicSharedMemorySize, LDS_BYTES);
        hipOccupancyMaxActiveBlocksPerMultiprocessor(&per_cu, (const void*)trunk_fwd, 512, LDS_BYTES);
        if (per_cu < 1) { fprintf(stderr, "kernel_launch: occupancy query says %d blocks per CU\n", per_cu); per_cu = 1; }
        (void)hipGetLastError();
        grid = cus;
    }
    if (grid < 0) return;
    Params p{};
    p.x = (const float*)d_in[0]; p.c = (const float*)d_in[1]; p.pos = (const int*)d_in[2]; p.mod_w = (const float*)d_in[3]; p.mod_b = (const float*)d_in[4]; p.norm_g = (const float*)d_in[5];
    p.ret_w_in = (const float*)d_in[6]; p.ret_w_out = (const float*)d_in[7]; p.fox_w_in = (const float*)d_in[8]; p.fox_b_f = (const float*)d_in[9]; p.fox_q_gain = (const float*)d_in[10]; p.fox_k_gain = (const float*)d_in[11];
    p.fox_w_out = (const float*)d_in[12]; p.gla_w_in = (const float*)d_in[13]; p.gla_w_gate2 = (const float*)d_in[14]; p.gla_b_gate = (const float*)d_in[15]; p.gla_w_out = (const float*)d_in[16]; p.final_g = (const float*)d_in[17];
    p.out = (float*)d_out; p.ws = (unsigned char*)d_ws;
    if (hipMemsetAsync(d_ws, 0, 16384, stream) != hipSuccess) { fprintf(stderr, "kernel_launch: memset failed\n"); return; }
    void* args[] = {&p};
    hipError_t e = hipLaunchCooperativeKernel((const void*)trunk_fwd, dim3(grid), dim3(512), args, LDS_BYTES, stream);
    if (e != hipSuccess) fprintf(stderr, "cooperative launch failed: %s (grid %d)\n", hipGetErrorString(e), grid);
}
```

```cpp
#include <hip/hip_runtime.h>
#include <hip/hip_cooperative_groups.h>
#include <cstdio>
#include <cstdint>
#include <cmath>
namespace cg = cooperative_groups;

#define LAS __attribute__((address_space(3)))
typedef unsigned short bf16_t;
typedef short bf16x8 __attribute__((ext_vector_type(8)));
typedef float f32x4 __attribute__((ext_vector_type(4)));
typedef float f32x2 __attribute__((ext_vector_type(2)));
typedef unsigned u32x4 __attribute__((ext_vector_type(4)));
typedef unsigned u32x2 __attribute__((ext_vector_type(2)));

constexpr int DM = 1024, NB = 4, SEQ = 4096, MT = NB * SEQ;
constexpr float EPS = 1e-6f;
constexpr int RET_IN = 6144, FOX_IN = 4112, GLA_IN = 3088;
constexpr float LOG2E = 1.4426950408889634f;

constexpr size_t MiB = 1u << 20;
constexpr size_t WS_MOD = 1 * MiB;
constexpr size_t WS_S16 = 2 * MiB;
constexpr size_t WS_CUM = 3 * MiB;
constexpr size_t WS_ROPE = 4 * MiB;
constexpr size_t WS_W = 12 * MiB;
constexpr size_t WS_WOUT = WS_W + 12 * MiB;
constexpr size_t WS_WGLA = 164 * MiB;
constexpr size_t WS_XN = 28 * MiB;
constexpr size_t WS_ACT = 60 * MiB;
constexpr size_t WS_END = 252 * MiB;

__device__ __forceinline__ unsigned f2bf(float f) { unsigned u = __builtin_bit_cast(unsigned, f); return (u + 0x7fffu + ((u >> 16) & 1u)) >> 16; }
typedef float f32x2_hw __attribute__((ext_vector_type(2))); typedef __bf16 bf16x2_hw __attribute__((ext_vector_type(2)));
__device__ __forceinline__ unsigned pk2(float lo, float hi) { f32x2_hw v = {lo, hi}; bf16x2_hw b = __builtin_convertvector(v, bf16x2_hw); return __builtin_bit_cast(unsigned, b); }
__device__ __forceinline__ float bf2f(unsigned h) { return __builtin_bit_cast(float, h << 16); }
__device__ __forceinline__ u32x2 pk4(f32x4 v) { u32x2 r; r.x = pk2(v[0], v[1]); r.y = pk2(v[2], v[3]); return r; }
__device__ __forceinline__ f32x4 unpk4(u32x2 w) { f32x4 r; r[0] = bf2f(w.x & 0xffffu); r[1] = bf2f(w.x >> 16); r[2] = bf2f(w.y & 0xffffu); r[3] = bf2f(w.y >> 16); return r; }
__device__ __forceinline__ float silu_f(float v) { return v * __builtin_amdgcn_rcpf(1.0f + __expf(-v)); }
__device__ __forceinline__ float logsig_f(float v) { return fminf(v, 0.0f) - __logf(1.0f + __expf(-fabsf(v))); }
template <int CTRL> __device__ __forceinline__ float dpp_mov(float v) { return __builtin_bit_cast(float, __builtin_amdgcn_update_dpp(0, __builtin_bit_cast(int, v), CTRL, 0xf, 0xf, true)); }
__device__ __forceinline__ float swap32_sum(float x, float y) { auto r = __builtin_amdgcn_permlane32_swap(__builtin_bit_cast(unsigned, x), __builtin_bit_cast(unsigned, y), false, false); const unsigned r0 = r[0], r1 = r[1]; return __builtin_bit_cast(float, r0) + __builtin_bit_cast(float, r1); }
__device__ __forceinline__ float swap16_sum(float x, float y) { auto r = __builtin_amdgcn_permlane16_swap(__builtin_bit_cast(unsigned, x), __builtin_bit_cast(unsigned, y), false, false); const unsigned r0 = r[0], r1 = r[1]; return __builtin_bit_cast(float, r0) + __builtin_bit_cast(float, r1); }
__device__ __forceinline__ float row_sum16(float v) {
    v += dpp_mov<0xB1>(v);
    v += dpp_mov<0x4E>(v);
    v += dpp_mov<0x141>(v);
    v += dpp_mov<0x140>(v);
    return v;
}
__device__ __forceinline__ float xsum_16_32(float v) { v = swap16_sum(v, v); return swap32_sum(v, v); }
__device__ __forceinline__ float wave_sum(float v) { return xsum_16_32(row_sum16(v)); }
__device__ __forceinline__ float reduce_scatter16(const float (&a)[16], int lane) {
    float b8[8], c4[4], d2[2], e1;
#pragma unroll
    for (int i = 0; i < 8; ++i) b8[i] = swap32_sum(a[i], a[i + 8]);
#pragma unroll
    for (int i = 0; i < 4; ++i) c4[i] = swap16_sum(b8[i], b8[i + 4]);
    { const bool hi = (lane & 8) != 0;
#pragma unroll
      for (int i = 0; i < 2; ++i) { const float snd = hi ? c4[i] : c4[i + 2], kp = hi ? c4[i + 2] : c4[i]; d2[i] = kp + dpp_mov<0x128>(snd); } }
    { const bool hi = (lane & 4) != 0; const float snd = hi ? d2[0] : d2[1], kp = hi ? d2[1] : d2[0]; e1 = kp + dpp_mov<0x1B>(dpp_mov<0x141>(snd)); }
    e1 += dpp_mov<0x4E>(e1); e1 += dpp_mov<0xB1>(e1);
    return e1;
}
#define LDS_WAIT() asm volatile("s_waitcnt lgkmcnt(0)" ::: "memory")

__device__ __forceinline__ f32x4 mma_rc(f32x4 acc, bf16x8 a_rows, bf16x8 b_cols) { return __builtin_amdgcn_mfma_f32_16x16x32_bf16(b_cols, a_rows, acc, 0, 0, 0); }
__device__ __forceinline__ f32x4 mma_cr(f32x4 acc, bf16x8 a_rows, bf16x8 b_cols) { return __builtin_amdgcn_mfma_f32_16x16x32_bf16(a_rows, b_cols, acc, 0, 0, 0); }
__device__ __forceinline__ bf16x8 gfrag(const bf16_t* base, int pitch, int lane) { return *(const bf16x8*)(base + (size_t)(lane & 15) * pitch + 8 * (lane >> 4)); }
__device__ __forceinline__ bf16x8 lfrag(const LAS bf16_t* base, int pitch, int lane) { return *(const LAS bf16x8*)(base + (lane & 15) * pitch + 8 * (lane >> 4)); }

namespace pg8 {
#define PG8_LAS __attribute__((address_space(3)))
constexpr int BM = 256, BK = 64, HALF = 128, HTB = HALF * BK * 2, STAGE_BYTES = 8 * HTB, NXCD = 8, WGM = 8;
__host__ __device__ __forceinline__ int lds_byte(int r, int c) { const int st = (r >> 4) * 2 + (c >> 5), rr = r & 15, cc = c & 31, ob = rr * 64 + cc * 2; return st * 1024 + (ob ^ (((ob >> 9) & 1) << 5)); }
__host__ __device__ __forceinline__ void stage_rc(int b, int& R, int& C) { const int st = b / 1024, sb = b % 1024, swz = sb ^ (((sb >> 9) & 1) << 5); R = (st >> 1) * 16 + swz / 64; C = (st & 1) * 32 + (swz % 64) / 2; }
__host__ __device__ __forceinline__ int perm32(int rho) { const int n = rho >> 4, i = rho & 15; return 8 * (i >> 2) + 4 * n + (i & 3); }

struct Unit { int pm, pn; };
struct Gemm { const bf16_t* A; const bf16_t* Bt; int M, N, K; };
struct StaticOrder {
    int nM, nN, nwg, G, c;
    __host__ __device__ void init(int M, int N, int G_, int c_) { nM = M / BM; nN = N / BM; nwg = nM * nN; G = G_; c = c_; }
    __host__ __device__ bool next(int i, Unit& u) const {
        const long L = (long)i * G + c; if (L >= nwg) return false;
        int wgid = (int)L; { const int q = nwg / NXCD, r = nwg % NXCD, xcd = wgid % NXCD, off = wgid / NXCD; wgid = (xcd < r ? xcd * (q + 1) : r * (q + 1) + (xcd - r) * q) + off; }
        const int nig = WGM * nN, gid = wgid / nig, fm = gid * WGM, gsz = (nM - fm) < WGM ? (nM - fm) : WGM;
        u.pm = fm + ((wgid % nig) % gsz); u.pn = (wgid % nig) / gsz; return true;
    }
    __device__ __forceinline__ void a_ready(const Unit&) const {}
    __device__ __forceinline__ void done(const Unit&) const {}
};

struct PairOrder {
    int G, c;
    __device__ __forceinline__ bool next(int i, Unit& u) const { const int pair = (i >> 1) * G + c; if (pair >= 256) return false; u.pm = pair >> 2; u.pn = 2 * (pair & 3) + (i & 1); return true; }
    __device__ __forceinline__ void a_ready(const Unit&) const {}
    __device__ __forceinline__ void done(const Unit&) const {}
};
template <class Epi, class Sched, bool ALIGN_EPI = false, bool SP2 = false>
__device__ __forceinline__ void gemm_phase(PG8_LAS unsigned char* lds, const Gemm g, const Sched& S, const Epi& E, int tid) {
    const int wid = __builtin_amdgcn_readfirstlane(tid >> 6), lane = tid & 63, wr = wid >> 2, wc = wid & 3, fr = lane & 15, fq = lane >> 4;
    const int K = g.K, nt = K / BK;
    unsigned voffA[2], voffB[2];
#pragma unroll
    for (int i = 0; i < 2; ++i) { int R, C; stage_rc(tid * 16 + i * 8192, R, C); const int Rb = Epi::PERM ? ((R & ~31) + perm32(R & 31)) : R;
        voffA[i] = (unsigned)(R * K + C) * 2u; voffB[i] = (unsigned)(Rb * K + C) * 2u; }
    const size_t kstep = (size_t)(BK * 2);
    const size_t hstep = (size_t)HALF * K * 2;
    const size_t tstep = 2 * hstep;
    const unsigned ldsw = (unsigned)wid * 1024u;
    const int aoff = lds_byte(wr * 64 + fr, fq * 8), boff = lds_byte(wc * 32 + fr, fq * 8);
#define PG8_SA(b, h) (((b) * 2 + (h)) * HTB)
#define PG8_SB(b, h) ((4 + (b) * 2 + (h)) * HTB)
#define PG8_STAGE(bufoff, gbase, voff) do { _Pragma("unroll") for (int _i = 0; _i < 2; ++_i) \
        __builtin_amdgcn_global_load_lds((const unsigned*)((const char*)(gbase) + (voff)[_i]), (PG8_LAS unsigned*)(lds + (bufoff) + ldsw + _i * 8192), 16, 0, 0); } while (0)
#define PG8_LDA(dst, b, h) do { _Pragma("unroll") for (int m = 0; m < 4; ++m) _Pragma("unroll") for (int k = 0; k < 2; ++k) dst[m][k] = *(const PG8_LAS bf16x8*)(lds + PG8_SA(b, h) + aoff + m * 2048 + k * 1024); } while (0)
#define PG8_LDB(dst, b, h) do { _Pragma("unroll") for (int n = 0; n < 2; ++n) _Pragma("unroll") for (int k = 0; k < 2; ++k) dst[n][k] = *(const PG8_LAS bf16x8*)(lds + PG8_SB(b, h) + boff + n * 2048 + k * 1024); } while (0)
#define PG8_MMA(ai, bj, At, Bt) do { __builtin_amdgcn_s_setprio(1); _Pragma("unroll") for (int m = 0; m < 4; ++m) _Pragma("unroll") for (int n = 0; n < 2; ++n) _Pragma("unroll") for (int k = 0; k < 2; ++k) \
        acc[ai][bj][m][n] = __builtin_amdgcn_mfma_f32_16x16x32_bf16(Bt[n][k], At[m][k], acc[ai][bj][m][n], 0, 0, 0); __builtin_amdgcn_s_setprio(0); } while (0)
#define PG8_WAIT_V(n) asm volatile("s_waitcnt vmcnt(" #n ")" ::: "memory")
#define PG8_WAIT_L(n) asm volatile("s_waitcnt lgkmcnt(" #n ")" ::: "memory")
#define PG8_BAR __builtin_amdgcn_s_barrier()
#define PG8_SCHED __builtin_amdgcn_sched_barrier(0)
    Unit cur, nxt; int ui = 0;
    if (!S.next(0, cur)) return;
    f32x4 acc[2][2][4][2];
#pragma unroll
    for (int a = 0; a < 2; ++a)
#pragma unroll
        for (int b = 0; b < 2; ++b)
#pragma unroll
            for (int m = 0; m < 4; ++m)
#pragma unroll
                for (int n = 0; n < 2; ++n) acc[a][b][m][n] = (f32x4){0.f, 0.f, 0.f, 0.f};
    bf16x8 At[4][2], B0[2][2], B1[2][2];
    const char* cA = (const char*)g.A + (size_t)cur.pm * tstep; const char* cB = (const char*)g.Bt + (size_t)cur.pn * tstep;
    S.a_ready(cur);
    if constexpr (SP2) {
        PG8_STAGE(PG8_SB(0, 0), cB, voffB); PG8_STAGE(PG8_SB(0, 1), cB + hstep, voffB); PG8_STAGE(PG8_SA(0, 0), cA, voffA); PG8_STAGE(PG8_SA(0, 1), cA + hstep, voffA);
        if (wr == 1) PG8_BAR;
        PG8_WAIT_V(2); PG8_BAR;
        PG8_STAGE(PG8_SB(1, 0), cB + kstep, voffB); PG8_STAGE(PG8_SA(1, 0), cA + kstep, voffA); PG8_STAGE(PG8_SB(1, 1), cB + hstep + kstep, voffB);
        PG8_WAIT_V(6); PG8_BAR;
    } else {
        PG8_STAGE(PG8_SB(0, 0), cB, voffB); PG8_STAGE(PG8_SA(0, 0), cA, voffA); PG8_STAGE(PG8_SB(0, 1), cB + hstep, voffB); PG8_STAGE(PG8_SA(0, 1), cA + hstep, voffA);
        if (wr == 1) PG8_BAR;
        PG8_WAIT_V(4); PG8_BAR;
        PG8_STAGE(PG8_SB(1, 0), cB + kstep, voffB); PG8_STAGE(PG8_SA(1, 0), cA + kstep, voffA); PG8_STAGE(PG8_SB(1, 1), cB + hstep + kstep, voffB);
        PG8_WAIT_V(6); PG8_BAR;
    }
    for (;;) {
        const bool has_next = S.next(ui + 1, nxt);
        const char* nA = has_next ? (const char*)g.A + (size_t)nxt.pm * tstep : cA; const char* nB = has_next ? (const char*)g.Bt + (size_t)nxt.pn * tstep : cB;
        for (int t = 0; t < nt; t += 2) {
            const bool last = (t == nt - 2);
            const char* a1 = cA + (size_t)(t + 1) * kstep;
            const char* a2 = last ? nA : cA + (size_t)(t + 2) * kstep; const char* b2 = last ? nB : cB + (size_t)(t + 2) * kstep;
            const char* a3 = a2 + kstep; const char* b3 = b2 + kstep;
            if (last && has_next) S.a_ready(nxt);
            if constexpr (SP2) {
            PG8_LDB(B0, 0, 0); PG8_LDB(B1, 0, 1); PG8_SCHED; PG8_LDA(At, 0, 0); PG8_STAGE(PG8_SA(1, 1), a1 + hstep, voffA);
            PG8_WAIT_V(8); PG8_WAIT_L(0); PG8_BAR; PG8_MMA(0, 0, At, B0); PG8_MMA(0, 1, At, B1); PG8_BAR; PG8_SCHED;
            PG8_LDA(At, 0, 1); PG8_STAGE(PG8_SB(0, 0), b2, voffB); PG8_STAGE(PG8_SB(0, 1), b2 + hstep, voffB); PG8_STAGE(PG8_SA(0, 0), a2, voffA);
            PG8_WAIT_V(8); PG8_WAIT_L(0); PG8_BAR; PG8_MMA(1, 0, At, B0); PG8_MMA(1, 1, At, B1); PG8_BAR; PG8_SCHED;
            PG8_LDB(B0, 1, 0); PG8_LDB(B1, 1, 1); PG8_SCHED; PG8_LDA(At, 1, 0); PG8_STAGE(PG8_SA(0, 1), a2 + hstep, voffA);
            PG8_WAIT_V(8); PG8_WAIT_L(0); PG8_BAR; PG8_MMA(0, 0, At, B0); PG8_MMA(0, 1, At, B1); PG8_BAR; PG8_SCHED;
            PG8_LDA(At, 1, 1); PG8_STAGE(PG8_SB(1, 0), b3, voffB); PG8_STAGE(PG8_SB(1, 1), b3 + hstep, voffB); PG8_STAGE(PG8_SA(1, 0), a3, voffA);
            PG8_WAIT_V(8); PG8_WAIT_L(0); PG8_BAR; PG8_MMA(1, 0, At, B0); PG8_MMA(1, 1, At, B1); PG8_BAR; PG8_SCHED;
            } else {
            PG8_LDB(B0, 0, 0); PG8_SCHED; PG8_LDA(At, 0, 0); PG8_STAGE(PG8_SA(1, 1), a1 + hstep, voffA);
            PG8_WAIT_L(8); PG8_BAR; PG8_WAIT_L(0); PG8_MMA(0, 0, At, B0); PG8_BAR; PG8_SCHED;
            PG8_LDB(B1, 0, 1); PG8_STAGE(PG8_SB(0, 0), b2, voffB);
            PG8_BAR; PG8_WAIT_L(0); PG8_MMA(0, 1, At, B1); PG8_BAR;
            PG8_LDA(At, 0, 1); PG8_STAGE(PG8_SA(0, 0), a2, voffA);
            PG8_BAR; PG8_WAIT_L(0); PG8_MMA(1, 0, At, B0); PG8_BAR; PG8_SCHED;
            PG8_STAGE(PG8_SB(0, 1), b2 + hstep, voffB);
            PG8_WAIT_V(6); PG8_BAR; PG8_MMA(1, 1, At, B1); PG8_BAR;
            PG8_LDB(B0, 1, 0); PG8_SCHED; PG8_LDA(At, 1, 0); PG8_STAGE(PG8_SA(0, 1), a2 + hstep, voffA);
            PG8_WAIT_L(8); PG8_BAR; PG8_WAIT_L(0); PG8_MMA(0, 0, At, B0); PG8_BAR; PG8_SCHED;
            PG8_LDB(B1, 1, 1); PG8_STAGE(PG8_SB(1, 0), b3, voffB);
            PG8_BAR; PG8_WAIT_L(0); PG8_MMA(0, 1, At, B1); PG8_BAR;
            PG8_LDA(At, 1, 1); PG8_STAGE(PG8_SA(1, 0), a3, voffA);
            PG8_BAR; PG8_WAIT_L(0); PG8_MMA(1, 0, At, B0); PG8_BAR; PG8_SCHED;
            PG8_STAGE(PG8_SB(1, 1), b3 + hstep, voffB);
            PG8_WAIT_V(6); PG8_BAR; PG8_MMA(1, 1, At, B1); PG8_BAR;
            }
        }
        if constexpr (ALIGN_EPI) { if (wr == 0) PG8_BAR; }
        E(acc, cur, wr, wc, fr, fq); S.done(cur);
        if (!has_next) break;
#pragma unroll
        for (int a = 0; a < 2; ++a)
#pragma unroll
            for (int b = 0; b < 2; ++b)
#pragma unroll
                for (int m = 0; m < 4; ++m)
#pragma unroll
                    for (int n = 0; n < 2; ++n) acc[a][b][m][n] = (f32x4){0.f, 0.f, 0.f, 0.f};
        cur = nxt; cA = nA; cB = nB; ++ui;
        if constexpr (ALIGN_EPI) { if (wr == 1) PG8_BAR; }
    }
    PG8_WAIT_V(0);
    if constexpr (!ALIGN_EPI) { if (wr == 0) PG8_BAR; }
    PG8_BAR;
#undef PG8_SA
#undef PG8_SB
#undef PG8_STAGE
#undef PG8_LDA
#undef PG8_LDB
#undef PG8_MMA
#undef PG8_WAIT_V
#undef PG8_WAIT_L
#undef PG8_BAR
#undef PG8_SCHED
}
}

struct Params {
    const float* x; const float* c; const int* pos; const float* mod_w; const float* mod_b; const float* norm_g;
    const float* ret_w_in; const float* ret_w_out; const float* fox_w_in; const float* fox_b_f; const float* fox_q_gain; const float* fox_k_gain; const float* fox_w_out;
    const float* gla_w_in; const float* gla_w_gate2; const float* gla_b_gate; const float* gla_w_out; const float* final_g;
    float* out; unsigned char* ws;
};

struct EpiRetIn {
    static constexpr bool PERM = false;
    bf16_t* Q; bf16_t* Kb; bf16_t* V; const unsigned* rope;
    __device__ __forceinline__ void operator()(const f32x4 (&acc)[2][2][4][2], const pg8::Unit& u, int wr, int wc, int fr, int fq) const {
        const int pn = u.pn;
        if (pn < 8) {
            bf16_t* dst = (pn < 4) ? Q : Kb; const int head = pn & 3; const float sc = (pn < 4) ? 0.0625f : 1.0f;
#pragma unroll
            for (int ai = 0; ai < 2; ++ai) {
                u32x4 cs[4][2];
#pragma unroll
                for (int m = 0; m < 4; ++m)
#pragma unroll
                    for (int n = 0; n < 2; ++n) cs[m][n] = *(const u32x4*)(rope + (size_t)(u.pm * 256 + ai * 128 + wr * 64 + m * 16 + fr) * 128 + wc * 32 + n * 16 + fq * 4);
                asm volatile("" ::: "memory");
#pragma unroll
                for (int m = 0; m < 4; ++m) {
                    const int row = u.pm * 256 + ai * 128 + wr * 64 + m * 16 + fr;
#pragma unroll
                    for (int n = 0; n < 2; ++n) {
                        const int d1 = wc * 32 + n * 16 + fq * 4;
                        const f32x4 x1 = acc[ai][0][m][n], x2 = acc[ai][1][m][n]; f32x4 o1, o2;
#pragma unroll
                        for (int j = 0; j < 4; ++j) {
                            const unsigned w = cs[m][n][j];
                            const float co = (float)__builtin_bit_cast(_Float16, (unsigned short)(w & 0xffffu)), si = (float)__builtin_bit_cast(_Float16, (unsigned short)(w >> 16));
                            o1[j] = (x1[j] * co - x2[j] * si) * sc; o2[j] = (x1[j] * si + x2[j] * co) * sc;
                        }
                        bf16_t* p = dst + (size_t)row * 1024 + head * 256 + d1;
                        *(u32x2*)p = pk4(o1); *(u32x2*)(p + 128) = pk4(o2);
                    }
                }
            }
        } else {
            const int cbase = (pn - 8) * 256;
#pragma unroll
            for (int ai = 0; ai < 2; ++ai)
#pragma unroll
                for (int m = 0; m < 4; ++m) {
                    const int row = u.pm * 256 + ai * 128 + wr * 64 + m * 16 + fr;
#pragma unroll
                    for (int bj = 0; bj < 2; ++bj)
#pragma unroll
                        for (int n = 0; n < 2; ++n) *(u32x2*)(V + (size_t)row * 2048 + cbase + bj * 128 + wc * 32 + n * 16 + fq * 4) = pk4(acc[ai][bj][m][n]);
                }
        }
    }
};
struct EpiSplit {
    static constexpr bool PERM = false;
    bf16_t* dst; int tpg; size_t gstride; int ldc; int silu_grp;
    __device__ __forceinline__ void operator()(const f32x4 (&acc)[2][2][4][2], const pg8::Unit& u, int wr, int wc, int fr, int fq) const {
        const int t = u.pn / tpg; bf16_t* base = dst + (size_t)t * gstride; const int cb = (u.pn - t * tpg) * 256; const bool act = (t == silu_grp);
#pragma unroll
        for (int ai = 0; ai < 2; ++ai)
#pragma unroll
            for (int m = 0; m < 4; ++m) {
                const int row = u.pm * 256 + ai * 128 + wr * 64 + m * 16 + fr;
#pragma unroll
                for (int bj = 0; bj < 2; ++bj)
#pragma unroll
                    for (int n = 0; n < 2; ++n) {
                        f32x4 a = acc[ai][bj][m][n];
                        if (act) {
#pragma unroll
                            for (int j = 0; j < 4; ++j) a[j] = silu_f(a[j]);
                        }
                        *(u32x2*)(base + (size_t)row * ldc + cb + bj * 128 + wc * 32 + n * 16 + fq * 4) = pk4(a);
                    }
            }
    }
};
struct EpiFoxIn {
    static constexpr bool PERM = false;
    bf16_t* dst; const float* qgain; const float* kgain; LAS float* tbl;
    __device__ __forceinline__ void operator()(const f32x4 (&acc)[2][2][4][2], const pg8::Unit& u, int wr, int wc, int fr, int fq) const {
        const int t = u.pn >> 2; bf16_t* base = dst + (size_t)t * ((size_t)16 * MiB); const int cb = (u.pn & 3) * 256;
        if (t < 2) {
#pragma unroll
            for (int ai = 0; ai < 2; ++ai)
#pragma unroll
                for (int m = 0; m < 4; ++m)
#pragma unroll
                    for (int bj = 0; bj < 2; ++bj) {
                        float sq = 0.f;
#pragma unroll
                        for (int n = 0; n < 2; ++n) { const f32x4 a = acc[ai][bj][m][n]; sq += (a[0] * a[0] + a[1] * a[1]) + (a[2] * a[2] + a[3] * a[3]); }
                        sq = xsum_16_32(sq);
                        if (fq == 0) tbl[(((ai * 128 + wr * 64 + m * 16 + fr) * 4) + bj * 2 + (wc >> 1)) * 2 + (wc & 1)] = sq;
                    }
            asm volatile("s_waitcnt lgkmcnt(0)" ::: "memory"); __builtin_amdgcn_s_barrier(); asm volatile("" ::: "memory");
            const float* gn = (t == 0) ? qgain : kgain; const float sc = (t == 0) ? (0.125f * LOG2E) : 1.0f;
            f32x4 gv[2];
#pragma unroll
            for (int n = 0; n < 2; ++n) gv[n] = *(const f32x4*)(gn + (wc & 1) * 32 + n * 16 + fq * 4) * sc;
#pragma unroll
            for (int ai = 0; ai < 2; ++ai)
#pragma unroll
                for (int m = 0; m < 4; ++m) {
                    const int rl = ai * 128 + wr * 64 + m * 16 + fr; const int row = u.pm * 256 + rl;
#pragma unroll
                    for (int bj = 0; bj < 2; ++bj) {
                        const f32x2 pr = *(const LAS f32x2*)(tbl + ((rl * 4) + bj * 2 + (wc >> 1)) * 2);
                        const float rstd = __builtin_amdgcn_rsqf((pr.x + pr.y) * (1.0f / 64.0f) + EPS);
#pragma unroll
                        for (int n = 0; n < 2; ++n) *(u32x2*)(base + (size_t)row * 1024 + cb + bj * 128 + wc * 32 + n * 16 + fq * 4) = pk4(acc[ai][bj][m][n] * rstd * gv[n]);
                    }
                }
        } else {
            const bool act = (t == 3);
#pragma unroll
            for (int ai = 0; ai < 2; ++ai)
#pragma unroll
                for (int m = 0; m < 4; ++m) {
                    const int row = u.pm * 256 + ai * 128 + wr * 64 + m * 16 + fr;
#pragma unroll
                    for (int bj = 0; bj < 2; ++bj)
#pragma unroll
                        for (int n = 0; n < 2; ++n) {
                            f32x4 a = acc[ai][bj][m][n];
                            if (act) {
#pragma unroll
                                for (int j = 0; j < 4; ++j) a[j] = silu_f(a[j]);
                            }
                            *(u32x2*)(base + (size_t)row * 1024 + cb + bj * 128 + wc * 32 + n * 16 + fq * 4) = pk4(a);
                        }
                }
        }
    }
};
struct EpiGlaIn {
    static constexpr bool PERM = false;
    bf16_t *QE, *QN, *KE, *KN, *V, *G; const float* CB;
    __device__ __forceinline__ void operator()(const f32x4 (&acc)[2][2][4][2], const pg8::Unit& u, int wr, int wc, int fr, int fq) const {
        const int pn = u.pn;
        if (pn < 4) {
            const float s = (pn < 2) ? 0.08838834764831845f : 1.0f;
            bf16_t* De = (pn < 2 ? QE : KE); bf16_t* Dn = (pn < 2 ? QN : KN);
#pragma unroll
            for (int ai = 0; ai < 2; ++ai)
#pragma unroll
            for (int mh = 0; mh < 2; ++mh) {
                f32x4 cb[2][2][2];
#pragma unroll
                for (int mm = 0; mm < 2; ++mm)
#pragma unroll
                    for (int bj = 0; bj < 2; ++bj)
#pragma unroll
                        for (int n = 0; n < 2; ++n) cb[mm][bj][n] = *(const f32x4*)(CB + (size_t)(u.pm * 256 + ai * 128 + wr * 64 + (2 * mh + mm) * 16 + fr) * 512 + (pn & 1) * 256 + bj * 128 + wc * 32 + n * 16 + fq * 4);
                asm volatile("" ::: "memory");
#pragma unroll
                for (int mm = 0; mm < 2; ++mm) {
                    const int m = 2 * mh + mm; const int row = u.pm * 256 + ai * 128 + wr * 64 + m * 16 + fr;
#pragma unroll
                    for (int bj = 0; bj < 2; ++bj)
#pragma unroll
                        for (int n = 0; n < 2; ++n) {
                            const int col = (pn & 1) * 256 + bj * 128 + wc * 32 + n * 16 + fq * 4;
                            const f32x4 a = acc[ai][bj][m][n]; f32x4 e, en;
#pragma unroll
                            for (int j = 0; j < 4; ++j) { const float ee = __expf(cb[mm][bj][n][j]); e[j] = a[j] * s * ee; en[j] = a[j] * s * __builtin_amdgcn_rcpf(ee); }
                            *(u32x2*)(De + (size_t)row * 512 + col) = pk4(e); *(u32x2*)(Dn + (size_t)row * 512 + col) = pk4(en);
                        }
                }
                asm volatile("" ::: "memory");
            }
        } else {
#pragma unroll
            for (int ai = 0; ai < 2; ++ai)
#pragma unroll
                for (int m = 0; m < 4; ++m) {
                    const int row = u.pm * 256 + ai * 128 + wr * 64 + m * 16 + fr;
#pragma unroll
                    for (int bj = 0; bj < 2; ++bj)
#pragma unroll
                        for (int n = 0; n < 2; ++n) *(u32x2*)(V + (size_t)row * 1024 + (pn - 4) * 256 + bj * 128 + wc * 32 + n * 16 + fq * 4) = pk4(acc[ai][bj][m][n]);
                }
        }
    }
};
struct EpiNone {
    static constexpr bool PERM = false; float* sink;
    __device__ __forceinline__ void operator()(const f32x4 (&acc)[2][2][4][2], const pg8::Unit& u, int wr, int wc, int fr, int fq) const {
        f32x4 t = acc[0][0][0][0];
#pragma unroll
        for (int ai = 0; ai < 2; ++ai)
#pragma unroll
            for (int bj = 0; bj < 2; ++bj)
#pragma unroll
                for (int m = 0; m < 4; ++m)
#pragma unroll
                    for (int n = 0; n < 2; ++n) t += acc[ai][bj][m][n];
        if (t[0] + t[1] + t[2] + t[3] == 12345.678f) sink[0] = t[0];
    }
};
struct EpiOut {
    static constexpr bool PERM = false;
    const float* xold; float* xnew; const float* gate;
    __device__ __forceinline__ void operator()(const f32x4 (&acc)[2][2][4][2], const pg8::Unit& u, int wr, int wc, int fr, int fq) const {
        const int b = (u.pm * 256) >> 12;
        f32x4 gv[2][2];
#pragma unroll
        for (int bj = 0; bj < 2; ++bj)
#pragma unroll
            for (int n = 0; n < 2; ++n) gv[bj][n] = *(const f32x4*)(gate + (size_t)b * 3072 + u.pn * 256 + bj * 128 + wc * 32 + n * 16 + fq * 4);
#pragma unroll
        for (int ai = 0; ai < 2; ++ai)
#pragma unroll
            for (int mh = 0; mh < 2; ++mh) {
                f32x4 xo[2][2][2];
#pragma unroll
                for (int mm = 0; mm < 2; ++mm)
#pragma unroll
                    for (int bj = 0; bj < 2; ++bj)
#pragma unroll
                        for (int n = 0; n < 2; ++n) xo[mm][bj][n] = *(const f32x4*)(xold + (size_t)(u.pm * 256 + ai * 128 + wr * 64 + (2 * mh + mm) * 16 + fr) * 1024 + u.pn * 256 + bj * 128 + wc * 32 + n * 16 + fq * 4);
                asm volatile("" ::: "memory");
#pragma unroll
                for (int mm = 0; mm < 2; ++mm)
#pragma unroll
                    for (int bj = 0; bj < 2; ++bj)
#pragma unroll
                        for (int n = 0; n < 2; ++n)
                            *(f32x4*)(xnew + (size_t)(u.pm * 256 + ai * 128 + wr * 64 + (2 * mh + mm) * 16 + fr) * 1024 + u.pn * 256 + bj * 128 + wc * 32 + n * 16 + fq * 4) = xo[mm][bj][n] + gv[bj][n] * acc[ai][bj][2 * mh + mm][n];
                asm volatile("" ::: "memory");
            }
    }
};

__device__ __forceinline__ void transpose_item(const float* W, int ldw, int K, int nblk, bf16_t* WT, LAS float* scr, int item, int lane) {
    const int kb = item / nblk, nb = item % nblk, k0 = 64 * kb, n0 = 32 * nb;
#pragma unroll 8
    for (int i = 0; i < 32; ++i) { const int kk = 2 * i + (lane >> 5); scr[kk * 33 + (lane & 31)] = W[(size_t)(k0 + kk) * ldw + n0 + (lane & 31)]; }
    LDS_WAIT(); asm volatile("" ::: "memory");
    const int c = lane & 7;
#pragma unroll
    for (int j = 0; j < 4; ++j) { const int n = (lane >> 3) + 8 * j; const LAS float* s = scr + (8 * c) * 33 + n;
        u32x4 o; o.x = pk2(s[0 * 33], s[1 * 33]); o.y = pk2(s[2 * 33], s[3 * 33]); o.z = pk2(s[4 * 33], s[5 * 33]); o.w = pk2(s[6 * 33], s[7 * 33]);
        *(u32x4*)(WT + (size_t)(n0 + n) * K + k0 + 8 * c) = o; }
    LDS_WAIT(); asm volatile("" ::: "memory");
}
__device__ __forceinline__ void conv_weights(const float* w_in, int ld_in, int n_in, const float* w_out, int k_out, unsigned char* wdst, LAS unsigned char* lds, int tid, int bid, int G) {
    const int lane = tid & 63, wave = tid >> 6;
    LAS float* scr = (LAS float*)(lds + wave * 16384);
    const int gw = bid * 8 + wave, NGW = G * 8;
    const int I_in = (1024 / 64) * (n_in / 32), I_out = (k_out / 64) * (1024 / 32);
    bf16_t* WinT = (bf16_t*)wdst; bf16_t* WoutT = (bf16_t*)(wdst + 12 * MiB);
    for (int it = gw; it < I_in + I_out; it += NGW) {
        if (it < I_in) transpose_item(w_in, ld_in, 1024, n_in / 32, WinT, scr, it, lane);
        else transpose_item(w_out, 1024, k_out, 32, WoutT, scr, it - I_in, lane);
    }
}
__device__ __forceinline__ void p0_mod(const Params& P, LAS unsigned char* lds, int tid, int bid, int G) {
    LAS float* sc = (LAS float*)lds;
    LAS float* red = sc + 4096;
    const int lane = tid & 63, wave = tid >> 6;
    float* MOD = (float*)(P.ws + WS_MOD);
    for (int i = tid; i < 4096; i += 512) sc[i] = silu_f(P.c[i]);
    __syncthreads();
    for (int it = bid; it < 192; it += G) {
        const int l = it / 48, cb = it % 48, n = cb * 64 + lane;
        const float* W = P.mod_w + (size_t)l * 1024 * 3072 + n;
        float a0 = 0.f, a1 = 0.f, a2 = 0.f, a3 = 0.f;
        const int k0 = wave * 128;
#pragma unroll 8
        for (int k = k0; k < k0 + 128; ++k) { const float w = W[(size_t)k * 3072]; a0 += sc[k] * w; a1 += sc[1024 + k] * w; a2 += sc[2048 + k] * w; a3 += sc[3072 + k] * w; }
        red[(wave * 4 + 0) * 64 + lane] = a0; red[(wave * 4 + 1) * 64 + lane] = a1; red[(wave * 4 + 2) * 64 + lane] = a2; red[(wave * 4 + 3) * 64 + lane] = a3;
        __syncthreads();
        if (wave < 4) { float s = 0.f;
#pragma unroll
            for (int w = 0; w < 8; ++w) s += red[(w * 4 + wave) * 64 + lane];
            MOD[(size_t)(l * 4 + wave) * 3072 + n] = s + P.mod_b[l * 3072 + n]; }
        __syncthreads();
    }
}
__device__ __forceinline__ void p0_rope(const Params& P, int tid, int bid, int G) {
    unsigned* rope = (unsigned*)(P.ws + WS_ROPE);
    const int gt = bid * 512 + tid, NT = G * 512;
    for (int idx = gt; idx < MT * 128; idx += NT) {
        const int row = idx >> 7, d = idx & 127;
        const float inv = powf(10000.0f, -(float)d * (1.0f / 128.0f));
        const float ang = (float)P.pos[row] * inv;
        double t = (double)ang * 0.15915494309189535; t -= rint(t);
        const float fr = (float)t;
        const float co = __builtin_amdgcn_cosf(fr), si = __builtin_amdgcn_sinf(fr);
        const unsigned lo = __builtin_bit_cast(unsigned short, (_Float16)co), hi = __builtin_bit_cast(unsigned short, (_Float16)si);
        rope[idx] = lo | (hi << 16);
    }
}

template <int KIND>
__device__ __forceinline__ void h_phase(const Params& P, int layer, const float* xin, LAS unsigned char* lds, int tid, int bid, int G) {
    const int lane = tid & 63, wave = tid >> 6;
    LAS float* WxT = (LAS float*)lds;
    LAS float* W2 = (LAS float*)(lds + 65536);
    LAS float* TOT = (LAS float*)(lds + 98304);
    const float* MOD = (const float*)(P.ws + WS_MOD);
    bf16_t* XN = (bf16_t*)(P.ws + WS_XN);
    if (KIND > 0) {
        const float* wsrc = (KIND == 1) ? (P.fox_w_in + 4096) : (P.gla_w_in + 3072); const int ldw = (KIND == 1) ? FOX_IN : GLA_IN;
        {
            float wv[32];
#pragma unroll
            for (int it = 0; it < 32; ++it) { const int idx = tid + 512 * it; wv[it] = wsrc[(size_t)(idx >> 4) * ldw + (idx & 15)]; }
#pragma unroll
            for (int it = 0; it < 32; ++it) { const int idx = tid + 512 * it; WxT[(idx & 15) * 1024 + (idx >> 4)] = wv[it]; }
        }
        if (KIND == 2) {
            float w2v[16];
#pragma unroll
            for (int it = 0; it < 16; ++it) w2v[it] = P.gla_w_gate2[tid + 512 * it];
#pragma unroll
            for (int it = 0; it < 16; ++it) W2[tid + 512 * it] = w2v[it];
        }
        __syncthreads();
    }
    for (int ci = bid; ci < MT / 64; ci += G) {
        const int b = ci >> 6;
        if (KIND != 1) ((float*)(P.ws + WS_S16))[ci * 512 + tid] = 0.f;
        const float* mod = MOD + (size_t)(layer * 4 + b) * 3072;
        f32x4 ga[4], sh[4];
#pragma unroll
        for (int j = 0; j < 4; ++j) { const int col = 4 * lane + 256 * j;
            const f32x4 g4 = *(const f32x4*)(P.norm_g + layer * 1024 + col), s4 = *(const f32x4*)(mod + 1024 + col);
            ga[j] = g4 * (s4 + 1.0f); sh[j] = *(const f32x4*)(mod + col); }
        float run[8]; f32x4 cbv[8][2];
        if (KIND == 2) {
#pragma unroll
            for (int c = 0; c < 8; ++c) run[c] = 0.f;
        }
        if constexpr (false) {
        constexpr int BS = (KIND == 2) ? 2 : 4;
#pragma unroll (KIND == 2 ? 8 / BS : 1)
        for (int rb = 0; rb < 8; rb += BS) {
            asm volatile("" ::: "memory");
            f32x4 xv[BS][4];
#pragma unroll
            for (int bb = 0; bb < BS; ++bb) { const f32x4* xr = (const f32x4*)(xin + (size_t)(ci * 64 + wave * 8 + rb + bb) * 1024) + lane;
#pragma unroll
                for (int j = 0; j < 4; ++j) xv[bb][j] = xr[64 * j]; }
#pragma unroll
        for (int bb = 0; bb < BS; ++bb) {
            const int rr = rb + bb;
            asm volatile("" ::: "memory");
            const int row = ci * 64 + wave * 8 + rr;
            f32x4 v[4]; float ss = 0.f;
#pragma unroll
            for (int j = 0; j < 4; ++j) { v[j] = xv[bb][j]; ss += (v[j][0] * v[j][0] + v[j][1] * v[j][1]) + (v[j][2] * v[j][2] + v[j][3] * v[j][3]); }
            const float rstd = rsqrtf(wave_sum(ss) * (1.0f / 1024.0f) + EPS);
#pragma unroll
            for (int j = 0; j < 4; ++j) { v[j] = (v[j] * rstd) * ga[j] + sh[j]; *(u32x2*)(XN + (size_t)row * 1024 + 4 * lane + 256 * j) = pk4(v[j]); }
            if (KIND > 0) {
                float r[16];
#pragma unroll
                for (int i = 0; i < 16; ++i) { float a = 0.f;
#pragma unroll
                    for (int j = 0; j < 4; ++j) { const f32x4 w = *(const LAS f32x4*)(WxT + i * 1024 + 4 * lane + 256 * j); a += (v[j][0] * w[0] + v[j][1] * w[1]) + (v[j][2] * w[2] + v[j][3] * w[3]); }
                    r[i] = a; }
                if (KIND == 1) {
                    const float e1 = reduce_scatter16(r, lane);
                    const int idx = ((lane >> 5) & 1) * 8 + ((lane >> 4) & 1) * 4 + ((lane >> 3) & 1) * 2 + ((lane >> 2) & 1);
                    if ((lane & 3) == 0) ((float*)(P.ws + WS_S16))[(size_t)row * 16 + idx] = logsig_f(e1 + P.fox_b_f[idx]);
                } else {
                    f32x4 z0 = *(const f32x4*)(P.gla_b_gate + 8 * lane), z1 = *(const f32x4*)(P.gla_b_gate + 8 * lane + 4);
#pragma unroll
                    for (int i = 0; i < 16; ++i) { const f32x4 w0 = *(const LAS f32x4*)(W2 + i * 512 + 8 * lane), w1 = *(const LAS f32x4*)(W2 + i * 512 + 8 * lane + 4); z0 += w0 * r[i]; z1 += w1 * r[i]; }
#pragma unroll
                    for (int c = 0; c < 4; ++c) { run[c] += logsig_f(z0[c]) * 0.0625f; run[4 + c] += logsig_f(z1[c]) * 0.0625f; }
                    cbv[rr][0] = (f32x4){run[0], run[1], run[2], run[3]}; cbv[rr][1] = (f32x4){run[4], run[5], run[6], run[7]};
                }
            }
        }
        }
        } else {
        constexpr int BS = (KIND == 2) ? 2 : 4;
#pragma unroll (KIND != 0 ? 8 / BS : 1)
        for (int rb = 0; rb < 8; rb += BS) {
            asm volatile("" ::: "memory");
            f32x4 v[BS][4];
#pragma unroll
            for (int bb = 0; bb < BS; ++bb) { const f32x4* xr = (const f32x4*)(xin + (size_t)(ci * 64 + wave * 8 + rb + bb) * 1024) + lane;
#pragma unroll
                for (int j = 0; j < 4; ++j) v[bb][j] = xr[64 * j]; }
#pragma unroll
            for (int bb = 0; bb < BS; ++bb) {
                const int row = ci * 64 + wave * 8 + rb + bb; float ss = 0.f;
#pragma unroll
                for (int j = 0; j < 4; ++j) ss += (v[bb][j][0] * v[bb][j][0] + v[bb][j][1] * v[bb][j][1]) + (v[bb][j][2] * v[bb][j][2] + v[bb][j][3] * v[bb][j][3]);
                const float rstd = rsqrtf(wave_sum(ss) * (1.0f / 1024.0f) + EPS);
#pragma unroll
                for (int j = 0; j < 4; ++j) { v[bb][j] = (v[bb][j] * rstd) * ga[j] + sh[j]; *(u32x2*)(XN + (size_t)row * 1024 + 4 * lane + 256 * j) = pk4(v[bb][j]); }
            }
            if (KIND > 0) {
                float acc[BS][16];
#pragma unroll
                for (int i = 0; i < 16; ++i) {
                    f32x4 w[4];
#pragma unroll
                    for (int j = 0; j < 4; ++j) w[j] = *(const LAS f32x4*)(WxT + i * 1024 + 4 * lane + 256 * j);
#pragma unroll
                    for (int bb = 0; bb < BS; ++bb) { float a = 0.f;
#pragma unroll
                        for (int j = 0; j < 4; ++j) a += (v[bb][j][0] * w[j][0] + v[bb][j][1] * w[j][1]) + (v[bb][j][2] * w[j][2] + v[bb][j][3] * w[j][3]);
                        acc[bb][i] = a; }
                    if (i & 1) { __builtin_amdgcn_sched_barrier(0); asm volatile("" ::: "memory"); }
                }
#pragma unroll
                for (int bb = 0; bb < BS; ++bb) {
                    const int rr = rb + bb, row = ci * 64 + wave * 8 + rr;
                    asm volatile("" ::: "memory");
                    const float e1 = reduce_scatter16(acc[bb], lane);
                    if (KIND == 1) {
                        const int idx = ((lane >> 5) & 1) * 8 + ((lane >> 4) & 1) * 4 + ((lane >> 3) & 1) * 2 + ((lane >> 2) & 1);
                        ((float*)(P.ws + WS_S16))[(size_t)row * 16 + idx] = logsig_f(e1 + P.fox_b_f[idx]);
                    } else {
                        float r[16];
#pragma unroll
                        for (int i = 0; i < 16; ++i) r[i] = __builtin_bit_cast(float, __builtin_amdgcn_readlane(__builtin_bit_cast(int, e1), ((i >> 3) & 1) * 32 + ((i >> 2) & 1) * 16 + ((i >> 1) & 1) * 8 + (i & 1) * 4));
                        f32x4 z0 = *(const f32x4*)(P.gla_b_gate + 8 * lane), z1 = *(const f32x4*)(P.gla_b_gate + 8 * lane + 4);
#pragma unroll
                        for (int i = 0; i < 16; ++i) { const f32x4 w0 = *(const LAS f32x4*)(W2 + i * 512 + 8 * lane), w1 = *(const LAS f32x4*)(W2 + i * 512 + 8 * lane + 4); z0 += w0 * r[i]; z1 += w1 * r[i]; }
#pragma unroll
                        for (int c = 0; c < 4; ++c) { run[c] += logsig_f(z0[c]) * 0.0625f; run[4 + c] += logsig_f(z1[c]) * 0.0625f; }
                        cbv[rr][0] = (f32x4){run[0], run[1], run[2], run[3]}; cbv[rr][1] = (f32x4){run[4], run[5], run[6], run[7]};
                    }
                }
            }
        }
        }
        if (KIND == 2) {
            float* CB = (float*)(P.ws + WS_ACT + 160 * MiB);
            *(LAS f32x4*)(TOT + wave * 512 + 8 * lane) = (f32x4){run[0], run[1], run[2], run[3]};
            *(LAS f32x4*)(TOT + wave * 512 + 8 * lane + 4) = (f32x4){run[4], run[5], run[6], run[7]};
            __syncthreads();
            f32x4 o0 = (f32x4){0.f, 0.f, 0.f, 0.f}, o1 = o0;
            for (int w = 0; w < wave; ++w) { o0 += *(const LAS f32x4*)(TOT + w * 512 + 8 * lane); o1 += *(const LAS f32x4*)(TOT + w * 512 + 8 * lane + 4); }
#pragma unroll
            for (int rr = 0; rr < 8; ++rr) { const int row = ci * 64 + wave * 8 + rr;
                *(f32x4*)(CB + (size_t)row * 512 + 8 * lane) = cbv[rr][0] + o0; *(f32x4*)(CB + (size_t)row * 512 + 8 * lane + 4) = cbv[rr][1] + o1; }
            __syncthreads();
        }
    }
}

template <int KIND> struct LinCfg {
    static constexpr int DK = KIND == 0 ? 256 : 128, QP = KIND == 0 ? 1024 : 512, VP = KIND == 0 ? 2048 : 1024, HV = KIND == 0 ? 512 : 256;
    static constexpr int NSL = HV / 32, NITEM = 16 * NSL, NKF = DK / 32, RW = DK / 8, NDT = RW / 16, KPITCH = DK * 2 + 32, STP = DK + 8, KCH = DK / 64;
    static constexpr int LDS_ST = 0, LDS_K = 2 * 32 * STP * 2, LDS_P = LDS_K + 2 * 64 * KPITCH, LDS_V = LDS_P + 2 * 8192, LDS_END = LDS_V + 2 * 2 * 4096;
};
__device__ __forceinline__ float ret_log2g(int h) { return (h == 0) ? -0.045803689613124796f : (h == 1) ? -0.02272007650008353f : (h == 2) ? -0.011315313227834146f : -0.005646563141142062f; }

template <int KIND>
__device__ __forceinline__ void lin_pphase(const bf16_t* Qa, const bf16_t* Ka, const bf16_t* Qb, const bf16_t* Kb2, bf16_t* Pimg, int tid, int bid, int G) {
    typedef LinCfg<KIND> C;
    const int lane = tid & 63, wave = __builtin_amdgcn_readfirstlane(tid >> 6);
    for (int hw = bid * 8 + wave; hw < 2048; hw += G * 8) {
        const int item = hw >> 1, half = hw & 1;
        const int bh = item >> 6, n = item & 63, b = bh >> 2, h = bh & 3;
        const size_t t0 = (size_t)b * SEQ + (size_t)n * 64;
        f32x4 pa[2][4], pb[2][4];
#pragma unroll
        for (int r = 0; r < 2; ++r)
#pragma unroll
            for (int c = 0; c < 4; ++c) { pa[r][c] = (f32x4){0.f, 0.f, 0.f, 0.f}; pb[r][c] = (f32x4){0.f, 0.f, 0.f, 0.f}; }
        const bf16_t* qa = Qa + (t0 + 32 * half) * C::QP + h * C::DK; const bf16_t* ka = Ka + t0 * C::QP + h * C::DK;
        const bf16_t* qb = Qb + (t0 + 32 * half) * C::QP + h * C::DK; const bf16_t* kb = Kb2 + t0 * C::QP + h * C::DK;
#pragma unroll 2
        for (int k = 0; k < C::NKF; ++k) {
            bf16x8 af[2], bfr[4];
#pragma unroll
            for (int r = 0; r < 2; ++r) af[r] = gfrag(qa + (size_t)(16 * r) * C::QP + 32 * k, C::QP, lane);
#pragma unroll
            for (int c = 0; c < 4; ++c) bfr[c] = gfrag(ka + (size_t)(16 * c) * C::QP + 32 * k, C::QP, lane);
#pragma unroll
            for (int r = 0; r < 2; ++r)
#pragma unroll
                for (int c = 0; c < 4; ++c) pa[r][c] = mma_rc(pa[r][c], af[r], bfr[c]);
            if (KIND == 1) {
#pragma unroll
                for (int r = 0; r < 2; ++r) af[r] = gfrag(qb + (size_t)(16 * r) * C::QP + 32 * k, C::QP, lane);
#pragma unroll
                for (int c = 0; c < 4; ++c) bfr[c] = gfrag(kb + (size_t)(16 * c) * C::QP + 32 * k, C::QP, lane);
#pragma unroll
                for (int r = 0; r < 2; ++r)
#pragma unroll
                    for (int c = 0; c < 4; ++c) pb[r][c] = mma_rc(pb[r][c], af[r], bfr[c]);
            }
        }
        const int g4 = lane >> 4;
        const float l2g = (KIND == 0) ? ret_log2g(h) : 0.f;
#pragma unroll
        for (int r = 0; r < 2; ++r) {
            const int c = 32 * half + 16 * r + (lane & 15);
#pragma unroll
            for (int ct = 0; ct < 4; ++ct) {
                f32x4 p;
#pragma unroll
                for (int e = 0; e < 4; ++e) { const int mm = 16 * ct + 4 * g4 + e;
                    if (KIND == 0) { const int dd = c > mm ? c - mm : mm - c; p[e] = pa[r][ct][e] * exp2f(l2g * (float)dd); }
                    else p[e] = (c >= mm) ? pa[r][ct][e] : pb[r][ct][e]; }
                const int ks = ct >> 1, gg = 2 * (ct & 1) + (g4 & 1);
                const int off = c * 128 + (((4 * ks + gg) ^ (c & 7)) << 4) + 8 * (g4 >> 1);
                *(u32x2*)((char*)Pimg + (size_t)item * 8192 + off) = pk4(p);
            }
        }
    }
}

typedef short v4i16_t __attribute__((ext_vector_type(4)));
__device__ __forceinline__ bf16x8 trfrag2(const LAS char* p0, int second_off) {
    const v4i16_t a = __builtin_amdgcn_ds_read_tr16_b64_v4i16((LAS v4i16_t*)p0);
    const v4i16_t b = __builtin_amdgcn_ds_read_tr16_b64_v4i16((LAS v4i16_t*)(p0 + second_off));
    return (bf16x8){a[0], a[1], a[2], a[3], b[0], b[1], b[2], b[3]};
}

template <int KIND> struct LsStage { u32x4 x[LinCfg<KIND>::NKF]; u32x4 p; u32x2 v; f32x4 dec; };

template <int KIND, int VAR = 0>
__device__ __forceinline__ void lin_scan(const bf16_t* Qg, const bf16_t* Kg, const bf16_t* Vg, const bf16_t* Pimg, const float* CB, bf16_t* O, float* DUMMY, LAS unsigned char* lds, int tid, int bid, int G) {
    typedef LinCfg<KIND> C;
    const int lane = tid & 63, wave = __builtin_amdgcn_readfirstlane(tid >> 6);
    const int g4 = lane >> 4, i16 = lane & 15, q4 = i16 >> 2, p4 = i16 & 3;
    const int nit = (G == 256) ? 1 : (C::NITEM + G - 1) / G;
    for (int it = 0; it < nit; ++it) {
        int item;
        if (G == 256) { const int x = bid & 7, j = bid >> 3; if (KIND == 0) item = x * 32 + j; else { if (j >= 16) break; item = x * 16 + j; } }
        else { item = it * G + bid; if (item >= C::NITEM) break; }
        const int bh = item / C::NSL, dvs = item % C::NSL, b = bh >> 2, h = bh & 3;
        const size_t t0 = (size_t)b * SEQ;
        const int rt = wave & 3; const bool rdw = wave < 4;
        const float l2g = (KIND == 0) ? ret_log2g(h) : 0.f;
        const float qsc = (KIND == 0) ? exp2f(l2g * (float)(16 * rt + i16 + 1)) : 1.0f;
        const float sdec = (KIND == 0) ? exp2f(l2g * 64.0f) : 1.0f;
        const int vm = tid >> 3, vp8 = tid & 7;
        const float vsc = (KIND == 0) ? exp2f(l2g * (float)(63 - vm)) : 1.0f;
        constexpr int CPT = C::DK / 8, KTS = 256 / CPT;
        const int tq = tid & 255, ktok = tq / CPT, kch = tq % CPT;
        const bf16_t* xbase = rdw ? Qg + (t0 + 16 * rt + i16) * C::QP + h * C::DK + 8 * g4 : Kg + (t0 + ktok) * C::QP + h * C::DK + 8 * kch;
        const int xstride = rdw ? 32 : KTS * C::QP;
        const bf16_t* vbase = Vg + (t0 + vm) * C::VP + h * C::HV + 32 * dvs + 4 * vp8;
        bf16_t* obase = O + (t0 + vm) * C::VP + h * C::HV + 32 * dvs + 4 * vp8;
        bf16_t* odummy = (bf16_t*)DUMMY + ((size_t)bid * 512 + tid) * 4;
        const bf16_t* pbase = Pimg + ((size_t)bh * 64) * 4096 + (size_t)tid * 8;
        LAS bf16_t* ST = (LAS bf16_t*)(lds + C::LDS_ST);
        LAS char* KI = (LAS char*)(lds + C::LDS_K);
        LAS char* PI = (LAS char*)(lds + C::LDS_P);
        LAS char* VI = (LAS char*)(lds + C::LDS_V);
        LAS char* OT = (LAS char*)(lds + C::LDS_END);
        const int trow = 16 * (g4 >> 1) + 4 * (g4 & 1) + q4;
        const int koff = trow * C::KPITCH + (C::RW * wave + 4 * p4) * 2;
        const int voff = trow * 32 + 8 * p4;
        const int poff_row = (16 * rt + i16) * 128, psw = (16 * rt + i16) & 7;

        LsStage<KIND> A, B;
#define LS_LOAD(S, nn) do { const int n_ = (nn) < 64 ? (nn) : 63; \
            if (!((VAR & 1) && (nn) >= 2)) { _Pragma("unroll") for (int k_ = 0; k_ < C::NKF; ++k_) S.x[k_] = *(const u32x4*)(xbase + (size_t)n_ * 64 * C::QP + k_ * xstride); } \
            S.p = *(const u32x4*)(pbase + (size_t)n_ * 4096); \
            S.v = *(const u32x2*)(vbase + (size_t)n_ * 64 * C::VP); \
            if (KIND == 1) S.dec = *(const f32x4*)(CB + (t0 + (size_t)n_ * 64 + 63) * 512 + h * 128 + 16 * wave + 4 * g4); } while (0)
#define LS_WRITE(S, img) do { \
            if (!rdw) { _Pragma("unroll") for (int k_ = 0; k_ < C::NKF; ++k_) *(LAS u32x4*)(KI + (img) * 64 * C::KPITCH + (ktok + KTS * k_) * C::KPITCH + kch * 16) = S.x[k_]; } \
            *(LAS u32x4*)(PI + (img) * 8192 + tid * 16) = S.p; \
            { LAS char* vd_ = VI + (img) * 8192 + (vp8 >> 2) * 2048 + vm * 32 + (vp8 & 3) * 8; *(LAS u32x2*)vd_ = S.v; \
              if (KIND == 0) { u32x2 w_; w_.x = pk2(bf2f(S.v.x & 0xffffu) * vsc, bf2f(S.v.x >> 16) * vsc); w_.y = pk2(bf2f(S.v.y & 0xffffu) * vsc, bf2f(S.v.y >> 16) * vsc); *(LAS u32x2*)(vd_ + 4096) = w_; } } } while (0)

        for (int i = tid; i < 32 * C::STP / 2; i += 512) ((LAS unsigned*)ST)[i] = 0u;
        f32x4 s[C::NDT][2];
#pragma unroll
        for (int a = 0; a < C::NDT; ++a)
#pragma unroll
            for (int e = 0; e < 2; ++e) s[a][e] = (f32x4){0.f, 0.f, 0.f, 0.f};
        LS_LOAD(A, 0); LS_LOAD(B, 1);
        LS_WRITE(A, 0);
        __syncthreads();

#define LS_STEP(n, SC, SN) do { const int img_ = (n) & 1; \
            const f32x4 dcur_ = SC.dec; \
              \
            if (rdw && !(VAR & 16)) { \
                const LAS bf16_t* STc_ = ST + img_ * 32 * C::STP; \
                  \
                _Pragma("unroll") for (int ct_ = 0; ct_ < 2; ++ct_) { \
                    constexpr int HB_ = C::NKF / 2; bf16x8 sb_[HB_], pf_[2], vf_[2]; \
                    f32x4 o0_ = (f32x4){0.f, 0.f, 0.f, 0.f}, o1_ = o0_; \
                    _Pragma("unroll") for (int k_ = 0; k_ < HB_; ++k_) sb_[k_] = lfrag(STc_ + 16 * ct_ * C::STP + 32 * k_, C::STP, lane); \
                    __builtin_amdgcn_sched_barrier(0); \
                    _Pragma("unroll") for (int k_ = 0; k_ < HB_; k_ += 2) { o0_ = mma_rc(o0_, __builtin_bit_cast(bf16x8, SC.x[k_]), sb_[k_]); o1_ = mma_rc(o1_, __builtin_bit_cast(bf16x8, SC.x[k_ + 1]), sb_[k_ + 1]); } \
                    __builtin_amdgcn_sched_barrier(0); \
                    _Pragma("unroll") for (int k_ = 0; k_ < HB_; ++k_) sb_[k_] = lfrag(STc_ + 16 * ct_ * C::STP + 32 * (HB_ + k_), C::STP, lane); \
                    _Pragma("unroll") for (int ks_ = 0; ks_ < 2; ++ks_) { \
                        pf_[ks_] = *(const LAS bf16x8*)(PI + img_ * 8192 + poff_row + (((4 * ks_ + g4) ^ psw) << 4)); \
                        vf_[ks_] = trfrag2(VI + img_ * 8192 + ct_ * 2048 + ks_ * 1024 + voff, 256); } \
                    __builtin_amdgcn_sched_barrier(0); \
                    _Pragma("unroll") for (int k_ = 0; k_ < HB_; k_ += 2) { o0_ = mma_rc(o0_, __builtin_bit_cast(bf16x8, SC.x[HB_ + k_]), sb_[k_]); o1_ = mma_rc(o1_, __builtin_bit_cast(bf16x8, SC.x[HB_ + k_ + 1]), sb_[k_ + 1]); } \
                    f32x4 oa_ = (o0_ + o1_) * qsc; \
                    _Pragma("unroll") for (int ks_ = 0; ks_ < 2; ++ks_) oa_ = mma_rc(oa_, pf_[ks_], vf_[ks_]); \
                    *(LAS u32x2*)(OT + img_ * 4608 + (16 * rt + i16) * 72 + (16 * ct_ + 4 * g4) * 2) = pk4(oa_); \
                    __builtin_amdgcn_sched_barrier(0); } } \
              \
            { const u32x2 ov_ = *(const LAS u32x2*)(OT + (img_ ^ 1) * 4608 + vm * 72 + vp8 * 8); \
              bf16_t* od_ = (n) > 0 ? obase + (size_t)((n) - 1) * 64 * C::VP : odummy; \
              *(u32x2*)od_ = ov_; } \
              \
            LS_LOAD(SC, (n) + 2); \
              \
            if (KIND == 0) { _Pragma("unroll") for (int a_ = 0; a_ < C::NDT; ++a_) _Pragma("unroll") for (int e_ = 0; e_ < 2; ++e_) s[a_][e_] = s[a_][e_] * sdec; } \
            if (!(VAR & 4)) _Pragma("unroll") for (int ks_ = 0; ks_ < 2; ++ks_) { bf16x8 kf_[C::NDT], vf_[2]; \
                _Pragma("unroll") for (int a_ = 0; a_ < C::NDT; ++a_) kf_[a_] = trfrag2(KI + img_ * 64 * C::KPITCH + ks_ * 32 * C::KPITCH + a_ * 32 + koff, 8 * C::KPITCH); \
                _Pragma("unroll") for (int e_ = 0; e_ < 2; ++e_) vf_[e_] = trfrag2(VI + img_ * 8192 + (KIND == 0 ? 4096 : 0) + e_ * 2048 + ks_ * 1024 + voff, 256); \
                _Pragma("unroll") for (int a_ = 0; a_ < C::NDT; ++a_) _Pragma("unroll") for (int e_ = 0; e_ < 2; ++e_) s[a_][e_] = mma_cr(s[a_][e_], kf_[a_], vf_[e_]); } \
            if (KIND == 1) { f32x4 dc_; _Pragma("unroll") for (int r_ = 0; r_ < 4; ++r_) dc_[r_] = __expf(dcur_[r_]); \
                _Pragma("unroll") for (int e_ = 0; e_ < 2; ++e_) s[0][e_] = s[0][e_] * dc_; } \
              \
            { LAS bf16_t* STn_ = ST + (img_ ^ 1) * 32 * C::STP; \
              _Pragma("unroll") for (int a_ = 0; a_ < C::NDT; ++a_) _Pragma("unroll") for (int e_ = 0; e_ < 2; ++e_) \
                  *(LAS u32x2*)(STn_ + (16 * e_ + i16) * C::STP + C::RW * wave + 16 * a_ + 4 * g4) = pk4(s[a_][e_]); } \
              \
            LS_WRITE(SN, img_ ^ 1); \
            asm volatile("s_waitcnt lgkmcnt(0)" ::: "memory"); __builtin_amdgcn_s_barrier(); asm volatile("" ::: "memory"); } while (0)

        for (int n = 0; n < 64; n += 2) { LS_STEP(n, A, B); LS_STEP(n + 1, B, A); }
        *(u32x2*)(obase + (size_t)63 * 64 * C::VP) = *(const LAS u32x2*)(OT + 4608 + vm * 72 + vp8 * 8);
        __syncthreads();
#undef LS_LOAD
#undef LS_WRITE
#undef LS_STEP
    }
}


template <int KIND>
__device__ __forceinline__ void lin_stats(const bf16_t* O, float* STATS, int tid, int bid, int G) {
    const int lane = tid & 63, wave = tid >> 6;
    const int gw = bid * 8 + wave, NGW = G * 8;
    constexpr int NJ = KIND == 0 ? 4 : 2, PITCH = KIND == 0 ? 2048 : 1024, RB = 4;
    for (int row0 = gw; row0 < MT; row0 += RB * NGW) {
        u32x4 w[RB][NJ];
#pragma unroll
        for (int rb = 0; rb < RB; ++rb) { const int row = row0 + rb * NGW < MT ? row0 + rb * NGW : row0;
#pragma unroll
            for (int j = 0; j < NJ; ++j) w[rb][j] = *(const u32x4*)(O + (size_t)row * PITCH + 512 * j + 8 * lane); }
#pragma unroll
        for (int rb = 0; rb < RB; ++rb) { const int row = row0 + rb * NGW; if (row >= MT) break;
#pragma unroll
            for (int j = 0; j < NJ; ++j) {
                float sm = 0.f, sq = 0.f;
#pragma unroll
                for (int i = 0; i < 4; ++i) { const float a = bf2f(w[rb][j][i] & 0xffffu), b = bf2f(w[rb][j][i] >> 16); sm += a + b; sq += a * a + b * b; }
                if (KIND == 0) { sm = wave_sum(sm); sq = wave_sum(sq); if (lane == 0) *(f32x2*)(STATS + (size_t)row * 8 + 2 * j) = (f32x2){sm, sq}; }
                else {
#pragma unroll
                    for (int o = 1; o < 32; o <<= 1) sq += __shfl_xor(sq, o);
                    if ((lane & 31) == 0) *(f32x2*)(STATS + (size_t)row * 8 + 2 * (2 * j + (lane >> 5))) = (f32x2){0.f, sq}; }
            }
        }
    }
}

template <int KIND> struct EpiGateNorm {
    static constexpr bool PERM = false;
    bf16_t* O; const float* STATS; LAS float* tbl;
    __device__ __forceinline__ void operator()(const f32x4 (&acc)[2][2][4][2], const pg8::Unit& u, int wr, int wc, int fr, int fq) const {
        constexpr int N = KIND == 0 ? 2048 : 1024; constexpr float INV = KIND == 0 ? 1.0f / 512.0f : 1.0f / 256.0f;
        const int head = KIND == 0 ? (u.pn >> 1) : u.pn;
        if (KIND == 0) {
            if ((u.pn & 1) == 0) {
                LAS f32x2* tb2 = (LAS f32x2*)tbl;
#pragma unroll
                for (int ai = 0; ai < 2; ++ai)
#pragma unroll
                    for (int m = 0; m < 4; ++m) { const int rl = ai * 128 + wr * 64 + m * 16 + fr; const int row = u.pm * 256 + rl; float sm = 0.f, sq = 0.f;
                        const bf16_t* prow = O + (size_t)row * N + u.pn * 256 + wc * 32 + fq * 4;
#pragma unroll
                        for (int tt = 0; tt < 2; ++tt) {
                            const u32x2 w0 = *(const u32x2*)(prow + tt * 256), w1 = *(const u32x2*)(prow + tt * 256 + 16), w2 = *(const u32x2*)(prow + tt * 256 + 128), w3 = *(const u32x2*)(prow + tt * 256 + 144);
                            const f32x4 o0 = unpk4(w0), o1 = unpk4(w1), o2 = unpk4(w2), o3 = unpk4(w3);
                            const f32x4 ss = (o0 + o1) + (o2 + o3), qq = (o0 * o0 + o1 * o1) + (o2 * o2 + o3 * o3);
                            sm += (ss[0] + ss[1]) + (ss[2] + ss[3]); sq += (qq[0] + qq[1]) + (qq[2] + qq[3]);
                            asm volatile("" ::: "memory"); }
                        sm = xsum_16_32(sm); sq = xsum_16_32(sq);
                        if (fq == 0) tb2[rl * 4 + wc] = (f32x2){sm, sq};
                        asm volatile("" ::: "memory"); }
                asm volatile("s_waitcnt lgkmcnt(0)" ::: "memory"); __builtin_amdgcn_s_barrier(); asm volatile("" ::: "memory");
            }
#pragma unroll
            for (int ai = 0; ai < 2; ++ai)
#pragma unroll
            for (int mh = 0; mh < 2; ++mh) {
                u32x2 ov[2][2][2];
#pragma unroll
                for (int mm = 0; mm < 2; ++mm) { const int row = u.pm * 256 + ai * 128 + wr * 64 + (2 * mh + mm) * 16 + fr;
#pragma unroll
                    for (int bj = 0; bj < 2; ++bj)
#pragma unroll
                        for (int n = 0; n < 2; ++n) ov[mm][bj][n] = *(const u32x2*)(O + (size_t)row * N + u.pn * 256 + bj * 128 + wc * 32 + n * 16 + fq * 4); }
                asm volatile("" ::: "memory");
#pragma unroll
                for (int mm = 0; mm < 2; ++mm) { const int m = 2 * mh + mm; const int rl = ai * 128 + wr * 64 + m * 16 + fr; const int row = u.pm * 256 + rl;
                    const LAS f32x2* tb2 = (const LAS f32x2*)tbl + rl * 4;
                    const f32x2 p0 = tb2[0], p1 = tb2[1], p2 = tb2[2], p3 = tb2[3];
                    const float mean = ((p0.x + p1.x) + (p2.x + p3.x)) * INV, rstd = __builtin_amdgcn_rsqf(fmaxf(((p0.y + p1.y) + (p2.y + p3.y)) * INV - mean * mean, 0.f) + EPS);
#pragma unroll
                    for (int bj = 0; bj < 2; ++bj)
#pragma unroll
                        for (int n = 0; n < 2; ++n) {
                            const f32x4 o = unpk4(ov[mm][bj][n]), a = acc[ai][bj][m][n]; f32x4 r;
#pragma unroll
                            for (int j = 0; j < 4; ++j) r[j] = (o[j] - mean) * rstd * silu_f(a[j]);
                            *(u32x2*)(O + (size_t)row * N + u.pn * 256 + bj * 128 + wc * 32 + n * 16 + fq * 4) = pk4(r);
                        }
                }
                asm volatile("" ::: "memory");
            }
        } else {
#pragma unroll
            for (int ai = 0; ai < 2; ++ai)
#pragma unroll
                for (int m = 0; m < 4; ++m) { const int rl = ai * 128 + wr * 64 + m * 16 + fr; const int row = u.pm * 256 + rl; float sq = 0.f;
#pragma unroll
                    for (int bj = 0; bj < 2; ++bj)
#pragma unroll
                        for (int n = 0; n < 2; ++n) { const f32x4 o = unpk4(*(const u32x2*)(O + (size_t)row * N + u.pn * 256 + bj * 128 + wc * 32 + n * 16 + fq * 4)); sq += (o[0] * o[0] + o[1] * o[1]) + (o[2] * o[2] + o[3] * o[3]); }
                    sq = xsum_16_32(sq);
                    if (fq == 0) tbl[rl * 4 + wc] = sq; }
            asm volatile("s_waitcnt lgkmcnt(0)" ::: "memory"); __builtin_amdgcn_s_barrier(); asm volatile("" ::: "memory");
#pragma unroll
            for (int ai = 0; ai < 2; ++ai) {
                u32x2 ov[4][2][2];
#pragma unroll
                for (int m = 0; m < 4; ++m) { const int row = u.pm * 256 + ai * 128 + wr * 64 + m * 16 + fr;
#pragma unroll
                    for (int bj = 0; bj < 2; ++bj)
#pragma unroll
                        for (int n = 0; n < 2; ++n) ov[m][bj][n] = *(const u32x2*)(O + (size_t)row * N + u.pn * 256 + bj * 128 + wc * 32 + n * 16 + fq * 4); }
                asm volatile("" ::: "memory");
#pragma unroll
                for (int m = 0; m < 4; ++m) { const int rl = ai * 128 + wr * 64 + m * 16 + fr; const int row = u.pm * 256 + rl;
                    const f32x4 pr = *(const LAS f32x4*)(tbl + rl * 4);
                    const float rstd = __builtin_amdgcn_rsqf(((pr[0] + pr[1]) + (pr[2] + pr[3])) * INV + EPS);
#pragma unroll
                    for (int bj = 0; bj < 2; ++bj)
#pragma unroll
                        for (int n = 0; n < 2; ++n) {
                            const f32x4 o = unpk4(ov[m][bj][n]), a = acc[ai][bj][m][n]; f32x4 r;
#pragma unroll
                            for (int j = 0; j < 4; ++j) r[j] = o[j] * rstd * silu_f(a[j]);
                            *(u32x2*)(O + (size_t)row * N + u.pn * 256 + bj * 128 + wc * 32 + n * 16 + fq * 4) = pk4(r);
                        }
                }
                asm volatile("" ::: "memory");
            }
        }
    }
};

namespace attn_body {
using bf16=unsigned short;
using bf16x8=__attribute__((ext_vector_type(8)))short;
using s16x4=__attribute__((ext_vector_type(4)))short;
using f32x16=__attribute__((ext_vector_type(16)))float;
using u32x4=__attribute__((ext_vector_type(4)))unsigned;
constexpr int BATCH=4,NHEAD=16,SEQ=4096,D=64,DM=NHEAD*D;
constexpr int NW=8,QBLK=32,QB=QBLK*NW,KVBLK=64,NQB=SEQ/QB;
constexpr int ATTN_PITCH=DM, ATTN_UNIT_ROWS=QB;
__device__ __forceinline__ int crow(int r,int hi){return (r&3)+8*(r>>2)+4*hi;}
#define SBAR() __builtin_amdgcn_sched_barrier(0)
__device__ __forceinline__ void cmask(f32x16&p0,f32x16&p1,int jb,int qrel,int hi){
  const float NEG=-INFINITY; int kb=64*jb+4*hi;
  #pragma unroll
  for(int r=0;r<16;++r){int kv=kb+(r&3)+8*(r>>2); if(kv>qrel)p0[r]=NEG; if(kv+32>qrel)p1[r]=NEG;}
}

constexpr int NSLOT=3, SLOTB=8192;
constexpr int LDS_K=0, LDS_V=NSLOT*SLOTB, LDS_WS=2*NSLOT*SLOTB, LDS_OST=LDS_WS+NW*64*4, LDS_NC=LDS_OST+NW*4096, LDS_FT=LDS_NC+SEQ*4, LDS_RE=LDS_FT+256, LDS_BYTES=LDS_RE+256;
constexpr float C2=0.125f*1.4426950408889634f;
__device__ __forceinline__ void glds16(const void*gsrc,unsigned lds_dst){unsigned keep;
  asm volatile("s_mov_b32 %0, m0\n\ts_mov_b32 m0, %2\n\ts_nop 0\n\tglobal_load_lds_dwordx4 %1, off\n\ts_mov_b32 m0, %0":"=&s"(keep):"v"(gsrc),"s"(lds_dst):"memory");}
__device__ __forceinline__ float max3f(float a,float b,float c){float r;asm("v_max3_f32 %0, %1, %2, %3":"=v"(r):"v"(a),"v"(b),"v"(c));return r;}
__device__ __forceinline__ float max2f(float a,float b){float r;asm("v_max_f32_e32 %0, %1, %2":"=v"(r):"v"(a),"v"(b));return r;}
__device__ __forceinline__ float fadd_s(float a,float b){float r;asm("v_add_f32_e32 %0, %1, %2":"=v"(r):"v"(a),"v"(b));return r;}
__device__ __forceinline__ float fsub_s(float a,float b){float r;asm("v_sub_f32_e32 %0, %1, %2":"=v"(r):"v"(a),"v"(b));return r;}
typedef float f32x2_t __attribute__((ext_vector_type(2))); typedef __bf16 bf16x2_t __attribute__((ext_vector_type(2)));
__device__ __forceinline__ unsigned cvtpk_s(float lo,float hi){f32x2_t v={lo,hi};bf16x2_t b=__builtin_convertvector(v,bf16x2_t);return __builtin_bit_cast(unsigned,b);}
#define WAIT_BAR(N) asm volatile("s_waitcnt vmcnt(" #N ") lgkmcnt(0)\n\ts_barrier":::"memory")

__device__ __forceinline__ void qkt(f32x16&p0,f32x16&p1,const char*Kslot,const bf16x8*qr,const f32x16&negm,int r32,int hi){
  const char*kb=Kslot+hi*1024+r32*16;
  #pragma unroll
  for(int d0=0;d0<4;++d0){
    const bf16x8 b0=*reinterpret_cast<const bf16x8*>(kb+d0*2048);
    const bf16x8 b1=*reinterpret_cast<const bf16x8*>(kb+d0*2048+512);
    if(d0==0){p0=__builtin_amdgcn_mfma_f32_32x32x16_bf16(b0,qr[0],negm,0,0,0);p1=__builtin_amdgcn_mfma_f32_32x32x16_bf16(b1,qr[0],negm,0,0,0);}
    else{p0=__builtin_amdgcn_mfma_f32_32x32x16_bf16(b0,qr[d0],p0,0,0,0);p1=__builtin_amdgcn_mfma_f32_32x32x16_bf16(b1,qr[d0],p1,0,0,0);}}
}
typedef __attribute__((address_space(3))) const char* lds_cptr;
typedef short v4i16_t __attribute__((ext_vector_type(4)));
__device__ __forceinline__ void kload8(bf16x8*kf,lds_cptr kp){
  kf[0]=*(const __attribute__((address_space(3))) bf16x8*)(kp);      kf[1]=*(const __attribute__((address_space(3))) bf16x8*)(kp+512);
  kf[2]=*(const __attribute__((address_space(3))) bf16x8*)(kp+2048); kf[3]=*(const __attribute__((address_space(3))) bf16x8*)(kp+2560);
  kf[4]=*(const __attribute__((address_space(3))) bf16x8*)(kp+4096); kf[5]=*(const __attribute__((address_space(3))) bf16x8*)(kp+4608);
  kf[6]=*(const __attribute__((address_space(3))) bf16x8*)(kp+6144); kf[7]=*(const __attribute__((address_space(3))) bf16x8*)(kp+6656);
}
__device__ __forceinline__ void kload2(bf16x8*kf,lds_cptr kp,int j){ kf[2*j]=*(const __attribute__((address_space(3))) bf16x8*)(kp+j*2048); kf[2*j+1]=*(const __attribute__((address_space(3))) bf16x8*)(kp+j*2048+512); }
__device__ __forceinline__ s16x4 vtr(lds_cptr p){ return __builtin_bit_cast(s16x4,__builtin_amdgcn_ds_read_tr16_b64_v4i16((__attribute__((address_space(3))) v4i16_t*)p)); }
__device__ __forceinline__ float rowmax(const f32x16&p0,const f32x16&p1){
  float a=max3f(p0[0],p0[1],p1[0]),b=max3f(p0[2],p0[3],p1[1]);a=max3f(a,p1[2],p1[3]);
  #pragma unroll
  for(int r=4;r<16;r+=4){a=max3f(a,p0[r],p0[r+1]);b=max3f(b,p0[r+2],p0[r+3]);a=max3f(a,p1[r],p1[r+1]);b=max3f(b,p1[r+2],p1[r+3]);}
  const float m=max2f(a,b);
  auto rr=__builtin_amdgcn_permlane32_swap(__float_as_uint(m),__float_as_uint(m),false,false);
  return max2f(__uint_as_float(rr[0]),__uint_as_float(rr[1]));
}
__device__ __forceinline__ void pv(f32x16*o,int vb,bf16x8 pa0,bf16x8 pa1,bf16x8 pa2,bf16x8 pa3){
  #pragma unroll
  for(int d0=0;d0<2;++d0){s16x4 lo[4],hi[4];
    #pragma unroll
    for(int ks=0;ks<4;++ks){
      asm volatile("ds_read_b64_tr_b16 %0,%1 offset:%c2":"=&v"(lo[ks]):"v"(vb),"i"(d0*4096+ks*1024):"memory");
      asm volatile("ds_read_b64_tr_b16 %0,%1 offset:%c2":"=&v"(hi[ks]):"v"(vb),"i"(d0*4096+ks*1024+512):"memory");}
    asm volatile("s_waitcnt lgkmcnt(0)":::"memory");SBAR();
    #define PK(k) (bf16x8){lo[k][0],lo[k][1],lo[k][2],lo[k][3],hi[k][0],hi[k][1],hi[k][2],hi[k][3]}
    o[d0]=__builtin_amdgcn_mfma_f32_32x32x16_bf16(pa0,PK(0),o[d0],0,0,0);
    o[d0]=__builtin_amdgcn_mfma_f32_32x32x16_bf16(pa1,PK(1),o[d0],0,0,0);
    o[d0]=__builtin_amdgcn_mfma_f32_32x32x16_bf16(pa2,PK(2),o[d0],0,0,0);
    o[d0]=__builtin_amdgcn_mfma_f32_32x32x16_bf16(pa3,PK(3),o[d0],0,0,0);
    #undef PK
  }
}

#ifndef ATTN_STORE16
#define ATTN_STORE16(p,v) (*(u32x4*)(p)=(v))
#endif
template<int THRL> __device__ __forceinline__ void attn_unit(int b,int h,int qb,int ts,const bf16*Q,const bf16*__restrict__ K,const bf16*__restrict__ V,const bf16*__restrict__ Gt,bf16*O,char*shm,int tid){
  const int lane=tid&63,r32=lane&31,hi=lane>>5; const int wid=__builtin_amdgcn_readfirstlane(tid>>6);
  const long rowbase=(long)b*SEQ; const int q0=qb*QB;
  typedef __attribute__((address_space(3))) const float* lds_fptr; typedef float f32x4b __attribute__((ext_vector_type(4)));
  const lds_fptr ncum=(lds_fptr)((__attribute__((address_space(3))) const char*)shm+LDS_NC)+64*ts+4*hi;
  const lds_fptr ftp=(lds_fptr)((__attribute__((address_space(3))) const char*)shm+LDS_FT)+ts;
  const bf16*Qw=Q+(rowbase+q0+wid*QBLK)*DM+h*D;
  const bf16*Kh=K+(rowbase+(long)ts*KVBLK)*DM+h*D,*Vh=V+(rowbase+(long)ts*KVBLK)*DM+h*D;
  const unsigned lds0=(unsigned)(uintptr_t)shm;
  float*wsf=(float*)(shm+LDS_WS)+wid*64;
  const bf16*ksrc=Kh+(long)lane*DM+wid*8;
  const bf16*vsrc=Vh+(long)(16*(wid&3)+(lane>>2))*DM+(wid>>2)*32+(lane&3)*8;
  const unsigned kdst=lds0+LDS_K+wid*1024, vdst=lds0+LDS_V+wid*1024;
  #define DMA_K(t,slot) glds16(ksrc+(long)(t)*KVBLK*DM,(unsigned)__builtin_amdgcn_readfirstlane(kdst+(slot)))
  #define DMA_V(t,slot) glds16(vsrc+(long)(t)*KVBLK*DM,(unsigned)__builtin_amdgcn_readfirstlane(vdst+(slot)))
  const int vb0=(int)(lds0+LDS_V)+((lane>>4)&1)*32+(lane&3)*8+(4*hi+((lane&15)>>2))*64;
  const char*Kbase=shm+LDS_K; bf16x8 kf[8];
  const lds_cptr shm3=(lds_cptr)shm; const lds_cptr kp0=shm3+LDS_K+hi*1024+r32*16; const lds_cptr vp0=shm3+LDS_V+((lane>>4)&1)*32+(lane&3)*8+(4*hi+((lane&15)>>2))*64;
  const int NT=(q0+QB)/KVBLK-ts;
  DMA_K(0,0);DMA_V(0,0);DMA_K(1,SLOTB);
  bf16x8 qr[4];
  #pragma unroll
  for(int d0=0;d0<4;++d0)qr[d0]=*reinterpret_cast<const bf16x8*>(&Qw[(long)r32*DM+d0*16+hi*8]);
  float l_reg=0.f,fcur=1.f;f32x16 o[2];o[0]=f32x16{};o[1]=f32x16{};const f32x16 negm=f32x16{};
  const int qrel=wid*QBLK+r32;
  #define CMASK(P0,P1,t) do{int jb_=(t)-(NT-4); if(jb_>=0)cmask(P0,P1,jb_,qrel,hi);}while(0)
  #define LDSF4(p) (*(const __attribute__((address_space(3))) f32x4b*)(p))
  #define BIAS(P0,P1,t) do{ const lds_fptr nb_=ncum+64*(t); \
      { const f32x4b a0_=LDSF4(nb_), a1_=LDSF4(nb_+8), a2_=LDSF4(nb_+16), a3_=LDSF4(nb_+24); \
        _Pragma("unroll") for(int j_=0;j_<4;++j_){ P0[j_]+=a0_[j_]; P0[4+j_]+=a1_[j_]; P0[8+j_]+=a2_[j_]; P0[12+j_]+=a3_[j_]; } } SBAR(); \
      { const f32x4b b0_=LDSF4(nb_+32), b1_=LDSF4(nb_+40), b2_=LDSF4(nb_+48), b3_=LDSF4(nb_+56); \
        _Pragma("unroll") for(int j_=0;j_<4;++j_){ P1[j_]+=b0_[j_]; P1[4+j_]+=b1_[j_]; P1[8+j_]+=b2_[j_]; P1[12+j_]+=b3_[j_]; } } SBAR(); }while(0)
  #define START(P0,P1) do{ _Pragma("unroll") for(int r=0;r<16;++r)P0[r]=__builtin_amdgcn_exp2f(P0[r]); }while(0)
  #define RESC() do{ _Pragma("unroll") for(int d_=0;d_<2;++d_) _Pragma("unroll") for(int r=0;r<16;++r)o[d_][r]*=fcur; }while(0)
  f32x16 pA0,pA1,pB0,pB1;
  int sl_prev=0,sl_cur=0,sl_next=SLOTB;
  #define ROT() do{sl_prev=sl_cur;sl_cur=sl_next;sl_next=(sl_next==(NSLOT-1)*SLOTB)?0:sl_next+SLOTB;}while(0)
  DMA_K(2,2*SLOTB);
  WAIT_BAR(3);
  qkt(pA0,pA1,Kbase,qr,negm,r32,hi);asm volatile("s_nop 15\n\ts_nop 7":"+v"(pA0),"+v"(pA1));BIAS(pA0,pA1,0);CMASK(pA0,pA1,0);
  START(pA0,pA1);
  _Pragma("unroll") for(int r=0;r<16;++r)pA1[r]=__builtin_amdgcn_exp2f(pA1[r]);
  WAIT_BAR(0);
  DMA_K(3,0);DMA_V(1,SLOTB);
  ROT();
  kload8(kf,kp0+sl_cur);
  WAIT_BAR(2);
  s16x4 vlo[8],vhi[8]; u32x4 pw0,pw1,pw2,pw3;
  #define PKW(P,B) cvtpk_s(P[B],P[B+1])
  #define PAF(k) __builtin_bit_cast(bf16x8,pw##k)
  #define VFR(i) (bf16x8){vlo[i][0],vlo[i][1],vlo[i][2],vlo[i][3],vhi[i][0],vhi[i][1],vhi[i][2],vhi[i][3]}
  #define PIN(x) asm volatile("":"+v"(x))
  #define MX3(a,b,c) __builtin_fmaxf(__builtin_fmaxf((a),(b)),(c))
  #define GAPA(MF,A0,A1,A2,A3,W0,W1,PW) do{ MF; sacc+=A0; sacc+=A1; sacc+=A2; sacc+=A3; PIN(sacc); W0; W1; PIN(PW); SBAR(); }while(0)
  #define EX(v) __builtin_amdgcn_exp2f(v)
  #define GAPB(MF,X,B) do{ MF; X[B]=EX(X[B]); X[B+1]=EX(X[B+1]); X[B+2]=EX(X[B+2]); X[B+3]=EX(X[B+3]); PIN(X); SBAR(); }while(0)
  #define VRD(i) do{ vlo[i]=vtr(vp_+(((i)>>2)*4096+((i)&3)*1024)); vhi[i]=vtr(vp_+(((i)>>2)*4096+((i)&3)*1024+512)); }while(0)
  #define KRD(G,j) do{ if(G){ kload2(kf,kp0+sl_next,j); SBAR(); } }while(0)
  #define STEP(C0,C1,P0,P1,t,GK,GV,GL) do{ SBAR(); \
    const lds_cptr vp_=vp0+sl_prev; \
    VRD(0); SBAR(); float sacc=(P0[0]+P0[1]); \
    GAPA(C0=__builtin_amdgcn_mfma_f32_32x32x16_bf16(kf[0],qr[0],negm,0,0,0), P0[2],P0[3],P0[4],P0[5],     pw0[0]=PKW(P0,0), pw0[1]=PKW(P0,2), pw0); \
    VRD(4); SBAR(); GAPA(C1=__builtin_amdgcn_mfma_f32_32x32x16_bf16(kf[1],qr[0],negm,0,0,0), P0[6],P0[7],P0[8],P0[9],     pw0[2]=PKW(P0,4), pw0[3]=PKW(P0,6), pw0); \
    VRD(1); SBAR(); GAPA(C0=__builtin_amdgcn_mfma_f32_32x32x16_bf16(kf[2],qr[1],C0,0,0,0),   P0[10],P0[11],P0[12],P0[13], pw1[0]=PKW(P0,8), pw1[1]=PKW(P0,10), pw1); \
    VRD(5); SBAR(); GAPA(C1=__builtin_amdgcn_mfma_f32_32x32x16_bf16(kf[3],qr[1],C1,0,0,0),   P0[14],P0[15],P1[0],P1[1],   pw1[2]=PKW(P0,12),pw1[3]=PKW(P0,14), pw1); \
    VRD(2); SBAR(); GAPA(C0=__builtin_amdgcn_mfma_f32_32x32x16_bf16(kf[4],qr[2],C0,0,0,0),   P1[2],P1[3],P1[4],P1[5],     pw2[0]=PKW(P1,0), pw2[1]=PKW(P1,2), pw2); \
    VRD(6); SBAR(); GAPA(C1=__builtin_amdgcn_mfma_f32_32x32x16_bf16(kf[5],qr[2],C1,0,0,0),   P1[6],P1[7],P1[8],P1[9],     pw2[2]=PKW(P1,4), pw2[3]=PKW(P1,6), pw2); \
    VRD(3); SBAR(); GAPA(C0=__builtin_amdgcn_mfma_f32_32x32x16_bf16(kf[6],qr[3],C0,0,0,0),   P1[10],P1[11],P1[12],P1[13], pw3[0]=PKW(P1,8), pw3[1]=PKW(P1,10), pw3); \
    VRD(7); SBAR(); GAPA(C1=__builtin_amdgcn_mfma_f32_32x32x16_bf16(kf[7],qr[3],C1,0,0,0),   P1[14],P1[15],0.f,0.f,       pw3[2]=PKW(P1,12),pw3[3]=PKW(P1,14), pw3); \
    l_reg+=sacc; \
    if(GK){DMA_K((t)+3,sl_cur);} if(GV){DMA_V((t)+1,sl_next);} \
    BIAS(C0,C1,t); CMASK(C0,C1,t); \
    { const int jb2_=2*((t)-(NT-4)); fcur=(jb2_>wid)?1.0f:ftp[(t)]; l_reg*=fcur; } \
    SBAR(); \
    GAPB(o[0]=__builtin_amdgcn_mfma_f32_32x32x16_bf16(PAF(0),VFR(0),o[0],0,0,0), C0,0); \
    GAPB(o[1]=__builtin_amdgcn_mfma_f32_32x32x16_bf16(PAF(0),VFR(4),o[1],0,0,0), C0,4); \
    KRD(GL,0); GAPB(o[0]=__builtin_amdgcn_mfma_f32_32x32x16_bf16(PAF(1),VFR(1),o[0],0,0,0), C0,8); \
    KRD(GL,1); GAPB(o[1]=__builtin_amdgcn_mfma_f32_32x32x16_bf16(PAF(1),VFR(5),o[1],0,0,0), C0,12); \
    KRD(GL,2); GAPB(o[0]=__builtin_amdgcn_mfma_f32_32x32x16_bf16(PAF(2),VFR(2),o[0],0,0,0), C1,0); \
    KRD(GL,3); GAPB(o[1]=__builtin_amdgcn_mfma_f32_32x32x16_bf16(PAF(2),VFR(6),o[1],0,0,0), C1,4); \
    GAPB(o[0]=__builtin_amdgcn_mfma_f32_32x32x16_bf16(PAF(3),VFR(3),o[0],0,0,0), C1,8); \
    GAPB(o[1]=__builtin_amdgcn_mfma_f32_32x32x16_bf16(PAF(3),VFR(7),o[1],0,0,0), C1,12); \
    }while(0)
  int t=1;
  #undef CMASK
  #define CMASK(P0,P1,t) do{}while(0)
  for(;t+5<NT;t+=2){
    STEP(pB0,pB1,pA0,pA1,t,true,true,true);     WAIT_BAR(2); RESC(); ROT();
    STEP(pA0,pA1,pB0,pB1,t+1,true,true,true);   WAIT_BAR(2); RESC(); ROT();
  }
  #undef CMASK
  int qrel_m=qrel,hi_m=hi; asm volatile("":"+v"(qrel_m),"+v"(hi_m));
  #define CMASK(P0,P1,t) do{int jb_=(t)-(NT-4); if(jb_>=0)cmask(P0,P1,jb_,qrel_m,hi_m);}while(0)
  #define ENDW(tt) do{ if((tt)+3<NT){WAIT_BAR(2);} else if((tt)+2<NT){WAIT_BAR(1);} else {WAIT_BAR(0);} }while(0)
  for(;t+1<NT;t+=2){
    STEP(pB0,pB1,pA0,pA1,t,(t+3<NT),(t+1<NT),(t+1<NT));       ENDW(t);   RESC(); ROT();
    STEP(pA0,pA1,pB0,pB1,t+1,(t+4<NT),(t+2<NT),(t+2<NT));     ENDW(t+1); RESC(); ROT();
  }
  STEP(pB0,pB1,pA0,pA1,NT-1,false,false,false); RESC();
  { float sacc=pB0[0]+pB0[1]; _Pragma("unroll") for(int r=2;r<16;++r)sacc+=pB0[r]; _Pragma("unroll") for(int r=0;r<16;++r)sacc+=pB1[r]; l_reg+=sacc;
    pw0=(u32x4){PKW(pB0,0),PKW(pB0,2),PKW(pB0,4),PKW(pB0,6)};pw1=(u32x4){PKW(pB0,8),PKW(pB0,10),PKW(pB0,12),PKW(pB0,14)};pw2=(u32x4){PKW(pB1,0),PKW(pB1,2),PKW(pB1,4),PKW(pB1,6)};pw3=(u32x4){PKW(pB1,8),PKW(pB1,10),PKW(pB1,12),PKW(pB1,14)};
    SBAR(); pv(o,vb0+sl_cur,PAF(0),PAF(1),PAF(2),PAF(3)); }
  #undef PKW
  #undef PAF
  #undef VFR
  #undef PIN
  #undef MX3
  #undef GAPA
  #undef GAPB
  #undef EX
  #undef VRD
  #undef KRD
  #undef STEP
  #undef ENDW
  {auto rr=__builtin_amdgcn_permlane32_swap(__float_as_uint(l_reg),__float_as_uint(l_reg),false,false);l_reg=__uint_as_float(rr[0])+__uint_as_float(rr[1]);}
  if(hi==0)wsf[32+r32]=l_reg;asm volatile("s_waitcnt lgkmcnt(0)":::"memory");
  float rli[16];
  #pragma unroll
  for(int r=0;r<16;++r)rli[r]=__builtin_amdgcn_rcpf(wsf[32+crow(r,hi)]);
  bf16*Ow=O+(rowbase+q0+wid*QBLK)*DM+h*D;
  { bf16*stg=(bf16*)(shm+LDS_OST)+wid*2048;
    #pragma unroll
    for(int r=0;r<16;++r){const int orow=crow(r,hi);
      #pragma unroll
      for(int d0=0;d0<2;++d0){const float gv=__uint_as_float((unsigned)Gt[(rowbase+q0+wid*QBLK+orow)*DM+h*D+d0*32+r32]<<16); const float ov=o[d0][r]*rli[r]*gv; unsigned ub=__float_as_uint(ov); ub=(ub+0x7fffu+((ub>>16)&1u))>>16; stg[orow*64+d0*32+r32]=(bf16)ub;}}
    asm volatile("s_waitcnt lgkmcnt(0)":::"memory");
    #pragma unroll
    for(int i=0;i<4;++i){const int row=i*8+(lane>>3),ch=lane&7; const u32x4 v=*(const u32x4*)(stg+row*64+ch*8); ATTN_STORE16(Ow+(long)row*DM+ch*8,v);} }
  asm volatile("s_waitcnt lgkmcnt(0)\n\ts_barrier":::"memory");
  #undef DMA_K
  #undef DMA_V
  #undef CMASK
  #undef BIAS
  #undef LDSF4
  #undef START
  #undef RESC
  #undef ROT
}
constexpr int ATTN_LDS_BYTES=LDS_BYTES;
#undef SBAR
#undef WAIT_BAR
}

__device__ __forceinline__ void fox_attn2(const Params& P, char* shm, int tid, int bid, int G, unsigned short* Odst) {
    const int lane = tid & 63;
    unsigned short* Q = (unsigned short*)(P.ws + WS_ACT); const unsigned short* Kb = (const unsigned short*)(P.ws + WS_ACT + 32 * MiB); const unsigned short* V = (const unsigned short*)(P.ws + WS_ACT + 64 * MiB);
    const unsigned short* Gt = (const unsigned short*)(P.ws + WS_ACT + 96 * MiB);
    LAS float* nc = (LAS float*)((LAS char*)shm + attn_body::LDS_NC);
    LAS float* ft = (LAS float*)((LAS char*)shm + attn_body::LDS_FT);
    LAS float* re = (LAS float*)((LAS char*)shm + attn_body::LDS_RE);
    float gq = fabsf(P.fox_q_gain[lane]), gk = fabsf(P.fox_k_gain[lane]);
#pragma unroll
    for (int o = 1; o < 64; o <<= 1) { gq = fmaxf(gq, __shfl_xor(gq, o)); gk = fmaxf(gk, __shfl_xor(gk, o)); }
    const float Smax = 1.02f * (64.0f * gq * gk * 0.125f * LOG2E);
    const float T = 2.0f * Smax + 40.0f;
    const int vcu = (G % 8 == 0) ? (bid % 8) * (G / 8) + bid / 8 : bid;
    int last_bh = -1;
    for (int i = 0;; ++i) {
        int bh, qb;
        if (G == 256) { if (i >= 4) break; bh = vcu >> 2; const int s = vcu & 3; qb = (i == 0) ? s : (i == 1) ? 7 - s : (i == 2) ? 8 + s : 15 - s; }
        else { const int ui = i * G + bid; if (ui >= 1024) break; bh = ui >> 4; qb = ui & 15; }
        if (bh != last_bh) {
            const float* LF = (const float*)(P.ws + WS_S16) + ((size_t)(bh >> 4) * SEQ + 8 * tid) * 16 + (bh & 15);
            float v8[8]; float run = 0.f;
#pragma unroll
            for (int i2 = 0; i2 < 8; ++i2) { run += LF[(size_t)i2 * 16]; v8[i2] = run; }
            float inc = run;
#pragma unroll
            for (int o = 1; o < 64; o <<= 1) { const float tt = __shfl_up(inc, o); if (lane >= o) inc += tt; }
            if (lane == 63) ft[tid >> 6] = inc;
            __syncthreads();
            float pre = inc - run;
            for (int w = 0; w < (tid >> 6); ++w) pre += ft[w];
            __syncthreads();
#pragma unroll
            for (int i2 = 0; i2 < 8; ++i2) nc[8 * tid + i2] = -(pre + v8[i2]) * LOG2E;
            __syncthreads();
            if (tid < 64) { const float e = nc[64 * tid + 63]; re[tid] = e; const float ep = (tid > 0) ? nc[64 * tid - 1] : e; ft[tid] = exp2f(ep - e); }
            __syncthreads();
#pragma unroll
            for (int i2 = 0; i2 < 8; ++i2) nc[8 * tid + i2] += -re[tid >> 3] - Smax + 40.0f;
            __syncthreads(); last_bh = bh;
        }
        const int ntf = 4 * qb + 4;
        const float thr = (qb > 0 ? re[4 * qb - 1] : 0.0f) - T;
        const bool pred = (lane < ntf) && (re[lane] < thr);
        int ts = __builtin_popcountll(__ballot(pred)) & ~1; ts = ts > ntf - 4 ? ntf - 4 : ts; ts = __builtin_amdgcn_readfirstlane(ts);
        int tid_u = tid; asm volatile("" : "+v"(tid_u));
        attn_body::attn_unit<8>(bh >> 4, bh & 15, qb, ts, Q, Kb, V, Gt, Odst ? Odst : Q, shm, tid_u);
    }
}

__device__ __forceinline__ void final_norm(const Params& P, int tid, int bid, int G) {
    const int lane = tid & 63, wave = tid >> 6;
    const int gw = bid * 8 + wave, NGW = G * 8;
    f32x4 g[4];
#pragma unroll
    for (int j = 0; j < 4; ++j) g[j] = *(const f32x4*)(P.final_g + 4 * lane + 256 * j);
    constexpr int RB = 4;
    for (int row0 = gw; row0 < MT; row0 += RB * NGW) {
        f32x4 v[RB][4];
#pragma unroll
        for (int rb = 0; rb < RB; ++rb) { const int row = row0 + rb * NGW < MT ? row0 + rb * NGW : row0; const f32x4* xr = (const f32x4*)(P.out + (size_t)row * 1024) + lane;
#pragma unroll
            for (int j = 0; j < 4; ++j) v[rb][j] = xr[64 * j]; }
#pragma unroll
        for (int rb = 0; rb < RB; ++rb) { const int row = row0 + rb * NGW; if (row >= MT) break;
            float ss = 0.f;
#pragma unroll
            for (int j = 0; j < 4; ++j) ss += (v[rb][j][0] * v[rb][j][0] + v[rb][j][1] * v[rb][j][1]) + (v[rb][j][2] * v[rb][j][2] + v[rb][j][3] * v[rb][j][3]);
            const float rstd = rsqrtf(wave_sum(ss) * (1.0f / 1024.0f) + EPS);
            f32x4* xw = (f32x4*)(P.out + (size_t)row * 1024) + lane;
#pragma unroll
            for (int j = 0; j < 4; ++j) xw[64 * j] = (v[rb][j] * rstd) * g[j];
        }
    }
}

#define XB_TMO      128
#define XB_XCNT(j)  (256  + 64 * (j))
#define XB_XSUB(j)  (1280 + 64 * (j))
#define XB_XGEN(j)  (2304 + 64 * (j))
#define XB_TOP      3328
#define XB_TOPGEN   3392
#define XCD_BAR_WORDS 3456
#define XB_SPIN_CAP (1u << 20)
__device__ __forceinline__ unsigned xb_ld(unsigned* p)              { return __hip_atomic_load(p, __ATOMIC_RELAXED, __HIP_MEMORY_SCOPE_AGENT); }
__device__ __forceinline__ unsigned xb_add(unsigned* p, unsigned v) { return __hip_atomic_fetch_add(p, v, __ATOMIC_RELAXED, __HIP_MEMORY_SCOPE_AGENT); }
__device__ __forceinline__ unsigned xb_xcc_id() { return (unsigned)__builtin_amdgcn_s_getreg((3 << 11) | 20) & 0xFu; }
#define XB_SPIN(cond, bar) do { unsigned _sp = 0; while (cond) { __builtin_amdgcn_s_sleep(1); \
    if ((++_sp & 255u) == 0u) { if (xb_ld(&(bar)[XB_TMO])) break; if (_sp > XB_SPIN_CAP) { atomicAdd(&(bar)[XB_TMO], 1u); break; } } } } while (0)
struct XcdBarrier { unsigned* bar; unsigned x; volatile LAS unsigned* st; int wave_s; };
__device__ __forceinline__ int lane_id() { return (int)__builtin_amdgcn_mbcnt_hi(~0u, __builtin_amdgcn_mbcnt_lo(~0u, 0u)); }
__device__ __forceinline__ XcdBarrier xcd_barrier_post(unsigned* bar, volatile LAS unsigned* st, int wave_s) {
    XcdBarrier b; b.bar = bar; b.x = xb_xcc_id(); b.st = st; b.wave_s = wave_s;
    if (threadIdx.x == 0) (void)xb_add(&bar[XB_XCNT(b.x)], 1u);
    return b;
}
__device__ __forceinline__ void xcd_barrier_complete(unsigned* bar, unsigned x, unsigned& nloc, unsigned& nx) {
    const unsigned G = gridDim.x * gridDim.y * gridDim.z;
    asm volatile("" : "+s"(x));
    unsigned sum, cnt, mine, sp = 0u;
    for (;;) {
        sum = 0u; cnt = 0u; mine = 0u;
#pragma unroll
        for (unsigned j = 0; j < 16; ++j) { const unsigned c = xb_ld(&bar[XB_XCNT(j)]); sum += c; cnt += (c > 0u) ? 1u : 0u; mine = (j == x) ? c : mine; }
        if (sum == G) break;
        __builtin_amdgcn_s_sleep(1);
        if ((++sp & 255u) == 0u) { if (xb_ld(&bar[XB_TMO])) break; if (sp > XB_SPIN_CAP) { atomicAdd(&bar[XB_TMO], 1u); break; } }
    }
    nloc = mine > 0u ? mine : 1u; nx = cnt > 0u ? cnt : 1u;
}
__device__ __forceinline__ void xcd_barrier(const XcdBarrier& b) {
    asm volatile("s_waitcnt vmcnt(0)" ::: "memory");
    __syncthreads();
    if (threadIdx.x == 0) {
        unsigned* bar = b.bar;
        __builtin_amdgcn_s_waitcnt(0);
        unsigned nloc = b.st[0], nx = b.st[1];
        if (nloc == 0u) { xcd_barrier_complete(bar, b.x, nloc, nx); b.st[0] = nloc; b.st[1] = nx; }
        const unsigned old = xb_add(&bar[XB_XSUB(b.x)], 1u);
        const unsigned gen = old / nloc;
        if (old + 1u == (gen + 1u) * nloc) {
            __builtin_amdgcn_fence(__ATOMIC_RELEASE, "agent");
            asm volatile("s_waitcnt vmcnt(0)" ::: "memory");
            const unsigned og = xb_add(&bar[XB_TOP], 1u);
            const unsigned tg = og / nx;
            if (og + 1u == (tg + 1u) * nx) xb_add(&bar[XB_TOPGEN], 1u);
            else XB_SPIN(xb_ld(&bar[XB_TOPGEN]) == tg, bar);
            xb_add(&bar[XB_XGEN(b.x)], 1u);
            __builtin_amdgcn_fence(__ATOMIC_ACQUIRE, "agent");
            asm volatile("s_waitcnt vmcnt(0)" ::: "memory");
        } else {
            XB_SPIN(xb_ld(&bar[XB_XGEN(b.x)]) == gen, bar);
            __builtin_amdgcn_fence(__ATOMIC_ACQUIRE, "agent");
            asm volatile("s_waitcnt vmcnt(0)" ::: "memory");
        }
    }
    __syncthreads();
}

constexpr int LDS_BYTES = 147456;
#ifndef PROBE
#define PROBE 0
#endif
#define FRESH() int tid = threadIdx.x, bid = blockIdx.x; asm volatile("" : "+v"(tid)); asm volatile("" : "+s"(bid));
__global__ void __launch_bounds__(512, 2) trunk_fwd(Params P) {
    extern __shared__ __attribute__((aligned(16))) unsigned char lds_raw[];
    LAS unsigned char* lds = (LAS unsigned char*)lds_raw;
    cg::grid_group grid = cg::this_grid();
    const int G = gridDim.x;
    volatile LAS unsigned* MISC = (volatile LAS unsigned*)(lds + LDS_BYTES - 128);
    const int wave_s = __builtin_amdgcn_readfirstlane((int)threadIdx.x >> 6);
    if (threadIdx.x < 32) MISC[threadIdx.x] = 0u;
    __syncthreads();
    XcdBarrier xbar = xcd_barrier_post((unsigned*)P.ws, MISC + 8, wave_s);
    unsigned char* ws = P.ws;
    const float* MOD = (const float*)(ws + WS_MOD);
    bf16_t* XN = (bf16_t*)(ws + WS_XN);
    bf16_t* ACT = (bf16_t*)(ws + WS_ACT);
#define GSYNC() xcd_barrier(xbar)
    if (PROBE == 30) { { FRESH(); p0_mod(P, lds, tid, bid, G); } { FRESH(); p0_rope(P, tid, bid, G); } __syncthreads(); }
    if (PROBE == 31) { FRESH(); conv_weights(P.ret_w_in, RET_IN, 6144, P.ret_w_out, 2048, ws + WS_W, lds, tid, bid, G); __syncthreads(); }
    { FRESH(); p0_mod(P, lds, tid, bid, G); }
    { FRESH(); p0_rope(P, tid, bid, G); }
    { FRESH(); conv_weights(P.ret_w_in, RET_IN, 6144, P.ret_w_out, 2048, ws + WS_W, lds, tid, bid, G); }
    grid.sync();
#pragma unroll 1
    for (int layer = 0; layer < 4; ++layer) {
        const int kind = layer % 3, j = layer / 3;
        unsigned char* wbase = ws + ((kind == 2) ? WS_WGLA : WS_W);
        bf16_t* WinT = (bf16_t*)wbase; bf16_t* WoutT = (bf16_t*)(wbase + 12 * MiB);
        const float* xin = (layer == 0) ? P.x : P.out;
        if (layer > 0) {
            FRESH();
            if (kind == 0) { if (G != 256) conv_weights(P.ret_w_in + (size_t)j * 1024 * RET_IN, RET_IN, 6144, P.ret_w_out + (size_t)j * 2048 * 1024, 2048, ws + WS_W, lds, tid, bid, G); }
            else if (kind == 1) conv_weights(P.fox_w_in, FOX_IN, 4096, P.fox_w_out, 1024, ws + WS_W, lds, tid, bid, G);
            else conv_weights(P.gla_w_in, GLA_IN, 3072, P.gla_w_out, 1024, ws + WS_WGLA, lds, tid, bid, G);
            __syncthreads();
        }
        if (PROBE == 5 || (PROBE >= 50 && PROBE <= 53 && layer == PROBE - 50)) {
            if (kind == 0) { FRESH(); h_phase<0>(P, layer, xin, lds, tid, bid, G); }
            else if (kind == 1) { FRESH(); h_phase<1>(P, layer, xin, lds, tid, bid, G); }
            else { FRESH(); h_phase<2>(P, layer, xin, lds, tid, bid, G); }
            __syncthreads();
        }
        if (kind == 0) { FRESH(); h_phase<0>(P, layer, xin, lds, tid, bid, G); }
        else if (kind == 1) { FRESH(); h_phase<1>(P, layer, xin, lds, tid, bid, G); }
        else { FRESH(); h_phase<2>(P, layer, xin, lds, tid, bid, G); }
        GSYNC();
        const float* gate = MOD + (size_t)(layer * 4) * 3072 + 2048;
        if (kind == 0) {
            bf16_t* rQ = ACT; bf16_t* rK = (bf16_t*)(ws + WS_ACT + 32 * MiB); bf16_t* rV = (bf16_t*)(ws + WS_ACT + 64 * MiB); bf16_t* rO = (bf16_t*)(ws + WS_ACT + 128 * MiB);
            bf16_t* rP = WinT;
            float* STATS = (float*)(ws + WS_S16);
            {
                FRESH();
                pg8::Gemm g{XN, WinT, MT, 4096, 1024}; pg8::StaticOrder S; S.init(MT, 4096, G, bid);
                EpiRetIn E{rQ, rK, rV, (const unsigned*)(ws + WS_ROPE)};
                pg8::gemm_phase<EpiRetIn, pg8::StaticOrder, true, true>(lds, g, S, E, tid);
            }
            GSYNC();
            if (PROBE == 40) { FRESH();
                pg8::Gemm g{XN, WinT, MT, 4096, 1024}; pg8::StaticOrder S; S.init(MT, 4096, G, bid);
                EpiRetIn E{rQ, rK, rV, (const unsigned*)(ws + WS_ROPE)};
                pg8::gemm_phase<EpiRetIn, pg8::StaticOrder, true, true>(lds, g, S, E, tid); GSYNC(); }
            if (PROBE == 6) { FRESH();
                pg8::Gemm g{XN, WinT + (size_t)4096 * 1024, MT, 2048, 1024}; pg8::StaticOrder S; S.init(MT, 2048, G, bid);
                EpiSplit E{(bf16_t*)P.out, 8, 0, 2048, -1};
                if (layer == 0) { pg8::gemm_phase<EpiSplit, pg8::StaticOrder, true, true>(lds, g, S, E, tid); GSYNC(); } }
            if (PROBE == 62 && layer == 0) { FRESH();
                pg8::Gemm g{XN, WinT, MT, 4096, 1024}; pg8::StaticOrder S; S.init(MT, 4096, G, bid);
                EpiNone E{P.out};
                pg8::gemm_phase<EpiNone, pg8::StaticOrder, true, true>(lds, g, S, E, tid); GSYNC(); }
            if (PROBE == 60 && layer == 0) { FRESH();
                pg8::Gemm g{XN, WinT + (size_t)4096 * 1024, MT, 2048, 1024}; pg8::StaticOrder S; S.init(MT, 2048, G, bid);
                EpiNone E{P.out};
                pg8::gemm_phase<EpiNone, pg8::StaticOrder, true, true>(lds, g, S, E, tid); GSYNC(); }
            if (PROBE == 8) { FRESH(); lin_pphase<0>(rQ, rK, rQ, rK, rP, tid, bid, G); GSYNC(); }
            { FRESH(); lin_pphase<0>(rQ, rK, rQ, rK, rP, tid, bid, G); }
            GSYNC();
            if (PROBE == 2) { FRESH(); lin_scan<0>(rQ, rK, rV, rP, nullptr, rO, (float*)(ws + WS_CUM), lds, tid, bid, G); GSYNC(); }
            if (PROBE == 20 && layer == 0) { FRESH(); lin_scan<0, 1>(rQ, rK, rV, rP, nullptr, (bf16_t*)P.out, (float*)(ws + WS_CUM), lds, tid, bid, G); GSYNC(); }
            if (PROBE == 23 && layer == 0) { FRESH(); lin_scan<0, 4>(rQ, rK, rV, rP, nullptr, (bf16_t*)P.out, (float*)(ws + WS_CUM), lds, tid, bid, G); GSYNC(); }
            if (PROBE == 25 && layer == 0) { FRESH(); lin_scan<0, 16>(rQ, rK, rV, rP, nullptr, (bf16_t*)P.out, (float*)(ws + WS_CUM), lds, tid, bid, G); GSYNC(); }
            if (PROBE == 22 && layer == 0) { FRESH(); lin_scan<0, 0>(rQ, rK, rV, rP, nullptr, (bf16_t*)P.out, (float*)(ws + WS_CUM), lds, tid, bid, G); GSYNC(); }
            { FRESH(); lin_scan<0>(rQ, rK, rV, rP, nullptr, rO, (float*)(ws + WS_CUM), lds, tid, bid, G); }
            GSYNC();
            {
                FRESH();
                pg8::Gemm g{XN, WinT + (size_t)4096 * 1024, MT, 2048, 1024}; pg8::PairOrder S{G, (G % 8 == 0) ? (bid % 8) * (G / 8) + bid / 8 : bid};
                EpiGateNorm<0> E{rO, STATS, (LAS float*)(lds + 131072)};
                pg8::gemm_phase<EpiGateNorm<0>, pg8::PairOrder, true, true>(lds, g, S, E, tid);
            }
            GSYNC();
            if (PROBE == 42 && layer == 0) { FRESH();
                pg8::Gemm g{rO, WoutT, MT, 1024, 2048}; pg8::StaticOrder S; S.init(MT, 1024, G, bid);
                EpiOut E{xin, P.out, gate};
                pg8::gemm_phase<EpiOut, pg8::StaticOrder, true, true>(lds, g, S, E, tid); GSYNC(); }
            {
                FRESH();
                pg8::Gemm g{rO, WoutT, MT, 1024, 2048}; pg8::StaticOrder S; S.init(MT, 1024, G, bid);
                EpiOut E{xin, P.out, gate};
                pg8::gemm_phase<EpiOut, pg8::StaticOrder, true, true>(lds, g, S, E, tid);
            }
            GSYNC();
        } else if (kind == 1) {
            {
                FRESH();
                pg8::Gemm g{XN, WinT, MT, 4096, 1024}; pg8::StaticOrder S; S.init(MT, 4096, G, bid);
                EpiFoxIn E{ACT, P.fox_q_gain, P.fox_k_gain, (LAS float*)(lds + 131072)};
                pg8::gemm_phase<EpiFoxIn, pg8::StaticOrder, true, true>(lds, g, S, E, tid);
            }
            GSYNC();
            if (PROBE == 41) { FRESH();
                pg8::Gemm g{XN, WinT, MT, 4096, 1024}; pg8::StaticOrder S; S.init(MT, 4096, G, bid);
                EpiFoxIn E{ACT, P.fox_q_gain, P.fox_k_gain, (LAS float*)(lds + 131072)};
                pg8::gemm_phase<EpiFoxIn, pg8::StaticOrder, true, true>(lds, g, S, E, tid); GSYNC(); }
            if (PROBE == 1) { FRESH(); fox_attn2(P, (char*)lds_raw, tid, bid, G, XN); GSYNC(); }
            { FRESH(); fox_attn2(P, (char*)lds_raw, tid, bid, G, nullptr); }
            GSYNC();
            {
                FRESH();
                pg8::Gemm g{ACT, WoutT, MT, 1024, 1024}; pg8::StaticOrder S; S.init(MT, 1024, G, bid);
                EpiOut E{xin, P.out, gate};
                pg8::gemm_phase<EpiOut, pg8::StaticOrder, true, true>(lds, g, S, E, tid);
            }
            GSYNC();
        } else {
            bf16_t* gQE = ACT; bf16_t* gQN = (bf16_t*)(ws + WS_ACT + 16 * MiB); bf16_t* gKE = (bf16_t*)(ws + WS_ACT + 32 * MiB); bf16_t* gKN = (bf16_t*)(ws + WS_ACT + 48 * MiB);
            bf16_t* gV = (bf16_t*)(ws + WS_ACT + 64 * MiB); bf16_t* gP = (bf16_t*)(ws + WS_ACT + 96 * MiB); bf16_t* gO = (bf16_t*)(ws + WS_ACT + 128 * MiB);
            const float* gCB = (const float*)(ws + WS_ACT + 160 * MiB);
            float* STATS = (float*)(ws + WS_S16);
            {
                FRESH();
                pg8::Gemm g{XN, WinT, MT, 2048, 1024}; pg8::StaticOrder S; S.init(MT, 2048, G, bid);
                EpiGlaIn E{gQE, gQN, gKE, gKN, gV, nullptr, gCB};
                pg8::gemm_phase<EpiGlaIn, pg8::StaticOrder, true, true>(lds, g, S, E, tid);
            }
            GSYNC();
            { FRESH(); lin_pphase<1>(gQE, gKN, gQN, gKE, gP, tid, bid, G); }
            GSYNC();
            if (PROBE == 3) { FRESH(); lin_scan<1>(gQE, gKN, gV, gP, gCB, gO, (float*)(ws + WS_CUM), lds, tid, bid, G); GSYNC(); }
            if (G == 256 && ((int)blockIdx.x >> 3) >= 16) {
                FRESH(); const int sub = (bid & 7) * 16 + ((bid >> 3) - 16);
                conv_weights(P.ret_w_in + (size_t)1 * 1024 * RET_IN, RET_IN, 6144, P.ret_w_out + (size_t)1 * 2048 * 1024, 2048, ws + WS_W, lds, tid, sub, 128);
            } else { FRESH(); lin_scan<1>(gQE, gKN, gV, gP, gCB, gO, (float*)(ws + WS_CUM), lds, tid, bid, G); }
            GSYNC();
            {
                FRESH();
                pg8::Gemm g{XN, WinT + (size_t)2048 * 1024, MT, 1024, 1024}; pg8::StaticOrder S; S.init(MT, 1024, G, bid);
                EpiGateNorm<1> E{gO, STATS, (LAS float*)(lds + 131072)};
                pg8::gemm_phase<EpiGateNorm<1>, pg8::StaticOrder, true, true>(lds, g, S, E, tid);
            }
            GSYNC();
            {
                FRESH();
                pg8::Gemm g{gO, WoutT, MT, 1024, 1024}; pg8::StaticOrder S; S.init(MT, 1024, G, bid);
                EpiOut E{xin, P.out, gate};
                pg8::gemm_phase<EpiOut, pg8::StaticOrder, true, true>(lds, g, S, E, tid);
            }
            GSYNC();
        }
    }
    if (PROBE == 70) { for (int i = 0; i < 10; ++i) GSYNC(); }
    { FRESH(); final_norm(P, tid, bid, G); }
}

extern "C" void kernel_launch(void* const* d_in, const int* in_sizes, int n_in, void* d_out, int out_size, void* d_ws, size_t ws_size, hipStream_t stream) {
    static int grid = 0;
    if (grid == 0) {
        if (n_in != 18 || out_size != MT * DM || ws_size < WS_END) { fprintf(stderr, "kernel_launch: unexpected shapes (n_in %d out %d ws %zu)\n", n_in, out_size, ws_size); grid = -1; return; }
        int dev = 0, cus = 0, per_cu = 0;
        hipGetDevice(&dev);
        hipDeviceGetAttribute(&cus, hipDeviceAttributeMultiprocessorCount, dev);
        hipFuncSetAttribute((const void*)trunk_fwd, hipFuncAttributeMaxDynamicSharedMemorySize, LDS_BYTES);
        hipOccupancyMaxActiveBlocksPerMultiprocessor(&per_cu, (const void*)trunk_fwd, 512, LDS_BYTES);
        if (per_cu < 1) { fprintf(stderr, "kernel_launch: occupancy query says %d blocks per CU\n", per_cu); per_cu = 1; }
        (void)hipGetLastError();
        grid = cus;
    }
    if (grid < 0) return;
    Params p{};
    p.x = (const float*)d_in[0]; p.c = (const float*)d_in[1]; p.pos = (const int*)d_in[2]; p.mod_w = (const float*)d_in[3]; p.mod_b = (const float*)d_in[4]; p.norm_g = (const float*)d_in[5];
    p.ret_w_in = (const float*)d_in[6]; p.ret_w_out = (const float*)d_in[7]; p.fox_w_in = (const float*)d_in[8]; p.fox_b_f = (const float*)d_in[9]; p.fox_q_gain = (const float*)d_in[10]; p.fox_k_gain = (const float*)d_in[11];
    p.fox_w_out = (const float*)d_in[12]; p.gla_w_in = (const float*)d_in[13]; p.gla_w_gate2 = (const float*)d_in[14]; p.gla_b_gate = (const float*)d_in[15]; p.gla_w_out = (const float*)d_in[16]; p.final_g = (const float*)d_in[17];
    p.out = (float*)d_out; p.ws = (unsigned char*)d_ws;
    if (hipMemsetAsync(d_ws, 0, 16384, stream) != hipSuccess) { fprintf(stderr, "kernel_launch: memset failed\n"); return; }
    void* args[] = {&p};
    hipError_t e = hipLaunchCooperativeKernel((const void*)trunk_fwd, dim3(grid), dim3(512), args, LDS_BYTES, stream);
    if (e != hipSuccess) fprintf(stderr, "cooperative launch failed: %s (grid %d)\n", hipGetErrorString(e), grid);
}
```

```cpp
#include <hip/hip_runtime.h>
#include <hip/hip_cooperative_groups.h>
#include <cstdio>
#include <cstdint>
#include <cmath>
namespace cg = cooperative_groups;

#define LAS __attribute__((address_space(3)))
typedef unsigned short bf16_t;
typedef short bf16x8 __attribute__((ext_vector_type(8)));
typedef float f32x4 __attribute__((ext_vector_type(4)));
typedef float f32x2 __attribute__((ext_vector_type(2)));
typedef unsigned u32x4 __attribute__((ext_vector_type(4)));
typedef unsigned u32x2 __attribute__((ext_vector_type(2)));

constexpr int DM = 1024, NB = 4, SEQ = 4096, MT = NB * SEQ;
constexpr float EPS = 1e-6f;
constexpr int RET_IN = 6144, FOX_IN = 4112, GLA_IN = 3088;
constexpr float LOG2E = 1.4426950408889634f;

constexpr size_t MiB = 1u << 20;
constexpr size_t WS_MOD = 1 * MiB;
constexpr size_t WS_S16 = 2 * MiB;
constexpr size_t WS_CUM = 3 * MiB;
constexpr size_t WS_ROPE = 4 * MiB;
constexpr size_t WS_W = 12 * MiB;
constexpr size_t WS_WOUT = WS_W + 12 * MiB;
constexpr size_t WS_WGLA = 164 * MiB;
constexpr size_t WS_XN = 28 * MiB;
constexpr size_t WS_ACT = 60 * MiB;
constexpr size_t WS_END = 252 * MiB;

__device__ __forceinline__ unsigned f2bf(float f) { unsigned u = __builtin_bit_cast(unsigned, f); return (u + 0x7fffu + ((u >> 16) & 1u)) >> 16; }
typedef float f32x2_hw __attribute__((ext_vector_type(2))); typedef __bf16 bf16x2_hw __attribute__((ext_vector_type(2)));
__device__ __forceinline__ unsigned pk2(float lo, float hi) { f32x2_hw v = {lo, hi}; bf16x2_hw b = __builtin_convertvector(v, bf16x2_hw); return __builtin_bit_cast(unsigned, b); }
__device__ __forceinline__ float bf2f(unsigned h) { return __builtin_bit_cast(float, h << 16); }
__device__ __forceinline__ u32x2 pk4(f32x4 v) { u32x2 r; r.x = pk2(v[0], v[1]); r.y = pk2(v[2], v[3]); return r; }
__device__ __forceinline__ f32x4 unpk4(u32x2 w) { f32x4 r; r[0] = bf2f(w.x & 0xffffu); r[1] = bf2f(w.x >> 16); r[2] = bf2f(w.y & 0xffffu); r[3] = bf2f(w.y >> 16); return r; }
__device__ __forceinline__ float silu_f(float v) { return v * __builtin_amdgcn_rcpf(1.0f + __expf(-v)); }
__device__ __forceinline__ float logsig_f(float v) { return fminf(v, 0.0f) - __logf(1.0f + __expf(-fabsf(v))); }
template <int CTRL> __device__ __forceinline__ float dpp_mov(float v) { return __builtin_bit_cast(float, __builtin_amdgcn_update_dpp(0, __builtin_bit_cast(int, v), CTRL, 0xf, 0xf, true)); }
__device__ __forceinline__ float swap32_sum(float x, float y) { auto r = __builtin_amdgcn_permlane32_swap(__builtin_bit_cast(unsigned, x), __builtin_bit_cast(unsigned, y), false, false); const unsigned r0 = r[0], r1 = r[1]; return __builtin_bit_cast(float, r0) + __builtin_bit_cast(float, r1); }
__device__ __forceinline__ float swap16_sum(float x, float y) { auto r = __builtin_amdgcn_permlane16_swap(__builtin_bit_cast(unsigned, x), __builtin_bit_cast(unsigned, y), false, false); const unsigned r0 = r[0], r1 = r[1]; return __builtin_bit_cast(float, r0) + __builtin_bit_cast(float, r1); }
__device__ __forceinline__ float row_sum16(float v) {
    v += dpp_mov<0xB1>(v);
    v += dpp_mov<0x4E>(v);
    v += dpp_mov<0x141>(v);
    v += dpp_mov<0x140>(v);
    return v;
}
__device__ __forceinline__ float xsum_16_32(float v) { v = swap16_sum(v, v); return swap32_sum(v, v); }
__device__ __forceinline__ float wave_sum(float v) { return xsum_16_32(row_sum16(v)); }
__device__ __forceinline__ float reduce_scatter16(const float (&a)[16], int lane) {
    float b8[8], c4[4], d2[2], e1;
#pragma unroll
    for (int i = 0; i < 8; ++i) b8[i] = swap32_sum(a[i], a[i + 8]);
#pragma unroll
    for (int i = 0; i < 4; ++i) c4[i] = swap16_sum(b8[i], b8[i + 4]);
    { const bool hi = (lane & 8) != 0;
#pragma unroll
      for (int i = 0; i < 2; ++i) { const float snd = hi ? c4[i] : c4[i + 2], kp = hi ? c4[i + 2] : c4[i]; d2[i] = kp + dpp_mov<0x128>(snd); } }
    { const bool hi = (lane & 4) != 0; const float snd = hi ? d2[0] : d2[1], kp = hi ? d2[1] : d2[0]; e1 = kp + dpp_mov<0x1B>(dpp_mov<0x141>(snd)); }
    e1 += dpp_mov<0x4E>(e1); e1 += dpp_mov<0xB1>(e1);
    return e1;
}
#define LDS_WAIT() asm volatile("s_waitcnt lgkmcnt(0)" ::: "memory")

__device__ __forceinline__ f32x4 mma_rc(f32x4 acc, bf16x8 a_rows, bf16x8 b_cols) { return __builtin_amdgcn_mfma_f32_16x16x32_bf16(b_cols, a_rows, acc, 0, 0, 0); }
__device__ __forceinline__ f32x4 mma_cr(f32x4 acc, bf16x8 a_rows, bf16x8 b_cols) { return __builtin_amdgcn_mfma_f32_16x16x32_bf16(a_rows, b_cols, acc, 0, 0, 0); }
__device__ __forceinline__ bf16x8 gfrag(const bf16_t* base, int pitch, int lane) { return *(const bf16x8*)(base + (size_t)(lane & 15) * pitch + 8 * (lane >> 4)); }
__device__ __forceinline__ bf16x8 lfrag(const LAS bf16_t* base, int pitch, int lane) { return *(const LAS bf16x8*)(base + (lane & 15) * pitch + 8 * (lane >> 4)); }

namespace pg8 {
#define PG8_LAS __attribute__((address_space(3)))
constexpr int BM = 256, BK = 64, HALF = 128, HTB = HALF * BK * 2, STAGE_BYTES = 8 * HTB, NXCD = 8, WGM = 8;
__host__ __device__ __forceinline__ int lds_byte(int r, int c) { const int st = (r >> 4) * 2 + (c >> 5), rr = r & 15, cc = c & 31, ob = rr * 64 + cc * 2; return st * 1024 + (ob ^ (((ob >> 9) & 1) << 5)); }
__host__ __device__ __forceinline__ void stage_rc(int b, int& R, int& C) { const int st = b / 1024, sb = b % 1024, swz = sb ^ (((sb >> 9) & 1) << 5); R = (st >> 1) * 16 + swz / 64; C = (st & 1) * 32 + (swz % 64) / 2; }
__host__ __device__ __forceinline__ int perm32(int rho) { const int n = rho >> 4, i = rho & 15; return 8 * (i >> 2) + 4 * n + (i & 3); }

struct Unit { int pm, pn; };
struct Gemm { const bf16_t* A; const bf16_t* Bt; int M, N, K; };
struct StaticOrder {
    int nM, nN, nwg, G, c;
    __host__ __device__ void init(int M, int N, int G_, int c_) { nM = M / BM; nN = N / BM; nwg = nM * nN; G = G_; c = c_; }
    __host__ __device__ bool next(int i, Unit& u) const {
        const long L = (long)i * G + c; if (L >= nwg) return false;
        int wgid = (int)L; { const int q = nwg / NXCD, r = nwg % NXCD, xcd = wgid % NXCD, off = wgid / NXCD; wgid = (xcd < r ? xcd * (q + 1) : r * (q + 1) + (xcd - r) * q) + off; }
        const int nig = WGM * nN, gid = wgid / nig, fm = gid * WGM, gsz = (nM - fm) < WGM ? (nM - fm) : WGM;
        u.pm = fm + ((wgid % nig) % gsz); u.pn = (wgid % nig) / gsz; return true;
    }
    __device__ __forceinline__ void a_ready(const Unit&) const {}
    __device__ __forceinline__ void done(const Unit&) const {}
};

struct PairOrder {
    int G, c;
    __device__ __forceinline__ bool next(int i, Unit& u) const { const int pair = (i >> 1) * G + c; if (pair >= 256) return false; u.pm = pair >> 2; u.pn = 2 * (pair & 3) + (i & 1); return true; }
    __device__ __forceinline__ void a_ready(const Unit&) const {}
    __device__ __forceinline__ void done(const Unit&) const {}
};
template <class Epi, class Sched, bool ALIGN_EPI = false, bool SP2 = false>
__device__ __forceinline__ void gemm_phase(PG8_LAS unsigned char* lds, const Gemm g, const Sched& S, const Epi& E, int tid) {
    const int wid = __builtin_amdgcn_readfirstlane(tid >> 6), lane = tid & 63, wr = wid >> 2, wc = wid & 3, fr = lane & 15, fq = lane >> 4;
    const int K = g.K, nt = K / BK;
    unsigned voffA[2], voffB[2];
#pragma unroll
    for (int i = 0; i < 2; ++i) { int R, C; stage_rc(tid * 16 + i * 8192, R, C); const int Rb = Epi::PERM ? ((R & ~31) + perm32(R & 31)) : R;
        voffA[i] = (unsigned)(R * K + C) * 2u; voffB[i] = (unsigned)(Rb * K + C) * 2u; }
    const size_t kstep = (size_t)(BK * 2);
    const size_t hstep = (size_t)HALF * K * 2;
    const size_t tstep = 2 * hstep;
    const unsigned ldsw = (unsigned)wid * 1024u;
    const int aoff = lds_byte(wr * 64 + fr, fq * 8), boff = lds_byte(wc * 32 + fr, fq * 8);
#define PG8_SA(b, h) (((b) * 2 + (h)) * HTB)
#define PG8_SB(b, h) ((4 + (b) * 2 + (h)) * HTB)
#define PG8_STAGE(bufoff, gbase, voff) do { _Pragma("unroll") for (int _i = 0; _i < 2; ++_i) \
        __builtin_amdgcn_global_load_lds((const unsigned*)((const char*)(gbase) + (voff)[_i]), (PG8_LAS unsigned*)(lds + (bufoff) + ldsw + _i * 8192), 16, 0, 0); } while (0)
#define PG8_LDA(dst, b, h) do { _Pragma("unroll") for (int m = 0; m < 4; ++m) _Pragma("unroll") for (int k = 0; k < 2; ++k) dst[m][k] = *(const PG8_LAS bf16x8*)(lds + PG8_SA(b, h) + aoff + m * 2048 + k * 1024); } while (0)
#define PG8_LDB(dst, b, h) do { _Pragma("unroll") for (int n = 0; n < 2; ++n) _Pragma("unroll") for (int k = 0; k < 2; ++k) dst[n][k] = *(const PG8_LAS bf16x8*)(lds + PG8_SB(b, h) + boff + n * 2048 + k * 1024); } while (0)
#define PG8_MMA(ai, bj, At, Bt) do { __builtin_amdgcn_s_setprio(1); _Pragma("unroll") for (int m = 0; m < 4; ++m) _Pragma("unroll") for (int n = 0; n < 2; ++n) _Pragma("unroll") for (int k = 0; k < 2; ++k) \
        acc[ai][bj][m][n] = __builtin_amdgcn_mfma_f32_16x16x32_bf16(Bt[n][k], At[m][k], acc[ai][bj][m][n], 0, 0, 0); __builtin_amdgcn_s_setprio(0); } while (0)
#define PG8_WAIT_V(n) asm volatile("s_waitcnt vmcnt(" #n ")" ::: "memory")
#define PG8_WAIT_L(n) asm volatile("s_waitcnt lgkmcnt(" #n ")" ::: "memory")
#define PG8_BAR __builtin_amdgcn_s_barrier()
#define PG8_SCHED __builtin_amdgcn_sched_barrier(0)
    Unit cur, nxt; int ui = 0;
    if (!S.next(0, cur)) return;
    f32x4 acc[2][2][4][2];
#pragma unroll
    for (int a = 0; a < 2; ++a)
#pragma unroll
        for (int b = 0; b < 2; ++b)
#pragma unroll
            for (int m = 0; m < 4; ++m)
#pragma unroll
                for (int n = 0; n < 2; ++n) acc[a][b][m][n] = (f32x4){0.f, 0.f, 0.f, 0.f};
    bf16x8 At[4][2], B0[2][2], B1[2][2];
    const char* cA = (const char*)g.A + (size_t)cur.pm * tstep; const char* cB = (const char*)g.Bt + (size_t)cur.pn * tstep;
    S.a_ready(cur);
    if constexpr (SP2) {
        PG8_STAGE(PG8_SB(0, 0), cB, voffB); PG8_STAGE(PG8_SB(0, 1), cB + hstep, voffB); PG8_STAGE(PG8_SA(0, 0), cA, voffA); PG8_STAGE(PG8_SA(0, 1), cA + hstep, voffA);
        if (wr == 1) PG8_BAR;
        PG8_WAIT_V(2); PG8_BAR;
        PG8_STAGE(PG8_SB(1, 0), cB + kstep, voffB); PG8_STAGE(PG8_SA(1, 0), cA + kstep, voffA); PG8_STAGE(PG8_SB(1, 1), cB + hstep + kstep, voffB);
        PG8_WAIT_V(6); PG8_BAR;
    } else {
        PG8_STAGE(PG8_SB(0, 0), cB, voffB); PG8_STAGE(PG8_SA(0, 0), cA, voffA); PG8_STAGE(PG8_SB(0, 1), cB + hstep, voffB); PG8_STAGE(PG8_SA(0, 1), cA + hstep, voffA);
        if (wr == 1) PG8_BAR;
        PG8_WAIT_V(4); PG8_BAR;
        PG8_STAGE(PG8_SB(1, 0), cB + kstep, voffB); PG8_STAGE(PG8_SA(1, 0), cA + kstep, voffA); PG8_STAGE(PG8_SB(1, 1), cB + hstep + kstep, voffB);
        PG8_WAIT_V(6); PG8_BAR;
    }
    for (;;) {
        const bool has_next = S.next(ui + 1, nxt);
        const char* nA = has_next ? (const char*)g.A + (size_t)nxt.pm * tstep : cA; const char* nB = has_next ? (const char*)g.Bt + (size_t)nxt.pn * tstep : cB;
        for (int t = 0; t < nt; t += 2) {
            const bool last = (t == nt - 2);
            const char* a1 = cA + (size_t)(t + 1) * kstep;
            const char* a2 = last ? nA : cA + (size_t)(t + 2) * kstep; const char* b2 = last ? nB : cB + (size_t)(t + 2) * kstep;
            const char* a3 = a2 + kstep; const char* b3 = b2 + kstep;
            if (last && has_next) S.a_ready(nxt);
            if constexpr (SP2) {
            PG8_LDB(B0, 0, 0); PG8_LDB(B1, 0, 1); PG8_SCHED; PG8_LDA(At, 0, 0); PG8_STAGE(PG8_SA(1, 1), a1 + hstep, voffA);
            PG8_WAIT_V(8); PG8_WAIT_L(0); PG8_BAR; PG8_MMA(0, 0, At, B0); PG8_MMA(0, 1, At, B1); PG8_BAR; PG8_SCHED;
            PG8_LDA(At, 0, 1); PG8_STAGE(PG8_SB(0, 0), b2, voffB); PG8_STAGE(PG8_SB(0, 1), b2 + hstep, voffB); PG8_STAGE(PG8_SA(0, 0), a2, voffA);
            PG8_WAIT_V(8); PG8_WAIT_L(0); PG8_BAR; PG8_MMA(1, 0, At, B0); PG8_MMA(1, 1, At, B1); PG8_BAR; PG8_SCHED;
            PG8_LDB(B0, 1, 0); PG8_LDB(B1, 1, 1); PG8_SCHED; PG8_LDA(At, 1, 0); PG8_STAGE(PG8_SA(0, 1), a2 + hstep, voffA);
            PG8_WAIT_V(8); PG8_WAIT_L(0); PG8_BAR; PG8_MMA(0, 0, At, B0); PG8_MMA(0, 1, At, B1); PG8_BAR; PG8_SCHED;
            PG8_LDA(At, 1, 1); PG8_STAGE(PG8_SB(1, 0), b3, voffB); PG8_STAGE(PG8_SB(1, 1), b3 + hstep, voffB); PG8_STAGE(PG8_SA(1, 0), a3, voffA);
            PG8_WAIT_V(8); PG8_WAIT_L(0); PG8_BAR; PG8_MMA(1, 0, At, B0); PG8_MMA(1, 1, At, B1); PG8_BAR; PG8_SCHED;
            } else {
            PG8_LDB(B0, 0, 0); PG8_SCHED; PG8_LDA(At, 0, 0); PG8_STAGE(PG8_SA(1, 1), a1 + hstep, voffA);
            PG8_WAIT_L(8); PG8_BAR; PG8_WAIT_L(0); PG8_MMA(0, 0, At, B0); PG8_BAR; PG8_SCHED;
            PG8_LDB(B1, 0, 1); PG8_STAGE(PG8_SB(0, 0), b2, voffB);
            PG8_BAR; PG8_WAIT_L(0); PG8_MMA(0, 1, At, B1); PG8_BAR;
            PG8_LDA(At, 0, 1); PG8_STAGE(PG8_SA(0, 0), a2, voffA);
            PG8_BAR; PG8_WAIT_L(0); PG8_MMA(1, 0, At, B0); PG8_BAR; PG8_SCHED;
            PG8_STAGE(PG8_SB(0, 1), b2 + hstep, voffB);
            PG8_WAIT_V(6); PG8_BAR; PG8_MMA(1, 1, At, B1); PG8_BAR;
            PG8_LDB(B0, 1, 0); PG8_SCHED; PG8_LDA(At, 1, 0); PG8_STAGE(PG8_SA(0, 1), a2 + hstep, voffA);
            PG8_WAIT_L(8); PG8_BAR; PG8_WAIT_L(0); PG8_MMA(0, 0, At, B0); PG8_BAR; PG8_SCHED;
            PG8_LDB(B1, 1, 1); PG8_STAGE(PG8_SB(1, 0), b3, voffB);
            PG8_BAR; PG8_WAIT_L(0); PG8_MMA(0, 1, At, B1); PG8_BAR;
            PG8_LDA(At, 1, 1); PG8_STAGE(PG8_SA(1, 0), a3, voffA);
            PG8_BAR; PG8_WAIT_L(0); PG8_MMA(1, 0, At, B0); PG8_BAR; PG8_SCHED;
            PG8_STAGE(PG8_SB(1, 1), b3 + hstep, voffB);
            PG8_WAIT_V(6); PG8_BAR; PG8_MMA(1, 1, At, B1); PG8_BAR;
            }
        }
        if constexpr (ALIGN_EPI) { if (wr == 0) PG8_BAR; }
        E(acc, cur, wr, wc, fr, fq); S.done(cur);
        if (!has_next) break;
#pragma unroll
        for (int a = 0; a < 2; ++a)
#pragma unroll
            for (int b = 0; b < 2; ++b)
#pragma unroll
                for (int m = 0; m < 4; ++m)
#pragma unroll
                    for (int n = 0; n < 2; ++n) acc[a][b][m][n] = (f32x4){0.f, 0.f, 0.f, 0.f};
        cur = nxt; cA = nA; cB = nB; ++ui;
        if constexpr (ALIGN_EPI) { if (wr == 1) PG8_BAR; }
    }
    PG8_WAIT_V(0);
    if constexpr (!ALIGN_EPI) { if (wr == 0) PG8_BAR; }
    PG8_BAR;
#undef PG8_SA
#undef PG8_SB
#undef PG8_STAGE
#undef PG8_LDA
#undef PG8_LDB
#undef PG8_MMA
#undef PG8_WAIT_V
#undef PG8_WAIT_L
#undef PG8_BAR
#undef PG8_SCHED
}
}

struct Params {
    const float* x; const float* c; const int* pos; const float* mod_w; const float* mod_b; const float* norm_g;
    const float* ret_w_in; const float* ret_w_out; const float* fox_w_in; const float* fox_b_f; const float* fox_q_gain; const float* fox_k_gain; const float* fox_w_out;
    const float* gla_w_in; const float* gla_w_gate2; const float* gla_b_gate; const float* gla_w_out; const float* final_g;
    float* out; unsigned char* ws;
};

template <int DK> __device__ __forceinline__ size_t frag_img_off(int row, int head, int ch0) {
    const int b = row >> 12, tok = row & 4095;
    return (size_t)((b * 4 + head) * 64 + (tok >> 6)) * (64 * DK * 2) + (size_t)((((ch0 >> 5) * 4 + ((tok >> 4) & 3)) * 64 + 16 * ((ch0 >> 3) & 3) + (tok & 15)) * 16 + 2 * (ch0 & 7));
}
struct EpiRetIn {
    static constexpr bool PERM = false;
    bf16_t* Q; bf16_t* Kb; bf16_t* V; const unsigned* rope;
    __device__ __forceinline__ void operator()(const f32x4 (&acc)[2][2][4][2], const pg8::Unit& u, int wr, int wc, int fr, int fq) const {
        const int pn = u.pn;
        if (pn < 8) {
            bf16_t* dst = (pn < 4) ? Q : Kb; const int head = pn & 3; const float sc = (pn < 4) ? 0.0625f : 1.0f;
#pragma unroll
            for (int ai = 0; ai < 2; ++ai) {
                u32x4 cs[4][2];
#pragma unroll
                for (int m = 0; m < 4; ++m)
#pragma unroll
                    for (int n = 0; n < 2; ++n) cs[m][n] = *(const u32x4*)(rope + (size_t)(u.pm * 256 + ai * 128 + wr * 64 + m * 16 + fr) * 128 + wc * 32 + n * 16 + fq * 4);
                asm volatile("" ::: "memory");
#pragma unroll
                for (int m = 0; m < 4; ++m) {
                    const int row = u.pm * 256 + ai * 128 + wr * 64 + m * 16 + fr;
#pragma unroll
                    for (int n = 0; n < 2; ++n) {
                        const int d1 = wc * 32 + n * 16 + fq * 4;
                        const f32x4 x1 = acc[ai][0][m][n], x2 = acc[ai][1][m][n]; f32x4 o1, o2;
#pragma unroll
                        for (int j = 0; j < 4; ++j) {
                            const unsigned w = cs[m][n][j];
                            const float co = (float)__builtin_bit_cast(_Float16, (unsigned short)(w & 0xffffu)), si = (float)__builtin_bit_cast(_Float16, (unsigned short)(w >> 16));
                            o1[j] = (x1[j] * co - x2[j] * si) * sc; o2[j] = (x1[j] * si + x2[j] * co) * sc;
                        }
                        char* p = (char*)dst + frag_img_off<256>(row, head, d1);
                        *(u32x2*)p = pk4(o1); *(u32x2*)(p + 16384) = pk4(o2);
                    }
                }
            }
        } else {
            const int cbase = (pn - 8) * 256;
#pragma unroll
            for (int ai = 0; ai < 2; ++ai)
#pragma unroll
                for (int m = 0; m < 4; ++m) {
                    const int row = u.pm * 256 + ai * 128 + wr * 64 + m * 16 + fr;
#pragma unroll
                    for (int bj = 0; bj < 2; ++bj)
#pragma unroll
                        for (int n = 0; n < 2; ++n) *(u32x2*)(V + (size_t)row * 2048 + cbase + bj * 128 + wc * 32 + n * 16 + fq * 4) = pk4(acc[ai][bj][m][n]);
                }
        }
    }
};
struct EpiSplit {
    static constexpr bool PERM = false;
    bf16_t* dst; int tpg; size_t gstride; int ldc; int silu_grp;
    __device__ __forceinline__ void operator()(const f32x4 (&acc)[2][2][4][2], const pg8::Unit& u, int wr, int wc, int fr, int fq) const {
        const int t = u.pn / tpg; bf16_t* base = dst + (size_t)t * gstride; const int cb = (u.pn - t * tpg) * 256; const bool act = (t == silu_grp);
#pragma unroll
        for (int ai = 0; ai < 2; ++ai)
#pragma unroll
            for (int m = 0; m < 4; ++m) {
                const int row = u.pm * 256 + ai * 128 + wr * 64 + m * 16 + fr;
#pragma unroll
                for (int bj = 0; bj < 2; ++bj)
#pragma unroll
                    for (int n = 0; n < 2; ++n) {
                        f32x4 a = acc[ai][bj][m][n];
                        if (act) {
#pragma unroll
                            for (int j = 0; j < 4; ++j) a[j] = silu_f(a[j]);
                        }
                        *(u32x2*)(base + (size_t)row * ldc + cb + bj * 128 + wc * 32 + n * 16 + fq * 4) = pk4(a);
                    }
            }
    }
};
struct EpiFoxIn {
    static constexpr bool PERM = false;
    bf16_t* dst; const float* qgain; const float* kgain; LAS float* tbl;
    __device__ __forceinline__ void operator()(const f32x4 (&acc)[2][2][4][2], const pg8::Unit& u, int wr, int wc, int fr, int fq) const {
        const int t = u.pn >> 2; bf16_t* base = dst + (size_t)t * ((size_t)16 * MiB); const int cb = (u.pn & 3) * 256;
        if (t < 2) {
#pragma unroll
            for (int ai = 0; ai < 2; ++ai)
#pragma unroll
                for (int m = 0; m < 4; ++m)
#pragma unroll
                    for (int bj = 0; bj < 2; ++bj) {
                        float sq = 0.f;
#pragma unroll
                        for (int n = 0; n < 2; ++n) { const f32x4 a = acc[ai][bj][m][n]; sq += (a[0] * a[0] + a[1] * a[1]) + (a[2] * a[2] + a[3] * a[3]); }
                        sq = xsum_16_32(sq);
                        if (fq == 0) tbl[(((ai * 128 + wr * 64 + m * 16 + fr) * 4) + bj * 2 + (wc >> 1)) * 2 + (wc & 1)] = sq;
                    }
            asm volatile("s_waitcnt lgkmcnt(0)" ::: "memory"); __builtin_amdgcn_s_barrier(); asm volatile("" ::: "memory");
            const float* gn = (t == 0) ? qgain : kgain; const float sc = (t == 0) ? (0.125f * LOG2E) : 1.0f;
            f32x4 gv[2];
#pragma unroll
            for (int n = 0; n < 2; ++n) gv[n] = *(const f32x4*)(gn + (wc & 1) * 32 + n * 16 + fq * 4) * sc;
#pragma unroll
            for (int ai = 0; ai < 2; ++ai)
#pragma unroll
                for (int m = 0; m < 4; ++m) {
                    const int rl = ai * 128 + wr * 64 + m * 16 + fr; const int row = u.pm * 256 + rl;
#pragma unroll
                    for (int bj = 0; bj < 2; ++bj) {
                        const f32x2 pr = *(const LAS f32x2*)(tbl + ((rl * 4) + bj * 2 + (wc >> 1)) * 2);
                        const float rstd = __builtin_amdgcn_rsqf((pr.x + pr.y) * (1.0f / 64.0f) + EPS);
#pragma unroll
                        for (int n = 0; n < 2; ++n) *(u32x2*)(base + (size_t)row * 1024 + cb + bj * 128 + wc * 32 + n * 16 + fq * 4) = pk4(acc[ai][bj][m][n] * rstd * gv[n]);
                    }
                }
        } else {
            const bool act = (t == 3);
#pragma unroll
            for (int ai = 0; ai < 2; ++ai)
#pragma unroll
                for (int m = 0; m < 4; ++m) {
                    const int row = u.pm * 256 + ai * 128 + wr * 64 + m * 16 + fr;
#pragma unroll
                    for (int bj = 0; bj < 2; ++bj)
#pragma unroll
                        for (int n = 0; n < 2; ++n) {
                            f32x4 a = acc[ai][bj][m][n];
                            if (act) {
#pragma unroll
                                for (int j = 0; j < 4; ++j) a[j] = silu_f(a[j]);
                            }
                            *(u32x2*)(base + (size_t)row * 1024 + cb + bj * 128 + wc * 32 + n * 16 + fq * 4) = pk4(a);
                        }
                }
        }
    }
};
struct EpiGlaIn {
    static constexpr bool PERM = false;
    bf16_t *QE, *QN, *KE, *KN, *V, *G; const float* CB;
    __device__ __forceinline__ void operator()(const f32x4 (&acc)[2][2][4][2], const pg8::Unit& u, int wr, int wc, int fr, int fq) const {
        const int pn = u.pn;
        if (pn < 4) {
            const float s = (pn < 2) ? 0.08838834764831845f : 1.0f;
            bf16_t* De = (pn < 2 ? QE : KE); bf16_t* Dn = (pn < 2 ? QN : KN);
#pragma unroll
            for (int ai = 0; ai < 2; ++ai)
#pragma unroll
            for (int mh = 0; mh < 2; ++mh) {
                f32x4 cb[2][2][2];
#pragma unroll
                for (int mm = 0; mm < 2; ++mm)
#pragma unroll
                    for (int bj = 0; bj < 2; ++bj)
#pragma unroll
                        for (int n = 0; n < 2; ++n) cb[mm][bj][n] = *(const f32x4*)(CB + (size_t)(u.pm * 256 + ai * 128 + wr * 64 + (2 * mh + mm) * 16 + fr) * 512 + (pn & 1) * 256 + bj * 128 + wc * 32 + n * 16 + fq * 4);
                asm volatile("" ::: "memory");
#pragma unroll
                for (int mm = 0; mm < 2; ++mm) {
                    const int m = 2 * mh + mm; const int row = u.pm * 256 + ai * 128 + wr * 64 + m * 16 + fr;
#pragma unroll
                    for (int bj = 0; bj < 2; ++bj)
#pragma unroll
                        for (int n = 0; n < 2; ++n) {
                            const int col = (pn & 1) * 256 + bj * 128 + wc * 32 + n * 16 + fq * 4;
                            const f32x4 a = acc[ai][bj][m][n]; f32x4 e, en;
#pragma unroll
                            for (int j = 0; j < 4; ++j) { const float ee = __expf(cb[mm][bj][n][j]); e[j] = a[j] * s * ee; en[j] = a[j] * s * __builtin_amdgcn_rcpf(ee); }
                            const size_t io = frag_img_off<128>(row, col >> 7, col & 127);
                            *(u32x2*)((char*)De + io) = pk4(e); *(u32x2*)((char*)Dn + io) = pk4(en);
                        }
                }
                asm volatile("" ::: "memory");
            }
        } else {
#pragma unroll
            for (int ai = 0; ai < 2; ++ai)
#pragma unroll
                for (int m = 0; m < 4; ++m) {
                    const int row = u.pm * 256 + ai * 128 + wr * 64 + m * 16 + fr;
#pragma unroll
                    for (int bj = 0; bj < 2; ++bj)
#pragma unroll
                        for (int n = 0; n < 2; ++n) *(u32x2*)(V + (size_t)row * 1024 + (pn - 4) * 256 + bj * 128 + wc * 32 + n * 16 + fq * 4) = pk4(acc[ai][bj][m][n]);
                }
        }
    }
};
struct EpiNone {
    static constexpr bool PERM = false; float* sink;
    __device__ __forceinline__ void operator()(const f32x4 (&acc)[2][2][4][2], const pg8::Unit& u, int wr, int wc, int fr, int fq) const {
        f32x4 t = acc[0][0][0][0];
#pragma unroll
        for (int ai = 0; ai < 2; ++ai)
#pragma unroll
            for (int bj = 0; bj < 2; ++bj)
#pragma unroll
                for (int m = 0; m < 4; ++m)
#pragma unroll
                    for (int n = 0; n < 2; ++n) t += acc[ai][bj][m][n];
        if (t[0] + t[1] + t[2] + t[3] == 12345.678f) sink[0] = t[0];
    }
};
struct EpiOut {
    static constexpr bool PERM = false;
    const float* xold; float* xnew; const float* gate;
    __device__ __forceinline__ void operator()(const f32x4 (&acc)[2][2][4][2], const pg8::Unit& u, int wr, int wc, int fr, int fq) const {
        const int b = (u.pm * 256) >> 12;
        f32x4 gv[2][2];
#pragma unroll
        for (int bj = 0; bj < 2; ++bj)
#pragma unroll
            for (int n = 0; n < 2; ++n) gv[bj][n] = *(const f32x4*)(gate + (size_t)b * 3072 + u.pn * 256 + bj * 128 + wc * 32 + n * 16 + fq * 4);
#pragma unroll
        for (int ai = 0; ai < 2; ++ai)
#pragma unroll
            for (int mh = 0; mh < 2; ++mh) {
                f32x4 xo[2][2][2];
#pragma unroll
                for (int mm = 0; mm < 2; ++mm)
#pragma unroll
                    for (int bj = 0; bj < 2; ++bj)
#pragma unroll
                        for (int n = 0; n < 2; ++n) xo[mm][bj][n] = *(const f32x4*)(xold + (size_t)(u.pm * 256 + ai * 128 + wr * 64 + (2 * mh + mm) * 16 + fr) * 1024 + u.pn * 256 + bj * 128 + wc * 32 + n * 16 + fq * 4);
                asm volatile("" ::: "memory");
#pragma unroll
                for (int mm = 0; mm < 2; ++mm)
#pragma unroll
                    for (int bj = 0; bj < 2; ++bj)
#pragma unroll
                        for (int n = 0; n < 2; ++n)
                            *(f32x4*)(xnew + (size_t)(u.pm * 256 + ai * 128 + wr * 64 + (2 * mh + mm) * 16 + fr) * 1024 + u.pn * 256 + bj * 128 + wc * 32 + n * 16 + fq * 4) = xo[mm][bj][n] + gv[bj][n] * acc[ai][bj][2 * mh + mm][n];
                asm volatile("" ::: "memory");
            }
    }
};

__device__ __forceinline__ void transpose_item(const float* W, int ldw, int K, int nblk, bf16_t* WT, LAS float* scr, int item, int lane) {
    const int kb = item / nblk, nb = item % nblk, k0 = 64 * kb, n0 = 32 * nb;
#pragma unroll 8
    for (int i = 0; i < 32; ++i) { const int kk = 2 * i + (lane >> 5); scr[kk * 33 + (lane & 31)] = W[(size_t)(k0 + kk) * ldw + n0 + (lane & 31)]; }
    LDS_WAIT(); asm volatile("" ::: "memory");
    const int c = lane & 7;
#pragma unroll
    for (int j = 0; j < 4; ++j) { const int n = (lane >> 3) + 8 * j; const LAS float* s = scr + (8 * c) * 33 + n;
        u32x4 o; o.x = pk2(s[0 * 33], s[1 * 33]); o.y = pk2(s[2 * 33], s[3 * 33]); o.z = pk2(s[4 * 33], s[5 * 33]); o.w = pk2(s[6 * 33], s[7 * 33]);
        *(u32x4*)(WT + (size_t)(n0 + n) * K + k0 + 8 * c) = o; }
    LDS_WAIT(); asm volatile("" ::: "memory");
}
__device__ __forceinline__ void conv_weights(const float* w_in, int ld_in, int n_in, const float* w_out, int k_out, unsigned char* wdst, LAS unsigned char* lds, int tid, int bid, int G) {
    const int lane = tid & 63, wave = tid >> 6;
    LAS float* scr = (LAS float*)(lds + wave * 16384);
    const int gw = bid * 8 + wave, NGW = G * 8;
    const int I_in = (1024 / 64) * (n_in / 32), I_out = (k_out / 64) * (1024 / 32);
    bf16_t* WinT = (bf16_t*)wdst; bf16_t* WoutT = (bf16_t*)(wdst + 12 * MiB);
    for (int it = gw; it < I_in + I_out; it += NGW) {
        if (it < I_in) transpose_item(w_in, ld_in, 1024, n_in / 32, WinT, scr, it, lane);
        else transpose_item(w_out, 1024, k_out, 32, WoutT, scr, it - I_in, lane);
    }
}
__device__ __forceinline__ void p0_mod(const Params& P, LAS unsigned char* lds, int tid, int bid, int G) {
    LAS float* sc = (LAS float*)lds;
    LAS float* red = sc + 4096;
    const int lane = tid & 63, wave = tid >> 6;
    float* MOD = (float*)(P.ws + WS_MOD);
    for (int i = tid; i < 4096; i += 512) sc[i] = silu_f(P.c[i]);
    __syncthreads();
    for (int it = bid; it < 192; it += G) {
        const int l = it / 48, cb = it % 48, n = cb * 64 + lane;
        const float* W = P.mod_w + (size_t)l * 1024 * 3072 + n;
        float a0 = 0.f, a1 = 0.f, a2 = 0.f, a3 = 0.f;
        const int k0 = wave * 128;
#pragma unroll 8
        for (int k = k0; k < k0 + 128; ++k) { const float w = W[(size_t)k * 3072]; a0 += sc[k] * w; a1 += sc[1024 + k] * w; a2 += sc[2048 + k] * w; a3 += sc[3072 + k] * w; }
        red[(wave * 4 + 0) * 64 + lane] = a0; red[(wave * 4 + 1) * 64 + lane] = a1; red[(wave * 4 + 2) * 64 + lane] = a2; red[(wave * 4 + 3) * 64 + lane] = a3;
        __syncthreads();
        if (wave < 4) { float s = 0.f;
#pragma unroll
            for (int w = 0; w < 8; ++w) s += red[(w * 4 + wave) * 64 + lane];
            MOD[(size_t)(l * 4 + wave) * 3072 + n] = s + P.mod_b[l * 3072 + n]; }
        __syncthreads();
    }
}
__device__ __forceinline__ void p0_rope(const Params& P, int tid, int bid, int G) {
    unsigned* rope = (unsigned*)(P.ws + WS_ROPE);
    const int gt = bid * 512 + tid, NT = G * 512;
    for (int idx = gt; idx < MT * 128; idx += NT) {
        const int row = idx >> 7, d = idx & 127;
        const float inv = powf(10000.0f, -(float)d * (1.0f / 128.0f));
        const float ang = (float)P.pos[row] * inv;
        double t = (double)ang * 0.15915494309189535; t -= rint(t);
        const float fr = (float)t;
        const float co = __builtin_amdgcn_cosf(fr), si = __builtin_amdgcn_sinf(fr);
        const unsigned lo = __builtin_bit_cast(unsigned short, (_Float16)co), hi = __builtin_bit_cast(unsigned short, (_Float16)si);
        rope[idx] = lo | (hi << 16);
    }
}

template <int KIND>
__device__ __forceinline__ void h_phase(const Params& P, int layer, const float* xin, LAS unsigned char* lds, int tid, int bid, int G) {
    const int lane = tid & 63, wave = tid >> 6;
    LAS float* WxT = (LAS float*)lds;
    LAS float* W2 = (LAS float*)(lds + 65536);
    LAS float* TOT = (LAS float*)(lds + 98304);
    const float* MOD = (const float*)(P.ws + WS_MOD);
    bf16_t* XN = (bf16_t*)(P.ws + WS_XN);
    if (KIND > 0) {
        const float* wsrc = (KIND == 1) ? (P.fox_w_in + 4096) : (P.gla_w_in + 3072); const int ldw = (KIND == 1) ? FOX_IN : GLA_IN;
        {
            float wv[32];
#pragma unroll
            for (int it = 0; it < 32; ++it) { const int idx = tid + 512 * it; wv[it] = wsrc[(size_t)(idx >> 4) * ldw + (idx & 15)]; }
#pragma unroll
            for (int it = 0; it < 32; ++it) { const int idx = tid + 512 * it; WxT[(idx & 15) * 1024 + (idx >> 4)] = wv[it]; }
        }
        if (KIND == 2) {
            float w2v[16];
#pragma unroll
            for (int it = 0; it < 16; ++it) w2v[it] = P.gla_w_gate2[tid + 512 * it];
#pragma unroll
            for (int it = 0; it < 16; ++it) W2[tid + 512 * it] = w2v[it];
        }
        __syncthreads();
    }
    for (int ci = bid; ci < MT / 64; ci += G) {
        const int b = ci >> 6;
        if (KIND != 1) ((float*)(P.ws + WS_S16))[ci * 512 + tid] = 0.f;
        const float* mod = MOD + (size_t)(layer * 4 + b) * 3072;
        f32x4 ga[4], sh[4];
#pragma unroll
        for (int j = 0; j < 4; ++j) { const int col = 4 * lane + 256 * j;
            const f32x4 g4 = *(const f32x4*)(P.norm_g + layer * 1024 + col), s4 = *(const f32x4*)(mod + 1024 + col);
            ga[j] = g4 * (s4 + 1.0f); sh[j] = *(const f32x4*)(mod + col); }
        float run[8]; f32x4 cbv[8][2];
        if (KIND == 2) {
#pragma unroll
            for (int c = 0; c < 8; ++c) run[c] = 0.f;
        }
        if constexpr (false) {
        constexpr int BS = (KIND == 2) ? 2 : 4;
#pragma unroll (KIND == 2 ? 8 / BS : 1)
        for (int rb = 0; rb < 8; rb += BS) {
            asm volatile("" ::: "memory");
            f32x4 xv[BS][4];
#pragma unroll
            for (int bb = 0; bb < BS; ++bb) { const f32x4* xr = (const f32x4*)(xin + (size_t)(ci * 64 + wave * 8 + rb + bb) * 1024) + lane;
#pragma unroll
                for (int j = 0; j < 4; ++j) xv[bb][j] = xr[64 * j]; }
#pragma unroll
        for (int bb = 0; bb < BS; ++bb) {
            const int rr = rb + bb;
            asm volatile("" ::: "memory");
            const int row = ci * 64 + wave * 8 + rr;
            f32x4 v[4]; float ss = 0.f;
#pragma unroll
            for (int j = 0; j < 4; ++j) { v[j] = xv[bb][j]; ss += (v[j][0] * v[j][0] + v[j][1] * v[j][1]) + (v[j][2] * v[j][2] + v[j][3] * v[j][3]); }
            const float rstd = rsqrtf(wave_sum(ss) * (1.0f / 1024.0f) + EPS);
#pragma unroll
            for (int j = 0; j < 4; ++j) { v[j] = (v[j] * rstd) * ga[j] + sh[j]; *(u32x2*)(XN + (size_t)row * 1024 + 4 * lane + 256 * j) = pk4(v[j]); }
            if (KIND > 0) {
                float r[16];
#pragma unroll
                for (int i = 0; i < 16; ++i) { float a = 0.f;
#pragma unroll
                    for (int j = 0; j < 4; ++j) { const f32x4 w = *(const LAS f32x4*)(WxT + i * 1024 + 4 * lane + 256 * j); a += (v[j][0] * w[0] + v[j][1] * w[1]) + (v[j][2] * w[2] + v[j][3] * w[3]); }
                    r[i] = a; }
                if (KIND == 1) {
                    const float e1 = reduce_scatter16(r, lane);
                    const int idx = ((lane >> 5) & 1) * 8 + ((lane >> 4) & 1) * 4 + ((lane >> 3) & 1) * 2 + ((lane >> 2) & 1);
                    if ((lane & 3) == 0) ((float*)(P.ws + WS_S16))[(size_t)row * 16 + idx] = logsig_f(e1 + P.fox_b_f[idx]);
                } else {
                    f32x4 z0 = *(const f32x4*)(P.gla_b_gate + 8 * lane), z1 = *(const f32x4*)(P.gla_b_gate + 8 * lane + 4);
#pragma unroll
                    for (int i = 0; i < 16; ++i) { const f32x4 w0 = *(const LAS f32x4*)(W2 + i * 512 + 8 * lane), w1 = *(const LAS f32x4*)(W2 + i * 512 + 8 * lane + 4); z0 += w0 * r[i]; z1 += w1 * r[i]; }
#pragma unroll
                    for (int c = 0; c < 4; ++c) { run[c] += logsig_f(z0[c]) * 0.0625f; run[4 + c] += logsig_f(z1[c]) * 0.0625f; }
                    cbv[rr][0] = (f32x4){run[0], run[1], run[2], run[3]}; cbv[rr][1] = (f32x4){run[4], run[5], run[6], run[7]};
                }
            }
        }
        }
        } else {
        constexpr int BS = (KIND == 2) ? 2 : 4;
#pragma unroll (KIND != 0 ? 8 / BS : 1)
        for (int rb = 0; rb < 8; rb += BS) {
            asm volatile("" ::: "memory");
            f32x4 v[BS][4];
#pragma unroll
            for (int bb = 0; bb < BS; ++bb) { const f32x4* xr = (const f32x4*)(xin + (size_t)(ci * 64 + wave * 8 + rb + bb) * 1024) + lane;
#pragma unroll
                for (int j = 0; j < 4; ++j) v[bb][j] = xr[64 * j]; }
#pragma unroll
            for (int bb = 0; bb < BS; ++bb) {
                const int row = ci * 64 + wave * 8 + rb + bb; float ss = 0.f;
#pragma unroll
                for (int j = 0; j < 4; ++j) ss += (v[bb][j][0] * v[bb][j][0] + v[bb][j][1] * v[bb][j][1]) + (v[bb][j][2] * v[bb][j][2] + v[bb][j][3] * v[bb][j][3]);
                const float rstd = rsqrtf(wave_sum(ss) * (1.0f / 1024.0f) + EPS);
#pragma unroll
                for (int j = 0; j < 4; ++j) { v[bb][j] = (v[bb][j] * rstd) * ga[j] + sh[j]; *(u32x2*)(XN + (size_t)row * 1024 + 4 * lane + 256 * j) = pk4(v[bb][j]); }
            }
            if (KIND > 0) {
                float acc[BS][16];
#pragma unroll
                for (int i = 0; i < 16; ++i) {
                    f32x4 w[4];
#pragma unroll
                    for (int j = 0; j < 4; ++j) w[j] = *(const LAS f32x4*)(WxT + i * 1024 + 4 * lane + 256 * j);
#pragma unroll
                    for (int bb = 0; bb < BS; ++bb) { float a = 0.f;
#pragma unroll
                        for (int j = 0; j < 4; ++j) a += (v[bb][j][0] * w[j][0] + v[bb][j][1] * w[j][1]) + (v[bb][j][2] * w[j][2] + v[bb][j][3] * w[j][3]);
                        acc[bb][i] = a; }
                    if (i & 1) { __builtin_amdgcn_sched_barrier(0); asm volatile("" ::: "memory"); }
                }
#pragma unroll
                for (int bb = 0; bb < BS; ++bb) {
                    const int rr = rb + bb, row = ci * 64 + wave * 8 + rr;
                    asm volatile("" ::: "memory");
                    const float e1 = reduce_scatter16(acc[bb], lane);
                    if (KIND == 1) {
                        const int idx = ((lane >> 5) & 1) * 8 + ((lane >> 4) & 1) * 4 + ((lane >> 3) & 1) * 2 + ((lane >> 2) & 1);
                        ((float*)(P.ws + WS_S16))[(size_t)row * 16 + idx] = logsig_f(e1 + P.fox_b_f[idx]);
                    } else {
                        float r[16];
#pragma unroll
                        for (int i = 0; i < 16; ++i) r[i] = __builtin_bit_cast(float, __builtin_amdgcn_readlane(__builtin_bit_cast(int, e1), ((i >> 3) & 1) * 32 + ((i >> 2) & 1) * 16 + ((i >> 1) & 1) * 8 + (i & 1) * 4));
                        f32x4 z0 = *(const f32x4*)(P.gla_b_gate + 8 * lane), z1 = *(const f32x4*)(P.gla_b_gate + 8 * lane + 4);
#pragma unroll
                        for (int i = 0; i < 16; ++i) { const f32x4 w0 = *(const LAS f32x4*)(W2 + i * 512 + 8 * lane), w1 = *(const LAS f32x4*)(W2 + i * 512 + 8 * lane + 4); z0 += w0 * r[i]; z1 += w1 * r[i]; }
#pragma unroll
                        for (int c = 0; c < 4; ++c) { run[c] += logsig_f(z0[c]) * 0.0625f; run[4 + c] += logsig_f(z1[c]) * 0.0625f; }
                        cbv[rr][0] = (f32x4){run[0], run[1], run[2], run[3]}; cbv[rr][1] = (f32x4){run[4], run[5], run[6], run[7]};
                    }
                }
            }
        }
        }
        if (KIND == 2) {
            float* CB = (float*)(P.ws + WS_ACT + 160 * MiB);
            *(LAS f32x4*)(TOT + wave * 512 + 8 * lane) = (f32x4){run[0], run[1], run[2], run[3]};
            *(LAS f32x4*)(TOT + wave * 512 + 8 * lane + 4) = (f32x4){run[4], run[5], run[6], run[7]};
            __syncthreads();
            f32x4 o0 = (f32x4){0.f, 0.f, 0.f, 0.f}, o1 = o0;
            for (int w = 0; w < wave; ++w) { o0 += *(const LAS f32x4*)(TOT + w * 512 + 8 * lane); o1 += *(const LAS f32x4*)(TOT + w * 512 + 8 * lane + 4); }
#pragma unroll
            for (int rr = 0; rr < 8; ++rr) { const int row = ci * 64 + wave * 8 + rr;
                *(f32x4*)(CB + (size_t)row * 512 + 8 * lane) = cbv[rr][0] + o0; *(f32x4*)(CB + (size_t)row * 512 + 8 * lane + 4) = cbv[rr][1] + o1; }
            __syncthreads();
        }
    }
}

template <int KIND> struct LinCfg {
    static constexpr int DK = KIND == 0 ? 256 : 128, QP = KIND == 0 ? 1024 : 512, VP = KIND == 0 ? 2048 : 1024, HV = KIND == 0 ? 512 : 256;
    static constexpr int NSL = HV / 32, NITEM = 16 * NSL, NKF = DK / 32, RW = DK / 8, NDT = RW / 16, KPITCH = DK * 2 + 32, STP = DK + 8, KCH = DK / 64;
    static constexpr int LDS_ST = 0, LDS_P = 2 * 32 * STP * 2, LDS_V = LDS_P + 2 * 8192, LDS_END = LDS_V + 2 * 2 * 4096;
    static constexpr int NA = DK / 16;
};
__device__ __forceinline__ float ret_log2g(int h) { return (h == 0) ? -0.045803689613124796f : (h == 1) ? -0.02272007650008353f : (h == 2) ? -0.011315313227834146f : -0.005646563141142062f; }

template <int KIND>
__device__ __forceinline__ void lin_pphase(const bf16_t* Qa, bf16_t* Ka, const bf16_t* Qb, const bf16_t* Kb2, bf16_t* Pimg, int tid, int bid, int G) {
    typedef LinCfg<KIND> C;
    const int lane = tid & 63, wave = __builtin_amdgcn_readfirstlane(tid >> 6);
    const int g4 = lane >> 4, i16 = lane & 15;
    bf16x8 idf[2];
#pragma unroll
    for (int sel = 0; sel < 2; ++sel)
#pragma unroll
        for (int j = 0; j < 8; ++j) idf[sel][j] = (short)((8 * g4 + j == i16 + 16 * sel) ? 0x3F80 : 0);
    for (int hw0 = bid * 8; hw0 < 2048; hw0 += G * 8) {
        const int hw = hw0 + wave;
        const int item = hw >> 1, half = hw & 1;
        const int bh = item >> 6, n = item & 63, b = bh >> 2, h = bh & 3;
        const size_t t0 = (size_t)b * SEQ + (size_t)n * 64;
        f32x4 pa[2][4], pb[2][4];
#pragma unroll
        for (int r = 0; r < 2; ++r)
#pragma unroll
            for (int c = 0; c < 4; ++c) { pa[r][c] = (f32x4){0.f, 0.f, 0.f, 0.f}; pb[r][c] = (f32x4){0.f, 0.f, 0.f, 0.f}; }
        constexpr size_t BLK = (size_t)64 * C::DK * 2;
        const char* qa = (const char*)Qa + (size_t)item * BLK + lane * 16; char* ka = (char*)Ka + (size_t)item * BLK + lane * 16;
        const char* qb = (const char*)Qb + (size_t)item * BLK + lane * 16; const char* kb = (const char*)Kb2 + (size_t)item * BLK + lane * 16;
        bf16x8 kall[C::NKF][4];
#pragma unroll
        for (int k = 0; k < C::NKF; ++k)
#pragma unroll
            for (int c = 0; c < 4; ++c) kall[k][c] = *(const bf16x8*)(ka + (k * 4 + c) * 1024);
#pragma unroll
        for (int k = 0; k < C::NKF; ++k) {
            bf16x8 af[2];
#pragma unroll
            for (int r = 0; r < 2; ++r) af[r] = *(const bf16x8*)(qa + (k * 4 + 2 * half + r) * 1024);
#pragma unroll
            for (int r = 0; r < 2; ++r)
#pragma unroll
                for (int c = 0; c < 4; ++c) pa[r][c] = mma_rc(pa[r][c], af[r], kall[k][c]);
            if (KIND == 1) {
                bf16x8 bfr[4];
#pragma unroll
                for (int r = 0; r < 2; ++r) af[r] = *(const bf16x8*)(qb + (k * 4 + 2 * half + r) * 1024);
#pragma unroll
                for (int c = 0; c < 4; ++c) bfr[c] = *(const bf16x8*)(kb + (k * 4 + c) * 1024);
#pragma unroll
                for (int r = 0; r < 2; ++r)
#pragma unroll
                    for (int c = 0; c < 4; ++c) pb[r][c] = mma_rc(pb[r][c], af[r], bfr[c]);
            }
        }
        const float l2g = (KIND == 0) ? ret_log2g(h) : 0.f;
#pragma unroll
        for (int r = 0; r < 2; ++r) {
            const int c = 32 * half + 16 * r + (lane & 15);
#pragma unroll
            for (int ct = 0; ct < 4; ++ct) {
                f32x4 p;
#pragma unroll
                for (int e = 0; e < 4; ++e) { const int mm = 16 * ct + 4 * g4 + e;
                    if (KIND == 0) { const int dd = c > mm ? c - mm : mm - c; p[e] = pa[r][ct][e] * exp2f(l2g * (float)dd); }
                    else p[e] = (c >= mm) ? pa[r][ct][e] : pb[r][ct][e]; }
                const int ks = ct >> 1, gg = 2 * (ct & 1) + (g4 & 1);
                const int off = c * 128 + (((4 * ks + gg) ^ (c & 7)) << 4) + 8 * (g4 >> 1);
                *(u32x2*)((char*)Pimg + (size_t)item * 8192 + off) = pk4(p);
            }
        }
        __syncthreads();
        {
            char* kdst = ka - lane * 16 + (16 * (g4 & 1) + i16) * 16 + 8 * (g4 >> 1);
#define PP_TR(HALF) _Pragma("unroll") for (int k = 0; k < C::NKF; ++k) _Pragma("unroll") for (int sel = 0; sel < 2; ++sel) _Pragma("unroll") for (int T = 0; T < 2; ++T) { \
                const f32x4 tr_ = mma_rc((f32x4){0.f, 0.f, 0.f, 0.f}, idf[sel], kall[k][2 * (HALF) + T]); \
                *(u32x2*)(kdst + ((HALF) * C::NA + 2 * k + sel) * 1024 + T * 512) = pk4(tr_); }
            if (half == 0) { PP_TR(0) } else { PP_TR(1) }
#undef PP_TR
        }
    }
}

typedef short v4i16_t __attribute__((ext_vector_type(4)));
__device__ __forceinline__ bf16x8 trfrag2(const LAS char* p0, int second_off) {
    const v4i16_t a = __builtin_amdgcn_ds_read_tr16_b64_v4i16((LAS v4i16_t*)p0);
    const v4i16_t b = __builtin_amdgcn_ds_read_tr16_b64_v4i16((LAS v4i16_t*)(p0 + second_off));
    return (bf16x8){a[0], a[1], a[2], a[3], b[0], b[1], b[2], b[3]};
}

template <int KIND> struct LsStage { u32x4 x[LinCfg<KIND>::NKF]; u32x4 p; u32x2 v; f32x4 dec[2]; };

template <int KIND, int VAR = 0>
__device__ __forceinline__ void lin_scan(const bf16_t* Qg, const bf16_t* Kg, const bf16_t* Vg, const bf16_t* Pimg, const float* CB, bf16_t* O, float* DUMMY, LAS unsigned char* lds, int tid, int bid, int G) {
    typedef LinCfg<KIND> C;
    const int nit = (G == 256) ? 1 : (C::NITEM + G - 1) / G;
    const int tid0 = tid;
    for (int it = 0; it < nit; ++it) {
        int tid = tid0; asm volatile("" : "+v"(tid));
        const int lane = tid & 63, wave = __builtin_amdgcn_readfirstlane(tid >> 6);
        const int g4 = lane >> 4, i16 = lane & 15, q4 = i16 >> 2, p4 = i16 & 3;
        int item;
        if (G == 256) { const int x = bid & 7, j = bid >> 3; if (KIND == 0) item = x * 32 + j; else { if (j >= 16) break; item = x * 16 + j; } }
        else { item = it * G + bid; if (item >= C::NITEM) break; }
        const int bh = item / C::NSL, dvs = item % C::NSL, b = bh >> 2, h = bh & 3;
        const size_t t0 = (size_t)b * SEQ;
        const int rt = wave & 3; const bool rdw = wave < 4;
        constexpr int RWU = C::DK / 4, NDU = RWU / 16;
        const float l2g = (KIND == 0) ? ret_log2g(h) : 0.f;
        const float qsc = (KIND == 0) ? exp2f(l2g * (float)(16 * rt + i16 + 1)) : 1.0f;
        const float sdec = (KIND == 0) ? exp2f(l2g * 64.0f) : 1.0f;
        const int vm = tid >> 3, vp8 = tid & 7;
        const float vsc = (KIND == 0) ? exp2f(l2g * (float)(63 - vm)) : 1.0f;
        constexpr size_t BLK = (size_t)64 * C::DK * 2;
        const char* xsb = (const char*)(rdw ? Qg : Kg) + (size_t)bh * 64 * BLK + (rdw ? rt * 1024 : NDU * rt * 1024);
        const unsigned xvo = (unsigned)(lane * 16);
        const char* vsb = (const char*)Vg + (t0 * C::VP + h * C::HV + 32 * dvs) * 2;
        char* osb = (char*)O + (t0 * C::VP + h * C::HV + 32 * dvs) * 2;
        const unsigned vvo = (unsigned)((vm * C::VP + 4 * vp8) * 2);
        char* dmb = (char*)DUMMY + (size_t)bid * 4096; const unsigned dmo = (unsigned)(tid * 8);
        const char* psb = (const char*)Pimg + (size_t)bh * 64 * 8192; const unsigned pvo = (unsigned)(tid * 16);
        const char* dcb = (KIND == 1) ? (const char*)CB + ((t0 + 63) * 512 + h * 128 + RWU * rt) * 4 : nullptr; const unsigned dco = (unsigned)(g4 * 16);
        LAS bf16_t* ST = (LAS bf16_t*)(lds + C::LDS_ST);
        LAS char* PI = (LAS char*)(lds + C::LDS_P);
        LAS char* VI = (LAS char*)(lds + C::LDS_V);
        LAS char* OT = (LAS char*)(lds + C::LDS_END);
        const int trow = 16 * (g4 >> 1) + 4 * (g4 & 1) + q4;
        const int voff = trow * 32 + 8 * p4;
        const int poff_row = (16 * rt + i16) * 128, psw = (16 * rt + i16) & 7;

        LsStage<KIND> A, B;
#define LS_LOAD_PV(S, nn) do { const int n_ = (nn) < 64 ? (nn) : 63; \
            unsigned po_ = pvo, vo_ = vvo, do_ = dco; asm volatile("" : "+v"(po_), "+v"(vo_), "+v"(do_)); \
            if (!((VAR & 2) && (nn) >= 2)) { S.p = *(const u32x4*)(psb + (size_t)n_ * 8192 + po_); \
            S.v = *(const u32x2*)(vsb + (size_t)n_ * (64 * C::VP * 2) + vo_); } \
            if (KIND == 1) { _Pragma("unroll") for (int a_ = 0; a_ < NDU; ++a_) S.dec[a_] = *(const f32x4*)(dcb + (size_t)n_ * (64 * 512 * 4) + 64 * a_ + do_); } } while (0)
#define LS_LOAD_X(S, nn) do { const int n_ = (nn) < 64 ? (nn) : 63; \
            if (!((VAR & 1) && (nn) >= 2)) { const char* xs_ = xsb + (size_t)n_ * BLK; unsigned xo_ = xvo; asm volatile("" : "+v"(xo_));        \
                _Pragma("unroll") for (int k_ = 0; k_ < C::NKF; ++k_) S.x[k_] = *(const u32x4*)(xs_ + (size_t)(rdw ? k_ * 4096 : ((k_ / NDU) * C::NA + (k_ % NDU)) * 1024) + xo_); } } while (0)
#define LS_LOAD(S, nn) do { LS_LOAD_PV(S, nn); LS_LOAD_X(S, nn); } while (0)
#define LS_WRITE(S, img) do { \
            *(LAS u32x4*)(PI + (img) * 8192 + tid * 16) = S.p; \
            { LAS char* vd_ = VI + (img) * 8192 + (vp8 >> 2) * 2048 + vm * 32 + (vp8 & 3) * 8; *(LAS u32x2*)vd_ = S.v; \
              if (KIND == 0) { u32x2 w_; w_.x = pk2(bf2f(S.v.x & 0xffffu) * vsc, bf2f(S.v.x >> 16) * vsc); w_.y = pk2(bf2f(S.v.y & 0xffffu) * vsc, bf2f(S.v.y >> 16) * vsc); *(LAS u32x2*)(vd_ + 4096) = w_; } } } while (0)

        for (int i = tid; i < 32 * C::STP / 2; i += 512) ((LAS unsigned*)ST)[i] = 0u;
        f32x4 s[NDU][2];
#pragma unroll
        for (int a = 0; a < NDU; ++a)
#pragma unroll
            for (int e = 0; e < 2; ++e) s[a][e] = (f32x4){0.f, 0.f, 0.f, 0.f};
        LS_LOAD(A, 0); LS_LOAD(B, 1);
        LS_WRITE(A, 0);
        __syncthreads();

#define LS_SB(k) s[1 + (k) / 2][(k) % 2]
#define LS_STEP(n, SC, SN) do { const int img_ = (n) & 1; \
            f32x4 dcur_[2]; if (KIND == 1) { _Pragma("unroll") for (int a_ = 0; a_ < NDU; ++a_) dcur_[a_] = SC.dec[a_]; } \
              \
            LS_LOAD_PV(SC, (n) + 2); \
            if (rdw) { \
                  \
                if (!(VAR & 16)) { \
                const LAS bf16_t* STc_ = ST + img_ * 32 * C::STP; \
                  \
                  \
                _Pragma("unroll") for (int ct_ = 0; ct_ < 2; ++ct_) { \
                    constexpr int HB_ = C::NKF / 2; bf16x8 pf_[2], vf_[2]; \
                    s[0][0] = (f32x4){0.f, 0.f, 0.f, 0.f}; s[0][1] = s[0][0]; \
                    _Pragma("unroll") for (int k_ = 0; k_ < HB_; ++k_) LS_SB(k_) = __builtin_bit_cast(f32x4, lfrag(STc_ + 16 * ct_ * C::STP + 32 * k_, C::STP, lane)); \
                    __builtin_amdgcn_sched_barrier(0); \
                    _Pragma("unroll") for (int k_ = 0; k_ < HB_; k_ += 2) { s[0][0] = mma_rc(s[0][0], __builtin_bit_cast(bf16x8, SC.x[k_]), __builtin_bit_cast(bf16x8, LS_SB(k_))); s[0][1] = mma_rc(s[0][1], __builtin_bit_cast(bf16x8, SC.x[k_ + 1]), __builtin_bit_cast(bf16x8, LS_SB(k_ + 1))); } \
                    __builtin_amdgcn_sched_barrier(0); \
                    _Pragma("unroll") for (int k_ = 0; k_ < HB_; ++k_) LS_SB(k_) = __builtin_bit_cast(f32x4, lfrag(STc_ + 16 * ct_ * C::STP + 32 * (HB_ + k_), C::STP, lane)); \
                    _Pragma("unroll") for (int ks_ = 0; ks_ < 2; ++ks_) { \
                        pf_[ks_] = *(const LAS bf16x8*)(PI + img_ * 8192 + poff_row + (((4 * ks_ + g4) ^ psw) << 4)); \
                        vf_[ks_] = trfrag2(VI + img_ * 8192 + ct_ * 2048 + ks_ * 1024 + voff, 256); } \
                    __builtin_amdgcn_sched_barrier(0); \
                    _Pragma("unroll") for (int k_ = 0; k_ < HB_; k_ += 2) { s[0][0] = mma_rc(s[0][0], __builtin_bit_cast(bf16x8, SC.x[HB_ + k_]), __builtin_bit_cast(bf16x8, LS_SB(k_))); s[0][1] = mma_rc(s[0][1], __builtin_bit_cast(bf16x8, SC.x[HB_ + k_ + 1]), __builtin_bit_cast(bf16x8, LS_SB(k_ + 1))); } \
                    f32x4 oa_ = (s[0][0] + s[0][1]) * qsc; \
                    _Pragma("unroll") for (int ks_ = 0; ks_ < 2; ++ks_) oa_ = mma_rc(oa_, pf_[ks_], vf_[ks_]); \
                    *(LAS u32x2*)(OT + img_ * 4608 + (16 * rt + i16) * 72 + (16 * ct_ + 4 * g4) * 2) = pk4(oa_); \
                    __builtin_amdgcn_sched_barrier(0); } } \
                  \
                LS_LOAD_X(SC, (n) + 2); \
            } else { \
                  \
                if (KIND == 0) { _Pragma("unroll") for (int a_ = 0; a_ < NDU; ++a_) _Pragma("unroll") for (int e_ = 0; e_ < 2; ++e_) s[a_][e_] = s[a_][e_] * sdec; } \
                if (!(VAR & 4)) { bf16x8 vf_[2][2]; \
                    _Pragma("unroll") for (int ks_ = 0; ks_ < 2; ++ks_) _Pragma("unroll") for (int e_ = 0; e_ < 2; ++e_) vf_[ks_][e_] = trfrag2(VI + img_ * 8192 + (KIND == 0 ? 4096 : 0) + e_ * 2048 + ks_ * 1024 + voff, 256); \
                    _Pragma("unroll") for (int ks_ = 0; ks_ < 2; ++ks_) _Pragma("unroll") for (int a_ = 0; a_ < NDU; ++a_) _Pragma("unroll") for (int e_ = 0; e_ < 2; ++e_) \
                        s[a_][e_] = mma_cr(s[a_][e_], __builtin_bit_cast(bf16x8, SC.x[ks_ * NDU + a_]), vf_[ks_][e_]); } \
                  \
                LS_LOAD_X(SC, (n) + 2); \
                if (KIND == 1) { _Pragma("unroll") for (int a_ = 0; a_ < NDU; ++a_) { f32x4 dc_; _Pragma("unroll") for (int r_ = 0; r_ < 4; ++r_) dc_[r_] = __expf(dcur_[a_][r_]); \
                    _Pragma("unroll") for (int e_ = 0; e_ < 2; ++e_) s[a_][e_] = s[a_][e_] * dc_; } } \
                  \
                { LAS bf16_t* STn_ = ST + (img_ ^ 1) * 32 * C::STP; \
                  _Pragma("unroll") for (int a_ = 0; a_ < NDU; ++a_) _Pragma("unroll") for (int e_ = 0; e_ < 2; ++e_) \
                      *(LAS u32x2*)(STn_ + (16 * e_ + i16) * C::STP + RWU * rt + 16 * a_ + 4 * g4) = pk4(s[a_][e_]); } \
            } \
              \
            { const u32x2 ov_ = *(const LAS u32x2*)(OT + (img_ ^ 1) * 4608 + vm * 72 + vp8 * 8); \
              char* ob_ = (n) > 0 ? osb + (size_t)((n) - 1) * (64 * C::VP * 2) : dmb; unsigned oo_ = (n) > 0 ? vvo : dmo; asm volatile("" : "+v"(oo_)); \
              if (!((VAR & 8) && (n) >= 2)) *(u32x2*)(ob_ + oo_) = ov_; } \
              \
            LS_WRITE(SN, img_ ^ 1); \
            asm volatile("s_waitcnt lgkmcnt(0)" ::: "memory"); __builtin_amdgcn_s_barrier(); asm volatile("" ::: "memory"); } while (0)

#pragma nounroll
        for (int n = 0; n < 64; n += 2) { LS_STEP(n, A, B); LS_STEP(n + 1, B, A); }
        *(u32x2*)(osb + (size_t)63 * (64 * C::VP * 2) + vvo) = *(const LAS u32x2*)(OT + 4608 + vm * 72 + vp8 * 8);
        __syncthreads();
#undef LS_LOAD
#undef LS_LOAD_PV
#undef LS_LOAD_X
#undef LS_WRITE
#undef LS_STEP
#undef LS_SB
    }
}


template <int KIND>
__device__ __forceinline__ void lin_stats(const bf16_t* O, float* STATS, int tid, int bid, int G) {
    const int lane = tid & 63, wave = tid >> 6;
    const int gw = bid * 8 + wave, NGW = G * 8;
    constexpr int NJ = KIND == 0 ? 4 : 2, PITCH = KIND == 0 ? 2048 : 1024, RB = 4;
    for (int row0 = gw; row0 < MT; row0 += RB * NGW) {
        u32x4 w[RB][NJ];
#pragma unroll
        for (int rb = 0; rb < RB; ++rb) { const int row = row0 + rb * NGW < MT ? row0 + rb * NGW : row0;
#pragma unroll
            for (int j = 0; j < NJ; ++j) w[rb][j] = *(const u32x4*)(O + (size_t)row * PITCH + 512 * j + 8 * lane); }
#pragma unroll
        for (int rb = 0; rb < RB; ++rb) { const int row = row0 + rb * NGW; if (row >= MT) break;
#pragma unroll
            for (int j = 0; j < NJ; ++j) {
                float sm = 0.f, sq = 0.f;
#pragma unroll
                for (int i = 0; i < 4; ++i) { const float a = bf2f(w[rb][j][i] & 0xffffu), b = bf2f(w[rb][j][i] >> 16); sm += a + b; sq += a * a + b * b; }
                if (KIND == 0) { sm = wave_sum(sm); sq = wave_sum(sq); if (lane == 0) *(f32x2*)(STATS + (size_t)row * 8 + 2 * j) = (f32x2){sm, sq}; }
                else {
#pragma unroll
                    for (int o = 1; o < 32; o <<= 1) sq += __shfl_xor(sq, o);
                    if ((lane & 31) == 0) *(f32x2*)(STATS + (size_t)row * 8 + 2 * (2 * j + (lane >> 5))) = (f32x2){0.f, sq}; }
            }
        }
    }
}

template <int KIND> struct EpiGateNorm {
    static constexpr bool PERM = false;
    bf16_t* O; const float* STATS; LAS float* tbl;
    __device__ __forceinline__ void operator()(const f32x4 (&acc)[2][2][4][2], const pg8::Unit& u, int wr, int wc, int fr, int fq) const {
        constexpr int N = KIND == 0 ? 2048 : 1024; constexpr float INV = KIND == 0 ? 1.0f / 512.0f : 1.0f / 256.0f;
        const int head = KIND == 0 ? (u.pn >> 1) : u.pn;
        if (KIND == 0) {
            if ((u.pn & 1) == 0) {
                LAS f32x2* tb2 = (LAS f32x2*)tbl;
#pragma unroll
                for (int ai = 0; ai < 2; ++ai)
#pragma unroll
                    for (int m = 0; m < 4; ++m) { const int rl = ai * 128 + wr * 64 + m * 16 + fr; const int row = u.pm * 256 + rl; float sm = 0.f, sq = 0.f;
                        const bf16_t* prow = O + (size_t)row * N + u.pn * 256 + wc * 32 + fq * 4;
#pragma unroll
                        for (int tt = 0; tt < 2; ++tt) {
                            const u32x2 w0 = *(const u32x2*)(prow + tt * 256), w1 = *(const u32x2*)(prow + tt * 256 + 16), w2 = *(const u32x2*)(prow + tt * 256 + 128), w3 = *(const u32x2*)(prow + tt * 256 + 144);
                            const f32x4 o0 = unpk4(w0), o1 = unpk4(w1), o2 = unpk4(w2), o3 = unpk4(w3);
                            const f32x4 ss = (o0 + o1) + (o2 + o3), qq = (o0 * o0 + o1 * o1) + (o2 * o2 + o3 * o3);
                            sm += (ss[0] + ss[1]) + (ss[2] + ss[3]); sq += (qq[0] + qq[1]) + (qq[2] + qq[3]);
                            asm volatile("" ::: "memory"); }
                        sm = xsum_16_32(sm); sq = xsum_16_32(sq);
                        if (fq == 0) tb2[rl * 4 + wc] = (f32x2){sm, sq};
                        asm volatile("" ::: "memory"); }
                asm volatile("s_waitcnt lgkmcnt(0)" ::: "memory"); __builtin_amdgcn_s_barrier(); asm volatile("" ::: "memory");
            }
#pragma unroll
            for (int ai = 0; ai < 2; ++ai)
#pragma unroll
            for (int mh = 0; mh < 2; ++mh) {
                u32x2 ov[2][2][2];
#pragma unroll
                for (int mm = 0; mm < 2; ++mm) { const int row = u.pm * 256 + ai * 128 + wr * 64 + (2 * mh + mm) * 16 + fr;
#pragma unroll
                    for (int bj = 0; bj < 2; ++bj)
#pragma unroll
                        for (int n = 0; n < 2; ++n) ov[mm][bj][n] = *(const u32x2*)(O + (size_t)row * N + u.pn * 256 + bj * 128 + wc * 32 + n * 16 + fq * 4); }
                asm volatile("" ::: "memory");
#pragma unroll
                for (int mm = 0; mm < 2; ++mm) { const int m = 2 * mh + mm; const int rl = ai * 128 + wr * 64 + m * 16 + fr; const int row = u.pm * 256 + rl;
                    const LAS f32x2* tb2 = (const LAS f32x2*)tbl + rl * 4;
                    const f32x2 p0 = tb2[0], p1 = tb2[1], p2 = tb2[2], p3 = tb2[3];
                    const float mean = ((p0.x + p1.x) + (p2.x + p3.x)) * INV, rstd = __builtin_amdgcn_rsqf(fmaxf(((p0.y + p1.y) + (p2.y + p3.y)) * INV - mean * mean, 0.f) + EPS);
#pragma unroll
                    for (int bj = 0; bj < 2; ++bj)
#pragma unroll
                        for (int n = 0; n < 2; ++n) {
                            const f32x4 o = unpk4(ov[mm][bj][n]), a = acc[ai][bj][m][n]; f32x4 r;
#pragma unroll
                            for (int j = 0; j < 4; ++j) r[j] = (o[j] - mean) * rstd * silu_f(a[j]);
                            *(u32x2*)(O + (size_t)row * N + u.pn * 256 + bj * 128 + wc * 32 + n * 16 + fq * 4) = pk4(r);
                        }
                }
                asm volatile("" ::: "memory");
            }
        } else {
#pragma unroll
            for (int ai = 0; ai < 2; ++ai)
#pragma unroll
                for (int m = 0; m < 4; ++m) { const int rl = ai * 128 + wr * 64 + m * 16 + fr; const int row = u.pm * 256 + rl; float sq = 0.f;
#pragma unroll
                    for (int bj = 0; bj < 2; ++bj)
#pragma unroll
                        for (int n = 0; n < 2; ++n) { const f32x4 o = unpk4(*(const u32x2*)(O + (size_t)row * N + u.pn * 256 + bj * 128 + wc * 32 + n * 16 + fq * 4)); sq += (o[0] * o[0] + o[1] * o[1]) + (o[2] * o[2] + o[3] * o[3]); }
                    sq = xsum_16_32(sq);
                    if (fq == 0) tbl[rl * 4 + wc] = sq; }
            asm volatile("s_waitcnt lgkmcnt(0)" ::: "memory"); __builtin_amdgcn_s_barrier(); asm volatile("" ::: "memory");
#pragma unroll
            for (int ai = 0; ai < 2; ++ai) {
                u32x2 ov[4][2][2];
#pragma unroll
                for (int m = 0; m < 4; ++m) { const int row = u.pm * 256 + ai * 128 + wr * 64 + m * 16 + fr;
#pragma unroll
                    for (int bj = 0; bj < 2; ++bj)
#pragma unroll
                        for (int n = 0; n < 2; ++n) ov[m][bj][n] = *(const u32x2*)(O + (size_t)row * N + u.pn * 256 + bj * 128 + wc * 32 + n * 16 + fq * 4); }
                asm volatile("" ::: "memory");
#pragma unroll
                for (int m = 0; m < 4; ++m) { const int rl = ai * 128 + wr * 64 + m * 16 + fr; const int row = u.pm * 256 + rl;
                    const f32x4 pr = *(const LAS f32x4*)(tbl + rl * 4);
                    const float rstd = __builtin_amdgcn_rsqf(((pr[0] + pr[1]) + (pr[2] + pr[3])) * INV + EPS);
#pragma unroll
                    for (int bj = 0; bj < 2; ++bj)
#pragma unroll
                        for (int n = 0; n < 2; ++n) {
                            const f32x4 o = unpk4(ov[m][bj][n]), a = acc[ai][bj][m][n]; f32x4 r;
#pragma unroll
                            for (int j = 0; j < 4; ++j) r[j] = o[j] * rstd * silu_f(a[j]);
                            *(u32x2*)(O + (size_t)row * N + u.pn * 256 + bj * 128 + wc * 32 + n * 16 + fq * 4) = pk4(r);
                        }
                }
                asm volatile("" ::: "memory");
            }
        }
    }
};

namespace attn_body {
using bf16=unsigned short;
using bf16x8=__attribute__((ext_vector_type(8)))short;
using s16x4=__attribute__((ext_vector_type(4)))short;
using f32x16=__attribute__((ext_vector_type(16)))float;
using u32x4=__attribute__((ext_vector_type(4)))unsigned;
constexpr int BATCH=4,NHEAD=16,SEQ=4096,D=64,DM=NHEAD*D;
constexpr int NW=8,QBLK=32,QB=QBLK*NW,KVBLK=64,NQB=SEQ/QB;
constexpr int ATTN_PITCH=DM, ATTN_UNIT_ROWS=QB;
__device__ __forceinline__ int crow(int r,int hi){return (r&3)+8*(r>>2)+4*hi;}
#define SBAR() __builtin_amdgcn_sched_barrier(0)
__device__ __forceinline__ void cmask(f32x16&p0,f32x16&p1,int jb,int qrel,int hi){
  const float NEG=-INFINITY; int kb=64*jb+4*hi;
  #pragma unroll
  for(int r=0;r<16;++r){int kv=kb+(r&3)+8*(r>>2); if(kv>qrel)p0[r]=NEG; if(kv+32>qrel)p1[r]=NEG;}
}

constexpr int NSLOT=3, SLOTB=8192;
constexpr int LDS_K=0, LDS_V=NSLOT*SLOTB, LDS_WS=2*NSLOT*SLOTB, LDS_OST=LDS_WS+NW*64*4, LDS_NC=LDS_OST+NW*4096, LDS_FT=LDS_NC+SEQ*4, LDS_RE=LDS_FT+256, LDS_BYTES=LDS_RE+256;
constexpr float C2=0.125f*1.4426950408889634f;
__device__ __forceinline__ void glds16(const void*gsrc,unsigned lds_dst){unsigned keep;
  asm volatile("s_mov_b32 %0, m0\n\ts_mov_b32 m0, %2\n\ts_nop 0\n\tglobal_load_lds_dwordx4 %1, off\n\ts_mov_b32 m0, %0":"=&s"(keep):"v"(gsrc),"s"(lds_dst):"memory");}
__device__ __forceinline__ float max3f(float a,float b,float c){float r;asm("v_max3_f32 %0, %1, %2, %3":"=v"(r):"v"(a),"v"(b),"v"(c));return r;}
__device__ __forceinline__ float max2f(float a,float b){float r;asm("v_max_f32_e32 %0, %1, %2":"=v"(r):"v"(a),"v"(b));return r;}
__device__ __forceinline__ float fadd_s(float a,float b){float r;asm("v_add_f32_e32 %0, %1, %2":"=v"(r):"v"(a),"v"(b));return r;}
__device__ __forceinline__ float fsub_s(float a,float b){float r;asm("v_sub_f32_e32 %0, %1, %2":"=v"(r):"v"(a),"v"(b));return r;}
typedef float f32x2_t __attribute__((ext_vector_type(2))); typedef __bf16 bf16x2_t __attribute__((ext_vector_type(2)));
__device__ __forceinline__ unsigned cvtpk_s(float lo,float hi){f32x2_t v={lo,hi};bf16x2_t b=__builtin_convertvector(v,bf16x2_t);return __builtin_bit_cast(unsigned,b);}
#define WAIT_BAR(N) asm volatile("s_waitcnt vmcnt(" #N ") lgkmcnt(0)\n\ts_barrier":::"memory")

__device__ __forceinline__ void qkt(f32x16&p0,f32x16&p1,const char*Kslot,const bf16x8*qr,const f32x16&negm,int r32,int hi){
  const char*kb=Kslot+hi*1024+r32*16;
  #pragma unroll
  for(int d0=0;d0<4;++d0){
    const bf16x8 b0=*reinterpret_cast<const bf16x8*>(kb+d0*2048);
    const bf16x8 b1=*reinterpret_cast<const bf16x8*>(kb+d0*2048+512);
    if(d0==0){p0=__builtin_amdgcn_mfma_f32_32x32x16_bf16(b0,qr[0],negm,0,0,0);p1=__builtin_amdgcn_mfma_f32_32x32x16_bf16(b1,qr[0],negm,0,0,0);}
    else{p0=__builtin_amdgcn_mfma_f32_32x32x16_bf16(b0,qr[d0],p0,0,0,0);p1=__builtin_amdgcn_mfma_f32_32x32x16_bf16(b1,qr[d0],p1,0,0,0);}}
}
typedef __attribute__((address_space(3))) const char* lds_cptr;
typedef short v4i16_t __attribute__((ext_vector_type(4)));
__device__ __forceinline__ void kload8(bf16x8*kf,lds_cptr kp){
  kf[0]=*(const __attribute__((address_space(3))) bf16x8*)(kp);      kf[1]=*(const __attribute__((address_space(3))) bf16x8*)(kp+512);
  kf[2]=*(const __attribute__((address_space(3))) bf16x8*)(kp+2048); kf[3]=*(const __attribute__((address_space(3))) bf16x8*)(kp+2560);
  kf[4]=*(const __attribute__((address_space(3))) bf16x8*)(kp+4096); kf[5]=*(const __attribute__((address_space(3))) bf16x8*)(kp+4608);
  kf[6]=*(const __attribute__((address_space(3))) bf16x8*)(kp+6144); kf[7]=*(const __attribute__((address_space(3))) bf16x8*)(kp+6656);
}
__device__ __forceinline__ void kload2(bf16x8*kf,lds_cptr kp,int j){ kf[2*j]=*(const __attribute__((address_space(3))) bf16x8*)(kp+j*2048); kf[2*j+1]=*(const __attribute__((address_space(3))) bf16x8*)(kp+j*2048+512); }
__device__ __forceinline__ s16x4 vtr(lds_cptr p){ return __builtin_bit_cast(s16x4,__builtin_amdgcn_ds_read_tr16_b64_v4i16((__attribute__((address_space(3))) v4i16_t*)p)); }
__device__ __forceinline__ float rowmax(const f32x16&p0,const f32x16&p1){
  float a=max3f(p0[0],p0[1],p1[0]),b=max3f(p0[2],p0[3],p1[1]);a=max3f(a,p1[2],p1[3]);
  #pragma unroll
  for(int r=4;r<16;r+=4){a=max3f(a,p0[r],p0[r+1]);b=max3f(b,p0[r+2],p0[r+3]);a=max3f(a,p1[r],p1[r+1]);b=max3f(b,p1[r+2],p1[r+3]);}
  const float m=max2f(a,b);
  auto rr=__builtin_amdgcn_permlane32_swap(__float_as_uint(m),__float_as_uint(m),false,false);
  return max2f(__uint_as_float(rr[0]),__uint_as_float(rr[1]));
}
__device__ __forceinline__ void pv(f32x16*o,int vb,bf16x8 pa0,bf16x8 pa1,bf16x8 pa2,bf16x8 pa3){
  #pragma unroll
  for(int d0=0;d0<2;++d0){s16x4 lo[4],hi[4];
    #pragma unroll
    for(int ks=0;ks<4;++ks){
      asm volatile("ds_read_b64_tr_b16 %0,%1 offset:%c2":"=&v"(lo[ks]):"v"(vb),"i"(d0*4096+ks*1024):"memory");
      asm volatile("ds_read_b64_tr_b16 %0,%1 offset:%c2":"=&v"(hi[ks]):"v"(vb),"i"(d0*4096+ks*1024+512):"memory");}
    asm volatile("s_waitcnt lgkmcnt(0)":::"memory");SBAR();
    #define PK(k) (bf16x8){lo[k][0],lo[k][1],lo[k][2],lo[k][3],hi[k][0],hi[k][1],hi[k][2],hi[k][3]}
    o[d0]=__builtin_amdgcn_mfma_f32_32x32x16_bf16(pa0,PK(0),o[d0],0,0,0);
    o[d0]=__builtin_amdgcn_mfma_f32_32x32x16_bf16(pa1,PK(1),o[d0],0,0,0);
    o[d0]=__builtin_amdgcn_mfma_f32_32x32x16_bf16(pa2,PK(2),o[d0],0,0,0);
    o[d0]=__builtin_amdgcn_mfma_f32_32x32x16_bf16(pa3,PK(3),o[d0],0,0,0);
    #undef PK
  }
}

#ifndef ATTN_STORE16
#define ATTN_STORE16(p,v) (*(u32x4*)(p)=(v))
#endif
template<int THRL> __device__ __forceinline__ void attn_unit(int b,int h,int qb,int ts,const bf16*Q,const bf16*__restrict__ K,const bf16*__restrict__ V,const bf16*__restrict__ Gt,bf16*O,char*shm,int tid){
  const int lane=tid&63,r32=lane&31,hi=lane>>5; const int wid=__builtin_amdgcn_readfirstlane(tid>>6);
  const long rowbase=(long)b*SEQ; const int q0=qb*QB;
  typedef __attribute__((address_space(3))) const float* lds_fptr; typedef float f32x4b __attribute__((ext_vector_type(4)));
  const lds_fptr ncum=(lds_fptr)((__attribute__((address_space(3))) const char*)shm+LDS_NC)+64*ts+4*hi;
  const lds_fptr ftp=(lds_fptr)((__attribute__((address_space(3))) const char*)shm+LDS_FT)+ts;
  const bf16*Qw=Q+(rowbase+q0+wid*QBLK)*DM+h*D;
  const bf16*Kh=K+(rowbase+(long)ts*KVBLK)*DM+h*D,*Vh=V+(rowbase+(long)ts*KVBLK)*DM+h*D;
  const unsigned lds0=(unsigned)(uintptr_t)shm;
  float*wsf=(float*)(shm+LDS_WS)+wid*64;
  const bf16*ksrc=Kh+(long)lane*DM+wid*8;
  const bf16*vsrc=Vh+(long)(16*(wid&3)+(lane>>2))*DM+(wid>>2)*32+(lane&3)*8;
  const unsigned kdst=lds0+LDS_K+wid*1024, vdst=lds0+LDS_V+wid*1024;
  #define DMA_K(t,slot) glds16(ksrc+(long)(t)*KVBLK*DM,(unsigned)__builtin_amdgcn_readfirstlane(kdst+(slot)))
  #define DMA_V(t,slot) glds16(vsrc+(long)(t)*KVBLK*DM,(unsigned)__builtin_amdgcn_readfirstlane(vdst+(slot)))
  const int vb0=(int)(lds0+LDS_V)+((lane>>4)&1)*32+(lane&3)*8+(4*hi+((lane&15)>>2))*64;
  const char*Kbase=shm+LDS_K; bf16x8 kf[8];
  const lds_cptr shm3=(lds_cptr)shm; const lds_cptr kp0=shm3+LDS_K+hi*1024+r32*16; const lds_cptr vp0=shm3+LDS_V+((lane>>4)&1)*32+(lane&3)*8+(4*hi+((lane&15)>>2))*64;
  const int NT=(q0+QB)/KVBLK-ts;
  DMA_K(0,0);DMA_V(0,0);DMA_K(1,SLOTB);
  bf16x8 qr[4];
  #pragma unroll
  for(int d0=0;d0<4;++d0)qr[d0]=*reinterpret_cast<const bf16x8*>(&Qw[(long)r32*DM+d0*16+hi*8]);
  float l_reg=0.f,fcur=1.f;f32x16 o[2];o[0]=f32x16{};o[1]=f32x16{};const f32x16 negm=f32x16{};
  const int qrel=wid*QBLK+r32;
  #define CMASK(P0,P1,t) do{int jb_=(t)-(NT-4); if(jb_>=0)cmask(P0,P1,jb_,qrel,hi);}while(0)
  #define LDSF4(p) (*(const __attribute__((address_space(3))) f32x4b*)(p))
  #define BIAS(P0,P1,t) do{ const lds_fptr nb_=ncum+64*(t); \
      { const f32x4b a0_=LDSF4(nb_), a1_=LDSF4(nb_+8), a2_=LDSF4(nb_+16), a3_=LDSF4(nb_+24); \
        _Pragma("unroll") for(int j_=0;j_<4;++j_){ P0[j_]+=a0_[j_]; P0[4+j_]+=a1_[j_]; P0[8+j_]+=a2_[j_]; P0[12+j_]+=a3_[j_]; } } SBAR(); \
      { const f32x4b b0_=LDSF4(nb_+32), b1_=LDSF4(nb_+40), b2_=LDSF4(nb_+48), b3_=LDSF4(nb_+56); \
        _Pragma("unroll") for(int j_=0;j_<4;++j_){ P1[j_]+=b0_[j_]; P1[4+j_]+=b1_[j_]; P1[8+j_]+=b2_[j_]; P1[12+j_]+=b3_[j_]; } } SBAR(); }while(0)
  #define START(P0,P1) do{ _Pragma("unroll") for(int r=0;r<16;++r)P0[r]=__builtin_amdgcn_exp2f(P0[r]); }while(0)
  #define RESC() do{ _Pragma("unroll") for(int d_=0;d_<2;++d_) _Pragma("unroll") for(int r=0;r<16;++r)o[d_][r]*=fcur; }while(0)
  f32x16 pA0,pA1,pB0,pB1;
  int sl_prev=0,sl_cur=0,sl_next=SLOTB;
  #define ROT() do{sl_prev=sl_cur;sl_cur=sl_next;sl_next=(sl_next==(NSLOT-1)*SLOTB)?0:sl_next+SLOTB;}while(0)
  DMA_K(2,2*SLOTB);
  WAIT_BAR(3);
  qkt(pA0,pA1,Kbase,qr,negm,r32,hi);asm volatile("s_nop 15\n\ts_nop 7":"+v"(pA0),"+v"(pA1));BIAS(pA0,pA1,0);CMASK(pA0,pA1,0);
  START(pA0,pA1);
  _Pragma("unroll") for(int r=0;r<16;++r)pA1[r]=__builtin_amdgcn_exp2f(pA1[r]);
  WAIT_BAR(0);
  DMA_K(3,0);DMA_V(1,SLOTB);
  ROT();
  kload8(kf,kp0+sl_cur);
  WAIT_BAR(2);
  s16x4 vlo[8],vhi[8]; u32x4 pw0,pw1,pw2,pw3;
  #define PKW(P,B) cvtpk_s(P[B],P[B+1])
  #define PAF(k) __builtin_bit_cast(bf16x8,pw##k)
  #define VFR(i) (bf16x8){vlo[i][0],vlo[i][1],vlo[i][2],vlo[i][3],vhi[i][0],vhi[i][1],vhi[i][2],vhi[i][3]}
  #define PIN(x) asm volatile("":"+v"(x))
  #define MX3(a,b,c) __builtin_fmaxf(__builtin_fmaxf((a),(b)),(c))
  #define GAPA(MF,A0,A1,A2,A3,W0,W1,PW) do{ MF; sacc+=A0; sacc+=A1; sacc+=A2; sacc+=A3; PIN(sacc); W0; W1; PIN(PW); SBAR(); }while(0)
  #define EX(v) __builtin_amdgcn_exp2f(v)
  #define GAPB(MF,X,B) do{ MF; X[B]=EX(X[B]); X[B+1]=EX(X[B+1]); X[B+2]=EX(X[B+2]); X[B+3]=EX(X[B+3]); PIN(X); SBAR(); }while(0)
  #define VRD(i) do{ vlo[i]=vtr(vp_+(((i)>>2)*4096+((i)&3)*1024)); vhi[i]=vtr(vp_+(((i)>>2)*4096+((i)&3)*1024+512)); }while(0)
  #define KRD(G,j) do{ if(G){ kload2(kf,kp0+sl_next,j); SBAR(); } }while(0)
  #define STEP(C0,C1,P0,P1,t,GK,GV,GL) do{ SBAR(); \
    const lds_cptr vp_=vp0+sl_prev; \
    VRD(0); SBAR(); float sacc=(P0[0]+P0[1]); \
    GAPA(C0=__builtin_amdgcn_mfma_f32_32x32x16_bf16(kf[0],qr[0],negm,0,0,0), P0[2],P0[3],P0[4],P0[5],     pw0[0]=PKW(P0,0), pw0[1]=PKW(P0,2), pw0); \
    VRD(4); SBAR(); GAPA(C1=__builtin_amdgcn_mfma_f32_32x32x16_bf16(kf[1],qr[0],negm,0,0,0), P0[6],P0[7],P0[8],P0[9],     pw0[2]=PKW(P0,4), pw0[3]=PKW(P0,6), pw0); \
    VRD(1); SBAR(); GAPA(C0=__builtin_amdgcn_mfma_f32_32x32x16_bf16(kf[2],qr[1],C0,0,0,0),   P0[10],P0[11],P0[12],P0[13], pw1[0]=PKW(P0,8), pw1[1]=PKW(P0,10), pw1); \
    VRD(5); SBAR(); GAPA(C1=__builtin_amdgcn_mfma_f32_32x32x16_bf16(kf[3],qr[1],C1,0,0,0),   P0[14],P0[15],P1[0],P1[1],   pw1[2]=PKW(P0,12),pw1[3]=PKW(P0,14), pw1); \
    VRD(2); SBAR(); GAPA(C0=__builtin_amdgcn_mfma_f32_32x32x16_bf16(kf[4],qr[2],C0,0,0,0),   P1[2],P1[3],P1[4],P1[5],     pw2[0]=PKW(P1,0), pw2[1]=PKW(P1,2), pw2); \
    VRD(6); SBAR(); GAPA(C1=__builtin_amdgcn_mfma_f32_32x32x16_bf16(kf[5],qr[2],C1,0,0,0),   P1[6],P1[7],P1[8],P1[9],     pw2[2]=PKW(P1,4), pw2[3]=PKW(P1,6), pw2); \
    VRD(3); SBAR(); GAPA(C0=__builtin_amdgcn_mfma_f32_32x32x16_bf16(kf[6],qr[3],C0,0,0,0),   P1[10],P1[11],P1[12],P1[13], pw3[0]=PKW(P1,8), pw3[1]=PKW(P1,10), pw3); \
    VRD(7); SBAR(); GAPA(C1=__builtin_amdgcn_mfma_f32_32x32x16_bf16(kf[7],qr[3],C1,0,0,0),   P1[14],P1[15],0.f,0.f,       pw3[2]=PKW(P1,12),pw3[3]=PKW(P1,14), pw3); \
    l_reg+=sacc; \
    if(GK){DMA_K((t)+3,sl_cur);} if(GV){DMA_V((t)+1,sl_next);} \
    BIAS(C0,C1,t); CMASK(C0,C1,t); \
    { const int jb2_=2*((t)-(NT-4)); fcur=(jb2_>wid)?1.0f:ftp[(t)]; l_reg*=fcur; } \
    SBAR(); \
    GAPB(o[0]=__builtin_amdgcn_mfma_f32_32x32x16_bf16(PAF(0),VFR(0),o[0],0,0,0), C0,0); \
    GAPB(o[1]=__builtin_amdgcn_mfma_f32_32x32x16_bf16(PAF(0),VFR(4),o[1],0,0,0), C0,4); \
    KRD(GL,0); GAPB(o[0]=__builtin_amdgcn_mfma_f32_32x32x16_bf16(PAF(1),VFR(1),o[0],0,0,0), C0,8); \
    KRD(GL,1); GAPB(o[1]=__builtin_amdgcn_mfma_f32_32x32x16_bf16(PAF(1),VFR(5),o[1],0,0,0), C0,12); \
    KRD(GL,2); GAPB(o[0]=__builtin_amdgcn_mfma_f32_32x32x16_bf16(PAF(2),VFR(2),o[0],0,0,0), C1,0); \
    KRD(GL,3); GAPB(o[1]=__builtin_amdgcn_mfma_f32_32x32x16_bf16(PAF(2),VFR(6),o[1],0,0,0), C1,4); \
    GAPB(o[0]=__builtin_amdgcn_mfma_f32_32x32x16_bf16(PAF(3),VFR(3),o[0],0,0,0), C1,8); \
    GAPB(o[1]=__builtin_amdgcn_mfma_f32_32x32x16_bf16(PAF(3),VFR(7),o[1],0,0,0), C1,12); \
    }while(0)
  int t=1;
  #undef CMASK
  #define CMASK(P0,P1,t) do{}while(0)
  for(;t+5<NT;t+=2){
    STEP(pB0,pB1,pA0,pA1,t,true,true,true);     WAIT_BAR(2); RESC(); ROT();
    STEP(pA0,pA1,pB0,pB1,t+1,true,true,true);   WAIT_BAR(2); RESC(); ROT();
  }
  #undef CMASK
  int qrel_m=qrel,hi_m=hi; asm volatile("":"+v"(qrel_m),"+v"(hi_m));
  #define CMASK(P0,P1,t) do{int jb_=(t)-(NT-4); if(jb_>=0)cmask(P0,P1,jb_,qrel_m,hi_m);}while(0)
  #define ENDW(tt) do{ if((tt)+3<NT){WAIT_BAR(2);} else if((tt)+2<NT){WAIT_BAR(1);} else {WAIT_BAR(0);} }while(0)
  for(;t+1<NT;t+=2){
    STEP(pB0,pB1,pA0,pA1,t,(t+3<NT),(t+1<NT),(t+1<NT));       ENDW(t);   RESC(); ROT();
    STEP(pA0,pA1,pB0,pB1,t+1,(t+4<NT),(t+2<NT),(t+2<NT));     ENDW(t+1); RESC(); ROT();
  }
  STEP(pB0,pB1,pA0,pA1,NT-1,false,false,false); RESC();
  { float sacc=pB0[0]+pB0[1]; _Pragma("unroll") for(int r=2;r<16;++r)sacc+=pB0[r]; _Pragma("unroll") for(int r=0;r<16;++r)sacc+=pB1[r]; l_reg+=sacc;
    pw0=(u32x4){PKW(pB0,0),PKW(pB0,2),PKW(pB0,4),PKW(pB0,6)};pw1=(u32x4){PKW(pB0,8),PKW(pB0,10),PKW(pB0,12),PKW(pB0,14)};pw2=(u32x4){PKW(pB1,0),PKW(pB1,2),PKW(pB1,4),PKW(pB1,6)};pw3=(u32x4){PKW(pB1,8),PKW(pB1,10),PKW(pB1,12),PKW(pB1,14)};
    SBAR(); pv(o,vb0+sl_cur,PAF(0),PAF(1),PAF(2),PAF(3)); }
  #undef PKW
  #undef PAF
  #undef VFR
  #undef PIN
  #undef MX3
  #undef GAPA
  #undef GAPB
  #undef EX
  #undef VRD
  #undef KRD
  #undef STEP
  #undef ENDW
  {auto rr=__builtin_amdgcn_permlane32_swap(__float_as_uint(l_reg),__float_as_uint(l_reg),false,false);l_reg=__uint_as_float(rr[0])+__uint_as_float(rr[1]);}
  if(hi==0)wsf[32+r32]=l_reg;asm volatile("s_waitcnt lgkmcnt(0)":::"memory");
  float rli[16];
  #pragma unroll
  for(int r=0;r<16;++r)rli[r]=__builtin_amdgcn_rcpf(wsf[32+crow(r,hi)]);
  bf16*Ow=O+(rowbase+q0+wid*QBLK)*DM+h*D;
  { bf16*stg=(bf16*)(shm+LDS_OST)+wid*2048;
    #pragma unroll
    for(int r=0;r<16;++r){const int orow=crow(r,hi);
      #pragma unroll
      for(int d0=0;d0<2;++d0){const float gv=__uint_as_float((unsigned)Gt[(rowbase+q0+wid*QBLK+orow)*DM+h*D+d0*32+r32]<<16); const float ov=o[d0][r]*rli[r]*gv; unsigned ub=__float_as_uint(ov); ub=(ub+0x7fffu+((ub>>16)&1u))>>16; stg[orow*64+d0*32+r32]=(bf16)ub;}}
    asm volatile("s_waitcnt lgkmcnt(0)":::"memory");
    #pragma unroll
    for(int i=0;i<4;++i){const int row=i*8+(lane>>3),ch=lane&7; const u32x4 v=*(const u32x4*)(stg+row*64+ch*8); ATTN_STORE16(Ow+(long)row*DM+ch*8,v);} }
  asm volatile("s_waitcnt lgkmcnt(0)\n\ts_barrier":::"memory");
  #undef DMA_K
  #undef DMA_V
  #undef CMASK
  #undef BIAS
  #undef LDSF4
  #undef START
  #undef RESC
  #undef ROT
}
constexpr int ATTN_LDS_BYTES=LDS_BYTES;
#undef SBAR
#undef WAIT_BAR
}

__device__ __forceinline__ void fox_attn2(const Params& P, char* shm, int tid, int bid, int G, unsigned short* Odst) {
    const int lane = tid & 63;
    unsigned short* Q = (unsigned short*)(P.ws + WS_ACT); const unsigned short* Kb = (const unsigned short*)(P.ws + WS_ACT + 32 * MiB); const unsigned short* V = (const unsigned short*)(P.ws + WS_ACT + 64 * MiB);
    const unsigned short* Gt = (const unsigned short*)(P.ws + WS_ACT + 96 * MiB);
    LAS float* nc = (LAS float*)((LAS char*)shm + attn_body::LDS_NC);
    LAS float* ft = (LAS float*)((LAS char*)shm + attn_body::LDS_FT);
    LAS float* re = (LAS float*)((LAS char*)shm + attn_body::LDS_RE);
    float gq = fabsf(P.fox_q_gain[lane]), gk = fabsf(P.fox_k_gain[lane]);
#pragma unroll
    for (int o = 1; o < 64; o <<= 1) { gq = fmaxf(gq, __shfl_xor(gq, o)); gk = fmaxf(gk, __shfl_xor(gk, o)); }
    const float Smax = 1.02f * (64.0f * gq * gk * 0.125f * LOG2E);
    const float T = 2.0f * Smax + 40.0f;
    const int vcu = (G % 8 == 0) ? (bid % 8) * (G / 8) + bid / 8 : bid;
    int last_bh = -1;
    for (int i = 0;; ++i) {
        int bh, qb;
        if (G == 256) { if (i >= 4) break; bh = vcu >> 2; const int s = vcu & 3; qb = (i == 0) ? s : (i == 1) ? 7 - s : (i == 2) ? 8 + s : 15 - s; }
        else { const int ui = i * G + bid; if (ui >= 1024) break; bh = ui >> 4; qb = ui & 15; }
        if (bh != last_bh) {
            const float* LF = (const float*)(P.ws + WS_S16) + ((size_t)(bh >> 4) * SEQ + 8 * tid) * 16 + (bh & 15);
            float v8[8]; float run = 0.f;
#pragma unroll
            for (int i2 = 0; i2 < 8; ++i2) { run += LF[(size_t)i2 * 16]; v8[i2] = run; }
            float inc = run;
#pragma unroll
            for (int o = 1; o < 64; o <<= 1) { const float tt = __shfl_up(inc, o); if (lane >= o) inc += tt; }
            if (lane == 63) ft[tid >> 6] = inc;
            __syncthreads();
            float pre = inc - run;
            for (int w = 0; w < (tid >> 6); ++w) pre += ft[w];
            __syncthreads();
#pragma unroll
            for (int i2 = 0; i2 < 8; ++i2) nc[8 * tid + i2] = -(pre + v8[i2]) * LOG2E;
            __syncthreads();
            if (tid < 64) { const float e = nc[64 * tid + 63]; re[tid] = e; const float ep = (tid > 0) ? nc[64 * tid - 1] : e; ft[tid] = exp2f(ep - e); }
            __syncthreads();
#pragma unroll
            for (int i2 = 0; i2 < 8; ++i2) nc[8 * tid + i2] += -re[tid >> 3] - Smax + 40.0f;
            __syncthreads(); last_bh = bh;
        }
        const int ntf = 4 * qb + 4;
        const float thr = (qb > 0 ? re[4 * qb - 1] : 0.0f) - T;
        const bool pred = (lane < ntf) && (re[lane] < thr);
        int ts = __builtin_popcountll(__ballot(pred)) & ~1; ts = ts > ntf - 4 ? ntf - 4 : ts; ts = __builtin_amdgcn_readfirstlane(ts);
        int tid_u = tid; asm volatile("" : "+v"(tid_u));
        attn_body::attn_unit<8>(bh >> 4, bh & 15, qb, ts, Q, Kb, V, Gt, Odst ? Odst : Q, shm, tid_u);
    }
}

__device__ __forceinline__ void final_norm(const Params& P, int tid, int bid, int G) {
    const int lane = tid & 63, wave = tid >> 6;
    const int gw = bid * 8 + wave, NGW = G * 8;
    f32x4 g[4];
#pragma unroll
    for (int j = 0; j < 4; ++j) g[j] = *(const f32x4*)(P.final_g + 4 * lane + 256 * j);
    constexpr int RB = 4;
    for (int row0 = gw; row0 < MT; row0 += RB * NGW) {
        f32x4 v[RB][4];
#pragma unroll
        for (int rb = 0; rb < RB; ++rb) { const int row = row0 + rb * NGW < MT ? row0 + rb * NGW : row0; const f32x4* xr = (const f32x4*)(P.out + (size_t)row * 1024) + lane;
#pragma unroll
            for (int j = 0; j < 4; ++j) v[rb][j] = xr[64 * j]; }
#pragma unroll
        for (int rb = 0; rb < RB; ++rb) { const int row = row0 + rb * NGW; if (row >= MT) break;
            float ss = 0.f;
#pragma unroll
            for (int j = 0; j < 4; ++j) ss += (v[rb][j][0] * v[rb][j][0] + v[rb][j][1] * v[rb][j][1]) + (v[rb][j][2] * v[rb][j][2] + v[rb][j][3] * v[rb][j][3]);
            const float rstd = rsqrtf(wave_sum(ss) * (1.0f / 1024.0f) + EPS);
            f32x4* xw = (f32x4*)(P.out + (size_t)row * 1024) + lane;
#pragma unroll
            for (int j = 0; j < 4; ++j) xw[64 * j] = (v[rb][j] * rstd) * g[j];
        }
    }
}

#define XB_TMO      128
#define XB_XCNT(j)  (256  + 64 * (j))
#define XB_XSUB(j)  (1280 + 64 * (j))
#define XB_XGEN(j)  (2304 + 64 * (j))
#define XB_TOP      3328
#define XB_TOPGEN   3392
#define XCD_BAR_WORDS 3456
#define XB_SPIN_CAP (1u << 20)
__device__ __forceinline__ unsigned xb_ld(unsigned* p)              { return __hip_atomic_load(p, __ATOMIC_RELAXED, __HIP_MEMORY_SCOPE_AGENT); }
__device__ __forceinline__ unsigned xb_add(unsigned* p, unsigned v) { return __hip_atomic_fetch_add(p, v, __ATOMIC_RELAXED, __HIP_MEMORY_SCOPE_AGENT); }
__device__ __forceinline__ unsigned xb_xcc_id() { return (unsigned)__builtin_amdgcn_s_getreg((3 << 11) | 20) & 0xFu; }
#define XB_SPIN(cond, bar) do { unsigned _sp = 0; while (cond) { __builtin_amdgcn_s_sleep(1); \
    if ((++_sp & 255u) == 0u) { if (xb_ld(&(bar)[XB_TMO])) break; if (_sp > XB_SPIN_CAP) { atomicAdd(&(bar)[XB_TMO], 1u); break; } } } } while (0)
struct XcdBarrier { unsigned* bar; unsigned x; volatile LAS unsigned* st; int wave_s; };
__device__ __forceinline__ int lane_id() { return (int)__builtin_amdgcn_mbcnt_hi(~0u, __builtin_amdgcn_mbcnt_lo(~0u, 0u)); }
__device__ __forceinline__ XcdBarrier xcd_barrier_post(unsigned* bar, volatile LAS unsigned* st, int wave_s) {
    XcdBarrier b; b.bar = bar; b.x = xb_xcc_id(); b.st = st; b.wave_s = wave_s;
    if (threadIdx.x == 0) (void)xb_add(&bar[XB_XCNT(b.x)], 1u);
    return b;
}
__device__ __forceinline__ void xcd_barrier_complete(unsigned* bar, unsigned x, unsigned& nloc, unsigned& nx) {
    const unsigned G = gridDim.x * gridDim.y * gridDim.z;
    asm volatile("" : "+s"(x));
    unsigned sum, cnt, mine, sp = 0u;
    for (;;) {
        sum = 0u; cnt = 0u; mine = 0u;
#pragma unroll
        for (unsigned j = 0; j < 16; ++j) { const unsigned c = xb_ld(&bar[XB_XCNT(j)]); sum += c; cnt += (c > 0u) ? 1u : 0u; mine = (j == x) ? c : mine; }
        if (sum == G) break;
        __builtin_amdgcn_s_sleep(1);
        if ((++sp & 255u) == 0u) { if (xb_ld(&bar[XB_TMO])) break; if (sp > XB_SPIN_CAP) { atomicAdd(&bar[XB_TMO], 1u); break; } }
    }
    nloc = mine > 0u ? mine : 1u; nx = cnt > 0u ? cnt : 1u;
}
__device__ __forceinline__ void xcd_barrier(const XcdBarrier& b) {
    asm volatile("s_waitcnt vmcnt(0)" ::: "memory");
    __syncthreads();
    if (threadIdx.x == 0) {
        unsigned* bar = b.bar;
        __builtin_amdgcn_s_waitcnt(0);
        unsigned nloc = b.st[0], nx = b.st[1];
        if (nloc == 0u) { xcd_barrier_complete(bar, b.x, nloc, nx); b.st[0] = nloc; b.st[1] = nx; }
        const unsigned old = xb_add(&bar[XB_XSUB(b.x)], 1u);
        const unsigned gen = old / nloc;
        if (old + 1u == (gen + 1u) * nloc) {
            __builtin_amdgcn_fence(__ATOMIC_RELEASE, "agent");
            asm volatile("s_waitcnt vmcnt(0)" ::: "memory");
            const unsigned og = xb_add(&bar[XB_TOP], 1u);
            const unsigned tg = og / nx;
            if (og + 1u == (tg + 1u) * nx) xb_add(&bar[XB_TOPGEN], 1u);
            else XB_SPIN(xb_ld(&bar[XB_TOPGEN]) == tg, bar);
            xb_add(&bar[XB_XGEN(b.x)], 1u);
            __builtin_amdgcn_fence(__ATOMIC_ACQUIRE, "agent");
            asm volatile("s_waitcnt vmcnt(0)" ::: "memory");
        } else {
            XB_SPIN(xb_ld(&bar[XB_XGEN(b.x)]) == gen, bar);
            __builtin_amdgcn_fence(__ATOMIC_ACQUIRE, "agent");
            asm volatile("s_waitcnt vmcnt(0)" ::: "memory");
        }
    }
    __syncthreads();
}

constexpr int LDS_BYTES = 147456;
#ifndef PROBE
#define PROBE 0
#endif
#define FRESH() int tid = threadIdx.x, bid = blockIdx.x; asm volatile("" : "+v"(tid)); asm volatile("" : "+s"(bid));
__global__ void __launch_bounds__(512, 2) trunk_fwd(Params P) {
    extern __shared__ __attribute__((aligned(16))) unsigned char lds_raw[];
    LAS unsigned char* lds = (LAS unsigned char*)lds_raw;
    cg::grid_group grid = cg::this_grid();
    const int G = gridDim.x;
    volatile LAS unsigned* MISC = (volatile LAS unsigned*)(lds + LDS_BYTES - 128);
    const int wave_s = __builtin_amdgcn_readfirstlane((int)threadIdx.x >> 6);
    if (threadIdx.x < 32) MISC[threadIdx.x] = 0u;
    __syncthreads();
    XcdBarrier xbar = xcd_barrier_post((unsigned*)P.ws, MISC + 8, wave_s);
    unsigned char* ws = P.ws;
    const float* MOD = (const float*)(ws + WS_MOD);
    bf16_t* XN = (bf16_t*)(ws + WS_XN);
    bf16_t* ACT = (bf16_t*)(ws + WS_ACT);
#define GSYNC() xcd_barrier(xbar)
    if (PROBE == 30) { { FRESH(); p0_mod(P, lds, tid, bid, G); } { FRESH(); p0_rope(P, tid, bid, G); } __syncthreads(); }
    if (PROBE == 31) { FRESH(); conv_weights(P.ret_w_in, RET_IN, 6144, P.ret_w_out, 2048, ws + WS_W, lds, tid, bid, G); __syncthreads(); }
    { FRESH(); p0_mod(P, lds, tid, bid, G); }
    { FRESH(); p0_rope(P, tid, bid, G); }
    { FRESH(); conv_weights(P.ret_w_in, RET_IN, 6144, P.ret_w_out, 2048, ws + WS_W, lds, tid, bid, G); }
    grid.sync();
#pragma unroll 1
    for (int layer = 0; layer < 4; ++layer) {
        const int kind = layer % 3, j = layer / 3;
        unsigned char* wbase = ws + ((kind == 2) ? WS_WGLA : WS_W);
        bf16_t* WinT = (bf16_t*)wbase; bf16_t* WoutT = (bf16_t*)(wbase + 12 * MiB);
        const float* xin = (layer == 0) ? P.x : P.out;
        if (layer > 0) {
            FRESH();
            if (kind == 0) { if (G != 256) conv_weights(P.ret_w_in + (size_t)j * 1024 * RET_IN, RET_IN, 6144, P.ret_w_out + (size_t)j * 2048 * 1024, 2048, ws + WS_W, lds, tid, bid, G); }
            else if (kind == 1) conv_weights(P.fox_w_in, FOX_IN, 4096, P.fox_w_out, 1024, ws + WS_W, lds, tid, bid, G);
            else conv_weights(P.gla_w_in, GLA_IN, 3072, P.gla_w_out, 1024, ws + WS_WGLA, lds, tid, bid, G);
            __syncthreads();
        }
        if (PROBE == 5 || (PROBE >= 50 && PROBE <= 53 && layer == PROBE - 50)) {
            if (kind == 0) { FRESH(); h_phase<0>(P, layer, xin, lds, tid, bid, G); }
            else if (kind == 1) { FRESH(); h_phase<1>(P, layer, xin, lds, tid, bid, G); }
            else { FRESH(); h_phase<2>(P, layer, xin, lds, tid, bid, G); }
            __syncthreads();
        }
        if (kind == 0) { FRESH(); h_phase<0>(P, layer, xin, lds, tid, bid, G); }
        else if (kind == 1) { FRESH(); h_phase<1>(P, layer, xin, lds, tid, bid, G); }
        else { FRESH(); h_phase<2>(P, layer, xin, lds, tid, bid, G); }
        GSYNC();
        const float* gate = MOD + (size_t)(layer * 4) * 3072 + 2048;
        if (kind == 0) {
            bf16_t* rQ = ACT; bf16_t* rK = (bf16_t*)(ws + WS_ACT + 32 * MiB); bf16_t* rV = (bf16_t*)(ws + WS_ACT + 64 * MiB); bf16_t* rO = (bf16_t*)(ws + WS_ACT + 128 * MiB);
            bf16_t* rP = WinT;
            float* STATS = (float*)(ws + WS_S16);
            {
                FRESH();
                pg8::Gemm g{XN, WinT, MT, 4096, 1024}; pg8::StaticOrder S; S.init(MT, 4096, G, bid);
                EpiRetIn E{rQ, rK, rV, (const unsigned*)(ws + WS_ROPE)};
                pg8::gemm_phase<EpiRetIn, pg8::StaticOrder, true, true>(lds, g, S, E, tid);
            }
            GSYNC();
            if (PROBE == 40) { FRESH();
                pg8::Gemm g{XN, WinT, MT, 4096, 1024}; pg8::StaticOrder S; S.init(MT, 4096, G, bid);
                EpiRetIn E{rQ, rK, rV, (const unsigned*)(ws + WS_ROPE)};
                pg8::gemm_phase<EpiRetIn, pg8::StaticOrder, true, true>(lds, g, S, E, tid); GSYNC(); }
            if (PROBE == 6) { FRESH();
                pg8::Gemm g{XN, WinT + (size_t)4096 * 1024, MT, 2048, 1024}; pg8::StaticOrder S; S.init(MT, 2048, G, bid);
                EpiSplit E{(bf16_t*)P.out, 8, 0, 2048, -1};
                if (layer == 0) { pg8::gemm_phase<EpiSplit, pg8::StaticOrder, true, true>(lds, g, S, E, tid); GSYNC(); } }
            if (PROBE == 62 && layer == 0) { FRESH();
                pg8::Gemm g{XN, WinT, MT, 4096, 1024}; pg8::StaticOrder S; S.init(MT, 4096, G, bid);
                EpiNone E{P.out};
                pg8::gemm_phase<EpiNone, pg8::StaticOrder, true, true>(lds, g, S, E, tid); GSYNC(); }
            if (PROBE == 60 && layer == 0) { FRESH();
                pg8::Gemm g{XN, WinT + (size_t)4096 * 1024, MT, 2048, 1024}; pg8::StaticOrder S; S.init(MT, 2048, G, bid);
                EpiNone E{P.out};
                pg8::gemm_phase<EpiNone, pg8::StaticOrder, true, true>(lds, g, S, E, tid); GSYNC(); }
            { FRESH(); lin_pphase<0>(rQ, rK, rQ, rK, rP, tid, bid, G); }
            GSYNC();
            if (PROBE == 2) { FRESH(); lin_scan<0>(rQ, rK, rV, rP, nullptr, rO, (float*)(ws + WS_CUM), lds, tid, bid, G); GSYNC(); }
            if (PROBE == 20 && layer == 0) { FRESH(); lin_scan<0, 1>(rQ, rK, rV, rP, nullptr, (bf16_t*)P.out, (float*)(ws + WS_CUM), lds, tid, bid, G); GSYNC(); }
            if (PROBE == 23 && layer == 0) { FRESH(); lin_scan<0, 4>(rQ, rK, rV, rP, nullptr, (bf16_t*)P.out, (float*)(ws + WS_CUM), lds, tid, bid, G); GSYNC(); }
            if (PROBE == 25 && layer == 0) { FRESH(); lin_scan<0, 16>(rQ, rK, rV, rP, nullptr, (bf16_t*)P.out, (float*)(ws + WS_CUM), lds, tid, bid, G); GSYNC(); }
            if (PROBE == 21 && layer == 0) { FRESH(); lin_scan<0, 2>(rQ, rK, rV, rP, nullptr, (bf16_t*)P.out, (float*)(ws + WS_CUM), lds, tid, bid, G); GSYNC(); }
            if (PROBE == 24 && layer == 0) { FRESH(); lin_scan<0, 8>(rQ, rK, rV, rP, nullptr, (bf16_t*)P.out, (float*)(ws + WS_CUM), lds, tid, bid, G); GSYNC(); }
            if (PROBE == 26 && layer == 0) { FRESH(); lin_scan<0, 3>(rQ, rK, rV, rP, nullptr, (bf16_t*)P.out, (float*)(ws + WS_CUM), lds, tid, bid, G); GSYNC(); }
            if (PROBE == 27 && layer == 0) { FRESH(); lin_scan<0, 11>(rQ, rK, rV, rP, nullptr, (bf16_t*)P.out, (float*)(ws + WS_CUM), lds, tid, bid, G); GSYNC(); }
            if (PROBE == 28 && layer == 0) { FRESH(); lin_scan<0, 31>(rQ, rK, rV, rP, nullptr, (bf16_t*)P.out, (float*)(ws + WS_CUM), lds, tid, bid, G); GSYNC(); }
            if (PROBE == 22 && layer == 0) { FRESH(); lin_scan<0, 0>(rQ, rK, rV, rP, nullptr, (bf16_t*)P.out, (float*)(ws + WS_CUM), lds, tid, bid, G); GSYNC(); }
            { FRESH(); lin_scan<0>(rQ, rK, rV, rP, nullptr, rO, (float*)(ws + WS_CUM), lds, tid, bid, G); }
            GSYNC();
            {
                FRESH();
                pg8::Gemm g{XN, WinT + (size_t)4096 * 1024, MT, 2048, 1024}; pg8::PairOrder S{G, (G % 8 == 0) ? (bid % 8) * (G / 8) + bid / 8 : bid};
                EpiGateNorm<0> E{rO, STATS, (LAS float*)(lds + 131072)};
                pg8::gemm_phase<EpiGateNorm<0>, pg8::PairOrder, true, true>(lds, g, S, E, tid);
            }
            GSYNC();
            if (PROBE == 42 && layer == 0) { FRESH();
                pg8::Gemm g{rO, WoutT, MT, 1024, 2048}; pg8::StaticOrder S; S.init(MT, 1024, G, bid);
                EpiOut E{xin, P.out, gate};
                pg8::gemm_phase<EpiOut, pg8::StaticOrder, true, true>(lds, g, S, E, tid); GSYNC(); }
            {
                FRESH();
                pg8::Gemm g{rO, WoutT, MT, 1024, 2048}; pg8::StaticOrder S; S.init(MT, 1024, G, bid);
                EpiOut E{xin, P.out, gate};
                pg8::gemm_phase<EpiOut, pg8::StaticOrder, true, true>(lds, g, S, E, tid);
            }
            GSYNC();
        } else if (kind == 1) {
            {
                FRESH();
                pg8::Gemm g{XN, WinT, MT, 4096, 1024}; pg8::StaticOrder S; S.init(MT, 4096, G, bid);
                EpiFoxIn E{ACT, P.fox_q_gain, P.fox_k_gain, (LAS float*)(lds + 131072)};
                pg8::gemm_phase<EpiFoxIn, pg8::StaticOrder, true, true>(lds, g, S, E, tid);
            }
            GSYNC();
            if (PROBE == 41) { FRESH();
                pg8::Gemm g{XN, WinT, MT, 4096, 1024}; pg8::StaticOrder S; S.init(MT, 4096, G, bid);
                EpiFoxIn E{ACT, P.fox_q_gain, P.fox_k_gain, (LAS float*)(lds + 131072)};
                pg8::gemm_phase<EpiFoxIn, pg8::StaticOrder, true, true>(lds, g, S, E, tid); GSYNC(); }
            if (PROBE == 1) { FRESH(); fox_attn2(P, (char*)lds_raw, tid, bid, G, XN); GSYNC(); }
            { FRESH(); fox_attn2(P, (char*)lds_raw, tid, bid, G, nullptr); }
            GSYNC();
            {
                FRESH();
                pg8::Gemm g{ACT, WoutT, MT, 1024, 1024}; pg8::StaticOrder S; S.init(MT, 1024, G, bid);
                EpiOut E{xin, P.out, gate};
                pg8::gemm_phase<EpiOut, pg8::StaticOrder, true, true>(lds, g, S, E, tid);
            }
            GSYNC();
        } else {
            bf16_t* gQE = ACT; bf16_t* gQN = (bf16_t*)(ws + WS_ACT + 16 * MiB); bf16_t* gKE = (bf16_t*)(ws + WS_ACT + 32 * MiB); bf16_t* gKN = (bf16_t*)(ws + WS_ACT + 48 * MiB);
            bf16_t* gV = (bf16_t*)(ws + WS_ACT + 64 * MiB); bf16_t* gP = (bf16_t*)(ws + WS_ACT + 96 * MiB); bf16_t* gO = (bf16_t*)(ws + WS_ACT + 128 * MiB);
            const float* gCB = (const float*)(ws + WS_ACT + 160 * MiB);
            float* STATS = (float*)(ws + WS_S16);
            {
                FRESH();
                pg8::Gemm g{XN, WinT, MT, 2048, 1024}; pg8::StaticOrder S; S.init(MT, 2048, G, bid);
                EpiGlaIn E{gQE, gQN, gKE, gKN, gV, nullptr, gCB};
                pg8::gemm_phase<EpiGlaIn, pg8::StaticOrder, true, true>(lds, g, S, E, tid);
            }
            GSYNC();
            { FRESH(); lin_pphase<1>(gQE, gKN, gQN, gKE, gP, tid, bid, G); }
            GSYNC();
            if (PROBE == 3) { FRESH(); lin_scan<1>(gQE, gKN, gV, gP, gCB, gO, (float*)(ws + WS_CUM), lds, tid, bid, G); GSYNC(); }
            if (G == 256 && ((int)blockIdx.x >> 3) >= 16) {
                FRESH(); const int sub = (bid & 7) * 16 + ((bid >> 3) - 16);
                conv_weights(P.ret_w_in + (size_t)1 * 1024 * RET_IN, RET_IN, 6144, P.ret_w_out + (size_t)1 * 2048 * 1024, 2048, ws + WS_W, lds, tid, sub, 128);
            } else { FRESH(); lin_scan<1>(gQE, gKN, gV, gP, gCB, gO, (float*)(ws + WS_CUM), lds, tid, bid, G); }
            GSYNC();
            {
                FRESH();
                pg8::Gemm g{XN, WinT + (size_t)2048 * 1024, MT, 1024, 1024}; pg8::StaticOrder S; S.init(MT, 1024, G, bid);
                EpiGateNorm<1> E{gO, STATS, (LAS float*)(lds + 131072)};
                pg8::gemm_phase<EpiGateNorm<1>, pg8::StaticOrder, true, true>(lds, g, S, E, tid);
            }
            GSYNC();
            {
                FRESH();
                pg8::Gemm g{gO, WoutT, MT, 1024, 1024}; pg8::StaticOrder S; S.init(MT, 1024, G, bid);
                EpiOut E{xin, P.out, gate};
                pg8::gemm_phase<EpiOut, pg8::StaticOrder, true, true>(lds, g, S, E, tid);
            }
            GSYNC();
        }
    }
    if (PROBE == 70) { for (int i = 0; i < 10; ++i) GSYNC(); }
    { FRESH(); final_norm(P, tid, bid, G); }
}

extern "C" void kernel_launch(void* const* d_in, const int* in_sizes, int n_in, void* d_out, int out_size, void* d_ws, size_t ws_size, hipStream_t stream) {
    static int grid = 0;
    if (grid == 0) {
        if (n_in != 18 || out_size != MT * DM || ws_size < WS_END) { fprintf(stderr, "kernel_launch: unexpected shapes (n_in %d out %d ws %zu)\n", n_in, out_size, ws_size); grid = -1; return; }
        int dev = 0, cus = 0, per_cu = 0;
        hipGetDevice(&dev);
        hipDeviceGetAttribute(&cus, hipDeviceAttributeMultiprocessorCount, dev);
        hipFuncSetAttribute((const void*)trunk_fwd, hipFuncAttributeMaxDynamicSharedMemorySize, LDS_BYTES);
        hipOccupancyMaxActiveBlocksPerMultiprocessor(&per_cu, (const void*)trunk_fwd, 512, LDS_BYTES);
        if (per_cu < 1) { fprintf(stderr, "kernel_launch: occupancy query says %d blocks per CU\n", per_cu); per_cu = 1; }
        (void)hipGetLastError();
        grid = cus;
    }
    if (grid < 0) return;
    Params p{};
    p.x = (const float*)d_in[0]; p.c = (const float*)d_in[1]; p.pos = (const int*)d_in[2]; p.mod_w = (const float*)d_in[3]; p.mod_b = (const float*)d_in[4]; p.norm_g = (const float*)d_in[5];
    p.ret_w_in = (const float*)d_in[6]; p.ret_w_out = (const float*)d_in[7]; p.fox_w_in = (const float*)d_in[8]; p.fox_b_f = (const float*)d_in[9]; p.fox_q_gain = (const float*)d_in[10]; p.fox_k_gain = (const float*)d_in[11];
    p.fox_w_out = (const float*)d_in[12]; p.gla_w_in = (const float*)d_in[13]; p.gla_w_gate2 = (const float*)d_in[14]; p.gla_b_gate = (const float*)d_in[15]; p.gla_w_out = (const float*)d_in[16]; p.final_g = (const float*)d_in[17];
    p.out = (float*)d_out; p.ws = (unsigned char*)d_ws;
    if (hipMemsetAsync(d_ws, 0, 16384, stream) != hipSuccess) { fprintf(stderr, "kernel_launch: memset failed\n"); return; }
    void* args[] = {&p};
    hipError_t e = hipLaunchCooperativeKernel((const void*)trunk_fwd, dim3(grid), dim3(512), args, LDS_BYTES, stream);
    if (e != hipSuccess) fprintf(stderr, "cooperative launch failed: %s (grid %d)\n", hipGetErrorString(e), grid);
}
```

```cpp
#include <hip/hip_runtime.h>
#include <hip/hip_cooperative_groups.h>
#include <cstdio>
#include <cstdint>
#include <cmath>
namespace cg = cooperative_groups;

#define LAS __attribute__((address_space(3)))
typedef unsigned short bf16_t;
typedef short bf16x8 __attribute__((ext_vector_type(8)));
typedef float f32x4 __attribute__((ext_vector_type(4)));
typedef float f32x2 __attribute__((ext_vector_type(2)));
typedef unsigned u32x4 __attribute__((ext_vector_type(4)));
typedef unsigned u32x2 __attribute__((ext_vector_type(2)));

constexpr int DM = 1024, NB = 4, SEQ = 4096, MT = NB * SEQ;
constexpr float EPS = 1e-6f;
constexpr int RET_IN = 6144, FOX_IN = 4112, GLA_IN = 3088;
constexpr float LOG2E = 1.4426950408889634f;

constexpr size_t MiB = 1u << 20;
constexpr size_t WS_MOD = 1 * MiB;
constexpr size_t WS_S16 = 2 * MiB;
constexpr size_t WS_CUM = 3 * MiB;
constexpr size_t WS_ROPE = 4 * MiB;
constexpr size_t WS_W = 12 * MiB;
constexpr size_t WS_WOUT = WS_W + 12 * MiB;
constexpr size_t WS_WGLA = 164 * MiB;
constexpr size_t WS_XN = 28 * MiB;
constexpr size_t WS_ACT = 60 * MiB;
constexpr size_t WS_END = 252 * MiB;

__device__ __forceinline__ unsigned f2bf(float f) { unsigned u = __builtin_bit_cast(unsigned, f); return (u + 0x7fffu + ((u >> 16) & 1u)) >> 16; }
typedef float f32x2_hw __attribute__((ext_vector_type(2))); typedef __bf16 bf16x2_hw __attribute__((ext_vector_type(2)));
__device__ __forceinline__ unsigned pk2(float lo, float hi) { f32x2_hw v = {lo, hi}; bf16x2_hw b = __builtin_convertvector(v, bf16x2_hw); return __builtin_bit_cast(unsigned, b); }
__device__ __forceinline__ float bf2f(unsigned h) { return __builtin_bit_cast(float, h << 16); }
__device__ __forceinline__ u32x2 pk4(f32x4 v) { u32x2 r; r.x = pk2(v[0], v[1]); r.y = pk2(v[2], v[3]); return r; }
__device__ __forceinline__ f32x4 unpk4(u32x2 w) { f32x4 r; r[0] = bf2f(w.x & 0xffffu); r[1] = bf2f(w.x >> 16); r[2] = bf2f(w.y & 0xffffu); r[3] = bf2f(w.y >> 16); return r; }
__device__ __forceinline__ float silu_f(float v) { return v * __builtin_amdgcn_rcpf(1.0f + __expf(-v)); }
__device__ __forceinline__ float logsig_f(float v) { return fminf(v, 0.0f) - __logf(1.0f + __expf(-fabsf(v))); }
template <int CTRL> __device__ __forceinline__ float dpp_mov(float v) { return __builtin_bit_cast(float, __builtin_amdgcn_update_dpp(0, __builtin_bit_cast(int, v), CTRL, 0xf, 0xf, true)); }
__device__ __forceinline__ float swap32_sum(float x, float y) { auto r = __builtin_amdgcn_permlane32_swap(__builtin_bit_cast(unsigned, x), __builtin_bit_cast(unsigned, y), false, false); const unsigned r0 = r[0], r1 = r[1]; return __builtin_bit_cast(float, r0) + __builtin_bit_cast(float, r1); }
__device__ __forceinline__ float swap16_sum(float x, float y) { auto r = __builtin_amdgcn_permlane16_swap(__builtin_bit_cast(unsigned, x), __builtin_bit_cast(unsigned, y), false, false); const unsigned r0 = r[0], r1 = r[1]; return __builtin_bit_cast(float, r0) + __builtin_bit_cast(float, r1); }
__device__ __forceinline__ float row_sum16(float v) {
    v += dpp_mov<0xB1>(v);
    v += dpp_mov<0x4E>(v);
    v += dpp_mov<0x141>(v);
    v += dpp_mov<0x140>(v);
    return v;
}
__device__ __forceinline__ float xsum_16_32(float v) { v = swap16_sum(v, v); return swap32_sum(v, v); }
__device__ __forceinline__ float wave_sum(float v) { return xsum_16_32(row_sum16(v)); }
__device__ __forceinline__ float reduce_scatter16(const float (&a)[16], int lane) {
    float b8[8], c4[4], d2[2], e1;
#pragma unroll
    for (int i = 0; i < 8; ++i) b8[i] = swap32_sum(a[i], a[i + 8]);
#pragma unroll
    for (int i = 0; i < 4; ++i) c4[i] = swap16_sum(b8[i], b8[i + 4]);
    { const bool hi = (lane & 8) != 0;
#pragma unroll
      for (int i = 0; i < 2; ++i) { const float snd = hi ? c4[i] : c4[i + 2], kp = hi ? c4[i + 2] : c4[i]; d2[i] = kp + dpp_mov<0x128>(snd); } }
    { const bool hi = (lane & 4) != 0; const float snd = hi ? d2[0] : d2[1], kp = hi ? d2[1] : d2[0]; e1 = kp + dpp_mov<0x1B>(dpp_mov<0x141>(snd)); }
    e1 += dpp_mov<0x4E>(e1); e1 += dpp_mov<0xB1>(e1);
    return e1;
}
#define LDS_WAIT() asm volatile("s_waitcnt lgkmcnt(0)" ::: "memory")

__device__ __forceinline__ f32x4 mma_rc(f32x4 acc, bf16x8 a_rows, bf16x8 b_cols) { return __builtin_amdgcn_mfma_f32_16x16x32_bf16(b_cols, a_rows, acc, 0, 0, 0); }
__device__ __forceinline__ f32x4 mma_cr(f32x4 acc, bf16x8 a_rows, bf16x8 b_cols) { return __builtin_amdgcn_mfma_f32_16x16x32_bf16(a_rows, b_cols, acc, 0, 0, 0); }
__device__ __forceinline__ bf16x8 gfrag(const bf16_t* base, int pitch, int lane) { return *(const bf16x8*)(base + (size_t)(lane & 15) * pitch + 8 * (lane >> 4)); }
__device__ __forceinline__ bf16x8 lfrag(const LAS bf16_t* base, int pitch, int lane) { return *(const LAS bf16x8*)(base + (lane & 15) * pitch + 8 * (lane >> 4)); }

namespace pg8 {
#define PG8_LAS __attribute__((address_space(3)))
constexpr int BM = 256, BK = 64, HALF = 128, HTB = HALF * BK * 2, STAGE_BYTES = 8 * HTB, NXCD = 8, WGM = 8;
__host__ __device__ __forceinline__ int lds_byte(int r, int c) { const int st = (r >> 4) * 2 + (c >> 5), rr = r & 15, cc = c & 31, ob = rr * 64 + cc * 2; return st * 1024 + (ob ^ (((ob >> 9) & 1) << 5)); }
__host__ __device__ __forceinline__ void stage_rc(int b, int& R, int& C) { const int st = b / 1024, sb = b % 1024, swz = sb ^ (((sb >> 9) & 1) << 5); R = (st >> 1) * 16 + swz / 64; C = (st & 1) * 32 + (swz % 64) / 2; }
__host__ __device__ __forceinline__ int perm32(int rho) { const int n = rho >> 4, i = rho & 15; return 8 * (i >> 2) + 4 * n + (i & 3); }

struct Unit { int pm, pn; };
struct Gemm { const bf16_t* A; const bf16_t* Bt; int M, N, K; };
struct StaticOrder {
    int nM, nN, nwg, G, c;
    __host__ __device__ void init(int M, int N, int G_, int c_) { nM = M / BM; nN = N / BM; nwg = nM * nN; G = G_; c = c_; }
    __host__ __device__ bool next(int i, Unit& u) const {
        const long L = (long)i * G + c; if (L >= nwg) return false;
        int wgid = (int)L; { const int q = nwg / NXCD, r = nwg % NXCD, xcd = wgid % NXCD, off = wgid / NXCD; wgid = (xcd < r ? xcd * (q + 1) : r * (q + 1) + (xcd - r) * q) + off; }
        const int nig = WGM * nN, gid = wgid / nig, fm = gid * WGM, gsz = (nM - fm) < WGM ? (nM - fm) : WGM;
        u.pm = fm + ((wgid % nig) % gsz); u.pn = (wgid % nig) / gsz; return true;
    }
    __device__ __forceinline__ void a_ready(const Unit&) const {}
    __device__ __forceinline__ void done(const Unit&) const {}
};

struct PairOrder {
    int G, c;
    __device__ __forceinline__ bool next(int i, Unit& u) const { const int pair = (i >> 1) * G + c; if (pair >= 256) return false; u.pm = pair >> 2; u.pn = 2 * (pair & 3) + (i & 1); return true; }
    __device__ __forceinline__ void a_ready(const Unit&) const {}
    __device__ __forceinline__ void done(const Unit&) const {}
};
template <class Epi, class Sched, bool ALIGN_EPI = false, bool SP2 = false>
__device__ __forceinline__ void gemm_phase(PG8_LAS unsigned char* lds, const Gemm g, const Sched& S, const Epi& E, int tid) {
    const int wid = __builtin_amdgcn_readfirstlane(tid >> 6), lane = tid & 63, wr = wid >> 2, wc = wid & 3, fr = lane & 15, fq = lane >> 4;
    const int K = g.K, nt = K / BK;
    unsigned voffA[2], voffB[2];
#pragma unroll
    for (int i = 0; i < 2; ++i) { int R, C; stage_rc(tid * 16 + i * 8192, R, C); const int Rb = Epi::PERM ? ((R & ~31) + perm32(R & 31)) : R;
        voffA[i] = (unsigned)(R * K + C) * 2u; voffB[i] = (unsigned)(Rb * K + C) * 2u; }
    const size_t kstep = (size_t)(BK * 2);
    const size_t hstep = (size_t)HALF * K * 2;
    const size_t tstep = 2 * hstep;
    const unsigned ldsw = (unsigned)wid * 1024u;
    const int aoff = lds_byte(wr * 64 + fr, fq * 8), boff = lds_byte(wc * 32 + fr, fq * 8);
#define PG8_SA(b, h) (((b) * 2 + (h)) * HTB)
#define PG8_SB(b, h) ((4 + (b) * 2 + (h)) * HTB)
#define PG8_STAGE(bufoff, gbase, voff) do { _Pragma("unroll") for (int _i = 0; _i < 2; ++_i) \
        __builtin_amdgcn_global_load_lds((const unsigned*)((const char*)(gbase) + (voff)[_i]), (PG8_LAS unsigned*)(lds + (bufoff) + ldsw + _i * 8192), 16, 0, 0); } while (0)
#define PG8_LDA(dst, b, h) do { _Pragma("unroll") for (int m = 0; m < 4; ++m) _Pragma("unroll") for (int k = 0; k < 2; ++k) dst[m][k] = *(const PG8_LAS bf16x8*)(lds + PG8_SA(b, h) + aoff + m * 2048 + k * 1024); } while (0)
#define PG8_LDB(dst, b, h) do { _Pragma("unroll") for (int n = 0; n < 2; ++n) _Pragma("unroll") for (int k = 0; k < 2; ++k) dst[n][k] = *(const PG8_LAS bf16x8*)(lds + PG8_SB(b, h) + boff + n * 2048 + k * 1024); } while (0)
#define PG8_MMA(ai, bj, At, Bt) do { __builtin_amdgcn_s_setprio(1); _Pragma("unroll") for (int m = 0; m < 4; ++m) _Pragma("unroll") for (int n = 0; n < 2; ++n) _Pragma("unroll") for (int k = 0; k < 2; ++k) \
        acc[ai][bj][m][n] = __builtin_amdgcn_mfma_f32_16x16x32_bf16(Bt[n][k], At[m][k], acc[ai][bj][m][n], 0, 0, 0); __builtin_amdgcn_s_setprio(0); } while (0)
#define PG8_WAIT_V(n) asm volatile("s_waitcnt vmcnt(" #n ")" ::: "memory")
#define PG8_WAIT_L(n) asm volatile("s_waitcnt lgkmcnt(" #n ")" ::: "memory")
#define PG8_BAR __builtin_amdgcn_s_barrier()
#define PG8_SCHED __builtin_amdgcn_sched_barrier(0)
    Unit cur, nxt; int ui = 0;
    if (!S.next(0, cur)) return;
    f32x4 acc[2][2][4][2];
#pragma unroll
    for (int a = 0; a < 2; ++a)
#pragma unroll
        for (int b = 0; b < 2; ++b)
#pragma unroll
            for (int m = 0; m < 4; ++m)
#pragma unroll
                for (int n = 0; n < 2; ++n) acc[a][b][m][n] = (f32x4){0.f, 0.f, 0.f, 0.f};
    bf16x8 At[4][2], B0[2][2], B1[2][2];
    const char* cA = (const char*)g.A + (size_t)cur.pm * tstep; const char* cB = (const char*)g.Bt + (size_t)cur.pn * tstep;
    S.a_ready(cur);
    if constexpr (SP2) {
        PG8_STAGE(PG8_SB(0, 0), cB, voffB); PG8_STAGE(PG8_SB(0, 1), cB + hstep, voffB); PG8_STAGE(PG8_SA(0, 0), cA, voffA); PG8_STAGE(PG8_SA(0, 1), cA + hstep, voffA);
        if (wr == 1) PG8_BAR;
        PG8_WAIT_V(2); PG8_BAR;
        PG8_STAGE(PG8_SB(1, 0), cB + kstep, voffB); PG8_STAGE(PG8_SA(1, 0), cA + kstep, voffA); PG8_STAGE(PG8_SB(1, 1), cB + hstep + kstep, voffB);
        PG8_WAIT_V(6); PG8_BAR;
    } else {
        PG8_STAGE(PG8_SB(0, 0), cB, voffB); PG8_STAGE(PG8_SA(0, 0), cA, voffA); PG8_STAGE(PG8_SB(0, 1), cB + hstep, voffB); PG8_STAGE(PG8_SA(0, 1), cA + hstep, voffA);
        if (wr == 1) PG8_BAR;
        PG8_WAIT_V(4); PG8_BAR;
        PG8_STAGE(PG8_SB(1, 0), cB + kstep, voffB); PG8_STAGE(PG8_SA(1, 0), cA + kstep, voffA); PG8_STAGE(PG8_SB(1, 1), cB + hstep + kstep, voffB);
        PG8_WAIT_V(6); PG8_BAR;
    }
    for (;;) {
        const bool has_next = S.next(ui + 1, nxt);
        const char* nA = has_next ? (const char*)g.A + (size_t)nxt.pm * tstep : cA; const char* nB = has_next ? (const char*)g.Bt + (size_t)nxt.pn * tstep : cB;
        for (int t = 0; t < nt; t += 2) {
            const bool last = (t == nt - 2);
            const char* a1 = cA + (size_t)(t + 1) * kstep;
            const char* a2 = last ? nA : cA + (size_t)(t + 2) * kstep; const char* b2 = last ? nB : cB + (size_t)(t + 2) * kstep;
            const char* a3 = a2 + kstep; const char* b3 = b2 + kstep;
            if (last && has_next) S.a_ready(nxt);
            if constexpr (SP2) {
            PG8_LDB(B0, 0, 0); PG8_LDB(B1, 0, 1); PG8_SCHED; PG8_LDA(At, 0, 0); PG8_STAGE(PG8_SA(1, 1), a1 + hstep, voffA);
            PG8_WAIT_V(8); PG8_WAIT_L(0); PG8_BAR; PG8_MMA(0, 0, At, B0); PG8_MMA(0, 1, At, B1); PG8_BAR; PG8_SCHED;
            PG8_LDA(At, 0, 1); PG8_STAGE(PG8_SB(0, 0), b2, voffB); PG8_STAGE(PG8_SB(0, 1), b2 + hstep, voffB); PG8_STAGE(PG8_SA(0, 0), a2, voffA);
            PG8_WAIT_V(8); PG8_WAIT_L(0); PG8_BAR; PG8_MMA(1, 0, At, B0); PG8_MMA(1, 1, At, B1); PG8_BAR; PG8_SCHED;
            PG8_LDB(B0, 1, 0); PG8_LDB(B1, 1, 1); PG8_SCHED; PG8_LDA(At, 1, 0); PG8_STAGE(PG8_SA(0, 1), a2 + hstep, voffA);
            PG8_WAIT_V(8); PG8_WAIT_L(0); PG8_BAR; PG8_MMA(0, 0, At, B0); PG8_MMA(0, 1, At, B1); PG8_BAR; PG8_SCHED;
            PG8_LDA(At, 1, 1); PG8_STAGE(PG8_SB(1, 0), b3, voffB); PG8_STAGE(PG8_SB(1, 1), b3 + hstep, voffB); PG8_STAGE(PG8_SA(1, 0), a3, voffA);
            PG8_WAIT_V(8); PG8_WAIT_L(0); PG8_BAR; PG8_MMA(1, 0, At, B0); PG8_MMA(1, 1, At, B1); PG8_BAR; PG8_SCHED;
            } else {
            PG8_LDB(B0, 0, 0); PG8_SCHED; PG8_LDA(At, 0, 0); PG8_STAGE(PG8_SA(1, 1), a1 + hstep, voffA);
            PG8_WAIT_L(8); PG8_BAR; PG8_WAIT_L(0); PG8_MMA(0, 0, At, B0); PG8_BAR; PG8_SCHED;
            PG8_LDB(B1, 0, 1); PG8_STAGE(PG8_SB(0, 0), b2, voffB);
            PG8_BAR; PG8_WAIT_L(0); PG8_MMA(0, 1, At, B1); PG8_BAR;
            PG8_LDA(At, 0, 1); PG8_STAGE(PG8_SA(0, 0), a2, voffA);
            PG8_BAR; PG8_WAIT_L(0); PG8_MMA(1, 0, At, B0); PG8_BAR; PG8_SCHED;
            PG8_STAGE(PG8_SB(0, 1), b2 + hstep, voffB);
            PG8_WAIT_V(6); PG8_BAR; PG8_MMA(1, 1, At, B1); PG8_BAR;
            PG8_LDB(B0, 1, 0); PG8_SCHED; PG8_LDA(At, 1, 0); PG8_STAGE(PG8_SA(0, 1), a2 + hstep, voffA);
            PG8_WAIT_L(8); PG8_BAR; PG8_WAIT_L(0); PG8_MMA(0, 0, At, B0); PG8_BAR; PG8_SCHED;
            PG8_LDB(B1, 1, 1); PG8_STAGE(PG8_SB(1, 0), b3, voffB);
            PG8_BAR; PG8_WAIT_L(0); PG8_MMA(0, 1, At, B1); PG8_BAR;
            PG8_LDA(At, 1, 1); PG8_STAGE(PG8_SA(1, 0), a3, voffA);
            PG8_BAR; PG8_WAIT_L(0); PG8_MMA(1, 0, At, B0); PG8_BAR; PG8_SCHED;
            PG8_STAGE(PG8_SB(1, 1), b3 + hstep, voffB);
            PG8_WAIT_V(6); PG8_BAR; PG8_MMA(1, 1, At, B1); PG8_BAR;
            }
        }
        if constexpr (ALIGN_EPI) { if (wr == 0) PG8_BAR; }
        E(acc, cur, wr, wc, fr, fq); S.done(cur);
        if (!has_next) break;
#pragma unroll
        for (int a = 0; a < 2; ++a)
#pragma unroll
            for (int b = 0; b < 2; ++b)
#pragma unroll
                for (int m = 0; m < 4; ++m)
#pragma unroll
                    for (int n = 0; n < 2; ++n) acc[a][b][m][n] = (f32x4){0.f, 0.f, 0.f, 0.f};
        cur = nxt; cA = nA; cB = nB; ++ui;
        if constexpr (ALIGN_EPI) { if (wr == 1) PG8_BAR; }
    }
    PG8_WAIT_V(0);
    if constexpr (!ALIGN_EPI) { if (wr == 0) PG8_BAR; }
    PG8_BAR;
#undef PG8_SA
#undef PG8_SB
#undef PG8_STAGE
#undef PG8_LDA
#undef PG8_LDB
#undef PG8_MMA
#undef PG8_WAIT_V
#undef PG8_WAIT_L
#undef PG8_BAR
#undef PG8_SCHED
}
}

struct Params {
    const float* x; const float* c; const int* pos; const float* mod_w; const float* mod_b; const float* norm_g;
    const float* ret_w_in; const float* ret_w_out; const float* fox_w_in; const float* fox_b_f; const float* fox_q_gain; const float* fox_k_gain; const float* fox_w_out;
    const float* gla_w_in; const float* gla_w_gate2; const float* gla_b_gate; const float* gla_w_out; const float* final_g;
    float* out; unsigned char* ws;
};

template <int DK> __device__ __forceinline__ size_t frag_img_off(int row, int head, int ch0) {
    const int b = row >> 12, tok = row & 4095;
    return (size_t)((b * 4 + head) * 64 + (tok >> 6)) * (64 * DK * 2) + (size_t)((((ch0 >> 5) * 4 + ((tok >> 4) & 3)) * 64 + 16 * ((ch0 >> 3) & 3) + (tok & 15)) * 16 + 2 * (ch0 & 7));
}
template <int HV> __device__ __forceinline__ size_t v_img_off(int row, int col) {
    const int b = row >> 12, tok = row & 4095, head = col / HV, e = col % HV;
    return ((size_t)((b * 4 + head) * (HV / 32) + (e >> 5)) * 4096 + tok) * 64 + (size_t)((e & 31) * 2);
}
struct EpiRetIn {
    static constexpr bool PERM = true;
    bf16_t* Q; bf16_t* Kb; bf16_t* V; const unsigned* rope;
    __device__ __forceinline__ void operator()(const f32x4 (&acc)[2][2][4][2], const pg8::Unit& u, int wr, int wc, int fr, int fq) const {
        const int pn = u.pn;
        if (pn < 8) {
            bf16_t* dst = (pn < 4) ? Q : Kb; const int head = pn & 3; const float sc = (pn < 4) ? 0.0625f : 1.0f;
#pragma unroll
            for (int ai = 0; ai < 2; ++ai) {
                u32x4 cs[4][2];
#pragma unroll
                for (int m = 0; m < 4; ++m)
#pragma unroll
                    for (int n = 0; n < 2; ++n) cs[m][n] = *(const u32x4*)(rope + (size_t)(u.pm * 256 + ai * 128 + wr * 64 + m * 16 + fr) * 128 + wc * 32 + fq * 8 + n * 4);
                asm volatile("" ::: "memory");
#pragma unroll
                for (int m = 0; m < 4; ++m) {
                    const int row = u.pm * 256 + ai * 128 + wr * 64 + m * 16 + fr;
                    u32x4 w1, w2;
#pragma unroll
                    for (int n = 0; n < 2; ++n) {
                        const f32x4 x1 = acc[ai][0][m][n], x2 = acc[ai][1][m][n]; f32x4 o1, o2;
#pragma unroll
                        for (int j = 0; j < 4; ++j) {
                            const unsigned w = cs[m][n][j];
                            const float co = (float)__builtin_bit_cast(_Float16, (unsigned short)(w & 0xffffu)), si = (float)__builtin_bit_cast(_Float16, (unsigned short)(w >> 16));
                            o1[j] = (x1[j] * co - x2[j] * si) * sc; o2[j] = (x1[j] * si + x2[j] * co) * sc;
                        }
                        const u32x2 a1 = pk4(o1), a2 = pk4(o2);
                        if (n == 0) { w1.x = a1.x; w1.y = a1.y; w2.x = a2.x; w2.y = a2.y; } else { w1.z = a1.x; w1.w = a1.y; w2.z = a2.x; w2.w = a2.y; }
                    }
                    char* p = (char*)dst + frag_img_off<256>(row, head, wc * 32 + fq * 8);
                    *(u32x4*)p = w1; *(u32x4*)(p + 16384) = w2;
                }
            }
        } else {
            const int cbase = (pn - 8) * 256;
#pragma unroll
            for (int ai = 0; ai < 2; ++ai)
#pragma unroll
                for (int m = 0; m < 4; ++m) {
                    const int row = u.pm * 256 + ai * 128 + wr * 64 + m * 16 + fr;
#pragma unroll
                    for (int bj = 0; bj < 2; ++bj) { const u32x2 a0 = pk4(acc[ai][bj][m][0]), a1 = pk4(acc[ai][bj][m][1]);
                        *(u32x4*)((char*)V + v_img_off<512>(row, cbase + bj * 128 + wc * 32 + fq * 8)) = (u32x4){a0.x, a0.y, a1.x, a1.y}; }
                }
        }
    }
};
struct EpiSplit {
    static constexpr bool PERM = false;
    bf16_t* dst; int tpg; size_t gstride; int ldc; int silu_grp;
    __device__ __forceinline__ void operator()(const f32x4 (&acc)[2][2][4][2], const pg8::Unit& u, int wr, int wc, int fr, int fq) const {
        const int t = u.pn / tpg; bf16_t* base = dst + (size_t)t * gstride; const int cb = (u.pn - t * tpg) * 256; const bool act = (t == silu_grp);
#pragma unroll
        for (int ai = 0; ai < 2; ++ai)
#pragma unroll
            for (int m = 0; m < 4; ++m) {
                const int row = u.pm * 256 + ai * 128 + wr * 64 + m * 16 + fr;
#pragma unroll
                for (int bj = 0; bj < 2; ++bj)
#pragma unroll
                    for (int n = 0; n < 2; ++n) {
                        f32x4 a = acc[ai][bj][m][n];
                        if (act) {
#pragma unroll
                            for (int j = 0; j < 4; ++j) a[j] = silu_f(a[j]);
                        }
                        *(u32x2*)(base + (size_t)row * ldc + cb + bj * 128 + wc * 32 + n * 16 + fq * 4) = pk4(a);
                    }
            }
    }
};
struct EpiFoxIn {
    static constexpr bool PERM = false;
    bf16_t* dst; const float* qgain; const float* kgain; LAS float* tbl;
    __device__ __forceinline__ void operator()(const f32x4 (&acc)[2][2][4][2], const pg8::Unit& u, int wr, int wc, int fr, int fq) const {
        const int t = u.pn >> 2; bf16_t* base = dst + (size_t)t * ((size_t)16 * MiB); const int cb = (u.pn & 3) * 256;
        if (t < 2) {
#pragma unroll
            for (int ai = 0; ai < 2; ++ai)
#pragma unroll
                for (int m = 0; m < 4; ++m)
#pragma unroll
                    for (int bj = 0; bj < 2; ++bj) {
                        float sq = 0.f;
#pragma unroll
                        for (int n = 0; n < 2; ++n) { const f32x4 a = acc[ai][bj][m][n]; sq += (a[0] * a[0] + a[1] * a[1]) + (a[2] * a[2] + a[3] * a[3]); }
                        sq = xsum_16_32(sq);
                        if (fq == 0) tbl[(((ai * 128 + wr * 64 + m * 16 + fr) * 4) + bj * 2 + (wc >> 1)) * 2 + (wc & 1)] = sq;
                    }
            asm volatile("s_waitcnt lgkmcnt(0)" ::: "memory"); __builtin_amdgcn_s_barrier(); asm volatile("" ::: "memory");
            const float* gn = (t == 0) ? qgain : kgain; const float sc = (t == 0) ? (0.125f * LOG2E) : 1.0f;
            f32x4 gv[2];
#pragma unroll
            for (int n = 0; n < 2; ++n) gv[n] = *(const f32x4*)(gn + (wc & 1) * 32 + n * 16 + fq * 4) * sc;
#pragma unroll
            for (int ai = 0; ai < 2; ++ai)
#pragma unroll
                for (int m = 0; m < 4; ++m) {
                    const int rl = ai * 128 + wr * 64 + m * 16 + fr; const int row = u.pm * 256 + rl;
#pragma unroll
                    for (int bj = 0; bj < 2; ++bj) {
                        const f32x2 pr = *(const LAS f32x2*)(tbl + ((rl * 4) + bj * 2 + (wc >> 1)) * 2);
                        const float rstd = __builtin_amdgcn_rsqf((pr.x + pr.y) * (1.0f / 64.0f) + EPS);
#pragma unroll
                        for (int n = 0; n < 2; ++n) *(u32x2*)(base + (size_t)row * 1024 + cb + bj * 128 + wc * 32 + n * 16 + fq * 4) = pk4(acc[ai][bj][m][n] * rstd * gv[n]);
                    }
                }
        } else {
            const bool act = (t == 3);
#pragma unroll
            for (int ai = 0; ai < 2; ++ai)
#pragma unroll
                for (int m = 0; m < 4; ++m) {
                    const int row = u.pm * 256 + ai * 128 + wr * 64 + m * 16 + fr;
#pragma unroll
                    for (int bj = 0; bj < 2; ++bj)
#pragma unroll
                        for (int n = 0; n < 2; ++n) {
                            f32x4 a = acc[ai][bj][m][n];
                            if (act) {
#pragma unroll
                                for (int j = 0; j < 4; ++j) a[j] = silu_f(a[j]);
                            }
                            *(u32x2*)(base + (size_t)row * 1024 + cb + bj * 128 + wc * 32 + n * 16 + fq * 4) = pk4(a);
                        }
                }
        }
    }
};
struct EpiGlaIn {
    static constexpr bool PERM = true;
    bf16_t *QE, *QN, *KE, *KN, *V, *G; const float* CB;
    __device__ __forceinline__ void operator()(const f32x4 (&acc)[2][2][4][2], const pg8::Unit& u, int wr, int wc, int fr, int fq) const {
        const int pn = u.pn;
        if (pn < 4) {
            const float s = (pn < 2) ? 0.08838834764831845f : 1.0f;
            bf16_t* De = (pn < 2 ? QE : KE); bf16_t* Dn = (pn < 2 ? QN : KN);
#pragma unroll
            for (int ai = 0; ai < 2; ++ai)
#pragma unroll
            for (int mh = 0; mh < 2; ++mh) {
                f32x4 cb[2][2][2];
#pragma unroll
                for (int mm = 0; mm < 2; ++mm)
#pragma unroll
                    for (int bj = 0; bj < 2; ++bj)
#pragma unroll
                        for (int n = 0; n < 2; ++n) cb[mm][bj][n] = *(const f32x4*)(CB + (size_t)(u.pm * 256 + ai * 128 + wr * 64 + (2 * mh + mm) * 16 + fr) * 512 + (pn & 1) * 256 + bj * 128 + wc * 32 + fq * 8 + n * 4);
                asm volatile("" ::: "memory");
#pragma unroll
                for (int mm = 0; mm < 2; ++mm) {
                    const int m = 2 * mh + mm; const int row = u.pm * 256 + ai * 128 + wr * 64 + m * 16 + fr;
#pragma unroll
                    for (int bj = 0; bj < 2; ++bj) {
                        u32x4 we, wn;
#pragma unroll
                        for (int n = 0; n < 2; ++n) {
                            const f32x4 a = acc[ai][bj][m][n]; f32x4 e, en;
#pragma unroll
                            for (int j = 0; j < 4; ++j) { const float ee = __expf(cb[mm][bj][n][j]); e[j] = a[j] * s * ee; en[j] = a[j] * s * __builtin_amdgcn_rcpf(ee); }
                            const u32x2 a1 = pk4(e), a2 = pk4(en);
                            if (n == 0) { we.x = a1.x; we.y = a1.y; wn.x = a2.x; wn.y = a2.y; } else { we.z = a1.x; we.w = a1.y; wn.z = a2.x; wn.w = a2.y; }
                        }
                        const size_t io = frag_img_off<128>(row, (pn & 1) * 2 + bj, wc * 32 + fq * 8);
                        *(u32x4*)((char*)De + io) = we; *(u32x4*)((char*)Dn + io) = wn;
                    }
                }
                asm volatile("" ::: "memory");
            }
        } else {
#pragma unroll
            for (int ai = 0; ai < 2; ++ai)
#pragma unroll
                for (int m = 0; m < 4; ++m) {
                    const int row = u.pm * 256 + ai * 128 + wr * 64 + m * 16 + fr;
#pragma unroll
                    for (int bj = 0; bj < 2; ++bj) { const u32x2 a0 = pk4(acc[ai][bj][m][0]), a1 = pk4(acc[ai][bj][m][1]);
                        *(u32x4*)((char*)V + v_img_off<256>(row, (pn - 4) * 256 + bj * 128 + wc * 32 + fq * 8)) = (u32x4){a0.x, a0.y, a1.x, a1.y}; }
                }
        }
    }
};
struct EpiNone {
    static constexpr bool PERM = false; float* sink;
    __device__ __forceinline__ void operator()(const f32x4 (&acc)[2][2][4][2], const pg8::Unit& u, int wr, int wc, int fr, int fq) const {
        f32x4 t = acc[0][0][0][0];
#pragma unroll
        for (int ai = 0; ai < 2; ++ai)
#pragma unroll
            for (int bj = 0; bj < 2; ++bj)
#pragma unroll
                for (int m = 0; m < 4; ++m)
#pragma unroll
                    for (int n = 0; n < 2; ++n) t += acc[ai][bj][m][n];
        if (t[0] + t[1] + t[2] + t[3] == 12345.678f) sink[0] = t[0];
    }
};
struct EpiOut {
    static constexpr bool PERM = false;
    const float* xold; float* xnew; const float* gate;
    __device__ __forceinline__ void operator()(const f32x4 (&acc)[2][2][4][2], const pg8::Unit& u, int wr, int wc, int fr, int fq) const {
        const int b = (u.pm * 256) >> 12;
        f32x4 gv[2][2];
#pragma unroll
        for (int bj = 0; bj < 2; ++bj)
#pragma unroll
            for (int n = 0; n < 2; ++n) gv[bj][n] = *(const f32x4*)(gate + (size_t)b * 3072 + u.pn * 256 + bj * 128 + wc * 32 + n * 16 + fq * 4);
#pragma unroll
        for (int ai = 0; ai < 2; ++ai)
#pragma unroll
            for (int mh = 0; mh < 2; ++mh) {
                f32x4 xo[2][2][2];
#pragma unroll
                for (int mm = 0; mm < 2; ++mm)
#pragma unroll
                    for (int bj = 0; bj < 2; ++bj)
#pragma unroll
                        for (int n = 0; n < 2; ++n) xo[mm][bj][n] = *(const f32x4*)(xold + (size_t)(u.pm * 256 + ai * 128 + wr * 64 + (2 * mh + mm) * 16 + fr) * 1024 + u.pn * 256 + bj * 128 + wc * 32 + n * 16 + fq * 4);
                asm volatile("" ::: "memory");
#pragma unroll
                for (int mm = 0; mm < 2; ++mm)
#pragma unroll
                    for (int bj = 0; bj < 2; ++bj)
#pragma unroll
                        for (int n = 0; n < 2; ++n)
                            *(f32x4*)(xnew + (size_t)(u.pm * 256 + ai * 128 + wr * 64 + (2 * mh + mm) * 16 + fr) * 1024 + u.pn * 256 + bj * 128 + wc * 32 + n * 16 + fq * 4) = xo[mm][bj][n] + gv[bj][n] * acc[ai][bj][2 * mh + mm][n];
                asm volatile("" ::: "memory");
            }
    }
};

__device__ __forceinline__ void transpose_item(const float* W, int ldw, int K, int nblk, bf16_t* WT, LAS float* scr, int item, int lane) {
    const int kb = item / nblk, nb = item % nblk, k0 = 64 * kb, n0 = 32 * nb;
#pragma unroll 8
    for (int i = 0; i < 32; ++i) { const int kk = 2 * i + (lane >> 5); scr[kk * 33 + (lane & 31)] = W[(size_t)(k0 + kk) * ldw + n0 + (lane & 31)]; }
    LDS_WAIT(); asm volatile("" ::: "memory");
    const int c = lane & 7;
#pragma unroll
    for (int j = 0; j < 4; ++j) { const int n = (lane >> 3) + 8 * j; const LAS float* s = scr + (8 * c) * 33 + n;
        u32x4 o; o.x = pk2(s[0 * 33], s[1 * 33]); o.y = pk2(s[2 * 33], s[3 * 33]); o.z = pk2(s[4 * 33], s[5 * 33]); o.w = pk2(s[6 * 33], s[7 * 33]);
        *(u32x4*)(WT + (size_t)(n0 + n) * K + k0 + 8 * c) = o; }
    LDS_WAIT(); asm volatile("" ::: "memory");
}
__device__ __forceinline__ void conv_weights(const float* w_in, int ld_in, int n_in, const float* w_out, int k_out, unsigned char* wdst, LAS unsigned char* lds, int tid, int bid, int G) {
    const int lane = tid & 63, wave = tid >> 6;
    LAS float* scr = (LAS float*)(lds + wave * 16384);
    const int gw = bid * 8 + wave, NGW = G * 8;
    const int I_in = (1024 / 64) * (n_in / 32), I_out = (k_out / 64) * (1024 / 32);
    bf16_t* WinT = (bf16_t*)wdst; bf16_t* WoutT = (bf16_t*)(wdst + 12 * MiB);
    for (int it = gw; it < I_in + I_out; it += NGW) {
        if (it < I_in) transpose_item(w_in, ld_in, 1024, n_in / 32, WinT, scr, it, lane);
        else transpose_item(w_out, 1024, k_out, 32, WoutT, scr, it - I_in, lane);
    }
}
__device__ __forceinline__ void p0_mod(const Params& P, LAS unsigned char* lds, int tid, int bid, int G) {
    LAS float* sc = (LAS float*)lds;
    LAS float* red = sc + 4096;
    const int lane = tid & 63, wave = tid >> 6;
    float* MOD = (float*)(P.ws + WS_MOD);
    for (int i = tid; i < 4096; i += 512) sc[i] = silu_f(P.c[i]);
    __syncthreads();
    for (int it = bid; it < 192; it += G) {
        const int l = it / 48, cb = it % 48, n = cb * 64 + lane;
        const float* W = P.mod_w + (size_t)l * 1024 * 3072 + n;
        float a0 = 0.f, a1 = 0.f, a2 = 0.f, a3 = 0.f;
        const int k0 = wave * 128;
#pragma unroll 8
        for (int k = k0; k < k0 + 128; ++k) { const float w = W[(size_t)k * 3072]; a0 += sc[k] * w; a1 += sc[1024 + k] * w; a2 += sc[2048 + k] * w; a3 += sc[3072 + k] * w; }
        red[(wave * 4 + 0) * 64 + lane] = a0; red[(wave * 4 + 1) * 64 + lane] = a1; red[(wave * 4 + 2) * 64 + lane] = a2; red[(wave * 4 + 3) * 64 + lane] = a3;
        __syncthreads();
        if (wave < 4) { float s = 0.f;
#pragma unroll
            for (int w = 0; w < 8; ++w) s += red[(w * 4 + wave) * 64 + lane];
            MOD[(size_t)(l * 4 + wave) * 3072 + n] = s + P.mod_b[l * 3072 + n]; }
        __syncthreads();
    }
}
__device__ __forceinline__ void p0_rope(const Params& P, int tid, int bid, int G) {
    unsigned* rope = (unsigned*)(P.ws + WS_ROPE);
    const int gt = bid * 512 + tid, NT = G * 512;
    for (int idx = gt; idx < MT * 128; idx += NT) {
        const int row = idx >> 7, d = idx & 127;
        const float inv = powf(10000.0f, -(float)d * (1.0f / 128.0f));
        const float ang = (float)P.pos[row] * inv;
        double t = (double)ang * 0.15915494309189535; t -= rint(t);
        const float fr = (float)t;
        const float co = __builtin_amdgcn_cosf(fr), si = __builtin_amdgcn_sinf(fr);
        const unsigned lo = __builtin_bit_cast(unsigned short, (_Float16)co), hi = __builtin_bit_cast(unsigned short, (_Float16)si);
        rope[idx] = lo | (hi << 16);
    }
}

template <int KIND>
__device__ __forceinline__ void h_phase(const Params& P, int layer, const float* xin, LAS unsigned char* lds, int tid, int bid, int G) {
    const int lane = tid & 63, wave = tid >> 6;
    LAS float* WxT = (LAS float*)lds;
    LAS float* W2 = (LAS float*)(lds + 65536);
    LAS float* TOT = (LAS float*)(lds + 98304);
    const float* MOD = (const float*)(P.ws + WS_MOD);
    bf16_t* XN = (bf16_t*)(P.ws + WS_XN);
    if (KIND > 0) {
        const float* wsrc = (KIND == 1) ? (P.fox_w_in + 4096) : (P.gla_w_in + 3072); const int ldw = (KIND == 1) ? FOX_IN : GLA_IN;
        {
            float wv[32];
#pragma unroll
            for (int it = 0; it < 32; ++it) { const int idx = tid + 512 * it; wv[it] = wsrc[(size_t)(idx >> 4) * ldw + (idx & 15)]; }
#pragma unroll
            for (int it = 0; it < 32; ++it) { const int idx = tid + 512 * it; WxT[(idx & 15) * 1024 + (idx >> 4)] = wv[it]; }
        }
        if (KIND == 2) {
            float w2v[16];
#pragma unroll
            for (int it = 0; it < 16; ++it) w2v[it] = P.gla_w_gate2[tid + 512 * it];
#pragma unroll
            for (int it = 0; it < 16; ++it) W2[tid + 512 * it] = w2v[it];
        }
        __syncthreads();
    }
    for (int ci = bid; ci < MT / 64; ci += G) {
        const int b = ci >> 6;
        if (KIND != 1) ((float*)(P.ws + WS_S16))[ci * 512 + tid] = 0.f;
        const float* mod = MOD + (size_t)(layer * 4 + b) * 3072;
        f32x4 ga[4], sh[4];
#pragma unroll
        for (int j = 0; j < 4; ++j) { const int col = 4 * lane + 256 * j;
            const f32x4 g4 = *(const f32x4*)(P.norm_g + layer * 1024 + col), s4 = *(const f32x4*)(mod + 1024 + col);
            ga[j] = g4 * (s4 + 1.0f); sh[j] = *(const f32x4*)(mod + col); }
        float run[8]; f32x4 cbv[8][2];
        if (KIND == 2) {
#pragma unroll
            for (int c = 0; c < 8; ++c) run[c] = 0.f;
        }
        if constexpr (false) {
        constexpr int BS = (KIND == 2) ? 2 : 4;
#pragma unroll (KIND == 2 ? 8 / BS : 1)
        for (int rb = 0; rb < 8; rb += BS) {
            asm volatile("" ::: "memory");
            f32x4 xv[BS][4];
#pragma unroll
            for (int bb = 0; bb < BS; ++bb) { const f32x4* xr = (const f32x4*)(xin + (size_t)(ci * 64 + wave * 8 + rb + bb) * 1024) + lane;
#pragma unroll
                for (int j = 0; j < 4; ++j) xv[bb][j] = xr[64 * j]; }
#pragma unroll
        for (int bb = 0; bb < BS; ++bb) {
            const int rr = rb + bb;
            asm volatile("" ::: "memory");
            const int row = ci * 64 + wave * 8 + rr;
            f32x4 v[4]; float ss = 0.f;
#pragma unroll
            for (int j = 0; j < 4; ++j) { v[j] = xv[bb][j]; ss += (v[j][0] * v[j][0] + v[j][1] * v[j][1]) + (v[j][2] * v[j][2] + v[j][3] * v[j][3]); }
            const float rstd = rsqrtf(wave_sum(ss) * (1.0f / 1024.0f) + EPS);
#pragma unroll
            for (int j = 0; j < 4; ++j) { v[j] = (v[j] * rstd) * ga[j] + sh[j]; *(u32x2*)(XN + (size_t)row * 1024 + 4 * lane + 256 * j) = pk4(v[j]); }
            if (KIND > 0) {
                float r[16];
#pragma unroll
                for (int i = 0; i < 16; ++i) { float a = 0.f;
#pragma unroll
                    for (int j = 0; j < 4; ++j) { const f32x4 w = *(const LAS f32x4*)(WxT + i * 1024 + 4 * lane + 256 * j); a += (v[j][0] * w[0] + v[j][1] * w[1]) + (v[j][2] * w[2] + v[j][3] * w[3]); }
                    r[i] = a; }
                if (KIND == 1) {
                    const float e1 = reduce_scatter16(r, lane);
                    const int idx = ((lane >> 5) & 1) * 8 + ((lane >> 4) & 1) * 4 + ((lane >> 3) & 1) * 2 + ((lane >> 2) & 1);
                    if ((lane & 3) == 0) ((float*)(P.ws + WS_S16))[(size_t)row * 16 + idx] = logsig_f(e1 + P.fox_b_f[idx]);
                } else {
                    f32x4 z0 = *(const f32x4*)(P.gla_b_gate + 8 * lane), z1 = *(const f32x4*)(P.gla_b_gate + 8 * lane + 4);
#pragma unroll
                    for (int i = 0; i < 16; ++i) { const f32x4 w0 = *(const LAS f32x4*)(W2 + i * 512 + 8 * lane), w1 = *(const LAS f32x4*)(W2 + i * 512 + 8 * lane + 4); z0 += w0 * r[i]; z1 += w1 * r[i]; }
#pragma unroll
                    for (int c = 0; c < 4; ++c) { run[c] += logsig_f(z0[c]) * 0.0625f; run[4 + c] += logsig_f(z1[c]) * 0.0625f; }
                    cbv[rr][0] = (f32x4){run[0], run[1], run[2], run[3]}; cbv[rr][1] = (f32x4){run[4], run[5], run[6], run[7]};
                }
            }
        }
        }
        } else {
        constexpr int BS = (KIND == 2) ? 2 : 4;
#pragma unroll (KIND != 0 ? 8 / BS : 1)
        for (int rb = 0; rb < 8; rb += BS) {
            asm volatile("" ::: "memory");
            f32x4 v[BS][4];
#pragma unroll
            for (int bb = 0; bb < BS; ++bb) { const f32x4* xr = (const f32x4*)(xin + (size_t)(ci * 64 + wave * 8 + rb + bb) * 1024) + lane;
#pragma unroll
                for (int j = 0; j < 4; ++j) v[bb][j] = xr[64 * j]; }
#pragma unroll
            for (int bb = 0; bb < BS; ++bb) {
                const int row = ci * 64 + wave * 8 + rb + bb; float ss = 0.f;
#pragma unroll
                for (int j = 0; j < 4; ++j) ss += (v[bb][j][0] * v[bb][j][0] + v[bb][j][1] * v[bb][j][1]) + (v[bb][j][2] * v[bb][j][2] + v[bb][j][3] * v[bb][j][3]);
                const float rstd = rsqrtf(wave_sum(ss) * (1.0f / 1024.0f) + EPS);
#pragma unroll
                for (int j = 0; j < 4; ++j) { v[bb][j] = (v[bb][j] * rstd) * ga[j] + sh[j]; *(u32x2*)(XN + (size_t)row * 1024 + 4 * lane + 256 * j) = pk4(v[bb][j]); }
            }
            if (KIND > 0) {
                float acc[BS][16];
#pragma unroll
                for (int i = 0; i < 16; ++i) {
                    f32x4 w[4];
#pragma unroll
                    for (int j = 0; j < 4; ++j) w[j] = *(const LAS f32x4*)(WxT + i * 1024 + 4 * lane + 256 * j);
#pragma unroll
                    for (int bb = 0; bb < BS; ++bb) { float a = 0.f;
#pragma unroll
                        for (int j = 0; j < 4; ++j) a += (v[bb][j][0] * w[j][0] + v[bb][j][1] * w[j][1]) + (v[bb][j][2] * w[j][2] + v[bb][j][3] * w[j][3]);
                        acc[bb][i] = a; }
                    if (i & 1) { __builtin_amdgcn_sched_barrier(0); asm volatile("" ::: "memory"); }
                }
#pragma unroll
                for (int bb = 0; bb < BS; ++bb) {
                    const int rr = rb + bb, row = ci * 64 + wave * 8 + rr;
                    asm volatile("" ::: "memory");
                    const float e1 = reduce_scatter16(acc[bb], lane);
                    if (KIND == 1) {
                        const int idx = ((lane >> 5) & 1) * 8 + ((lane >> 4) & 1) * 4 + ((lane >> 3) & 1) * 2 + ((lane >> 2) & 1);
                        ((float*)(P.ws + WS_S16))[(size_t)row * 16 + idx] = logsig_f(e1 + P.fox_b_f[idx]);
                    } else {
                        float r[16];
#pragma unroll
                        for (int i = 0; i < 16; ++i) r[i] = __builtin_bit_cast(float, __builtin_amdgcn_readlane(__builtin_bit_cast(int, e1), ((i >> 3) & 1) * 32 + ((i >> 2) & 1) * 16 + ((i >> 1) & 1) * 8 + (i & 1) * 4));
                        f32x4 z0 = *(const f32x4*)(P.gla_b_gate + 8 * lane), z1 = *(const f32x4*)(P.gla_b_gate + 8 * lane + 4);
#pragma unroll
                        for (int i = 0; i < 16; ++i) { const f32x4 w0 = *(const LAS f32x4*)(W2 + i * 512 + 8 * lane), w1 = *(const LAS f32x4*)(W2 + i * 512 + 8 * lane + 4); z0 += w0 * r[i]; z1 += w1 * r[i]; }
#pragma unroll
                        for (int c = 0; c < 4; ++c) { run[c] += logsig_f(z0[c]) * 0.0625f; run[4 + c] += logsig_f(z1[c]) * 0.0625f; }
                        cbv[rr][0] = (f32x4){run[0], run[1], run[2], run[3]}; cbv[rr][1] = (f32x4){run[4], run[5], run[6], run[7]};
                    }
                }
            }
        }
        }
        if (KIND == 2) {
            float* CB = (float*)(P.ws + WS_ACT + 160 * MiB);
            *(LAS f32x4*)(TOT + wave * 512 + 8 * lane) = (f32x4){run[0], run[1], run[2], run[3]};
            *(LAS f32x4*)(TOT + wave * 512 + 8 * lane + 4) = (f32x4){run[4], run[5], run[6], run[7]};
            __syncthreads();
            f32x4 o0 = (f32x4){0.f, 0.f, 0.f, 0.f}, o1 = o0;
            for (int w = 0; w < wave; ++w) { o0 += *(const LAS f32x4*)(TOT + w * 512 + 8 * lane); o1 += *(const LAS f32x4*)(TOT + w * 512 + 8 * lane + 4); }
#pragma unroll
            for (int rr = 0; rr < 8; ++rr) { const int row = ci * 64 + wave * 8 + rr;
                *(f32x4*)(CB + (size_t)row * 512 + 8 * lane) = cbv[rr][0] + o0; *(f32x4*)(CB + (size_t)row * 512 + 8 * lane + 4) = cbv[rr][1] + o1; }
            __syncthreads();
        }
    }
}

template <int KIND> struct LinCfg {
    static constexpr int DK = KIND == 0 ? 256 : 128, QP = KIND == 0 ? 1024 : 512, VP = KIND == 0 ? 2048 : 1024, HV = KIND == 0 ? 512 : 256;
    static constexpr int NSL = HV / 32, NITEM = 16 * NSL, NKF = DK / 32, RW = DK / 8, NDT = RW / 16, KPITCH = DK * 2 + 32, STP = DK + 8, KCH = DK / 64;
    static constexpr int LDS_ST = 0, LDS_P = 2 * 32 * STP * 2, LDS_V = LDS_P + 2 * 8192, LDS_END = LDS_V + 2 * 2 * 4096;
    static constexpr int NA = DK / 16;
};
__device__ __forceinline__ float ret_log2g(int h) { return (h == 0) ? -0.045803689613124796f : (h == 1) ? -0.02272007650008353f : (h == 2) ? -0.011315313227834146f : -0.005646563141142062f; }

template <int KIND>
__device__ __forceinline__ void lin_pphase(const bf16_t* Qa, bf16_t* Ka, const bf16_t* Qb, const bf16_t* Kb2, bf16_t* Pimg, int tid, int bid, int G) {
    typedef LinCfg<KIND> C;
    const int lane = tid & 63, wave = __builtin_amdgcn_readfirstlane(tid >> 6);
    const int g4 = lane >> 4, i16 = lane & 15;
    bf16x8 idf[2];
#pragma unroll
    for (int sel = 0; sel < 2; ++sel)
#pragma unroll
        for (int j = 0; j < 8; ++j) idf[sel][j] = (short)((8 * g4 + j == i16 + 16 * sel) ? 0x3F80 : 0);
    for (int hw0 = bid * 8; hw0 < 2048; hw0 += G * 8) {
        const int hw = hw0 + wave;
        const int item = hw >> 1, half = hw & 1;
        const int bh = item >> 6, n = item & 63, b = bh >> 2, h = bh & 3;
        const size_t t0 = (size_t)b * SEQ + (size_t)n * 64;
        f32x4 pa[2][4], pb[2][4];
#pragma unroll
        for (int r = 0; r < 2; ++r)
#pragma unroll
            for (int c = 0; c < 4; ++c) { pa[r][c] = (f32x4){0.f, 0.f, 0.f, 0.f}; pb[r][c] = (f32x4){0.f, 0.f, 0.f, 0.f}; }
        constexpr size_t BLK = (size_t)64 * C::DK * 2;
        const char* qa = (const char*)Qa + (size_t)item * BLK + lane * 16; char* ka = (char*)Ka + (size_t)item * BLK + lane * 16;
        const char* qb = (const char*)Qb + (size_t)item * BLK + lane * 16; const char* kb = (const char*)Kb2 + (size_t)item * BLK + lane * 16;
        bf16x8 kall[C::NKF][4];
#pragma unroll
        for (int k = 0; k < C::NKF; ++k)
#pragma unroll
            for (int c = 0; c < 4; ++c) kall[k][c] = *(const bf16x8*)(ka + (k * 4 + c) * 1024);
#pragma unroll
        for (int k = 0; k < C::NKF; ++k) {
            bf16x8 af[2];
#pragma unroll
            for (int r = 0; r < 2; ++r) af[r] = *(const bf16x8*)(qa + (k * 4 + 2 * half + r) * 1024);
#pragma unroll
            for (int r = 0; r < 2; ++r)
#pragma unroll
                for (int c = 0; c < 4; ++c) pa[r][c] = mma_rc(pa[r][c], af[r], kall[k][c]);
            if (KIND == 1) {
                bf16x8 bfr[4];
#pragma unroll
                for (int r = 0; r < 2; ++r) af[r] = *(const bf16x8*)(qb + (k * 4 + 2 * half + r) * 1024);
#pragma unroll
                for (int c = 0; c < 4; ++c) bfr[c] = *(const bf16x8*)(kb + (k * 4 + c) * 1024);
#pragma unroll
                for (int r = 0; r < 2; ++r)
#pragma unroll
                    for (int c = 0; c < 4; ++c) pb[r][c] = mma_rc(pb[r][c], af[r], bfr[c]);
            }
        }
        const float l2g = (KIND == 0) ? ret_log2g(h) : 0.f;
#pragma unroll
        for (int r = 0; r < 2; ++r) {
            const int c = 32 * half + 16 * r + (lane & 15);
#pragma unroll
            for (int ct = 0; ct < 4; ++ct) {
                f32x4 p;
#pragma unroll
                for (int e = 0; e < 4; ++e) { const int mm = 16 * ct + 4 * g4 + e;
                    if (KIND == 0) { const int dd = c > mm ? c - mm : mm - c; p[e] = pa[r][ct][e] * exp2f(l2g * (float)dd); }
                    else p[e] = (c >= mm) ? pa[r][ct][e] : pb[r][ct][e]; }
                const int ks = ct >> 1, gg = 2 * (ct & 1) + (g4 & 1);
                const int off = c * 128 + (((4 * ks + gg) ^ (c & 7)) << 4) + 8 * (g4 >> 1);
                *(u32x2*)((char*)Pimg + (size_t)item * 8192 + off) = pk4(p);
            }
        }
        __syncthreads();
        {
            char* kdst = ka - lane * 16 + (16 * (g4 & 1) + i16) * 16 + 8 * (g4 >> 1);
#define PP_TR(HALF) _Pragma("unroll") for (int k = 0; k < C::NKF; ++k) _Pragma("unroll") for (int sel = 0; sel < 2; ++sel) _Pragma("unroll") for (int T = 0; T < 2; ++T) { \
                const f32x4 tr_ = mma_rc((f32x4){0.f, 0.f, 0.f, 0.f}, idf[sel], kall[k][2 * (HALF) + T]); \
                *(u32x2*)(kdst + ((HALF) * C::NA + 2 * k + sel) * 1024 + T * 512) = pk4(tr_); }
            if (half == 0) { PP_TR(0) } else { PP_TR(1) }
#undef PP_TR
        }
    }
}

typedef short v4i16_t __attribute__((ext_vector_type(4)));
__device__ __forceinline__ bf16x8 trfrag2(const LAS char* p0, int second_off) {
    const v4i16_t a = __builtin_amdgcn_ds_read_tr16_b64_v4i16((LAS v4i16_t*)p0);
    const v4i16_t b = __builtin_amdgcn_ds_read_tr16_b64_v4i16((LAS v4i16_t*)(p0 + second_off));
    return (bf16x8){a[0], a[1], a[2], a[3], b[0], b[1], b[2], b[3]};
}

template <int KIND> struct LsStage { u32x4 x[LinCfg<KIND>::NKF]; u32x4 p; u32x2 v; f32x4 dec[2]; };

template <int KIND, int VAR = 0>
__device__ __forceinline__ void lin_scan(const bf16_t* Qg, const bf16_t* Kg, const bf16_t* Vg, const bf16_t* Pimg, const float* CB, bf16_t* O, float* DUMMY, LAS unsigned char* lds, int tid, int bid, int G) {
    typedef LinCfg<KIND> C;
    const int nit = (G == 256) ? 1 : (C::NITEM + G - 1) / G;
    const int tid0 = tid;
    for (int it = 0; it < nit; ++it) {
        int tid = tid0; asm volatile("" : "+v"(tid));
        const int lane = tid & 63, wave = __builtin_amdgcn_readfirstlane(tid >> 6);
        const int g4 = lane >> 4, i16 = lane & 15, q4 = i16 >> 2, p4 = i16 & 3;
        int item;
        if (G == 256) { const int x = bid & 7, j = bid >> 3; if (KIND == 0) item = x * 32 + j; else { if (j >= 16) break; item = x * 16 + j; } }
        else { item = it * G + bid; if (item >= C::NITEM) break; }
        const int bh = item / C::NSL, dvs = item % C::NSL, b = bh >> 2, h = bh & 3;
        const size_t t0 = (size_t)b * SEQ;
        const int rt = wave & 3; const bool rdw = wave < 4;
        constexpr int RWU = C::DK / 4, NDU = RWU / 16;
        const float l2g = (KIND == 0) ? ret_log2g(h) : 0.f;
        const float qsc = (KIND == 0) ? exp2f(l2g * (float)(16 * rt + i16 + 1)) : 1.0f;
        const float sdec = (KIND == 0) ? exp2f(l2g * 64.0f) : 1.0f;
        const int vm = tid >> 3, vp8 = tid & 7;
        const float vsc = (KIND == 0) ? exp2f(l2g * (float)(63 - vm)) : 1.0f;
        constexpr size_t BLK = (size_t)64 * C::DK * 2;
        const char* xsb = (const char*)(rdw ? Qg : Kg) + (size_t)bh * 64 * BLK + (rdw ? rt * 1024 : NDU * rt * 1024);
        const unsigned xvo = (unsigned)(lane * 16);
        const char* vsb = (const char*)Vg + (size_t)(bh * C::NSL + dvs) * (4096 * 64);
        char* osb = (char*)O + (t0 * C::VP + h * C::HV + 32 * dvs) * 2;
        const unsigned vvo = (unsigned)((vm * C::VP + 4 * vp8) * 2);
        const unsigned vio = (unsigned)(tid * 8);
        char* dmb = (char*)DUMMY + (size_t)bid * 4096; const unsigned dmo = (unsigned)(tid * 8);
        const char* psb = (const char*)Pimg + (size_t)bh * 64 * 8192; const unsigned pvo = (unsigned)(tid * 16);
        const char* dcb = (KIND == 1) ? (const char*)CB + ((t0 + 63) * 512 + h * 128 + RWU * rt) * 4 : nullptr; const unsigned dco = (unsigned)(g4 * 16);
        LAS bf16_t* ST = (LAS bf16_t*)(lds + C::LDS_ST);
        LAS char* PI = (LAS char*)(lds + C::LDS_P);
        LAS char* VI = (LAS char*)(lds + C::LDS_V);
        LAS char* OT = (LAS char*)(lds + C::LDS_END);
        const int trow = 16 * (g4 >> 1) + 4 * (g4 & 1) + q4;
        const int voff = trow * 32 + 8 * p4;
        const int poff_row = (16 * rt + i16) * 128, psw = (16 * rt + i16) & 7;

        LsStage<KIND> A, B;
#define LS_LOAD_PV(S, nn) do { const int n_ = (nn) < 64 ? (nn) : 63; \
            unsigned po_ = pvo, vo_ = vio, do_ = dco; asm volatile("" : "+v"(po_), "+v"(vo_), "+v"(do_)); \
            if (!((VAR & 2) && (nn) >= 2)) { S.p = *(const u32x4*)(psb + (size_t)n_ * 8192 + po_); \
            S.v = *(const u32x2*)(vsb + (size_t)n_ * 4096 + vo_); } \
            if (KIND == 1) { _Pragma("unroll") for (int a_ = 0; a_ < NDU; ++a_) S.dec[a_] = *(const f32x4*)(dcb + (size_t)n_ * (64 * 512 * 4) + 64 * a_ + do_); } } while (0)
#define LS_LOAD_X(S, nn) do { const int n_ = (nn) < 64 ? (nn) : 63; \
            if (!((VAR & 1) && (nn) >= 2)) { const char* xs_ = xsb + (size_t)n_ * BLK; unsigned xo_ = xvo; asm volatile("" : "+v"(xo_));        \
                _Pragma("unroll") for (int k_ = 0; k_ < C::NKF; ++k_) S.x[k_] = *(const u32x4*)(xs_ + (size_t)(rdw ? k_ * 4096 : ((k_ / NDU) * C::NA + (k_ % NDU)) * 1024) + xo_); } } while (0)
#define LS_LOAD(S, nn) do { LS_LOAD_PV(S, nn); LS_LOAD_X(S, nn); } while (0)
#define LS_WRITE(S, img) do { \
            *(LAS u32x4*)(PI + (img) * 8192 + tid * 16) = S.p; \
            { LAS char* vd_ = VI + (img) * 8192 + (vp8 >> 2) * 2048 + vm * 32 + (vp8 & 3) * 8; *(LAS u32x2*)vd_ = S.v; \
              if (KIND == 0) { u32x2 w_; w_.x = pk2(bf2f(S.v.x & 0xffffu) * vsc, bf2f(S.v.x >> 16) * vsc); w_.y = pk2(bf2f(S.v.y & 0xffffu) * vsc, bf2f(S.v.y >> 16) * vsc); *(LAS u32x2*)(vd_ + 4096) = w_; } } } while (0)

        for (int i = tid; i < 32 * C::STP / 2; i += 512) ((LAS unsigned*)ST)[i] = 0u;
        f32x4 s[NDU][2];
#pragma unroll
        for (int a = 0; a < NDU; ++a)
#pragma unroll
            for (int e = 0; e < 2; ++e) s[a][e] = (f32x4){0.f, 0.f, 0.f, 0.f};
        LS_LOAD(A, 0); LS_LOAD(B, 1);
        LS_WRITE(A, 0);
        __syncthreads();

#define LS_SB(k) s[1 + (k) / 2][(k) % 2]
#define LS_STEP(n, SC, SN) do { const int img_ = (n) & 1; \
            f32x4 dcur_[2]; if (KIND == 1) { _Pragma("unroll") for (int a_ = 0; a_ < NDU; ++a_) dcur_[a_] = SC.dec[a_]; } \
              \
            LS_LOAD_PV(SC, (n) + 2); \
            if (rdw) { \
                  \
                if (!(VAR & 16)) { \
                const LAS bf16_t* STc_ = ST + img_ * 32 * C::STP; \
                  \
                  \
                _Pragma("unroll") for (int ct_ = 0; ct_ < 2; ++ct_) { \
                    constexpr int HB_ = C::NKF / 2; bf16x8 pf_[2], vf_[2]; \
                    s[0][0] = (f32x4){0.f, 0.f, 0.f, 0.f}; s[0][1] = s[0][0]; \
                    _Pragma("unroll") for (int k_ = 0; k_ < HB_; ++k_) LS_SB(k_) = __builtin_bit_cast(f32x4, lfrag(STc_ + 16 * ct_ * C::STP + 32 * k_, C::STP, lane)); \
                    __builtin_amdgcn_sched_barrier(0); \
                    _Pragma("unroll") for (int k_ = 0; k_ < HB_; k_ += 2) { s[0][0] = mma_rc(s[0][0], __builtin_bit_cast(bf16x8, SC.x[k_]), __builtin_bit_cast(bf16x8, LS_SB(k_))); s[0][1] = mma_rc(s[0][1], __builtin_bit_cast(bf16x8, SC.x[k_ + 1]), __builtin_bit_cast(bf16x8, LS_SB(k_ + 1))); } \
                    __builtin_amdgcn_sched_barrier(0); \
                    _Pragma("unroll") for (int k_ = 0; k_ < HB_; ++k_) LS_SB(k_) = __builtin_bit_cast(f32x4, lfrag(STc_ + 16 * ct_ * C::STP + 32 * (HB_ + k_), C::STP, lane)); \
                    _Pragma("unroll") for (int ks_ = 0; ks_ < 2; ++ks_) { \
                        pf_[ks_] = *(const LAS bf16x8*)(PI + img_ * 8192 + poff_row + (((4 * ks_ + g4) ^ psw) << 4)); \
                        vf_[ks_] = trfrag2(VI + img_ * 8192 + ct_ * 2048 + ks_ * 1024 + voff, 256); } \
                    __builtin_amdgcn_sched_barrier(0); \
                    _Pragma("unroll") for (int k_ = 0; k_ < HB_; k_ += 2) { s[0][0] = mma_rc(s[0][0], __builtin_bit_cast(bf16x8, SC.x[HB_ + k_]), __builtin_bit_cast(bf16x8, LS_SB(k_))); s[0][1] = mma_rc(s[0][1], __builtin_bit_cast(bf16x8, SC.x[HB_ + k_ + 1]), __builtin_bit_cast(bf16x8, LS_SB(k_ + 1))); } \
                    f32x4 oa_ = (s[0][0] + s[0][1]) * qsc; \
                    _Pragma("unroll") for (int ks_ = 0; ks_ < 2; ++ks_) oa_ = mma_rc(oa_, pf_[ks_], vf_[ks_]); \
                    *(LAS u32x2*)(OT + img_ * 4608 + (16 * rt + i16) * 72 + (16 * ct_ + 4 * g4) * 2) = pk4(oa_); \
                    __builtin_amdgcn_sched_barrier(0); } } \
                  \
                LS_LOAD_X(SC, (n) + 2); \
            } else { \
                  \
                if (KIND == 0) { _Pragma("unroll") for (int a_ = 0; a_ < NDU; ++a_) _Pragma("unroll") for (int e_ = 0; e_ < 2; ++e_) s[a_][e_] = s[a_][e_] * sdec; } \
                if (!(VAR & 4)) { bf16x8 vf_[2][2]; \
                    _Pragma("unroll") for (int ks_ = 0; ks_ < 2; ++ks_) _Pragma("unroll") for (int e_ = 0; e_ < 2; ++e_) vf_[ks_][e_] = trfrag2(VI + img_ * 8192 + (KIND == 0 ? 4096 : 0) + e_ * 2048 + ks_ * 1024 + voff, 256); \
                    _Pragma("unroll") for (int ks_ = 0; ks_ < 2; ++ks_) _Pragma("unroll") for (int a_ = 0; a_ < NDU; ++a_) _Pragma("unroll") for (int e_ = 0; e_ < 2; ++e_) \
                        s[a_][e_] = mma_cr(s[a_][e_], __builtin_bit_cast(bf16x8, SC.x[ks_ * NDU + a_]), vf_[ks_][e_]); } \
                  \
                LS_LOAD_X(SC, (n) + 2); \
                if (KIND == 1) { _Pragma("unroll") for (int a_ = 0; a_ < NDU; ++a_) { f32x4 dc_; _Pragma("unroll") for (int r_ = 0; r_ < 4; ++r_) dc_[r_] = __expf(dcur_[a_][r_]); \
                    _Pragma("unroll") for (int e_ = 0; e_ < 2; ++e_) s[a_][e_] = s[a_][e_] * dc_; } } \
                  \
                { LAS bf16_t* STn_ = ST + (img_ ^ 1) * 32 * C::STP; \
                  _Pragma("unroll") for (int a_ = 0; a_ < NDU; ++a_) _Pragma("unroll") for (int e_ = 0; e_ < 2; ++e_) \
                      *(LAS u32x2*)(STn_ + (16 * e_ + i16) * C::STP + RWU * rt + 16 * a_ + 4 * g4) = pk4(s[a_][e_]); } \
            } \
              \
            { const u32x2 ov_ = *(const LAS u32x2*)(OT + (img_ ^ 1) * 4608 + vm * 72 + vp8 * 8); \
              char* ob_ = (n) > 0 ? osb + (size_t)((n) - 1) * (64 * C::VP * 2) : dmb; unsigned oo_ = (n) > 0 ? vvo : dmo; asm volatile("" : "+v"(oo_)); \
              if (!((VAR & 8) && (n) >= 2)) *(u32x2*)(ob_ + oo_) = ov_; } \
              \
            LS_WRITE(SN, img_ ^ 1); \
            asm volatile("s_waitcnt lgkmcnt(0)" ::: "memory"); __builtin_amdgcn_s_barrier(); asm volatile("" ::: "memory"); } while (0)

#pragma nounroll
        for (int n = 0; n < 64; n += 2) { LS_STEP(n, A, B); LS_STEP(n + 1, B, A); }
        *(u32x2*)(osb + (size_t)63 * (64 * C::VP * 2) + vvo) = *(const LAS u32x2*)(OT + 4608 + vm * 72 + vp8 * 8);
        __syncthreads();
#undef LS_LOAD
#undef LS_LOAD_PV
#undef LS_LOAD_X
#undef LS_WRITE
#undef LS_STEP
#undef LS_SB
    }
}


template <int KIND>
__device__ __forceinline__ void lin_stats(const bf16_t* O, float* STATS, int tid, int bid, int G) {
    const int lane = tid & 63, wave = tid >> 6;
    const int gw = bid * 8 + wave, NGW = G * 8;
    constexpr int NJ = KIND == 0 ? 4 : 2, PITCH = KIND == 0 ? 2048 : 1024, RB = 4;
    for (int row0 = gw; row0 < MT; row0 += RB * NGW) {
        u32x4 w[RB][NJ];
#pragma unroll
        for (int rb = 0; rb < RB; ++rb) { const int row = row0 + rb * NGW < MT ? row0 + rb * NGW : row0;
#pragma unroll
            for (int j = 0; j < NJ; ++j) w[rb][j] = *(const u32x4*)(O + (size_t)row * PITCH + 512 * j + 8 * lane); }
#pragma unroll
        for (int rb = 0; rb < RB; ++rb) { const int row = row0 + rb * NGW; if (row >= MT) break;
#pragma unroll
            for (int j = 0; j < NJ; ++j) {
                float sm = 0.f, sq = 0.f;
#pragma unroll
                for (int i = 0; i < 4; ++i) { const float a = bf2f(w[rb][j][i] & 0xffffu), b = bf2f(w[rb][j][i] >> 16); sm += a + b; sq += a * a + b * b; }
                if (KIND == 0) { sm = wave_sum(sm); sq = wave_sum(sq); if (lane == 0) *(f32x2*)(STATS + (size_t)row * 8 + 2 * j) = (f32x2){sm, sq}; }
                else {
#pragma unroll
                    for (int o = 1; o < 32; o <<= 1) sq += __shfl_xor(sq, o);
                    if ((lane & 31) == 0) *(f32x2*)(STATS + (size_t)row * 8 + 2 * (2 * j + (lane >> 5))) = (f32x2){0.f, sq}; }
            }
        }
    }
}

template <int KIND> struct EpiGateNorm {
    static constexpr bool PERM = false;
    bf16_t* O; const float* STATS; LAS float* tbl;
    __device__ __forceinline__ void operator()(const f32x4 (&acc)[2][2][4][2], const pg8::Unit& u, int wr, int wc, int fr, int fq) const {
        constexpr int N = KIND == 0 ? 2048 : 1024; constexpr float INV = KIND == 0 ? 1.0f / 512.0f : 1.0f / 256.0f;
        const int head = KIND == 0 ? (u.pn >> 1) : u.pn;
        if (KIND == 0) {
            if ((u.pn & 1) == 0) {
                LAS f32x2* tb2 = (LAS f32x2*)tbl;
#pragma unroll
                for (int ai = 0; ai < 2; ++ai)
#pragma unroll
                    for (int m = 0; m < 4; ++m) { const int rl = ai * 128 + wr * 64 + m * 16 + fr; const int row = u.pm * 256 + rl; float sm = 0.f, sq = 0.f;
                        const bf16_t* prow = O + (size_t)row * N + u.pn * 256 + wc * 32 + fq * 4;
#pragma unroll
                        for (int tt = 0; tt < 2; ++tt) {
                            const u32x2 w0 = *(const u32x2*)(prow + tt * 256), w1 = *(const u32x2*)(prow + tt * 256 + 16), w2 = *(const u32x2*)(prow + tt * 256 + 128), w3 = *(const u32x2*)(prow + tt * 256 + 144);
                            const f32x4 o0 = unpk4(w0), o1 = unpk4(w1), o2 = unpk4(w2), o3 = unpk4(w3);
                            const f32x4 ss = (o0 + o1) + (o2 + o3), qq = (o0 * o0 + o1 * o1) + (o2 * o2 + o3 * o3);
                            sm += (ss[0] + ss[1]) + (ss[2] + ss[3]); sq += (qq[0] + qq[1]) + (qq[2] + qq[3]);
                            asm volatile("" ::: "memory"); }
                        sm = xsum_16_32(sm); sq = xsum_16_32(sq);
                        if (fq == 0) tb2[rl * 4 + wc] = (f32x2){sm, sq};
                        asm volatile("" ::: "memory"); }
                asm volatile("s_waitcnt lgkmcnt(0)" ::: "memory"); __builtin_amdgcn_s_barrier(); asm volatile("" ::: "memory");
            }
#pragma unroll
            for (int ai = 0; ai < 2; ++ai)
#pragma unroll
            for (int mh = 0; mh < 2; ++mh) {
                u32x2 ov[2][2][2];
#pragma unroll
                for (int mm = 0; mm < 2; ++mm) { const int row = u.pm * 256 + ai * 128 + wr * 64 + (2 * mh + mm) * 16 + fr;
#pragma unroll
                    for (int bj = 0; bj < 2; ++bj)
#pragma unroll
                        for (int n = 0; n < 2; ++n) ov[mm][bj][n] = *(const u32x2*)(O + (size_t)row * N + u.pn * 256 + bj * 128 + wc * 32 + n * 16 + fq * 4); }
                asm volatile("" ::: "memory");
#pragma unroll
                for (int mm = 0; mm < 2; ++mm) { const int m = 2 * mh + mm; const int rl = ai * 128 + wr * 64 + m * 16 + fr; const int row = u.pm * 256 + rl;
                    const LAS f32x2* tb2 = (const LAS f32x2*)tbl + rl * 4;
                    const f32x2 p0 = tb2[0], p1 = tb2[1], p2 = tb2[2], p3 = tb2[3];
                    const float mean = ((p0.x + p1.x) + (p2.x + p3.x)) * INV, rstd = __builtin_amdgcn_rsqf(fmaxf(((p0.y + p1.y) + (p2.y + p3.y)) * INV - mean * mean, 0.f) + EPS);
#pragma unroll
                    for (int bj = 0; bj < 2; ++bj)
#pragma unroll
                        for (int n = 0; n < 2; ++n) {
                            const f32x4 o = unpk4(ov[mm][bj][n]), a = acc[ai][bj][m][n]; f32x4 r;
#pragma unroll
                            for (int j = 0; j < 4; ++j) r[j] = (o[j] - mean) * rstd * silu_f(a[j]);
                            *(u32x2*)(O + (size_t)row * N + u.pn * 256 + bj * 128 + wc * 32 + n * 16 + fq * 4) = pk4(r);
                        }
                }
                asm volatile("" ::: "memory");
            }
        } else {
#pragma unroll
            for (int ai = 0; ai < 2; ++ai)
#pragma unroll
                for (int m = 0; m < 4; ++m) { const int rl = ai * 128 + wr * 64 + m * 16 + fr; const int row = u.pm * 256 + rl; float sq = 0.f;
#pragma unroll
                    for (int bj = 0; bj < 2; ++bj)
#pragma unroll
                        for (int n = 0; n < 2; ++n) { const f32x4 o = unpk4(*(const u32x2*)(O + (size_t)row * N + u.pn * 256 + bj * 128 + wc * 32 + n * 16 + fq * 4)); sq += (o[0] * o[0] + o[1] * o[1]) + (o[2] * o[2] + o[3] * o[3]); }
                    sq = xsum_16_32(sq);
                    if (fq == 0) tbl[rl * 4 + wc] = sq; }
            asm volatile("s_waitcnt lgkmcnt(0)" ::: "memory"); __builtin_amdgcn_s_barrier(); asm volatile("" ::: "memory");
#pragma unroll
            for (int ai = 0; ai < 2; ++ai) {
                u32x2 ov[4][2][2];
#pragma unroll
                for (int m = 0; m < 4; ++m) { const int row = u.pm * 256 + ai * 128 + wr * 64 + m * 16 + fr;
#pragma unroll
                    for (int bj = 0; bj < 2; ++bj)
#pragma unroll
                        for (int n = 0; n < 2; ++n) ov[m][bj][n] = *(const u32x2*)(O + (size_t)row * N + u.pn * 256 + bj * 128 + wc * 32 + n * 16 + fq * 4); }
                asm volatile("" ::: "memory");
#pragma unroll
                for (int m = 0; m < 4; ++m) { const int rl = ai * 128 + wr * 64 + m * 16 + fr; const int row = u.pm * 256 + rl;
                    const f32x4 pr = *(const LAS f32x4*)(tbl + rl * 4);
                    const float rstd = __builtin_amdgcn_rsqf(((pr[0] + pr[1]) + (pr[2] + pr[3])) * INV + EPS);
#pragma unroll
                    for (int bj = 0; bj < 2; ++bj)
#pragma unroll
                        for (int n = 0; n < 2; ++n) {
                            const f32x4 o = unpk4(ov[m][bj][n]), a = acc[ai][bj][m][n]; f32x4 r;
#pragma unroll
                            for (int j = 0; j < 4; ++j) r[j] = o[j] * rstd * silu_f(a[j]);
                            *(u32x2*)(O + (size_t)row * N + u.pn * 256 + bj * 128 + wc * 32 + n * 16 + fq * 4) = pk4(r);
                        }
                }
                asm volatile("" ::: "memory");
            }
        }
    }
};

namespace attn_body {
using bf16=unsigned short;
using bf16x8=__attribute__((ext_vector_type(8)))short;
using s16x4=__attribute__((ext_vector_type(4)))short;
using f32x16=__attribute__((ext_vector_type(16)))float;
using u32x4=__attribute__((ext_vector_type(4)))unsigned;
constexpr int BATCH=4,NHEAD=16,SEQ=4096,D=64,DM=NHEAD*D;
constexpr int NW=8,QBLK=32,QB=QBLK*NW,KVBLK=64,NQB=SEQ/QB;
constexpr int ATTN_PITCH=DM, ATTN_UNIT_ROWS=QB;
__device__ __forceinline__ int crow(int r,int hi){return (r&3)+8*(r>>2)+4*hi;}
#define SBAR() __builtin_amdgcn_sched_barrier(0)
__device__ __forceinline__ void cmask(f32x16&p0,f32x16&p1,int jb,int qrel,int hi){
  const float NEG=-INFINITY; int kb=64*jb+4*hi;
  #pragma unroll
  for(int r=0;r<16;++r){int kv=kb+(r&3)+8*(r>>2); if(kv>qrel)p0[r]=NEG; if(kv+32>qrel)p1[r]=NEG;}
}

constexpr int NSLOT=3, SLOTB=8192;
constexpr int LDS_K=0, LDS_V=NSLOT*SLOTB, LDS_WS=2*NSLOT*SLOTB, LDS_OST=LDS_WS+NW*64*4, LDS_NC=LDS_OST+NW*4096, LDS_FT=LDS_NC+SEQ*4, LDS_RE=LDS_FT+256, LDS_BYTES=LDS_RE+256;
constexpr float C2=0.125f*1.4426950408889634f;
__device__ __forceinline__ void glds16(const void*gsrc,unsigned lds_dst){unsigned keep;
  asm volatile("s_mov_b32 %0, m0\n\ts_mov_b32 m0, %2\n\ts_nop 0\n\tglobal_load_lds_dwordx4 %1, off\n\ts_mov_b32 m0, %0":"=&s"(keep):"v"(gsrc),"s"(lds_dst):"memory");}
__device__ __forceinline__ float max3f(float a,float b,float c){float r;asm("v_max3_f32 %0, %1, %2, %3":"=v"(r):"v"(a),"v"(b),"v"(c));return r;}
__device__ __forceinline__ float max2f(float a,float b){float r;asm("v_max_f32_e32 %0, %1, %2":"=v"(r):"v"(a),"v"(b));return r;}
__device__ __forceinline__ float fadd_s(float a,float b){float r;asm("v_add_f32_e32 %0, %1, %2":"=v"(r):"v"(a),"v"(b));return r;}
__device__ __forceinline__ float fsub_s(float a,float b){float r;asm("v_sub_f32_e32 %0, %1, %2":"=v"(r):"v"(a),"v"(b));return r;}
typedef float f32x2_t __attribute__((ext_vector_type(2))); typedef __bf16 bf16x2_t __attribute__((ext_vector_type(2)));
__device__ __forceinline__ unsigned cvtpk_s(float lo,float hi){f32x2_t v={lo,hi};bf16x2_t b=__builtin_convertvector(v,bf16x2_t);return __builtin_bit_cast(unsigned,b);}
#define WAIT_BAR(N) asm volatile("s_waitcnt vmcnt(" #N ") lgkmcnt(0)\n\ts_barrier":::"memory")

__device__ __forceinline__ void qkt(f32x16&p0,f32x16&p1,const char*Kslot,const bf16x8*qr,const f32x16&negm,int r32,int hi){
  const char*kb=Kslot+hi*1024+r32*16;
  #pragma unroll
  for(int d0=0;d0<4;++d0){
    const bf16x8 b0=*reinterpret_cast<const bf16x8*>(kb+d0*2048);
    const bf16x8 b1=*reinterpret_cast<const bf16x8*>(kb+d0*2048+512);
    if(d0==0){p0=__builtin_amdgcn_mfma_f32_32x32x16_bf16(b0,qr[0],negm,0,0,0);p1=__builtin_amdgcn_mfma_f32_32x32x16_bf16(b1,qr[0],negm,0,0,0);}
    else{p0=__builtin_amdgcn_mfma_f32_32x32x16_bf16(b0,qr[d0],p0,0,0,0);p1=__builtin_amdgcn_mfma_f32_32x32x16_bf16(b1,qr[d0],p1,0,0,0);}}
}
typedef __attribute__((address_space(3))) const char* lds_cptr;
typedef short v4i16_t __attribute__((ext_vector_type(4)));
__device__ __forceinline__ void kload8(bf16x8*kf,lds_cptr kp){
  kf[0]=*(const __attribute__((address_space(3))) bf16x8*)(kp);      kf[1]=*(const __attribute__((address_space(3))) bf16x8*)(kp+512);
  kf[2]=*(const __attribute__((address_space(3))) bf16x8*)(kp+2048); kf[3]=*(const __attribute__((address_space(3))) bf16x8*)(kp+2560);
  kf[4]=*(const __attribute__((address_space(3))) bf16x8*)(kp+4096); kf[5]=*(const __attribute__((address_space(3))) bf16x8*)(kp+4608);
  kf[6]=*(const __attribute__((address_space(3))) bf16x8*)(kp+6144); kf[7]=*(const __attribute__((address_space(3))) bf16x8*)(kp+6656);
}
__device__ __forceinline__ void kload2(bf16x8*kf,lds_cptr kp,int j){ kf[2*j]=*(const __attribute__((address_space(3))) bf16x8*)(kp+j*2048); kf[2*j+1]=*(const __attribute__((address_space(3))) bf16x8*)(kp+j*2048+512); }
__device__ __forceinline__ s16x4 vtr(lds_cptr p){ return __builtin_bit_cast(s16x4,__builtin_amdgcn_ds_read_tr16_b64_v4i16((__attribute__((address_space(3))) v4i16_t*)p)); }
__device__ __forceinline__ float rowmax(const f32x16&p0,const f32x16&p1){
  float a=max3f(p0[0],p0[1],p1[0]),b=max3f(p0[2],p0[3],p1[1]);a=max3f(a,p1[2],p1[3]);
  #pragma unroll
  for(int r=4;r<16;r+=4){a=max3f(a,p0[r],p0[r+1]);b=max3f(b,p0[r+2],p0[r+3]);a=max3f(a,p1[r],p1[r+1]);b=max3f(b,p1[r+2],p1[r+3]);}
  const float m=max2f(a,b);
  auto rr=__builtin_amdgcn_permlane32_swap(__float_as_uint(m),__float_as_uint(m),false,false);
  return max2f(__uint_as_float(rr[0]),__uint_as_float(rr[1]));
}
__device__ __forceinline__ void pv(f32x16*o,int vb,bf16x8 pa0,bf16x8 pa1,bf16x8 pa2,bf16x8 pa3){
  #pragma unroll
  for(int d0=0;d0<2;++d0){s16x4 lo[4],hi[4];
    #pragma unroll
    for(int ks=0;ks<4;++ks){
      asm volatile("ds_read_b64_tr_b16 %0,%1 offset:%c2":"=&v"(lo[ks]):"v"(vb),"i"(d0*4096+ks*1024):"memory");
      asm volatile("ds_read_b64_tr_b16 %0,%1 offset:%c2":"=&v"(hi[ks]):"v"(vb),"i"(d0*4096+ks*1024+512):"memory");}
    asm volatile("s_waitcnt lgkmcnt(0)":::"memory");SBAR();
    #define PK(k) (bf16x8){lo[k][0],lo[k][1],lo[k][2],lo[k][3],hi[k][0],hi[k][1],hi[k][2],hi[k][3]}
    o[d0]=__builtin_amdgcn_mfma_f32_32x32x16_bf16(pa0,PK(0),o[d0],0,0,0);
    o[d0]=__builtin_amdgcn_mfma_f32_32x32x16_bf16(pa1,PK(1),o[d0],0,0,0);
    o[d0]=__builtin_amdgcn_mfma_f32_32x32x16_bf16(pa2,PK(2),o[d0],0,0,0);
    o[d0]=__builtin_amdgcn_mfma_f32_32x32x16_bf16(pa3,PK(3),o[d0],0,0,0);
    #undef PK
  }
}

#ifndef ATTN_STORE16
#define ATTN_STORE16(p,v) (*(u32x4*)(p)=(v))
#endif
template<int THRL> __device__ __forceinline__ void attn_unit(int b,int h,int qb,int ts,const bf16*Q,const bf16*__restrict__ K,const bf16*__restrict__ V,const bf16*__restrict__ Gt,bf16*O,char*shm,int tid){
  const int lane=tid&63,r32=lane&31,hi=lane>>5; const int wid=__builtin_amdgcn_readfirstlane(tid>>6);
  const long rowbase=(long)b*SEQ; const int q0=qb*QB;
  typedef __attribute__((address_space(3))) const float* lds_fptr; typedef float f32x4b __attribute__((ext_vector_type(4)));
  const lds_fptr ncum=(lds_fptr)((__attribute__((address_space(3))) const char*)shm+LDS_NC)+64*ts+4*hi;
  const lds_fptr ftp=(lds_fptr)((__attribute__((address_space(3))) const char*)shm+LDS_FT)+ts;
  const bf16*Qw=Q+(rowbase+q0+wid*QBLK)*DM+h*D;
  const bf16*Kh=K+(rowbase+(long)ts*KVBLK)*DM+h*D,*Vh=V+(rowbase+(long)ts*KVBLK)*DM+h*D;
  const unsigned lds0=(unsigned)(uintptr_t)shm;
  float*wsf=(float*)(shm+LDS_WS)+wid*64;
  const bf16*ksrc=Kh+(long)lane*DM+wid*8;
  const bf16*vsrc=Vh+(long)(16*(wid&3)+(lane>>2))*DM+(wid>>2)*32+(lane&3)*8;
  const unsigned kdst=lds0+LDS_K+wid*1024, vdst=lds0+LDS_V+wid*1024;
  #define DMA_K(t,slot) glds16(ksrc+(long)(t)*KVBLK*DM,(unsigned)__builtin_amdgcn_readfirstlane(kdst+(slot)))
  #define DMA_V(t,slot) glds16(vsrc+(long)(t)*KVBLK*DM,(unsigned)__builtin_amdgcn_readfirstlane(vdst+(slot)))
  const int vb0=(int)(lds0+LDS_V)+((lane>>4)&1)*32+(lane&3)*8+(4*hi+((lane&15)>>2))*64;
  const char*Kbase=shm+LDS_K; bf16x8 kf[8];
  const lds_cptr shm3=(lds_cptr)shm; const lds_cptr kp0=shm3+LDS_K+hi*1024+r32*16; const lds_cptr vp0=shm3+LDS_V+((lane>>4)&1)*32+(lane&3)*8+(4*hi+((lane&15)>>2))*64;
  const int NT=(q0+QB)/KVBLK-ts;
  DMA_K(0,0);DMA_V(0,0);DMA_K(1,SLOTB);
  bf16x8 qr[4];
  #pragma unroll
  for(int d0=0;d0<4;++d0)qr[d0]=*reinterpret_cast<const bf16x8*>(&Qw[(long)r32*DM+d0*16+hi*8]);
  float l_reg=0.f,fcur=1.f;f32x16 o[2];o[0]=f32x16{};o[1]=f32x16{};const f32x16 negm=f32x16{};
  const int qrel=wid*QBLK+r32;
  #define CMASK(P0,P1,t) do{int jb_=(t)-(NT-4); if(jb_>=0)cmask(P0,P1,jb_,qrel,hi);}while(0)
  #define LDSF4(p) (*(const __attribute__((address_space(3))) f32x4b*)(p))
  #define BIAS(P0,P1,t) do{ const lds_fptr nb_=ncum+64*(t); \
      { const f32x4b a0_=LDSF4(nb_), a1_=LDSF4(nb_+8), a2_=LDSF4(nb_+16), a3_=LDSF4(nb_+24); \
        _Pragma("unroll") for(int j_=0;j_<4;++j_){ P0[j_]+=a0_[j_]; P0[4+j_]+=a1_[j_]; P0[8+j_]+=a2_[j_]; P0[12+j_]+=a3_[j_]; } } SBAR(); \
      { const f32x4b b0_=LDSF4(nb_+32), b1_=LDSF4(nb_+40), b2_=LDSF4(nb_+48), b3_=LDSF4(nb_+56); \
        _Pragma("unroll") for(int j_=0;j_<4;++j_){ P1[j_]+=b0_[j_]; P1[4+j_]+=b1_[j_]; P1[8+j_]+=b2_[j_]; P1[12+j_]+=b3_[j_]; } } SBAR(); }while(0)
  #define START(P0,P1) do{ _Pragma("unroll") for(int r=0;r<16;++r)P0[r]=__builtin_amdgcn_exp2f(P0[r]); }while(0)
  #define RESC() do{ _Pragma("unroll") for(int d_=0;d_<2;++d_) _Pragma("unroll") for(int r=0;r<16;++r)o[d_][r]*=fcur; }while(0)
  f32x16 pA0,pA1,pB0,pB1;
  int sl_prev=0,sl_cur=0,sl_next=SLOTB;
  #define ROT() do{sl_prev=sl_cur;sl_cur=sl_next;sl_next=(sl_next==(NSLOT-1)*SLOTB)?0:sl_next+SLOTB;}while(0)
  DMA_K(2,2*SLOTB);
  WAIT_BAR(3);
  qkt(pA0,pA1,Kbase,qr,negm,r32,hi);asm volatile("s_nop 15\n\ts_nop 7":"+v"(pA0),"+v"(pA1));BIAS(pA0,pA1,0);CMASK(pA0,pA1,0);
  START(pA0,pA1);
  _Pragma("unroll") for(int r=0;r<16;++r)pA1[r]=__builtin_amdgcn_exp2f(pA1[r]);
  WAIT_BAR(0);
  DMA_K(3,0);DMA_V(1,SLOTB);
  ROT();
  kload8(kf,kp0+sl_cur);
  WAIT_BAR(2);
  s16x4 vlo[8],vhi[8]; u32x4 pw0,pw1,pw2,pw3;
  #define PKW(P,B) cvtpk_s(P[B],P[B+1])
  #define PAF(k) __builtin_bit_cast(bf16x8,pw##k)
  #define VFR(i) (bf16x8){vlo[i][0],vlo[i][1],vlo[i][2],vlo[i][3],vhi[i][0],vhi[i][1],vhi[i][2],vhi[i][3]}
  #define PIN(x) asm volatile("":"+v"(x))
  #define MX3(a,b,c) __builtin_fmaxf(__builtin_fmaxf((a),(b)),(c))
  #define GAPA(MF,A0,A1,A2,A3,W0,W1,PW) do{ MF; sacc+=A0; sacc+=A1; sacc+=A2; sacc+=A3; PIN(sacc); W0; W1; PIN(PW); SBAR(); }while(0)
  #define EX(v) __builtin_amdgcn_exp2f(v)
  #define GAPB(MF,X,B) do{ MF; X[B]=EX(X[B]); X[B+1]=EX(X[B+1]); X[B+2]=EX(X[B+2]); X[B+3]=EX(X[B+3]); PIN(X); SBAR(); }while(0)
  #define VRD(i) do{ vlo[i]=vtr(vp_+(((i)>>2)*4096+((i)&3)*1024)); vhi[i]=vtr(vp_+(((i)>>2)*4096+((i)&3)*1024+512)); }while(0)
  #define KRD(G,j) do{ if(G){ kload2(kf,kp0+sl_next,j); SBAR(); } }while(0)
  #define STEP(C0,C1,P0,P1,t,GK,GV,GL) do{ SBAR(); \
    const lds_cptr vp_=vp0+sl_prev; \
    VRD(0); SBAR(); float sacc=(P0[0]+P0[1]); \
    GAPA(C0=__builtin_amdgcn_mfma_f32_32x32x16_bf16(kf[0],qr[0],negm,0,0,0), P0[2],P0[3],P0[4],P0[5],     pw0[0]=PKW(P0,0), pw0[1]=PKW(P0,2), pw0); \
    VRD(4); SBAR(); GAPA(C1=__builtin_amdgcn_mfma_f32_32x32x16_bf16(kf[1],qr[0],negm,0,0,0), P0[6],P0[7],P0[8],P0[9],     pw0[2]=PKW(P0,4), pw0[3]=PKW(P0,6), pw0); \
    VRD(1); SBAR(); GAPA(C0=__builtin_amdgcn_mfma_f32_32x32x16_bf16(kf[2],qr[1],C0,0,0,0),   P0[10],P0[11],P0[12],P0[13], pw1[0]=PKW(P0,8), pw1[1]=PKW(P0,10), pw1); \
    VRD(5); SBAR(); GAPA(C1=__builtin_amdgcn_mfma_f32_32x32x16_bf16(kf[3],qr[1],C1,0,0,0),   P0[14],P0[15],P1[0],P1[1],   pw1[2]=PKW(P0,12),pw1[3]=PKW(P0,14), pw1); \
    VRD(2); SBAR(); GAPA(C0=__builtin_amdgcn_mfma_f32_32x32x16_bf16(kf[4],qr[2],C0,0,0,0),   P1[2],P1[3],P1[4],P1[5],     pw2[0]=PKW(P1,0), pw2[1]=PKW(P1,2), pw2); \
    VRD(6); SBAR(); GAPA(C1=__builtin_amdgcn_mfma_f32_32x32x16_bf16(kf[5],qr[2],C1,0,0,0),   P1[6],P1[7],P1[8],P1[9],     pw2[2]=PKW(P1,4), pw2[3]=PKW(P1,6), pw2); \
    VRD(3); SBAR(); GAPA(C0=__builtin_amdgcn_mfma_f32_32x32x16_bf16(kf[6],qr[3],C0,0,0,0),   P1[10],P1[11],P1[12],P1[13], pw3[0]=PKW(P1,8), pw3[1]=PKW(P1,10), pw3); \
    VRD(7); SBAR(); GAPA(C1=__builtin_amdgcn_mfma_f32_32x32x16_bf16(kf[7],qr[3],C1,0,0,0),   P1[14],P1[15],0.f,0.f,       pw3[2]=PKW(P1,12),pw3[3]=PKW(P1,14), pw3); \
    l_reg+=sacc; \
    if(GK){DMA_K((t)+3,sl_cur);} if(GV){DMA_V((t)+1,sl_next);} \
    BIAS(C0,C1,t); CMASK(C0,C1,t); \
    { const int jb2_=2*((t)-(NT-4)); fcur=(jb2_>wid)?1.0f:ftp[(t)]; l_reg*=fcur; } \
    SBAR(); \
    GAPB(o[0]=__builtin_amdgcn_mfma_f32_32x32x16_bf16(PAF(0),VFR(0),o[0],0,0,0), C0,0); \
    GAPB(o[1]=__builtin_amdgcn_mfma_f32_32x32x16_bf16(PAF(0),VFR(4),o[1],0,0,0), C0,4); \
    KRD(GL,0); GAPB(o[0]=__builtin_amdgcn_mfma_f32_32x32x16_bf16(PAF(1),VFR(1),o[0],0,0,0), C0,8); \
    KRD(GL,1); GAPB(o[1]=__builtin_amdgcn_mfma_f32_32x32x16_bf16(PAF(1),VFR(5),o[1],0,0,0), C0,12); \
    KRD(GL,2); GAPB(o[0]=__builtin_amdgcn_mfma_f32_32x32x16_bf16(PAF(2),VFR(2),o[0],0,0,0), C1,0); \
    KRD(GL,3); GAPB(o[1]=__builtin_amdgcn_mfma_f32_32x32x16_bf16(PAF(2),VFR(6),o[1],0,0,0), C1,4); \
    GAPB(o[0]=__builtin_amdgcn_mfma_f32_32x32x16_bf16(PAF(3),VFR(3),o[0],0,0,0), C1,8); \
    GAPB(o[1]=__builtin_amdgcn_mfma_f32_32x32x16_bf16(PAF(3),VFR(7),o[1],0,0,0), C1,12); \
    }while(0)
  int t=1;
  #undef CMASK
  #define CMASK(P0,P1,t) do{}while(0)
  for(;t+5<NT;t+=2){
    STEP(pB0,pB1,pA0,pA1,t,true,true,true);     WAIT_BAR(2); RESC(); ROT();
    STEP(pA0,pA1,pB0,pB1,t+1,true,true,true);   WAIT_BAR(2); RESC(); ROT();
  }
  #undef CMASK
  int qrel_m=qrel,hi_m=hi; asm volatile("":"+v"(qrel_m),"+v"(hi_m));
  #define CMASK(P0,P1,t) do{int jb_=(t)-(NT-4); if(jb_>=0)cmask(P0,P1,jb_,qrel_m,hi_m);}while(0)
  #define ENDW(tt) do{ if((tt)+3<NT){WAIT_BAR(2);} else if((tt)+2<NT){WAIT_BAR(1);} else {WAIT_BAR(0);} }while(0)
  for(;t+1<NT;t+=2){
    STEP(pB0,pB1,pA0,pA1,t,(t+3<NT),(t+1<NT),(t+1<NT));       ENDW(t);   RESC(); ROT();
    STEP(pA0,pA1,pB0,pB1,t+1,(t+4<NT),(t+2<NT),(t+2<NT));     ENDW(t+1); RESC(); ROT();
  }
  STEP(pB0,pB1,pA0,pA1,NT-1,false,false,false); RESC();
  { float sacc=pB0[0]+pB0[1]; _Pragma("unroll") for(int r=2;r<16;++r)sacc+=pB0[r]; _Pragma("unroll") for(int r=0;r<16;++r)sacc+=pB1[r]; l_reg+=sacc;
    pw0=(u32x4){PKW(pB0,0),PKW(pB0,2),PKW(pB0,4),PKW(pB0,6)};pw1=(u32x4){PKW(pB0,8),PKW(pB0,10),PKW(pB0,12),PKW(pB0,14)};pw2=(u32x4){PKW(pB1,0),PKW(pB1,2),PKW(pB1,4),PKW(pB1,6)};pw3=(u32x4){PKW(pB1,8),PKW(pB1,10),PKW(pB1,12),PKW(pB1,14)};
    SBAR(); pv(o,vb0+sl_cur,PAF(0),PAF(1),PAF(2),PAF(3)); }
  #undef PKW
  #undef PAF
  #undef VFR
  #undef PIN
  #undef MX3
  #undef GAPA
  #undef GAPB
  #undef EX
  #undef VRD
  #undef KRD
  #undef STEP
  #undef ENDW
  {auto rr=__builtin_amdgcn_permlane32_swap(__float_as_uint(l_reg),__float_as_uint(l_reg),false,false);l_reg=__uint_as_float(rr[0])+__uint_as_float(rr[1]);}
  if(hi==0)wsf[32+r32]=l_reg;asm volatile("s_waitcnt lgkmcnt(0)":::"memory");
  float rli[16];
  #pragma unroll
  for(int r=0;r<16;++r)rli[r]=__builtin_amdgcn_rcpf(wsf[32+crow(r,hi)]);
  bf16*Ow=O+(rowbase+q0+wid*QBLK)*DM+h*D;
  { bf16*stg=(bf16*)(shm+LDS_OST)+wid*2048;
    #pragma unroll
    for(int r=0;r<16;++r){const int orow=crow(r,hi);
      #pragma unroll
      for(int d0=0;d0<2;++d0){const float gv=__uint_as_float((unsigned)Gt[(rowbase+q0+wid*QBLK+orow)*DM+h*D+d0*32+r32]<<16); const float ov=o[d0][r]*rli[r]*gv; unsigned ub=__float_as_uint(ov); ub=(ub+0x7fffu+((ub>>16)&1u))>>16; stg[orow*64+d0*32+r32]=(bf16)ub;}}
    asm volatile("s_waitcnt lgkmcnt(0)":::"memory");
    #pragma unroll
    for(int i=0;i<4;++i){const int row=i*8+(lane>>3),ch=lane&7; const u32x4 v=*(const u32x4*)(stg+row*64+ch*8); ATTN_STORE16(Ow+(long)row*DM+ch*8,v);} }
  asm volatile("s_waitcnt lgkmcnt(0)\n\ts_barrier":::"memory");
  #undef DMA_K
  #undef DMA_V
  #undef CMASK
  #undef BIAS
  #undef LDSF4
  #undef START
  #undef RESC
  #undef ROT
}
constexpr int ATTN_LDS_BYTES=LDS_BYTES;
#undef SBAR
#undef WAIT_BAR
}

__device__ __forceinline__ void fox_attn2(const Params& P, char* shm, int tid, int bid, int G, unsigned short* Odst) {
    const int lane = tid & 63;
    unsigned short* Q = (unsigned short*)(P.ws + WS_ACT); const unsigned short* Kb = (const unsigned short*)(P.ws + WS_ACT + 32 * MiB); const unsigned short* V = (const unsigned short*)(P.ws + WS_ACT + 64 * MiB);
    const unsigned short* Gt = (const unsigned short*)(P.ws + WS_ACT + 96 * MiB);
    LAS float* nc = (LAS float*)((LAS char*)shm + attn_body::LDS_NC);
    LAS float* ft = (LAS float*)((LAS char*)shm + attn_body::LDS_FT);
    LAS float* re = (LAS float*)((LAS char*)shm + attn_body::LDS_RE);
    float gq = fabsf(P.fox_q_gain[lane]), gk = fabsf(P.fox_k_gain[lane]);
#pragma unroll
    for (int o = 1; o < 64; o <<= 1) { gq = fmaxf(gq, __shfl_xor(gq, o)); gk = fmaxf(gk, __shfl_xor(gk, o)); }
    const float Smax = 1.02f * (64.0f * gq * gk * 0.125f * LOG2E);
    const float T = 2.0f * Smax + 40.0f;
    const int vcu = (G % 8 == 0) ? (bid % 8) * (G / 8) + bid / 8 : bid;
    int last_bh = -1;
    for (int i = 0;; ++i) {
        int bh, qb;
        if (G == 256) { if (i >= 4) break; bh = vcu >> 2; const int s = vcu & 3; qb = (i == 0) ? s : (i == 1) ? 7 - s : (i == 2) ? 8 + s : 15 - s; }
        else { const int ui = i * G + bid; if (ui >= 1024) break; bh = ui >> 4; qb = ui & 15; }
        if (bh != last_bh) {
            const float* LF = (const float*)(P.ws + WS_S16) + ((size_t)(bh >> 4) * SEQ + 8 * tid) * 16 + (bh & 15);
            float v8[8]; float run = 0.f;
#pragma unroll
            for (int i2 = 0; i2 < 8; ++i2) { run += LF[(size_t)i2 * 16]; v8[i2] = run; }
            float inc = run;
#pragma unroll
            for (int o = 1; o < 64; o <<= 1) { const float tt = __shfl_up(inc, o); if (lane >= o) inc += tt; }
            if (lane == 63) ft[tid >> 6] = inc;
            __syncthreads();
            float pre = inc - run;
            for (int w = 0; w < (tid >> 6); ++w) pre += ft[w];
            __syncthreads();
#pragma unroll
            for (int i2 = 0; i2 < 8; ++i2) nc[8 * tid + i2] = -(pre + v8[i2]) * LOG2E;
            __syncthreads();
            if (tid < 64) { const float e = nc[64 * tid + 63]; re[tid] = e; const float ep = (tid > 0) ? nc[64 * tid - 1] : e; ft[tid] = exp2f(ep - e); }
            __syncthreads();
#pragma unroll
            for (int i2 = 0; i2 < 8; ++i2) nc[8 * tid + i2] += -re[tid >> 3] - Smax + 40.0f;
            __syncthreads(); last_bh = bh;
        }
        const int ntf = 4 * qb + 4;
        const float thr = (qb > 0 ? re[4 * qb - 1] : 0.0f) - T;
        const bool pred = (lane < ntf) && (re[lane] < thr);
        int ts = __builtin_popcountll(__ballot(pred)) & ~1; ts = ts > ntf - 4 ? ntf - 4 : ts; ts = __builtin_amdgcn_readfirstlane(ts);
        int tid_u = tid; asm volatile("" : "+v"(tid_u));
        attn_body::attn_unit<8>(bh >> 4, bh & 15, qb, ts, Q, Kb, V, Gt, Odst ? Odst : Q, shm, tid_u);
    }
}

__device__ __forceinline__ void final_norm(const Params& P, int tid, int bid, int G) {
    const int lane = tid & 63, wave = tid >> 6;
    const int gw = bid * 8 + wave, NGW = G * 8;
    f32x4 g[4];
#pragma unroll
    for (int j = 0; j < 4; ++j) g[j] = *(const f32x4*)(P.final_g + 4 * lane + 256 * j);
    constexpr int RB = 4;
    for (int row0 = gw; row0 < MT; row0 += RB * NGW) {
        f32x4 v[RB][4];
#pragma unroll
        for (int rb = 0; rb < RB; ++rb) { const int row = row0 + rb * NGW < MT ? row0 + rb * NGW : row0; const f32x4* xr = (const f32x4*)(P.out + (size_t)row * 1024) + lane;
#pragma unroll
            for (int j = 0; j < 4; ++j) v[rb][j] = xr[64 * j]; }
#pragma unroll
        for (int rb = 0; rb < RB; ++rb) { const int row = row0 + rb * NGW; if (row >= MT) break;
            float ss = 0.f;
#pragma unroll
            for (int j = 0; j < 4; ++j) ss += (v[rb][j][0] * v[rb][j][0] + v[rb][j][1] * v[rb][j][1]) + (v[rb][j][2] * v[rb][j][2] + v[rb][j][3] * v[rb][j][3]);
            const float rstd = rsqrtf(wave_sum(ss) * (1.0f / 1024.0f) + EPS);
            f32x4* xw = (f32x4*)(P.out + (size_t)row * 1024) + lane;
#pragma unroll
            for (int j = 0; j < 4; ++j) xw[64 * j] = (v[rb][j] * rstd) * g[j];
        }
    }
}

#define XB_TMO      128
#define XB_XCNT(j)  (256  + 64 * (j))
#define XB_XSUB(j)  (1280 + 64 * (j))
#define XB_XGEN(j)  (2304 + 64 * (j))
#define XB_TOP      3328
#define XB_TOPGEN   3392
#define XCD_BAR_WORDS 3456
#define XB_SPIN_CAP (1u << 20)
__device__ __forceinline__ unsigned xb_ld(unsigned* p)              { return __hip_atomic_load(p, __ATOMIC_RELAXED, __HIP_MEMORY_SCOPE_AGENT); }
__device__ __forceinline__ unsigned xb_add(unsigned* p, unsigned v) { return __hip_atomic_fetch_add(p, v, __ATOMIC_RELAXED, __HIP_MEMORY_SCOPE_AGENT); }
__device__ __forceinline__ unsigned xb_xcc_id() { return (unsigned)__builtin_amdgcn_s_getreg((3 << 11) | 20) & 0xFu; }
#define XB_SPIN(cond, bar) do { unsigned _sp = 0; while (cond) { __builtin_amdgcn_s_sleep(1); \
    if ((++_sp & 255u) == 0u) { if (xb_ld(&(bar)[XB_TMO])) break; if (_sp > XB_SPIN_CAP) { atomicAdd(&(bar)[XB_TMO], 1u); break; } } } } while (0)
struct XcdBarrier { unsigned* bar; unsigned x; volatile LAS unsigned* st; int wave_s; };
__device__ __forceinline__ int lane_id() { return (int)__builtin_amdgcn_mbcnt_hi(~0u, __builtin_amdgcn_mbcnt_lo(~0u, 0u)); }
__device__ __forceinline__ XcdBarrier xcd_barrier_post(unsigned* bar, volatile LAS unsigned* st, int wave_s) {
    XcdBarrier b; b.bar = bar; b.x = xb_xcc_id(); b.st = st; b.wave_s = wave_s;
    if (threadIdx.x == 0) (void)xb_add(&bar[XB_XCNT(b.x)], 1u);
    return b;
}
__device__ __forceinline__ void xcd_barrier_complete(unsigned* bar, unsigned x, unsigned& nloc, unsigned& nx) {
    const unsigned G = gridDim.x * gridDim.y * gridDim.z;
    asm volatile("" : "+s"(x));
    unsigned sum, cnt, mine, sp = 0u;
    for (;;) {
        sum = 0u; cnt = 0u; mine = 0u;
#pragma unroll
        for (unsigned j = 0; j < 16; ++j) { const unsigned c = xb_ld(&bar[XB_XCNT(j)]); sum += c; cnt += (c > 0u) ? 1u : 0u; mine = (j == x) ? c : mine; }
        if (sum == G) break;
        __builtin_amdgcn_s_sleep(1);
        if ((++sp & 255u) == 0u) { if (xb_ld(&bar[XB_TMO])) break; if (sp > XB_SPIN_CAP) { atomicAdd(&bar[XB_TMO], 1u); break; } }
    }
    nloc = mine > 0u ? mine : 1u; nx = cnt > 0u ? cnt : 1u;
}
__device__ __forceinline__ void xcd_barrier(const XcdBarrier& b) {
    asm volatile("s_waitcnt vmcnt(0)" ::: "memory");
    __syncthreads();
    if (threadIdx.x == 0) {
        unsigned* bar = b.bar;
        __builtin_amdgcn_s_waitcnt(0);
        unsigned nloc = b.st[0], nx = b.st[1];
        if (nloc == 0u) { xcd_barrier_complete(bar, b.x, nloc, nx); b.st[0] = nloc; b.st[1] = nx; }
        const unsigned old = xb_add(&bar[XB_XSUB(b.x)], 1u);
        const unsigned gen = old / nloc;
        if (old + 1u == (gen + 1u) * nloc) {
            __builtin_amdgcn_fence(__ATOMIC_RELEASE, "agent");
            asm volatile("s_waitcnt vmcnt(0)" ::: "memory");
            const unsigned og = xb_add(&bar[XB_TOP], 1u);
            const unsigned tg = og / nx;
            if (og + 1u == (tg + 1u) * nx) xb_add(&bar[XB_TOPGEN], 1u);
            else XB_SPIN(xb_ld(&bar[XB_TOPGEN]) == tg, bar);
            xb_add(&bar[XB_XGEN(b.x)], 1u);
            __builtin_amdgcn_fence(__ATOMIC_ACQUIRE, "agent");
            asm volatile("s_waitcnt vmcnt(0)" ::: "memory");
        } else {
            XB_SPIN(xb_ld(&bar[XB_XGEN(b.x)]) == gen, bar);
            __builtin_amdgcn_fence(__ATOMIC_ACQUIRE, "agent");
            asm volatile("s_waitcnt vmcnt(0)" ::: "memory");
        }
    }
    __syncthreads();
}

constexpr int LDS_BYTES = 147456;
#ifndef PROBE
#define PROBE 0
#endif
#define FRESH() int tid = threadIdx.x, bid = blockIdx.x; asm volatile("" : "+v"(tid)); asm volatile("" : "+s"(bid));
__global__ void __launch_bounds__(512, 2) trunk_fwd(Params P) {
    extern __shared__ __attribute__((aligned(16))) unsigned char lds_raw[];
    LAS unsigned char* lds = (LAS unsigned char*)lds_raw;
    cg::grid_group grid = cg::this_grid();
    const int G = gridDim.x;
    volatile LAS unsigned* MISC = (volatile LAS unsigned*)(lds + LDS_BYTES - 128);
    const int wave_s = __builtin_amdgcn_readfirstlane((int)threadIdx.x >> 6);
    if (threadIdx.x < 32) MISC[threadIdx.x] = 0u;
    __syncthreads();
    XcdBarrier xbar = xcd_barrier_post((unsigned*)P.ws, MISC + 8, wave_s);
    unsigned char* ws = P.ws;
    const float* MOD = (const float*)(ws + WS_MOD);
    bf16_t* XN = (bf16_t*)(ws + WS_XN);
    bf16_t* ACT = (bf16_t*)(ws + WS_ACT);
#define GSYNC() xcd_barrier(xbar)
    if (PROBE == 30) { { FRESH(); p0_mod(P, lds, tid, bid, G); } { FRESH(); p0_rope(P, tid, bid, G); } __syncthreads(); }
    if (PROBE == 31) { FRESH(); conv_weights(P.ret_w_in, RET_IN, 6144, P.ret_w_out, 2048, ws + WS_W, lds, tid, bid, G); __syncthreads(); }
    { FRESH(); p0_mod(P, lds, tid, bid, G); }
    { FRESH(); p0_rope(P, tid, bid, G); }
    { FRESH(); conv_weights(P.ret_w_in, RET_IN, 6144, P.ret_w_out, 2048, ws + WS_W, lds, tid, bid, G); }
    grid.sync();
#pragma unroll 1
    for (int layer = 0; layer < 4; ++layer) {
        const int kind = layer % 3, j = layer / 3;
        unsigned char* wbase = ws + ((kind == 2) ? WS_WGLA : WS_W);
        bf16_t* WinT = (bf16_t*)wbase; bf16_t* WoutT = (bf16_t*)(wbase + 12 * MiB);
        const float* xin = (layer == 0) ? P.x : P.out;
        if (layer > 0) {
            FRESH();
            if (kind == 0) { if (G != 256) conv_weights(P.ret_w_in + (size_t)j * 1024 * RET_IN, RET_IN, 6144, P.ret_w_out + (size_t)j * 2048 * 1024, 2048, ws + WS_W, lds, tid, bid, G); }
            else if (kind == 1) conv_weights(P.fox_w_in, FOX_IN, 4096, P.fox_w_out, 1024, ws + WS_W, lds, tid, bid, G);
            else conv_weights(P.gla_w_in, GLA_IN, 3072, P.gla_w_out, 1024, ws + WS_WGLA, lds, tid, bid, G);
            __syncthreads();
        }
        if (PROBE == 5 || (PROBE >= 50 && PROBE <= 53 && layer == PROBE - 50)) {
            if (kind == 0) { FRESH(); h_phase<0>(P, layer, xin, lds, tid, bid, G); }
            else if (kind == 1) { FRESH(); h_phase<1>(P, layer, xin, lds, tid, bid, G); }
            else { FRESH(); h_phase<2>(P, layer, xin, lds, tid, bid, G); }
            __syncthreads();
        }
        if (kind == 0) { FRESH(); h_phase<0>(P, layer, xin, lds, tid, bid, G); }
        else if (kind == 1) { FRESH(); h_phase<1>(P, layer, xin, lds, tid, bid, G); }
        else { FRESH(); h_phase<2>(P, layer, xin, lds, tid, bid, G); }
        GSYNC();
        const float* gate = MOD + (size_t)(layer * 4) * 3072 + 2048;
        if (kind == 0) {
            bf16_t* rQ = ACT; bf16_t* rK = (bf16_t*)(ws + WS_ACT + 32 * MiB); bf16_t* rV = (bf16_t*)(ws + WS_ACT + 64 * MiB); bf16_t* rO = (bf16_t*)(ws + WS_ACT + 128 * MiB);
            bf16_t* rP = WinT;
            float* STATS = (float*)(ws + WS_S16);
            {
                FRESH();
                pg8::Gemm g{XN, WinT, MT, 4096, 1024}; pg8::StaticOrder S; S.init(MT, 4096, G, bid);
                EpiRetIn E{rQ, rK, rV, (const unsigned*)(ws + WS_ROPE)};
                pg8::gemm_phase<EpiRetIn, pg8::StaticOrder, true, true>(lds, g, S, E, tid);
            }
            GSYNC();
            if (PROBE == 40) { FRESH();
                pg8::Gemm g{XN, WinT, MT, 4096, 1024}; pg8::StaticOrder S; S.init(MT, 4096, G, bid);
                EpiRetIn E{rQ, rK, rV, (const unsigned*)(ws + WS_ROPE)};
                pg8::gemm_phase<EpiRetIn, pg8::StaticOrder, true, true>(lds, g, S, E, tid); GSYNC(); }
            if (PROBE == 6) { FRESH();
                pg8::Gemm g{XN, WinT + (size_t)4096 * 1024, MT, 2048, 1024}; pg8::StaticOrder S; S.init(MT, 2048, G, bid);
                EpiSplit E{(bf16_t*)P.out, 8, 0, 2048, -1};
                if (layer == 0) { pg8::gemm_phase<EpiSplit, pg8::StaticOrder, true, true>(lds, g, S, E, tid); GSYNC(); } }
            if (PROBE == 62 && layer == 0) { FRESH();
                pg8::Gemm g{XN, WinT, MT, 4096, 1024}; pg8::StaticOrder S; S.init(MT, 4096, G, bid);
                EpiNone E{P.out};
                pg8::gemm_phase<EpiNone, pg8::StaticOrder, true, true>(lds, g, S, E, tid); GSYNC(); }
            if (PROBE == 60 && layer == 0) { FRESH();
                pg8::Gemm g{XN, WinT + (size_t)4096 * 1024, MT, 2048, 1024}; pg8::StaticOrder S; S.init(MT, 2048, G, bid);
                EpiNone E{P.out};
                pg8::gemm_phase<EpiNone, pg8::StaticOrder, true, true>(lds, g, S, E, tid); GSYNC(); }
            { FRESH(); lin_pphase<0>(rQ, rK, rQ, rK, rP, tid, bid, G); }
            GSYNC();
            if (PROBE == 2) { FRESH(); lin_scan<0>(rQ, rK, rV, rP, nullptr, rO, (float*)(ws + WS_CUM), lds, tid, bid, G); GSYNC(); }
            if (PROBE == 20 && layer == 0) { FRESH(); lin_scan<0, 1>(rQ, rK, rV, rP, nullptr, (bf16_t*)P.out, (float*)(ws + WS_CUM), lds, tid, bid, G); GSYNC(); }
            if (PROBE == 23 && layer == 0) { FRESH(); lin_scan<0, 4>(rQ, rK, rV, rP, nullptr, (bf16_t*)P.out, (float*)(ws + WS_CUM), lds, tid, bid, G); GSYNC(); }
            if (PROBE == 25 && layer == 0) { FRESH(); lin_scan<0, 16>(rQ, rK, rV, rP, nullptr, (bf16_t*)P.out, (float*)(ws + WS_CUM), lds, tid, bid, G); GSYNC(); }
            if (PROBE == 21 && layer == 0) { FRESH(); lin_scan<0, 2>(rQ, rK, rV, rP, nullptr, (bf16_t*)P.out, (float*)(ws + WS_CUM), lds, tid, bid, G); GSYNC(); }
            if (PROBE == 24 && layer == 0) { FRESH(); lin_scan<0, 8>(rQ, rK, rV, rP, nullptr, (bf16_t*)P.out, (float*)(ws + WS_CUM), lds, tid, bid, G); GSYNC(); }
            if (PROBE == 26 && layer == 0) { FRESH(); lin_scan<0, 3>(rQ, rK, rV, rP, nullptr, (bf16_t*)P.out, (float*)(ws + WS_CUM), lds, tid, bid, G); GSYNC(); }
            if (PROBE == 27 && layer == 0) { FRESH(); lin_scan<0, 11>(rQ, rK, rV, rP, nullptr, (bf16_t*)P.out, (float*)(ws + WS_CUM), lds, tid, bid, G); GSYNC(); }
            if (PROBE == 28 && layer == 0) { FRESH(); lin_scan<0, 31>(rQ, rK, rV, rP, nullptr, (bf16_t*)P.out, (float*)(ws + WS_CUM), lds, tid, bid, G); GSYNC(); }
            if (PROBE == 22 && layer == 0) { FRESH(); lin_scan<0, 0>(rQ, rK, rV, rP, nullptr, (bf16_t*)P.out, (float*)(ws + WS_CUM), lds, tid, bid, G); GSYNC(); }
            { FRESH(); lin_scan<0>(rQ, rK, rV, rP, nullptr, rO, (float*)(ws + WS_CUM), lds, tid, bid, G); }
            GSYNC();
            {
                FRESH();
                pg8::Gemm g{XN, WinT + (size_t)4096 * 1024, MT, 2048, 1024}; pg8::PairOrder S{G, (G % 8 == 0) ? (bid % 8) * (G / 8) + bid / 8 : bid};
                EpiGateNorm<0> E{rO, STATS, (LAS float*)(lds + 131072)};
                pg8::gemm_phase<EpiGateNorm<0>, pg8::PairOrder, true, true>(lds, g, S, E, tid);
            }
            GSYNC();
            if (PROBE == 42 && layer == 0) { FRESH();
                pg8::Gemm g{rO, WoutT, MT, 1024, 2048}; pg8::StaticOrder S; S.init(MT, 1024, G, bid);
                EpiOut E{xin, P.out, gate};
                pg8::gemm_phase<EpiOut, pg8::StaticOrder, true, true>(lds, g, S, E, tid); GSYNC(); }
            {
                FRESH();
                pg8::Gemm g{rO, WoutT, MT, 1024, 2048}; pg8::StaticOrder S; S.init(MT, 1024, G, bid);
                EpiOut E{xin, P.out, gate};
                pg8::gemm_phase<EpiOut, pg8::StaticOrder, true, true>(lds, g, S, E, tid);
            }
            GSYNC();
        } else if (kind == 1) {
            {
                FRESH();
                pg8::Gemm g{XN, WinT, MT, 4096, 1024}; pg8::StaticOrder S; S.init(MT, 4096, G, bid);
                EpiFoxIn E{ACT, P.fox_q_gain, P.fox_k_gain, (LAS float*)(lds + 131072)};
                pg8::gemm_phase<EpiFoxIn, pg8::StaticOrder, true, true>(lds, g, S, E, tid);
            }
            GSYNC();
            if (PROBE == 41) { FRESH();
                pg8::Gemm g{XN, WinT, MT, 4096, 1024}; pg8::StaticOrder S; S.init(MT, 4096, G, bid);
                EpiFoxIn E{ACT, P.fox_q_gain, P.fox_k_gain, (LAS float*)(lds + 131072)};
                pg8::gemm_phase<EpiFoxIn, pg8::StaticOrder, true, true>(lds, g, S, E, tid); GSYNC(); }
            if (PROBE == 1) { FRESH(); fox_attn2(P, (char*)lds_raw, tid, bid, G, XN); GSYNC(); }
            { FRESH(); fox_attn2(P, (char*)lds_raw, tid, bid, G, nullptr); }
            GSYNC();
            {
                FRESH();
                pg8::Gemm g{ACT, WoutT, MT, 1024, 1024}; pg8::StaticOrder S; S.init(MT, 1024, G, bid);
                EpiOut E{xin, P.out, gate};
                pg8::gemm_phase<EpiOut, pg8::StaticOrder, true, true>(lds, g, S, E, tid);
            }
            GSYNC();
        } else {
            bf16_t* gQE = ACT; bf16_t* gQN = (bf16_t*)(ws + WS_ACT + 16 * MiB); bf16_t* gKE = (bf16_t*)(ws + WS_ACT + 32 * MiB); bf16_t* gKN = (bf16_t*)(ws + WS_ACT + 48 * MiB);
            bf16_t* gV = (bf16_t*)(ws + WS_ACT + 64 * MiB); bf16_t* gP = (bf16_t*)(ws + WS_ACT + 96 * MiB); bf16_t* gO = (bf16_t*)(ws + WS_ACT + 128 * MiB);
            const float* gCB = (const float*)(ws + WS_ACT + 160 * MiB);
            float* STATS = (float*)(ws + WS_S16);
            {
                FRESH();
                pg8::Gemm g{XN, WinT, MT, 2048, 1024}; pg8::StaticOrder S; S.init(MT, 2048, G, bid);
                EpiGlaIn E{gQE, gQN, gKE, gKN, gV, nullptr, gCB};
                pg8::gemm_phase<EpiGlaIn, pg8::StaticOrder, true, true>(lds, g, S, E, tid);
            }
            GSYNC();
            { FRESH(); lin_pphase<1>(gQE, gKN, gQN, gKE, gP, tid, bid, G); }
            GSYNC();
            if (PROBE == 3) { FRESH(); lin_scan<1>(gQE, gKN, gV, gP, gCB, gO, (float*)(ws + WS_CUM), lds, tid, bid, G); GSYNC(); }
            if (G == 256 && ((int)blockIdx.x >> 3) >= 16) {
                FRESH(); const int sub = (bid & 7) * 16 + ((bid >> 3) - 16);
                conv_weights(P.ret_w_in + (size_t)1 * 1024 * RET_IN, RET_IN, 6144, P.ret_w_out + (size_t)1 * 2048 * 1024, 2048, ws + WS_W, lds, tid, sub, 128);
            } else { FRESH(); lin_scan<1>(gQE, gKN, gV, gP, gCB, gO, (float*)(ws + WS_CUM), lds, tid, bid, G); }
            GSYNC();
            {
                FRESH();
                pg8::Gemm g{XN, WinT + (size_t)2048 * 1024, MT, 1024, 1024}; pg8::StaticOrder S; S.init(MT, 1024, G, bid);
                EpiGateNorm<1> E{gO, STATS, (LAS float*)(lds + 131072)};
                pg8::gemm_phase<EpiGateNorm<1>, pg8::StaticOrder, true, true>(lds, g, S, E, tid);
            }
            GSYNC();
            {
                FRESH();
                pg8::Gemm g{gO, WoutT, MT, 1024, 1024}; pg8::StaticOrder S; S.init(MT, 1024, G, bid);
                EpiOut E{xin, P.out, gate};
                pg8::gemm_phase<EpiOut, pg8::StaticOrder, true, true>(lds, g, S, E, tid);
            }
            GSYNC();
        }
    }
    if (PROBE == 70) { for (int i = 0; i < 10; ++i) GSYNC(); }
    { FRESH(); final_norm(P, tid, bid, G); }
}

extern "C" void kernel_launch(void* const* d_in, const int* in_sizes, int n_in, void* d_out, int out_size, void* d_ws, size_t ws_size, hipStream_t stream) {
    static int grid = 0;
    if (grid == 0) {
        if (n_in != 18 || out_size != MT * DM || ws_size < WS_END) { fprintf(stderr, "kernel_launch: unexpected shapes (n_in %d out %d ws %zu)\n", n_in, out_size, ws_size); grid = -1; return; }
        int dev = 0, cus = 0, per_cu = 0;
        hipGetDevice(&dev);
        hipDeviceGetAttribute(&cus, hipDeviceAttributeMultiprocessorCount, dev);
        hipFuncSetAttribute((const void*)trunk_fwd, hipFuncAttributeMaxDynamicSharedMemorySize, LDS_BYTES);
        hipOccupancyMaxActiveBlocksPerMultiprocessor(&per_cu, (const void*)trunk_fwd, 512, LDS_BYTES);
        if (per_cu < 1) { fprintf(stderr, "kernel_launch: occupancy query says %d blocks per CU\n", per_cu); per_cu = 1; }
        (void)hipGetLastError();
        grid = cus;
    }
    if (grid < 0) return;
    Params p{};
    p.x = (const float*)d_in[0]; p.c = (const float*)d_in[1]; p.pos = (const int*)d_in[2]; p.mod_w = (const float*)d_in[3]; p.mod_b = (const float*)d_in[4]; p.norm_g = (const float*)d_in[5];
    p.ret_w_in = (const float*)d_in[6]; p.ret_w_out = (const float*)d_in[7]; p.fox_w_in = (const float*)d_in[8]; p.fox_b_f = (const float*)d_in[9]; p.fox_q_gain = (const float*)d_in[10]; p.fox_k_gain = (const float*)d_in[11];
    p.fox_w_out = (const float*)d_in[12]; p.gla_w_in = (const float*)d_in[13]; p.gla_w_gate2 = (const float*)d_in[14]; p.gla_b_gate = (const float*)d_in[15]; p.gla_w_out = (const float*)d_in[16]; p.final_g = (const float*)d_in[17];
    p.out = (float*)d_out; p.ws = (unsigned char*)d_ws;
    if (hipMemsetAsync(d_ws, 0, 16384, stream) != hipSuccess) { fprintf(stderr, "kernel_launch: memset failed\n"); return; }
    void* args[] = {&p};
    hipError_t e = hipLaunchCooperativeKernel((const void*)trunk_fwd, dim3(grid), dim3(512), args, LDS_BYTES, stream);
    if (e != hipSuccess) fprintf(stderr, "cooperative launch failed: %s (grid %d)\n", hipGetErrorString(e), grid);
}
```

```cpp
#include <hip/hip_runtime.h>
#include <hip/hip_cooperative_groups.h>
#include <cstdio>
#include <cstdint>
#include <cmath>
namespace cg = cooperative_groups;

#define LAS __attribute__((address_space(3)))
typedef unsigned short bf16_t;
typedef short bf16x8 __attribute__((ext_vector_type(8)));
typedef float f32x4 __attribute__((ext_vector_type(4)));
typedef float f32x2 __attribute__((ext_vector_type(2)));
typedef unsigned u32x4 __attribute__((ext_vector_type(4)));
typedef unsigned u32x2 __attribute__((ext_vector_type(2)));

constexpr int DM = 1024, NB = 4, SEQ = 4096, MT = NB * SEQ;
constexpr float EPS = 1e-6f;
constexpr int RET_IN = 6144, FOX_IN = 4112, GLA_IN = 3088;
constexpr float LOG2E = 1.4426950408889634f;

constexpr size_t MiB = 1u << 20;
constexpr size_t WS_MOD = 1 * MiB;
constexpr size_t WS_S16 = 2 * MiB;
constexpr size_t WS_CUM = 3 * MiB;
constexpr size_t WS_ROPE = 4 * MiB;
constexpr size_t WS_W = 12 * MiB;
constexpr size_t WS_WOUT = WS_W + 12 * MiB;
constexpr size_t WS_WGLA = 164 * MiB;
constexpr size_t WS_XN = 28 * MiB;
constexpr size_t WS_ACT = 60 * MiB;
constexpr size_t WS_END = 252 * MiB;

__device__ __forceinline__ unsigned f2bf(float f) { unsigned u = __builtin_bit_cast(unsigned, f); return (u + 0x7fffu + ((u >> 16) & 1u)) >> 16; }
typedef float f32x2_hw __attribute__((ext_vector_type(2))); typedef __bf16 bf16x2_hw __attribute__((ext_vector_type(2)));
__device__ __forceinline__ unsigned pk2(float lo, float hi) { f32x2_hw v = {lo, hi}; bf16x2_hw b = __builtin_convertvector(v, bf16x2_hw); return __builtin_bit_cast(unsigned, b); }
__device__ __forceinline__ float bf2f(unsigned h) { return __builtin_bit_cast(float, h << 16); }
__device__ __forceinline__ u32x2 pk4(f32x4 v) { u32x2 r; r.x = pk2(v[0], v[1]); r.y = pk2(v[2], v[3]); return r; }
__device__ __forceinline__ f32x4 unpk4(u32x2 w) { f32x4 r; r[0] = bf2f(w.x & 0xffffu); r[1] = bf2f(w.x >> 16); r[2] = bf2f(w.y & 0xffffu); r[3] = bf2f(w.y >> 16); return r; }
__device__ __forceinline__ float silu_f(float v) { return v * __builtin_amdgcn_rcpf(1.0f + __expf(-v)); }
__device__ __forceinline__ float logsig_f(float v) { return fminf(v, 0.0f) - __logf(1.0f + __expf(-fabsf(v))); }
template <int CTRL> __device__ __forceinline__ float dpp_mov(float v) { return __builtin_bit_cast(float, __builtin_amdgcn_update_dpp(0, __builtin_bit_cast(int, v), CTRL, 0xf, 0xf, true)); }
__device__ __forceinline__ float swap32_sum(float x, float y) { auto r = __builtin_amdgcn_permlane32_swap(__builtin_bit_cast(unsigned, x), __builtin_bit_cast(unsigned, y), false, false); const unsigned r0 = r[0], r1 = r[1]; return __builtin_bit_cast(float, r0) + __builtin_bit_cast(float, r1); }
__device__ __forceinline__ float swap16_sum(float x, float y) { auto r = __builtin_amdgcn_permlane16_swap(__builtin_bit_cast(unsigned, x), __builtin_bit_cast(unsigned, y), false, false); const unsigned r0 = r[0], r1 = r[1]; return __builtin_bit_cast(float, r0) + __builtin_bit_cast(float, r1); }
__device__ __forceinline__ float row_sum16(float v) {
    v += dpp_mov<0xB1>(v);
    v += dpp_mov<0x4E>(v);
    v += dpp_mov<0x141>(v);
    v += dpp_mov<0x140>(v);
    return v;
}
__device__ __forceinline__ float xsum_16_32(float v) { v = swap16_sum(v, v); return swap32_sum(v, v); }
__device__ __forceinline__ float wave_sum(float v) { return xsum_16_32(row_sum16(v)); }
__device__ __forceinline__ float reduce_scatter16(const float (&a)[16], int lane) {
    float b8[8], c4[4], d2[2], e1;
#pragma unroll
    for (int i = 0; i < 8; ++i) b8[i] = swap32_sum(a[i], a[i + 8]);
#pragma unroll
    for (int i = 0; i < 4; ++i) c4[i] = swap16_sum(b8[i], b8[i + 4]);
    { const bool hi = (lane & 8) != 0;
#pragma unroll
      for (int i = 0; i < 2; ++i) { const float snd = hi ? c4[i] : c4[i + 2], kp = hi ? c4[i + 2] : c4[i]; d2[i] = kp + dpp_mov<0x128>(snd); } }
    { const bool hi = (lane & 4) != 0; const float snd = hi ? d2[0] : d2[1], kp = hi ? d2[1] : d2[0]; e1 = kp + dpp_mov<0x1B>(dpp_mov<0x141>(snd)); }
    e1 += dpp_mov<0x4E>(e1); e1 += dpp_mov<0xB1>(e1);
    return e1;
}
#define LDS_WAIT() asm volatile("s_waitcnt lgkmcnt(0)" ::: "memory")

__device__ __forceinline__ f32x4 mma_rc(f32x4 acc, bf16x8 a_rows, bf16x8 b_cols) { return __builtin_amdgcn_mfma_f32_16x16x32_bf16(b_cols, a_rows, acc, 0, 0, 0); }
__device__ __forceinline__ f32x4 mma_cr(f32x4 acc, bf16x8 a_rows, bf16x8 b_cols) { return __builtin_amdgcn_mfma_f32_16x16x32_bf16(a_rows, b_cols, acc, 0, 0, 0); }
__device__ __forceinline__ bf16x8 gfrag(const bf16_t* base, int pitch, int lane) { return *(const bf16x8*)(base + (size_t)(lane & 15) * pitch + 8 * (lane >> 4)); }
__device__ __forceinline__ bf16x8 lfrag(const LAS bf16_t* base, int pitch, int lane) { return *(const LAS bf16x8*)(base + (lane & 15) * pitch + 8 * (lane >> 4)); }

namespace pg8 {
#define PG8_LAS __attribute__((address_space(3)))
constexpr int BM = 256, BK = 64, HALF = 128, HTB = HALF * BK * 2, STAGE_BYTES = 8 * HTB, NXCD = 8, WGM = 8;
__host__ __device__ __forceinline__ int lds_byte(int r, int c) { const int st = (r >> 4) * 2 + (c >> 5), rr = r & 15, cc = c & 31, ob = rr * 64 + cc * 2; return st * 1024 + (ob ^ (((ob >> 9) & 1) << 5)); }
__host__ __device__ __forceinline__ void stage_rc(int b, int& R, int& C) { const int st = b / 1024, sb = b % 1024, swz = sb ^ (((sb >> 9) & 1) << 5); R = (st >> 1) * 16 + swz / 64; C = (st & 1) * 32 + (swz % 64) / 2; }
__host__ __device__ __forceinline__ int perm32(int rho) { const int n = rho >> 4, i = rho & 15; return 8 * (i >> 2) + 4 * n + (i & 3); }

struct Unit { int pm, pn; };
struct Gemm { const bf16_t* A; const bf16_t* Bt; int M, N, K; };
struct StaticOrder {
    int nM, nN, nwg, G, c;
    __host__ __device__ void init(int M, int N, int G_, int c_) { nM = M / BM; nN = N / BM; nwg = nM * nN; G = G_; c = c_; }
    __host__ __device__ bool next(int i, Unit& u) const {
        const long L = (long)i * G + c; if (L >= nwg) return false;
        int wgid = (int)L; { const int q = nwg / NXCD, r = nwg % NXCD, xcd = wgid % NXCD, off = wgid / NXCD; wgid = (xcd < r ? xcd * (q + 1) : r * (q + 1) + (xcd - r) * q) + off; }
        const int nig = WGM * nN, gid = wgid / nig, fm = gid * WGM, gsz = (nM - fm) < WGM ? (nM - fm) : WGM;
        u.pm = fm + ((wgid % nig) % gsz); u.pn = (wgid % nig) / gsz; return true;
    }
    __device__ __forceinline__ void a_ready(const Unit&) const {}
    __device__ __forceinline__ void done(const Unit&) const {}
};

struct PairOrder {
    int G, c;
    __device__ __forceinline__ bool next(int i, Unit& u) const { const int pair = (i >> 1) * G + c; if (pair >= 256) return false; u.pm = pair >> 2; u.pn = 2 * (pair & 3) + (i & 1); return true; }
    __device__ __forceinline__ void a_ready(const Unit&) const {}
    __device__ __forceinline__ void done(const Unit&) const {}
};
template <class Epi, class Sched, bool ALIGN_EPI = false, bool SP2 = false>
__device__ __forceinline__ void gemm_phase(PG8_LAS unsigned char* lds, const Gemm g, const Sched& S, const Epi& E, int tid) {
    const int wid = __builtin_amdgcn_readfirstlane(tid >> 6), lane = tid & 63, wr = wid >> 2, wc = wid & 3, fr = lane & 15, fq = lane >> 4;
    const int K = g.K, nt = K / BK;
    unsigned voffA[2], voffB[2];
#pragma unroll
    for (int i = 0; i < 2; ++i) { int R, C; stage_rc(tid * 16 + i * 8192, R, C); const int Rb = Epi::PERM ? ((R & ~31) + perm32(R & 31)) : R;
        voffA[i] = (unsigned)(R * K + C) * 2u; voffB[i] = (unsigned)(Rb * K + C) * 2u; }
    const size_t kstep = (size_t)(BK * 2);
    const size_t hstep = (size_t)HALF * K * 2;
    const size_t tstep = 2 * hstep;
    const unsigned ldsw = (unsigned)wid * 1024u;
    const int aoff = lds_byte(wr * 64 + fr, fq * 8), boff = lds_byte(wc * 32 + fr, fq * 8);
#define PG8_SA(b, h) (((b) * 2 + (h)) * HTB)
#define PG8_SB(b, h) ((4 + (b) * 2 + (h)) * HTB)
#define PG8_STAGE(bufoff, gbase, voff) do { _Pragma("unroll") for (int _i = 0; _i < 2; ++_i) \
        __builtin_amdgcn_global_load_lds((const unsigned*)((const char*)(gbase) + (voff)[_i]), (PG8_LAS unsigned*)(lds + (bufoff) + ldsw + _i * 8192), 16, 0, 0); } while (0)
#define PG8_LDA(dst, b, h) do { _Pragma("unroll") for (int m = 0; m < 4; ++m) _Pragma("unroll") for (int k = 0; k < 2; ++k) dst[m][k] = *(const PG8_LAS bf16x8*)(lds + PG8_SA(b, h) + aoff + m * 2048 + k * 1024); } while (0)
#define PG8_LDB(dst, b, h) do { _Pragma("unroll") for (int n = 0; n < 2; ++n) _Pragma("unroll") for (int k = 0; k < 2; ++k) dst[n][k] = *(const PG8_LAS bf16x8*)(lds + PG8_SB(b, h) + boff + n * 2048 + k * 1024); } while (0)
#define PG8_MMA(ai, bj, At, Bt) do { __builtin_amdgcn_s_setprio(1); _Pragma("unroll") for (int m = 0; m < 4; ++m) _Pragma("unroll") for (int n = 0; n < 2; ++n) _Pragma("unroll") for (int k = 0; k < 2; ++k) \
        acc[ai][bj][m][n] = __builtin_amdgcn_mfma_f32_16x16x32_bf16(Bt[n][k], At[m][k], acc[ai][bj][m][n], 0, 0, 0); __builtin_amdgcn_s_setprio(0); } while (0)
#define PG8_WAIT_V(n) asm volatile("s_waitcnt vmcnt(" #n ")" ::: "memory")
#define PG8_WAIT_L(n) asm volatile("s_waitcnt lgkmcnt(" #n ")" ::: "memory")
#define PG8_BAR __builtin_amdgcn_s_barrier()
#define PG8_SCHED __builtin_amdgcn_sched_barrier(0)
    Unit cur, nxt; int ui = 0;
    if (!S.next(0, cur)) return;
    f32x4 acc[2][2][4][2];
#pragma unroll
    for (int a = 0; a < 2; ++a)
#pragma unroll
        for (int b = 0; b < 2; ++b)
#pragma unroll
            for (int m = 0; m < 4; ++m)
#pragma unroll
                for (int n = 0; n < 2; ++n) acc[a][b][m][n] = (f32x4){0.f, 0.f, 0.f, 0.f};
    bf16x8 At[4][2], B0[2][2], B1[2][2];
    const char* cA = (const char*)g.A + (size_t)cur.pm * tstep; const char* cB = (const char*)g.Bt + (size_t)cur.pn * tstep;
    S.a_ready(cur);
    if constexpr (SP2) {
        PG8_STAGE(PG8_SB(0, 0), cB, voffB); PG8_STAGE(PG8_SB(0, 1), cB + hstep, voffB); PG8_STAGE(PG8_SA(0, 0), cA, voffA); PG8_STAGE(PG8_SA(0, 1), cA + hstep, voffA);
        if (wr == 1) PG8_BAR;
        PG8_WAIT_V(2); PG8_BAR;
        PG8_STAGE(PG8_SB(1, 0), cB + kstep, voffB); PG8_STAGE(PG8_SA(1, 0), cA + kstep, voffA); PG8_STAGE(PG8_SB(1, 1), cB + hstep + kstep, voffB);
        PG8_WAIT_V(6); PG8_BAR;
    } else {
        PG8_STAGE(PG8_SB(0, 0), cB, voffB); PG8_STAGE(PG8_SA(0, 0), cA, voffA); PG8_STAGE(PG8_SB(0, 1), cB + hstep, voffB); PG8_STAGE(PG8_SA(0, 1), cA + hstep, voffA);
        if (wr == 1) PG8_BAR;
        PG8_WAIT_V(4); PG8_BAR;
        PG8_STAGE(PG8_SB(1, 0), cB + kstep, voffB); PG8_STAGE(PG8_SA(1, 0), cA + kstep, voffA); PG8_STAGE(PG8_SB(1, 1), cB + hstep + kstep, voffB);
        PG8_WAIT_V(6); PG8_BAR;
    }
    for (;;) {
        const bool has_next = S.next(ui + 1, nxt);
        const char* nA = has_next ? (const char*)g.A + (size_t)nxt.pm * tstep : cA; const char* nB = has_next ? (const char*)g.Bt + (size_t)nxt.pn * tstep : cB;
        for (int t = 0; t < nt; t += 2) {
            const bool last = (t == nt - 2);
            const char* a1 = cA + (size_t)(t + 1) * kstep;
            const char* a2 = last ? nA : cA + (size_t)(t + 2) * kstep; const char* b2 = last ? nB : cB + (size_t)(t + 2) * kstep;
            const char* a3 = a2 + kstep; const char* b3 = b2 + kstep;
            if (last && has_next) S.a_ready(nxt);
            if constexpr (SP2) {
            PG8_LDB(B0, 0, 0); PG8_LDB(B1, 0, 1); PG8_SCHED; PG8_LDA(At, 0, 0); PG8_STAGE(PG8_SA(1, 1), a1 + hstep, voffA);
            PG8_WAIT_V(8); PG8_WAIT_L(0); PG8_BAR; PG8_MMA(0, 0, At, B0); PG8_MMA(0, 1, At, B1); PG8_BAR; PG8_SCHED;
            PG8_LDA(At, 0, 1); PG8_STAGE(PG8_SB(0, 0), b2, voffB); PG8_STAGE(PG8_SB(0, 1), b2 + hstep, voffB); PG8_STAGE(PG8_SA(0, 0), a2, voffA);
            PG8_WAIT_V(8); PG8_WAIT_L(0); PG8_BAR; PG8_MMA(1, 0, At, B0); PG8_MMA(1, 1, At, B1); PG8_BAR; PG8_SCHED;
            PG8_LDB(B0, 1, 0); PG8_LDB(B1, 1, 1); PG8_SCHED; PG8_LDA(At, 1, 0); PG8_STAGE(PG8_SA(0, 1), a2 + hstep, voffA);
            PG8_WAIT_V(8); PG8_WAIT_L(0); PG8_BAR; PG8_MMA(0, 0, At, B0); PG8_MMA(0, 1, At, B1); PG8_BAR; PG8_SCHED;
            PG8_LDA(At, 1, 1); PG8_STAGE(PG8_SB(1, 0), b3, voffB); PG8_STAGE(PG8_SB(1, 1), b3 + hstep, voffB); PG8_STAGE(PG8_SA(1, 0), a3, voffA);
            PG8_WAIT_V(8); PG8_WAIT_L(0); PG8_BAR; PG8_MMA(1, 0, At, B0); PG8_MMA(1, 1, At, B1); PG8_BAR; PG8_SCHED;
            } else {
            PG8_LDB(B0, 0, 0); PG8_SCHED; PG8_LDA(At, 0, 0); PG8_STAGE(PG8_SA(1, 1), a1 + hstep, voffA);
            PG8_WAIT_L(8); PG8_BAR; PG8_WAIT_L(0); PG8_MMA(0, 0, At, B0); PG8_BAR; PG8_SCHED;
            PG8_LDB(B1, 0, 1); PG8_STAGE(PG8_SB(0, 0), b2, voffB);
            PG8_BAR; PG8_WAIT_L(0); PG8_MMA(0, 1, At, B1); PG8_BAR;
            PG8_LDA(At, 0, 1); PG8_STAGE(PG8_SA(0, 0), a2, voffA);
            PG8_BAR; PG8_WAIT_L(0); PG8_MMA(1, 0, At, B0); PG8_BAR; PG8_SCHED;
            PG8_STAGE(PG8_SB(0, 1), b2 + hstep, voffB);
            PG8_WAIT_V(6); PG8_BAR; PG8_MMA(1, 1, At, B1); PG8_BAR;
            PG8_LDB(B0, 1, 0); PG8_SCHED; PG8_LDA(At, 1, 0); PG8_STAGE(PG8_SA(0, 1), a2 + hstep, voffA);
            PG8_WAIT_L(8); PG8_BAR; PG8_WAIT_L(0); PG8_MMA(0, 0, At, B0); PG8_BAR; PG8_SCHED;
            PG8_LDB(B1, 1, 1); PG8_STAGE(PG8_SB(1, 0), b3, voffB);
            PG8_BAR; PG8_WAIT_L(0); PG8_MMA(0, 1, At, B1); PG8_BAR;
            PG8_LDA(At, 1, 1); PG8_STAGE(PG8_SA(1, 0), a3, voffA);
            PG8_BAR; PG8_WAIT_L(0); PG8_MMA(1, 0, At, B0); PG8_BAR; PG8_SCHED;
            PG8_STAGE(PG8_SB(1, 1), b3 + hstep, voffB);
            PG8_WAIT_V(6); PG8_BAR; PG8_MMA(1, 1, At, B1); PG8_BAR;
            }
        }
        if constexpr (ALIGN_EPI) { if (wr == 0) PG8_BAR; }
        E(acc, cur, wr, wc, fr, fq); S.done(cur);
        if (!has_next) break;
#pragma unroll
        for (int a = 0; a < 2; ++a)
#pragma unroll
            for (int b = 0; b < 2; ++b)
#pragma unroll
                for (int m = 0; m < 4; ++m)
#pragma unroll
                    for (int n = 0; n < 2; ++n) acc[a][b][m][n] = (f32x4){0.f, 0.f, 0.f, 0.f};
        cur = nxt; cA = nA; cB = nB; ++ui;
        if constexpr (ALIGN_EPI) { if (wr == 1) PG8_BAR; }
    }
    PG8_WAIT_V(0);
    if constexpr (!ALIGN_EPI) { if (wr == 0) PG8_BAR; }
    PG8_BAR;
#undef PG8_SA
#undef PG8_SB
#undef PG8_STAGE
#undef PG8_LDA
#undef PG8_LDB
#undef PG8_MMA
#undef PG8_WAIT_V
#undef PG8_WAIT_L
#undef PG8_BAR
#undef PG8_SCHED
}
}

struct Params {
    const float* x; const float* c; const int* pos; const float* mod_w; const float* mod_b; const float* norm_g;
    const float* ret_w_in; const float* ret_w_out; const float* fox_w_in; const float* fox_b_f; const float* fox_q_gain; const float* fox_k_gain; const float* fox_w_out;
    const float* gla_w_in; const float* gla_w_gate2; const float* gla_b_gate; const float* gla_w_out; const float* final_g;
    float* out; unsigned char* ws;
};

template <int DK> __device__ __forceinline__ size_t frag_img_off(int row, int head, int ch0) {
    const int b = row >> 12, tok = row & 4095;
    return (size_t)((b * 4 + head) * 64 + (tok >> 6)) * (64 * DK * 2) + (size_t)((((ch0 >> 5) * 4 + ((tok >> 4) & 3)) * 64 + 16 * ((ch0 >> 3) & 3) + (tok & 15)) * 16 + 2 * (ch0 & 7));
}
template <int HV> __device__ __forceinline__ size_t v_img_off(int row, int col) {
    const int b = row >> 12, tok = row & 4095, head = col / HV, e = col % HV;
    return ((size_t)((b * 4 + head) * (HV / 32) + (e >> 5)) * 4096 + tok) * 64 + (size_t)((e & 31) * 2);
}
struct EpiRetIn {
    static constexpr bool PERM = true;
    bf16_t* Q; bf16_t* Kb; bf16_t* V; const unsigned* rope;
    __device__ __forceinline__ void operator()(const f32x4 (&acc)[2][2][4][2], const pg8::Unit& u, int wr, int wc, int fr, int fq) const {
        const int pn = u.pn;
        if (pn < 8) {
            bf16_t* dst = (pn < 4) ? Q : Kb; const int head = pn & 3; const float sc = (pn < 4) ? 0.0625f : 1.0f;
#pragma unroll
            for (int ai = 0; ai < 2; ++ai) {
                u32x4 cs[4][2];
#pragma unroll
                for (int m = 0; m < 4; ++m)
#pragma unroll
                    for (int n = 0; n < 2; ++n) cs[m][n] = *(const u32x4*)(rope + (size_t)(u.pm * 256 + ai * 128 + wr * 64 + m * 16 + fr) * 128 + wc * 32 + fq * 8 + n * 4);
                asm volatile("" ::: "memory");
#pragma unroll
                for (int m = 0; m < 4; ++m) {
                    const int row = u.pm * 256 + ai * 128 + wr * 64 + m * 16 + fr;
                    u32x4 w1, w2;
#pragma unroll
                    for (int n = 0; n < 2; ++n) {
                        const f32x4 x1 = acc[ai][0][m][n], x2 = acc[ai][1][m][n]; f32x4 o1, o2;
#pragma unroll
                        for (int j = 0; j < 4; ++j) {
                            const unsigned w = cs[m][n][j];
                            const float co = (float)__builtin_bit_cast(_Float16, (unsigned short)(w & 0xffffu)), si = (float)__builtin_bit_cast(_Float16, (unsigned short)(w >> 16));
                            o1[j] = (x1[j] * co - x2[j] * si) * sc; o2[j] = (x1[j] * si + x2[j] * co) * sc;
                        }
                        const u32x2 a1 = pk4(o1), a2 = pk4(o2);
                        if (n == 0) { w1.x = a1.x; w1.y = a1.y; w2.x = a2.x; w2.y = a2.y; } else { w1.z = a1.x; w1.w = a1.y; w2.z = a2.x; w2.w = a2.y; }
                    }
                    char* p = (char*)dst + frag_img_off<256>(row, head, wc * 32 + fq * 8);
                    *(u32x4*)p = w1; *(u32x4*)(p + 16384) = w2;
                }
            }
        } else {
            const int cbase = (pn - 8) * 256;
#pragma unroll
            for (int ai = 0; ai < 2; ++ai)
#pragma unroll
                for (int m = 0; m < 4; ++m) {
                    const int row = u.pm * 256 + ai * 128 + wr * 64 + m * 16 + fr;
#pragma unroll
                    for (int bj = 0; bj < 2; ++bj) { const u32x2 a0 = pk4(acc[ai][bj][m][0]), a1 = pk4(acc[ai][bj][m][1]);
                        *(u32x4*)((char*)V + v_img_off<512>(row, cbase + bj * 128 + wc * 32 + fq * 8)) = (u32x4){a0.x, a0.y, a1.x, a1.y}; }
                }
        }
    }
};
struct EpiSplit {
    static constexpr bool PERM = false;
    bf16_t* dst; int tpg; size_t gstride; int ldc; int silu_grp;
    __device__ __forceinline__ void operator()(const f32x4 (&acc)[2][2][4][2], const pg8::Unit& u, int wr, int wc, int fr, int fq) const {
        const int t = u.pn / tpg; bf16_t* base = dst + (size_t)t * gstride; const int cb = (u.pn - t * tpg) * 256; const bool act = (t == silu_grp);
#pragma unroll
        for (int ai = 0; ai < 2; ++ai)
#pragma unroll
            for (int m = 0; m < 4; ++m) {
                const int row = u.pm * 256 + ai * 128 + wr * 64 + m * 16 + fr;
#pragma unroll
                for (int bj = 0; bj < 2; ++bj)
#pragma unroll
                    for (int n = 0; n < 2; ++n) {
                        f32x4 a = acc[ai][bj][m][n];
                        if (act) {
#pragma unroll
                            for (int j = 0; j < 4; ++j) a[j] = silu_f(a[j]);
                        }
                        *(u32x2*)(base + (size_t)row * ldc + cb + bj * 128 + wc * 32 + n * 16 + fq * 4) = pk4(a);
                    }
            }
    }
};
struct EpiFoxIn {
    static constexpr bool PERM = false;
    bf16_t* dst; const float* qgain; const float* kgain; LAS float* tbl;
    __device__ __forceinline__ void operator()(const f32x4 (&acc)[2][2][4][2], const pg8::Unit& u, int wr, int wc, int fr, int fq) const {
        const int t = u.pn >> 2; bf16_t* base = dst + (size_t)t * ((size_t)16 * MiB); const int cb = (u.pn & 3) * 256;
        if (t < 2) {
#pragma unroll
            for (int ai = 0; ai < 2; ++ai)
#pragma unroll
                for (int m = 0; m < 4; ++m)
#pragma unroll
                    for (int bj = 0; bj < 2; ++bj) {
                        float sq = 0.f;
#pragma unroll
                        for (int n = 0; n < 2; ++n) { const f32x4 a = acc[ai][bj][m][n]; sq += (a[0] * a[0] + a[1] * a[1]) + (a[2] * a[2] + a[3] * a[3]); }
                        sq = xsum_16_32(sq);
                        if (fq == 0) tbl[(((ai * 128 + wr * 64 + m * 16 + fr) * 4) + bj * 2 + (wc >> 1)) * 2 + (wc & 1)] = sq;
                    }
            asm volatile("s_waitcnt lgkmcnt(0)" ::: "memory"); __builtin_amdgcn_s_barrier(); asm volatile("" ::: "memory");
            const float* gn = (t == 0) ? qgain : kgain; const float sc = (t == 0) ? (0.125f * LOG2E) : 1.0f;
            f32x4 gv[2];
#pragma unroll
            for (int n = 0; n < 2; ++n) gv[n] = *(const f32x4*)(gn + (wc & 1) * 32 + n * 16 + fq * 4) * sc;
#pragma unroll
            for (int ai = 0; ai < 2; ++ai)
#pragma unroll
                for (int m = 0; m < 4; ++m) {
                    const int rl = ai * 128 + wr * 64 + m * 16 + fr; const int row = u.pm * 256 + rl;
#pragma unroll
                    for (int bj = 0; bj < 2; ++bj) {
                        const f32x2 pr = *(const LAS f32x2*)(tbl + ((rl * 4) + bj * 2 + (wc >> 1)) * 2);
                        const float rstd = __builtin_amdgcn_rsqf((pr.x + pr.y) * (1.0f / 64.0f) + EPS);
#pragma unroll
                        for (int n = 0; n < 2; ++n) *(u32x2*)(base + (size_t)row * 1024 + cb + bj * 128 + wc * 32 + n * 16 + fq * 4) = pk4(acc[ai][bj][m][n] * rstd * gv[n]);
                    }
                }
        } else {
            const bool act = (t == 3);
#pragma unroll
            for (int ai = 0; ai < 2; ++ai)
#pragma unroll
                for (int m = 0; m < 4; ++m) {
                    const int row = u.pm * 256 + ai * 128 + wr * 64 + m * 16 + fr;
#pragma unroll
                    for (int bj = 0; bj < 2; ++bj)
#pragma unroll
                        for (int n = 0; n < 2; ++n) {
                            f32x4 a = acc[ai][bj][m][n];
                            if (act) {
#pragma unroll
                                for (int j = 0; j < 4; ++j) a[j] = silu_f(a[j]);
                            }
                            *(u32x2*)(base + (size_t)row * 1024 + cb + bj * 128 + wc * 32 + n * 16 + fq * 4) = pk4(a);
                        }
                }
        }
    }
};
struct EpiGlaIn {
    static constexpr bool PERM = true;
    bf16_t *QE, *QN, *KE, *KN, *V, *G; const float* CB;
    __device__ __forceinline__ void operator()(const f32x4 (&acc)[2][2][4][2], const pg8::Unit& u, int wr, int wc, int fr, int fq) const {
        const int pn = u.pn;
        if (pn < 4) {
            const float s = (pn < 2) ? 0.08838834764831845f : 1.0f;
            bf16_t* De = (pn < 2 ? QE : KE); bf16_t* Dn = (pn < 2 ? QN : KN);
#pragma unroll
            for (int ai = 0; ai < 2; ++ai)
#pragma unroll
            for (int mh = 0; mh < 2; ++mh) {
                f32x4 cb[2][2][2];
#pragma unroll
                for (int mm = 0; mm < 2; ++mm)
#pragma unroll
                    for (int bj = 0; bj < 2; ++bj)
#pragma unroll
                        for (int n = 0; n < 2; ++n) cb[mm][bj][n] = *(const f32x4*)(CB + (size_t)(u.pm * 256 + ai * 128 + wr * 64 + (2 * mh + mm) * 16 + fr) * 512 + (pn & 1) * 256 + bj * 128 + wc * 32 + fq * 8 + n * 4);
                asm volatile("" ::: "memory");
#pragma unroll
                for (int mm = 0; mm < 2; ++mm) {
                    const int m = 2 * mh + mm; const int row = u.pm * 256 + ai * 128 + wr * 64 + m * 16 + fr;
#pragma unroll
                    for (int bj = 0; bj < 2; ++bj) {
                        u32x4 we, wn;
#pragma unroll
                        for (int n = 0; n < 2; ++n) {
                            const f32x4 a = acc[ai][bj][m][n]; f32x4 e, en;
#pragma unroll
                            for (int j = 0; j < 4; ++j) { const float ee = __expf(cb[mm][bj][n][j]); e[j] = a[j] * s * ee; en[j] = a[j] * s * __builtin_amdgcn_rcpf(ee); }
                            const u32x2 a1 = pk4(e), a2 = pk4(en);
                            if (n == 0) { we.x = a1.x; we.y = a1.y; wn.x = a2.x; wn.y = a2.y; } else { we.z = a1.x; we.w = a1.y; wn.z = a2.x; wn.w = a2.y; }
                        }
                        const size_t io = frag_img_off<128>(row, (pn & 1) * 2 + bj, wc * 32 + fq * 8);
                        *(u32x4*)((char*)De + io) = we; *(u32x4*)((char*)Dn + io) = wn;
                    }
                }
                asm volatile("" ::: "memory");
            }
        } else {
#pragma unroll
            for (int ai = 0; ai < 2; ++ai)
#pragma unroll
                for (int m = 0; m < 4; ++m) {
                    const int row = u.pm * 256 + ai * 128 + wr * 64 + m * 16 + fr;
#pragma unroll
                    for (int bj = 0; bj < 2; ++bj) { const u32x2 a0 = pk4(acc[ai][bj][m][0]), a1 = pk4(acc[ai][bj][m][1]);
                        *(u32x4*)((char*)V + v_img_off<256>(row, (pn - 4) * 256 + bj * 128 + wc * 32 + fq * 8)) = (u32x4){a0.x, a0.y, a1.x, a1.y}; }
                }
        }
    }
};
struct EpiNone {
    static constexpr bool PERM = false; float* sink;
    __device__ __forceinline__ void operator()(const f32x4 (&acc)[2][2][4][2], const pg8::Unit& u, int wr, int wc, int fr, int fq) const {
        f32x4 t = acc[0][0][0][0];
#pragma unroll
        for (int ai = 0; ai < 2; ++ai)
#pragma unroll
            for (int bj = 0; bj < 2; ++bj)
#pragma unroll
                for (int m = 0; m < 4; ++m)
#pragma unroll
                    for (int n = 0; n < 2; ++n) t += acc[ai][bj][m][n];
        if (t[0] + t[1] + t[2] + t[3] == 12345.678f) sink[0] = t[0];
    }
};
struct EpiOut {
    static constexpr bool PERM = false;
    const float* xold; float* xnew; const float* gate;
    __device__ __forceinline__ void operator()(const f32x4 (&acc)[2][2][4][2], const pg8::Unit& u, int wr, int wc, int fr, int fq) const {
        const int b = (u.pm * 256) >> 12;
        f32x4 gv[2][2];
#pragma unroll
        for (int bj = 0; bj < 2; ++bj)
#pragma unroll
            for (int n = 0; n < 2; ++n) gv[bj][n] = *(const f32x4*)(gate + (size_t)b * 3072 + u.pn * 256 + bj * 128 + wc * 32 + n * 16 + fq * 4);
#pragma unroll
        for (int ai = 0; ai < 2; ++ai)
#pragma unroll
            for (int mh = 0; mh < 2; ++mh) {
                f32x4 xo[2][2][2];
#pragma unroll
                for (int mm = 0; mm < 2; ++mm)
#pragma unroll
                    for (int bj = 0; bj < 2; ++bj)
#pragma unroll
                        for (int n = 0; n < 2; ++n) xo[mm][bj][n] = *(const f32x4*)(xold + (size_t)(u.pm * 256 + ai * 128 + wr * 64 + (2 * mh + mm) * 16 + fr) * 1024 + u.pn * 256 + bj * 128 + wc * 32 + n * 16 + fq * 4);
                asm volatile("" ::: "memory");
#pragma unroll
                for (int mm = 0; mm < 2; ++mm)
#pragma unroll
                    for (int bj = 0; bj < 2; ++bj)
#pragma unroll
                        for (int n = 0; n < 2; ++n)
                            *(f32x4*)(xnew + (size_t)(u.pm * 256 + ai * 128 + wr * 64 + (2 * mh + mm) * 16 + fr) * 1024 + u.pn * 256 + bj * 128 + wc * 32 + n * 16 + fq * 4) = xo[mm][bj][n] + gv[bj][n] * acc[ai][bj][2 * mh + mm][n];
                asm volatile("" ::: "memory");
            }
    }
};

__device__ __forceinline__ void transpose_item(const float* W, int ldw, int K, int nblk, bf16_t* WT, LAS float* scr, int item, int lane) {
    const int kb = item / nblk, nb = item % nblk, k0 = 64 * kb, n0 = 32 * nb;
#pragma unroll 8
    for (int i = 0; i < 32; ++i) { const int kk = 2 * i + (lane >> 5); scr[kk * 33 + (lane & 31)] = W[(size_t)(k0 + kk) * ldw + n0 + (lane & 31)]; }
    LDS_WAIT(); asm volatile("" ::: "memory");
    const int c = lane & 7;
#pragma unroll
    for (int j = 0; j < 4; ++j) { const int n = (lane >> 3) + 8 * j; const LAS float* s = scr + (8 * c) * 33 + n;
        u32x4 o; o.x = pk2(s[0 * 33], s[1 * 33]); o.y = pk2(s[2 * 33], s[3 * 33]); o.z = pk2(s[4 * 33], s[5 * 33]); o.w = pk2(s[6 * 33], s[7 * 33]);
        *(u32x4*)(WT + (size_t)(n0 + n) * K + k0 + 8 * c) = o; }
    LDS_WAIT(); asm volatile("" ::: "memory");
}
__device__ __forceinline__ void conv_weights(const float* w_in, int ld_in, int n_in, const float* w_out, int k_out, unsigned char* wdst, LAS unsigned char* lds, int tid, int bid, int G) {
    const int lane = tid & 63, wave = tid >> 6;
    LAS float* scr = (LAS float*)(lds + wave * 16384);
    const int gw = bid * 8 + wave, NGW = G * 8;
    const int I_in = (1024 / 64) * (n_in / 32), I_out = (k_out / 64) * (1024 / 32);
    bf16_t* WinT = (bf16_t*)wdst; bf16_t* WoutT = (bf16_t*)(wdst + 12 * MiB);
    for (int it = gw; it < I_in + I_out; it += NGW) {
        if (it < I_in) transpose_item(w_in, ld_in, 1024, n_in / 32, WinT, scr, it, lane);
        else transpose_item(w_out, 1024, k_out, 32, WoutT, scr, it - I_in, lane);
    }
}
__device__ __forceinline__ void p0_mod(const Params& P, LAS unsigned char* lds, int tid, int bid, int G) {
    LAS float* sc = (LAS float*)lds;
    LAS float* red = sc + 4096;
    const int lane = tid & 63, wave = tid >> 6;
    float* MOD = (float*)(P.ws + WS_MOD);
    for (int i = tid; i < 4096; i += 512) sc[i] = silu_f(P.c[i]);
    __syncthreads();
    for (int it = bid; it < 192; it += G) {
        const int l = it / 48, cb = it % 48, n = cb * 64 + lane;
        const float* W = P.mod_w + (size_t)l * 1024 * 3072 + n;
        float a0 = 0.f, a1 = 0.f, a2 = 0.f, a3 = 0.f;
        const int k0 = wave * 128;
#pragma unroll 8
        for (int k = k0; k < k0 + 128; ++k) { const float w = W[(size_t)k * 3072]; a0 += sc[k] * w; a1 += sc[1024 + k] * w; a2 += sc[2048 + k] * w; a3 += sc[3072 + k] * w; }
        red[(wave * 4 + 0) * 64 + lane] = a0; red[(wave * 4 + 1) * 64 + lane] = a1; red[(wave * 4 + 2) * 64 + lane] = a2; red[(wave * 4 + 3) * 64 + lane] = a3;
        __syncthreads();
        if (wave < 4) { float s = 0.f;
#pragma unroll
            for (int w = 0; w < 8; ++w) s += red[(w * 4 + wave) * 64 + lane];
            MOD[(size_t)(l * 4 + wave) * 3072 + n] = s + P.mod_b[l * 3072 + n]; }
        __syncthreads();
    }
}
__device__ __forceinline__ void p0_rope(const Params& P, int tid, int bid, int G) {
    unsigned* rope = (unsigned*)(P.ws + WS_ROPE);
    const int gt = bid * 512 + tid, NT = G * 512;
    for (int idx = gt; idx < MT * 128; idx += NT) {
        const int row = idx >> 7, d = idx & 127;
        const float inv = powf(10000.0f, -(float)d * (1.0f / 128.0f));
        const float ang = (float)P.pos[row] * inv;
        double t = (double)ang * 0.15915494309189535; t -= rint(t);
        const float fr = (float)t;
        const float co = __builtin_amdgcn_cosf(fr), si = __builtin_amdgcn_sinf(fr);
        const unsigned lo = __builtin_bit_cast(unsigned short, (_Float16)co), hi = __builtin_bit_cast(unsigned short, (_Float16)si);
        rope[idx] = lo | (hi << 16);
    }
}

template <int KIND>
__device__ __forceinline__ void h_phase(const Params& P, int layer, const float* xin, LAS unsigned char* lds, int tid, int bid, int G) {
    const int lane = tid & 63, wave = tid >> 6;
    LAS float* WxT = (LAS float*)lds;
    LAS float* W2 = (LAS float*)(lds + 65536);
    LAS float* TOT = (LAS float*)(lds + 98304);
    const float* MOD = (const float*)(P.ws + WS_MOD);
    bf16_t* XN = (bf16_t*)(P.ws + WS_XN);
    if (KIND > 0) {
        const float* wsrc = (KIND == 1) ? (P.fox_w_in + 4096) : (P.gla_w_in + 3072); const int ldw = (KIND == 1) ? FOX_IN : GLA_IN;
        {
            float wv[32];
#pragma unroll
            for (int it = 0; it < 32; ++it) { const int idx = tid + 512 * it; wv[it] = wsrc[(size_t)(idx >> 4) * ldw + (idx & 15)]; }
#pragma unroll
            for (int it = 0; it < 32; ++it) { const int idx = tid + 512 * it; WxT[(idx & 15) * 1024 + (idx >> 4)] = wv[it]; }
        }
        if (KIND == 2) {
            float w2v[16];
#pragma unroll
            for (int it = 0; it < 16; ++it) w2v[it] = P.gla_w_gate2[tid + 512 * it];
#pragma unroll
            for (int it = 0; it < 16; ++it) W2[tid + 512 * it] = w2v[it];
        }
        __syncthreads();
    }
    for (int ci = bid; ci < MT / 64; ci += G) {
        const int b = ci >> 6;
        if (KIND != 1) ((float*)(P.ws + WS_S16))[ci * 512 + tid] = 0.f;
        const float* mod = MOD + (size_t)(layer * 4 + b) * 3072;
        f32x4 ga[4], sh[4];
#pragma unroll
        for (int j = 0; j < 4; ++j) { const int col = 4 * lane + 256 * j;
            const f32x4 g4 = *(const f32x4*)(P.norm_g + layer * 1024 + col), s4 = *(const f32x4*)(mod + 1024 + col);
            ga[j] = g4 * (s4 + 1.0f); sh[j] = *(const f32x4*)(mod + col); }
        float run[8]; f32x4 cbv[8][2];
        if (KIND == 2) {
#pragma unroll
            for (int c = 0; c < 8; ++c) run[c] = 0.f;
        }
        if constexpr (false) {
        constexpr int BS = (KIND == 2) ? 2 : 4;
#pragma unroll (KIND == 2 ? 8 / BS : 1)
        for (int rb = 0; rb < 8; rb += BS) {
            asm volatile("" ::: "memory");
            f32x4 xv[BS][4];
#pragma unroll
            for (int bb = 0; bb < BS; ++bb) { const f32x4* xr = (const f32x4*)(xin + (size_t)(ci * 64 + wave * 8 + rb + bb) * 1024) + lane;
#pragma unroll
                for (int j = 0; j < 4; ++j) xv[bb][j] = xr[64 * j]; }
#pragma unroll
        for (int bb = 0; bb < BS; ++bb) {
            const int rr = rb + bb;
            asm volatile("" ::: "memory");
            const int row = ci * 64 + wave * 8 + rr;
            f32x4 v[4]; float ss = 0.f;
#pragma unroll
            for (int j = 0; j < 4; ++j) { v[j] = xv[bb][j]; ss += (v[j][0] * v[j][0] + v[j][1] * v[j][1]) + (v[j][2] * v[j][2] + v[j][3] * v[j][3]); }
            const float rstd = rsqrtf(wave_sum(ss) * (1.0f / 1024.0f) + EPS);
#pragma unroll
            for (int j = 0; j < 4; ++j) { v[j] = (v[j] * rstd) * ga[j] + sh[j]; *(u32x2*)(XN + (size_t)row * 1024 + 4 * lane + 256 * j) = pk4(v[j]); }
            if (KIND > 0) {
                float r[16];
#pragma unroll
                for (int i = 0; i < 16; ++i) { float a = 0.f;
#pragma unroll
                    for (int j = 0; j < 4; ++j) { const f32x4 w = *(const LAS f32x4*)(WxT + i * 1024 + 4 * lane + 256 * j); a += (v[j][0] * w[0] + v[j][1] * w[1]) + (v[j][2] * w[2] + v[j][3] * w[3]); }
                    r[i] = a; }
                if (KIND == 1) {
                    const float e1 = reduce_scatter16(r, lane);
                    const int idx = ((lane >> 5) & 1) * 8 + ((lane >> 4) & 1) * 4 + ((lane >> 3) & 1) * 2 + ((lane >> 2) & 1);
                    if ((lane & 3) == 0) ((float*)(P.ws + WS_S16))[(size_t)row * 16 + idx] = logsig_f(e1 + P.fox_b_f[idx]);
                } else {
                    f32x4 z0 = *(const f32x4*)(P.gla_b_gate + 8 * lane), z1 = *(const f32x4*)(P.gla_b_gate + 8 * lane + 4);
#pragma unroll
                    for (int i = 0; i < 16; ++i) { const f32x4 w0 = *(const LAS f32x4*)(W2 + i * 512 + 8 * lane), w1 = *(const LAS f32x4*)(W2 + i * 512 + 8 * lane + 4); z0 += w0 * r[i]; z1 += w1 * r[i]; }
#pragma unroll
                    for (int c = 0; c < 4; ++c) { run[c] += logsig_f(z0[c]) * 0.0625f; run[4 + c] += logsig_f(z1[c]) * 0.0625f; }
                    cbv[rr][0] = (f32x4){run[0], run[1], run[2], run[3]}; cbv[rr][1] = (f32x4){run[4], run[5], run[6], run[7]};
                }
            }
        }
        }
        } else {
        constexpr int BS = (KIND == 2) ? 2 : 4;
#pragma unroll (KIND != 0 ? 8 / BS : 1)
        for (int rb = 0; rb < 8; rb += BS) {
            asm volatile("" ::: "memory");
            f32x4 v[BS][4];
#pragma unroll
            for (int bb = 0; bb < BS; ++bb) { const f32x4* xr = (const f32x4*)(xin + (size_t)(ci * 64 + wave * 8 + rb + bb) * 1024) + lane;
#pragma unroll
                for (int j = 0; j < 4; ++j) v[bb][j] = xr[64 * j]; }
#pragma unroll
            for (int bb = 0; bb < BS; ++bb) {
                const int row = ci * 64 + wave * 8 + rb + bb; float ss = 0.f;
#pragma unroll
                for (int j = 0; j < 4; ++j) ss += (v[bb][j][0] * v[bb][j][0] + v[bb][j][1] * v[bb][j][1]) + (v[bb][j][2] * v[bb][j][2] + v[bb][j][3] * v[bb][j][3]);
                const float rstd = rsqrtf(wave_sum(ss) * (1.0f / 1024.0f) + EPS);
#pragma unroll
                for (int j = 0; j < 4; ++j) { v[bb][j] = (v[bb][j] * rstd) * ga[j] + sh[j]; *(u32x2*)(XN + (size_t)row * 1024 + 4 * lane + 256 * j) = pk4(v[bb][j]); }
            }
            if (KIND > 0) {
                float acc[BS][16];
#pragma unroll
                for (int i = 0; i < 16; ++i) {
                    f32x4 w[4];
#pragma unroll
                    for (int j = 0; j < 4; ++j) w[j] = *(const LAS f32x4*)(WxT + i * 1024 + 4 * lane + 256 * j);
#pragma unroll
                    for (int bb = 0; bb < BS; ++bb) { float a = 0.f;
#pragma unroll
                        for (int j = 0; j < 4; ++j) a += (v[bb][j][0] * w[j][0] + v[bb][j][1] * w[j][1]) + (v[bb][j][2] * w[j][2] + v[bb][j][3] * w[j][3]);
                        acc[bb][i] = a; }
                    if (i & 1) { __builtin_amdgcn_sched_barrier(0); asm volatile("" ::: "memory"); }
                }
#pragma unroll
                for (int bb = 0; bb < BS; ++bb) {
                    const int rr = rb + bb, row = ci * 64 + wave * 8 + rr;
                    asm volatile("" ::: "memory");
                    const float e1 = reduce_scatter16(acc[bb], lane);
                    if (KIND == 1) {
                        const int idx = ((lane >> 5) & 1) * 8 + ((lane >> 4) & 1) * 4 + ((lane >> 3) & 1) * 2 + ((lane >> 2) & 1);
                        ((float*)(P.ws + WS_S16))[(size_t)row * 16 + idx] = logsig_f(e1 + P.fox_b_f[idx]);
                    } else {
                        float r[16];
#pragma unroll
                        for (int i = 0; i < 16; ++i) r[i] = __builtin_bit_cast(float, __builtin_amdgcn_readlane(__builtin_bit_cast(int, e1), ((i >> 3) & 1) * 32 + ((i >> 2) & 1) * 16 + ((i >> 1) & 1) * 8 + (i & 1) * 4));
                        f32x4 z0 = *(const f32x4*)(P.gla_b_gate + 8 * lane), z1 = *(const f32x4*)(P.gla_b_gate + 8 * lane + 4);
#pragma unroll
                        for (int i = 0; i < 16; ++i) { const f32x4 w0 = *(const LAS f32x4*)(W2 + i * 512 + 8 * lane), w1 = *(const LAS f32x4*)(W2 + i * 512 + 8 * lane + 4); z0 += w0 * r[i]; z1 += w1 * r[i]; }
#pragma unroll
                        for (int c = 0; c < 4; ++c) { run[c] += logsig_f(z0[c]) * 0.0625f; run[4 + c] += logsig_f(z1[c]) * 0.0625f; }
                        cbv[rr][0] = (f32x4){run[0], run[1], run[2], run[3]}; cbv[rr][1] = (f32x4){run[4], run[5], run[6], run[7]};
                    }
                }
            }
        }
        }
        if (KIND == 2) {
            float* CB = (float*)(P.ws + WS_ACT + 160 * MiB);
            *(LAS f32x4*)(TOT + wave * 512 + 8 * lane) = (f32x4){run[0], run[1], run[2], run[3]};
            *(LAS f32x4*)(TOT + wave * 512 + 8 * lane + 4) = (f32x4){run[4], run[5], run[6], run[7]};
            __syncthreads();
            f32x4 o0 = (f32x4){0.f, 0.f, 0.f, 0.f}, o1 = o0;
            for (int w = 0; w < wave; ++w) { o0 += *(const LAS f32x4*)(TOT + w * 512 + 8 * lane); o1 += *(const LAS f32x4*)(TOT + w * 512 + 8 * lane + 4); }
#pragma unroll
            for (int rr = 0; rr < 8; ++rr) { const int row = ci * 64 + wave * 8 + rr;
                *(f32x4*)(CB + (size_t)row * 512 + 8 * lane) = cbv[rr][0] + o0; *(f32x4*)(CB + (size_t)row * 512 + 8 * lane + 4) = cbv[rr][1] + o1; }
            __syncthreads();
        }
    }
}

template <int KIND> struct LinCfg {
    static constexpr int DK = KIND == 0 ? 256 : 128, QP = KIND == 0 ? 1024 : 512, VP = KIND == 0 ? 2048 : 1024, HV = KIND == 0 ? 512 : 256;
    static constexpr int NSL = HV / 32, NITEM = 16 * NSL, NKF = DK / 32, RW = DK / 8, NDT = RW / 16, KPITCH = DK * 2 + 32, STP = DK + 8, KCH = DK / 64;
    static constexpr int LDS_ST = 0, LDS_P = 2 * 32 * STP * 2, LDS_V = LDS_P + 2 * 8192, LDS_END = LDS_V + 2 * 2 * 4096;
    static constexpr int NA = DK / 16;
};
__device__ __forceinline__ float ret_log2g(int h) { return (h == 0) ? -0.045803689613124796f : (h == 1) ? -0.02272007650008353f : (h == 2) ? -0.011315313227834146f : -0.005646563141142062f; }

template <int KIND>
__device__ __forceinline__ void lin_pphase(const bf16_t* Qa, bf16_t* Ka, const bf16_t* Qb, const bf16_t* Kb2, bf16_t* Pimg, int tid, int bid, int G) {
    typedef LinCfg<KIND> C;
    const int lane = tid & 63, wave = __builtin_amdgcn_readfirstlane(tid >> 6);
    const int g4 = lane >> 4, i16 = lane & 15;
    bf16x8 idf[2];
#pragma unroll
    for (int sel = 0; sel < 2; ++sel)
#pragma unroll
        for (int j = 0; j < 8; ++j) idf[sel][j] = (short)((8 * g4 + j == i16 + 16 * sel) ? 0x3F80 : 0);
    for (int hw0 = bid * 8; hw0 < 2048; hw0 += G * 8) {
        const int hw = hw0 + wave;
        const int item = hw >> 1, half = hw & 1;
        const int bh = item >> 6, n = item & 63, b = bh >> 2, h = bh & 3;
        const size_t t0 = (size_t)b * SEQ + (size_t)n * 64;
        f32x4 pa[2][4], pb[2][4];
#pragma unroll
        for (int r = 0; r < 2; ++r)
#pragma unroll
            for (int c = 0; c < 4; ++c) { pa[r][c] = (f32x4){0.f, 0.f, 0.f, 0.f}; pb[r][c] = (f32x4){0.f, 0.f, 0.f, 0.f}; }
        constexpr size_t BLK = (size_t)64 * C::DK * 2;
        const char* qa = (const char*)Qa + (size_t)item * BLK + lane * 16; char* ka = (char*)Ka + (size_t)item * BLK + lane * 16;
        const char* qb = (const char*)Qb + (size_t)item * BLK + lane * 16; const char* kb = (const char*)Kb2 + (size_t)item * BLK + lane * 16;
        bf16x8 kall[C::NKF][4];
#pragma unroll
        for (int k = 0; k < C::NKF; ++k)
#pragma unroll
            for (int c = 0; c < 4; ++c) kall[k][c] = *(const bf16x8*)(ka + (k * 4 + c) * 1024);
#pragma unroll
        for (int k = 0; k < C::NKF; ++k) {
            bf16x8 af[2];
#pragma unroll
            for (int r = 0; r < 2; ++r) af[r] = *(const bf16x8*)(qa + (k * 4 + 2 * half + r) * 1024);
#pragma unroll
            for (int r = 0; r < 2; ++r)
#pragma unroll
                for (int c = 0; c < 4; ++c) pa[r][c] = mma_rc(pa[r][c], af[r], kall[k][c]);
            if (KIND == 1) {
                bf16x8 bfr[4];
#pragma unroll
                for (int r = 0; r < 2; ++r) af[r] = *(const bf16x8*)(qb + (k * 4 + 2 * half + r) * 1024);
#pragma unroll
                for (int c = 0; c < 4; ++c) bfr[c] = *(const bf16x8*)(kb + (k * 4 + c) * 1024);
#pragma unroll
                for (int r = 0; r < 2; ++r)
#pragma unroll
                    for (int c = 0; c < 4; ++c) pb[r][c] = mma_rc(pb[r][c], af[r], bfr[c]);
            }
        }
        const float l2g = (KIND == 0) ? ret_log2g(h) : 0.f;
#pragma unroll
        for (int r = 0; r < 2; ++r) {
            const int c = 32 * half + 16 * r + (lane & 15);
#pragma unroll
            for (int ct = 0; ct < 4; ++ct) {
                f32x4 p;
#pragma unroll
                for (int e = 0; e < 4; ++e) { const int mm = 16 * ct + 4 * g4 + e;
                    if (KIND == 0) { const int dd = c > mm ? c - mm : mm - c; p[e] = pa[r][ct][e] * exp2f(l2g * (float)dd); }
                    else p[e] = (c >= mm) ? pa[r][ct][e] : pb[r][ct][e]; }
                const int ks = ct >> 1, gg = 2 * (ct & 1) + (g4 & 1);
                const int off = c * 128 + (((4 * ks + gg) ^ (c & 7)) << 4) + 8 * (g4 >> 1);
                *(u32x2*)((char*)Pimg + (size_t)item * 8192 + off) = pk4(p);
            }
        }
        __syncthreads();
        {
            char* kdst = ka - lane * 16 + (16 * (g4 & 1) + i16) * 16 + 8 * (g4 >> 1);
#define PP_TR(HALF) _Pragma("unroll") for (int k = 0; k < C::NKF; ++k) _Pragma("unroll") for (int sel = 0; sel < 2; ++sel) _Pragma("unroll") for (int T = 0; T < 2; ++T) { \
                const f32x4 tr_ = mma_rc((f32x4){0.f, 0.f, 0.f, 0.f}, idf[sel], kall[k][2 * (HALF) + T]); \
                *(u32x2*)(kdst + ((HALF) * C::NA + 2 * k + sel) * 1024 + T * 512) = pk4(tr_); }
            if (half == 0) { PP_TR(0) } else { PP_TR(1) }
#undef PP_TR
        }
    }
}

typedef short v4i16_t __attribute__((ext_vector_type(4)));
__device__ __forceinline__ bf16x8 trfrag2(const LAS char* p0, int second_off) {
    const v4i16_t a = __builtin_amdgcn_ds_read_tr16_b64_v4i16((LAS v4i16_t*)p0);
    const v4i16_t b = __builtin_amdgcn_ds_read_tr16_b64_v4i16((LAS v4i16_t*)(p0 + second_off));
    return (bf16x8){a[0], a[1], a[2], a[3], b[0], b[1], b[2], b[3]};
}

template <int KIND> struct LsStage { u32x4 x[LinCfg<KIND>::NKF]; u32x4 p; u32x2 v; f32x4 dec[2]; };

template <int KIND, int VAR = 0>
__device__ __forceinline__ void lin_scan(const bf16_t* Qg, const bf16_t* Kg, const bf16_t* Vg, const bf16_t* Pimg, const float* CB, bf16_t* O, float* DUMMY, LAS unsigned char* lds, int tid, int bid, int G) {
    typedef LinCfg<KIND> C;
    const int nit = (G == 256) ? 1 : (C::NITEM + G - 1) / G;
    const int tid0 = tid;
    for (int it = 0; it < nit; ++it) {
        int tid = tid0; asm volatile("" : "+v"(tid));
        const int lane = tid & 63, wave = __builtin_amdgcn_readfirstlane(tid >> 6);
        const int g4 = lane >> 4, i16 = lane & 15, q4 = i16 >> 2, p4 = i16 & 3;
        int item;
        if (G == 256) { const int x = bid & 7, j = bid >> 3; if (KIND == 0) item = x * 32 + j; else { if (j >= 16) break; item = x * 16 + j; } }
        else { item = it * G + bid; if (item >= C::NITEM) break; }
        const int bh = item / C::NSL, dvs = item % C::NSL, b = bh >> 2, h = bh & 3;
        const size_t t0 = (size_t)b * SEQ;
        const int rt = wave & 3; const bool rdw = wave < 4;
        constexpr int RWU = C::DK / 4, NDU = RWU / 16;
        const float l2g = (KIND == 0) ? ret_log2g(h) : 0.f;
        const float qsc = (KIND == 0) ? exp2f(l2g * (float)(16 * rt + i16 + 1)) : 1.0f;
        const float sdec = (KIND == 0) ? exp2f(l2g * 64.0f) : 1.0f;
        const int vm = tid >> 3, vp8 = tid & 7;
        const float vsc = (KIND == 0) ? exp2f(l2g * (float)(63 - vm)) : 1.0f;
        constexpr size_t BLK = (size_t)64 * C::DK * 2;
        const char* xsb = (const char*)(rdw ? Qg : Kg) + (size_t)bh * 64 * BLK + (rdw ? rt * 1024 : NDU * rt * 1024);
        const unsigned xvo = (unsigned)(lane * 16);
        const char* vsb = (const char*)Vg + (size_t)(bh * C::NSL + dvs) * (4096 * 64);
        char* osb = (char*)O + (size_t)(bh * C::NSL + dvs) * (4096 * 64);
        const unsigned vio = (unsigned)(tid * 8);
        char* dmb = (char*)DUMMY + (size_t)bid * 4096;
        const char* psb = (const char*)Pimg + (size_t)bh * 64 * 8192; const unsigned pvo = (unsigned)(tid * 16);
        const char* dcb = (KIND == 1) ? (const char*)CB + ((t0 + 63) * 512 + h * 128 + RWU * rt) * 4 : nullptr; const unsigned dco = (unsigned)(g4 * 16);
        LAS bf16_t* ST = (LAS bf16_t*)(lds + C::LDS_ST);
        LAS char* PI = (LAS char*)(lds + C::LDS_P);
        LAS char* VI = (LAS char*)(lds + C::LDS_V);
        LAS char* OT = (LAS char*)(lds + C::LDS_END);
        const int trow = 16 * (g4 >> 1) + 4 * (g4 & 1) + q4;
        const int voff = trow * 32 + 8 * p4;
        const int poff_row = (16 * rt + i16) * 128, psw = (16 * rt + i16) & 7;

        LsStage<KIND> A, B;
#define LS_LOAD_PV(S, nn) do { const int n_ = (nn) < 64 ? (nn) : 63; \
            unsigned po_ = pvo, vo_ = vio, do_ = dco; asm volatile("" : "+v"(po_), "+v"(vo_), "+v"(do_)); \
            if (!((VAR & 2) && (nn) >= 2)) { S.p = *(const u32x4*)(psb + (size_t)n_ * 8192 + po_); \
            S.v = *(const u32x2*)(vsb + (size_t)n_ * 4096 + vo_); } \
            if (KIND == 1) { _Pragma("unroll") for (int a_ = 0; a_ < NDU; ++a_) S.dec[a_] = *(const f32x4*)(dcb + (size_t)n_ * (64 * 512 * 4) + 64 * a_ + do_); } } while (0)
#define LS_LOAD_X(S, nn) do { const int n_ = (nn) < 64 ? (nn) : 63; \
            if (!((VAR & 1) && (nn) >= 2)) { const char* xs_ = xsb + (size_t)n_ * BLK; unsigned xo_ = xvo; asm volatile("" : "+v"(xo_));        \
                _Pragma("unroll") for (int k_ = 0; k_ < C::NKF; ++k_) S.x[k_] = *(const u32x4*)(xs_ + (size_t)(rdw ? k_ * 4096 : ((k_ / NDU) * C::NA + (k_ % NDU)) * 1024) + xo_); } } while (0)
#define LS_LOAD(S, nn) do { LS_LOAD_PV(S, nn); LS_LOAD_X(S, nn); } while (0)
#define LS_WRITE(S, img) do { \
            *(LAS u32x4*)(PI + (img) * 8192 + tid * 16) = S.p; \
            { LAS char* vd_ = VI + (img) * 8192 + (vp8 >> 2) * 2048 + vm * 32 + (vp8 & 3) * 8; *(LAS u32x2*)vd_ = S.v; \
              if (KIND == 0) { u32x2 w_; w_.x = pk2(bf2f(S.v.x & 0xffffu) * vsc, bf2f(S.v.x >> 16) * vsc); w_.y = pk2(bf2f(S.v.y & 0xffffu) * vsc, bf2f(S.v.y >> 16) * vsc); *(LAS u32x2*)(vd_ + 4096) = w_; } } } while (0)

        for (int i = tid; i < 32 * C::STP / 2; i += 512) ((LAS unsigned*)ST)[i] = 0u;
        f32x4 s[NDU][2];
#pragma unroll
        for (int a = 0; a < NDU; ++a)
#pragma unroll
            for (int e = 0; e < 2; ++e) s[a][e] = (f32x4){0.f, 0.f, 0.f, 0.f};
        LS_LOAD(A, 0); LS_LOAD(B, 1);
        LS_WRITE(A, 0);
        __syncthreads();

#define LS_SB(k) s[1 + (k) / 2][(k) % 2]
#define LS_STEP(n, SC, SN) do { const int img_ = (n) & 1; \
            f32x4 dcur_[2]; if (KIND == 1) { _Pragma("unroll") for (int a_ = 0; a_ < NDU; ++a_) dcur_[a_] = SC.dec[a_]; } \
              \
            LS_LOAD_PV(SC, (n) + 2); \
            if (rdw) { \
                  \
                if (!(VAR & 16)) { \
                const LAS bf16_t* STc_ = ST + img_ * 32 * C::STP; \
                  \
                  \
                _Pragma("unroll") for (int ct_ = 0; ct_ < 2; ++ct_) { \
                    constexpr int HB_ = C::NKF / 2; bf16x8 pf_[2], vf_[2]; \
                    s[0][0] = (f32x4){0.f, 0.f, 0.f, 0.f}; s[0][1] = s[0][0]; \
                    _Pragma("unroll") for (int k_ = 0; k_ < HB_; ++k_) LS_SB(k_) = __builtin_bit_cast(f32x4, lfrag(STc_ + 16 * ct_ * C::STP + 32 * k_, C::STP, lane)); \
                    __builtin_amdgcn_sched_barrier(0); \
                    _Pragma("unroll") for (int k_ = 0; k_ < HB_; k_ += 2) { s[0][0] = mma_rc(s[0][0], __builtin_bit_cast(bf16x8, SC.x[k_]), __builtin_bit_cast(bf16x8, LS_SB(k_))); s[0][1] = mma_rc(s[0][1], __builtin_bit_cast(bf16x8, SC.x[k_ + 1]), __builtin_bit_cast(bf16x8, LS_SB(k_ + 1))); } \
                    __builtin_amdgcn_sched_barrier(0); \
                    _Pragma("unroll") for (int k_ = 0; k_ < HB_; ++k_) LS_SB(k_) = __builtin_bit_cast(f32x4, lfrag(STc_ + 16 * ct_ * C::STP + 32 * (HB_ + k_), C::STP, lane)); \
                    _Pragma("unroll") for (int ks_ = 0; ks_ < 2; ++ks_) { \
                        pf_[ks_] = *(const LAS bf16x8*)(PI + img_ * 8192 + poff_row + (((4 * ks_ + g4) ^ psw) << 4)); \
                        vf_[ks_] = trfrag2(VI + img_ * 8192 + ct_ * 2048 + ks_ * 1024 + voff, 256); } \
                    __builtin_amdgcn_sched_barrier(0); \
                    _Pragma("unroll") for (int k_ = 0; k_ < HB_; k_ += 2) { s[0][0] = mma_rc(s[0][0], __builtin_bit_cast(bf16x8, SC.x[HB_ + k_]), __builtin_bit_cast(bf16x8, LS_SB(k_))); s[0][1] = mma_rc(s[0][1], __builtin_bit_cast(bf16x8, SC.x[HB_ + k_ + 1]), __builtin_bit_cast(bf16x8, LS_SB(k_ + 1))); } \
                    f32x4 oa_ = (s[0][0] + s[0][1]) * qsc; \
                    _Pragma("unroll") for (int ks_ = 0; ks_ < 2; ++ks_) oa_ = mma_rc(oa_, pf_[ks_], vf_[ks_]); \
                    *(LAS u32x2*)(OT + img_ * 4608 + (16 * rt + i16) * 72 + (16 * ct_ + 4 * g4) * 2) = pk4(oa_); \
                    __builtin_amdgcn_sched_barrier(0); } } \
                  \
                LS_LOAD_X(SC, (n) + 2); \
            } else { \
                  \
                if (KIND == 0) { _Pragma("unroll") for (int a_ = 0; a_ < NDU; ++a_) _Pragma("unroll") for (int e_ = 0; e_ < 2; ++e_) s[a_][e_] = s[a_][e_] * sdec; } \
                if (!(VAR & 4)) { bf16x8 vf_[2][2]; \
                    _Pragma("unroll") for (int ks_ = 0; ks_ < 2; ++ks_) _Pragma("unroll") for (int e_ = 0; e_ < 2; ++e_) vf_[ks_][e_] = trfrag2(VI + img_ * 8192 + (KIND == 0 ? 4096 : 0) + e_ * 2048 + ks_ * 1024 + voff, 256); \
                    _Pragma("unroll") for (int ks_ = 0; ks_ < 2; ++ks_) _Pragma("unroll") for (int a_ = 0; a_ < NDU; ++a_) _Pragma("unroll") for (int e_ = 0; e_ < 2; ++e_) \
                        s[a_][e_] = mma_cr(s[a_][e_], __builtin_bit_cast(bf16x8, SC.x[ks_ * NDU + a_]), vf_[ks_][e_]); } \
                  \
                LS_LOAD_X(SC, (n) + 2); \
                if (KIND == 1) { _Pragma("unroll") for (int a_ = 0; a_ < NDU; ++a_) { f32x4 dc_; _Pragma("unroll") for (int r_ = 0; r_ < 4; ++r_) dc_[r_] = __expf(dcur_[a_][r_]); \
                    _Pragma("unroll") for (int e_ = 0; e_ < 2; ++e_) s[a_][e_] = s[a_][e_] * dc_; } } \
                  \
                { LAS bf16_t* STn_ = ST + (img_ ^ 1) * 32 * C::STP; \
                  _Pragma("unroll") for (int a_ = 0; a_ < NDU; ++a_) _Pragma("unroll") for (int e_ = 0; e_ < 2; ++e_) \
                      *(LAS u32x2*)(STn_ + (16 * e_ + i16) * C::STP + RWU * rt + 16 * a_ + 4 * g4) = pk4(s[a_][e_]); } \
            } \
              \
            { const u32x2 ov_ = *(const LAS u32x2*)(OT + (img_ ^ 1) * 4608 + vm * 72 + vp8 * 8); \
              char* ob_ = (n) > 0 ? osb + (size_t)((n) - 1) * 4096 : dmb; unsigned oo_ = vio; asm volatile("" : "+v"(oo_)); \
              if (!((VAR & 8) && (n) >= 2)) *(u32x2*)(ob_ + oo_) = ov_; } \
              \
            LS_WRITE(SN, img_ ^ 1); \
            asm volatile("s_waitcnt lgkmcnt(0)" ::: "memory"); __builtin_amdgcn_s_barrier(); asm volatile("" ::: "memory"); } while (0)

#pragma nounroll
        for (int n = 0; n < 64; n += 2) { LS_STEP(n, A, B); LS_STEP(n + 1, B, A); }
        *(u32x2*)(osb + (size_t)63 * 4096 + vio) = *(const LAS u32x2*)(OT + 4608 + vm * 72 + vp8 * 8);
        __syncthreads();
#undef LS_LOAD
#undef LS_LOAD_PV
#undef LS_LOAD_X
#undef LS_WRITE
#undef LS_STEP
#undef LS_SB
    }
}


template <int KIND>
__device__ __forceinline__ void lin_stats(const bf16_t* O, float* STATS, int tid, int bid, int G) {
    const int lane = tid & 63, wave = tid >> 6;
    const int gw = bid * 8 + wave, NGW = G * 8;
    constexpr int NJ = KIND == 0 ? 4 : 2, PITCH = KIND == 0 ? 2048 : 1024, RB = 4;
    for (int row0 = gw; row0 < MT; row0 += RB * NGW) {
        u32x4 w[RB][NJ];
#pragma unroll
        for (int rb = 0; rb < RB; ++rb) { const int row = row0 + rb * NGW < MT ? row0 + rb * NGW : row0;
#pragma unroll
            for (int j = 0; j < NJ; ++j) w[rb][j] = *(const u32x4*)(O + (size_t)row * PITCH + 512 * j + 8 * lane); }
#pragma unroll
        for (int rb = 0; rb < RB; ++rb) { const int row = row0 + rb * NGW; if (row >= MT) break;
#pragma unroll
            for (int j = 0; j < NJ; ++j) {
                float sm = 0.f, sq = 0.f;
#pragma unroll
                for (int i = 0; i < 4; ++i) { const float a = bf2f(w[rb][j][i] & 0xffffu), b = bf2f(w[rb][j][i] >> 16); sm += a + b; sq += a * a + b * b; }
                if (KIND == 0) { sm = wave_sum(sm); sq = wave_sum(sq); if (lane == 0) *(f32x2*)(STATS + (size_t)row * 8 + 2 * j) = (f32x2){sm, sq}; }
                else {
#pragma unroll
                    for (int o = 1; o < 32; o <<= 1) sq += __shfl_xor(sq, o);
                    if ((lane & 31) == 0) *(f32x2*)(STATS + (size_t)row * 8 + 2 * (2 * j + (lane >> 5))) = (f32x2){0.f, sq}; }
            }
        }
    }
}

template <int KIND> struct EpiGateNorm {
    static constexpr bool PERM = true;
    const bf16_t* O; bf16_t* A; LAS float* tbl;
    __device__ __forceinline__ void operator()(const f32x4 (&acc)[2][2][4][2], const pg8::Unit& u, int wr, int wc, int fr, int fq) const {
        constexpr int N = KIND == 0 ? 2048 : 1024, HV = KIND == 0 ? 512 : 256; constexpr float INV = KIND == 0 ? 1.0f / 512.0f : 1.0f / 256.0f;
        const int c0 = u.pn * 256 + wc * 32 + fq * 8;
        if (KIND == 0) {
            if ((u.pn & 1) == 0) {
                LAS f32x2* tb2 = (LAS f32x2*)tbl;
#pragma unroll
                for (int ai = 0; ai < 2; ++ai)
#pragma unroll
                    for (int m = 0; m < 4; ++m) { const int rl = ai * 128 + wr * 64 + m * 16 + fr; const int row = u.pm * 256 + rl; float sm = 0.f, sq = 0.f;
                        u32x4 w[4];
#pragma unroll
                        for (int tt = 0; tt < 2; ++tt)
#pragma unroll
                            for (int bj = 0; bj < 2; ++bj) w[2 * tt + bj] = *(const u32x4*)((const char*)O + v_img_off<HV>(row, c0 + tt * 256 + bj * 128));
#pragma unroll
                        for (int i = 0; i < 4; ++i) {
                            const f32x4 o0 = unpk4((u32x2){w[i].x, w[i].y}), o1 = unpk4((u32x2){w[i].z, w[i].w});
                            const f32x4 ss = o0 + o1, qq = o0 * o0 + o1 * o1;
                            sm += (ss[0] + ss[1]) + (ss[2] + ss[3]); sq += (qq[0] + qq[1]) + (qq[2] + qq[3]); }
                        sm = xsum_16_32(sm); sq = xsum_16_32(sq);
                        if (fq == 0) tb2[rl * 4 + wc] = (f32x2){sm, sq};
                        asm volatile("" ::: "memory"); }
                asm volatile("s_waitcnt lgkmcnt(0)" ::: "memory"); __builtin_amdgcn_s_barrier(); asm volatile("" ::: "memory");
            }
#pragma unroll
            for (int ai = 0; ai < 2; ++ai)
#pragma unroll
            for (int mh = 0; mh < 2; ++mh) {
                u32x4 ov[2][2];
#pragma unroll
                for (int mm = 0; mm < 2; ++mm) { const int row = u.pm * 256 + ai * 128 + wr * 64 + (2 * mh + mm) * 16 + fr;
#pragma unroll
                    for (int bj = 0; bj < 2; ++bj) ov[mm][bj] = *(const u32x4*)((const char*)O + v_img_off<HV>(row, c0 + bj * 128)); }
                asm volatile("" ::: "memory");
#pragma unroll
                for (int mm = 0; mm < 2; ++mm) { const int m = 2 * mh + mm; const int rl = ai * 128 + wr * 64 + m * 16 + fr; const int row = u.pm * 256 + rl;
                    const LAS f32x2* tb2 = (const LAS f32x2*)tbl + rl * 4;
                    const f32x2 p0 = tb2[0], p1 = tb2[1], p2 = tb2[2], p3 = tb2[3];
                    const float mean = ((p0.x + p1.x) + (p2.x + p3.x)) * INV, rstd = __builtin_amdgcn_rsqf(fmaxf(((p0.y + p1.y) + (p2.y + p3.y)) * INV - mean * mean, 0.f) + EPS);
#pragma unroll
                    for (int bj = 0; bj < 2; ++bj) {
                        const f32x4 o0 = unpk4((u32x2){ov[mm][bj].x, ov[mm][bj].y}), o1 = unpk4((u32x2){ov[mm][bj].z, ov[mm][bj].w}), a0 = acc[ai][bj][m][0], a1 = acc[ai][bj][m][1]; f32x4 r0, r1;
#pragma unroll
                        for (int j = 0; j < 4; ++j) { r0[j] = (o0[j] - mean) * rstd * silu_f(a0[j]); r1[j] = (o1[j] - mean) * rstd * silu_f(a1[j]); }
                        const u32x2 q0 = pk4(r0), q1 = pk4(r1);
                        *(u32x4*)(A + (size_t)row * N + c0 + bj * 128) = (u32x4){q0.x, q0.y, q1.x, q1.y};
                    }
                }
                asm volatile("" ::: "memory");
            }
        } else {
#pragma unroll
            for (int ai = 0; ai < 2; ++ai)
#pragma unroll
                for (int m = 0; m < 4; ++m) { const int rl = ai * 128 + wr * 64 + m * 16 + fr; const int row = u.pm * 256 + rl; float sq = 0.f;
#pragma unroll
                    for (int bj = 0; bj < 2; ++bj) { const u32x4 w = *(const u32x4*)((const char*)O + v_img_off<HV>(row, c0 + bj * 128));
                        const f32x4 o0 = unpk4((u32x2){w.x, w.y}), o1 = unpk4((u32x2){w.z, w.w}); const f32x4 qq = o0 * o0 + o1 * o1; sq += (qq[0] + qq[1]) + (qq[2] + qq[3]); }
                    sq = xsum_16_32(sq);
                    if (fq == 0) tbl[rl * 4 + wc] = sq; }
            asm volatile("s_waitcnt lgkmcnt(0)" ::: "memory"); __builtin_amdgcn_s_barrier(); asm volatile("" ::: "memory");
#pragma unroll
            for (int ai = 0; ai < 2; ++ai) {
                u32x4 ov[4][2];
#pragma unroll
                for (int m = 0; m < 4; ++m) { const int row = u.pm * 256 + ai * 128 + wr * 64 + m * 16 + fr;
#pragma unroll
                    for (int bj = 0; bj < 2; ++bj) ov[m][bj] = *(const u32x4*)((const char*)O + v_img_off<HV>(row, c0 + bj * 128)); }
                asm volatile("" ::: "memory");
#pragma unroll
                for (int m = 0; m < 4; ++m) { const int rl = ai * 128 + wr * 64 + m * 16 + fr; const int row = u.pm * 256 + rl;
                    const f32x4 pr = *(const LAS f32x4*)(tbl + rl * 4);
                    const float rstd = __builtin_amdgcn_rsqf(((pr[0] + pr[1]) + (pr[2] + pr[3])) * INV + EPS);
#pragma unroll
                    for (int bj = 0; bj < 2; ++bj) {
                        const f32x4 o0 = unpk4((u32x2){ov[m][bj].x, ov[m][bj].y}), o1 = unpk4((u32x2){ov[m][bj].z, ov[m][bj].w}), a0 = acc[ai][bj][m][0], a1 = acc[ai][bj][m][1]; f32x4 r0, r1;
#pragma unroll
                        for (int j = 0; j < 4; ++j) { r0[j] = o0[j] * rstd * silu_f(a0[j]); r1[j] = o1[j] * rstd * silu_f(a1[j]); }
                        const u32x2 q0 = pk4(r0), q1 = pk4(r1);
                        *(u32x4*)(A + (size_t)row * N + c0 + bj * 128) = (u32x4){q0.x, q0.y, q1.x, q1.y};
                    }
                }
                asm volatile("" ::: "memory");
            }
        }
    }
};
namespace attn_body {
using bf16=unsigned short;
using bf16x8=__attribute__((ext_vector_type(8)))short;
using s16x4=__attribute__((ext_vector_type(4)))short;
using f32x16=__attribute__((ext_vector_type(16)))float;
using u32x4=__attribute__((ext_vector_type(4)))unsigned;
constexpr int BATCH=4,NHEAD=16,SEQ=4096,D=64,DM=NHEAD*D;
constexpr int NW=8,QBLK=32,QB=QBLK*NW,KVBLK=64,NQB=SEQ/QB;
constexpr int ATTN_PITCH=DM, ATTN_UNIT_ROWS=QB;
__device__ __forceinline__ int crow(int r,int hi){return (r&3)+8*(r>>2)+4*hi;}
#define SBAR() __builtin_amdgcn_sched_barrier(0)
__device__ __forceinline__ void cmask(f32x16&p0,f32x16&p1,int jb,int qrel,int hi){
  const float NEG=-INFINITY; int kb=64*jb+4*hi;
  #pragma unroll
  for(int r=0;r<16;++r){int kv=kb+(r&3)+8*(r>>2); if(kv>qrel)p0[r]=NEG; if(kv+32>qrel)p1[r]=NEG;}
}

constexpr int NSLOT=3, SLOTB=8192;
constexpr int LDS_K=0, LDS_V=NSLOT*SLOTB, LDS_WS=2*NSLOT*SLOTB, LDS_OST=LDS_WS+NW*64*4, LDS_NC=LDS_OST+NW*4096, LDS_FT=LDS_NC+SEQ*4, LDS_RE=LDS_FT+256, LDS_BYTES=LDS_RE+256;
constexpr float C2=0.125f*1.4426950408889634f;
__device__ __forceinline__ void glds16(const void*gsrc,unsigned lds_dst){unsigned keep;
  asm volatile("s_mov_b32 %0, m0\n\ts_mov_b32 m0, %2\n\ts_nop 0\n\tglobal_load_lds_dwordx4 %1, off\n\ts_mov_b32 m0, %0":"=&s"(keep):"v"(gsrc),"s"(lds_dst):"memory");}
__device__ __forceinline__ float max3f(float a,float b,float c){float r;asm("v_max3_f32 %0, %1, %2, %3":"=v"(r):"v"(a),"v"(b),"v"(c));return r;}
__device__ __forceinline__ float max2f(float a,float b){float r;asm("v_max_f32_e32 %0, %1, %2":"=v"(r):"v"(a),"v"(b));return r;}
__device__ __forceinline__ float fadd_s(float a,float b){float r;asm("v_add_f32_e32 %0, %1, %2":"=v"(r):"v"(a),"v"(b));return r;}
__device__ __forceinline__ float fsub_s(float a,float b){float r;asm("v_sub_f32_e32 %0, %1, %2":"=v"(r):"v"(a),"v"(b));return r;}
typedef float f32x2_t __attribute__((ext_vector_type(2))); typedef __bf16 bf16x2_t __attribute__((ext_vector_type(2)));
__device__ __forceinline__ unsigned cvtpk_s(float lo,float hi){f32x2_t v={lo,hi};bf16x2_t b=__builtin_convertvector(v,bf16x2_t);return __builtin_bit_cast(unsigned,b);}
#define WAIT_BAR(N) asm volatile("s_waitcnt vmcnt(" #N ") lgkmcnt(0)\n\ts_barrier":::"memory")

__device__ __forceinline__ void qkt(f32x16&p0,f32x16&p1,const char*Kslot,const bf16x8*qr,const f32x16&negm,int r32,int hi){
  const char*kb=Kslot+hi*1024+r32*16;
  #pragma unroll
  for(int d0=0;d0<4;++d0){
    const bf16x8 b0=*reinterpret_cast<const bf16x8*>(kb+d0*2048);
    const bf16x8 b1=*reinterpret_cast<const bf16x8*>(kb+d0*2048+512);
    if(d0==0){p0=__builtin_amdgcn_mfma_f32_32x32x16_bf16(b0,qr[0],negm,0,0,0);p1=__builtin_amdgcn_mfma_f32_32x32x16_bf16(b1,qr[0],negm,0,0,0);}
    else{p0=__builtin_amdgcn_mfma_f32_32x32x16_bf16(b0,qr[d0],p0,0,0,0);p1=__builtin_amdgcn_mfma_f32_32x32x16_bf16(b1,qr[d0],p1,0,0,0);}}
}
typedef __attribute__((address_space(3))) const char* lds_cptr;
typedef short v4i16_t __attribute__((ext_vector_type(4)));
__device__ __forceinline__ void kload8(bf16x8*kf,lds_cptr kp){
  kf[0]=*(const __attribute__((address_space(3))) bf16x8*)(kp);      kf[1]=*(const __attribute__((address_space(3))) bf16x8*)(kp+512);
  kf[2]=*(const __attribute__((address_space(3))) bf16x8*)(kp+2048); kf[3]=*(const __attribute__((address_space(3))) bf16x8*)(kp+2560);
  kf[4]=*(const __attribute__((address_space(3))) bf16x8*)(kp+4096); kf[5]=*(const __attribute__((address_space(3))) bf16x8*)(kp+4608);
  kf[6]=*(const __attribute__((address_space(3))) bf16x8*)(kp+6144); kf[7]=*(const __attribute__((address_space(3))) bf16x8*)(kp+6656);
}
__device__ __forceinline__ void kload2(bf16x8*kf,lds_cptr kp,int j){ kf[2*j]=*(const __attribute__((address_space(3))) bf16x8*)(kp+j*2048); kf[2*j+1]=*(const __attribute__((address_space(3))) bf16x8*)(kp+j*2048+512); }
__device__ __forceinline__ s16x4 vtr(lds_cptr p){ return __builtin_bit_cast(s16x4,__builtin_amdgcn_ds_read_tr16_b64_v4i16((__attribute__((address_space(3))) v4i16_t*)p)); }
__device__ __forceinline__ float rowmax(const f32x16&p0,const f32x16&p1){
  float a=max3f(p0[0],p0[1],p1[0]),b=max3f(p0[2],p0[3],p1[1]);a=max3f(a,p1[2],p1[3]);
  #pragma unroll
  for(int r=4;r<16;r+=4){a=max3f(a,p0[r],p0[r+1]);b=max3f(b,p0[r+2],p0[r+3]);a=max3f(a,p1[r],p1[r+1]);b=max3f(b,p1[r+2],p1[r+3]);}
  const float m=max2f(a,b);
  auto rr=__builtin_amdgcn_permlane32_swap(__float_as_uint(m),__float_as_uint(m),false,false);
  return max2f(__uint_as_float(rr[0]),__uint_as_float(rr[1]));
}
__device__ __forceinline__ void pv(f32x16*o,int vb,bf16x8 pa0,bf16x8 pa1,bf16x8 pa2,bf16x8 pa3){
  #pragma unroll
  for(int d0=0;d0<2;++d0){s16x4 lo[4],hi[4];
    #pragma unroll
    for(int ks=0;ks<4;++ks){
      asm volatile("ds_read_b64_tr_b16 %0,%1 offset:%c2":"=&v"(lo[ks]):"v"(vb),"i"(d0*4096+ks*1024):"memory");
      asm volatile("ds_read_b64_tr_b16 %0,%1 offset:%c2":"=&v"(hi[ks]):"v"(vb),"i"(d0*4096+ks*1024+512):"memory");}
    asm volatile("s_waitcnt lgkmcnt(0)":::"memory");SBAR();
    #define PK(k) (bf16x8){lo[k][0],lo[k][1],lo[k][2],lo[k][3],hi[k][0],hi[k][1],hi[k][2],hi[k][3]}
    o[d0]=__builtin_amdgcn_mfma_f32_32x32x16_bf16(pa0,PK(0),o[d0],0,0,0);
    o[d0]=__builtin_amdgcn_mfma_f32_32x32x16_bf16(pa1,PK(1),o[d0],0,0,0);
    o[d0]=__builtin_amdgcn_mfma_f32_32x32x16_bf16(pa2,PK(2),o[d0],0,0,0);
    o[d0]=__builtin_amdgcn_mfma_f32_32x32x16_bf16(pa3,PK(3),o[d0],0,0,0);
    #undef PK
  }
}

#ifndef ATTN_STORE16
#define ATTN_STORE16(p,v) (*(u32x4*)(p)=(v))
#endif
template<int THRL> __device__ __forceinline__ void attn_unit(int b,int h,int qb,int ts,const bf16*Q,const bf16*__restrict__ K,const bf16*__restrict__ V,const bf16*__restrict__ Gt,bf16*O,char*shm,int tid){
  const int lane=tid&63,r32=lane&31,hi=lane>>5; const int wid=__builtin_amdgcn_readfirstlane(tid>>6);
  const long rowbase=(long)b*SEQ; const int q0=qb*QB;
  typedef __attribute__((address_space(3))) const float* lds_fptr; typedef float f32x4b __attribute__((ext_vector_type(4)));
  const lds_fptr ncum=(lds_fptr)((__attribute__((address_space(3))) const char*)shm+LDS_NC)+64*ts+4*hi;
  const lds_fptr ftp=(lds_fptr)((__attribute__((address_space(3))) const char*)shm+LDS_FT)+ts;
  const bf16*Qw=Q+(rowbase+q0+wid*QBLK)*DM+h*D;
  const bf16*Kh=K+(rowbase+(long)ts*KVBLK)*DM+h*D,*Vh=V+(rowbase+(long)ts*KVBLK)*DM+h*D;
  const unsigned lds0=(unsigned)(uintptr_t)shm;
  float*wsf=(float*)(shm+LDS_WS)+wid*64;
  const bf16*ksrc=Kh+(long)lane*DM+wid*8;
  const bf16*vsrc=Vh+(long)(16*(wid&3)+(lane>>2))*DM+(wid>>2)*32+(lane&3)*8;
  const unsigned kdst=lds0+LDS_K+wid*1024, vdst=lds0+LDS_V+wid*1024;
  #define DMA_K(t,slot) glds16(ksrc+(long)(t)*KVBLK*DM,(unsigned)__builtin_amdgcn_readfirstlane(kdst+(slot)))
  #define DMA_V(t,slot) glds16(vsrc+(long)(t)*KVBLK*DM,(unsigned)__builtin_amdgcn_readfirstlane(vdst+(slot)))
  const int vb0=(int)(lds0+LDS_V)+((lane>>4)&1)*32+(lane&3)*8+(4*hi+((lane&15)>>2))*64;
  const char*Kbase=shm+LDS_K; bf16x8 kf[8];
  const lds_cptr shm3=(lds_cptr)shm; const lds_cptr kp0=shm3+LDS_K+hi*1024+r32*16; const lds_cptr vp0=shm3+LDS_V+((lane>>4)&1)*32+(lane&3)*8+(4*hi+((lane&15)>>2))*64;
  const int NT=(q0+QB)/KVBLK-ts;
  DMA_K(0,0);DMA_V(0,0);DMA_K(1,SLOTB);
  bf16x8 qr[4];
  #pragma unroll
  for(int d0=0;d0<4;++d0)qr[d0]=*reinterpret_cast<const bf16x8*>(&Qw[(long)r32*DM+d0*16+hi*8]);
  float l_reg=0.f,fcur=1.f;f32x16 o[2];o[0]=f32x16{};o[1]=f32x16{};const f32x16 negm=f32x16{};
  const int qrel=wid*QBLK+r32;
  #define CMASK(P0,P1,t) do{int jb_=(t)-(NT-4); if(jb_>=0)cmask(P0,P1,jb_,qrel,hi);}while(0)
  #define LDSF4(p) (*(const __attribute__((address_space(3))) f32x4b*)(p))
  #define BIAS(P0,P1,t) do{ const lds_fptr nb_=ncum+64*(t); \
      { const f32x4b a0_=LDSF4(nb_), a1_=LDSF4(nb_+8), a2_=LDSF4(nb_+16), a3_=LDSF4(nb_+24); \
        _Pragma("unroll") for(int j_=0;j_<4;++j_){ P0[j_]+=a0_[j_]; P0[4+j_]+=a1_[j_]; P0[8+j_]+=a2_[j_]; P0[12+j_]+=a3_[j_]; } } SBAR(); \
      { const f32x4b b0_=LDSF4(nb_+32), b1_=LDSF4(nb_+40), b2_=LDSF4(nb_+48), b3_=LDSF4(nb_+56); \
        _Pragma("unroll") for(int j_=0;j_<4;++j_){ P1[j_]+=b0_[j_]; P1[4+j_]+=b1_[j_]; P1[8+j_]+=b2_[j_]; P1[12+j_]+=b3_[j_]; } } SBAR(); }while(0)
  #define START(P0,P1) do{ _Pragma("unroll") for(int r=0;r<16;++r)P0[r]=__builtin_amdgcn_exp2f(P0[r]); }while(0)
  #define RESC() do{ _Pragma("unroll") for(int d_=0;d_<2;++d_) _Pragma("unroll") for(int r=0;r<16;++r)o[d_][r]*=fcur; }while(0)
  f32x16 pA0,pA1,pB0,pB1;
  int sl_prev=0,sl_cur=0,sl_next=SLOTB;
  #define ROT() do{sl_prev=sl_cur;sl_cur=sl_next;sl_next=(sl_next==(NSLOT-1)*SLOTB)?0:sl_next+SLOTB;}while(0)
  DMA_K(2,2*SLOTB);
  WAIT_BAR(3);
  qkt(pA0,pA1,Kbase,qr,negm,r32,hi);asm volatile("s_nop 15\n\ts_nop 7":"+v"(pA0),"+v"(pA1));BIAS(pA0,pA1,0);CMASK(pA0,pA1,0);
  START(pA0,pA1);
  _Pragma("unroll") for(int r=0;r<16;++r)pA1[r]=__builtin_amdgcn_exp2f(pA1[r]);
  WAIT_BAR(0);
  DMA_K(3,0);DMA_V(1,SLOTB);
  ROT();
  kload8(kf,kp0+sl_cur);
  WAIT_BAR(2);
  s16x4 vlo[8],vhi[8]; u32x4 pw0,pw1,pw2,pw3;
  #define PKW(P,B) cvtpk_s(P[B],P[B+1])
  #define PAF(k) __builtin_bit_cast(bf16x8,pw##k)
  #define VFR(i) (bf16x8){vlo[i][0],vlo[i][1],vlo[i][2],vlo[i][3],vhi[i][0],vhi[i][1],vhi[i][2],vhi[i][3]}
  #define PIN(x) asm volatile("":"+v"(x))
  #define MX3(a,b,c) __builtin_fmaxf(__builtin_fmaxf((a),(b)),(c))
  #define GAPA(MF,A0,A1,A2,A3,W0,W1,PW) do{ MF; sacc+=A0; sacc+=A1; sacc+=A2; sacc+=A3; PIN(sacc); W0; W1; PIN(PW); SBAR(); }while(0)
  #define EX(v) __builtin_amdgcn_exp2f(v)
  #define GAPB(MF,X,B) do{ MF; X[B]=EX(X[B]); X[B+1]=EX(X[B+1]); X[B+2]=EX(X[B+2]); X[B+3]=EX(X[B+3]); PIN(X); SBAR(); }while(0)
  #define VRD(i) do{ vlo[i]=vtr(vp_+(((i)>>2)*4096+((i)&3)*1024)); vhi[i]=vtr(vp_+(((i)>>2)*4096+((i)&3)*1024+512)); }while(0)
  #define KRD(G,j) do{ if(G){ kload2(kf,kp0+sl_next,j); SBAR(); } }while(0)
  #define STEP(C0,C1,P0,P1,t,GK,GV,GL) do{ SBAR(); \
    const lds_cptr vp_=vp0+sl_prev; \
    VRD(0); SBAR(); float sacc=(P0[0]+P0[1]); \
    GAPA(C0=__builtin_amdgcn_mfma_f32_32x32x16_bf16(kf[0],qr[0],negm,0,0,0), P0[2],P0[3],P0[4],P0[5],     pw0[0]=PKW(P0,0), pw0[1]=PKW(P0,2), pw0); \
    VRD(4); SBAR(); GAPA(C1=__builtin_amdgcn_mfma_f32_32x32x16_bf16(kf[1],qr[0],negm,0,0,0), P0[6],P0[7],P0[8],P0[9],     pw0[2]=PKW(P0,4), pw0[3]=PKW(P0,6), pw0); \
    VRD(1); SBAR(); GAPA(C0=__builtin_amdgcn_mfma_f32_32x32x16_bf16(kf[2],qr[1],C0,0,0,0),   P0[10],P0[11],P0[12],P0[13], pw1[0]=PKW(P0,8), pw1[1]=PKW(P0,10), pw1); \
    VRD(5); SBAR(); GAPA(C1=__builtin_amdgcn_mfma_f32_32x32x16_bf16(kf[3],qr[1],C1,0,0,0),   P0[14],P0[15],P1[0],P1[1],   pw1[2]=PKW(P0,12),pw1[3]=PKW(P0,14), pw1); \
    VRD(2); SBAR(); GAPA(C0=__builtin_amdgcn_mfma_f32_32x32x16_bf16(kf[4],qr[2],C0,0,0,0),   P1[2],P1[3],P1[4],P1[5],     pw2[0]=PKW(P1,0), pw2[1]=PKW(P1,2), pw2); \
    VRD(6); SBAR(); GAPA(C1=__builtin_amdgcn_mfma_f32_32x32x16_bf16(kf[5],qr[2],C1,0,0,0),   P1[6],P1[7],P1[8],P1[9],     pw2[2]=PKW(P1,4), pw2[3]=PKW(P1,6), pw2); \
    VRD(3); SBAR(); GAPA(C0=__builtin_amdgcn_mfma_f32_32x32x16_bf16(kf[6],qr[3],C0,0,0,0),   P1[10],P1[11],P1[12],P1[13], pw3[0]=PKW(P1,8), pw3[1]=PKW(P1,10), pw3); \
    VRD(7); SBAR(); GAPA(C1=__builtin_amdgcn_mfma_f32_32x32x16_bf16(kf[7],qr[3],C1,0,0,0),   P1[14],P1[15],0.f,0.f,       pw3[2]=PKW(P1,12),pw3[3]=PKW(P1,14), pw3); \
    l_reg+=sacc; \
    if(GK){DMA_K((t)+3,sl_cur);} if(GV){DMA_V((t)+1,sl_next);} \
    BIAS(C0,C1,t); CMASK(C0,C1,t); \
    { const int jb2_=2*((t)-(NT-4)); fcur=(jb2_>wid)?1.0f:ftp[(t)]; l_reg*=fcur; } \
    SBAR(); \
    GAPB(o[0]=__builtin_amdgcn_mfma_f32_32x32x16_bf16(PAF(0),VFR(0),o[0],0,0,0), C0,0); \
    GAPB(o[1]=__builtin_amdgcn_mfma_f32_32x32x16_bf16(PAF(0),VFR(4),o[1],0,0,0), C0,4); \
    KRD(GL,0); GAPB(o[0]=__builtin_amdgcn_mfma_f32_32x32x16_bf16(PAF(1),VFR(1),o[0],0,0,0), C0,8); \
    KRD(GL,1); GAPB(o[1]=__builtin_amdgcn_mfma_f32_32x32x16_bf16(PAF(1),VFR(5),o[1],0,0,0), C0,12); \
    KRD(GL,2); GAPB(o[0]=__builtin_amdgcn_mfma_f32_32x32x16_bf16(PAF(2),VFR(2),o[0],0,0,0), C1,0); \
    KRD(GL,3); GAPB(o[1]=__builtin_amdgcn_mfma_f32_32x32x16_bf16(PAF(2),VFR(6),o[1],0,0,0), C1,4); \
    GAPB(o[0]=__builtin_amdgcn_mfma_f32_32x32x16_bf16(PAF(3),VFR(3),o[0],0,0,0), C1,8); \
    GAPB(o[1]=__builtin_amdgcn_mfma_f32_32x32x16_bf16(PAF(3),VFR(7),o[1],0,0,0), C1,12); \
    }while(0)
  int t=1;
  #undef CMASK
  #define CMASK(P0,P1,t) do{}while(0)
  for(;t+5<NT;t+=2){
    STEP(pB0,pB1,pA0,pA1,t,true,true,true);     WAIT_BAR(2); RESC(); ROT();
    STEP(pA0,pA1,pB0,pB1,t+1,true,true,true);   WAIT_BAR(2); RESC(); ROT();
  }
  #undef CMASK
  int qrel_m=qrel,hi_m=hi; asm volatile("":"+v"(qrel_m),"+v"(hi_m));
  #define CMASK(P0,P1,t) do{int jb_=(t)-(NT-4); if(jb_>=0)cmask(P0,P1,jb_,qrel_m,hi_m);}while(0)
  #define ENDW(tt) do{ if((tt)+3<NT){WAIT_BAR(2);} else if((tt)+2<NT){WAIT_BAR(1);} else {WAIT_BAR(0);} }while(0)
  for(;t+1<NT;t+=2){
    STEP(pB0,pB1,pA0,pA1,t,(t+3<NT),(t+1<NT),(t+1<NT));       ENDW(t);   RESC(); ROT();
    STEP(pA0,pA1,pB0,pB1,t+1,(t+4<NT),(t+2<NT),(t+2<NT));     ENDW(t+1); RESC(); ROT();
  }
  STEP(pB0,pB1,pA0,pA1,NT-1,false,false,false); RESC();
  { float sacc=pB0[0]+pB0[1]; _Pragma("unroll") for(int r=2;r<16;++r)sacc+=pB0[r]; _Pragma("unroll") for(int r=0;r<16;++r)sacc+=pB1[r]; l_reg+=sacc;
    pw0=(u32x4){PKW(pB0,0),PKW(pB0,2),PKW(pB0,4),PKW(pB0,6)};pw1=(u32x4){PKW(pB0,8),PKW(pB0,10),PKW(pB0,12),PKW(pB0,14)};pw2=(u32x4){PKW(pB1,0),PKW(pB1,2),PKW(pB1,4),PKW(pB1,6)};pw3=(u32x4){PKW(pB1,8),PKW(pB1,10),PKW(pB1,12),PKW(pB1,14)};
    SBAR(); pv(o,vb0+sl_cur,PAF(0),PAF(1),PAF(2),PAF(3)); }
  #undef PKW
  #undef PAF
  #undef VFR
  #undef PIN
  #undef MX3
  #undef GAPA
  #undef GAPB
  #undef EX
  #undef VRD
  #undef KRD
  #undef STEP
  #undef ENDW
  {auto rr=__builtin_amdgcn_permlane32_swap(__float_as_uint(l_reg),__float_as_uint(l_reg),false,false);l_reg=__uint_as_float(rr[0])+__uint_as_float(rr[1]);}
  if(hi==0)wsf[32+r32]=l_reg;asm volatile("s_waitcnt lgkmcnt(0)":::"memory");
  float rli[16];
  #pragma unroll
  for(int r=0;r<16;++r)rli[r]=__builtin_amdgcn_rcpf(wsf[32+crow(r,hi)]);
  bf16*Ow=O+(rowbase+q0+wid*QBLK)*DM+h*D;
  { bf16*stg=(bf16*)(shm+LDS_OST)+wid*2048;
    #pragma unroll
    for(int r=0;r<16;++r){const int orow=crow(r,hi);
      #pragma unroll
      for(int d0=0;d0<2;++d0){const float gv=__uint_as_float((unsigned)Gt[(rowbase+q0+wid*QBLK+orow)*DM+h*D+d0*32+r32]<<16); const float ov=o[d0][r]*rli[r]*gv; unsigned ub=__float_as_uint(ov); ub=(ub+0x7fffu+((ub>>16)&1u))>>16; stg[orow*64+d0*32+r32]=(bf16)ub;}}
    asm volatile("s_waitcnt lgkmcnt(0)":::"memory");
    #pragma unroll
    for(int i=0;i<4;++i){const int row=i*8+(lane>>3),ch=lane&7; const u32x4 v=*(const u32x4*)(stg+row*64+ch*8); ATTN_STORE16(Ow+(long)row*DM+ch*8,v);} }
  asm volatile("s_waitcnt lgkmcnt(0)\n\ts_barrier":::"memory");
  #undef DMA_K
  #undef DMA_V
  #undef CMASK
  #undef BIAS
  #undef LDSF4
  #undef START
  #undef RESC
  #undef ROT
}
constexpr int ATTN_LDS_BYTES=LDS_BYTES;
#undef SBAR
#undef WAIT_BAR
}

__device__ __forceinline__ void fox_attn2(const Params& P, char* shm, int tid, int bid, int G, unsigned short* Odst) {
    const int lane = tid & 63;
    unsigned short* Q = (unsigned short*)(P.ws + WS_ACT); const unsigned short* Kb = (const unsigned short*)(P.ws + WS_ACT + 32 * MiB); const unsigned short* V = (const unsigned short*)(P.ws + WS_ACT + 64 * MiB);
    const unsigned short* Gt = (const unsigned short*)(P.ws + WS_ACT + 96 * MiB);
    LAS float* nc = (LAS float*)((LAS char*)shm + attn_body::LDS_NC);
    LAS float* ft = (LAS float*)((LAS char*)shm + attn_body::LDS_FT);
    LAS float* re = (LAS float*)((LAS char*)shm + attn_body::LDS_RE);
    float gq = fabsf(P.fox_q_gain[lane]), gk = fabsf(P.fox_k_gain[lane]);
#pragma unroll
    for (int o = 1; o < 64; o <<= 1) { gq = fmaxf(gq, __shfl_xor(gq, o)); gk = fmaxf(gk, __shfl_xor(gk, o)); }
    const float Smax = 1.02f * (64.0f * gq * gk * 0.125f * LOG2E);
    const float T = 2.0f * Smax + 40.0f;
    const int vcu = (G % 8 == 0) ? (bid % 8) * (G / 8) + bid / 8 : bid;
    int last_bh = -1;
    for (int i = 0;; ++i) {
        int bh, qb;
        if (G == 256) { if (i >= 4) break; bh = vcu >> 2; const int s = vcu & 3; qb = (i == 0) ? s : (i == 1) ? 7 - s : (i == 2) ? 8 + s : 15 - s; }
        else { const int ui = i * G + bid; if (ui >= 1024) break; bh = ui >> 4; qb = ui & 15; }
        if (bh != last_bh) {
            const float* LF = (const float*)(P.ws + WS_S16) + ((size_t)(bh >> 4) * SEQ + 8 * tid) * 16 + (bh & 15);
            float v8[8]; float run = 0.f;
#pragma unroll
            for (int i2 = 0; i2 < 8; ++i2) { run += LF[(size_t)i2 * 16]; v8[i2] = run; }
            float inc = run;
#pragma unroll
            for (int o = 1; o < 64; o <<= 1) { const float tt = __shfl_up(inc, o); if (lane >= o) inc += tt; }
            if (lane == 63) ft[tid >> 6] = inc;
            __syncthreads();
            float pre = inc - run;
            for (int w = 0; w < (tid >> 6); ++w) pre += ft[w];
            __syncthreads();
#pragma unroll
            for (int i2 = 0; i2 < 8; ++i2) nc[8 * tid + i2] = -(pre + v8[i2]) * LOG2E;
            __syncthreads();
            if (tid < 64) { const float e = nc[64 * tid + 63]; re[tid] = e; const float ep = (tid > 0) ? nc[64 * tid - 1] : e; ft[tid] = exp2f(ep - e); }
            __syncthreads();
#pragma unroll
            for (int i2 = 0; i2 < 8; ++i2) nc[8 * tid + i2] += -re[tid >> 3] - Smax + 40.0f;
            __syncthreads(); last_bh = bh;
        }
        const int ntf = 4 * qb + 4;
        const float thr = (qb > 0 ? re[4 * qb - 1] : 0.0f) - T;
        const bool pred = (lane < ntf) && (re[lane] < thr);
        int ts = __builtin_popcountll(__ballot(pred)) & ~1; ts = ts > ntf - 4 ? ntf - 4 : ts; ts = __builtin_amdgcn_readfirstlane(ts);
        int tid_u = tid; asm volatile("" : "+v"(tid_u));
        attn_body::attn_unit<8>(bh >> 4, bh & 15, qb, ts, Q, Kb, V, Gt, Odst ? Odst : Q, shm, tid_u);
    }
}

__device__ __forceinline__ void final_norm(const Params& P, int tid, int bid, int G) {
    const int lane = tid & 63, wave = tid >> 6;
    const int gw = bid * 8 + wave, NGW = G * 8;
    f32x4 g[4];
#pragma unroll
    for (int j = 0; j < 4; ++j) g[j] = *(const f32x4*)(P.final_g + 4 * lane + 256 * j);
    constexpr int RB = 4;
    for (int row0 = gw; row0 < MT; row0 += RB * NGW) {
        f32x4 v[RB][4];
#pragma unroll
        for (int rb = 0; rb < RB; ++rb) { const int row = row0 + rb * NGW < MT ? row0 + rb * NGW : row0; const f32x4* xr = (const f32x4*)(P.out + (size_t)row * 1024) + lane;
#pragma unroll
            for (int j = 0; j < 4; ++j) v[rb][j] = xr[64 * j]; }
#pragma unroll
        for (int rb = 0; rb < RB; ++rb) { const int row = row0 + rb * NGW; if (row >= MT) break;
            float ss = 0.f;
#pragma unroll
            for (int j = 0; j < 4; ++j) ss += (v[rb][j][0] * v[rb][j][0] + v[rb][j][1] * v[rb][j][1]) + (v[rb][j][2] * v[rb][j][2] + v[rb][j][3] * v[rb][j][3]);
            const float rstd = rsqrtf(wave_sum(ss) * (1.0f / 1024.0f) + EPS);
            f32x4* xw = (f32x4*)(P.out + (size_t)row * 1024) + lane;
#pragma unroll
            for (int j = 0; j < 4; ++j) xw[64 * j] = (v[rb][j] * rstd) * g[j];
        }
    }
}

#define XB_TMO      128
#define XB_XCNT(j)  (256  + 64 * (j))
#define XB_XSUB(j)  (1280 + 64 * (j))
#define XB_XGEN(j)  (2304 + 64 * (j))
#define XB_TOP      3328
#define XB_TOPGEN   3392
#define XCD_BAR_WORDS 3456
#define XB_SPIN_CAP (1u << 20)
__device__ __forceinline__ unsigned xb_ld(unsigned* p)              { return __hip_atomic_load(p, __ATOMIC_RELAXED, __HIP_MEMORY_SCOPE_AGENT); }
__device__ __forceinline__ unsigned xb_add(unsigned* p, unsigned v) { return __hip_atomic_fetch_add(p, v, __ATOMIC_RELAXED, __HIP_MEMORY_SCOPE_AGENT); }
__device__ __forceinline__ unsigned xb_xcc_id() { return (unsigned)__builtin_amdgcn_s_getreg((3 << 11) | 20) & 0xFu; }
#define XB_SPIN(cond, bar) do { unsigned _sp = 0; while (cond) { __builtin_amdgcn_s_sleep(1); \
    if ((++_sp & 255u) == 0u) { if (xb_ld(&(bar)[XB_TMO])) break; if (_sp > XB_SPIN_CAP) { atomicAdd(&(bar)[XB_TMO], 1u); break; } } } } while (0)
struct XcdBarrier { unsigned* bar; unsigned x; volatile LAS unsigned* st; int wave_s; };
__device__ __forceinline__ int lane_id() { return (int)__builtin_amdgcn_mbcnt_hi(~0u, __builtin_amdgcn_mbcnt_lo(~0u, 0u)); }
__device__ __forceinline__ XcdBarrier xcd_barrier_post(unsigned* bar, volatile LAS unsigned* st, int wave_s) {
    XcdBarrier b; b.bar = bar; b.x = xb_xcc_id(); b.st = st; b.wave_s = wave_s;
    if (threadIdx.x == 0) (void)xb_add(&bar[XB_XCNT(b.x)], 1u);
    return b;
}
__device__ __forceinline__ void xcd_barrier_complete(unsigned* bar, unsigned x, unsigned& nloc, unsigned& nx) {
    const unsigned G = gridDim.x * gridDim.y * gridDim.z;
    asm volatile("" : "+s"(x));
    unsigned sum, cnt, mine, sp = 0u;
    for (;;) {
        sum = 0u; cnt = 0u; mine = 0u;
#pragma unroll
        for (unsigned j = 0; j < 16; ++j) { const unsigned c = xb_ld(&bar[XB_XCNT(j)]); sum += c; cnt += (c > 0u) ? 1u : 0u; mine = (j == x) ? c : mine; }
        if (sum == G) break;
        __builtin_amdgcn_s_sleep(1);
        if ((++sp & 255u) == 0u) { if (xb_ld(&bar[XB_TMO])) break; if (sp > XB_SPIN_CAP) { atomicAdd(&bar[XB_TMO], 1u); break; } }
    }
    nloc = mine > 0u ? mine : 1u; nx = cnt > 0u ? cnt : 1u;
}
__device__ __forceinline__ void xcd_barrier(const XcdBarrier& b) {
    asm volatile("s_waitcnt vmcnt(0)" ::: "memory");
    __syncthreads();
    if (threadIdx.x == 0) {
        unsigned* bar = b.bar;
        __builtin_amdgcn_s_waitcnt(0);
        unsigned nloc = b.st[0], nx = b.st[1];
        if (nloc == 0u) { xcd_barrier_complete(bar, b.x, nloc, nx); b.st[0] = nloc; b.st[1] = nx; }
        const unsigned old = xb_add(&bar[XB_XSUB(b.x)], 1u);
        const unsigned gen = old / nloc;
        if (old + 1u == (gen + 1u) * nloc) {
            __builtin_amdgcn_fence(__ATOMIC_RELEASE, "agent");
            asm volatile("s_waitcnt vmcnt(0)" ::: "memory");
            const unsigned og = xb_add(&bar[XB_TOP], 1u);
            const unsigned tg = og / nx;
            if (og + 1u == (tg + 1u) * nx) xb_add(&bar[XB_TOPGEN], 1u);
            else XB_SPIN(xb_ld(&bar[XB_TOPGEN]) == tg, bar);
            xb_add(&bar[XB_XGEN(b.x)], 1u);
            __builtin_amdgcn_fence(__ATOMIC_ACQUIRE, "agent");
            asm volatile("s_waitcnt vmcnt(0)" ::: "memory");
        } else {
            XB_SPIN(xb_ld(&bar[XB_XGEN(b.x)]) == gen, bar);
            __builtin_amdgcn_fence(__ATOMIC_ACQUIRE, "agent");
            asm volatile("s_waitcnt vmcnt(0)" ::: "memory");
        }
    }
    __syncthreads();
}

constexpr int LDS_BYTES = 147456;
#ifndef PROBE
#define PROBE 0
#endif
#define FRESH() int tid = threadIdx.x, bid = blockIdx.x; asm volatile("" : "+v"(tid)); asm volatile("" : "+s"(bid));
__global__ void __launch_bounds__(512, 2) trunk_fwd(Params P) {
    extern __shared__ __attribute__((aligned(16))) unsigned char lds_raw[];
    LAS unsigned char* lds = (LAS unsigned char*)lds_raw;
    cg::grid_group grid = cg::this_grid();
    const int G = gridDim.x;
    volatile LAS unsigned* MISC = (volatile LAS unsigned*)(lds + LDS_BYTES - 128);
    const int wave_s = __builtin_amdgcn_readfirstlane((int)threadIdx.x >> 6);
    if (threadIdx.x < 32) MISC[threadIdx.x] = 0u;
    __syncthreads();
    XcdBarrier xbar = xcd_barrier_post((unsigned*)P.ws, MISC + 8, wave_s);
    unsigned char* ws = P.ws;
    const float* MOD = (const float*)(ws + WS_MOD);
    bf16_t* XN = (bf16_t*)(ws + WS_XN);
    bf16_t* ACT = (bf16_t*)(ws + WS_ACT);
#define GSYNC() xcd_barrier(xbar)
    if (PROBE == 30) { { FRESH(); p0_mod(P, lds, tid, bid, G); } { FRESH(); p0_rope(P, tid, bid, G); } __syncthreads(); }
    if (PROBE == 31) { FRESH(); conv_weights(P.ret_w_in, RET_IN, 6144, P.ret_w_out, 2048, ws + WS_W, lds, tid, bid, G); __syncthreads(); }
    { FRESH(); p0_mod(P, lds, tid, bid, G); }
    { FRESH(); p0_rope(P, tid, bid, G); }
    { FRESH(); conv_weights(P.ret_w_in, RET_IN, 6144, P.ret_w_out, 2048, ws + WS_W, lds, tid, bid, G); }
    grid.sync();
#pragma unroll 1
    for (int layer = 0; layer < 4; ++layer) {
        const int kind = layer % 3, j = layer / 3;
        unsigned char* wbase = ws + ((kind == 2) ? WS_WGLA : WS_W);
        bf16_t* WinT = (bf16_t*)wbase; bf16_t* WoutT = (bf16_t*)(wbase + 12 * MiB);
        const float* xin = (layer == 0) ? P.x : P.out;
        if (layer > 0) {
            FRESH();
            if (kind == 0) { if (G != 256) conv_weights(P.ret_w_in + (size_t)j * 1024 * RET_IN, RET_IN, 6144, P.ret_w_out + (size_t)j * 2048 * 1024, 2048, ws + WS_W, lds, tid, bid, G); }
            else if (kind == 1) conv_weights(P.fox_w_in, FOX_IN, 4096, P.fox_w_out, 1024, ws + WS_W, lds, tid, bid, G);
            else conv_weights(P.gla_w_in, GLA_IN, 3072, P.gla_w_out, 1024, ws + WS_WGLA, lds, tid, bid, G);
            __syncthreads();
        }
        if (PROBE == 5 || (PROBE >= 50 && PROBE <= 53 && layer == PROBE - 50)) {
            if (kind == 0) { FRESH(); h_phase<0>(P, layer, xin, lds, tid, bid, G); }
            else if (kind == 1) { FRESH(); h_phase<1>(P, layer, xin, lds, tid, bid, G); }
            else { FRESH(); h_phase<2>(P, layer, xin, lds, tid, bid, G); }
            __syncthreads();
        }
        if (kind == 0) { FRESH(); h_phase<0>(P, layer, xin, lds, tid, bid, G); }
        else if (kind == 1) { FRESH(); h_phase<1>(P, layer, xin, lds, tid, bid, G); }
        else { FRESH(); h_phase<2>(P, layer, xin, lds, tid, bid, G); }
        GSYNC();
        const float* gate = MOD + (size_t)(layer * 4) * 3072 + 2048;
        if (kind == 0) {
            bf16_t* rQ = ACT; bf16_t* rK = (bf16_t*)(ws + WS_ACT + 32 * MiB); bf16_t* rV = (bf16_t*)(ws + WS_ACT + 64 * MiB); bf16_t* rO = (bf16_t*)(ws + WS_ACT + 128 * MiB);
            bf16_t* rP = WinT;
            float* STATS = (float*)(ws + WS_S16);
            {
                FRESH();
                pg8::Gemm g{XN, WinT, MT, 4096, 1024}; pg8::StaticOrder S; S.init(MT, 4096, G, bid);
                EpiRetIn E{rQ, rK, rV, (const unsigned*)(ws + WS_ROPE)};
                pg8::gemm_phase<EpiRetIn, pg8::StaticOrder, true, true>(lds, g, S, E, tid);
            }
            GSYNC();
            if (PROBE == 40) { FRESH();
                pg8::Gemm g{XN, WinT, MT, 4096, 1024}; pg8::StaticOrder S; S.init(MT, 4096, G, bid);
                EpiRetIn E{rQ, rK, rV, (const unsigned*)(ws + WS_ROPE)};
                pg8::gemm_phase<EpiRetIn, pg8::StaticOrder, true, true>(lds, g, S, E, tid); GSYNC(); }
            if (PROBE == 6) { FRESH();
                pg8::Gemm g{XN, WinT + (size_t)4096 * 1024, MT, 2048, 1024}; pg8::StaticOrder S; S.init(MT, 2048, G, bid);
                EpiSplit E{(bf16_t*)P.out, 8, 0, 2048, -1};
                if (layer == 0) { pg8::gemm_phase<EpiSplit, pg8::StaticOrder, true, true>(lds, g, S, E, tid); GSYNC(); } }
            if (PROBE == 62 && layer == 0) { FRESH();
                pg8::Gemm g{XN, WinT, MT, 4096, 1024}; pg8::StaticOrder S; S.init(MT, 4096, G, bid);
                EpiNone E{P.out};
                pg8::gemm_phase<EpiNone, pg8::StaticOrder, true, true>(lds, g, S, E, tid); GSYNC(); }
            if (PROBE == 60 && layer == 0) { FRESH();
                pg8::Gemm g{XN, WinT + (size_t)4096 * 1024, MT, 2048, 1024}; pg8::StaticOrder S; S.init(MT, 2048, G, bid);
                EpiNone E{P.out};
                pg8::gemm_phase<EpiNone, pg8::StaticOrder, true, true>(lds, g, S, E, tid); GSYNC(); }
            { FRESH(); lin_pphase<0>(rQ, rK, rQ, rK, rP, tid, bid, G); }
            GSYNC();
            if (PROBE == 2) { FRESH(); lin_scan<0>(rQ, rK, rV, rP, nullptr, rO, (float*)(ws + WS_CUM), lds, tid, bid, G); GSYNC(); }
            if (PROBE == 20 && layer == 0) { FRESH(); lin_scan<0, 1>(rQ, rK, rV, rP, nullptr, (bf16_t*)P.out, (float*)(ws + WS_CUM), lds, tid, bid, G); GSYNC(); }
            if (PROBE == 23 && layer == 0) { FRESH(); lin_scan<0, 4>(rQ, rK, rV, rP, nullptr, (bf16_t*)P.out, (float*)(ws + WS_CUM), lds, tid, bid, G); GSYNC(); }
            if (PROBE == 25 && layer == 0) { FRESH(); lin_scan<0, 16>(rQ, rK, rV, rP, nullptr, (bf16_t*)P.out, (float*)(ws + WS_CUM), lds, tid, bid, G); GSYNC(); }
            if (PROBE == 21 && layer == 0) { FRESH(); lin_scan<0, 2>(rQ, rK, rV, rP, nullptr, (bf16_t*)P.out, (float*)(ws + WS_CUM), lds, tid, bid, G); GSYNC(); }
            if (PROBE == 24 && layer == 0) { FRESH(); lin_scan<0, 8>(rQ, rK, rV, rP, nullptr, (bf16_t*)P.out, (float*)(ws + WS_CUM), lds, tid, bid, G); GSYNC(); }
            if (PROBE == 26 && layer == 0) { FRESH(); lin_scan<0, 3>(rQ, rK, rV, rP, nullptr, (bf16_t*)P.out, (float*)(ws + WS_CUM), lds, tid, bid, G); GSYNC(); }
            if (PROBE == 27 && layer == 0) { FRESH(); lin_scan<0, 11>(rQ, rK, rV, rP, nullptr, (bf16_t*)P.out, (float*)(ws + WS_CUM), lds, tid, bid, G); GSYNC(); }
            if (PROBE == 28 && layer == 0) { FRESH(); lin_scan<0, 31>(rQ, rK, rV, rP, nullptr, (bf16_t*)P.out, (float*)(ws + WS_CUM), lds, tid, bid, G); GSYNC(); }
            if (PROBE == 22 && layer == 0) { FRESH(); lin_scan<0, 0>(rQ, rK, rV, rP, nullptr, (bf16_t*)P.out, (float*)(ws + WS_CUM), lds, tid, bid, G); GSYNC(); }
            { FRESH(); lin_scan<0>(rQ, rK, rV, rP, nullptr, rO, (float*)(ws + WS_CUM), lds, tid, bid, G); }
            GSYNC();
            {
                FRESH();
                pg8::Gemm g{XN, WinT + (size_t)4096 * 1024, MT, 2048, 1024}; pg8::PairOrder S{G, (G % 8 == 0) ? (bid % 8) * (G / 8) + bid / 8 : bid};
                EpiGateNorm<0> E{rO, rV, (LAS float*)(lds + 131072)};
                pg8::gemm_phase<EpiGateNorm<0>, pg8::PairOrder, true, true>(lds, g, S, E, tid);
            }
            GSYNC();
            if (PROBE == 42 && layer == 0) { FRESH();
                pg8::Gemm g{rV, WoutT, MT, 1024, 2048}; pg8::StaticOrder S; S.init(MT, 1024, G, bid);
                EpiOut E{xin, P.out, gate};
                pg8::gemm_phase<EpiOut, pg8::StaticOrder, true, true>(lds, g, S, E, tid); GSYNC(); }
            {
                FRESH();
                pg8::Gemm g{rV, WoutT, MT, 1024, 2048}; pg8::StaticOrder S; S.init(MT, 1024, G, bid);
                EpiOut E{xin, P.out, gate};
                pg8::gemm_phase<EpiOut, pg8::StaticOrder, true, true>(lds, g, S, E, tid);
            }
            GSYNC();
        } else if (kind == 1) {
            {
                FRESH();
                pg8::Gemm g{XN, WinT, MT, 4096, 1024}; pg8::StaticOrder S; S.init(MT, 4096, G, bid);
                EpiFoxIn E{ACT, P.fox_q_gain, P.fox_k_gain, (LAS float*)(lds + 131072)};
                pg8::gemm_phase<EpiFoxIn, pg8::StaticOrder, true, true>(lds, g, S, E, tid);
            }
            GSYNC();
            if (PROBE == 41) { FRESH();
                pg8::Gemm g{XN, WinT, MT, 4096, 1024}; pg8::StaticOrder S; S.init(MT, 4096, G, bid);
                EpiFoxIn E{ACT, P.fox_q_gain, P.fox_k_gain, (LAS float*)(lds + 131072)};
                pg8::gemm_phase<EpiFoxIn, pg8::StaticOrder, true, true>(lds, g, S, E, tid); GSYNC(); }
            if (PROBE == 1) { FRESH(); fox_attn2(P, (char*)lds_raw, tid, bid, G, XN); GSYNC(); }
            { FRESH(); fox_attn2(P, (char*)lds_raw, tid, bid, G, nullptr); }
            GSYNC();
            {
                FRESH();
                pg8::Gemm g{ACT, WoutT, MT, 1024, 1024}; pg8::StaticOrder S; S.init(MT, 1024, G, bid);
                EpiOut E{xin, P.out, gate};
                pg8::gemm_phase<EpiOut, pg8::StaticOrder, true, true>(lds, g, S, E, tid);
            }
            GSYNC();
        } else {
            bf16_t* gQE = ACT; bf16_t* gQN = (bf16_t*)(ws + WS_ACT + 16 * MiB); bf16_t* gKE = (bf16_t*)(ws + WS_ACT + 32 * MiB); bf16_t* gKN = (bf16_t*)(ws + WS_ACT + 48 * MiB);
            bf16_t* gV = (bf16_t*)(ws + WS_ACT + 64 * MiB); bf16_t* gP = (bf16_t*)(ws + WS_ACT + 96 * MiB); bf16_t* gO = (bf16_t*)(ws + WS_ACT + 128 * MiB);
            const float* gCB = (const float*)(ws + WS_ACT + 160 * MiB);
            float* STATS = (float*)(ws + WS_S16);
            {
                FRESH();
                pg8::Gemm g{XN, WinT, MT, 2048, 1024}; pg8::StaticOrder S; S.init(MT, 2048, G, bid);
                EpiGlaIn E{gQE, gQN, gKE, gKN, gV, nullptr, gCB};
                pg8::gemm_phase<EpiGlaIn, pg8::StaticOrder, true, true>(lds, g, S, E, tid);
            }
            GSYNC();
            { FRESH(); lin_pphase<1>(gQE, gKN, gQN, gKE, gP, tid, bid, G); }
            GSYNC();
            if (PROBE == 3) { FRESH(); lin_scan<1>(gQE, gKN, gV, gP, gCB, gO, (float*)(ws + WS_CUM), lds, tid, bid, G); GSYNC(); }
            if (G == 256 && ((int)blockIdx.x >> 3) >= 16) {
                FRESH(); const int sub = (bid & 7) * 16 + ((bid >> 3) - 16);
                conv_weights(P.ret_w_in + (size_t)1 * 1024 * RET_IN, RET_IN, 6144, P.ret_w_out + (size_t)1 * 2048 * 1024, 2048, ws + WS_W, lds, tid, sub, 128);
            } else { FRESH(); lin_scan<1>(gQE, gKN, gV, gP, gCB, gO, (float*)(ws + WS_CUM), lds, tid, bid, G); }
            GSYNC();
            {
                FRESH();
                pg8::Gemm g{XN, WinT + (size_t)2048 * 1024, MT, 1024, 1024}; pg8::StaticOrder S; S.init(MT, 1024, G, bid);
                EpiGateNorm<1> E{gO, gV, (LAS float*)(lds + 131072)};
                pg8::gemm_phase<EpiGateNorm<1>, pg8::StaticOrder, true, true>(lds, g, S, E, tid);
            }
            GSYNC();
            {
                FRESH();
                pg8::Gemm g{gV, WoutT, MT, 1024, 1024}; pg8::StaticOrder S; S.init(MT, 1024, G, bid);
                EpiOut E{xin, P.out, gate};
                pg8::gemm_phase<EpiOut, pg8::StaticOrder, true, true>(lds, g, S, E, tid);
            }
            GSYNC();
        }
    }
    if (PROBE == 70) { for (int i = 0; i < 10; ++i) GSYNC(); }
    { FRESH(); final_norm(P, tid, bid, G); }
}

extern "C" void kernel_launch(void* const* d_in, const int* in_sizes, int n_in, void* d_out, int out_size, void* d_ws, size_t ws_size, hipStream_t stream) {
    static int grid = 0;
    if (grid == 0) {
        if (n_in != 18 || out_size != MT * DM || ws_size < WS_END) { fprintf(stderr, "kernel_launch: unexpected shapes (n_in %d out %d ws %zu)\n", n_in, out_size, ws_size); grid = -1; return; }
        int dev = 0, cus = 0, per_cu = 0;
        hipGetDevice(&dev);
        hipDeviceGetAttribute(&cus, hipDeviceAttributeMultiprocessorCount, dev);
        hipFuncSetAttribute((const void*)trunk_fwd, hipFuncAttributeMaxDynamicSharedMemorySize, LDS_BYTES);
        hipOccupancyMaxActiveBlocksPerMultiprocessor(&per_cu, (const void*)trunk_fwd, 512, LDS_BYTES);
        if (per_cu < 1) { fprintf(stderr, "kernel_launch: occupancy query says %d blocks per CU\n", per_cu); per_cu = 1; }
        (void)hipGetLastError();
        grid = cus;
    }
    if (grid < 0) return;
    Params p{};
    p.x = (const float*)d_in[0]; p.c = (const float*)d_in[1]; p.pos = (const int*)d_in[2]; p.mod_w = (const float*)d_in[3]; p.mod_b = (const float*)d_in[4]; p.norm_g = (const float*)d_in[5];
    p.ret_w_in = (const float*)d_in[6]; p.ret_w_out = (const float*)d_in[7]; p.fox_w_in = (const float*)d_in[8]; p.fox_b_f = (const float*)d_in[9]; p.fox_q_gain = (const float*)d_in[10]; p.fox_k_gain = (const float*)d_in[11];
    p.fox_w_out = (const float*)d_in[12]; p.gla_w_in = (const float*)d_in[13]; p.gla_w_gate2 = (const float*)d_in[14]; p.gla_b_gate = (const float*)d_in[15]; p.gla_w_out = (const float*)d_in[16]; p.final_g = (const float*)d_in[17];
    p.out = (float*)d_out; p.ws = (unsigned char*)d_ws;
    if (hipMemsetAsync(d_ws, 0, 16384, stream) != hipSuccess) { fprintf(stderr, "kernel_launch: memset failed\n"); return; }
    void* args[] = {&p};
    hipError_t e = hipLaunchCooperativeKernel((const void*)trunk_fwd, dim3(grid), dim3(512), args, LDS_BYTES, stream);
    if (e != hipSuccess) fprintf(stderr, "cooperative launch failed: %s (grid %d)\n", hipGetErrorString(e), grid);
}
```

```cpp
#include <hip/hip_runtime.h>
#include <hip/hip_cooperative_groups.h>
#include <cstdio>
#include <cstdint>
#include <cmath>
namespace cg = cooperative_groups;

#define LAS __attribute__((address_space(3)))
typedef unsigned short bf16_t;
typedef short bf16x8 __attribute__((ext_vector_type(8)));
typedef float f32x4 __attribute__((ext_vector_type(4)));
typedef float f32x2 __attribute__((ext_vector_type(2)));
typedef unsigned u32x4 __attribute__((ext_vector_type(4)));
typedef unsigned u32x2 __attribute__((ext_vector_type(2)));

constexpr int DM = 1024, NB = 4, SEQ = 4096, MT = NB * SEQ;
constexpr float EPS = 1e-6f;
constexpr int RET_IN = 6144, FOX_IN = 4112, GLA_IN = 3088;
constexpr float LOG2E = 1.4426950408889634f;

constexpr size_t MiB = 1u << 20;
constexpr size_t WS_MOD = 1 * MiB;
constexpr size_t WS_S16 = 2 * MiB;
constexpr size_t WS_CUM = 3 * MiB;
constexpr size_t WS_ROPE = 4 * MiB;
constexpr size_t WS_W = 12 * MiB;
constexpr size_t WS_WOUT = WS_W + 12 * MiB;
constexpr size_t WS_WGLA = 164 * MiB;
constexpr size_t WS_XN = 28 * MiB;
constexpr size_t WS_ACT = 60 * MiB;
constexpr size_t WS_END = 252 * MiB;

__device__ __forceinline__ unsigned f2bf(float f) { unsigned u = __builtin_bit_cast(unsigned, f); return (u + 0x7fffu + ((u >> 16) & 1u)) >> 16; }
typedef float f32x2_hw __attribute__((ext_vector_type(2))); typedef __bf16 bf16x2_hw __attribute__((ext_vector_type(2)));
__device__ __forceinline__ unsigned pk2(float lo, float hi) { f32x2_hw v = {lo, hi}; bf16x2_hw b = __builtin_convertvector(v, bf16x2_hw); return __builtin_bit_cast(unsigned, b); }
__device__ __forceinline__ float bf2f(unsigned h) { return __builtin_bit_cast(float, h << 16); }
__device__ __forceinline__ u32x2 pk4(f32x4 v) { u32x2 r; r.x = pk2(v[0], v[1]); r.y = pk2(v[2], v[3]); return r; }
__device__ __forceinline__ f32x4 unpk4(u32x2 w) { f32x4 r; r[0] = bf2f(w.x & 0xffffu); r[1] = bf2f(w.x >> 16); r[2] = bf2f(w.y & 0xffffu); r[3] = bf2f(w.y >> 16); return r; }
__device__ __forceinline__ float silu_f(float v) { return v * __builtin_amdgcn_rcpf(1.0f + __expf(-v)); }
__device__ __forceinline__ float logsig_f(float v) { return fminf(v, 0.0f) - __logf(1.0f + __expf(-fabsf(v))); }
template <int CTRL> __device__ __forceinline__ float dpp_mov(float v) { return __builtin_bit_cast(float, __builtin_amdgcn_update_dpp(0, __builtin_bit_cast(int, v), CTRL, 0xf, 0xf, true)); }
__device__ __forceinline__ float swap32_sum(float x, float y) { auto r = __builtin_amdgcn_permlane32_swap(__builtin_bit_cast(unsigned, x), __builtin_bit_cast(unsigned, y), false, false); const unsigned r0 = r[0], r1 = r[1]; return __builtin_bit_cast(float, r0) + __builtin_bit_cast(float, r1); }
__device__ __forceinline__ float swap16_sum(float x, float y) { auto r = __builtin_amdgcn_permlane16_swap(__builtin_bit_cast(unsigned, x), __builtin_bit_cast(unsigned, y), false, false); const unsigned r0 = r[0], r1 = r[1]; return __builtin_bit_cast(float, r0) + __builtin_bit_cast(float, r1); }
__device__ __forceinline__ float row_sum16(float v) {
    v += dpp_mov<0xB1>(v);
    v += dpp_mov<0x4E>(v);
    v += dpp_mov<0x141>(v);
    v += dpp_mov<0x140>(v);
    return v;
}
__device__ __forceinline__ float xsum_16_32(float v) { v = swap16_sum(v, v); return swap32_sum(v, v); }
__device__ __forceinline__ float wave_sum(float v) { return xsum_16_32(row_sum16(v)); }
__device__ __forceinline__ float reduce_scatter16(const float (&a)[16], int lane) {
    float b8[8], c4[4], d2[2], e1;
#pragma unroll
    for (int i = 0; i < 8; ++i) b8[i] = swap32_sum(a[i], a[i + 8]);
#pragma unroll
    for (int i = 0; i < 4; ++i) c4[i] = swap16_sum(b8[i], b8[i + 4]);
    { const bool hi = (lane & 8) != 0;
#pragma unroll
      for (int i = 0; i < 2; ++i) { const float snd = hi ? c4[i] : c4[i + 2], kp = hi ? c4[i + 2] : c4[i]; d2[i] = kp + dpp_mov<0x128>(snd); } }
    { const bool hi = (lane & 4) != 0; const float snd = hi ? d2[0] : d2[1], kp = hi ? d2[1] : d2[0]; e1 = kp + dpp_mov<0x1B>(dpp_mov<0x141>(snd)); }
    e1 += dpp_mov<0x4E>(e1); e1 += dpp_mov<0xB1>(e1);
    return e1;
}
#define LDS_WAIT() asm volatile("s_waitcnt lgkmcnt(0)" ::: "memory")

__device__ __forceinline__ f32x4 mma_rc(f32x4 acc, bf16x8 a_rows, bf16x8 b_cols) { return __builtin_amdgcn_mfma_f32_16x16x32_bf16(b_cols, a_rows, acc, 0, 0, 0); }
__device__ __forceinline__ f32x4 mma_cr(f32x4 acc, bf16x8 a_rows, bf16x8 b_cols) { return __builtin_amdgcn_mfma_f32_16x16x32_bf16(a_rows, b_cols, acc, 0, 0, 0); }
__device__ __forceinline__ bf16x8 gfrag(const bf16_t* base, int pitch, int lane) { return *(const bf16x8*)(base + (size_t)(lane & 15) * pitch + 8 * (lane >> 4)); }
__device__ __forceinline__ bf16x8 lfrag(const LAS bf16_t* base, int pitch, int lane) { return *(const LAS bf16x8*)(base + (lane & 15) * pitch + 8 * (lane >> 4)); }

namespace pg8 {
#define PG8_LAS __attribute__((address_space(3)))
constexpr int BM = 256, BK = 64, HALF = 128, HTB = HALF * BK * 2, STAGE_BYTES = 8 * HTB, NXCD = 8, WGM = 8;
__host__ __device__ __forceinline__ int lds_byte(int r, int c) { const int st = (r >> 4) * 2 + (c >> 5), rr = r & 15, cc = c & 31, ob = rr * 64 + cc * 2; return st * 1024 + (ob ^ (((ob >> 9) & 1) << 5)); }
__host__ __device__ __forceinline__ void stage_rc(int b, int& R, int& C) { const int st = b / 1024, sb = b % 1024, swz = sb ^ (((sb >> 9) & 1) << 5); R = (st >> 1) * 16 + swz / 64; C = (st & 1) * 32 + (swz % 64) / 2; }
__host__ __device__ __forceinline__ int perm32(int rho) { const int n = rho >> 4, i = rho & 15; return 8 * (i >> 2) + 4 * n + (i & 3); }

struct Unit { int pm, pn; };
struct Gemm { const bf16_t* A; const bf16_t* Bt; int M, N, K; };
struct StaticOrder {
    int nM, nN, nwg, G, c;
    __host__ __device__ void init(int M, int N, int G_, int c_) { nM = M / BM; nN = N / BM; nwg = nM * nN; G = G_; c = c_; }
    __host__ __device__ bool next(int i, Unit& u) const {
        const long L = (long)i * G + c; if (L >= nwg) return false;
        int wgid = (int)L; { const int q = nwg / NXCD, r = nwg % NXCD, xcd = wgid % NXCD, off = wgid / NXCD; wgid = (xcd < r ? xcd * (q + 1) : r * (q + 1) + (xcd - r) * q) + off; }
        const int nig = WGM * nN, gid = wgid / nig, fm = gid * WGM, gsz = (nM - fm) < WGM ? (nM - fm) : WGM;
        u.pm = fm + ((wgid % nig) % gsz); u.pn = (wgid % nig) / gsz; return true;
    }
    __device__ __forceinline__ void a_ready(const Unit&) const {}
    __device__ __forceinline__ void done(const Unit&) const {}
};

struct PairOrder {
    int G, c;
    __device__ __forceinline__ bool next(int i, Unit& u) const { const int pair = (i >> 1) * G + c; if (pair >= 256) return false; u.pm = pair >> 2; u.pn = 2 * (pair & 3) + (i & 1); return true; }
    __device__ __forceinline__ void a_ready(const Unit&) const {}
    __device__ __forceinline__ void done(const Unit&) const {}
};
template <class Epi, class Sched, bool ALIGN_EPI = false, bool SP2 = false>
__device__ __forceinline__ void gemm_phase(PG8_LAS unsigned char* lds, const Gemm g, const Sched& S, const Epi& E, int tid) {
    const int wid = __builtin_amdgcn_readfirstlane(tid >> 6), lane = tid & 63, wr = wid >> 2, wc = wid & 3, fr = lane & 15, fq = lane >> 4;
    const int K = g.K, nt = K / BK;
    unsigned voffA[2], voffB[2];
#pragma unroll
    for (int i = 0; i < 2; ++i) { int R, C; stage_rc(tid * 16 + i * 8192, R, C); const int Rb = Epi::PERM ? ((R & ~31) + perm32(R & 31)) : R;
        voffA[i] = (unsigned)(R * K + C) * 2u; voffB[i] = (unsigned)(Rb * K + C) * 2u; }
    const size_t kstep = (size_t)(BK * 2);
    const size_t hstep = (size_t)HALF * K * 2;
    const size_t tstep = 2 * hstep;
    const unsigned ldsw = (unsigned)wid * 1024u;
    const int aoff = lds_byte(wr * 64 + fr, fq * 8), boff = lds_byte(wc * 32 + fr, fq * 8);
#define PG8_SA(b, h) (((b) * 2 + (h)) * HTB)
#define PG8_SB(b, h) ((4 + (b) * 2 + (h)) * HTB)
#define PG8_STAGE(bufoff, gbase, voff) do { _Pragma("unroll") for (int _i = 0; _i < 2; ++_i) \
        __builtin_amdgcn_global_load_lds((const unsigned*)((const char*)(gbase) + (voff)[_i]), (PG8_LAS unsigned*)(lds + (bufoff) + ldsw + _i * 8192), 16, 0, 0); } while (0)
#define PG8_LDA(dst, b, h) do { _Pragma("unroll") for (int m = 0; m < 4; ++m) _Pragma("unroll") for (int k = 0; k < 2; ++k) dst[m][k] = *(const PG8_LAS bf16x8*)(lds + PG8_SA(b, h) + aoff + m * 2048 + k * 1024); } while (0)
#define PG8_LDB(dst, b, h) do { _Pragma("unroll") for (int n = 0; n < 2; ++n) _Pragma("unroll") for (int k = 0; k < 2; ++k) dst[n][k] = *(const PG8_LAS bf16x8*)(lds + PG8_SB(b, h) + boff + n * 2048 + k * 1024); } while (0)
#define PG8_MMA(ai, bj, At, Bt) do { __builtin_amdgcn_s_setprio(1); _Pragma("unroll") for (int m = 0; m < 4; ++m) _Pragma("unroll") for (int n = 0; n < 2; ++n) _Pragma("unroll") for (int k = 0; k < 2; ++k) \
        acc[ai][bj][m][n] = __builtin_amdgcn_mfma_f32_16x16x32_bf16(Bt[n][k], At[m][k], acc[ai][bj][m][n], 0, 0, 0); __builtin_amdgcn_s_setprio(0); } while (0)
#define PG8_WAIT_V(n) asm volatile("s_waitcnt vmcnt(" #n ")" ::: "memory")
#define PG8_WAIT_L(n) asm volatile("s_waitcnt lgkmcnt(" #n ")" ::: "memory")
#define PG8_BAR __builtin_amdgcn_s_barrier()
#define PG8_SCHED __builtin_amdgcn_sched_barrier(0)
    Unit cur, nxt; int ui = 0;
    if (!S.next(0, cur)) return;
    f32x4 acc[2][2][4][2];
#pragma unroll
    for (int a = 0; a < 2; ++a)
#pragma unroll
        for (int b = 0; b < 2; ++b)
#pragma unroll
            for (int m = 0; m < 4; ++m)
#pragma unroll
                for (int n = 0; n < 2; ++n) acc[a][b][m][n] = (f32x4){0.f, 0.f, 0.f, 0.f};
    bf16x8 At[4][2], B0[2][2], B1[2][2];
    const char* cA = (const char*)g.A + (size_t)cur.pm * tstep; const char* cB = (const char*)g.Bt + (size_t)cur.pn * tstep;
    S.a_ready(cur);
    if constexpr (SP2) {
        PG8_STAGE(PG8_SB(0, 0), cB, voffB); PG8_STAGE(PG8_SB(0, 1), cB + hstep, voffB); PG8_STAGE(PG8_SA(0, 0), cA, voffA); PG8_STAGE(PG8_SA(0, 1), cA + hstep, voffA);
        if (wr == 1) PG8_BAR;
        PG8_WAIT_V(2); PG8_BAR;
        PG8_STAGE(PG8_SB(1, 0), cB + kstep, voffB); PG8_STAGE(PG8_SA(1, 0), cA + kstep, voffA); PG8_STAGE(PG8_SB(1, 1), cB + hstep + kstep, voffB);
        PG8_WAIT_V(6); PG8_BAR;
    } else {
        PG8_STAGE(PG8_SB(0, 0), cB, voffB); PG8_STAGE(PG8_SA(0, 0), cA, voffA); PG8_STAGE(PG8_SB(0, 1), cB + hstep, voffB); PG8_STAGE(PG8_SA(0, 1), cA + hstep, voffA);
        if (wr == 1) PG8_BAR;
        PG8_WAIT_V(4); PG8_BAR;
        PG8_STAGE(PG8_SB(1, 0), cB + kstep, voffB); PG8_STAGE(PG8_SA(1, 0), cA + kstep, voffA); PG8_STAGE(PG8_SB(1, 1), cB + hstep + kstep, voffB);
        PG8_WAIT_V(6); PG8_BAR;
    }
    for (;;) {
        const bool has_next = S.next(ui + 1, nxt);
        const char* nA = has_next ? (const char*)g.A + (size_t)nxt.pm * tstep : cA; const char* nB = has_next ? (const char*)g.Bt + (size_t)nxt.pn * tstep : cB;
        for (int t = 0; t < nt; t += 2) {
            const bool last = (t == nt - 2);
            const char* a1 = cA + (size_t)(t + 1) * kstep;
            const char* a2 = last ? nA : cA + (size_t)(t + 2) * kstep; const char* b2 = last ? nB : cB + (size_t)(t + 2) * kstep;
            const char* a3 = a2 + kstep; const char* b3 = b2 + kstep;
            if (last && has_next) S.a_ready(nxt);
            if constexpr (SP2) {
            PG8_LDB(B0, 0, 0); PG8_LDB(B1, 0, 1); PG8_SCHED; PG8_LDA(At, 0, 0); PG8_STAGE(PG8_SA(1, 1), a1 + hstep, voffA);
            PG8_WAIT_V(8); PG8_WAIT_L(0); PG8_BAR; PG8_MMA(0, 0, At, B0); PG8_MMA(0, 1, At, B1); PG8_BAR; PG8_SCHED;
            PG8_LDA(At, 0, 1); PG8_STAGE(PG8_SB(0, 0), b2, voffB); PG8_STAGE(PG8_SB(0, 1), b2 + hstep, voffB); PG8_STAGE(PG8_SA(0, 0), a2, voffA);
            PG8_WAIT_V(8); PG8_WAIT_L(0); PG8_BAR; PG8_MMA(1, 0, At, B0); PG8_MMA(1, 1, At, B1); PG8_BAR; PG8_SCHED;
            PG8_LDB(B0, 1, 0); PG8_LDB(B1, 1, 1); PG8_SCHED; PG8_LDA(At, 1, 0); PG8_STAGE(PG8_SA(0, 1), a2 + hstep, voffA);
            PG8_WAIT_V(8); PG8_WAIT_L(0); PG8_BAR; PG8_MMA(0, 0, At, B0); PG8_MMA(0, 1, At, B1); PG8_BAR; PG8_SCHED;
            PG8_LDA(At, 1, 1); PG8_STAGE(PG8_SB(1, 0), b3, voffB); PG8_STAGE(PG8_SB(1, 1), b3 + hstep, voffB); PG8_STAGE(PG8_SA(1, 0), a3, voffA);
            PG8_WAIT_V(8); PG8_WAIT_L(0); PG8_BAR; PG8_MMA(1, 0, At, B0); PG8_MMA(1, 1, At, B1); PG8_BAR; PG8_SCHED;
            } else {
            PG8_LDB(B0, 0, 0); PG8_SCHED; PG8_LDA(At, 0, 0); PG8_STAGE(PG8_SA(1, 1), a1 + hstep, voffA);
            PG8_WAIT_L(8); PG8_BAR; PG8_WAIT_L(0); PG8_MMA(0, 0, At, B0); PG8_BAR; PG8_SCHED;
            PG8_LDB(B1, 0, 1); PG8_STAGE(PG8_SB(0, 0), b2, voffB);
            PG8_BAR; PG8_WAIT_L(0); PG8_MMA(0, 1, At, B1); PG8_BAR;
            PG8_LDA(At, 0, 1); PG8_STAGE(PG8_SA(0, 0), a2, voffA);
            PG8_BAR; PG8_WAIT_L(0); PG8_MMA(1, 0, At, B0); PG8_BAR; PG8_SCHED;
            PG8_STAGE(PG8_SB(0, 1), b2 + hstep, voffB);
            PG8_WAIT_V(6); PG8_BAR; PG8_MMA(1, 1, At, B1); PG8_BAR;
            PG8_LDB(B0, 1, 0); PG8_SCHED; PG8_LDA(At, 1, 0); PG8_STAGE(PG8_SA(0, 1), a2 + hstep, voffA);
            PG8_WAIT_L(8); PG8_BAR; PG8_WAIT_L(0); PG8_MMA(0, 0, At, B0); PG8_BAR; PG8_SCHED;
            PG8_LDB(B1, 1, 1); PG8_STAGE(PG8_SB(1, 0), b3, voffB);
            PG8_BAR; PG8_WAIT_L(0); PG8_MMA(0, 1, At, B1); PG8_BAR;
            PG8_LDA(At, 1, 1); PG8_STAGE(PG8_SA(1, 0), a3, voffA);
            PG8_BAR; PG8_WAIT_L(0); PG8_MMA(1, 0, At, B0); PG8_BAR; PG8_SCHED;
            PG8_STAGE(PG8_SB(1, 1), b3 + hstep, voffB);
            PG8_WAIT_V(6); PG8_BAR; PG8_MMA(1, 1, At, B1); PG8_BAR;
            }
        }
        if constexpr (ALIGN_EPI) { if (wr == 0) PG8_BAR; }
        E(acc, cur, wr, wc, fr, fq); S.done(cur);
        if (!has_next) break;
#pragma unroll
        for (int a = 0; a < 2; ++a)
#pragma unroll
            for (int b = 0; b < 2; ++b)
#pragma unroll
                for (int m = 0; m < 4; ++m)
#pragma unroll
                    for (int n = 0; n < 2; ++n) acc[a][b][m][n] = (f32x4){0.f, 0.f, 0.f, 0.f};
        cur = nxt; cA = nA; cB = nB; ++ui;
        if constexpr (ALIGN_EPI) { if (wr == 1) PG8_BAR; }
    }
    PG8_WAIT_V(0);
    if constexpr (!ALIGN_EPI) { if (wr == 0) PG8_BAR; }
    PG8_BAR;
#undef PG8_SA
#undef PG8_SB
#undef PG8_STAGE
#undef PG8_LDA
#undef PG8_LDB
#undef PG8_MMA
#undef PG8_WAIT_V
#undef PG8_WAIT_L
#undef PG8_BAR
#undef PG8_SCHED
}
}

struct Params {
    const float* x; const float* c; const int* pos; const float* mod_w; const float* mod_b; const float* norm_g;
    const float* ret_w_in; const float* ret_w_out; const float* fox_w_in; const float* fox_b_f; const float* fox_q_gain; const float* fox_k_gain; const float* fox_w_out;
    const float* gla_w_in; const float* gla_w_gate2; const float* gla_b_gate; const float* gla_w_out; const float* final_g;
    float* out; unsigned char* ws;
};

template <int DK> __device__ __forceinline__ size_t frag_img_off(int row, int head, int ch0) {
    const int b = row >> 12, tok = row & 4095;
    return (size_t)((b * 4 + head) * 64 + (tok >> 6)) * (64 * DK * 2) + (size_t)((((ch0 >> 5) * 4 + ((tok >> 4) & 3)) * 64 + 16 * ((ch0 >> 3) & 3) + (tok & 15)) * 16 + 2 * (ch0 & 7));
}
template <int HV> __device__ __forceinline__ size_t v_img_off(int row, int col) {
    const int b = row >> 12, tok = row & 4095, head = col / HV, e = col % HV;
    return ((size_t)((b * 4 + head) * (HV / 32) + (e >> 5)) * 4096 + tok) * 64 + (size_t)((e & 31) * 2);
}
struct EpiRetIn {
    static constexpr bool PERM = true;
    bf16_t* Q; bf16_t* Kb; bf16_t* V; const unsigned* rope;
    __device__ __forceinline__ void operator()(const f32x4 (&acc)[2][2][4][2], const pg8::Unit& u, int wr, int wc, int fr, int fq) const {
        const int pn = u.pn;
        if (pn < 8) {
            bf16_t* dst = (pn < 4) ? Q : Kb; const int head = pn & 3; const float sc = (pn < 4) ? 0.0625f : 1.0f;
#pragma unroll
            for (int ai = 0; ai < 2; ++ai) {
                u32x4 cs[4][2];
#pragma unroll
                for (int m = 0; m < 4; ++m)
#pragma unroll
                    for (int n = 0; n < 2; ++n) cs[m][n] = *(const u32x4*)(rope + (size_t)(u.pm * 256 + ai * 128 + wr * 64 + m * 16 + fr) * 128 + wc * 32 + fq * 8 + n * 4);
                asm volatile("" ::: "memory");
#pragma unroll
                for (int m = 0; m < 4; ++m) {
                    const int row = u.pm * 256 + ai * 128 + wr * 64 + m * 16 + fr;
                    u32x4 w1, w2;
#pragma unroll
                    for (int n = 0; n < 2; ++n) {
                        const f32x4 x1 = acc[ai][0][m][n], x2 = acc[ai][1][m][n]; f32x4 o1, o2;
#pragma unroll
                        for (int j = 0; j < 4; ++j) {
                            const unsigned w = cs[m][n][j];
                            const float co = (float)__builtin_bit_cast(_Float16, (unsigned short)(w & 0xffffu)), si = (float)__builtin_bit_cast(_Float16, (unsigned short)(w >> 16));
                            o1[j] = (x1[j] * co - x2[j] * si) * sc; o2[j] = (x1[j] * si + x2[j] * co) * sc;
                        }
                        const u32x2 a1 = pk4(o1), a2 = pk4(o2);
                        if (n == 0) { w1.x = a1.x; w1.y = a1.y; w2.x = a2.x; w2.y = a2.y; } else { w1.z = a1.x; w1.w = a1.y; w2.z = a2.x; w2.w = a2.y; }
                    }
                    char* p = (char*)dst + frag_img_off<256>(row, head, wc * 32 + fq * 8);
                    *(u32x4*)p = w1; *(u32x4*)(p + 16384) = w2;
                }
            }
        } else {
            const int cbase = (pn - 8) * 256;
#pragma unroll
            for (int ai = 0; ai < 2; ++ai)
#pragma unroll
                for (int m = 0; m < 4; ++m) {
                    const int row = u.pm * 256 + ai * 128 + wr * 64 + m * 16 + fr;
#pragma unroll
                    for (int bj = 0; bj < 2; ++bj) { const u32x2 a0 = pk4(acc[ai][bj][m][0]), a1 = pk4(acc[ai][bj][m][1]);
                        *(u32x4*)((char*)V + v_img_off<512>(row, cbase + bj * 128 + wc * 32 + fq * 8)) = (u32x4){a0.x, a0.y, a1.x, a1.y}; }
                }
        }
    }
};
struct EpiSplit {
    static constexpr bool PERM = false;
    bf16_t* dst; int tpg; size_t gstride; int ldc; int silu_grp;
    __device__ __forceinline__ void operator()(const f32x4 (&acc)[2][2][4][2], const pg8::Unit& u, int wr, int wc, int fr, int fq) const {
        const int t = u.pn / tpg; bf16_t* base = dst + (size_t)t * gstride; const int cb = (u.pn - t * tpg) * 256; const bool act = (t == silu_grp);
#pragma unroll
        for (int ai = 0; ai < 2; ++ai)
#pragma unroll
            for (int m = 0; m < 4; ++m) {
                const int row = u.pm * 256 + ai * 128 + wr * 64 + m * 16 + fr;
#pragma unroll
                for (int bj = 0; bj < 2; ++bj)
#pragma unroll
                    for (int n = 0; n < 2; ++n) {
                        f32x4 a = acc[ai][bj][m][n];
                        if (act) {
#pragma unroll
                            for (int j = 0; j < 4; ++j) a[j] = silu_f(a[j]);
                        }
                        *(u32x2*)(base + (size_t)row * ldc + cb + bj * 128 + wc * 32 + n * 16 + fq * 4) = pk4(a);
                    }
            }
    }
};
struct EpiFoxIn {
    static constexpr bool PERM = false;
    bf16_t* dst; const float* qgain; const float* kgain; LAS float* tbl;
    __device__ __forceinline__ void operator()(const f32x4 (&acc)[2][2][4][2], const pg8::Unit& u, int wr, int wc, int fr, int fq) const {
        const int t = u.pn >> 2; bf16_t* base = dst + (size_t)t * ((size_t)16 * MiB); const int cb = (u.pn & 3) * 256;
        if (t < 2) {
#pragma unroll
            for (int ai = 0; ai < 2; ++ai)
#pragma unroll
                for (int m = 0; m < 4; ++m)
#pragma unroll
                    for (int bj = 0; bj < 2; ++bj) {
                        float sq = 0.f;
#pragma unroll
                        for (int n = 0; n < 2; ++n) { const f32x4 a = acc[ai][bj][m][n]; sq += (a[0] * a[0] + a[1] * a[1]) + (a[2] * a[2] + a[3] * a[3]); }
                        sq = xsum_16_32(sq);
                        if (fq == 0) tbl[(((ai * 128 + wr * 64 + m * 16 + fr) * 4) + bj * 2 + (wc >> 1)) * 2 + (wc & 1)] = sq;
                    }
            asm volatile("s_waitcnt lgkmcnt(0)" ::: "memory"); __builtin_amdgcn_s_barrier(); asm volatile("" ::: "memory");
            const float* gn = (t == 0) ? qgain : kgain; const float sc = (t == 0) ? (0.125f * LOG2E) : 1.0f;
            f32x4 gv[2];
#pragma unroll
            for (int n = 0; n < 2; ++n) gv[n] = *(const f32x4*)(gn + (wc & 1) * 32 + n * 16 + fq * 4) * sc;
#pragma unroll
            for (int ai = 0; ai < 2; ++ai)
#pragma unroll
                for (int m = 0; m < 4; ++m) {
                    const int rl = ai * 128 + wr * 64 + m * 16 + fr; const int row = u.pm * 256 + rl;
#pragma unroll
                    for (int bj = 0; bj < 2; ++bj) {
                        const f32x2 pr = *(const LAS f32x2*)(tbl + ((rl * 4) + bj * 2 + (wc >> 1)) * 2);
                        const float rstd = __builtin_amdgcn_rsqf((pr.x + pr.y) * (1.0f / 64.0f) + EPS);
#pragma unroll
                        for (int n = 0; n < 2; ++n) *(u32x2*)(base + (size_t)row * 1024 + cb + bj * 128 + wc * 32 + n * 16 + fq * 4) = pk4(acc[ai][bj][m][n] * rstd * gv[n]);
                    }
                }
        } else {
            const bool act = (t == 3);
#pragma unroll
            for (int ai = 0; ai < 2; ++ai)
#pragma unroll
                for (int m = 0; m < 4; ++m) {
                    const int row = u.pm * 256 + ai * 128 + wr * 64 + m * 16 + fr;
#pragma unroll
                    for (int bj = 0; bj < 2; ++bj)
#pragma unroll
                        for (int n = 0; n < 2; ++n) {
                            f32x4 a = acc[ai][bj][m][n];
                            if (act) {
#pragma unroll
                                for (int j = 0; j < 4; ++j) a[j] = silu_f(a[j]);
                            }
                            *(u32x2*)(base + (size_t)row * 1024 + cb + bj * 128 + wc * 32 + n * 16 + fq * 4) = pk4(a);
                        }
                }
        }
    }
};
struct EpiGlaIn {
    static constexpr bool PERM = true;
    bf16_t *QE, *QN, *KE, *KN, *V, *G; const float* CB;
    __device__ __forceinline__ void operator()(const f32x4 (&acc)[2][2][4][2], const pg8::Unit& u, int wr, int wc, int fr, int fq) const {
        const int pn = u.pn;
        if (pn < 4) {
            const float s = (pn < 2) ? 0.08838834764831845f : 1.0f;
            bf16_t* De = (pn < 2 ? QE : KE); bf16_t* Dn = (pn < 2 ? QN : KN);
#pragma unroll
            for (int ai = 0; ai < 2; ++ai)
#pragma unroll
            for (int mh = 0; mh < 2; ++mh) {
                f32x4 cb[2][2][2];
#pragma unroll
                for (int mm = 0; mm < 2; ++mm)
#pragma unroll
                    for (int bj = 0; bj < 2; ++bj)
#pragma unroll
                        for (int n = 0; n < 2; ++n) cb[mm][bj][n] = *(const f32x4*)(CB + (size_t)(u.pm * 256 + ai * 128 + wr * 64 + (2 * mh + mm) * 16 + fr) * 512 + (pn & 1) * 256 + bj * 128 + wc * 32 + fq * 8 + n * 4);
                asm volatile("" ::: "memory");
#pragma unroll
                for (int mm = 0; mm < 2; ++mm) {
                    const int m = 2 * mh + mm; const int row = u.pm * 256 + ai * 128 + wr * 64 + m * 16 + fr;
#pragma unroll
                    for (int bj = 0; bj < 2; ++bj) {
                        u32x4 we, wn;
#pragma unroll
                        for (int n = 0; n < 2; ++n) {
                            const f32x4 a = acc[ai][bj][m][n]; f32x4 e, en;
#pragma unroll
                            for (int j = 0; j < 4; ++j) { const float ee = __expf(cb[mm][bj][n][j]); e[j] = a[j] * s * ee; en[j] = a[j] * s * __builtin_amdgcn_rcpf(ee); }
                            const u32x2 a1 = pk4(e), a2 = pk4(en);
                            if (n == 0) { we.x = a1.x; we.y = a1.y; wn.x = a2.x; wn.y = a2.y; } else { we.z = a1.x; we.w = a1.y; wn.z = a2.x; wn.w = a2.y; }
                        }
                        const size_t io = frag_img_off<128>(row, (pn & 1) * 2 + bj, wc * 32 + fq * 8);
                        *(u32x4*)((char*)De + io) = we; *(u32x4*)((char*)Dn + io) = wn;
                    }
                }
                asm volatile("" ::: "memory");
            }
        } else {
#pragma unroll
            for (int ai = 0; ai < 2; ++ai)
#pragma unroll
                for (int m = 0; m < 4; ++m) {
                    const int row = u.pm * 256 + ai * 128 + wr * 64 + m * 16 + fr;
#pragma unroll
                    for (int bj = 0; bj < 2; ++bj) { const u32x2 a0 = pk4(acc[ai][bj][m][0]), a1 = pk4(acc[ai][bj][m][1]);
                        *(u32x4*)((char*)V + v_img_off<256>(row, (pn - 4) * 256 + bj * 128 + wc * 32 + fq * 8)) = (u32x4){a0.x, a0.y, a1.x, a1.y}; }
                }
        }
    }
};
struct EpiNone {
    static constexpr bool PERM = false; float* sink;
    __device__ __forceinline__ void operator()(const f32x4 (&acc)[2][2][4][2], const pg8::Unit& u, int wr, int wc, int fr, int fq) const {
        f32x4 t = acc[0][0][0][0];
#pragma unroll
        for (int ai = 0; ai < 2; ++ai)
#pragma unroll
            for (int bj = 0; bj < 2; ++bj)
#pragma unroll
                for (int m = 0; m < 4; ++m)
#pragma unroll
                    for (int n = 0; n < 2; ++n) t += acc[ai][bj][m][n];
        if (t[0] + t[1] + t[2] + t[3] == 12345.678f) sink[0] = t[0];
    }
};
template <bool XF32> struct EpiOut {
    static constexpr bool PERM = true;
    const void* xold; bf16_t* xnew; const float* gate;
    __device__ __forceinline__ void operator()(const f32x4 (&acc)[2][2][4][2], const pg8::Unit& u, int wr, int wc, int fr, int fq) const {
        const int b = (u.pm * 256) >> 12;
        const int c0 = u.pn * 256 + wc * 32 + fq * 8;
        f32x4 gv[2][2];
#pragma unroll
        for (int bj = 0; bj < 2; ++bj)
#pragma unroll
            for (int n = 0; n < 2; ++n) gv[bj][n] = *(const f32x4*)(gate + (size_t)b * 3072 + c0 + bj * 128 + n * 4);
#pragma unroll
        for (int ai = 0; ai < 2; ++ai)
#pragma unroll
            for (int mh = 0; mh < 2; ++mh) {
                f32x4 xo[2][2][2];
#pragma unroll
                for (int mm = 0; mm < 2; ++mm)
#pragma unroll
                    for (int bj = 0; bj < 2; ++bj) { const size_t o = (size_t)(u.pm * 256 + ai * 128 + wr * 64 + (2 * mh + mm) * 16 + fr) * 1024 + c0 + bj * 128;
                        if (XF32) { xo[mm][bj][0] = *(const f32x4*)((const float*)xold + o); xo[mm][bj][1] = *(const f32x4*)((const float*)xold + o + 4); }
                        else { const u32x4 w = *(const u32x4*)((const bf16_t*)xold + o); xo[mm][bj][0] = unpk4((u32x2){w.x, w.y}); xo[mm][bj][1] = unpk4((u32x2){w.z, w.w}); } }
                asm volatile("" ::: "memory");
#pragma unroll
                for (int mm = 0; mm < 2; ++mm)
#pragma unroll
                    for (int bj = 0; bj < 2; ++bj) {
                        const u32x2 q0 = pk4(xo[mm][bj][0] + gv[bj][0] * acc[ai][bj][2 * mh + mm][0]), q1 = pk4(xo[mm][bj][1] + gv[bj][1] * acc[ai][bj][2 * mh + mm][1]);
                        *(u32x4*)(xnew + (size_t)(u.pm * 256 + ai * 128 + wr * 64 + (2 * mh + mm) * 16 + fr) * 1024 + c0 + bj * 128) = (u32x4){q0.x, q0.y, q1.x, q1.y};
                    }
                asm volatile("" ::: "memory");
            }
    }
};

__device__ __forceinline__ void transpose_item(const float* W, int ldw, int K, int nblk, bf16_t* WT, LAS float* scr, int item, int lane) {
    const int kb = item / nblk, nb = item % nblk, k0 = 64 * kb, n0 = 32 * nb;
#pragma unroll 8
    for (int i = 0; i < 32; ++i) { const int kk = 2 * i + (lane >> 5); scr[kk * 33 + (lane & 31)] = W[(size_t)(k0 + kk) * ldw + n0 + (lane & 31)]; }
    LDS_WAIT(); asm volatile("" ::: "memory");
    const int c = lane & 7;
#pragma unroll
    for (int j = 0; j < 4; ++j) { const int n = (lane >> 3) + 8 * j; const LAS float* s = scr + (8 * c) * 33 + n;
        u32x4 o; o.x = pk2(s[0 * 33], s[1 * 33]); o.y = pk2(s[2 * 33], s[3 * 33]); o.z = pk2(s[4 * 33], s[5 * 33]); o.w = pk2(s[6 * 33], s[7 * 33]);
        *(u32x4*)(WT + (size_t)(n0 + n) * K + k0 + 8 * c) = o; }
    LDS_WAIT(); asm volatile("" ::: "memory");
}
__device__ __forceinline__ void conv_weights(const float* w_in, int ld_in, int n_in, const float* w_out, int k_out, unsigned char* wdst, LAS unsigned char* lds, int tid, int bid, int G) {
    const int lane = tid & 63, wave = tid >> 6;
    LAS float* scr = (LAS float*)(lds + wave * 16384);
    const int gw = bid * 8 + wave, NGW = G * 8;
    const int I_in = (1024 / 64) * (n_in / 32), I_out = (k_out / 64) * (1024 / 32);
    bf16_t* WinT = (bf16_t*)wdst; bf16_t* WoutT = (bf16_t*)(wdst + 12 * MiB);
    for (int it = gw; it < I_in + I_out; it += NGW) {
        if (it < I_in) transpose_item(w_in, ld_in, 1024, n_in / 32, WinT, scr, it, lane);
        else transpose_item(w_out, 1024, k_out, 32, WoutT, scr, it - I_in, lane);
    }
}
__device__ __forceinline__ void p0_mod(const Params& P, LAS unsigned char* lds, int tid, int bid, int G) {
    LAS float* sc = (LAS float*)lds;
    LAS float* red = sc + 4096;
    const int lane = tid & 63, wave = tid >> 6;
    float* MOD = (float*)(P.ws + WS_MOD);
    for (int i = tid; i < 4096; i += 512) sc[i] = silu_f(P.c[i]);
    __syncthreads();
    for (int it = bid; it < 192; it += G) {
        const int l = it / 48, cb = it % 48, n = cb * 64 + lane;
        const float* W = P.mod_w + (size_t)l * 1024 * 3072 + n;
        float a0 = 0.f, a1 = 0.f, a2 = 0.f, a3 = 0.f;
        const int k0 = wave * 128;
#pragma unroll 8
        for (int k = k0; k < k0 + 128; ++k) { const float w = W[(size_t)k * 3072]; a0 += sc[k] * w; a1 += sc[1024 + k] * w; a2 += sc[2048 + k] * w; a3 += sc[3072 + k] * w; }
        red[(wave * 4 + 0) * 64 + lane] = a0; red[(wave * 4 + 1) * 64 + lane] = a1; red[(wave * 4 + 2) * 64 + lane] = a2; red[(wave * 4 + 3) * 64 + lane] = a3;
        __syncthreads();
        if (wave < 4) { float s = 0.f;
#pragma unroll
            for (int w = 0; w < 8; ++w) s += red[(w * 4 + wave) * 64 + lane];
            MOD[(size_t)(l * 4 + wave) * 3072 + n] = s + P.mod_b[l * 3072 + n]; }
        __syncthreads();
    }
}
__device__ __forceinline__ void p0_rope(const Params& P, int tid, int bid, int G) {
    unsigned* rope = (unsigned*)(P.ws + WS_ROPE);
    const int gt = bid * 512 + tid, NT = G * 512;
    for (int idx = gt; idx < MT * 128; idx += NT) {
        const int row = idx >> 7, d = idx & 127;
        const float inv = powf(10000.0f, -(float)d * (1.0f / 128.0f));
        const float ang = (float)P.pos[row] * inv;
        double t = (double)ang * 0.15915494309189535; t -= rint(t);
        const float fr = (float)t;
        const float co = __builtin_amdgcn_cosf(fr), si = __builtin_amdgcn_sinf(fr);
        const unsigned lo = __builtin_bit_cast(unsigned short, (_Float16)co), hi = __builtin_bit_cast(unsigned short, (_Float16)si);
        rope[idx] = lo | (hi << 16);
    }
}

template <int KIND, bool XF32>
__device__ __forceinline__ void h_phase(const Params& P, int layer, const void* xin, LAS unsigned char* lds, int tid, int bid, int G) {
    const int lane = tid & 63, wave = tid >> 6;
    LAS float* WxT = (LAS float*)lds;
    LAS float* W2 = (LAS float*)(lds + 65536);
    LAS float* TOT = (LAS float*)(lds + 98304);
    const float* MOD = (const float*)(P.ws + WS_MOD);
    bf16_t* XN = (bf16_t*)(P.ws + WS_XN);
    if (KIND > 0) {
        const float* wsrc = (KIND == 1) ? (P.fox_w_in + 4096) : (P.gla_w_in + 3072); const int ldw = (KIND == 1) ? FOX_IN : GLA_IN;
        {
            float wv[32];
#pragma unroll
            for (int it = 0; it < 32; ++it) { const int idx = tid + 512 * it; wv[it] = wsrc[(size_t)(idx >> 4) * ldw + (idx & 15)]; }
#pragma unroll
            for (int it = 0; it < 32; ++it) { const int idx = tid + 512 * it; WxT[(idx & 15) * 1024 + (idx >> 4)] = wv[it]; }
        }
        if (KIND == 2) {
            float w2v[16];
#pragma unroll
            for (int it = 0; it < 16; ++it) w2v[it] = P.gla_w_gate2[tid + 512 * it];
#pragma unroll
            for (int it = 0; it < 16; ++it) W2[tid + 512 * it] = w2v[it];
        }
        __syncthreads();
    }
    for (int ci = bid; ci < MT / 64; ci += G) {
        const int b = ci >> 6;
        if (KIND != 1) ((float*)(P.ws + WS_S16))[ci * 512 + tid] = 0.f;
        const float* mod = MOD + (size_t)(layer * 4 + b) * 3072;
        f32x4 ga[4], sh[4];
#pragma unroll
        for (int j = 0; j < 4; ++j) { const int col = 4 * lane + 256 * j;
            const f32x4 g4 = *(const f32x4*)(P.norm_g + layer * 1024 + col), s4 = *(const f32x4*)(mod + 1024 + col);
            ga[j] = g4 * (s4 + 1.0f); sh[j] = *(const f32x4*)(mod + col); }
        float run[8]; f32x4 cbv[8][2];
        if (KIND == 2) {
#pragma unroll
            for (int c = 0; c < 8; ++c) run[c] = 0.f;
        }
        if constexpr (false) {
        constexpr int BS = (KIND == 2) ? 2 : 4;
#pragma unroll (KIND == 2 ? 8 / BS : 1)
        for (int rb = 0; rb < 8; rb += BS) {
            asm volatile("" ::: "memory");
            f32x4 xv[BS][4];
#pragma unroll
            for (int bb = 0; bb < BS; ++bb) { const size_t ro = (size_t)(ci * 64 + wave * 8 + rb + bb) * 1024;
                if (XF32) { const f32x4* xr = (const f32x4*)((const float*)xin + ro) + lane;
#pragma unroll
                    for (int j = 0; j < 4; ++j) xv[bb][j] = xr[64 * j]; }
                else { const u32x2* xr = (const u32x2*)((const bf16_t*)xin + ro) + lane;
#pragma unroll
                    for (int j = 0; j < 4; ++j) xv[bb][j] = unpk4(xr[64 * j]); } }
#pragma unroll
        for (int bb = 0; bb < BS; ++bb) {
            const int rr = rb + bb;
            asm volatile("" ::: "memory");
            const int row = ci * 64 + wave * 8 + rr;
            f32x4 v[4]; float ss = 0.f;
#pragma unroll
            for (int j = 0; j < 4; ++j) { v[j] = xv[bb][j]; ss += (v[j][0] * v[j][0] + v[j][1] * v[j][1]) + (v[j][2] * v[j][2] + v[j][3] * v[j][3]); }
            const float rstd = rsqrtf(wave_sum(ss) * (1.0f / 1024.0f) + EPS);
#pragma unroll
            for (int j = 0; j < 4; ++j) { v[j] = (v[j] * rstd) * ga[j] + sh[j]; *(u32x2*)(XN + (size_t)row * 1024 + 4 * lane + 256 * j) = pk4(v[j]); }
            if (KIND > 0) {
                float r[16];
#pragma unroll
                for (int i = 0; i < 16; ++i) { float a = 0.f;
#pragma unroll
                    for (int j = 0; j < 4; ++j) { const f32x4 w = *(const LAS f32x4*)(WxT + i * 1024 + 4 * lane + 256 * j); a += (v[j][0] * w[0] + v[j][1] * w[1]) + (v[j][2] * w[2] + v[j][3] * w[3]); }
                    r[i] = a; }
                if (KIND == 1) {
                    const float e1 = reduce_scatter16(r, lane);
                    const int idx = ((lane >> 5) & 1) * 8 + ((lane >> 4) & 1) * 4 + ((lane >> 3) & 1) * 2 + ((lane >> 2) & 1);
                    if ((lane & 3) == 0) ((float*)(P.ws + WS_S16))[(size_t)row * 16 + idx] = logsig_f(e1 + P.fox_b_f[idx]);
                } else {
                    f32x4 z0 = *(const f32x4*)(P.gla_b_gate + 8 * lane), z1 = *(const f32x4*)(P.gla_b_gate + 8 * lane + 4);
#pragma unroll
                    for (int i = 0; i < 16; ++i) { const f32x4 w0 = *(const LAS f32x4*)(W2 + i * 512 + 8 * lane), w1 = *(const LAS f32x4*)(W2 + i * 512 + 8 * lane + 4); z0 += w0 * r[i]; z1 += w1 * r[i]; }
#pragma unroll
                    for (int c = 0; c < 4; ++c) { run[c] += logsig_f(z0[c]) * 0.0625f; run[4 + c] += logsig_f(z1[c]) * 0.0625f; }
                    cbv[rr][0] = (f32x4){run[0], run[1], run[2], run[3]}; cbv[rr][1] = (f32x4){run[4], run[5], run[6], run[7]};
                }
            }
        }
        }
        } else {
        constexpr int BS = (KIND == 2) ? 2 : 4;
#pragma unroll (KIND != 0 ? 8 / BS : 1)
        for (int rb = 0; rb < 8; rb += BS) {
            asm volatile("" ::: "memory");
            f32x4 v[BS][4];
#pragma unroll
            for (int bb = 0; bb < BS; ++bb) { const size_t ro = (size_t)(ci * 64 + wave * 8 + rb + bb) * 1024;
                if (XF32) { const f32x4* xr = (const f32x4*)((const float*)xin + ro) + lane;
#pragma unroll
                    for (int j = 0; j < 4; ++j) v[bb][j] = xr[64 * j]; }
                else { const u32x2* xr = (const u32x2*)((const bf16_t*)xin + ro) + lane;
#pragma unroll
                    for (int j = 0; j < 4; ++j) v[bb][j] = unpk4(xr[64 * j]); } }
#pragma unroll
            for (int bb = 0; bb < BS; ++bb) {
                const int row = ci * 64 + wave * 8 + rb + bb; float ss = 0.f;
#pragma unroll
                for (int j = 0; j < 4; ++j) ss += (v[bb][j][0] * v[bb][j][0] + v[bb][j][1] * v[bb][j][1]) + (v[bb][j][2] * v[bb][j][2] + v[bb][j][3] * v[bb][j][3]);
                const float rstd = rsqrtf(wave_sum(ss) * (1.0f / 1024.0f) + EPS);
#pragma unroll
                for (int j = 0; j < 4; ++j) { v[bb][j] = (v[bb][j] * rstd) * ga[j] + sh[j]; *(u32x2*)(XN + (size_t)row * 1024 + 4 * lane + 256 * j) = pk4(v[bb][j]); }
            }
            if (KIND > 0) {
                float acc[BS][16];
#pragma unroll
                for (int i = 0; i < 16; ++i) {
                    f32x4 w[4];
#pragma unroll
                    for (int j = 0; j < 4; ++j) w[j] = *(const LAS f32x4*)(WxT + i * 1024 + 4 * lane + 256 * j);
#pragma unroll
                    for (int bb = 0; bb < BS; ++bb) { float a = 0.f;
#pragma unroll
                        for (int j = 0; j < 4; ++j) a += (v[bb][j][0] * w[j][0] + v[bb][j][1] * w[j][1]) + (v[bb][j][2] * w[j][2] + v[bb][j][3] * w[j][3]);
                        acc[bb][i] = a; }
                    if (i & 1) { __builtin_amdgcn_sched_barrier(0); asm volatile("" ::: "memory"); }
                }
#pragma unroll
                for (int bb = 0; bb < BS; ++bb) {
                    const int rr = rb + bb, row = ci * 64 + wave * 8 + rr;
                    asm volatile("" ::: "memory");
                    const float e1 = reduce_scatter16(acc[bb], lane);
                    if (KIND == 1) {
                        const int idx = ((lane >> 5) & 1) * 8 + ((lane >> 4) & 1) * 4 + ((lane >> 3) & 1) * 2 + ((lane >> 2) & 1);
                        ((float*)(P.ws + WS_S16))[(size_t)row * 16 + idx] = logsig_f(e1 + P.fox_b_f[idx]);
                    } else {
                        float r[16];
#pragma unroll
                        for (int i = 0; i < 16; ++i) r[i] = __builtin_bit_cast(float, __builtin_amdgcn_readlane(__builtin_bit_cast(int, e1), ((i >> 3) & 1) * 32 + ((i >> 2) & 1) * 16 + ((i >> 1) & 1) * 8 + (i & 1) * 4));
                        f32x4 z0 = *(const f32x4*)(P.gla_b_gate + 8 * lane), z1 = *(const f32x4*)(P.gla_b_gate + 8 * lane + 4);
#pragma unroll
                        for (int i = 0; i < 16; ++i) { const f32x4 w0 = *(const LAS f32x4*)(W2 + i * 512 + 8 * lane), w1 = *(const LAS f32x4*)(W2 + i * 512 + 8 * lane + 4); z0 += w0 * r[i]; z1 += w1 * r[i]; }
#pragma unroll
                        for (int c = 0; c < 4; ++c) { run[c] += logsig_f(z0[c]) * 0.0625f; run[4 + c] += logsig_f(z1[c]) * 0.0625f; }
                        cbv[rr][0] = (f32x4){run[0], run[1], run[2], run[3]}; cbv[rr][1] = (f32x4){run[4], run[5], run[6], run[7]};
                    }
                }
            }
        }
        }
        if (KIND == 2) {
            float* CB = (float*)(P.ws + WS_ACT + 160 * MiB);
            *(LAS f32x4*)(TOT + wave * 512 + 8 * lane) = (f32x4){run[0], run[1], run[2], run[3]};
            *(LAS f32x4*)(TOT + wave * 512 + 8 * lane + 4) = (f32x4){run[4], run[5], run[6], run[7]};
            __syncthreads();
            f32x4 o0 = (f32x4){0.f, 0.f, 0.f, 0.f}, o1 = o0;
            for (int w = 0; w < wave; ++w) { o0 += *(const LAS f32x4*)(TOT + w * 512 + 8 * lane); o1 += *(const LAS f32x4*)(TOT + w * 512 + 8 * lane + 4); }
#pragma unroll
            for (int rr = 0; rr < 8; ++rr) { const int row = ci * 64 + wave * 8 + rr;
                *(f32x4*)(CB + (size_t)row * 512 + 8 * lane) = cbv[rr][0] + o0; *(f32x4*)(CB + (size_t)row * 512 + 8 * lane + 4) = cbv[rr][1] + o1; }
            __syncthreads();
        }
    }
}

template <int KIND> struct LinCfg {
    static constexpr int DK = KIND == 0 ? 256 : 128, QP = KIND == 0 ? 1024 : 512, VP = KIND == 0 ? 2048 : 1024, HV = KIND == 0 ? 512 : 256;
    static constexpr int NSL = HV / 32, NITEM = 16 * NSL, NKF = DK / 32, RW = DK / 8, NDT = RW / 16, KPITCH = DK * 2 + 32, STP = DK + 8, KCH = DK / 64;
    static constexpr int LDS_ST = 0, LDS_P = 2 * 32 * STP * 2, LDS_V = LDS_P + 2 * 8192, LDS_END = LDS_V + 2 * 2 * 4096;
    static constexpr int NA = DK / 16;
};
__device__ __forceinline__ float ret_log2g(int h) { return (h == 0) ? -0.045803689613124796f : (h == 1) ? -0.02272007650008353f : (h == 2) ? -0.011315313227834146f : -0.005646563141142062f; }

template <int KIND>
__device__ __forceinline__ void lin_pphase(const bf16_t* Qa, bf16_t* Ka, const bf16_t* Qb, const bf16_t* Kb2, bf16_t* Pimg, int tid, int bid, int G) {
    typedef LinCfg<KIND> C;
    const int lane = tid & 63, wave = __builtin_amdgcn_readfirstlane(tid >> 6);
    const int g4 = lane >> 4, i16 = lane & 15;
    bf16x8 idf[2];
#pragma unroll
    for (int sel = 0; sel < 2; ++sel)
#pragma unroll
        for (int j = 0; j < 8; ++j) idf[sel][j] = (short)((8 * g4 + j == i16 + 16 * sel) ? 0x3F80 : 0);
    for (int hw0 = bid * 8; hw0 < 2048; hw0 += G * 8) {
        const int hw = hw0 + wave;
        const int item = hw >> 1, half = hw & 1;
        const int bh = item >> 6, n = item & 63, b = bh >> 2, h = bh & 3;
        const size_t t0 = (size_t)b * SEQ + (size_t)n * 64;
        f32x4 pa[2][4], pb[2][4];
#pragma unroll
        for (int r = 0; r < 2; ++r)
#pragma unroll
            for (int c = 0; c < 4; ++c) { pa[r][c] = (f32x4){0.f, 0.f, 0.f, 0.f}; pb[r][c] = (f32x4){0.f, 0.f, 0.f, 0.f}; }
        constexpr size_t BLK = (size_t)64 * C::DK * 2;
        const char* qa = (const char*)Qa + (size_t)item * BLK + lane * 16; char* ka = (char*)Ka + (size_t)item * BLK + lane * 16;
        const char* qb = (const char*)Qb + (size_t)item * BLK + lane * 16; const char* kb = (const char*)Kb2 + (size_t)item * BLK + lane * 16;
        bf16x8 kall[C::NKF][4];
#pragma unroll
        for (int k = 0; k < C::NKF; ++k)
#pragma unroll
            for (int c = 0; c < 4; ++c) kall[k][c] = *(const bf16x8*)(ka + (k * 4 + c) * 1024);
#pragma unroll
        for (int k = 0; k < C::NKF; ++k) {
            bf16x8 af[2];
#pragma unroll
            for (int r = 0; r < 2; ++r) af[r] = *(const bf16x8*)(qa + (k * 4 + 2 * half + r) * 1024);
#pragma unroll
            for (int r = 0; r < 2; ++r)
#pragma unroll
                for (int c = 0; c < 4; ++c) pa[r][c] = mma_rc(pa[r][c], af[r], kall[k][c]);
            if (KIND == 1) {
                bf16x8 bfr[4];
#pragma unroll
                for (int r = 0; r < 2; ++r) af[r] = *(const bf16x8*)(qb + (k * 4 + 2 * half + r) * 1024);
#pragma unroll
                for (int c = 0; c < 4; ++c) bfr[c] = *(const bf16x8*)(kb + (k * 4 + c) * 1024);
#pragma unroll
                for (int r = 0; r < 2; ++r)
#pragma unroll
                    for (int c = 0; c < 4; ++c) pb[r][c] = mma_rc(pb[r][c], af[r], bfr[c]);
            }
        }
        const float l2g = (KIND == 0) ? ret_log2g(h) : 0.f;
#pragma unroll
        for (int r = 0; r < 2; ++r) {
            const int c = 32 * half + 16 * r + (lane & 15);
#pragma unroll
            for (int ct = 0; ct < 4; ++ct) {
                f32x4 p;
#pragma unroll
                for (int e = 0; e < 4; ++e) { const int mm = 16 * ct + 4 * g4 + e;
                    if (KIND == 0) { const int dd = c > mm ? c - mm : mm - c; p[e] = pa[r][ct][e] * exp2f(l2g * (float)dd); }
                    else p[e] = (c >= mm) ? pa[r][ct][e] : pb[r][ct][e]; }
                const int ks = ct >> 1, gg = 2 * (ct & 1) + (g4 & 1);
                const int off = c * 128 + (((4 * ks + gg) ^ (c & 7)) << 4) + 8 * (g4 >> 1);
                *(u32x2*)((char*)Pimg + (size_t)item * 8192 + off) = pk4(p);
            }
        }
        __syncthreads();
        {
            char* kdst = ka - lane * 16 + (16 * (g4 & 1) + i16) * 16 + 8 * (g4 >> 1);
#define PP_TR(HALF) _Pragma("unroll") for (int k = 0; k < C::NKF; ++k) _Pragma("unroll") for (int sel = 0; sel < 2; ++sel) _Pragma("unroll") for (int T = 0; T < 2; ++T) { \
                const f32x4 tr_ = mma_rc((f32x4){0.f, 0.f, 0.f, 0.f}, idf[sel], kall[k][2 * (HALF) + T]); \
                *(u32x2*)(kdst + ((HALF) * C::NA + 2 * k + sel) * 1024 + T * 512) = pk4(tr_); }
            if (half == 0) { PP_TR(0) } else { PP_TR(1) }
#undef PP_TR
        }
    }
}

typedef short v4i16_t __attribute__((ext_vector_type(4)));
__device__ __forceinline__ bf16x8 trfrag2(const LAS char* p0, int second_off) {
    const v4i16_t a = __builtin_amdgcn_ds_read_tr16_b64_v4i16((LAS v4i16_t*)p0);
    const v4i16_t b = __builtin_amdgcn_ds_read_tr16_b64_v4i16((LAS v4i16_t*)(p0 + second_off));
    return (bf16x8){a[0], a[1], a[2], a[3], b[0], b[1], b[2], b[3]};
}

template <int KIND> struct LsStage { u32x4 x[LinCfg<KIND>::NKF]; u32x4 p; u32x2 v; f32x4 dec[2]; };

template <int KIND, int VAR = 0>
__device__ __forceinline__ void lin_scan(const bf16_t* Qg, const bf16_t* Kg, const bf16_t* Vg, const bf16_t* Pimg, const float* CB, bf16_t* O, float* DUMMY, LAS unsigned char* lds, int tid, int bid, int G) {
    typedef LinCfg<KIND> C;
    const int nit = (G == 256) ? 1 : (C::NITEM + G - 1) / G;
    const int tid0 = tid;
    for (int it = 0; it < nit; ++it) {
        int tid = tid0; asm volatile("" : "+v"(tid));
        const int lane = tid & 63, wave = __builtin_amdgcn_readfirstlane(tid >> 6);
        const int g4 = lane >> 4, i16 = lane & 15, q4 = i16 >> 2, p4 = i16 & 3;
        int item;
        if (G == 256) { const int x = bid & 7, j = bid >> 3; if (KIND == 0) item = x * 32 + j; else { if (j >= 16) break; item = x * 16 + j; } }
        else { item = it * G + bid; if (item >= C::NITEM) break; }
        const int bh = item / C::NSL, dvs = item % C::NSL, b = bh >> 2, h = bh & 3;
        const size_t t0 = (size_t)b * SEQ;
        const int rt = wave & 3; const bool rdw = wave < 4;
        constexpr int RWU = C::DK / 4, NDU = RWU / 16;
        const float l2g = (KIND == 0) ? ret_log2g(h) : 0.f;
        const float qsc = (KIND == 0) ? exp2f(l2g * (float)(16 * rt + i16 + 1)) : 1.0f;
        const float sdec = (KIND == 0) ? exp2f(l2g * 64.0f) : 1.0f;
        const int vm = tid >> 3, vp8 = tid & 7;
        const float vsc = (KIND == 0) ? exp2f(l2g * (float)(63 - vm)) : 1.0f;
        constexpr size_t BLK = (size_t)64 * C::DK * 2;
        const char* xsb = (const char*)(rdw ? Qg : Kg) + (size_t)bh * 64 * BLK + (rdw ? rt * 1024 : NDU * rt * 1024);
        const unsigned xvo = (unsigned)(lane * 16);
        const char* vsb = (const char*)Vg + (size_t)(bh * C::NSL + dvs) * (4096 * 64);
        char* osb = (char*)O + (size_t)(bh * C::NSL + dvs) * (4096 * 64);
        const unsigned vio = (unsigned)(tid * 8);
        char* dmb = (char*)DUMMY + (size_t)bid * 4096;
        const char* psb = (const char*)Pimg + (size_t)bh * 64 * 8192; const unsigned pvo = (unsigned)(tid * 16);
        const char* dcb = (KIND == 1) ? (const char*)CB + ((t0 + 63) * 512 + h * 128 + RWU * rt) * 4 : nullptr; const unsigned dco = (unsigned)(g4 * 16);
        LAS bf16_t* ST = (LAS bf16_t*)(lds + C::LDS_ST);
        LAS char* PI = (LAS char*)(lds + C::LDS_P);
        LAS char* VI = (LAS char*)(lds + C::LDS_V);
        LAS char* OT = (LAS char*)(lds + C::LDS_END);
        const int trow = 16 * (g4 >> 1) + 4 * (g4 & 1) + q4;
        const int voff = trow * 32 + 8 * p4;
        const int poff_row = (16 * rt + i16) * 128, psw = (16 * rt + i16) & 7;

        LsStage<KIND> A, B;
#define LS_LOAD_PV(S, nn) do { const int n_ = (nn) < 64 ? (nn) : 63; \
            unsigned po_ = pvo, vo_ = vio, do_ = dco; asm volatile("" : "+v"(po_), "+v"(vo_), "+v"(do_)); \
            if (!((VAR & 2) && (nn) >= 2)) { S.p = *(const u32x4*)(psb + (size_t)n_ * 8192 + po_); \
            S.v = *(const u32x2*)(vsb + (size_t)n_ * 4096 + vo_); } \
            if (KIND == 1) { _Pragma("unroll") for (int a_ = 0; a_ < NDU; ++a_) S.dec[a_] = *(const f32x4*)(dcb + (size_t)n_ * (64 * 512 * 4) + 64 * a_ + do_); } } while (0)
#define LS_LOAD_X(S, nn) do { const int n_ = (nn) < 64 ? (nn) : 63; \
            if (!((VAR & 1) && (nn) >= 2)) { const char* xs_ = xsb + (size_t)n_ * BLK; unsigned xo_ = xvo; asm volatile("" : "+v"(xo_));        \
                _Pragma("unroll") for (int k_ = 0; k_ < C::NKF; ++k_) S.x[k_] = *(const u32x4*)(xs_ + (size_t)(rdw ? k_ * 4096 : ((k_ / NDU) * C::NA + (k_ % NDU)) * 1024) + xo_); } } while (0)
#define LS_LOAD(S, nn) do { LS_LOAD_PV(S, nn); LS_LOAD_X(S, nn); } while (0)
#define LS_WRITE(S, img) do { \
            *(LAS u32x4*)(PI + (img) * 8192 + tid * 16) = S.p; \
            { LAS char* vd_ = VI + (img) * 8192 + (vp8 >> 2) * 2048 + vm * 32 + (vp8 & 3) * 8; *(LAS u32x2*)vd_ = S.v; \
              if (KIND == 0) { u32x2 w_; w_.x = pk2(bf2f(S.v.x & 0xffffu) * vsc, bf2f(S.v.x >> 16) * vsc); w_.y = pk2(bf2f(S.v.y & 0xffffu) * vsc, bf2f(S.v.y >> 16) * vsc); *(LAS u32x2*)(vd_ + 4096) = w_; } } } while (0)

        for (int i = tid; i < 32 * C::STP / 2; i += 512) ((LAS unsigned*)ST)[i] = 0u;
        f32x4 s[NDU][2];
#pragma unroll
        for (int a = 0; a < NDU; ++a)
#pragma unroll
            for (int e = 0; e < 2; ++e) s[a][e] = (f32x4){0.f, 0.f, 0.f, 0.f};
        LS_LOAD(A, 0); LS_LOAD(B, 1);
        LS_WRITE(A, 0);
        __syncthreads();

#define LS_SB(k) s[1 + (k) / 2][(k) % 2]
#define LS_STEP(n, SC, SN) do { const int img_ = (n) & 1; \
            f32x4 dcur_[2]; if (KIND == 1) { _Pragma("unroll") for (int a_ = 0; a_ < NDU; ++a_) dcur_[a_] = SC.dec[a_]; } \
              \
            LS_LOAD_PV(SC, (n) + 2); \
            if (rdw) { \
                  \
                if (!(VAR & 16)) { \
                const LAS bf16_t* STc_ = ST + img_ * 32 * C::STP; \
                  \
                  \
                _Pragma("unroll") for (int ct_ = 0; ct_ < 2; ++ct_) { \
                    constexpr int HB_ = C::NKF / 2; bf16x8 pf_[2], vf_[2]; \
                    s[0][0] = (f32x4){0.f, 0.f, 0.f, 0.f}; s[0][1] = s[0][0]; \
                    _Pragma("unroll") for (int k_ = 0; k_ < HB_; ++k_) LS_SB(k_) = __builtin_bit_cast(f32x4, lfrag(STc_ + 16 * ct_ * C::STP + 32 * k_, C::STP, lane)); \
                    __builtin_amdgcn_sched_barrier(0); \
                    _Pragma("unroll") for (int k_ = 0; k_ < HB_; k_ += 2) { s[0][0] = mma_rc(s[0][0], __builtin_bit_cast(bf16x8, SC.x[k_]), __builtin_bit_cast(bf16x8, LS_SB(k_))); s[0][1] = mma_rc(s[0][1], __builtin_bit_cast(bf16x8, SC.x[k_ + 1]), __builtin_bit_cast(bf16x8, LS_SB(k_ + 1))); } \
                    __builtin_amdgcn_sched_barrier(0); \
                    _Pragma("unroll") for (int k_ = 0; k_ < HB_; ++k_) LS_SB(k_) = __builtin_bit_cast(f32x4, lfrag(STc_ + 16 * ct_ * C::STP + 32 * (HB_ + k_), C::STP, lane)); \
                    _Pragma("unroll") for (int ks_ = 0; ks_ < 2; ++ks_) { \
                        pf_[ks_] = *(const LAS bf16x8*)(PI + img_ * 8192 + poff_row + (((4 * ks_ + g4) ^ psw) << 4)); \
                        vf_[ks_] = trfrag2(VI + img_ * 8192 + ct_ * 2048 + ks_ * 1024 + voff, 256); } \
                    __builtin_amdgcn_sched_barrier(0); \
                    _Pragma("unroll") for (int k_ = 0; k_ < HB_; k_ += 2) { s[0][0] = mma_rc(s[0][0], __builtin_bit_cast(bf16x8, SC.x[HB_ + k_]), __builtin_bit_cast(bf16x8, LS_SB(k_))); s[0][1] = mma_rc(s[0][1], __builtin_bit_cast(bf16x8, SC.x[HB_ + k_ + 1]), __builtin_bit_cast(bf16x8, LS_SB(k_ + 1))); } \
                    f32x4 oa_ = (s[0][0] + s[0][1]) * qsc; \
                    _Pragma("unroll") for (int ks_ = 0; ks_ < 2; ++ks_) oa_ = mma_rc(oa_, pf_[ks_], vf_[ks_]); \
                    *(LAS u32x2*)(OT + img_ * 4608 + (16 * rt + i16) * 72 + (16 * ct_ + 4 * g4) * 2) = pk4(oa_); \
                    __builtin_amdgcn_sched_barrier(0); } } \
                  \
                LS_LOAD_X(SC, (n) + 2); \
            } else { \
                  \
                if (KIND == 0) { _Pragma("unroll") for (int a_ = 0; a_ < NDU; ++a_) _Pragma("unroll") for (int e_ = 0; e_ < 2; ++e_) s[a_][e_] = s[a_][e_] * sdec; } \
                if (!(VAR & 4)) { bf16x8 vf_[2][2]; \
                    _Pragma("unroll") for (int ks_ = 0; ks_ < 2; ++ks_) _Pragma("unroll") for (int e_ = 0; e_ < 2; ++e_) vf_[ks_][e_] = trfrag2(VI + img_ * 8192 + (KIND == 0 ? 4096 : 0) + e_ * 2048 + ks_ * 1024 + voff, 256); \
                    _Pragma("unroll") for (int ks_ = 0; ks_ < 2; ++ks_) _Pragma("unroll") for (int a_ = 0; a_ < NDU; ++a_) _Pragma("unroll") for (int e_ = 0; e_ < 2; ++e_) \
                        s[a_][e_] = mma_cr(s[a_][e_], __builtin_bit_cast(bf16x8, SC.x[ks_ * NDU + a_]), vf_[ks_][e_]); } \
                  \
                LS_LOAD_X(SC, (n) + 2); \
                if (KIND == 1) { _Pragma("unroll") for (int a_ = 0; a_ < NDU; ++a_) { f32x4 dc_; _Pragma("unroll") for (int r_ = 0; r_ < 4; ++r_) dc_[r_] = __expf(dcur_[a_][r_]); \
                    _Pragma("unroll") for (int e_ = 0; e_ < 2; ++e_) s[a_][e_] = s[a_][e_] * dc_; } } \
                  \
                { LAS bf16_t* STn_ = ST + (img_ ^ 1) * 32 * C::STP; \
                  _Pragma("unroll") for (int a_ = 0; a_ < NDU; ++a_) _Pragma("unroll") for (int e_ = 0; e_ < 2; ++e_) \
                      *(LAS u32x2*)(STn_ + (16 * e_ + i16) * C::STP + RWU * rt + 16 * a_ + 4 * g4) = pk4(s[a_][e_]); } \
            } \
              \
            { const u32x2 ov_ = *(const LAS u32x2*)(OT + (img_ ^ 1) * 4608 + vm * 72 + vp8 * 8); \
              char* ob_ = (n) > 0 ? osb + (size_t)((n) - 1) * 4096 : dmb; unsigned oo_ = vio; asm volatile("" : "+v"(oo_)); \
              if (!((VAR & 8) && (n) >= 2)) *(u32x2*)(ob_ + oo_) = ov_; } \
              \
            LS_WRITE(SN, img_ ^ 1); \
            asm volatile("s_waitcnt lgkmcnt(0)" ::: "memory"); __builtin_amdgcn_s_barrier(); asm volatile("" ::: "memory"); } while (0)

#pragma nounroll
        for (int n = 0; n < 64; n += 2) { LS_STEP(n, A, B); LS_STEP(n + 1, B, A); }
        *(u32x2*)(osb + (size_t)63 * 4096 + vio) = *(const LAS u32x2*)(OT + 4608 + vm * 72 + vp8 * 8);
        __syncthreads();
#undef LS_LOAD
#undef LS_LOAD_PV
#undef LS_LOAD_X
#undef LS_WRITE
#undef LS_STEP
#undef LS_SB
    }
}


template <int KIND>
__device__ __forceinline__ void lin_stats(const bf16_t* O, float* STATS, int tid, int bid, int G) {
    const int lane = tid & 63, wave = tid >> 6;
    const int gw = bid * 8 + wave, NGW = G * 8;
    constexpr int NJ = KIND == 0 ? 4 : 2, PITCH = KIND == 0 ? 2048 : 1024, RB = 4;
    for (int row0 = gw; row0 < MT; row0 += RB * NGW) {
        u32x4 w[RB][NJ];
#pragma unroll
        for (int rb = 0; rb < RB; ++rb) { const int row = row0 + rb * NGW < MT ? row0 + rb * NGW : row0;
#pragma unroll
            for (int j = 0; j < NJ; ++j) w[rb][j] = *(const u32x4*)(O + (size_t)row * PITCH + 512 * j + 8 * lane); }
#pragma unroll
        for (int rb = 0; rb < RB; ++rb) { const int row = row0 + rb * NGW; if (row >= MT) break;
#pragma unroll
            for (int j = 0; j < NJ; ++j) {
                float sm = 0.f, sq = 0.f;
#pragma unroll
                for (int i = 0; i < 4; ++i) { const float a = bf2f(w[rb][j][i] & 0xffffu), b = bf2f(w[rb][j][i] >> 16); sm += a + b; sq += a * a + b * b; }
                if (KIND == 0) { sm = wave_sum(sm); sq = wave_sum(sq); if (lane == 0) *(f32x2*)(STATS + (size_t)row * 8 + 2 * j) = (f32x2){sm, sq}; }
                else {
#pragma unroll
                    for (int o = 1; o < 32; o <<= 1) sq += __shfl_xor(sq, o);
                    if ((lane & 31) == 0) *(f32x2*)(STATS + (size_t)row * 8 + 2 * (2 * j + (lane >> 5))) = (f32x2){0.f, sq}; }
            }
        }
    }
}

template <int KIND> struct EpiGateNorm {
    static constexpr bool PERM = true;
    const bf16_t* O; bf16_t* A; LAS float* tbl;
    __device__ __forceinline__ void operator()(const f32x4 (&acc)[2][2][4][2], const pg8::Unit& u, int wr, int wc, int fr, int fq) const {
        constexpr int N = KIND == 0 ? 2048 : 1024, HV = KIND == 0 ? 512 : 256; constexpr float INV = KIND == 0 ? 1.0f / 512.0f : 1.0f / 256.0f;
        const int c0 = u.pn * 256 + wc * 32 + fq * 8;
        if (KIND == 0) {
            if ((u.pn & 1) == 0) {
                LAS f32x2* tb2 = (LAS f32x2*)tbl;
#pragma unroll
                for (int ai = 0; ai < 2; ++ai)
#pragma unroll
                    for (int m = 0; m < 4; ++m) { const int rl = ai * 128 + wr * 64 + m * 16 + fr; const int row = u.pm * 256 + rl; float sm = 0.f, sq = 0.f;
                        u32x4 w[4];
#pragma unroll
                        for (int tt = 0; tt < 2; ++tt)
#pragma unroll
                            for (int bj = 0; bj < 2; ++bj) w[2 * tt + bj] = *(const u32x4*)((const char*)O + v_img_off<HV>(row, c0 + tt * 256 + bj * 128));
#pragma unroll
                        for (int i = 0; i < 4; ++i) {
                            const f32x4 o0 = unpk4((u32x2){w[i].x, w[i].y}), o1 = unpk4((u32x2){w[i].z, w[i].w});
                            const f32x4 ss = o0 + o1, qq = o0 * o0 + o1 * o1;
                            sm += (ss[0] + ss[1]) + (ss[2] + ss[3]); sq += (qq[0] + qq[1]) + (qq[2] + qq[3]); }
                        sm = xsum_16_32(sm); sq = xsum_16_32(sq);
                        if (fq == 0) tb2[rl * 4 + wc] = (f32x2){sm, sq};
                        asm volatile("" ::: "memory"); }
                asm volatile("s_waitcnt lgkmcnt(0)" ::: "memory"); __builtin_amdgcn_s_barrier(); asm volatile("" ::: "memory");
            }
#pragma unroll
            for (int ai = 0; ai < 2; ++ai)
#pragma unroll
            for (int mh = 0; mh < 2; ++mh) {
                u32x4 ov[2][2];
#pragma unroll
                for (int mm = 0; mm < 2; ++mm) { const int row = u.pm * 256 + ai * 128 + wr * 64 + (2 * mh + mm) * 16 + fr;
#pragma unroll
                    for (int bj = 0; bj < 2; ++bj) ov[mm][bj] = *(const u32x4*)((const char*)O + v_img_off<HV>(row, c0 + bj * 128)); }
                asm volatile("" ::: "memory");
#pragma unroll
                for (int mm = 0; mm < 2; ++mm) { const int m = 2 * mh + mm; const int rl = ai * 128 + wr * 64 + m * 16 + fr; const int row = u.pm * 256 + rl;
                    const LAS f32x2* tb2 = (const LAS f32x2*)tbl + rl * 4;
                    const f32x2 p0 = tb2[0], p1 = tb2[1], p2 = tb2[2], p3 = tb2[3];
                    const float mean = ((p0.x + p1.x) + (p2.x + p3.x)) * INV, rstd = __builtin_amdgcn_rsqf(fmaxf(((p0.y + p1.y) + (p2.y + p3.y)) * INV - mean * mean, 0.f) + EPS);
#pragma unroll
                    for (int bj = 0; bj < 2; ++bj) {
                        const f32x4 o0 = unpk4((u32x2){ov[mm][bj].x, ov[mm][bj].y}), o1 = unpk4((u32x2){ov[mm][bj].z, ov[mm][bj].w}), a0 = acc[ai][bj][m][0], a1 = acc[ai][bj][m][1]; f32x4 r0, r1;
#pragma unroll
                        for (int j = 0; j < 4; ++j) { r0[j] = (o0[j] - mean) * rstd * silu_f(a0[j]); r1[j] = (o1[j] - mean) * rstd * silu_f(a1[j]); }
                        const u32x2 q0 = pk4(r0), q1 = pk4(r1);
                        *(u32x4*)(A + (size_t)row * N + c0 + bj * 128) = (u32x4){q0.x, q0.y, q1.x, q1.y};
                    }
                }
                asm volatile("" ::: "memory");
            }
        } else {
#pragma unroll
            for (int ai = 0; ai < 2; ++ai)
#pragma unroll
                for (int m = 0; m < 4; ++m) { const int rl = ai * 128 + wr * 64 + m * 16 + fr; const int row = u.pm * 256 + rl; float sq = 0.f;
#pragma unroll
                    for (int bj = 0; bj < 2; ++bj) { const u32x4 w = *(const u32x4*)((const char*)O + v_img_off<HV>(row, c0 + bj * 128));
                        const f32x4 o0 = unpk4((u32x2){w.x, w.y}), o1 = unpk4((u32x2){w.z, w.w}); const f32x4 qq = o0 * o0 + o1 * o1; sq += (qq[0] + qq[1]) + (qq[2] + qq[3]); }
                    sq = xsum_16_32(sq);
                    if (fq == 0) tbl[rl * 4 + wc] = sq; }
            asm volatile("s_waitcnt lgkmcnt(0)" ::: "memory"); __builtin_amdgcn_s_barrier(); asm volatile("" ::: "memory");
#pragma unroll
            for (int ai = 0; ai < 2; ++ai) {
                u32x4 ov[4][2];
#pragma unroll
                for (int m = 0; m < 4; ++m) { const int row = u.pm * 256 + ai * 128 + wr * 64 + m * 16 + fr;
#pragma unroll
                    for (int bj = 0; bj < 2; ++bj) ov[m][bj] = *(const u32x4*)((const char*)O + v_img_off<HV>(row, c0 + bj * 128)); }
                asm volatile("" ::: "memory");
#pragma unroll
                for (int m = 0; m < 4; ++m) { const int rl = ai * 128 + wr * 64 + m * 16 + fr; const int row = u.pm * 256 + rl;
                    const f32x4 pr = *(const LAS f32x4*)(tbl + rl * 4);
                    const float rstd = __builtin_amdgcn_rsqf(((pr[0] + pr[1]) + (pr[2] + pr[3])) * INV + EPS);
#pragma unroll
                    for (int bj = 0; bj < 2; ++bj) {
                        const f32x4 o0 = unpk4((u32x2){ov[m][bj].x, ov[m][bj].y}), o1 = unpk4((u32x2){ov[m][bj].z, ov[m][bj].w}), a0 = acc[ai][bj][m][0], a1 = acc[ai][bj][m][1]; f32x4 r0, r1;
#pragma unroll
                        for (int j = 0; j < 4; ++j) { r0[j] = o0[j] * rstd * silu_f(a0[j]); r1[j] = o1[j] * rstd * silu_f(a1[j]); }
                        const u32x2 q0 = pk4(r0), q1 = pk4(r1);
                        *(u32x4*)(A + (size_t)row * N + c0 + bj * 128) = (u32x4){q0.x, q0.y, q1.x, q1.y};
                    }
                }
                asm volatile("" ::: "memory");
            }
        }
    }
};
namespace attn_body {
using bf16=unsigned short;
using bf16x8=__attribute__((ext_vector_type(8)))short;
using s16x4=__attribute__((ext_vector_type(4)))short;
using f32x16=__attribute__((ext_vector_type(16)))float;
using u32x4=__attribute__((ext_vector_type(4)))unsigned;
constexpr int BATCH=4,NHEAD=16,SEQ=4096,D=64,DM=NHEAD*D;
constexpr int NW=8,QBLK=32,QB=QBLK*NW,KVBLK=64,NQB=SEQ/QB;
constexpr int ATTN_PITCH=DM, ATTN_UNIT_ROWS=QB;
__device__ __forceinline__ int crow(int r,int hi){return (r&3)+8*(r>>2)+4*hi;}
#define SBAR() __builtin_amdgcn_sched_barrier(0)
__device__ __forceinline__ void cmask(f32x16&p0,f32x16&p1,int jb,int qrel,int hi){
  const float NEG=-INFINITY; int kb=64*jb+4*hi;
  #pragma unroll
  for(int r=0;r<16;++r){int kv=kb+(r&3)+8*(r>>2); if(kv>qrel)p0[r]=NEG; if(kv+32>qrel)p1[r]=NEG;}
}

constexpr int NSLOT=3, SLOTB=8192;
constexpr int LDS_K=0, LDS_V=NSLOT*SLOTB, LDS_WS=2*NSLOT*SLOTB, LDS_OST=LDS_WS+NW*64*4, LDS_NC=LDS_OST+NW*4096, LDS_FT=LDS_NC+SEQ*4, LDS_RE=LDS_FT+256, LDS_BYTES=LDS_RE+256;
constexpr float C2=0.125f*1.4426950408889634f;
__device__ __forceinline__ void glds16(const void*gsrc,unsigned lds_dst){unsigned keep;
  asm volatile("s_mov_b32 %0, m0\n\ts_mov_b32 m0, %2\n\ts_nop 0\n\tglobal_load_lds_dwordx4 %1, off\n\ts_mov_b32 m0, %0":"=&s"(keep):"v"(gsrc),"s"(lds_dst):"memory");}
__device__ __forceinline__ float max3f(float a,float b,float c){float r;asm("v_max3_f32 %0, %1, %2, %3":"=v"(r):"v"(a),"v"(b),"v"(c));return r;}
__device__ __forceinline__ float max2f(float a,float b){float r;asm("v_max_f32_e32 %0, %1, %2":"=v"(r):"v"(a),"v"(b));return r;}
__device__ __forceinline__ float fadd_s(float a,float b){float r;asm("v_add_f32_e32 %0, %1, %2":"=v"(r):"v"(a),"v"(b));return r;}
__device__ __forceinline__ float fsub_s(float a,float b){float r;asm("v_sub_f32_e32 %0, %1, %2":"=v"(r):"v"(a),"v"(b));return r;}
typedef float f32x2_t __attribute__((ext_vector_type(2))); typedef __bf16 bf16x2_t __attribute__((ext_vector_type(2)));
__device__ __forceinline__ unsigned cvtpk_s(float lo,float hi){f32x2_t v={lo,hi};bf16x2_t b=__builtin_convertvector(v,bf16x2_t);return __builtin_bit_cast(unsigned,b);}
#define WAIT_BAR(N) asm volatile("s_waitcnt vmcnt(" #N ") lgkmcnt(0)\n\ts_barrier":::"memory")

__device__ __forceinline__ void qkt(f32x16&p0,f32x16&p1,const char*Kslot,const bf16x8*qr,const f32x16&negm,int r32,int hi){
  const char*kb=Kslot+hi*1024+r32*16;
  #pragma unroll
  for(int d0=0;d0<4;++d0){
    const bf16x8 b0=*reinterpret_cast<const bf16x8*>(kb+d0*2048);
    const bf16x8 b1=*reinterpret_cast<const bf16x8*>(kb+d0*2048+512);
    if(d0==0){p0=__builtin_amdgcn_mfma_f32_32x32x16_bf16(b0,qr[0],negm,0,0,0);p1=__builtin_amdgcn_mfma_f32_32x32x16_bf16(b1,qr[0],negm,0,0,0);}
    else{p0=__builtin_amdgcn_mfma_f32_32x32x16_bf16(b0,qr[d0],p0,0,0,0);p1=__builtin_amdgcn_mfma_f32_32x32x16_bf16(b1,qr[d0],p1,0,0,0);}}
}
typedef __attribute__((address_space(3))) const char* lds_cptr;
typedef short v4i16_t __attribute__((ext_vector_type(4)));
__device__ __forceinline__ void kload8(bf16x8*kf,lds_cptr kp){
  kf[0]=*(const __attribute__((address_space(3))) bf16x8*)(kp);      kf[1]=*(const __attribute__((address_space(3))) bf16x8*)(kp+512);
  kf[2]=*(const __attribute__((address_space(3))) bf16x8*)(kp+2048); kf[3]=*(const __attribute__((address_space(3))) bf16x8*)(kp+2560);
  kf[4]=*(const __attribute__((address_space(3))) bf16x8*)(kp+4096); kf[5]=*(const __attribute__((address_space(3))) bf16x8*)(kp+4608);
  kf[6]=*(const __attribute__((address_space(3))) bf16x8*)(kp+6144); kf[7]=*(const __attribute__((address_space(3))) bf16x8*)(kp+6656);
}
__device__ __forceinline__ void kload2(bf16x8*kf,lds_cptr kp,int j){ kf[2*j]=*(const __attribute__((address_space(3))) bf16x8*)(kp+j*2048); kf[2*j+1]=*(const __attribute__((address_space(3))) bf16x8*)(kp+j*2048+512); }
__device__ __forceinline__ s16x4 vtr(lds_cptr p){ return __builtin_bit_cast(s16x4,__builtin_amdgcn_ds_read_tr16_b64_v4i16((__attribute__((address_space(3))) v4i16_t*)p)); }
__device__ __forceinline__ float rowmax(const f32x16&p0,const f32x16&p1){
  float a=max3f(p0[0],p0[1],p1[0]),b=max3f(p0[2],p0[3],p1[1]);a=max3f(a,p1[2],p1[3]);
  #pragma unroll
  for(int r=4;r<16;r+=4){a=max3f(a,p0[r],p0[r+1]);b=max3f(b,p0[r+2],p0[r+3]);a=max3f(a,p1[r],p1[r+1]);b=max3f(b,p1[r+2],p1[r+3]);}
  const float m=max2f(a,b);
  auto rr=__builtin_amdgcn_permlane32_swap(__float_as_uint(m),__float_as_uint(m),false,false);
  return max2f(__uint_as_float(rr[0]),__uint_as_float(rr[1]));
}
__device__ __forceinline__ void pv(f32x16*o,int vb,bf16x8 pa0,bf16x8 pa1,bf16x8 pa2,bf16x8 pa3){
  #pragma unroll
  for(int d0=0;d0<2;++d0){s16x4 lo[4],hi[4];
    #pragma unroll
    for(int ks=0;ks<4;++ks){
      asm volatile("ds_read_b64_tr_b16 %0,%1 offset:%c2":"=&v"(lo[ks]):"v"(vb),"i"(d0*4096+ks*1024):"memory");
      asm volatile("ds_read_b64_tr_b16 %0,%1 offset:%c2":"=&v"(hi[ks]):"v"(vb),"i"(d0*4096+ks*1024+512):"memory");}
    asm volatile("s_waitcnt lgkmcnt(0)":::"memory");SBAR();
    #define PK(k) (bf16x8){lo[k][0],lo[k][1],lo[k][2],lo[k][3],hi[k][0],hi[k][1],hi[k][2],hi[k][3]}
    o[d0]=__builtin_amdgcn_mfma_f32_32x32x16_bf16(pa0,PK(0),o[d0],0,0,0);
    o[d0]=__builtin_amdgcn_mfma_f32_32x32x16_bf16(pa1,PK(1),o[d0],0,0,0);
    o[d0]=__builtin_amdgcn_mfma_f32_32x32x16_bf16(pa2,PK(2),o[d0],0,0,0);
    o[d0]=__builtin_amdgcn_mfma_f32_32x32x16_bf16(pa3,PK(3),o[d0],0,0,0);
    #undef PK
  }
}

#ifndef ATTN_STORE16
#define ATTN_STORE16(p,v) (*(u32x4*)(p)=(v))
#endif
template<int THRL> __device__ __forceinline__ void attn_unit(int b,int h,int qb,int ts,const bf16*Q,const bf16*__restrict__ K,const bf16*__restrict__ V,const bf16*__restrict__ Gt,bf16*O,char*shm,int tid){
  const int lane=tid&63,r32=lane&31,hi=lane>>5; const int wid=__builtin_amdgcn_readfirstlane(tid>>6);
  const long rowbase=(long)b*SEQ; const int q0=qb*QB;
  typedef __attribute__((address_space(3))) const float* lds_fptr; typedef float f32x4b __attribute__((ext_vector_type(4)));
  const lds_fptr ncum=(lds_fptr)((__attribute__((address_space(3))) const char*)shm+LDS_NC)+64*ts+4*hi;
  const lds_fptr ftp=(lds_fptr)((__attribute__((address_space(3))) const char*)shm+LDS_FT)+ts;
  const bf16*Qw=Q+(rowbase+q0+wid*QBLK)*DM+h*D;
  const bf16*Kh=K+(rowbase+(long)ts*KVBLK)*DM+h*D,*Vh=V+(rowbase+(long)ts*KVBLK)*DM+h*D;
  const unsigned lds0=(unsigned)(uintptr_t)shm;
  float*wsf=(float*)(shm+LDS_WS)+wid*64;
  const bf16*ksrc=Kh+(long)lane*DM+wid*8;
  const bf16*vsrc=Vh+(long)(16*(wid&3)+(lane>>2))*DM+(wid>>2)*32+(lane&3)*8;
  const unsigned kdst=lds0+LDS_K+wid*1024, vdst=lds0+LDS_V+wid*1024;
  #define DMA_K(t,slot) glds16(ksrc+(long)(t)*KVBLK*DM,(unsigned)__builtin_amdgcn_readfirstlane(kdst+(slot)))
  #define DMA_V(t,slot) glds16(vsrc+(long)(t)*KVBLK*DM,(unsigned)__builtin_amdgcn_readfirstlane(vdst+(slot)))
  const int vb0=(int)(lds0+LDS_V)+((lane>>4)&1)*32+(lane&3)*8+(4*hi+((lane&15)>>2))*64;
  const char*Kbase=shm+LDS_K; bf16x8 kf[8];
  const lds_cptr shm3=(lds_cptr)shm; const lds_cptr kp0=shm3+LDS_K+hi*1024+r32*16; const lds_cptr vp0=shm3+LDS_V+((lane>>4)&1)*32+(lane&3)*8+(4*hi+((lane&15)>>2))*64;
  const int NT=(q0+QB)/KVBLK-ts;
  DMA_K(0,0);DMA_V(0,0);DMA_K(1,SLOTB);
  bf16x8 qr[4];
  #pragma unroll
  for(int d0=0;d0<4;++d0)qr[d0]=*reinterpret_cast<const bf16x8*>(&Qw[(long)r32*DM+d0*16+hi*8]);
  float l_reg=0.f,fcur=1.f;f32x16 o[2];o[0]=f32x16{};o[1]=f32x16{};const f32x16 negm=f32x16{};
  const int qrel=wid*QBLK+r32;
  #define CMASK(P0,P1,t) do{int jb_=(t)-(NT-4); if(jb_>=0)cmask(P0,P1,jb_,qrel,hi);}while(0)
  #define LDSF4(p) (*(const __attribute__((address_space(3))) f32x4b*)(p))
  #define BIAS(P0,P1,t) do{ const lds_fptr nb_=ncum+64*(t); \
      { const f32x4b a0_=LDSF4(nb_), a1_=LDSF4(nb_+8), a2_=LDSF4(nb_+16), a3_=LDSF4(nb_+24); \
        _Pragma("unroll") for(int j_=0;j_<4;++j_){ P0[j_]+=a0_[j_]; P0[4+j_]+=a1_[j_]; P0[8+j_]+=a2_[j_]; P0[12+j_]+=a3_[j_]; } } SBAR(); \
      { const f32x4b b0_=LDSF4(nb_+32), b1_=LDSF4(nb_+40), b2_=LDSF4(nb_+48), b3_=LDSF4(nb_+56); \
        _Pragma("unroll") for(int j_=0;j_<4;++j_){ P1[j_]+=b0_[j_]; P1[4+j_]+=b1_[j_]; P1[8+j_]+=b2_[j_]; P1[12+j_]+=b3_[j_]; } } SBAR(); }while(0)
  #define START(P0,P1) do{ _Pragma("unroll") for(int r=0;r<16;++r)P0[r]=__builtin_amdgcn_exp2f(P0[r]); }while(0)
  #define RESC() do{ _Pragma("unroll") for(int d_=0;d_<2;++d_) _Pragma("unroll") for(int r=0;r<16;++r)o[d_][r]*=fcur; }while(0)
  f32x16 pA0,pA1,pB0,pB1;
  int sl_prev=0,sl_cur=0,sl_next=SLOTB;
  #define ROT() do{sl_prev=sl_cur;sl_cur=sl_next;sl_next=(sl_next==(NSLOT-1)*SLOTB)?0:sl_next+SLOTB;}while(0)
  DMA_K(2,2*SLOTB);
  WAIT_BAR(3);
  qkt(pA0,pA1,Kbase,qr,negm,r32,hi);asm volatile("s_nop 15\n\ts_nop 7":"+v"(pA0),"+v"(pA1));BIAS(pA0,pA1,0);CMASK(pA0,pA1,0);
  START(pA0,pA1);
  _Pragma("unroll") for(int r=0;r<16;++r)pA1[r]=__builtin_amdgcn_exp2f(pA1[r]);
  WAIT_BAR(0);
  DMA_K(3,0);DMA_V(1,SLOTB);
  ROT();
  kload8(kf,kp0+sl_cur);
  WAIT_BAR(2);
  s16x4 vlo[8],vhi[8]; u32x4 pw0,pw1,pw2,pw3;
  #define PKW(P,B) cvtpk_s(P[B],P[B+1])
  #define PAF(k) __builtin_bit_cast(bf16x8,pw##k)
  #define VFR(i) (bf16x8){vlo[i][0],vlo[i][1],vlo[i][2],vlo[i][3],vhi[i][0],vhi[i][1],vhi[i][2],vhi[i][3]}
  #define PIN(x) asm volatile("":"+v"(x))
  #define MX3(a,b,c) __builtin_fmaxf(__builtin_fmaxf((a),(b)),(c))
  #define GAPA(MF,A0,A1,A2,A3,W0,W1,PW) do{ MF; sacc+=A0; sacc+=A1; sacc+=A2; sacc+=A3; PIN(sacc); W0; W1; PIN(PW); SBAR(); }while(0)
  #define EX(v) __builtin_amdgcn_exp2f(v)
  #define GAPB(MF,X,B) do{ MF; X[B]=EX(X[B]); X[B+1]=EX(X[B+1]); X[B+2]=EX(X[B+2]); X[B+3]=EX(X[B+3]); PIN(X); SBAR(); }while(0)
  #define VRD(i) do{ vlo[i]=vtr(vp_+(((i)>>2)*4096+((i)&3)*1024)); vhi[i]=vtr(vp_+(((i)>>2)*4096+((i)&3)*1024+512)); }while(0)
  #define KRD(G,j) do{ if(G){ kload2(kf,kp0+sl_next,j); SBAR(); } }while(0)
  #define STEP(C0,C1,P0,P1,t,GK,GV,GL) do{ SBAR(); \
    const lds_cptr vp_=vp0+sl_prev; \
    VRD(0); SBAR(); float sacc=(P0[0]+P0[1]); \
    GAPA(C0=__builtin_amdgcn_mfma_f32_32x32x16_bf16(kf[0],qr[0],negm,0,0,0), P0[2],P0[3],P0[4],P0[5],     pw0[0]=PKW(P0,0), pw0[1]=PKW(P0,2), pw0); \
    VRD(4); SBAR(); GAPA(C1=__builtin_amdgcn_mfma_f32_32x32x16_bf16(kf[1],qr[0],negm,0,0,0), P0[6],P0[7],P0[8],P0[9],     pw0[2]=PKW(P0,4), pw0[3]=PKW(P0,6), pw0); \
    VRD(1); SBAR(); GAPA(C0=__builtin_amdgcn_mfma_f32_32x32x16_bf16(kf[2],qr[1],C0,0,0,0),   P0[10],P0[11],P0[12],P0[13], pw1[0]=PKW(P0,8), pw1[1]=PKW(P0,10), pw1); \
    VRD(5); SBAR(); GAPA(C1=__builtin_amdgcn_mfma_f32_32x32x16_bf16(kf[3],qr[1],C1,0,0,0),   P0[14],P0[15],P1[0],P1[1],   pw1[2]=PKW(P0,12),pw1[3]=PKW(P0,14), pw1); \
    VRD(2); SBAR(); GAPA(C0=__builtin_amdgcn_mfma_f32_32x32x16_bf16(kf[4],qr[2],C0,0,0,0),   P1[2],P1[3],P1[4],P1[5],     pw2[0]=PKW(P1,0), pw2[1]=PKW(P1,2), pw2); \
    VRD(6); SBAR(); GAPA(C1=__builtin_amdgcn_mfma_f32_32x32x16_bf16(kf[5],qr[2],C1,0,0,0),   P1[6],P1[7],P1[8],P1[9],     pw2[2]=PKW(P1,4), pw2[3]=PKW(P1,6), pw2); \
    VRD(3); SBAR(); GAPA(C0=__builtin_amdgcn_mfma_f32_32x32x16_bf16(kf[6],qr[3],C0,0,0,0),   P1[10],P1[11],P1[12],P1[13], pw3[0]=PKW(P1,8), pw3[1]=PKW(P1,10), pw3); \
    VRD(7); SBAR(); GAPA(C1=__builtin_amdgcn_mfma_f32_32x32x16_bf16(kf[7],qr[3],C1,0,0,0),   P1[14],P1[15],0.f,0.f,       pw3[2]=PKW(P1,12),pw3[3]=PKW(P1,14), pw3); \
    l_reg+=sacc; \
    if(GK){DMA_K((t)+3,sl_cur);} if(GV){DMA_V((t)+1,sl_next);} \
    BIAS(C0,C1,t); CMASK(C0,C1,t); \
    { const int jb2_=2*((t)-(NT-4)); fcur=(jb2_>wid)?1.0f:ftp[(t)]; l_reg*=fcur; } \
    SBAR(); \
    GAPB(o[0]=__builtin_amdgcn_mfma_f32_32x32x16_bf16(PAF(0),VFR(0),o[0],0,0,0), C0,0); \
    GAPB(o[1]=__builtin_amdgcn_mfma_f32_32x32x16_bf16(PAF(0),VFR(4),o[1],0,0,0), C0,4); \
    KRD(GL,0); GAPB(o[0]=__builtin_amdgcn_mfma_f32_32x32x16_bf16(PAF(1),VFR(1),o[0],0,0,0), C0,8); \
    KRD(GL,1); GAPB(o[1]=__builtin_amdgcn_mfma_f32_32x32x16_bf16(PAF(1),VFR(5),o[1],0,0,0), C0,12); \
    KRD(GL,2); GAPB(o[0]=__builtin_amdgcn_mfma_f32_32x32x16_bf16(PAF(2),VFR(2),o[0],0,0,0), C1,0); \
    KRD(GL,3); GAPB(o[1]=__builtin_amdgcn_mfma_f32_32x32x16_bf16(PAF(2),VFR(6),o[1],0,0,0), C1,4); \
    GAPB(o[0]=__builtin_amdgcn_mfma_f32_32x32x16_bf16(PAF(3),VFR(3),o[0],0,0,0), C1,8); \
    GAPB(o[1]=__builtin_amdgcn_mfma_f32_32x32x16_bf16(PAF(3),VFR(7),o[1],0,0,0), C1,12); \
    }while(0)
  int t=1;
  #undef CMASK
  #define CMASK(P0,P1,t) do{}while(0)
  for(;t+5<NT;t+=2){
    STEP(pB0,pB1,pA0,pA1,t,true,true,true);     WAIT_BAR(2); RESC(); ROT();
    STEP(pA0,pA1,pB0,pB1,t+1,true,true,true);   WAIT_BAR(2); RESC(); ROT();
  }
  #undef CMASK
  int qrel_m=qrel,hi_m=hi; asm volatile("":"+v"(qrel_m),"+v"(hi_m));
  #define CMASK(P0,P1,t) do{int jb_=(t)-(NT-4); if(jb_>=0)cmask(P0,P1,jb_,qrel_m,hi_m);}while(0)
  #define ENDW(tt) do{ if((tt)+3<NT){WAIT_BAR(2);} else if((tt)+2<NT){WAIT_BAR(1);} else {WAIT_BAR(0);} }while(0)
  for(;t+1<NT;t+=2){
    STEP(pB0,pB1,pA0,pA1,t,(t+3<NT),(t+1<NT),(t+1<NT));       ENDW(t);   RESC(); ROT();
    STEP(pA0,pA1,pB0,pB1,t+1,(t+4<NT),(t+2<NT),(t+2<NT));     ENDW(t+1); RESC(); ROT();
  }
  STEP(pB0,pB1,pA0,pA1,NT-1,false,false,false); RESC();
  { float sacc=pB0[0]+pB0[1]; _Pragma("unroll") for(int r=2;r<16;++r)sacc+=pB0[r]; _Pragma("unroll") for(int r=0;r<16;++r)sacc+=pB1[r]; l_reg+=sacc;
    pw0=(u32x4){PKW(pB0,0),PKW(pB0,2),PKW(pB0,4),PKW(pB0,6)};pw1=(u32x4){PKW(pB0,8),PKW(pB0,10),PKW(pB0,12),PKW(pB0,14)};pw2=(u32x4){PKW(pB1,0),PKW(pB1,2),PKW(pB1,4),PKW(pB1,6)};pw3=(u32x4){PKW(pB1,8),PKW(pB1,10),PKW(pB1,12),PKW(pB1,14)};
    SBAR(); pv(o,vb0+sl_cur,PAF(0),PAF(1),PAF(2),PAF(3)); }
  #undef PKW
  #undef PAF
  #undef VFR
  #undef PIN
  #undef MX3
  #undef GAPA
  #undef GAPB
  #undef EX
  #undef VRD
  #undef KRD
  #undef STEP
  #undef ENDW
  {auto rr=__builtin_amdgcn_permlane32_swap(__float_as_uint(l_reg),__float_as_uint(l_reg),false,false);l_reg=__uint_as_float(rr[0])+__uint_as_float(rr[1]);}
  if(hi==0)wsf[32+r32]=l_reg;asm volatile("s_waitcnt lgkmcnt(0)":::"memory");
  float rli[16];
  #pragma unroll
  for(int r=0;r<16;++r)rli[r]=__builtin_amdgcn_rcpf(wsf[32+crow(r,hi)]);
  bf16*Ow=O+(rowbase+q0+wid*QBLK)*DM+h*D;
  { bf16*stg=(bf16*)(shm+LDS_OST)+wid*2048;
    #pragma unroll
    for(int r=0;r<16;++r){const int orow=crow(r,hi);
      #pragma unroll
      for(int d0=0;d0<2;++d0){const float gv=__uint_as_float((unsigned)Gt[(rowbase+q0+wid*QBLK+orow)*DM+h*D+d0*32+r32]<<16); const float ov=o[d0][r]*rli[r]*gv; unsigned ub=__float_as_uint(ov); ub=(ub+0x7fffu+((ub>>16)&1u))>>16; stg[orow*64+d0*32+r32]=(bf16)ub;}}
    asm volatile("s_waitcnt lgkmcnt(0)":::"memory");
    #pragma unroll
    for(int i=0;i<4;++i){const int row=i*8+(lane>>3),ch=lane&7; const u32x4 v=*(const u32x4*)(stg+row*64+ch*8); ATTN_STORE16(Ow+(long)row*DM+ch*8,v);} }
  asm volatile("s_waitcnt lgkmcnt(0)\n\ts_barrier":::"memory");
  #undef DMA_K
  #undef DMA_V
  #undef CMASK
  #undef BIAS
  #undef LDSF4
  #undef START
  #undef RESC
  #undef ROT
}
constexpr int ATTN_LDS_BYTES=LDS_BYTES;
#undef SBAR
#undef WAIT_BAR
}

__device__ __forceinline__ void fox_attn2(const Params& P, char* shm, int tid, int bid, int G, unsigned short* Odst) {
    const int lane = tid & 63;
    unsigned short* Q = (unsigned short*)(P.ws + WS_ACT); const unsigned short* Kb = (const unsigned short*)(P.ws + WS_ACT + 32 * MiB); const unsigned short* V = (const unsigned short*)(P.ws + WS_ACT + 64 * MiB);
    const unsigned short* Gt = (const unsigned short*)(P.ws + WS_ACT + 96 * MiB);
    LAS float* nc = (LAS float*)((LAS char*)shm + attn_body::LDS_NC);
    LAS float* ft = (LAS float*)((LAS char*)shm + attn_body::LDS_FT);
    LAS float* re = (LAS float*)((LAS char*)shm + attn_body::LDS_RE);
    float gq = fabsf(P.fox_q_gain[lane]), gk = fabsf(P.fox_k_gain[lane]);
#pragma unroll
    for (int o = 1; o < 64; o <<= 1) { gq = fmaxf(gq, __shfl_xor(gq, o)); gk = fmaxf(gk, __shfl_xor(gk, o)); }
    const float Smax = 1.02f * (64.0f * gq * gk * 0.125f * LOG2E);
    const float T = 2.0f * Smax + 40.0f;
    const int vcu = (G % 8 == 0) ? (bid % 8) * (G / 8) + bid / 8 : bid;
    int last_bh = -1;
    for (int i = 0;; ++i) {
        int bh, qb;
        if (G == 256) { if (i >= 4) break; bh = vcu >> 2; const int s = vcu & 3; qb = (i == 0) ? s : (i == 1) ? 7 - s : (i == 2) ? 8 + s : 15 - s; }
        else { const int ui = i * G + bid; if (ui >= 1024) break; bh = ui >> 4; qb = ui & 15; }
        if (bh != last_bh) {
            const float* LF = (const float*)(P.ws + WS_S16) + ((size_t)(bh >> 4) * SEQ + 8 * tid) * 16 + (bh & 15);
            float v8[8]; float run = 0.f;
#pragma unroll
            for (int i2 = 0; i2 < 8; ++i2) { run += LF[(size_t)i2 * 16]; v8[i2] = run; }
            float inc = run;
#pragma unroll
            for (int o = 1; o < 64; o <<= 1) { const float tt = __shfl_up(inc, o); if (lane >= o) inc += tt; }
            if (lane == 63) ft[tid >> 6] = inc;
            __syncthreads();
            float pre = inc - run;
            for (int w = 0; w < (tid >> 6); ++w) pre += ft[w];
            __syncthreads();
#pragma unroll
            for (int i2 = 0; i2 < 8; ++i2) nc[8 * tid + i2] = -(pre + v8[i2]) * LOG2E;
            __syncthreads();
            if (tid < 64) { const float e = nc[64 * tid + 63]; re[tid] = e; const float ep = (tid > 0) ? nc[64 * tid - 1] : e; ft[tid] = exp2f(ep - e); }
            __syncthreads();
#pragma unroll
            for (int i2 = 0; i2 < 8; ++i2) nc[8 * tid + i2] += -re[tid >> 3] - Smax + 40.0f;
            __syncthreads(); last_bh = bh;
        }
        const int ntf = 4 * qb + 4;
        const float thr = (qb > 0 ? re[4 * qb - 1] : 0.0f) - T;
        const bool pred = (lane < ntf) && (re[lane] < thr);
        int ts = __builtin_popcountll(__ballot(pred)) & ~1; ts = ts > ntf - 4 ? ntf - 4 : ts; ts = __builtin_amdgcn_readfirstlane(ts);
        int tid_u = tid; asm volatile("" : "+v"(tid_u));
        attn_body::attn_unit<8>(bh >> 4, bh & 15, qb, ts, Q, Kb, V, Gt, Odst ? Odst : Q, shm, tid_u);
    }
}

__device__ __forceinline__ void final_norm(const Params& P, const bf16_t* xin, int tid, int bid, int G) {
    const int lane = tid & 63, wave = tid >> 6;
    const int gw = bid * 8 + wave, NGW = G * 8;
    f32x4 g[4];
#pragma unroll
    for (int j = 0; j < 4; ++j) g[j] = *(const f32x4*)(P.final_g + 4 * lane + 256 * j);
    constexpr int RB = 4;
    for (int row0 = gw; row0 < MT; row0 += RB * NGW) {
        f32x4 v[RB][4];
#pragma unroll
        for (int rb = 0; rb < RB; ++rb) { const int row = row0 + rb * NGW < MT ? row0 + rb * NGW : row0; const u32x2* xr = (const u32x2*)(xin + (size_t)row * 1024) + lane;
#pragma unroll
            for (int j = 0; j < 4; ++j) v[rb][j] = unpk4(xr[64 * j]); }
#pragma unroll
        for (int rb = 0; rb < RB; ++rb) { const int row = row0 + rb * NGW; if (row >= MT) break;
            float ss = 0.f;
#pragma unroll
            for (int j = 0; j < 4; ++j) ss += (v[rb][j][0] * v[rb][j][0] + v[rb][j][1] * v[rb][j][1]) + (v[rb][j][2] * v[rb][j][2] + v[rb][j][3] * v[rb][j][3]);
            const float rstd = rsqrtf(wave_sum(ss) * (1.0f / 1024.0f) + EPS);
            f32x4* xw = (f32x4*)(P.out + (size_t)row * 1024) + lane;
#pragma unroll
            for (int j = 0; j < 4; ++j) xw[64 * j] = (v[rb][j] * rstd) * g[j];
        }
    }
}

#define XB_TMO      128
#define XB_XCNT(j)  (256  + 64 * (j))
#define XB_XSUB(j)  (1280 + 64 * (j))
#define XB_XGEN(j)  (2304 + 64 * (j))
#define XB_TOP      3328
#define XB_TOPGEN   3392
#define XCD_BAR_WORDS 3456
#define XB_SPIN_CAP (1u << 20)
__device__ __forceinline__ unsigned xb_ld(unsigned* p)              { return __hip_atomic_load(p, __ATOMIC_RELAXED, __HIP_MEMORY_SCOPE_AGENT); }
__device__ __forceinline__ unsigned xb_add(unsigned* p, unsigned v) { return __hip_atomic_fetch_add(p, v, __ATOMIC_RELAXED, __HIP_MEMORY_SCOPE_AGENT); }
__device__ __forceinline__ unsigned xb_xcc_id() { return (unsigned)__builtin_amdgcn_s_getreg((3 << 11) | 20) & 0xFu; }
#define XB_SPIN(cond, bar) do { unsigned _sp = 0; while (cond) { __builtin_amdgcn_s_sleep(1); \
    if ((++_sp & 255u) == 0u) { if (xb_ld(&(bar)[XB_TMO])) break; if (_sp > XB_SPIN_CAP) { atomicAdd(&(bar)[XB_TMO], 1u); break; } } } } while (0)
struct XcdBarrier { unsigned* bar; unsigned x; volatile LAS unsigned* st; int wave_s; };
__device__ __forceinline__ int lane_id() { return (int)__builtin_amdgcn_mbcnt_hi(~0u, __builtin_amdgcn_mbcnt_lo(~0u, 0u)); }
__device__ __forceinline__ XcdBarrier xcd_barrier_post(unsigned* bar, volatile LAS unsigned* st, int wave_s) {
    XcdBarrier b; b.bar = bar; b.x = xb_xcc_id(); b.st = st; b.wave_s = wave_s;
    if (threadIdx.x == 0) (void)xb_add(&bar[XB_XCNT(b.x)], 1u);
    return b;
}
__device__ __forceinline__ void xcd_barrier_complete(unsigned* bar, unsigned x, unsigned& nloc, unsigned& nx) {
    const unsigned G = gridDim.x * gridDim.y * gridDim.z;
    asm volatile("" : "+s"(x));
    unsigned sum, cnt, mine, sp = 0u;
    for (;;) {
        sum = 0u; cnt = 0u; mine = 0u;
#pragma unroll
        for (unsigned j = 0; j < 16; ++j) { const unsigned c = xb_ld(&bar[XB_XCNT(j)]); sum += c; cnt += (c > 0u) ? 1u : 0u; mine = (j == x) ? c : mine; }
        if (sum == G) break;
        __builtin_amdgcn_s_sleep(1);
        if ((++sp & 255u) == 0u) { if (xb_ld(&bar[XB_TMO])) break; if (sp > XB_SPIN_CAP) { atomicAdd(&bar[XB_TMO], 1u); break; } }
    }
    nloc = mine > 0u ? mine : 1u; nx = cnt > 0u ? cnt : 1u;
}
__device__ __forceinline__ void xcd_barrier(const XcdBarrier& b) {
    asm volatile("s_waitcnt vmcnt(0)" ::: "memory");
    __syncthreads();
    if (threadIdx.x == 0) {
        unsigned* bar = b.bar;
        __builtin_amdgcn_s_waitcnt(0);
        unsigned nloc = b.st[0], nx = b.st[1];
        if (nloc == 0u) { xcd_barrier_complete(bar, b.x, nloc, nx); b.st[0] = nloc; b.st[1] = nx; }
        const unsigned old = xb_add(&bar[XB_XSUB(b.x)], 1u);
        const unsigned gen = old / nloc;
        if (old + 1u == (gen + 1u) * nloc) {
            __builtin_amdgcn_fence(__ATOMIC_RELEASE, "agent");
            asm volatile("s_waitcnt vmcnt(0)" ::: "memory");
            const unsigned og = xb_add(&bar[XB_TOP], 1u);
            const unsigned tg = og / nx;
            if (og + 1u == (tg + 1u) * nx) xb_add(&bar[XB_TOPGEN], 1u);
            else XB_SPIN(xb_ld(&bar[XB_TOPGEN]) == tg, bar);
            xb_add(&bar[XB_XGEN(b.x)], 1u);
            __builtin_amdgcn_fence(__ATOMIC_ACQUIRE, "agent");
            asm volatile("s_waitcnt vmcnt(0)" ::: "memory");
        } else {
            XB_SPIN(xb_ld(&bar[XB_XGEN(b.x)]) == gen, bar);
            __builtin_amdgcn_fence(__ATOMIC_ACQUIRE, "agent");
            asm volatile("s_waitcnt vmcnt(0)" ::: "memory");
        }
    }
    __syncthreads();
}

constexpr int LDS_BYTES = 147456;
#ifndef PROBE
#define PROBE 0
#endif
#define FRESH() int tid = threadIdx.x, bid = blockIdx.x; asm volatile("" : "+v"(tid)); asm volatile("" : "+s"(bid));
__global__ void __launch_bounds__(512, 2) trunk_fwd(Params P) {
    extern __shared__ __attribute__((aligned(16))) unsigned char lds_raw[];
    LAS unsigned char* lds = (LAS unsigned char*)lds_raw;
    cg::grid_group grid = cg::this_grid();
    const int G = gridDim.x;
    volatile LAS unsigned* MISC = (volatile LAS unsigned*)(lds + LDS_BYTES - 128);
    const int wave_s = __builtin_amdgcn_readfirstlane((int)threadIdx.x >> 6);
    if (threadIdx.x < 32) MISC[threadIdx.x] = 0u;
    __syncthreads();
    XcdBarrier xbar = xcd_barrier_post((unsigned*)P.ws, MISC + 8, wave_s);
    unsigned char* ws = P.ws;
    const float* MOD = (const float*)(ws + WS_MOD);
    bf16_t* XN = (bf16_t*)(ws + WS_XN);
    bf16_t* ACT = (bf16_t*)(ws + WS_ACT);
#define GSYNC() xcd_barrier(xbar)
    if (PROBE == 30) { { FRESH(); p0_mod(P, lds, tid, bid, G); } { FRESH(); p0_rope(P, tid, bid, G); } __syncthreads(); }
    if (PROBE == 31) { FRESH(); conv_weights(P.ret_w_in, RET_IN, 6144, P.ret_w_out, 2048, ws + WS_W, lds, tid, bid, G); __syncthreads(); }
    { FRESH(); p0_mod(P, lds, tid, bid, G); }
    { FRESH(); p0_rope(P, tid, bid, G); }
    { FRESH(); conv_weights(P.ret_w_in, RET_IN, 6144, P.ret_w_out, 2048, ws + WS_W, lds, tid, bid, G); }
    grid.sync();
#pragma unroll 1
    for (int layer = 0; layer < 4; ++layer) {
        const int kind = layer % 3, j = layer / 3;
        unsigned char* wbase = ws + ((kind == 2) ? WS_WGLA : WS_W);
        bf16_t* WinT = (bf16_t*)wbase; bf16_t* WoutT = (bf16_t*)(wbase + 12 * MiB);
        bf16_t* R0 = (bf16_t*)P.out; bf16_t* R1 = R0 + (size_t)MT * 1024;
        const void* xin = (layer == 0) ? (const void*)P.x : (layer == 2) ? (const void*)R1 : (const void*)R0;
        bf16_t* xout = (layer == 0 || layer == 2) ? R0 : (layer == 1) ? R1 : (bf16_t*)(ws + WS_ACT);
        if (layer > 0) {
            FRESH();
            if (kind == 0) { if (G != 256) conv_weights(P.ret_w_in + (size_t)j * 1024 * RET_IN, RET_IN, 6144, P.ret_w_out + (size_t)j * 2048 * 1024, 2048, ws + WS_W, lds, tid, bid, G); }
            else if (kind == 1) conv_weights(P.fox_w_in, FOX_IN, 4096, P.fox_w_out, 1024, ws + WS_W, lds, tid, bid, G);
            else conv_weights(P.gla_w_in, GLA_IN, 3072, P.gla_w_out, 1024, ws + WS_WGLA, lds, tid, bid, G);
            __syncthreads();
        }
        if (PROBE == 5 || (PROBE >= 50 && PROBE <= 53 && layer == PROBE - 50)) {
            if (layer == 0) { FRESH(); h_phase<0, true>(P, layer, xin, lds, tid, bid, G); }
            else if (kind == 0) { FRESH(); h_phase<0, false>(P, layer, xin, lds, tid, bid, G); }
            else if (kind == 1) { FRESH(); h_phase<1, false>(P, layer, xin, lds, tid, bid, G); }
            else { FRESH(); h_phase<2, false>(P, layer, xin, lds, tid, bid, G); }
            __syncthreads();
        }
        if (layer == 0) { FRESH(); h_phase<0, true>(P, layer, xin, lds, tid, bid, G); }
            else if (kind == 0) { FRESH(); h_phase<0, false>(P, layer, xin, lds, tid, bid, G); }
        else if (kind == 1) { FRESH(); h_phase<1, false>(P, layer, xin, lds, tid, bid, G); }
        else { FRESH(); h_phase<2, false>(P, layer, xin, lds, tid, bid, G); }
        GSYNC();
        const float* gate = MOD + (size_t)(layer * 4) * 3072 + 2048;
        if (kind == 0) {
            bf16_t* rQ = ACT; bf16_t* rK = (bf16_t*)(ws + WS_ACT + 32 * MiB); bf16_t* rV = (bf16_t*)(ws + WS_ACT + 64 * MiB); bf16_t* rO = (bf16_t*)(ws + WS_ACT + 128 * MiB);
            bf16_t* rP = WinT;
            float* STATS = (float*)(ws + WS_S16);
            {
                FRESH();
                pg8::Gemm g{XN, WinT, MT, 4096, 1024}; pg8::StaticOrder S; S.init(MT, 4096, G, bid);
                EpiRetIn E{rQ, rK, rV, (const unsigned*)(ws + WS_ROPE)};
                pg8::gemm_phase<EpiRetIn, pg8::StaticOrder, true, true>(lds, g, S, E, tid);
            }
            GSYNC();
            if (PROBE == 40) { FRESH();
                pg8::Gemm g{XN, WinT, MT, 4096, 1024}; pg8::StaticOrder S; S.init(MT, 4096, G, bid);
                EpiRetIn E{rQ, rK, rV, (const unsigned*)(ws + WS_ROPE)};
                pg8::gemm_phase<EpiRetIn, pg8::StaticOrder, true, true>(lds, g, S, E, tid); GSYNC(); }
            if (PROBE == 6) { FRESH();
                pg8::Gemm g{XN, WinT + (size_t)4096 * 1024, MT, 2048, 1024}; pg8::StaticOrder S; S.init(MT, 2048, G, bid);
                EpiSplit E{(bf16_t*)P.out, 8, 0, 2048, -1};
                if (layer == 0) { pg8::gemm_phase<EpiSplit, pg8::StaticOrder, true, true>(lds, g, S, E, tid); GSYNC(); } }
            if (PROBE == 62 && layer == 0) { FRESH();
                pg8::Gemm g{XN, WinT, MT, 4096, 1024}; pg8::StaticOrder S; S.init(MT, 4096, G, bid);
                EpiNone E{P.out};
                pg8::gemm_phase<EpiNone, pg8::StaticOrder, true, true>(lds, g, S, E, tid); GSYNC(); }
            if (PROBE == 60 && layer == 0) { FRESH();
                pg8::Gemm g{XN, WinT + (size_t)4096 * 1024, MT, 2048, 1024}; pg8::StaticOrder S; S.init(MT, 2048, G, bid);
                EpiNone E{P.out};
                pg8::gemm_phase<EpiNone, pg8::StaticOrder, true, true>(lds, g, S, E, tid); GSYNC(); }
            { FRESH(); lin_pphase<0>(rQ, rK, rQ, rK, rP, tid, bid, G); }
            GSYNC();
            if (PROBE == 2) { FRESH(); lin_scan<0>(rQ, rK, rV, rP, nullptr, rO, (float*)(ws + WS_CUM), lds, tid, bid, G); GSYNC(); }
            if (PROBE == 20 && layer == 0) { FRESH(); lin_scan<0, 1>(rQ, rK, rV, rP, nullptr, (bf16_t*)P.out, (float*)(ws + WS_CUM), lds, tid, bid, G); GSYNC(); }
            if (PROBE == 23 && layer == 0) { FRESH(); lin_scan<0, 4>(rQ, rK, rV, rP, nullptr, (bf16_t*)P.out, (float*)(ws + WS_CUM), lds, tid, bid, G); GSYNC(); }
            if (PROBE == 25 && layer == 0) { FRESH(); lin_scan<0, 16>(rQ, rK, rV, rP, nullptr, (bf16_t*)P.out, (float*)(ws + WS_CUM), lds, tid, bid, G); GSYNC(); }
            if (PROBE == 21 && layer == 0) { FRESH(); lin_scan<0, 2>(rQ, rK, rV, rP, nullptr, (bf16_t*)P.out, (float*)(ws + WS_CUM), lds, tid, bid, G); GSYNC(); }
            if (PROBE == 24 && layer == 0) { FRESH(); lin_scan<0, 8>(rQ, rK, rV, rP, nullptr, (bf16_t*)P.out, (float*)(ws + WS_CUM), lds, tid, bid, G); GSYNC(); }
            if (PROBE == 26 && layer == 0) { FRESH(); lin_scan<0, 3>(rQ, rK, rV, rP, nullptr, (bf16_t*)P.out, (float*)(ws + WS_CUM), lds, tid, bid, G); GSYNC(); }
            if (PROBE == 27 && layer == 0) { FRESH(); lin_scan<0, 11>(rQ, rK, rV, rP, nullptr, (bf16_t*)P.out, (float*)(ws + WS_CUM), lds, tid, bid, G); GSYNC(); }
            if (PROBE == 28 && layer == 0) { FRESH(); lin_scan<0, 31>(rQ, rK, rV, rP, nullptr, (bf16_t*)P.out, (float*)(ws + WS_CUM), lds, tid, bid, G); GSYNC(); }
            if (PROBE == 22 && layer == 0) { FRESH(); lin_scan<0, 0>(rQ, rK, rV, rP, nullptr, (bf16_t*)P.out, (float*)(ws + WS_CUM), lds, tid, bid, G); GSYNC(); }
            { FRESH(); lin_scan<0>(rQ, rK, rV, rP, nullptr, rO, (float*)(ws + WS_CUM), lds, tid, bid, G); }
            GSYNC();
            {
                FRESH();
                pg8::Gemm g{XN, WinT + (size_t)4096 * 1024, MT, 2048, 1024}; pg8::PairOrder S{G, (G % 8 == 0) ? (bid % 8) * (G / 8) + bid / 8 : bid};
                EpiGateNorm<0> E{rO, rV, (LAS float*)(lds + 131072)};
                pg8::gemm_phase<EpiGateNorm<0>, pg8::PairOrder, true, true>(lds, g, S, E, tid);
            }
            GSYNC();
            if (PROBE == 42 && layer == 0) { FRESH();
                pg8::Gemm g{rV, WoutT, MT, 1024, 2048}; pg8::StaticOrder S; S.init(MT, 1024, G, bid);
                EpiOut<true> E{xin, xout, gate};
                pg8::gemm_phase<EpiOut<true>, pg8::StaticOrder, true, true>(lds, g, S, E, tid); GSYNC(); }
            if (layer == 0) {
                FRESH();
                pg8::Gemm g{rV, WoutT, MT, 1024, 2048}; pg8::StaticOrder S; S.init(MT, 1024, G, bid);
                EpiOut<true> E{xin, xout, gate};
                pg8::gemm_phase<EpiOut<true>, pg8::StaticOrder, true, true>(lds, g, S, E, tid);
            } else {
                FRESH();
                pg8::Gemm g{rV, WoutT, MT, 1024, 2048}; pg8::StaticOrder S; S.init(MT, 1024, G, bid);
                EpiOut<false> E{xin, xout, gate};
                pg8::gemm_phase<EpiOut<false>, pg8::StaticOrder, true, true>(lds, g, S, E, tid);
            }
            GSYNC();
        } else if (kind == 1) {
            {
                FRESH();
                pg8::Gemm g{XN, WinT, MT, 4096, 1024}; pg8::StaticOrder S; S.init(MT, 4096, G, bid);
                EpiFoxIn E{ACT, P.fox_q_gain, P.fox_k_gain, (LAS float*)(lds + 131072)};
                pg8::gemm_phase<EpiFoxIn, pg8::StaticOrder, true, true>(lds, g, S, E, tid);
            }
            GSYNC();
            if (PROBE == 41) { FRESH();
                pg8::Gemm g{XN, WinT, MT, 4096, 1024}; pg8::StaticOrder S; S.init(MT, 4096, G, bid);
                EpiFoxIn E{ACT, P.fox_q_gain, P.fox_k_gain, (LAS float*)(lds + 131072)};
                pg8::gemm_phase<EpiFoxIn, pg8::StaticOrder, true, true>(lds, g, S, E, tid); GSYNC(); }
            if (PROBE == 1) { FRESH(); fox_attn2(P, (char*)lds_raw, tid, bid, G, XN); GSYNC(); }
            { FRESH(); fox_attn2(P, (char*)lds_raw, tid, bid, G, nullptr); }
            GSYNC();
            {
                FRESH();
                pg8::Gemm g{ACT, WoutT, MT, 1024, 1024}; pg8::StaticOrder S; S.init(MT, 1024, G, bid);
                EpiOut<false> E{xin, xout, gate};
                pg8::gemm_phase<EpiOut<false>, pg8::StaticOrder, true, true>(lds, g, S, E, tid);
            }
            GSYNC();
        } else {
            bf16_t* gQE = ACT; bf16_t* gQN = (bf16_t*)(ws + WS_ACT + 16 * MiB); bf16_t* gKE = (bf16_t*)(ws + WS_ACT + 32 * MiB); bf16_t* gKN = (bf16_t*)(ws + WS_ACT + 48 * MiB);
            bf16_t* gV = (bf16_t*)(ws + WS_ACT + 64 * MiB); bf16_t* gP = (bf16_t*)(ws + WS_ACT + 96 * MiB); bf16_t* gO = (bf16_t*)(ws + WS_ACT + 128 * MiB);
            const float* gCB = (const float*)(ws + WS_ACT + 160 * MiB);
            float* STATS = (float*)(ws + WS_S16);
            {
                FRESH();
                pg8::Gemm g{XN, WinT, MT, 2048, 1024}; pg8::StaticOrder S; S.init(MT, 2048, G, bid);
                EpiGlaIn E{gQE, gQN, gKE, gKN, gV, nullptr, gCB};
                pg8::gemm_phase<EpiGlaIn, pg8::StaticOrder, true, true>(lds, g, S, E, tid);
            }
            GSYNC();
            { FRESH(); lin_pphase<1>(gQE, gKN, gQN, gKE, gP, tid, bid, G); }
            GSYNC();
            if (PROBE == 3) { FRESH(); lin_scan<1>(gQE, gKN, gV, gP, gCB, gO, (float*)(ws + WS_CUM), lds, tid, bid, G); GSYNC(); }
            if (G == 256 && ((int)blockIdx.x >> 3) >= 16) {
                FRESH(); const int sub = (bid & 7) * 16 + ((bid >> 3) - 16);
                conv_weights(P.ret_w_in + (size_t)1 * 1024 * RET_IN, RET_IN, 6144, P.ret_w_out + (size_t)1 * 2048 * 1024, 2048, ws + WS_W, lds, tid, sub, 128);
            } else { FRESH(); lin_scan<1>(gQE, gKN, gV, gP, gCB, gO, (float*)(ws + WS_CUM), lds, tid, bid, G); }
            GSYNC();
            {
                FRESH();
                pg8::Gemm g{XN, WinT + (size_t)2048 * 1024, MT, 1024, 1024}; pg8::StaticOrder S; S.init(MT, 1024, G, bid);
                EpiGateNorm<1> E{gO, gV, (LAS float*)(lds + 131072)};
                pg8::gemm_phase<EpiGateNorm<1>, pg8::StaticOrder, true, true>(lds, g, S, E, tid);
            }
            GSYNC();
            {
                FRESH();
                pg8::Gemm g{gV, WoutT, MT, 1024, 1024}; pg8::StaticOrder S; S.init(MT, 1024, G, bid);
                EpiOut<false> E{xin, xout, gate};
                pg8::gemm_phase<EpiOut<false>, pg8::StaticOrder, true, true>(lds, g, S, E, tid);
            }
            GSYNC();
        }
    }
    if (PROBE == 70) { for (int i = 0; i < 10; ++i) GSYNC(); }
    { FRESH(); final_norm(P, (const bf16_t*)(ws + WS_ACT), tid, bid, G); }
}

extern "C" void kernel_launch(void* const* d_in, const int* in_sizes, int n_in, void* d_out, int out_size, void* d_ws, size_t ws_size, hipStream_t stream) {
    static int grid = 0;
    if (grid == 0) {
        if (n_in != 18 || out_size != MT * DM || ws_size < WS_END) { fprintf(stderr, "kernel_launch: unexpected shapes (n_in %d out %d ws %zu)\n", n_in, out_size, ws_size); grid = -1; return; }
        int dev = 0, cus = 0, per_cu = 0;
        hipGetDevice(&dev);
        hipDeviceGetAttribute(&cus, hipDeviceAttributeMultiprocessorCount, dev);
        hipFuncSetAttribute((const void*)trunk_fwd, hipFuncAttributeMaxDynamicSharedMemorySize, LDS_BYTES);
        hipOccupancyMaxActiveBlocksPerMultiprocessor(&per_cu, (const void*)trunk_fwd, 512, LDS_BYTES);
        if (per_cu < 1) { fprintf(stderr, "kernel_launch: occupancy query says %d blocks per CU\n", per_cu); per_cu = 1; }
        (void)hipGetLastError();
        grid = cus;
    }
    if (grid < 0) return;
    Params p{};
    p.x = (const float*)d_in[0]; p.c = (const float*)d_in[1]; p.pos = (const int*)d_in[2]; p.mod_w = (const float*)d_in[3]; p.mod_b = (const float*)d_in[4]; p.norm_g = (const float*)d_in[5];
    p.ret_w_in = (const float*)d_in[6]; p.ret_w_out = (const float*)d_in[7]; p.fox_w_in = (const float*)d_in[8]; p.fox_b_f = (const float*)d_in[9]; p.fox_q_gain = (const float*)d_in[10]; p.fox_k_gain = (const float*)d_in[11];
    p.fox_w_out = (const float*)d_in[12]; p.gla_w_in = (const float*)d_in[13]; p.gla_w_gate2 = (const float*)d_in[14]; p.gla_b_gate = (const float*)d_in[15]; p.gla_w_out = (const float*)d_in[16]; p.final_g = (const float*)d_in[17];
    p.out = (float*)d_out; p.ws = (unsigned char*)d_ws;
    if (hipMemsetAsync(d_ws, 0, 16384, stream) != hipSuccess) { fprintf(stderr, "kernel_launch: memset failed\n"); return; }
    void* args[] = {&p};
    hipError_t e = hipLaunchCooperativeKernel((const void*)trunk_fwd, dim3(grid), dim3(512), args, LDS_BYTES, stream);
    if (e != hipSuccess) fprintf(stderr, "cooperative launch failed: %s (grid %d)\n", hipGetErrorString(e), grid);
}
```

```cpp
#include <hip/hip_runtime.h>
#include <hip/hip_cooperative_groups.h>
#include <cstdio>
#include <cstdint>
#include <cmath>
namespace cg = cooperative_groups;

#define LAS __attribute__((address_space(3)))
typedef unsigned short bf16_t;
typedef short bf16x8 __attribute__((ext_vector_type(8)));
typedef float f32x4 __attribute__((ext_vector_type(4)));
typedef float f32x2 __attribute__((ext_vector_type(2)));
typedef unsigned u32x4 __attribute__((ext_vector_type(4)));
typedef unsigned u32x2 __attribute__((ext_vector_type(2)));

constexpr int DM = 1024, NB = 4, SEQ = 4096, MT = NB * SEQ;
constexpr float EPS = 1e-6f;
constexpr int RET_IN = 6144, FOX_IN = 4112, GLA_IN = 3088;
constexpr float LOG2E = 1.4426950408889634f;

constexpr size_t MiB = 1u << 20;
constexpr size_t WS_MOD = 1 * MiB;
constexpr size_t WS_S16 = 2 * MiB;
constexpr size_t WS_CUM = 3 * MiB;
constexpr size_t WS_ROPE = 4 * MiB;
constexpr size_t WS_W = 12 * MiB;
constexpr size_t WS_WOUT = WS_W + 12 * MiB;
constexpr size_t WS_WGLA = 164 * MiB;
constexpr size_t WS_XN = 28 * MiB;
constexpr size_t WS_ACT = 60 * MiB;
constexpr size_t WS_END = 252 * MiB;

__device__ __forceinline__ unsigned f2bf(float f) { unsigned u = __builtin_bit_cast(unsigned, f); return (u + 0x7fffu + ((u >> 16) & 1u)) >> 16; }
typedef float f32x2_hw __attribute__((ext_vector_type(2))); typedef __bf16 bf16x2_hw __attribute__((ext_vector_type(2)));
__device__ __forceinline__ unsigned pk2(float lo, float hi) { f32x2_hw v = {lo, hi}; bf16x2_hw b = __builtin_convertvector(v, bf16x2_hw); return __builtin_bit_cast(unsigned, b); }
__device__ __forceinline__ float bf2f(unsigned h) { return __builtin_bit_cast(float, h << 16); }
__device__ __forceinline__ u32x2 pk4(f32x4 v) { u32x2 r; r.x = pk2(v[0], v[1]); r.y = pk2(v[2], v[3]); return r; }
__device__ __forceinline__ f32x4 unpk4(u32x2 w) { f32x4 r; r[0] = bf2f(w.x & 0xffffu); r[1] = bf2f(w.x >> 16); r[2] = bf2f(w.y & 0xffffu); r[3] = bf2f(w.y >> 16); return r; }
__device__ __forceinline__ float silu_f(float v) { return v * __builtin_amdgcn_rcpf(1.0f + __expf(-v)); }
__device__ __forceinline__ float logsig_f(float v) { return fminf(v, 0.0f) - __logf(1.0f + __expf(-fabsf(v))); }
template <int CTRL> __device__ __forceinline__ float dpp_mov(float v) { return __builtin_bit_cast(float, __builtin_amdgcn_update_dpp(0, __builtin_bit_cast(int, v), CTRL, 0xf, 0xf, true)); }
__device__ __forceinline__ float swap32_sum(float x, float y) { auto r = __builtin_amdgcn_permlane32_swap(__builtin_bit_cast(unsigned, x), __builtin_bit_cast(unsigned, y), false, false); const unsigned r0 = r[0], r1 = r[1]; return __builtin_bit_cast(float, r0) + __builtin_bit_cast(float, r1); }
__device__ __forceinline__ float swap16_sum(float x, float y) { auto r = __builtin_amdgcn_permlane16_swap(__builtin_bit_cast(unsigned, x), __builtin_bit_cast(unsigned, y), false, false); const unsigned r0 = r[0], r1 = r[1]; return __builtin_bit_cast(float, r0) + __builtin_bit_cast(float, r1); }
__device__ __forceinline__ float row_sum16(float v) {
    v += dpp_mov<0xB1>(v);
    v += dpp_mov<0x4E>(v);
    v += dpp_mov<0x141>(v);
    v += dpp_mov<0x140>(v);
    return v;
}
__device__ __forceinline__ float xsum_16_32(float v) { v = swap16_sum(v, v); return swap32_sum(v, v); }
__device__ __forceinline__ float lane_perm(float v, int src) { return __builtin_bit_cast(float, __builtin_amdgcn_ds_bpermute(src << 2, __builtin_bit_cast(int, v))); }
__device__ __forceinline__ float wave_sum(float v) { return xsum_16_32(row_sum16(v)); }
__device__ __forceinline__ float reduce_scatter16(const float (&a)[16], int lane) {
    float b8[8], c4[4], d2[2], e1;
#pragma unroll
    for (int i = 0; i < 8; ++i) b8[i] = swap32_sum(a[i], a[i + 8]);
#pragma unroll
    for (int i = 0; i < 4; ++i) c4[i] = swap16_sum(b8[i], b8[i + 4]);
    { const bool hi = (lane & 8) != 0;
#pragma unroll
      for (int i = 0; i < 2; ++i) { const float snd = hi ? c4[i] : c4[i + 2], kp = hi ? c4[i + 2] : c4[i]; d2[i] = kp + dpp_mov<0x128>(snd); } }
    { const bool hi = (lane & 4) != 0; const float snd = hi ? d2[0] : d2[1], kp = hi ? d2[1] : d2[0]; e1 = kp + dpp_mov<0x1B>(dpp_mov<0x141>(snd)); }
    e1 += dpp_mov<0x4E>(e1); e1 += dpp_mov<0xB1>(e1);
    return e1;
}
#define LDS_WAIT() asm volatile("s_waitcnt lgkmcnt(0)" ::: "memory")

__device__ __forceinline__ f32x4 mma_rc(f32x4 acc, bf16x8 a_rows, bf16x8 b_cols) { return __builtin_amdgcn_mfma_f32_16x16x32_bf16(b_cols, a_rows, acc, 0, 0, 0); }
__device__ __forceinline__ f32x4 mma_cr(f32x4 acc, bf16x8 a_rows, bf16x8 b_cols) { return __builtin_amdgcn_mfma_f32_16x16x32_bf16(a_rows, b_cols, acc, 0, 0, 0); }
__device__ __forceinline__ bf16x8 gfrag(const bf16_t* base, int pitch, int lane) { return *(const bf16x8*)(base + (size_t)(lane & 15) * pitch + 8 * (lane >> 4)); }
__device__ __forceinline__ bf16x8 lfrag(const LAS bf16_t* base, int pitch, int lane) { return *(const LAS bf16x8*)(base + (lane & 15) * pitch + 8 * (lane >> 4)); }

namespace pg8 {
#define PG8_LAS __attribute__((address_space(3)))
constexpr int BM = 256, BK = 64, HALF = 128, HTB = HALF * BK * 2, STAGE_BYTES = 8 * HTB, NXCD = 8, WGM = 8;
__host__ __device__ __forceinline__ int lds_byte(int r, int c) { const int st = (r >> 4) * 2 + (c >> 5), rr = r & 15, cc = c & 31, ob = rr * 64 + cc * 2; return st * 1024 + (ob ^ (((ob >> 9) & 1) << 5)); }
__host__ __device__ __forceinline__ void stage_rc(int b, int& R, int& C) { const int st = b / 1024, sb = b % 1024, swz = sb ^ (((sb >> 9) & 1) << 5); R = (st >> 1) * 16 + swz / 64; C = (st & 1) * 32 + (swz % 64) / 2; }
__host__ __device__ __forceinline__ int perm32(int rho) { const int n = rho >> 4, i = rho & 15; return 8 * (i >> 2) + 4 * n + (i & 3); }

struct Unit { int pm, pn; };
struct Gemm { const bf16_t* A; const bf16_t* Bt; int M, N, K; };
struct StaticOrder {
    int nM, nN, nwg, G, c;
    __host__ __device__ void init(int M, int N, int G_, int c_) { nM = M / BM; nN = N / BM; nwg = nM * nN; G = G_; c = c_; }
    __host__ __device__ bool next(int i, Unit& u) const {
        const long L = (long)i * G + c; if (L >= nwg) return false;
        int wgid = (int)L; { const int q = nwg / NXCD, r = nwg % NXCD, xcd = wgid % NXCD, off = wgid / NXCD; wgid = (xcd < r ? xcd * (q + 1) : r * (q + 1) + (xcd - r) * q) + off; }
        const int nig = WGM * nN, gid = wgid / nig, fm = gid * WGM, gsz = (nM - fm) < WGM ? (nM - fm) : WGM;
        u.pm = fm + ((wgid % nig) % gsz); u.pn = (wgid % nig) / gsz; return true;
    }
    __device__ __forceinline__ void a_ready(const Unit&) const {}
    __device__ __forceinline__ void done(const Unit&) const {}
};

struct PairOrder {
    int G, c;
    __device__ __forceinline__ bool next(int i, Unit& u) const { const int pair = (i >> 1) * G + c; if (pair >= 256) return false; u.pm = pair >> 2; u.pn = 2 * (pair & 3) + (i & 1); return true; }
    __device__ __forceinline__ void a_ready(const Unit&) const {}
    __device__ __forceinline__ void done(const Unit&) const {}
};
template <class Epi, class Sched, bool ALIGN_EPI = false, bool SP2 = false>
__device__ __forceinline__ void gemm_phase(PG8_LAS unsigned char* lds, const Gemm g, const Sched& S, const Epi& E, int tid) {
    const int wid = __builtin_amdgcn_readfirstlane(tid >> 6), lane = tid & 63, wr = wid >> 2, wc = wid & 3, fr = lane & 15, fq = lane >> 4;
    const int K = g.K, nt = K / BK;
    unsigned voffA[2], voffB[2];
#pragma unroll
    for (int i = 0; i < 2; ++i) { int R, C; stage_rc(tid * 16 + i * 8192, R, C); const int Rb = Epi::PERM ? ((R & ~31) + perm32(R & 31)) : R;
        voffA[i] = (unsigned)(R * K + C) * 2u; voffB[i] = (unsigned)(Rb * K + C) * 2u; }
    const size_t kstep = (size_t)(BK * 2);
    const size_t hstep = (size_t)HALF * K * 2;
    const size_t tstep = 2 * hstep;
    const unsigned ldsw = (unsigned)wid * 1024u;
    const int aoff = lds_byte(wr * 64 + fr, fq * 8), boff = lds_byte(wc * 32 + fr, fq * 8);
#define PG8_SA(b, h) (((b) * 2 + (h)) * HTB)
#define PG8_SB(b, h) ((4 + (b) * 2 + (h)) * HTB)
#define PG8_STAGE(bufoff, gbase, voff) do { _Pragma("unroll") for (int _i = 0; _i < 2; ++_i) \
        __builtin_amdgcn_global_load_lds((const unsigned*)((const char*)(gbase) + (voff)[_i]), (PG8_LAS unsigned*)(lds + (bufoff) + ldsw + _i * 8192), 16, 0, 0); } while (0)
#define PG8_LDA(dst, b, h) do { _Pragma("unroll") for (int m = 0; m < 4; ++m) _Pragma("unroll") for (int k = 0; k < 2; ++k) dst[m][k] = *(const PG8_LAS bf16x8*)(lds + PG8_SA(b, h) + aoff + m * 2048 + k * 1024); } while (0)
#define PG8_LDB(dst, b, h) do { _Pragma("unroll") for (int n = 0; n < 2; ++n) _Pragma("unroll") for (int k = 0; k < 2; ++k) dst[n][k] = *(const PG8_LAS bf16x8*)(lds + PG8_SB(b, h) + boff + n * 2048 + k * 1024); } while (0)
#define PG8_MMA(ai, bj, At, Bt) do { __builtin_amdgcn_s_setprio(1); _Pragma("unroll") for (int m = 0; m < 4; ++m) _Pragma("unroll") for (int n = 0; n < 2; ++n) _Pragma("unroll") for (int k = 0; k < 2; ++k) \
        acc[ai][bj][m][n] = __builtin_amdgcn_mfma_f32_16x16x32_bf16(Bt[n][k], At[m][k], acc[ai][bj][m][n], 0, 0, 0); __builtin_amdgcn_s_setprio(0); } while (0)
#define PG8_WAIT_V(n) asm volatile("s_waitcnt vmcnt(" #n ")" ::: "memory")
#define PG8_WAIT_L(n) asm volatile("s_waitcnt lgkmcnt(" #n ")" ::: "memory")
#define PG8_BAR __builtin_amdgcn_s_barrier()
#define PG8_SCHED __builtin_amdgcn_sched_barrier(0)
    Unit cur, nxt; int ui = 0;
    if (!S.next(0, cur)) return;
    f32x4 acc[2][2][4][2];
#pragma unroll
    for (int a = 0; a < 2; ++a)
#pragma unroll
        for (int b = 0; b < 2; ++b)
#pragma unroll
            for (int m = 0; m < 4; ++m)
#pragma unroll
                for (int n = 0; n < 2; ++n) acc[a][b][m][n] = (f32x4){0.f, 0.f, 0.f, 0.f};
    bf16x8 At[4][2], B0[2][2], B1[2][2];
    const char* cA = (const char*)g.A + (size_t)cur.pm * tstep; const char* cB = (const char*)g.Bt + (size_t)cur.pn * tstep;
    S.a_ready(cur);
    if constexpr (SP2) {
        PG8_STAGE(PG8_SB(0, 0), cB, voffB); PG8_STAGE(PG8_SB(0, 1), cB + hstep, voffB); PG8_STAGE(PG8_SA(0, 0), cA, voffA); PG8_STAGE(PG8_SA(0, 1), cA + hstep, voffA);
        if (wr == 1) PG8_BAR;
        PG8_WAIT_V(2); PG8_BAR;
        PG8_STAGE(PG8_SB(1, 0), cB + kstep, voffB); PG8_STAGE(PG8_SA(1, 0), cA + kstep, voffA); PG8_STAGE(PG8_SB(1, 1), cB + hstep + kstep, voffB);
        PG8_WAIT_V(6); PG8_BAR;
    } else {
        PG8_STAGE(PG8_SB(0, 0), cB, voffB); PG8_STAGE(PG8_SA(0, 0), cA, voffA); PG8_STAGE(PG8_SB(0, 1), cB + hstep, voffB); PG8_STAGE(PG8_SA(0, 1), cA + hstep, voffA);
        if (wr == 1) PG8_BAR;
        PG8_WAIT_V(4); PG8_BAR;
        PG8_STAGE(PG8_SB(1, 0), cB + kstep, voffB); PG8_STAGE(PG8_SA(1, 0), cA + kstep, voffA); PG8_STAGE(PG8_SB(1, 1), cB + hstep + kstep, voffB);
        PG8_WAIT_V(6); PG8_BAR;
    }
    for (;;) {
        const bool has_next = S.next(ui + 1, nxt);
        const char* nA = has_next ? (const char*)g.A + (size_t)nxt.pm * tstep : cA; const char* nB = has_next ? (const char*)g.Bt + (size_t)nxt.pn * tstep : cB;
        for (int t = 0; t < nt; t += 2) {
            const bool last = (t == nt - 2);
            const char* a1 = cA + (size_t)(t + 1) * kstep;
            const char* a2 = last ? nA : cA + (size_t)(t + 2) * kstep; const char* b2 = last ? nB : cB + (size_t)(t + 2) * kstep;
            const char* a3 = a2 + kstep; const char* b3 = b2 + kstep;
            if (last && has_next) S.a_ready(nxt);
            if constexpr (SP2) {
            PG8_LDB(B0, 0, 0); PG8_LDB(B1, 0, 1); PG8_SCHED; PG8_LDA(At, 0, 0); PG8_STAGE(PG8_SA(1, 1), a1 + hstep, voffA);
            PG8_WAIT_V(8); PG8_WAIT_L(0); PG8_BAR; PG8_MMA(0, 0, At, B0); PG8_MMA(0, 1, At, B1); PG8_BAR; PG8_SCHED;
            PG8_LDA(At, 0, 1); PG8_STAGE(PG8_SB(0, 0), b2, voffB); PG8_STAGE(PG8_SB(0, 1), b2 + hstep, voffB); PG8_STAGE(PG8_SA(0, 0), a2, voffA);
            PG8_WAIT_V(8); PG8_WAIT_L(0); PG8_BAR; PG8_MMA(1, 0, At, B0); PG8_MMA(1, 1, At, B1); PG8_BAR; PG8_SCHED;
            PG8_LDB(B0, 1, 0); PG8_LDB(B1, 1, 1); PG8_SCHED; PG8_LDA(At, 1, 0); PG8_STAGE(PG8_SA(0, 1), a2 + hstep, voffA);
            PG8_WAIT_V(8); PG8_WAIT_L(0); PG8_BAR; PG8_MMA(0, 0, At, B0); PG8_MMA(0, 1, At, B1); PG8_BAR; PG8_SCHED;
            PG8_LDA(At, 1, 1); PG8_STAGE(PG8_SB(1, 0), b3, voffB); PG8_STAGE(PG8_SB(1, 1), b3 + hstep, voffB); PG8_STAGE(PG8_SA(1, 0), a3, voffA);
            PG8_WAIT_V(8); PG8_WAIT_L(0); PG8_BAR; PG8_MMA(1, 0, At, B0); PG8_MMA(1, 1, At, B1); PG8_BAR; PG8_SCHED;
            } else {
            PG8_LDB(B0, 0, 0); PG8_SCHED; PG8_LDA(At, 0, 0); PG8_STAGE(PG8_SA(1, 1), a1 + hstep, voffA);
            PG8_WAIT_L(8); PG8_BAR; PG8_WAIT_L(0); PG8_MMA(0, 0, At, B0); PG8_BAR; PG8_SCHED;
            PG8_LDB(B1, 0, 1); PG8_STAGE(PG8_SB(0, 0), b2, voffB);
            PG8_BAR; PG8_WAIT_L(0); PG8_MMA(0, 1, At, B1); PG8_BAR;
            PG8_LDA(At, 0, 1); PG8_STAGE(PG8_SA(0, 0), a2, voffA);
            PG8_BAR; PG8_WAIT_L(0); PG8_MMA(1, 0, At, B0); PG8_BAR; PG8_SCHED;
            PG8_STAGE(PG8_SB(0, 1), b2 + hstep, voffB);
            PG8_WAIT_V(6); PG8_BAR; PG8_MMA(1, 1, At, B1); PG8_BAR;
            PG8_LDB(B0, 1, 0); PG8_SCHED; PG8_LDA(At, 1, 0); PG8_STAGE(PG8_SA(0, 1), a2 + hstep, voffA);
            PG8_WAIT_L(8); PG8_BAR; PG8_WAIT_L(0); PG8_MMA(0, 0, At, B0); PG8_BAR; PG8_SCHED;
            PG8_LDB(B1, 1, 1); PG8_STAGE(PG8_SB(1, 0), b3, voffB);
            PG8_BAR; PG8_WAIT_L(0); PG8_MMA(0, 1, At, B1); PG8_BAR;
            PG8_LDA(At, 1, 1); PG8_STAGE(PG8_SA(1, 0), a3, voffA);
            PG8_BAR; PG8_WAIT_L(0); PG8_MMA(1, 0, At, B0); PG8_BAR; PG8_SCHED;
            PG8_STAGE(PG8_SB(1, 1), b3 + hstep, voffB);
            PG8_WAIT_V(6); PG8_BAR; PG8_MMA(1, 1, At, B1); PG8_BAR;
            }
        }
        if constexpr (ALIGN_EPI) { if (wr == 0) PG8_BAR; }
        E(acc, cur, wr, wc, fr, fq); S.done(cur);
        if (!has_next) break;
#pragma unroll
        for (int a = 0; a < 2; ++a)
#pragma unroll
            for (int b = 0; b < 2; ++b)
#pragma unroll
                for (int m = 0; m < 4; ++m)
#pragma unroll
                    for (int n = 0; n < 2; ++n) acc[a][b][m][n] = (f32x4){0.f, 0.f, 0.f, 0.f};
        cur = nxt; cA = nA; cB = nB; ++ui;
        if constexpr (ALIGN_EPI) { if (wr == 1) PG8_BAR; }
    }
    PG8_WAIT_V(0);
    if constexpr (!ALIGN_EPI) { if (wr == 0) PG8_BAR; }
    PG8_BAR;
#undef PG8_SA
#undef PG8_SB
#undef PG8_STAGE
#undef PG8_LDA
#undef PG8_LDB
#undef PG8_MMA
#undef PG8_WAIT_V
#undef PG8_WAIT_L
#undef PG8_BAR
#undef PG8_SCHED
}
}

struct Params {
    const float* x; const float* c; const int* pos; const float* mod_w; const float* mod_b; const float* norm_g;
    const float* ret_w_in; const float* ret_w_out; const float* fox_w_in; const float* fox_b_f; const float* fox_q_gain; const float* fox_k_gain; const float* fox_w_out;
    const float* gla_w_in; const float* gla_w_gate2; const float* gla_b_gate; const float* gla_w_out; const float* final_g;
    float* out; unsigned char* ws;
};

template <int DK> __device__ __forceinline__ size_t frag_img_off(int row, int head, int ch0) {
    const int b = row >> 12, tok = row & 4095;
    return (size_t)((b * 4 + head) * 64 + (tok >> 6)) * (64 * DK * 2) + (size_t)((((ch0 >> 5) * 4 + ((tok >> 4) & 3)) * 64 + 16 * ((ch0 >> 3) & 3) + (tok & 15)) * 16 + 2 * (ch0 & 7));
}
template <int HV> __device__ __forceinline__ size_t v_img_off(int row, int col) {
    const int b = row >> 12, tok = row & 4095, head = col / HV, e = col % HV;
    return ((size_t)((b * 4 + head) * (HV / 32) + (e >> 5)) * 4096 + tok) * 64 + (size_t)((e & 31) * 2);
}
struct EpiRetIn {
    static constexpr bool PERM = true;
    bf16_t* Q; bf16_t* Kb; bf16_t* V; const unsigned* rope;
    __device__ __forceinline__ void operator()(const f32x4 (&acc)[2][2][4][2], const pg8::Unit& u, int wr, int wc, int fr, int fq) const {
        const int pn = u.pn;
        if (pn < 8) {
            bf16_t* dst = (pn < 4) ? Q : Kb; const int head = pn & 3; const float sc = (pn < 4) ? 0.0625f : 1.0f;
#pragma unroll
            for (int ai = 0; ai < 2; ++ai) {
                u32x4 cs[4][2];
#pragma unroll
                for (int m = 0; m < 4; ++m)
#pragma unroll
                    for (int n = 0; n < 2; ++n) cs[m][n] = *(const u32x4*)(rope + ((size_t)(((((u.pm * 256 + ai * 128 + wr * 64 + m * 16) >> 4) * 4 + wc) * 2 + n) * 64 + 16 * fq + fr) << 2));
                asm volatile("" ::: "memory");
#pragma unroll
                for (int m = 0; m < 4; ++m) {
                    const int row = u.pm * 256 + ai * 128 + wr * 64 + m * 16 + fr;
                    u32x4 w1, w2;
#pragma unroll
                    for (int n = 0; n < 2; ++n) {
                        const f32x4 x1 = acc[ai][0][m][n], x2 = acc[ai][1][m][n]; f32x4 o1, o2;
#pragma unroll
                        for (int j = 0; j < 4; ++j) {
                            const unsigned w = cs[m][n][j];
                            const float co = (float)__builtin_bit_cast(_Float16, (unsigned short)(w & 0xffffu)), si = (float)__builtin_bit_cast(_Float16, (unsigned short)(w >> 16));
                            o1[j] = (x1[j] * co - x2[j] * si) * sc; o2[j] = (x1[j] * si + x2[j] * co) * sc;
                        }
                        const u32x2 a1 = pk4(o1), a2 = pk4(o2);
                        if (n == 0) { w1.x = a1.x; w1.y = a1.y; w2.x = a2.x; w2.y = a2.y; } else { w1.z = a1.x; w1.w = a1.y; w2.z = a2.x; w2.w = a2.y; }
                    }
                    char* p = (char*)dst + frag_img_off<256>(row, head, wc * 32 + fq * 8);
                    *(u32x4*)p = w1; *(u32x4*)(p + 16384) = w2;
                }
            }
        } else {
            const int cbase = (pn - 8) * 256;
#pragma unroll
            for (int ai = 0; ai < 2; ++ai)
#pragma unroll
                for (int m = 0; m < 4; ++m) {
                    const int row = u.pm * 256 + ai * 128 + wr * 64 + m * 16 + fr;
#pragma unroll
                    for (int bj = 0; bj < 2; ++bj) { const u32x2 a0 = pk4(acc[ai][bj][m][0]), a1 = pk4(acc[ai][bj][m][1]);
                        *(u32x4*)((char*)V + v_img_off<512>(row, cbase + bj * 128 + wc * 32 + fq * 8)) = (u32x4){a0.x, a0.y, a1.x, a1.y}; }
                }
        }
    }
};
struct EpiSplit {
    static constexpr bool PERM = false;
    bf16_t* dst; int tpg; size_t gstride; int ldc; int silu_grp;
    __device__ __forceinline__ void operator()(const f32x4 (&acc)[2][2][4][2], const pg8::Unit& u, int wr, int wc, int fr, int fq) const {
        const int t = u.pn / tpg; bf16_t* base = dst + (size_t)t * gstride; const int cb = (u.pn - t * tpg) * 256; const bool act = (t == silu_grp);
#pragma unroll
        for (int ai = 0; ai < 2; ++ai)
#pragma unroll
            for (int m = 0; m < 4; ++m) {
                const int row = u.pm * 256 + ai * 128 + wr * 64 + m * 16 + fr;
#pragma unroll
                for (int bj = 0; bj < 2; ++bj)
#pragma unroll
                    for (int n = 0; n < 2; ++n) {
                        f32x4 a = acc[ai][bj][m][n];
                        if (act) {
#pragma unroll
                            for (int j = 0; j < 4; ++j) a[j] = silu_f(a[j]);
                        }
                        *(u32x2*)(base + (size_t)row * ldc + cb + bj * 128 + wc * 32 + n * 16 + fq * 4) = pk4(a);
                    }
            }
    }
};
struct EpiFoxIn {
    static constexpr bool PERM = true;
    bf16_t* dst; const float* qgain; const float* kgain; LAS float* tbl;
    __device__ __forceinline__ void operator()(const f32x4 (&acc)[2][2][4][2], const pg8::Unit& u, int wr, int wc, int fr, int fq) const {
        const int t = u.pn >> 2; bf16_t* base = dst + (size_t)t * ((size_t)16 * MiB); const int cb = (u.pn & 3) * 256;
        if (t < 2) {
#pragma unroll
            for (int ai = 0; ai < 2; ++ai)
#pragma unroll
                for (int m = 0; m < 4; ++m)
#pragma unroll
                    for (int bj = 0; bj < 2; ++bj) {
                        float sq = 0.f;
#pragma unroll
                        for (int n = 0; n < 2; ++n) { const f32x4 a = acc[ai][bj][m][n]; sq += (a[0] * a[0] + a[1] * a[1]) + (a[2] * a[2] + a[3] * a[3]); }
                        sq = xsum_16_32(sq);
                        if (fq == 0) tbl[(((ai * 128 + wr * 64 + m * 16 + fr) * 4) + bj * 2 + (wc >> 1)) * 2 + (wc & 1)] = sq;
                    }
            asm volatile("s_waitcnt lgkmcnt(0)" ::: "memory"); __builtin_amdgcn_s_barrier(); asm volatile("" ::: "memory");
            const float* gn = (t == 0) ? qgain : kgain; const float sc = (t == 0) ? (0.125f * LOG2E) : 1.0f;
            f32x4 gv[2];
#pragma unroll
            for (int n = 0; n < 2; ++n) gv[n] = *(const f32x4*)(gn + (wc & 1) * 32 + fq * 8 + n * 4) * sc;
#pragma unroll
            for (int ai = 0; ai < 2; ++ai)
#pragma unroll
                for (int m = 0; m < 4; ++m) {
                    const int rl = ai * 128 + wr * 64 + m * 16 + fr; const int row = u.pm * 256 + rl;
#pragma unroll
                    for (int bj = 0; bj < 2; ++bj) {
                        const f32x2 pr = *(const LAS f32x2*)(tbl + ((rl * 4) + bj * 2 + (wc >> 1)) * 2);
                        const float rstd = __builtin_amdgcn_rsqf((pr.x + pr.y) * (1.0f / 64.0f) + EPS);
                        const u32x2 q0 = pk4(acc[ai][bj][m][0] * rstd * gv[0]), q1 = pk4(acc[ai][bj][m][1] * rstd * gv[1]);
                        *(u32x4*)(base + (size_t)row * 1024 + cb + bj * 128 + wc * 32 + fq * 8) = (u32x4){q0.x, q0.y, q1.x, q1.y};
                    }
                }
        } else {
            const bool act = (t == 3);
#pragma unroll
            for (int ai = 0; ai < 2; ++ai)
#pragma unroll
                for (int m = 0; m < 4; ++m) {
                    const int row = u.pm * 256 + ai * 128 + wr * 64 + m * 16 + fr;
#pragma unroll
                    for (int bj = 0; bj < 2; ++bj) {
                        f32x4 a0 = acc[ai][bj][m][0], a1 = acc[ai][bj][m][1];
                        if (act) {
#pragma unroll
                            for (int j = 0; j < 4; ++j) { a0[j] = silu_f(a0[j]); a1[j] = silu_f(a1[j]); }
                        }
                        const u32x2 q0 = pk4(a0), q1 = pk4(a1);
                        *(u32x4*)(base + (size_t)row * 1024 + cb + bj * 128 + wc * 32 + fq * 8) = (u32x4){q0.x, q0.y, q1.x, q1.y};
                    }
                }
        }
    }
};
struct EpiGlaIn {
    static constexpr bool PERM = true;
    bf16_t *QE, *QN, *KE, *KN, *V, *G; const float* CB;
    __device__ __forceinline__ void operator()(const f32x4 (&acc)[2][2][4][2], const pg8::Unit& u, int wr, int wc, int fr, int fq) const {
        const int pn = u.pn;
        if (pn < 4) {
            const float s = (pn < 2) ? 0.08838834764831845f : 1.0f;
            bf16_t* De = (pn < 2 ? QE : KE); bf16_t* Dn = (pn < 2 ? QN : KN);
#pragma unroll
            for (int ai = 0; ai < 2; ++ai)
#pragma unroll
            for (int mh = 0; mh < 2; ++mh) {
                f32x4 cb[2][2][2];
#pragma unroll
                for (int mm = 0; mm < 2; ++mm)
#pragma unroll
                    for (int bj = 0; bj < 2; ++bj)
#pragma unroll
                        for (int n = 0; n < 2; ++n) cb[mm][bj][n] = *(const f32x4*)(CB + (size_t)(u.pm * 256 + ai * 128 + wr * 64 + (2 * mh + mm) * 16 + fr) * 512 + (pn & 1) * 256 + bj * 128 + wc * 32 + fq * 8 + n * 4);
                asm volatile("" ::: "memory");
#pragma unroll
                for (int mm = 0; mm < 2; ++mm) {
                    const int m = 2 * mh + mm; const int row = u.pm * 256 + ai * 128 + wr * 64 + m * 16 + fr;
#pragma unroll
                    for (int bj = 0; bj < 2; ++bj) {
                        u32x4 we, wn;
#pragma unroll
                        for (int n = 0; n < 2; ++n) {
                            const f32x4 a = acc[ai][bj][m][n]; f32x4 e, en;
#pragma unroll
                            for (int j = 0; j < 4; ++j) { const float ee = __expf(cb[mm][bj][n][j]); e[j] = a[j] * s * ee; en[j] = a[j] * s * __builtin_amdgcn_rcpf(ee); }
                            const u32x2 a1 = pk4(e), a2 = pk4(en);
                            if (n == 0) { we.x = a1.x; we.y = a1.y; wn.x = a2.x; wn.y = a2.y; } else { we.z = a1.x; we.w = a1.y; wn.z = a2.x; wn.w = a2.y; }
                        }
                        const size_t io = frag_img_off<128>(row, (pn & 1) * 2 + bj, wc * 32 + fq * 8);
                        *(u32x4*)((char*)De + io) = we; *(u32x4*)((char*)Dn + io) = wn;
                    }
                }
                asm volatile("" ::: "memory");
            }
        } else {
#pragma unroll
            for (int ai = 0; ai < 2; ++ai)
#pragma unroll
                for (int m = 0; m < 4; ++m) {
                    const int row = u.pm * 256 + ai * 128 + wr * 64 + m * 16 + fr;
#pragma unroll
                    for (int bj = 0; bj < 2; ++bj) { const u32x2 a0 = pk4(acc[ai][bj][m][0]), a1 = pk4(acc[ai][bj][m][1]);
                        *(u32x4*)((char*)V + v_img_off<256>(row, (pn - 4) * 256 + bj * 128 + wc * 32 + fq * 8)) = (u32x4){a0.x, a0.y, a1.x, a1.y}; }
                }
        }
    }
};
struct EpiNone {
    static constexpr bool PERM = false; float* sink;
    __device__ __forceinline__ void operator()(const f32x4 (&acc)[2][2][4][2], const pg8::Unit& u, int wr, int wc, int fr, int fq) const {
        f32x4 t = acc[0][0][0][0];
#pragma unroll
        for (int ai = 0; ai < 2; ++ai)
#pragma unroll
            for (int bj = 0; bj < 2; ++bj)
#pragma unroll
                for (int m = 0; m < 4; ++m)
#pragma unroll
                    for (int n = 0; n < 2; ++n) t += acc[ai][bj][m][n];
        if (t[0] + t[1] + t[2] + t[3] == 12345.678f) sink[0] = t[0];
    }
};
template <bool XF32> struct EpiOut {
    static constexpr bool PERM = true;
    const void* xold; bf16_t* xnew; const float* gate;
    __device__ __forceinline__ void operator()(const f32x4 (&acc)[2][2][4][2], const pg8::Unit& u, int wr, int wc, int fr, int fq) const {
        const int b = (u.pm * 256) >> 12;
        const int c0 = u.pn * 256 + wc * 32 + fq * 8;
        f32x4 gv[2][2];
#pragma unroll
        for (int bj = 0; bj < 2; ++bj)
#pragma unroll
            for (int n = 0; n < 2; ++n) gv[bj][n] = *(const f32x4*)(gate + (size_t)b * 3072 + c0 + bj * 128 + n * 4);
#pragma unroll
        for (int ai = 0; ai < 2; ++ai)
#pragma unroll
            for (int mh = 0; mh < 2; ++mh) {
                f32x4 xo[2][2][2];
#pragma unroll
                for (int mm = 0; mm < 2; ++mm)
#pragma unroll
                    for (int bj = 0; bj < 2; ++bj) { const size_t o = (size_t)(u.pm * 256 + ai * 128 + wr * 64 + (2 * mh + mm) * 16 + fr) * 1024 + c0 + bj * 128;
                        if (XF32) { xo[mm][bj][0] = *(const f32x4*)((const float*)xold + o); xo[mm][bj][1] = *(const f32x4*)((const float*)xold + o + 4); }
                        else { const u32x4 w = *(const u32x4*)((const bf16_t*)xold + o); xo[mm][bj][0] = unpk4((u32x2){w.x, w.y}); xo[mm][bj][1] = unpk4((u32x2){w.z, w.w}); } }
                asm volatile("" ::: "memory");
#pragma unroll
                for (int mm = 0; mm < 2; ++mm)
#pragma unroll
                    for (int bj = 0; bj < 2; ++bj) {
                        const u32x2 q0 = pk4(xo[mm][bj][0] + gv[bj][0] * acc[ai][bj][2 * mh + mm][0]), q1 = pk4(xo[mm][bj][1] + gv[bj][1] * acc[ai][bj][2 * mh + mm][1]);
                        *(u32x4*)(xnew + (size_t)(u.pm * 256 + ai * 128 + wr * 64 + (2 * mh + mm) * 16 + fr) * 1024 + c0 + bj * 128) = (u32x4){q0.x, q0.y, q1.x, q1.y};
                    }
                asm volatile("" ::: "memory");
            }
    }
};

__device__ __forceinline__ void transpose_item(const float* W, int ldw, int K, int nblk, bf16_t* WT, LAS float* scr, int item, int lane) {
    const int kb = item / nblk, nb = item % nblk, k0 = 64 * kb, n0 = 32 * nb;
#pragma unroll 8
    for (int i = 0; i < 32; ++i) { const int kk = 2 * i + (lane >> 5); scr[kk * 33 + (lane & 31)] = W[(size_t)(k0 + kk) * ldw + n0 + (lane & 31)]; }
    LDS_WAIT(); asm volatile("" ::: "memory");
    const int c = lane & 7;
#pragma unroll
    for (int j = 0; j < 4; ++j) { const int n = (lane >> 3) + 8 * j; const LAS float* s = scr + (8 * c) * 33 + n;
        u32x4 o; o.x = pk2(s[0 * 33], s[1 * 33]); o.y = pk2(s[2 * 33], s[3 * 33]); o.z = pk2(s[4 * 33], s[5 * 33]); o.w = pk2(s[6 * 33], s[7 * 33]);
        *(u32x4*)(WT + (size_t)(n0 + n) * K + k0 + 8 * c) = o; }
    LDS_WAIT(); asm volatile("" ::: "memory");
}
__device__ __forceinline__ void conv_weights(const float* w_in, int ld_in, int n_in, const float* w_out, int k_out, unsigned char* wdst, LAS unsigned char* lds, int tid, int bid, int G) {
    const int lane = tid & 63, wave = tid >> 6;
    LAS float* scr = (LAS float*)(lds + wave * 16384);
    const int gw = bid * 8 + wave, NGW = G * 8;
    const int I_in = (1024 / 64) * (n_in / 32), I_out = (k_out / 64) * (1024 / 32);
    bf16_t* WinT = (bf16_t*)wdst; bf16_t* WoutT = (bf16_t*)(wdst + 12 * MiB);
    for (int it = gw; it < I_in + I_out; it += NGW) {
        if (it < I_in) transpose_item(w_in, ld_in, 1024, n_in / 32, WinT, scr, it, lane);
        else transpose_item(w_out, 1024, k_out, 32, WoutT, scr, it - I_in, lane);
    }
}
__device__ __forceinline__ void p0_mod(const Params& P, LAS unsigned char* lds, int tid, int bid, int G) {
    LAS float* sc = (LAS float*)lds;
    LAS float* red = sc + 4096;
    const int lane = tid & 63, wave = tid >> 6;
    float* MOD = (float*)(P.ws + WS_MOD);
    for (int i = tid; i < 4096; i += 512) sc[i] = silu_f(P.c[i]);
    __syncthreads();
    for (int it = bid; it < 192; it += G) {
        const int l = it / 48, cb = it % 48, n = cb * 64 + lane;
        const float* W = P.mod_w + (size_t)l * 1024 * 3072 + n;
        float a0 = 0.f, a1 = 0.f, a2 = 0.f, a3 = 0.f;
        const int k0 = wave * 128;
#pragma unroll 8
        for (int k = k0; k < k0 + 128; ++k) { const float w = W[(size_t)k * 3072]; a0 += sc[k] * w; a1 += sc[1024 + k] * w; a2 += sc[2048 + k] * w; a3 += sc[3072 + k] * w; }
        red[(wave * 4 + 0) * 64 + lane] = a0; red[(wave * 4 + 1) * 64 + lane] = a1; red[(wave * 4 + 2) * 64 + lane] = a2; red[(wave * 4 + 3) * 64 + lane] = a3;
        __syncthreads();
        if (wave < 4) { float s = 0.f;
#pragma unroll
            for (int w = 0; w < 8; ++w) s += red[(w * 4 + wave) * 64 + lane];
            MOD[(size_t)(l * 4 + wave) * 3072 + n] = s + P.mod_b[l * 3072 + n]; }
        __syncthreads();
    }
}
__device__ __forceinline__ void p0_rope(const Params& P, int tid, int bid, int G) {
    unsigned* rope = (unsigned*)(P.ws + WS_ROPE);
    const int gt = bid * 512 + tid, NT = G * 512;
    for (int idx = gt; idx < MT * 128; idx += NT) {
        const int row = idx >> 7, d = idx & 127;
        const float inv = powf(10000.0f, -(float)d * (1.0f / 128.0f));
        const float ang = (float)P.pos[row] * inv;
        double t = (double)ang * 0.15915494309189535; t -= rint(t);
        const float fr = (float)t;
        const float co = __builtin_amdgcn_cosf(fr), si = __builtin_amdgcn_sinf(fr);
        const unsigned lo = __builtin_bit_cast(unsigned short, (_Float16)co), hi = __builtin_bit_cast(unsigned short, (_Float16)si);
        rope[(((((row >> 4) * 4 + (d >> 5)) * 2 + ((d >> 2) & 1)) * 64 + 16 * ((d >> 3) & 3) + (row & 15)) << 2) + (d & 3)] = lo | (hi << 16);
    }
}

template <int KIND, bool XF32>
__device__ __forceinline__ void h_phase(const Params& P, int layer, const void* xin, LAS unsigned char* lds, int tid, int bid, int G) {
    const int lane = tid & 63, wave = tid >> 6;
    LAS float* WxT = (LAS float*)lds;
    LAS float* W2 = (LAS float*)(lds + 65536);
    LAS float* TOT = (LAS float*)(lds + 98304);
    const float* MOD = (const float*)(P.ws + WS_MOD);
    bf16_t* XN = (bf16_t*)(P.ws + WS_XN);
    if (KIND > 0) {
        const float* wsrc = (KIND == 1) ? (P.fox_w_in + 4096) : (P.gla_w_in + 3072); const int ldw = (KIND == 1) ? FOX_IN : GLA_IN;
        {
            float wv[32];
#pragma unroll
            for (int it = 0; it < 32; ++it) { const int idx = tid + 512 * it; wv[it] = wsrc[(size_t)(idx >> 4) * ldw + (idx & 15)]; }
#pragma unroll
            for (int it = 0; it < 32; ++it) { const int idx = tid + 512 * it; WxT[(idx & 15) * 1024 + (idx >> 4)] = wv[it]; }
        }
        if (KIND == 2) {
            float w2v[16];
#pragma unroll
            for (int it = 0; it < 16; ++it) w2v[it] = P.gla_w_gate2[tid + 512 * it];
#pragma unroll
            for (int it = 0; it < 16; ++it) W2[tid + 512 * it] = w2v[it];
        }
        __syncthreads();
    }
    for (int ci = bid; ci < MT / 64; ci += G) {
        const int b = ci >> 6;
        if (KIND != 1) ((float*)(P.ws + WS_S16))[ci * 512 + tid] = 0.f;
        const float* mod = MOD + (size_t)(layer * 4 + b) * 3072;
        f32x4 ga[4], sh[4];
#pragma unroll
        for (int j = 0; j < 4; ++j) { const int col = 4 * lane + 256 * j;
            const f32x4 g4 = *(const f32x4*)(P.norm_g + layer * 1024 + col), s4 = *(const f32x4*)(mod + 1024 + col);
            ga[j] = g4 * (s4 + 1.0f); sh[j] = *(const f32x4*)(mod + col); }
        float run[8]; f32x4 cbv[8][2];
        if (KIND == 2) {
#pragma unroll
            for (int c = 0; c < 8; ++c) run[c] = 0.f;
        }
        if constexpr (false) {
        constexpr int BS = (KIND == 2) ? 2 : 4;
#pragma unroll (KIND == 2 ? 8 / BS : 1)
        for (int rb = 0; rb < 8; rb += BS) {
            asm volatile("" ::: "memory");
            f32x4 xv[BS][4];
#pragma unroll
            for (int bb = 0; bb < BS; ++bb) { const size_t ro = (size_t)(ci * 64 + wave * 8 + rb + bb) * 1024;
                if (XF32) { const f32x4* xr = (const f32x4*)((const float*)xin + ro) + lane;
#pragma unroll
                    for (int j = 0; j < 4; ++j) xv[bb][j] = xr[64 * j]; }
                else { const u32x2* xr = (const u32x2*)((const bf16_t*)xin + ro) + lane;
#pragma unroll
                    for (int j = 0; j < 4; ++j) xv[bb][j] = unpk4(xr[64 * j]); } }
#pragma unroll
        for (int bb = 0; bb < BS; ++bb) {
            const int rr = rb + bb;
            asm volatile("" ::: "memory");
            const int row = ci * 64 + wave * 8 + rr;
            f32x4 v[4]; float ss = 0.f;
#pragma unroll
            for (int j = 0; j < 4; ++j) { v[j] = xv[bb][j]; ss += (v[j][0] * v[j][0] + v[j][1] * v[j][1]) + (v[j][2] * v[j][2] + v[j][3] * v[j][3]); }
            const float rstd = rsqrtf(wave_sum(ss) * (1.0f / 1024.0f) + EPS);
#pragma unroll
            for (int j = 0; j < 4; ++j) { v[j] = (v[j] * rstd) * ga[j] + sh[j]; *(u32x2*)(XN + (size_t)row * 1024 + 4 * lane + 256 * j) = pk4(v[j]); }
            if (KIND > 0) {
                float r[16];
#pragma unroll
                for (int i = 0; i < 16; ++i) { float a = 0.f;
#pragma unroll
                    for (int j = 0; j < 4; ++j) { const f32x4 w = *(const LAS f32x4*)(WxT + i * 1024 + 4 * lane + 256 * j); a += (v[j][0] * w[0] + v[j][1] * w[1]) + (v[j][2] * w[2] + v[j][3] * w[3]); }
                    r[i] = a; }
                if (KIND == 1) {
                    const float e1 = reduce_scatter16(r, lane);
                    const int idx = ((lane >> 5) & 1) * 8 + ((lane >> 4) & 1) * 4 + ((lane >> 3) & 1) * 2 + ((lane >> 2) & 1);
                    if ((lane & 3) == 0) ((float*)(P.ws + WS_S16))[(size_t)row * 16 + idx] = logsig_f(e1 + P.fox_b_f[idx]);
                } else {
                    f32x4 z0 = *(const f32x4*)(P.gla_b_gate + 8 * lane), z1 = *(const f32x4*)(P.gla_b_gate + 8 * lane + 4);
#pragma unroll
                    for (int i = 0; i < 16; ++i) { const f32x4 w0 = *(const LAS f32x4*)(W2 + i * 512 + 8 * lane), w1 = *(const LAS f32x4*)(W2 + i * 512 + 8 * lane + 4); z0 += w0 * r[i]; z1 += w1 * r[i]; }
#pragma unroll
                    for (int c = 0; c < 4; ++c) { run[c] += logsig_f(z0[c]) * 0.0625f; run[4 + c] += logsig_f(z1[c]) * 0.0625f; }
                    cbv[rr][0] = (f32x4){run[0], run[1], run[2], run[3]}; cbv[rr][1] = (f32x4){run[4], run[5], run[6], run[7]};
                }
            }
        }
        }
        } else {
        constexpr int BS = (KIND == 2) ? 2 : 4;
#pragma unroll (KIND != 0 ? 8 / BS : 1)
        for (int rb = 0; rb < 8; rb += BS) {
            asm volatile("" ::: "memory");
            f32x4 v[BS][4];
#pragma unroll
            for (int bb = 0; bb < BS; ++bb) { const size_t ro = (size_t)(ci * 64 + wave * 8 + rb + bb) * 1024;
                if (XF32) { const f32x4* xr = (const f32x4*)((const float*)xin + ro) + lane;
#pragma unroll
                    for (int j = 0; j < 4; ++j) v[bb][j] = xr[64 * j]; }
                else { const u32x2* xr = (const u32x2*)((const bf16_t*)xin + ro) + lane;
#pragma unroll
                    for (int j = 0; j < 4; ++j) v[bb][j] = unpk4(xr[64 * j]); } }
#pragma unroll
            for (int bb = 0; bb < BS; ++bb) {
                const int row = ci * 64 + wave * 8 + rb + bb; float ss = 0.f;
#pragma unroll
                for (int j = 0; j < 4; ++j) ss += (v[bb][j][0] * v[bb][j][0] + v[bb][j][1] * v[bb][j][1]) + (v[bb][j][2] * v[bb][j][2] + v[bb][j][3] * v[bb][j][3]);
                const float rstd = rsqrtf(wave_sum(ss) * (1.0f / 1024.0f) + EPS);
#pragma unroll
                for (int j = 0; j < 4; ++j) { v[bb][j] = (v[bb][j] * rstd) * ga[j] + sh[j]; *(u32x2*)(XN + (size_t)row * 1024 + 4 * lane + 256 * j) = pk4(v[bb][j]); }
            }
            if (KIND > 0) {
                float acc[BS][16];
#pragma unroll
                for (int i = 0; i < 16; ++i) {
                    f32x4 w[4];
#pragma unroll
                    for (int j = 0; j < 4; ++j) w[j] = *(const LAS f32x4*)(WxT + i * 1024 + 4 * lane + 256 * j);
#pragma unroll
                    for (int bb = 0; bb < BS; ++bb) { float a = 0.f;
#pragma unroll
                        for (int j = 0; j < 4; ++j) a += (v[bb][j][0] * w[j][0] + v[bb][j][1] * w[j][1]) + (v[bb][j][2] * w[j][2] + v[bb][j][3] * w[j][3]);
                        acc[bb][i] = a; }
                    if (i & 1) { __builtin_amdgcn_sched_barrier(0); asm volatile("" ::: "memory"); }
                }
#pragma unroll
                for (int bb = 0; bb < BS; ++bb) {
                    const int rr = rb + bb, row = ci * 64 + wave * 8 + rr;
                    asm volatile("" ::: "memory");
                    const float e1 = reduce_scatter16(acc[bb], lane);
                    if (KIND == 1) {
                        const int idx = ((lane >> 5) & 1) * 8 + ((lane >> 4) & 1) * 4 + ((lane >> 3) & 1) * 2 + ((lane >> 2) & 1);
                        ((float*)(P.ws + WS_S16))[(size_t)row * 16 + idx] = logsig_f(e1 + P.fox_b_f[idx]);
                    } else {
                        float r[16];
#pragma unroll
                        for (int i = 0; i < 16; ++i) r[i] = __builtin_bit_cast(float, __builtin_amdgcn_readlane(__builtin_bit_cast(int, e1), ((i >> 3) & 1) * 32 + ((i >> 2) & 1) * 16 + ((i >> 1) & 1) * 8 + (i & 1) * 4));
                        f32x4 z0 = *(const f32x4*)(P.gla_b_gate + 8 * lane), z1 = *(const f32x4*)(P.gla_b_gate + 8 * lane + 4);
#pragma unroll
                        for (int i = 0; i < 16; ++i) { const f32x4 w0 = *(const LAS f32x4*)(W2 + i * 512 + 8 * lane), w1 = *(const LAS f32x4*)(W2 + i * 512 + 8 * lane + 4); z0 += w0 * r[i]; z1 += w1 * r[i]; }
#pragma unroll
                        for (int c = 0; c < 4; ++c) { run[c] += logsig_f(z0[c]) * 0.0625f; run[4 + c] += logsig_f(z1[c]) * 0.0625f; }
                        cbv[rr][0] = (f32x4){run[0], run[1], run[2], run[3]}; cbv[rr][1] = (f32x4){run[4], run[5], run[6], run[7]};
                    }
                }
            }
        }
        }
        if (KIND == 2) {
            float* CB = (float*)(P.ws + WS_ACT + 160 * MiB);
            *(LAS f32x4*)(TOT + wave * 512 + 8 * lane) = (f32x4){run[0], run[1], run[2], run[3]};
            *(LAS f32x4*)(TOT + wave * 512 + 8 * lane + 4) = (f32x4){run[4], run[5], run[6], run[7]};
            __syncthreads();
            f32x4 o0 = (f32x4){0.f, 0.f, 0.f, 0.f}, o1 = o0;
            for (int w = 0; w < wave; ++w) { o0 += *(const LAS f32x4*)(TOT + w * 512 + 8 * lane); o1 += *(const LAS f32x4*)(TOT + w * 512 + 8 * lane + 4); }
#pragma unroll
            for (int rr = 0; rr < 8; ++rr) { const int row = ci * 64 + wave * 8 + rr;
                *(f32x4*)(CB + (size_t)row * 512 + 8 * lane) = cbv[rr][0] + o0; *(f32x4*)(CB + (size_t)row * 512 + 8 * lane + 4) = cbv[rr][1] + o1; }
            __syncthreads();
        }
    }
}

template <int KIND> struct LinCfg {
    static constexpr int DK = KIND == 0 ? 256 : 128, QP = KIND == 0 ? 1024 : 512, VP = KIND == 0 ? 2048 : 1024, HV = KIND == 0 ? 512 : 256;
    static constexpr int NSL = HV / 32, NITEM = 16 * NSL, NKF = DK / 32, RW = DK / 8, NDT = RW / 16, KPITCH = DK * 2 + 32, STP = DK + 8, KCH = DK / 64;
    static constexpr int LDS_ST = 0, LDS_P = 2 * 32 * STP * 2, LDS_V = LDS_P + 2 * 8192, LDS_END = LDS_V + 2 * 2 * 4096;
    static constexpr int NA = DK / 16;
};
__device__ __forceinline__ float ret_log2g(int h) { return (h == 0) ? -0.045803689613124796f : (h == 1) ? -0.02272007650008353f : (h == 2) ? -0.011315313227834146f : -0.005646563141142062f; }

template <int KIND>
__device__ __forceinline__ void lin_pphase(const bf16_t* Qa, bf16_t* Ka, const bf16_t* Qb, const bf16_t* Kb2, bf16_t* Pimg, int tid, int bid, int G) {
    typedef LinCfg<KIND> C;
    const int lane = tid & 63, wave = __builtin_amdgcn_readfirstlane(tid >> 6);
    const int g4 = lane >> 4, i16 = lane & 15;
    bf16x8 idf[2];
#pragma unroll
    for (int sel = 0; sel < 2; ++sel)
#pragma unroll
        for (int j = 0; j < 8; ++j) idf[sel][j] = (short)((8 * g4 + j == i16 + 16 * sel) ? 0x3F80 : 0);
    for (int hw0 = bid * 8; hw0 < 2048; hw0 += G * 8) {
        const int hw = hw0 + wave;
        const int item = hw >> 1, half = hw & 1;
        const int bh = item >> 6, n = item & 63, b = bh >> 2, h = bh & 3;
        const size_t t0 = (size_t)b * SEQ + (size_t)n * 64;
        f32x4 pa[2][4], pb[2][4];
#pragma unroll
        for (int r = 0; r < 2; ++r)
#pragma unroll
            for (int c = 0; c < 4; ++c) { pa[r][c] = (f32x4){0.f, 0.f, 0.f, 0.f}; pb[r][c] = (f32x4){0.f, 0.f, 0.f, 0.f}; }
        constexpr size_t BLK = (size_t)64 * C::DK * 2;
        const char* qa = (const char*)Qa + (size_t)item * BLK + lane * 16; char* ka = (char*)Ka + (size_t)item * BLK + lane * 16;
        const char* qb = (const char*)Qb + (size_t)item * BLK + lane * 16; const char* kb = (const char*)Kb2 + (size_t)item * BLK + lane * 16;
        bf16x8 kall[C::NKF][4];
#pragma unroll
        for (int k = 0; k < C::NKF; ++k)
#pragma unroll
            for (int c = 0; c < 4; ++c) kall[k][c] = *(const bf16x8*)(ka + (k * 4 + c) * 1024);
#pragma unroll
        for (int k = 0; k < C::NKF; ++k) {
            bf16x8 af[2];
#pragma unroll
            for (int r = 0; r < 2; ++r) af[r] = *(const bf16x8*)(qa + (k * 4 + 2 * half + r) * 1024);
#pragma unroll
            for (int r = 0; r < 2; ++r)
#pragma unroll
                for (int c = 0; c < 4; ++c) pa[r][c] = mma_rc(pa[r][c], af[r], kall[k][c]);
            if (KIND == 1) {
                bf16x8 bfr[4];
#pragma unroll
                for (int r = 0; r < 2; ++r) af[r] = *(const bf16x8*)(qb + (k * 4 + 2 * half + r) * 1024);
#pragma unroll
                for (int c = 0; c < 4; ++c) bfr[c] = *(const bf16x8*)(kb + (k * 4 + c) * 1024);
#pragma unroll
                for (int r = 0; r < 2; ++r)
#pragma unroll
                    for (int c = 0; c < 4; ++c) pb[r][c] = mma_rc(pb[r][c], af[r], bfr[c]);
            }
        }
        const float l2g = (KIND == 0) ? ret_log2g(h) : 0.f;
#pragma unroll
        for (int r = 0; r < 2; ++r) {
            const int c = 32 * half + 16 * r + (lane & 15);
#pragma unroll
            for (int ct = 0; ct < 4; ++ct) {
                f32x4 p;
#pragma unroll
                for (int e = 0; e < 4; ++e) { const int mm = 16 * ct + 4 * g4 + e;
                    if (KIND == 0) { const int dd = c > mm ? c - mm : mm - c; p[e] = pa[r][ct][e] * exp2f(l2g * (float)dd); }
                    else p[e] = (c >= mm) ? pa[r][ct][e] : pb[r][ct][e]; }
                const int ks = ct >> 1, gg = 2 * (ct & 1) + (g4 & 1);
                const int off = c * 128 + (((4 * ks + gg) ^ (c & 7)) << 4) + 8 * (g4 >> 1);
                *(u32x2*)((char*)Pimg + (size_t)item * 8192 + off) = pk4(p);
            }
        }
        __syncthreads();
        {
            char* kdst = ka - lane * 16 + (16 * (g4 & 1) + i16) * 16 + 8 * (g4 >> 1);
#define PP_TR(HALF) _Pragma("unroll") for (int k = 0; k < C::NKF; ++k) _Pragma("unroll") for (int sel = 0; sel < 2; ++sel) _Pragma("unroll") for (int T = 0; T < 2; ++T) { \
                const f32x4 tr_ = mma_rc((f32x4){0.f, 0.f, 0.f, 0.f}, idf[sel], kall[k][2 * (HALF) + T]); \
                *(u32x2*)(kdst + ((HALF) * C::NA + 2 * k + sel) * 1024 + T * 512) = pk4(tr_); }
            if (half == 0) { PP_TR(0) } else { PP_TR(1) }
#undef PP_TR
        }
    }
}

typedef short v4i16_t __attribute__((ext_vector_type(4)));
__device__ __forceinline__ bf16x8 trfrag2(const LAS char* p0, int second_off) {
    const v4i16_t a = __builtin_amdgcn_ds_read_tr16_b64_v4i16((LAS v4i16_t*)p0);
    const v4i16_t b = __builtin_amdgcn_ds_read_tr16_b64_v4i16((LAS v4i16_t*)(p0 + second_off));
    return (bf16x8){a[0], a[1], a[2], a[3], b[0], b[1], b[2], b[3]};
}

template <int KIND> struct LsStage { u32x4 x[LinCfg<KIND>::NKF]; u32x4 p; u32x2 v; f32x4 dec[2]; };

template <int KIND, int VAR = 0>
__device__ __forceinline__ void lin_scan(const bf16_t* Qg, const bf16_t* Kg, const bf16_t* Vg, const bf16_t* Pimg, const float* CB, bf16_t* O, float* DUMMY, LAS unsigned char* lds, int tid, int bid, int G) {
    typedef LinCfg<KIND> C;
    const int nit = (G == 256) ? 1 : (C::NITEM + G - 1) / G;
    const int tid0 = tid;
    for (int it = 0; it < nit; ++it) {
        int tid = tid0; asm volatile("" : "+v"(tid));
        const int lane = tid & 63, wave = __builtin_amdgcn_readfirstlane(tid >> 6);
        const int g4 = lane >> 4, i16 = lane & 15, q4 = i16 >> 2, p4 = i16 & 3;
        int item;
        if (G == 256) { const int x = bid & 7, j = bid >> 3; if (KIND == 0) item = x * 32 + j; else { if (j >= 16) break; item = x * 16 + j; } }
        else { item = it * G + bid; if (item >= C::NITEM) break; }
        const int bh = item / C::NSL, dvs = item % C::NSL, b = bh >> 2, h = bh & 3;
        const size_t t0 = (size_t)b * SEQ;
        const int rt = wave & 3; const bool rdw = wave < 4;
        constexpr int RWU = C::DK / 4, NDU = RWU / 16;
        const float l2g = (KIND == 0) ? ret_log2g(h) : 0.f;
        const float qsc = (KIND == 0) ? exp2f(l2g * (float)(16 * rt + i16 + 1)) : 1.0f;
        const float sdec = (KIND == 0) ? exp2f(l2g * 64.0f) : 1.0f;
        const int vm = tid >> 3, vp8 = tid & 7;
        const float vsc = (KIND == 0) ? exp2f(l2g * (float)(63 - vm)) : 1.0f;
        constexpr size_t BLK = (size_t)64 * C::DK * 2;
        const char* xsb = (const char*)(rdw ? Qg : Kg) + (size_t)bh * 64 * BLK + (rdw ? rt * 1024 : NDU * rt * 1024);
        const unsigned xvo = (unsigned)(lane * 16);
        const char* vsb = (const char*)Vg + (size_t)(bh * C::NSL + dvs) * (4096 * 64);
        char* osb = (char*)O + (size_t)(bh * C::NSL + dvs) * (4096 * 64);
        const unsigned vio = (unsigned)(tid * 8);
        char* dmb = (char*)DUMMY + (size_t)bid * 4096;
        const char* psb = (const char*)Pimg + (size_t)bh * 64 * 8192; const unsigned pvo = (unsigned)(tid * 16);
        const char* dcb = (KIND == 1) ? (const char*)CB + ((t0 + 63) * 512 + h * 128 + RWU * rt) * 4 : nullptr; const unsigned dco = (unsigned)(g4 * 16);
        LAS bf16_t* ST = (LAS bf16_t*)(lds + C::LDS_ST);
        LAS char* PI = (LAS char*)(lds + C::LDS_P);
        LAS char* VI = (LAS char*)(lds + C::LDS_V);
        LAS char* OT = (LAS char*)(lds + C::LDS_END);
        const int trow = 16 * (g4 >> 1) + 4 * (g4 & 1) + q4;
        const int voff = trow * 32 + 8 * p4;
        const int poff_row = (16 * rt + i16) * 128, psw = (16 * rt + i16) & 7;

        LsStage<KIND> A, B;
#define LS_LOAD_PV(S, nn) do { const int n_ = (nn) < 64 ? (nn) : 63; \
            unsigned po_ = pvo, vo_ = vio, do_ = dco; asm volatile("" : "+v"(po_), "+v"(vo_), "+v"(do_)); \
            if (!((VAR & 2) && (nn) >= 2)) { S.p = *(const u32x4*)(psb + (size_t)n_ * 8192 + po_); \
            S.v = *(const u32x2*)(vsb + (size_t)n_ * 4096 + vo_); } \
            if (KIND == 1) { _Pragma("unroll") for (int a_ = 0; a_ < NDU; ++a_) S.dec[a_] = *(const f32x4*)(dcb + (size_t)n_ * (64 * 512 * 4) + 64 * a_ + do_); } } while (0)
#define LS_LOAD_X(S, nn) do { const int n_ = (nn) < 64 ? (nn) : 63; \
            if (!((VAR & 1) && (nn) >= 2)) { const char* xs_ = xsb + (size_t)n_ * BLK; unsigned xo_ = xvo; asm volatile("" : "+v"(xo_));        \
                _Pragma("unroll") for (int k_ = 0; k_ < C::NKF; ++k_) S.x[k_] = *(const u32x4*)(xs_ + (size_t)(rdw ? k_ * 4096 : ((k_ / NDU) * C::NA + (k_ % NDU)) * 1024) + xo_); } } while (0)
#define LS_LOAD(S, nn) do { LS_LOAD_PV(S, nn); LS_LOAD_X(S, nn); } while (0)
#define LS_WRITE(S, img) do { \
            *(LAS u32x4*)(PI + (img) * 8192 + tid * 16) = S.p; \
            { LAS char* vd_ = VI + (img) * 8192 + (vp8 >> 2) * 2048 + vm * 32 + (vp8 & 3) * 8; *(LAS u32x2*)vd_ = S.v; \
              if (KIND == 0) { u32x2 w_; w_.x = pk2(bf2f(S.v.x & 0xffffu) * vsc, bf2f(S.v.x >> 16) * vsc); w_.y = pk2(bf2f(S.v.y & 0xffffu) * vsc, bf2f(S.v.y >> 16) * vsc); *(LAS u32x2*)(vd_ + 4096) = w_; } } } while (0)

        for (int i = tid; i < 32 * C::STP / 2; i += 512) ((LAS unsigned*)ST)[i] = 0u;
        f32x4 s[NDU][2];
#pragma unroll
        for (int a = 0; a < NDU; ++a)
#pragma unroll
            for (int e = 0; e < 2; ++e) s[a][e] = (f32x4){0.f, 0.f, 0.f, 0.f};
        LS_LOAD(A, 0); LS_LOAD(B, 1);
        LS_WRITE(A, 0);
        __syncthreads();

#define LS_SB(k) s[1 + (k) / 2][(k) % 2]
#define LS_STEP(n, SC, SN) do { const int img_ = (n) & 1; \
            f32x4 dcur_[2]; if (KIND == 1) { _Pragma("unroll") for (int a_ = 0; a_ < NDU; ++a_) dcur_[a_] = SC.dec[a_]; } \
              \
            LS_LOAD_PV(SC, (n) + 2); \
            if (rdw) { \
                  \
                if (!(VAR & 16)) { \
                const LAS bf16_t* STc_ = ST + img_ * 32 * C::STP; \
                  \
                  \
                _Pragma("unroll") for (int ct_ = 0; ct_ < 2; ++ct_) { \
                    constexpr int HB_ = C::NKF / 2; bf16x8 pf_[2], vf_[2]; \
                    s[0][0] = (f32x4){0.f, 0.f, 0.f, 0.f}; s[0][1] = s[0][0]; \
                    _Pragma("unroll") for (int k_ = 0; k_ < HB_; ++k_) LS_SB(k_) = __builtin_bit_cast(f32x4, lfrag(STc_ + 16 * ct_ * C::STP + 32 * k_, C::STP, lane)); \
                    __builtin_amdgcn_sched_barrier(0); \
                    _Pragma("unroll") for (int k_ = 0; k_ < HB_; k_ += 2) { s[0][0] = mma_rc(s[0][0], __builtin_bit_cast(bf16x8, SC.x[k_]), __builtin_bit_cast(bf16x8, LS_SB(k_))); s[0][1] = mma_rc(s[0][1], __builtin_bit_cast(bf16x8, SC.x[k_ + 1]), __builtin_bit_cast(bf16x8, LS_SB(k_ + 1))); } \
                    __builtin_amdgcn_sched_barrier(0); \
                    _Pragma("unroll") for (int k_ = 0; k_ < HB_; ++k_) LS_SB(k_) = __builtin_bit_cast(f32x4, lfrag(STc_ + 16 * ct_ * C::STP + 32 * (HB_ + k_), C::STP, lane)); \
                    _Pragma("unroll") for (int ks_ = 0; ks_ < 2; ++ks_) { \
                        pf_[ks_] = *(const LAS bf16x8*)(PI + img_ * 8192 + poff_row + (((4 * ks_ + g4) ^ psw) << 4)); \
                        vf_[ks_] = trfrag2(VI + img_ * 8192 + ct_ * 2048 + ks_ * 1024 + voff, 256); } \
                    __builtin_amdgcn_sched_barrier(0); \
                    _Pragma("unroll") for (int k_ = 0; k_ < HB_; k_ += 2) { s[0][0] = mma_rc(s[0][0], __builtin_bit_cast(bf16x8, SC.x[HB_ + k_]), __builtin_bit_cast(bf16x8, LS_SB(k_))); s[0][1] = mma_rc(s[0][1], __builtin_bit_cast(bf16x8, SC.x[HB_ + k_ + 1]), __builtin_bit_cast(bf16x8, LS_SB(k_ + 1))); } \
                    f32x4 oa_ = (s[0][0] + s[0][1]) * qsc; \
                    _Pragma("unroll") for (int ks_ = 0; ks_ < 2; ++ks_) oa_ = mma_rc(oa_, pf_[ks_], vf_[ks_]); \
                    *(LAS u32x2*)(OT + img_ * 4608 + (16 * rt + i16) * 72 + (16 * ct_ + 4 * g4) * 2) = pk4(oa_); \
                    __builtin_amdgcn_sched_barrier(0); } } \
                  \
                LS_LOAD_X(SC, (n) + 2); \
            } else { \
                  \
                if (KIND == 0) { _Pragma("unroll") for (int a_ = 0; a_ < NDU; ++a_) _Pragma("unroll") for (int e_ = 0; e_ < 2; ++e_) s[a_][e_] = s[a_][e_] * sdec; } \
                if (!(VAR & 4)) { bf16x8 vf_[2][2]; \
                    _Pragma("unroll") for (int ks_ = 0; ks_ < 2; ++ks_) _Pragma("unroll") for (int e_ = 0; e_ < 2; ++e_) vf_[ks_][e_] = trfrag2(VI + img_ * 8192 + (KIND == 0 ? 4096 : 0) + e_ * 2048 + ks_ * 1024 + voff, 256); \
                    _Pragma("unroll") for (int ks_ = 0; ks_ < 2; ++ks_) _Pragma("unroll") for (int a_ = 0; a_ < NDU; ++a_) _Pragma("unroll") for (int e_ = 0; e_ < 2; ++e_) \
                        s[a_][e_] = mma_cr(s[a_][e_], __builtin_bit_cast(bf16x8, SC.x[ks_ * NDU + a_]), vf_[ks_][e_]); } \
                  \
                LS_LOAD_X(SC, (n) + 2); \
                if (KIND == 1) { _Pragma("unroll") for (int a_ = 0; a_ < NDU; ++a_) { f32x4 dc_; _Pragma("unroll") for (int r_ = 0; r_ < 4; ++r_) dc_[r_] = __expf(dcur_[a_][r_]); \
                    _Pragma("unroll") for (int e_ = 0; e_ < 2; ++e_) s[a_][e_] = s[a_][e_] * dc_; } } \
                  \
                { LAS bf16_t* STn_ = ST + (img_ ^ 1) * 32 * C::STP; \
                  _Pragma("unroll") for (int a_ = 0; a_ < NDU; ++a_) _Pragma("unroll") for (int e_ = 0; e_ < 2; ++e_) \
                      *(LAS u32x2*)(STn_ + (16 * e_ + i16) * C::STP + RWU * rt + 16 * a_ + 4 * g4) = pk4(s[a_][e_]); } \
            } \
              \
            { const u32x2 ov_ = *(const LAS u32x2*)(OT + (img_ ^ 1) * 4608 + vm * 72 + vp8 * 8); \
              char* ob_ = (n) > 0 ? osb + (size_t)((n) - 1) * 4096 : dmb; unsigned oo_ = vio; asm volatile("" : "+v"(oo_)); \
              if (!((VAR & 8) && (n) >= 2)) *(u32x2*)(ob_ + oo_) = ov_; } \
              \
            LS_WRITE(SN, img_ ^ 1); \
            asm volatile("s_waitcnt lgkmcnt(0)" ::: "memory"); __builtin_amdgcn_s_barrier(); asm volatile("" ::: "memory"); } while (0)

#pragma nounroll
        for (int n = 0; n < 64; n += 2) { LS_STEP(n, A, B); LS_STEP(n + 1, B, A); }
        *(u32x2*)(osb + (size_t)63 * 4096 + vio) = *(const LAS u32x2*)(OT + 4608 + vm * 72 + vp8 * 8);
        __syncthreads();
#undef LS_LOAD
#undef LS_LOAD_PV
#undef LS_LOAD_X
#undef LS_WRITE
#undef LS_STEP
#undef LS_SB
    }
}


template <int KIND>
__device__ __forceinline__ void lin_stats(const bf16_t* O, float* STATS, int tid, int bid, int G) {
    const int lane = tid & 63, wave = tid >> 6;
    const int gw = bid * 8 + wave, NGW = G * 8;
    constexpr int NJ = KIND == 0 ? 4 : 2, PITCH = KIND == 0 ? 2048 : 1024, RB = 4;
    for (int row0 = gw; row0 < MT; row0 += RB * NGW) {
        u32x4 w[RB][NJ];
#pragma unroll
        for (int rb = 0; rb < RB; ++rb) { const int row = row0 + rb * NGW < MT ? row0 + rb * NGW : row0;
#pragma unroll
            for (int j = 0; j < NJ; ++j) w[rb][j] = *(const u32x4*)(O + (size_t)row * PITCH + 512 * j + 8 * lane); }
#pragma unroll
        for (int rb = 0; rb < RB; ++rb) { const int row = row0 + rb * NGW; if (row >= MT) break;
#pragma unroll
            for (int j = 0; j < NJ; ++j) {
                float sm = 0.f, sq = 0.f;
#pragma unroll
                for (int i = 0; i < 4; ++i) { const float a = bf2f(w[rb][j][i] & 0xffffu), b = bf2f(w[rb][j][i] >> 16); sm += a + b; sq += a * a + b * b; }
                if (KIND == 0) { sm = wave_sum(sm); sq = wave_sum(sq); if (lane == 0) *(f32x2*)(STATS + (size_t)row * 8 + 2 * j) = (f32x2){sm, sq}; }
                else {
#pragma unroll
                    for (int o = 1; o < 32; o <<= 1) sq += __shfl_xor(sq, o);
                    if ((lane & 31) == 0) *(f32x2*)(STATS + (size_t)row * 8 + 2 * (2 * j + (lane >> 5))) = (f32x2){0.f, sq}; }
            }
        }
    }
}

template <int KIND> struct EpiGateNorm {
    static constexpr bool PERM = true;
    const bf16_t* O; bf16_t* A; LAS float* tbl;
    __device__ __forceinline__ void operator()(const f32x4 (&acc)[2][2][4][2], const pg8::Unit& u, int wr, int wc, int fr, int fq) const {
        constexpr int N = KIND == 0 ? 2048 : 1024, HV = KIND == 0 ? 512 : 256; constexpr float INV = KIND == 0 ? 1.0f / 512.0f : 1.0f / 256.0f;
        const int c0 = u.pn * 256 + wc * 32 + fq * 8;
        if (KIND == 0) {
            if ((u.pn & 1) == 0) {
                LAS f32x2* tb2 = (LAS f32x2*)tbl;
#pragma unroll
                for (int ai = 0; ai < 2; ++ai)
#pragma unroll
                    for (int m = 0; m < 4; ++m) { const int rl = ai * 128 + wr * 64 + m * 16 + fr; const int row = u.pm * 256 + rl; float sm = 0.f, sq = 0.f;
                        u32x4 w[4];
#pragma unroll
                        for (int tt = 0; tt < 2; ++tt)
#pragma unroll
                            for (int bj = 0; bj < 2; ++bj) w[2 * tt + bj] = *(const u32x4*)((const char*)O + v_img_off<HV>(row, c0 + tt * 256 + bj * 128));
#pragma unroll
                        for (int i = 0; i < 4; ++i) {
                            const f32x4 o0 = unpk4((u32x2){w[i].x, w[i].y}), o1 = unpk4((u32x2){w[i].z, w[i].w});
                            const f32x4 ss = o0 + o1, qq = o0 * o0 + o1 * o1;
                            sm += (ss[0] + ss[1]) + (ss[2] + ss[3]); sq += (qq[0] + qq[1]) + (qq[2] + qq[3]); }
                        sm = xsum_16_32(sm); sq = xsum_16_32(sq);
                        if (fq == 0) tb2[rl * 4 + wc] = (f32x2){sm, sq};
                        asm volatile("" ::: "memory"); }
                asm volatile("s_waitcnt lgkmcnt(0)" ::: "memory"); __builtin_amdgcn_s_barrier(); asm volatile("" ::: "memory");
            }
#pragma unroll
            for (int ai = 0; ai < 2; ++ai)
#pragma unroll
            for (int mh = 0; mh < 2; ++mh) {
                u32x4 ov[2][2];
#pragma unroll
                for (int mm = 0; mm < 2; ++mm) { const int row = u.pm * 256 + ai * 128 + wr * 64 + (2 * mh + mm) * 16 + fr;
#pragma unroll
                    for (int bj = 0; bj < 2; ++bj) ov[mm][bj] = *(const u32x4*)((const char*)O + v_img_off<HV>(row, c0 + bj * 128)); }
                asm volatile("" ::: "memory");
#pragma unroll
                for (int mm = 0; mm < 2; ++mm) { const int m = 2 * mh + mm; const int rl = ai * 128 + wr * 64 + m * 16 + fr; const int row = u.pm * 256 + rl;
                    const LAS f32x2* tb2 = (const LAS f32x2*)tbl + rl * 4;
                    const f32x2 p0 = tb2[0], p1 = tb2[1], p2 = tb2[2], p3 = tb2[3];
                    const float mean = ((p0.x + p1.x) + (p2.x + p3.x)) * INV, rstd = __builtin_amdgcn_rsqf(fmaxf(((p0.y + p1.y) + (p2.y + p3.y)) * INV - mean * mean, 0.f) + EPS);
#pragma unroll
                    for (int bj = 0; bj < 2; ++bj) {
                        const f32x4 o0 = unpk4((u32x2){ov[mm][bj].x, ov[mm][bj].y}), o1 = unpk4((u32x2){ov[mm][bj].z, ov[mm][bj].w}), a0 = acc[ai][bj][m][0], a1 = acc[ai][bj][m][1]; f32x4 r0, r1;
#pragma unroll
                        for (int j = 0; j < 4; ++j) { r0[j] = (o0[j] - mean) * rstd * silu_f(a0[j]); r1[j] = (o1[j] - mean) * rstd * silu_f(a1[j]); }
                        const u32x2 q0 = pk4(r0), q1 = pk4(r1);
                        *(u32x4*)(A + (size_t)row * N + c0 + bj * 128) = (u32x4){q0.x, q0.y, q1.x, q1.y};
                    }
                }
                asm volatile("" ::: "memory");
            }
        } else {
#pragma unroll
            for (int ai = 0; ai < 2; ++ai)
#pragma unroll
                for (int m = 0; m < 4; ++m) { const int rl = ai * 128 + wr * 64 + m * 16 + fr; const int row = u.pm * 256 + rl; float sq = 0.f;
#pragma unroll
                    for (int bj = 0; bj < 2; ++bj) { const u32x4 w = *(const u32x4*)((const char*)O + v_img_off<HV>(row, c0 + bj * 128));
                        const f32x4 o0 = unpk4((u32x2){w.x, w.y}), o1 = unpk4((u32x2){w.z, w.w}); const f32x4 qq = o0 * o0 + o1 * o1; sq += (qq[0] + qq[1]) + (qq[2] + qq[3]); }
                    sq = xsum_16_32(sq);
                    if (fq == 0) tbl[rl * 4 + wc] = sq; }
            asm volatile("s_waitcnt lgkmcnt(0)" ::: "memory"); __builtin_amdgcn_s_barrier(); asm volatile("" ::: "memory");
#pragma unroll
            for (int ai = 0; ai < 2; ++ai) {
                u32x4 ov[4][2];
#pragma unroll
                for (int m = 0; m < 4; ++m) { const int row = u.pm * 256 + ai * 128 + wr * 64 + m * 16 + fr;
#pragma unroll
                    for (int bj = 0; bj < 2; ++bj) ov[m][bj] = *(const u32x4*)((const char*)O + v_img_off<HV>(row, c0 + bj * 128)); }
                asm volatile("" ::: "memory");
#pragma unroll
                for (int m = 0; m < 4; ++m) { const int rl = ai * 128 + wr * 64 + m * 16 + fr; const int row = u.pm * 256 + rl;
                    const f32x4 pr = *(const LAS f32x4*)(tbl + rl * 4);
                    const float rstd = __builtin_amdgcn_rsqf(((pr[0] + pr[1]) + (pr[2] + pr[3])) * INV + EPS);
#pragma unroll
                    for (int bj = 0; bj < 2; ++bj) {
                        const f32x4 o0 = unpk4((u32x2){ov[m][bj].x, ov[m][bj].y}), o1 = unpk4((u32x2){ov[m][bj].z, ov[m][bj].w}), a0 = acc[ai][bj][m][0], a1 = acc[ai][bj][m][1]; f32x4 r0, r1;
#pragma unroll
                        for (int j = 0; j < 4; ++j) { r0[j] = o0[j] * rstd * silu_f(a0[j]); r1[j] = o1[j] * rstd * silu_f(a1[j]); }
                        const u32x2 q0 = pk4(r0), q1 = pk4(r1);
                        *(u32x4*)(A + (size_t)row * N + c0 + bj * 128) = (u32x4){q0.x, q0.y, q1.x, q1.y};
                    }
                }
                asm volatile("" ::: "memory");
            }
        }
    }
};
namespace attn_body {
using bf16=unsigned short;
using bf16x8=__attribute__((ext_vector_type(8)))short;
using s16x4=__attribute__((ext_vector_type(4)))short;
using f32x16=__attribute__((ext_vector_type(16)))float;
using u32x4=__attribute__((ext_vector_type(4)))unsigned;
constexpr int BATCH=4,NHEAD=16,SEQ=4096,D=64,DM=NHEAD*D;
constexpr int NW=8,QBLK=32,QB=QBLK*NW,KVBLK=64,NQB=SEQ/QB;
constexpr int ATTN_PITCH=DM, ATTN_UNIT_ROWS=QB;
__device__ __forceinline__ int crow(int r,int hi){return (r&3)+8*(r>>2)+4*hi;}
#define SBAR() __builtin_amdgcn_sched_barrier(0)
__device__ __forceinline__ void cmask(f32x16&p0,f32x16&p1,int jb,int qrel,int hi){
  const float NEG=-INFINITY; int kb=64*jb+4*hi;
  #pragma unroll
  for(int r=0;r<16;++r){int kv=kb+(r&3)+8*(r>>2); if(kv>qrel)p0[r]=NEG; if(kv+32>qrel)p1[r]=NEG;}
}

constexpr int NSLOT=3, SLOTB=8192;
constexpr int LDS_K=0, LDS_V=NSLOT*SLOTB, LDS_WS=2*NSLOT*SLOTB, LDS_OST=LDS_WS+NW*64*4, LDS_NC=LDS_OST+NW*4096, LDS_FT=LDS_NC+SEQ*4, LDS_RE=LDS_FT+256, LDS_BYTES=LDS_RE+256;
constexpr float C2=0.125f*1.4426950408889634f;
__device__ __forceinline__ void glds16(const void*gsrc,unsigned lds_dst){unsigned keep;
  asm volatile("s_mov_b32 %0, m0\n\ts_mov_b32 m0, %2\n\ts_nop 0\n\tglobal_load_lds_dwordx4 %1, off\n\ts_mov_b32 m0, %0":"=&s"(keep):"v"(gsrc),"s"(lds_dst):"memory");}
__device__ __forceinline__ float max3f(float a,float b,float c){float r;asm("v_max3_f32 %0, %1, %2, %3":"=v"(r):"v"(a),"v"(b),"v"(c));return r;}
__device__ __forceinline__ float max2f(float a,float b){float r;asm("v_max_f32_e32 %0, %1, %2":"=v"(r):"v"(a),"v"(b));return r;}
__device__ __forceinline__ float fadd_s(float a,float b){float r;asm("v_add_f32_e32 %0, %1, %2":"=v"(r):"v"(a),"v"(b));return r;}
__device__ __forceinline__ float fsub_s(float a,float b){float r;asm("v_sub_f32_e32 %0, %1, %2":"=v"(r):"v"(a),"v"(b));return r;}
typedef float f32x2_t __attribute__((ext_vector_type(2))); typedef __bf16 bf16x2_t __attribute__((ext_vector_type(2)));
__device__ __forceinline__ unsigned cvtpk_s(float lo,float hi){f32x2_t v={lo,hi};bf16x2_t b=__builtin_convertvector(v,bf16x2_t);return __builtin_bit_cast(unsigned,b);}
#define WAIT_BAR(N) asm volatile("s_waitcnt vmcnt(" #N ") lgkmcnt(0)\n\ts_barrier":::"memory")

__device__ __forceinline__ void qkt(f32x16&p0,f32x16&p1,const char*Kslot,const bf16x8*qr,const f32x16&negm,int r32,int hi){
  const char*kb=Kslot+hi*1024+r32*16;
  #pragma unroll
  for(int d0=0;d0<4;++d0){
    const bf16x8 b0=*reinterpret_cast<const bf16x8*>(kb+d0*2048);
    const bf16x8 b1=*reinterpret_cast<const bf16x8*>(kb+d0*2048+512);
    if(d0==0){p0=__builtin_amdgcn_mfma_f32_32x32x16_bf16(b0,qr[0],negm,0,0,0);p1=__builtin_amdgcn_mfma_f32_32x32x16_bf16(b1,qr[0],negm,0,0,0);}
    else{p0=__builtin_amdgcn_mfma_f32_32x32x16_bf16(b0,qr[d0],p0,0,0,0);p1=__builtin_amdgcn_mfma_f32_32x32x16_bf16(b1,qr[d0],p1,0,0,0);}}
}
typedef __attribute__((address_space(3))) const char* lds_cptr;
typedef short v4i16_t __attribute__((ext_vector_type(4)));
__device__ __forceinline__ void kload8(bf16x8*kf,lds_cptr kp){
  kf[0]=*(const __attribute__((address_space(3))) bf16x8*)(kp);      kf[1]=*(const __attribute__((address_space(3))) bf16x8*)(kp+512);
  kf[2]=*(const __attribute__((address_space(3))) bf16x8*)(kp+2048); kf[3]=*(const __attribute__((address_space(3))) bf16x8*)(kp+2560);
  kf[4]=*(const __attribute__((address_space(3))) bf16x8*)(kp+4096); kf[5]=*(const __attribute__((address_space(3))) bf16x8*)(kp+4608);
  kf[6]=*(const __attribute__((address_space(3))) bf16x8*)(kp+6144); kf[7]=*(const __attribute__((address_space(3))) bf16x8*)(kp+6656);
}
__device__ __forceinline__ void kload2(bf16x8*kf,lds_cptr kp,int j){ kf[2*j]=*(const __attribute__((address_space(3))) bf16x8*)(kp+j*2048); kf[2*j+1]=*(const __attribute__((address_space(3))) bf16x8*)(kp+j*2048+512); }
__device__ __forceinline__ s16x4 vtr(lds_cptr p){ return __builtin_bit_cast(s16x4,__builtin_amdgcn_ds_read_tr16_b64_v4i16((__attribute__((address_space(3))) v4i16_t*)p)); }
__device__ __forceinline__ float rowmax(const f32x16&p0,const f32x16&p1){
  float a=max3f(p0[0],p0[1],p1[0]),b=max3f(p0[2],p0[3],p1[1]);a=max3f(a,p1[2],p1[3]);
  #pragma unroll
  for(int r=4;r<16;r+=4){a=max3f(a,p0[r],p0[r+1]);b=max3f(b,p0[r+2],p0[r+3]);a=max3f(a,p1[r],p1[r+1]);b=max3f(b,p1[r+2],p1[r+3]);}
  const float m=max2f(a,b);
  auto rr=__builtin_amdgcn_permlane32_swap(__float_as_uint(m),__float_as_uint(m),false,false);
  return max2f(__uint_as_float(rr[0]),__uint_as_float(rr[1]));
}
__device__ __forceinline__ void pv(f32x16*o,int vb,bf16x8 pa0,bf16x8 pa1,bf16x8 pa2,bf16x8 pa3){
  #pragma unroll
  for(int d0=0;d0<2;++d0){s16x4 lo[4],hi[4];
    #pragma unroll
    for(int ks=0;ks<4;++ks){
      asm volatile("ds_read_b64_tr_b16 %0,%1 offset:%c2":"=&v"(lo[ks]):"v"(vb),"i"(d0*4096+ks*1024):"memory");
      asm volatile("ds_read_b64_tr_b16 %0,%1 offset:%c2":"=&v"(hi[ks]):"v"(vb),"i"(d0*4096+ks*1024+512):"memory");}
    asm volatile("s_waitcnt lgkmcnt(0)":::"memory");SBAR();
    #define PK(k) (bf16x8){lo[k][0],lo[k][1],lo[k][2],lo[k][3],hi[k][0],hi[k][1],hi[k][2],hi[k][3]}
    o[d0]=__builtin_amdgcn_mfma_f32_32x32x16_bf16(pa0,PK(0),o[d0],0,0,0);
    o[d0]=__builtin_amdgcn_mfma_f32_32x32x16_bf16(pa1,PK(1),o[d0],0,0,0);
    o[d0]=__builtin_amdgcn_mfma_f32_32x32x16_bf16(pa2,PK(2),o[d0],0,0,0);
    o[d0]=__builtin_amdgcn_mfma_f32_32x32x16_bf16(pa3,PK(3),o[d0],0,0,0);
    #undef PK
  }
}

#ifndef ATTN_STORE16
#define ATTN_STORE16(p,v) (*(u32x4*)(p)=(v))
#endif
template<int THRL> __device__ __forceinline__ void attn_unit(int b,int h,int qb,int ts,const bf16*Q,const bf16*__restrict__ K,const bf16*__restrict__ V,const bf16*__restrict__ Gt,bf16*O,char*shm,int tid){
  const int lane=tid&63,r32=lane&31,hi=lane>>5; const int wid=__builtin_amdgcn_readfirstlane(tid>>6);
  const long rowbase=(long)b*SEQ; const int q0=qb*QB;
  typedef __attribute__((address_space(3))) const float* lds_fptr; typedef float f32x4b __attribute__((ext_vector_type(4)));
  const lds_fptr ncum=(lds_fptr)((__attribute__((address_space(3))) const char*)shm+LDS_NC)+64*ts+4*hi;
  const lds_fptr ftp=(lds_fptr)((__attribute__((address_space(3))) const char*)shm+LDS_FT)+ts;
  const bf16*Qw=Q+(rowbase+q0+wid*QBLK)*DM+h*D;
  const bf16*Kh=K+(rowbase+(long)ts*KVBLK)*DM+h*D,*Vh=V+(rowbase+(long)ts*KVBLK)*DM+h*D;
  const unsigned lds0=(unsigned)(uintptr_t)shm;
  float*wsf=(float*)(shm+LDS_WS)+wid*64;
  const bf16*ksrc=Kh+(long)lane*DM+wid*8;
  const bf16*vsrc=Vh+(long)(16*(wid&3)+(lane>>2))*DM+(wid>>2)*32+(lane&3)*8;
  const unsigned kdst=lds0+LDS_K+wid*1024, vdst=lds0+LDS_V+wid*1024;
  #define DMA_K(t,slot) glds16(ksrc+(long)(t)*KVBLK*DM,(unsigned)__builtin_amdgcn_readfirstlane(kdst+(slot)))
  #define DMA_V(t,slot) glds16(vsrc+(long)(t)*KVBLK*DM,(unsigned)__builtin_amdgcn_readfirstlane(vdst+(slot)))
  const int vb0=(int)(lds0+LDS_V)+((lane>>4)&1)*32+(lane&3)*8+(4*hi+((lane&15)>>2))*64;
  const char*Kbase=shm+LDS_K; bf16x8 kf[8];
  const lds_cptr shm3=(lds_cptr)shm; const lds_cptr kp0=shm3+LDS_K+hi*1024+r32*16; const lds_cptr vp0=shm3+LDS_V+((lane>>4)&1)*32+(lane&3)*8+(4*hi+((lane&15)>>2))*64;
  const int NT=(q0+QB)/KVBLK-ts;
  DMA_K(0,0);DMA_V(0,0);DMA_K(1,SLOTB);
  bf16x8 qr[4];
  #pragma unroll
  for(int d0=0;d0<4;++d0)qr[d0]=*reinterpret_cast<const bf16x8*>(&Qw[(long)r32*DM+d0*16+hi*8]);
  float l_reg=0.f,fcur=1.f;f32x16 o[2];o[0]=f32x16{};o[1]=f32x16{};const f32x16 negm=f32x16{};
  const int qrel=wid*QBLK+r32;
  #define CMASK(P0,P1,t) do{int jb_=(t)-(NT-4); if(jb_>=0)cmask(P0,P1,jb_,qrel,hi);}while(0)
  #define LDSF4(p) (*(const __attribute__((address_space(3))) f32x4b*)(p))
  #define BIAS(P0,P1,t) do{ const lds_fptr nb_=ncum+64*(t); \
      { const f32x4b a0_=LDSF4(nb_), a1_=LDSF4(nb_+8), a2_=LDSF4(nb_+16), a3_=LDSF4(nb_+24); \
        _Pragma("unroll") for(int j_=0;j_<4;++j_){ P0[j_]+=a0_[j_]; P0[4+j_]+=a1_[j_]; P0[8+j_]+=a2_[j_]; P0[12+j_]+=a3_[j_]; } } SBAR(); \
      { const f32x4b b0_=LDSF4(nb_+32), b1_=LDSF4(nb_+40), b2_=LDSF4(nb_+48), b3_=LDSF4(nb_+56); \
        _Pragma("unroll") for(int j_=0;j_<4;++j_){ P1[j_]+=b0_[j_]; P1[4+j_]+=b1_[j_]; P1[8+j_]+=b2_[j_]; P1[12+j_]+=b3_[j_]; } } SBAR(); }while(0)
  #define START(P0,P1) do{ _Pragma("unroll") for(int r=0;r<16;++r)P0[r]=__builtin_amdgcn_exp2f(P0[r]); }while(0)
  #define RESC() do{ _Pragma("unroll") for(int d_=0;d_<2;++d_) _Pragma("unroll") for(int r=0;r<16;++r)o[d_][r]*=fcur; }while(0)
  f32x16 pA0,pA1,pB0,pB1;
  int sl_prev=0,sl_cur=0,sl_next=SLOTB;
  #define ROT() do{sl_prev=sl_cur;sl_cur=sl_next;sl_next=(sl_next==(NSLOT-1)*SLOTB)?0:sl_next+SLOTB;}while(0)
  DMA_K(2,2*SLOTB);
  WAIT_BAR(3);
  qkt(pA0,pA1,Kbase,qr,negm,r32,hi);asm volatile("s_nop 15\n\ts_nop 7":"+v"(pA0),"+v"(pA1));BIAS(pA0,pA1,0);CMASK(pA0,pA1,0);
  START(pA0,pA1);
  _Pragma("unroll") for(int r=0;r<16;++r)pA1[r]=__builtin_amdgcn_exp2f(pA1[r]);
  WAIT_BAR(0);
  DMA_K(3,0);DMA_V(1,SLOTB);
  ROT();
  kload8(kf,kp0+sl_cur);
  WAIT_BAR(2);
  s16x4 vlo[8],vhi[8]; u32x4 pw0,pw1,pw2,pw3;
  #define PKW(P,B) cvtpk_s(P[B],P[B+1])
  #define PAF(k) __builtin_bit_cast(bf16x8,pw##k)
  #define VFR(i) (bf16x8){vlo[i][0],vlo[i][1],vlo[i][2],vlo[i][3],vhi[i][0],vhi[i][1],vhi[i][2],vhi[i][3]}
  #define PIN(x) asm volatile("":"+v"(x))
  #define MX3(a,b,c) __builtin_fmaxf(__builtin_fmaxf((a),(b)),(c))
  #define GAPA(MF,A0,A1,A2,A3,W0,W1,PW) do{ MF; sacc+=A0; sacc+=A1; sacc+=A2; sacc+=A3; PIN(sacc); W0; W1; PIN(PW); SBAR(); }while(0)
  #define EX(v) __builtin_amdgcn_exp2f(v)
  #define GAPB(MF,X,B) do{ MF; X[B]=EX(X[B]); X[B+1]=EX(X[B+1]); X[B+2]=EX(X[B+2]); X[B+3]=EX(X[B+3]); PIN(X); SBAR(); }while(0)
  #define VRD(i) do{ vlo[i]=vtr(vp_+(((i)>>2)*4096+((i)&3)*1024)); vhi[i]=vtr(vp_+(((i)>>2)*4096+((i)&3)*1024+512)); }while(0)
  #define KRD(G,j) do{ if(G){ kload2(kf,kp0+sl_next,j); SBAR(); } }while(0)
  #define STEP(C0,C1,P0,P1,t,GK,GV,GL) do{ SBAR(); \
    const lds_cptr vp_=vp0+sl_prev; \
    VRD(0); SBAR(); float sacc=(P0[0]+P0[1]); \
    GAPA(C0=__builtin_amdgcn_mfma_f32_32x32x16_bf16(kf[0],qr[0],negm,0,0,0), P0[2],P0[3],P0[4],P0[5],     pw0[0]=PKW(P0,0), pw0[1]=PKW(P0,2), pw0); \
    VRD(4); SBAR(); GAPA(C1=__builtin_amdgcn_mfma_f32_32x32x16_bf16(kf[1],qr[0],negm,0,0,0), P0[6],P0[7],P0[8],P0[9],     pw0[2]=PKW(P0,4), pw0[3]=PKW(P0,6), pw0); \
    VRD(1); SBAR(); GAPA(C0=__builtin_amdgcn_mfma_f32_32x32x16_bf16(kf[2],qr[1],C0,0,0,0),   P0[10],P0[11],P0[12],P0[13], pw1[0]=PKW(P0,8), pw1[1]=PKW(P0,10), pw1); \
    VRD(5); SBAR(); GAPA(C1=__builtin_amdgcn_mfma_f32_32x32x16_bf16(kf[3],qr[1],C1,0,0,0),   P0[14],P0[15],P1[0],P1[1],   pw1[2]=PKW(P0,12),pw1[3]=PKW(P0,14), pw1); \
    VRD(2); SBAR(); GAPA(C0=__builtin_amdgcn_mfma_f32_32x32x16_bf16(kf[4],qr[2],C0,0,0,0),   P1[2],P1[3],P1[4],P1[5],     pw2[0]=PKW(P1,0), pw2[1]=PKW(P1,2), pw2); \
    VRD(6); SBAR(); GAPA(C1=__builtin_amdgcn_mfma_f32_32x32x16_bf16(kf[5],qr[2],C1,0,0,0),   P1[6],P1[7],P1[8],P1[9],     pw2[2]=PKW(P1,4), pw2[3]=PKW(P1,6), pw2); \
    VRD(3); SBAR(); GAPA(C0=__builtin_amdgcn_mfma_f32_32x32x16_bf16(kf[6],qr[3],C0,0,0,0),   P1[10],P1[11],P1[12],P1[13], pw3[0]=PKW(P1,8), pw3[1]=PKW(P1,10), pw3); \
    VRD(7); SBAR(); GAPA(C1=__builtin_amdgcn_mfma_f32_32x32x16_bf16(kf[7],qr[3],C1,0,0,0),   P1[14],P1[15],0.f,0.f,       pw3[2]=PKW(P1,12),pw3[3]=PKW(P1,14), pw3); \
    l_reg+=sacc; \
    if(GK){DMA_K((t)+3,sl_cur);} if(GV){DMA_V((t)+1,sl_next);} \
    BIAS(C0,C1,t); CMASK(C0,C1,t); \
    { const int jb2_=2*((t)-(NT-4)); fcur=(jb2_>wid)?1.0f:ftp[(t)]; l_reg*=fcur; } \
    SBAR(); \
    GAPB(o[0]=__builtin_amdgcn_mfma_f32_32x32x16_bf16(PAF(0),VFR(0),o[0],0,0,0), C0,0); \
    GAPB(o[1]=__builtin_amdgcn_mfma_f32_32x32x16_bf16(PAF(0),VFR(4),o[1],0,0,0), C0,4); \
    KRD(GL,0); GAPB(o[0]=__builtin_amdgcn_mfma_f32_32x32x16_bf16(PAF(1),VFR(1),o[0],0,0,0), C0,8); \
    KRD(GL,1); GAPB(o[1]=__builtin_amdgcn_mfma_f32_32x32x16_bf16(PAF(1),VFR(5),o[1],0,0,0), C0,12); \
    KRD(GL,2); GAPB(o[0]=__builtin_amdgcn_mfma_f32_32x32x16_bf16(PAF(2),VFR(2),o[0],0,0,0), C1,0); \
    KRD(GL,3); GAPB(o[1]=__builtin_amdgcn_mfma_f32_32x32x16_bf16(PAF(2),VFR(6),o[1],0,0,0), C1,4); \
    GAPB(o[0]=__builtin_amdgcn_mfma_f32_32x32x16_bf16(PAF(3),VFR(3),o[0],0,0,0), C1,8); \
    GAPB(o[1]=__builtin_amdgcn_mfma_f32_32x32x16_bf16(PAF(3),VFR(7),o[1],0,0,0), C1,12); \
    }while(0)
  int t=1;
  #undef CMASK
  #define CMASK(P0,P1,t) do{}while(0)
  for(;t+5<NT;t+=2){
    STEP(pB0,pB1,pA0,pA1,t,true,true,true);     WAIT_BAR(2); RESC(); ROT();
    STEP(pA0,pA1,pB0,pB1,t+1,true,true,true);   WAIT_BAR(2); RESC(); ROT();
  }
  #undef CMASK
  int qrel_m=qrel,hi_m=hi; asm volatile("":"+v"(qrel_m),"+v"(hi_m));
  #define CMASK(P0,P1,t) do{int jb_=(t)-(NT-4); if(jb_>=0)cmask(P0,P1,jb_,qrel_m,hi_m);}while(0)
  #define ENDW(tt) do{ if((tt)+3<NT){WAIT_BAR(2);} else if((tt)+2<NT){WAIT_BAR(1);} else {WAIT_BAR(0);} }while(0)
  for(;t+1<NT;t+=2){
    STEP(pB0,pB1,pA0,pA1,t,(t+3<NT),(t+1<NT),(t+1<NT));       ENDW(t);   RESC(); ROT();
    STEP(pA0,pA1,pB0,pB1,t+1,(t+4<NT),(t+2<NT),(t+2<NT));     ENDW(t+1); RESC(); ROT();
  }
  STEP(pB0,pB1,pA0,pA1,NT-1,false,false,false); RESC();
  { float sacc=pB0[0]+pB0[1]; _Pragma("unroll") for(int r=2;r<16;++r)sacc+=pB0[r]; _Pragma("unroll") for(int r=0;r<16;++r)sacc+=pB1[r]; l_reg+=sacc;
    pw0=(u32x4){PKW(pB0,0),PKW(pB0,2),PKW(pB0,4),PKW(pB0,6)};pw1=(u32x4){PKW(pB0,8),PKW(pB0,10),PKW(pB0,12),PKW(pB0,14)};pw2=(u32x4){PKW(pB1,0),PKW(pB1,2),PKW(pB1,4),PKW(pB1,6)};pw3=(u32x4){PKW(pB1,8),PKW(pB1,10),PKW(pB1,12),PKW(pB1,14)};
    SBAR(); pv(o,vb0+sl_cur,PAF(0),PAF(1),PAF(2),PAF(3)); }
  #undef PKW
  #undef PAF
  #undef VFR
  #undef PIN
  #undef MX3
  #undef GAPA
  #undef GAPB
  #undef EX
  #undef VRD
  #undef KRD
  #undef STEP
  #undef ENDW
  {auto rr=__builtin_amdgcn_permlane32_swap(__float_as_uint(l_reg),__float_as_uint(l_reg),false,false);l_reg=__uint_as_float(rr[0])+__uint_as_float(rr[1]);}
  if(hi==0)wsf[32+r32]=l_reg;asm volatile("s_waitcnt lgkmcnt(0)":::"memory");
  float rli[16];
  #pragma unroll
  for(int r=0;r<16;++r)rli[r]=__builtin_amdgcn_rcpf(wsf[32+crow(r,hi)]);
  bf16*Ow=O+(rowbase+q0+wid*QBLK)*DM+h*D;
  { bf16*stg=(bf16*)(shm+LDS_OST)+wid*2048;
    { const bf16*Gw=Gt+(rowbase+q0+wid*QBLK)*DM+h*D; u32x4 gt4[4];
      #pragma unroll
      for(int i=0;i<4;++i){const int row=i*8+(lane>>3),ch=lane&7; gt4[i]=*(const u32x4*)(Gw+(long)row*DM+ch*8);}
      #pragma unroll
      for(int i=0;i<4;++i){const int row=i*8+(lane>>3),ch=lane&7; *(u32x4*)(stg+row*64+ch*8)=gt4[i];}
      asm volatile("s_waitcnt lgkmcnt(0)":::"memory"); }
    #pragma unroll
    for(int r=0;r<16;++r){const int orow=crow(r,hi);
      #pragma unroll
      for(int d0=0;d0<2;++d0){const float gv=__uint_as_float((unsigned)stg[orow*64+d0*32+r32]<<16); const float ov=o[d0][r]*rli[r]*gv; unsigned ub=__float_as_uint(ov); ub=(ub+0x7fffu+((ub>>16)&1u))>>16; stg[orow*64+d0*32+r32]=(bf16)ub;}}
    asm volatile("s_waitcnt lgkmcnt(0)":::"memory");
    #pragma unroll
    for(int i=0;i<4;++i){const int row=i*8+(lane>>3),ch=lane&7; const u32x4 v=*(const u32x4*)(stg+row*64+ch*8); ATTN_STORE16(Ow+(long)row*DM+ch*8,v);} }
  asm volatile("s_waitcnt lgkmcnt(0)\n\ts_barrier":::"memory");
  #undef DMA_K
  #undef DMA_V
  #undef CMASK
  #undef BIAS
  #undef LDSF4
  #undef START
  #undef RESC
  #undef ROT
}
constexpr int ATTN_LDS_BYTES=LDS_BYTES;
#undef SBAR
#undef WAIT_BAR
}

__device__ __forceinline__ void fox_attn2(const Params& P, char* shm, int tid, int bid, int G, unsigned short* Odst) {
    const int lane = tid & 63;
    unsigned short* Q = (unsigned short*)(P.ws + WS_ACT); const unsigned short* Kb = (const unsigned short*)(P.ws + WS_ACT + 32 * MiB); const unsigned short* V = (const unsigned short*)(P.ws + WS_ACT + 64 * MiB);
    const unsigned short* Gt = (const unsigned short*)(P.ws + WS_ACT + 96 * MiB);
    LAS float* nc = (LAS float*)((LAS char*)shm + attn_body::LDS_NC);
    LAS float* ft = (LAS float*)((LAS char*)shm + attn_body::LDS_FT);
    LAS float* re = (LAS float*)((LAS char*)shm + attn_body::LDS_RE);
    float gq = fabsf(P.fox_q_gain[lane]), gk = fabsf(P.fox_k_gain[lane]);
#pragma unroll
    for (int o = 1; o < 64; o <<= 1) { gq = fmaxf(gq, lane_perm(gq, lane ^ o)); gk = fmaxf(gk, lane_perm(gk, lane ^ o)); }
    const float Smax = 1.02f * (64.0f * gq * gk * 0.125f * LOG2E);
    const float T = 2.0f * Smax + 40.0f;
    const int vcu = (G % 8 == 0) ? (bid % 8) * (G / 8) + bid / 8 : bid;
    int last_bh = -1;
    for (int i = 0;; ++i) {
        int bh, qb;
        if (G == 256) { if (i >= 4) break; bh = vcu >> 2; const int s = vcu & 3; qb = (i == 0) ? s : (i == 1) ? 7 - s : (i == 2) ? 8 + s : 15 - s; }
        else { const int ui = i * G + bid; if (ui >= 1024) break; bh = ui >> 4; qb = ui & 15; }
        if (bh != last_bh) {
            const float* LF = (const float*)(P.ws + WS_S16) + ((size_t)(bh >> 4) * SEQ + 8 * tid) * 16 + (bh & 15);
            float v8[8]; float run = 0.f;
#pragma unroll
            for (int i2 = 0; i2 < 8; ++i2) { run += LF[(size_t)i2 * 16]; v8[i2] = run; }
            float inc = run;
#pragma unroll
            for (int o = 1; o < 64; o <<= 1) { const float tt = lane_perm(inc, (lane - o) & 63); if (lane >= o) inc += tt; }
            if (lane == 63) ft[tid >> 6] = inc;
            __syncthreads();
            float pre = inc - run;
            for (int w = 0; w < (tid >> 6); ++w) pre += ft[w];
            __syncthreads();
#pragma unroll
            for (int i2 = 0; i2 < 8; ++i2) nc[8 * tid + i2] = -(pre + v8[i2]) * LOG2E;
            __syncthreads();
            if (tid < 64) { const float e = nc[64 * tid + 63]; re[tid] = e; const float ep = (tid > 0) ? nc[64 * tid - 1] : e; ft[tid] = exp2f(ep - e); }
            __syncthreads();
#pragma unroll
            for (int i2 = 0; i2 < 8; ++i2) nc[8 * tid + i2] += -re[tid >> 3] - Smax + 40.0f;
            __syncthreads(); last_bh = bh;
        }
        const int ntf = 4 * qb + 4;
        const float thr = (qb > 0 ? re[4 * qb - 1] : 0.0f) - T;
        const bool pred = (lane < ntf) && (re[lane] < thr);
        int ts = __builtin_popcountll(__ballot(pred)) & ~1; ts = ts > ntf - 4 ? ntf - 4 : ts; ts = __builtin_amdgcn_readfirstlane(ts);
        int tid_u = tid; asm volatile("" : "+v"(tid_u));
        attn_body::attn_unit<8>(bh >> 4, bh & 15, qb, ts, Q, Kb, V, Gt, Odst ? Odst : Q, shm, tid_u);
    }
}

__device__ __forceinline__ void final_norm(const Params& P, const bf16_t* xin, int tid, int bid, int G) {
    const int lane = tid & 63, wave = tid >> 6;
    const int gw = bid * 8 + wave, NGW = G * 8;
    f32x4 g[4];
#pragma unroll
    for (int j = 0; j < 4; ++j) g[j] = *(const f32x4*)(P.final_g + 4 * lane + 256 * j);
    constexpr int RB = 4;
    for (int row0 = gw; row0 < MT; row0 += RB * NGW) {
        f32x4 v[RB][4];
#pragma unroll
        for (int rb = 0; rb < RB; ++rb) { const int row = row0 + rb * NGW < MT ? row0 + rb * NGW : row0; const u32x2* xr = (const u32x2*)(xin + (size_t)row * 1024) + lane;
#pragma unroll
            for (int j = 0; j < 4; ++j) v[rb][j] = unpk4(xr[64 * j]); }
#pragma unroll
        for (int rb = 0; rb < RB; ++rb) { const int row = row0 + rb * NGW; if (row >= MT) break;
            float ss = 0.f;
#pragma unroll
            for (int j = 0; j < 4; ++j) ss += (v[rb][j][0] * v[rb][j][0] + v[rb][j][1] * v[rb][j][1]) + (v[rb][j][2] * v[rb][j][2] + v[rb][j][3] * v[rb][j][3]);
            const float rstd = rsqrtf(wave_sum(ss) * (1.0f / 1024.0f) + EPS);
            f32x4* xw = (f32x4*)(P.out + (size_t)row * 1024) + lane;
#pragma unroll
            for (int j = 0; j < 4; ++j) xw[64 * j] = (v[rb][j] * rstd) * g[j];
        }
    }
}

#define XB_TMO      128
#define XB_XCNT(j)  (256  + 64 * (j))
#define XB_XSUB(j)  (1280 + 64 * (j))
#define XB_XGEN(j)  (2304 + 64 * (j))
#define XB_TOP      3328
#define XB_TOPGEN   3392
#define XCD_BAR_WORDS 3456
#define XB_SPIN_CAP (1u << 20)
__device__ __forceinline__ unsigned xb_ld(unsigned* p)              { return __hip_atomic_load(p, __ATOMIC_RELAXED, __HIP_MEMORY_SCOPE_AGENT); }
__device__ __forceinline__ unsigned xb_add(unsigned* p, unsigned v) { return __hip_atomic_fetch_add(p, v, __ATOMIC_RELAXED, __HIP_MEMORY_SCOPE_AGENT); }
__device__ __forceinline__ unsigned xb_xcc_id() { return (unsigned)__builtin_amdgcn_s_getreg((3 << 11) | 20) & 0xFu; }
#define XB_SPIN(cond, bar) do { unsigned _sp = 0; while (cond) { __builtin_amdgcn_s_sleep(1); \
    if ((++_sp & 255u) == 0u) { if (xb_ld(&(bar)[XB_TMO])) break; if (_sp > XB_SPIN_CAP) { atomicAdd(&(bar)[XB_TMO], 1u); break; } } } } while (0)
struct XcdBarrier { unsigned* bar; unsigned x; volatile LAS unsigned* st; int wave_s; };
__device__ __forceinline__ XcdBarrier xcd_barrier_post(unsigned* bar, volatile LAS unsigned* st, int wave_s) {
    XcdBarrier b; b.bar = bar; b.x = xb_xcc_id(); b.st = st; b.wave_s = wave_s;
    if (threadIdx.x == 0) (void)xb_add(&bar[XB_XCNT(b.x)], 1u);
    return b;
}
__device__ __forceinline__ void xcd_barrier_complete(unsigned* bar, unsigned x, unsigned& nloc, unsigned& nx) {
    const unsigned G = gridDim.x * gridDim.y * gridDim.z;
    asm volatile("" : "+s"(x));
    unsigned sum, cnt, mine, sp = 0u;
    for (;;) {
        sum = 0u; cnt = 0u; mine = 0u;
#pragma unroll
        for (unsigned j = 0; j < 16; ++j) { const unsigned c = xb_ld(&bar[XB_XCNT(j)]); sum += c; cnt += (c > 0u) ? 1u : 0u; mine = (j == x) ? c : mine; }
        if (sum == G) break;
        __builtin_amdgcn_s_sleep(1);
        if ((++sp & 255u) == 0u) { if (xb_ld(&bar[XB_TMO])) break; if (sp > XB_SPIN_CAP) { atomicAdd(&bar[XB_TMO], 1u); break; } }
    }
    nloc = mine > 0u ? mine : 1u; nx = cnt > 0u ? cnt : 1u;
}
__device__ __forceinline__ void xcd_barrier(const XcdBarrier& b) {
    asm volatile("s_waitcnt vmcnt(0)" ::: "memory");
    __syncthreads();
    if (threadIdx.x == 0) {
        unsigned* bar = b.bar;
        __builtin_amdgcn_s_waitcnt(0);
        unsigned nloc = b.st[0], nx = b.st[1];
        if (nloc == 0u) { xcd_barrier_complete(bar, b.x, nloc, nx); b.st[0] = nloc; b.st[1] = nx; }
        const unsigned old = xb_add(&bar[XB_XSUB(b.x)], 1u);
        const unsigned gen = old / nloc;
        if (old + 1u == (gen + 1u) * nloc) {
            __builtin_amdgcn_fence(__ATOMIC_RELEASE, "agent");
            asm volatile("s_waitcnt vmcnt(0)" ::: "memory");
            const unsigned og = xb_add(&bar[XB_TOP], 1u);
            const unsigned tg = og / nx;
            if (og + 1u == (tg + 1u) * nx) xb_add(&bar[XB_TOPGEN], 1u);
            else XB_SPIN(xb_ld(&bar[XB_TOPGEN]) == tg, bar);
            xb_add(&bar[XB_XGEN(b.x)], 1u);
            __builtin_amdgcn_fence(__ATOMIC_ACQUIRE, "agent");
            asm volatile("s_waitcnt vmcnt(0)" ::: "memory");
        } else {
            XB_SPIN(xb_ld(&bar[XB_XGEN(b.x)]) == gen, bar);
            __builtin_amdgcn_fence(__ATOMIC_ACQUIRE, "agent");
            asm volatile("s_waitcnt vmcnt(0)" ::: "memory");
        }
    }
    __syncthreads();
}

constexpr int LDS_BYTES = 147456;
#ifndef PROBE
#define PROBE 0
#endif
#define FRESH() int tid = threadIdx.x, bid = blockIdx.x; asm volatile("" : "+v"(tid)); asm volatile("" : "+s"(bid));
__global__ void __launch_bounds__(512, 2) trunk_fwd(Params P) {
    extern __shared__ __attribute__((aligned(16))) unsigned char lds_raw[];
    LAS unsigned char* lds = (LAS unsigned char*)lds_raw;
    cg::grid_group grid = cg::this_grid();
    const int G = gridDim.x;
    volatile LAS unsigned* MISC = (volatile LAS unsigned*)(lds + LDS_BYTES - 128);
    const int wave_s = __builtin_amdgcn_readfirstlane((int)threadIdx.x >> 6);
    if (threadIdx.x < 32) MISC[threadIdx.x] = 0u;
    __syncthreads();
    XcdBarrier xbar = xcd_barrier_post((unsigned*)P.ws, MISC + 8, wave_s);
    unsigned char* ws = P.ws;
    const float* MOD = (const float*)(ws + WS_MOD);
    bf16_t* XN = (bf16_t*)(ws + WS_XN);
    bf16_t* ACT = (bf16_t*)(ws + WS_ACT);
#define GSYNC() xcd_barrier(xbar)
    if (PROBE == 30) { { FRESH(); p0_mod(P, lds, tid, bid, G); } { FRESH(); p0_rope(P, tid, bid, G); } __syncthreads(); }
    if (PROBE == 31) { FRESH(); conv_weights(P.ret_w_in, RET_IN, 6144, P.ret_w_out, 2048, ws + WS_W, lds, tid, bid, G); __syncthreads(); }
    { FRESH(); p0_mod(P, lds, tid, bid, G); }
    { FRESH(); p0_rope(P, tid, bid, G); }
    { FRESH(); conv_weights(P.ret_w_in, RET_IN, 6144, P.ret_w_out, 2048, ws + WS_W, lds, tid, bid, G); }
    grid.sync();
#pragma unroll 1
    for (int layer = 0; layer < 4; ++layer) {
        const int kind = layer % 3, j = layer / 3;
        unsigned char* wbase = ws + ((kind == 2) ? WS_WGLA : WS_W);
        bf16_t* WinT = (bf16_t*)wbase; bf16_t* WoutT = (bf16_t*)(wbase + 12 * MiB);
        bf16_t* R0 = (bf16_t*)P.out; bf16_t* R1 = R0 + (size_t)MT * 1024;
        const void* xin = (layer == 0) ? (const void*)P.x : (layer == 2) ? (const void*)R1 : (const void*)R0;
        bf16_t* xout = (layer == 0 || layer == 2) ? R0 : (layer == 1) ? R1 : (bf16_t*)(ws + WS_ACT);
        if (layer > 0) {
            FRESH();
            if (kind == 0) { if (G != 256) conv_weights(P.ret_w_in + (size_t)j * 1024 * RET_IN, RET_IN, 6144, P.ret_w_out + (size_t)j * 2048 * 1024, 2048, ws + WS_W, lds, tid, bid, G); }
            else if (kind == 1) conv_weights(P.fox_w_in, FOX_IN, 4096, P.fox_w_out, 1024, ws + WS_W, lds, tid, bid, G);
            else conv_weights(P.gla_w_in, GLA_IN, 3072, P.gla_w_out, 1024, ws + WS_WGLA, lds, tid, bid, G);
            __syncthreads();
        }
        if (PROBE == 5 || (PROBE >= 50 && PROBE <= 53 && layer == PROBE - 50)) {
            if (layer == 0) { FRESH(); h_phase<0, true>(P, layer, xin, lds, tid, bid, G); }
            else if (kind == 0) { FRESH(); h_phase<0, false>(P, layer, xin, lds, tid, bid, G); }
            else if (kind == 1) { FRESH(); h_phase<1, false>(P, layer, xin, lds, tid, bid, G); }
            else { FRESH(); h_phase<2, false>(P, layer, xin, lds, tid, bid, G); }
            __syncthreads();
        }
        if (layer == 0) { FRESH(); h_phase<0, true>(P, layer, xin, lds, tid, bid, G); }
            else if (kind == 0) { FRESH(); h_phase<0, false>(P, layer, xin, lds, tid, bid, G); }
        else if (kind == 1) { FRESH(); h_phase<1, false>(P, layer, xin, lds, tid, bid, G); }
        else { FRESH(); h_phase<2, false>(P, layer, xin, lds, tid, bid, G); }
        GSYNC();
        const float* gate = MOD + (size_t)(layer * 4) * 3072 + 2048;
        if (kind == 0) {
            bf16_t* rQ = ACT; bf16_t* rK = (bf16_t*)(ws + WS_ACT + 32 * MiB); bf16_t* rV = (bf16_t*)(ws + WS_ACT + 64 * MiB); bf16_t* rO = (bf16_t*)(ws + WS_ACT + 128 * MiB);
            bf16_t* rP = WinT;
            float* STATS = (float*)(ws + WS_S16);
            {
                FRESH();
                pg8::Gemm g{XN, WinT, MT, 4096, 1024}; pg8::StaticOrder S; S.init(MT, 4096, G, bid);
                EpiRetIn E{rQ, rK, rV, (const unsigned*)(ws + WS_ROPE)};
                pg8::gemm_phase<EpiRetIn, pg8::StaticOrder, true, true>(lds, g, S, E, tid);
            }
            GSYNC();
            if (PROBE == 40) { FRESH();
                pg8::Gemm g{XN, WinT, MT, 4096, 1024}; pg8::StaticOrder S; S.init(MT, 4096, G, bid);
                EpiRetIn E{rQ, rK, rV, (const unsigned*)(ws + WS_ROPE)};
                pg8::gemm_phase<EpiRetIn, pg8::StaticOrder, true, true>(lds, g, S, E, tid); GSYNC(); }
            if (PROBE == 6) { FRESH();
                pg8::Gemm g{XN, WinT + (size_t)4096 * 1024, MT, 2048, 1024}; pg8::StaticOrder S; S.init(MT, 2048, G, bid);
                EpiSplit E{(bf16_t*)P.out, 8, 0, 2048, -1};
                if (layer == 0) { pg8::gemm_phase<EpiSplit, pg8::StaticOrder, true, true>(lds, g, S, E, tid); GSYNC(); } }
            if (PROBE == 62 && layer == 0) { FRESH();
                pg8::Gemm g{XN, WinT, MT, 4096, 1024}; pg8::StaticOrder S; S.init(MT, 4096, G, bid);
                EpiNone E{P.out};
                pg8::gemm_phase<EpiNone, pg8::StaticOrder, true, true>(lds, g, S, E, tid); GSYNC(); }
            if (PROBE == 60 && layer == 0) { FRESH();
                pg8::Gemm g{XN, WinT + (size_t)4096 * 1024, MT, 2048, 1024}; pg8::StaticOrder S; S.init(MT, 2048, G, bid);
                EpiNone E{P.out};
                pg8::gemm_phase<EpiNone, pg8::StaticOrder, true, true>(lds, g, S, E, tid); GSYNC(); }
            { FRESH(); lin_pphase<0>(rQ, rK, rQ, rK, rP, tid, bid, G); }
            GSYNC();
            if (PROBE == 2) { FRESH(); lin_scan<0>(rQ, rK, rV, rP, nullptr, rO, (float*)(ws + WS_CUM), lds, tid, bid, G); GSYNC(); }
            if (PROBE == 20 && layer == 0) { FRESH(); lin_scan<0, 1>(rQ, rK, rV, rP, nullptr, (bf16_t*)P.out, (float*)(ws + WS_CUM), lds, tid, bid, G); GSYNC(); }
            if (PROBE == 23 && layer == 0) { FRESH(); lin_scan<0, 4>(rQ, rK, rV, rP, nullptr, (bf16_t*)P.out, (float*)(ws + WS_CUM), lds, tid, bid, G); GSYNC(); }
            if (PROBE == 25 && layer == 0) { FRESH(); lin_scan<0, 16>(rQ, rK, rV, rP, nullptr, (bf16_t*)P.out, (float*)(ws + WS_CUM), lds, tid, bid, G); GSYNC(); }
            if (PROBE == 21 && layer == 0) { FRESH(); lin_scan<0, 2>(rQ, rK, rV, rP, nullptr, (bf16_t*)P.out, (float*)(ws + WS_CUM), lds, tid, bid, G); GSYNC(); }
            if (PROBE == 24 && layer == 0) { FRESH(); lin_scan<0, 8>(rQ, rK, rV, rP, nullptr, (bf16_t*)P.out, (float*)(ws + WS_CUM), lds, tid, bid, G); GSYNC(); }
            if (PROBE == 26 && layer == 0) { FRESH(); lin_scan<0, 3>(rQ, rK, rV, rP, nullptr, (bf16_t*)P.out, (float*)(ws + WS_CUM), lds, tid, bid, G); GSYNC(); }
            if (PROBE == 27 && layer == 0) { FRESH(); lin_scan<0, 11>(rQ, rK, rV, rP, nullptr, (bf16_t*)P.out, (float*)(ws + WS_CUM), lds, tid, bid, G); GSYNC(); }
            if (PROBE == 28 && layer == 0) { FRESH(); lin_scan<0, 31>(rQ, rK, rV, rP, nullptr, (bf16_t*)P.out, (float*)(ws + WS_CUM), lds, tid, bid, G); GSYNC(); }
            if (PROBE == 22 && layer == 0) { FRESH(); lin_scan<0, 0>(rQ, rK, rV, rP, nullptr, (bf16_t*)P.out, (float*)(ws + WS_CUM), lds, tid, bid, G); GSYNC(); }
            { FRESH(); lin_scan<0>(rQ, rK, rV, rP, nullptr, rO, (float*)(ws + WS_CUM), lds, tid, bid, G); }
            GSYNC();
            {
                FRESH();
                pg8::Gemm g{XN, WinT + (size_t)4096 * 1024, MT, 2048, 1024}; pg8::PairOrder S{G, (G % 8 == 0) ? (bid % 8) * (G / 8) + bid / 8 : bid};
                EpiGateNorm<0> E{rO, rV, (LAS float*)(lds + 131072)};
                pg8::gemm_phase<EpiGateNorm<0>, pg8::PairOrder, true, true>(lds, g, S, E, tid);
            }
            GSYNC();
            if (PROBE == 42 && layer == 0) { FRESH();
                pg8::Gemm g{rV, WoutT, MT, 1024, 2048}; pg8::StaticOrder S; S.init(MT, 1024, G, bid);
                EpiOut<true> E{xin, xout, gate};
                pg8::gemm_phase<EpiOut<true>, pg8::StaticOrder, true, true>(lds, g, S, E, tid); GSYNC(); }
            if (layer == 0) {
                FRESH();
                pg8::Gemm g{rV, WoutT, MT, 1024, 2048}; pg8::StaticOrder S; S.init(MT, 1024, G, bid);
                EpiOut<true> E{xin, xout, gate};
                pg8::gemm_phase<EpiOut<true>, pg8::StaticOrder, true, true>(lds, g, S, E, tid);
            } else {
                FRESH();
                pg8::Gemm g{rV, WoutT, MT, 1024, 2048}; pg8::StaticOrder S; S.init(MT, 1024, G, bid);
                EpiOut<false> E{xin, xout, gate};
                pg8::gemm_phase<EpiOut<false>, pg8::StaticOrder, true, true>(lds, g, S, E, tid);
            }
            GSYNC();
        } else if (kind == 1) {
            {
                FRESH();
                pg8::Gemm g{XN, WinT, MT, 4096, 1024}; pg8::StaticOrder S; S.init(MT, 4096, G, bid);
                EpiFoxIn E{ACT, P.fox_q_gain, P.fox_k_gain, (LAS float*)(lds + 131072)};
                pg8::gemm_phase<EpiFoxIn, pg8::StaticOrder, true, true>(lds, g, S, E, tid);
            }
            GSYNC();
            if (PROBE == 41) { FRESH();
                pg8::Gemm g{XN, WinT, MT, 4096, 1024}; pg8::StaticOrder S; S.init(MT, 4096, G, bid);
                EpiFoxIn E{ACT, P.fox_q_gain, P.fox_k_gain, (LAS float*)(lds + 131072)};
                pg8::gemm_phase<EpiFoxIn, pg8::StaticOrder, true, true>(lds, g, S, E, tid); GSYNC(); }
            if (PROBE == 1) { FRESH(); fox_attn2(P, (char*)lds_raw, tid, bid, G, XN); GSYNC(); }
            { FRESH(); fox_attn2(P, (char*)lds_raw, tid, bid, G, nullptr); }
            GSYNC();
            {
                FRESH();
                pg8::Gemm g{ACT, WoutT, MT, 1024, 1024}; pg8::StaticOrder S; S.init(MT, 1024, G, bid);
                EpiOut<false> E{xin, xout, gate};
                pg8::gemm_phase<EpiOut<false>, pg8::StaticOrder, true, true>(lds, g, S, E, tid);
            }
            GSYNC();
        } else {
            bf16_t* gQE = ACT; bf16_t* gQN = (bf16_t*)(ws + WS_ACT + 16 * MiB); bf16_t* gKE = (bf16_t*)(ws + WS_ACT + 32 * MiB); bf16_t* gKN = (bf16_t*)(ws + WS_ACT + 48 * MiB);
            bf16_t* gV = (bf16_t*)(ws + WS_ACT + 64 * MiB); bf16_t* gP = (bf16_t*)(ws + WS_ACT + 96 * MiB); bf16_t* gO = (bf16_t*)(ws + WS_ACT + 128 * MiB);
            const float* gCB = (const float*)(ws + WS_ACT + 160 * MiB);
            float* STATS = (float*)(ws + WS_S16);
            {
                FRESH();
                pg8::Gemm g{XN, WinT, MT, 2048, 1024}; pg8::StaticOrder S; S.init(MT, 2048, G, bid);
                EpiGlaIn E{gQE, gQN, gKE, gKN, gV, nullptr, gCB};
                pg8::gemm_phase<EpiGlaIn, pg8::StaticOrder, true, true>(lds, g, S, E, tid);
            }
            GSYNC();
            { FRESH(); lin_pphase<1>(gQE, gKN, gQN, gKE, gP, tid, bid, G); }
            GSYNC();
            if (PROBE == 3) { FRESH(); lin_scan<1>(gQE, gKN, gV, gP, gCB, gO, (float*)(ws + WS_CUM), lds, tid, bid, G); GSYNC(); }
            if (G == 256 && ((int)blockIdx.x >> 3) >= 16) {
                FRESH(); const int sub = (bid & 7) * 16 + ((bid >> 3) - 16);
                conv_weights(P.ret_w_in + (size_t)1 * 1024 * RET_IN, RET_IN, 6144, P.ret_w_out + (size_t)1 * 2048 * 1024, 2048, ws + WS_W, lds, tid, sub, 128);
            } else { FRESH(); lin_scan<1>(gQE, gKN, gV, gP, gCB, gO, (float*)(ws + WS_CUM), lds, tid, bid, G); }
            GSYNC();
            {
                FRESH();
                pg8::Gemm g{XN, WinT + (size_t)2048 * 1024, MT, 1024, 1024}; pg8::StaticOrder S; S.init(MT, 1024, G, bid);
                EpiGateNorm<1> E{gO, gV, (LAS float*)(lds + 131072)};
                pg8::gemm_phase<EpiGateNorm<1>, pg8::StaticOrder, true, true>(lds, g, S, E, tid);
            }
            GSYNC();
            {
                FRESH();
                pg8::Gemm g{gV, WoutT, MT, 1024, 1024}; pg8::StaticOrder S; S.init(MT, 1024, G, bid);
                EpiOut<false> E{xin, xout, gate};
                pg8::gemm_phase<EpiOut<false>, pg8::StaticOrder, true, true>(lds, g, S, E, tid);
            }
            GSYNC();
        }
    }
    if (PROBE == 70) { for (int i = 0; i < 10; ++i) GSYNC(); }
    { FRESH(); final_norm(P, (const bf16_t*)(ws + WS_ACT), tid, bid, G); }
}

extern "C" void kernel_launch(void* const* d_in, const int* in_sizes, int n_in, void* d_out, int out_size, void* d_ws, size_t ws_size, hipStream_t stream) {
    static int grid = 0;
    if (grid == 0) {
        if (n_in != 18 || out_size != MT * DM || ws_size < WS_END) { fprintf(stderr, "kernel_launch: unexpected shapes (n_in %d out %d ws %zu)\n", n_in, out_size, ws_size); grid = -1; return; }
        int dev = 0, cus = 0, per_cu = 0;
        hipGetDevice(&dev);
        hipDeviceGetAttribute(&cus, hipDeviceAttributeMultiprocessorCount, dev);
        hipFuncSetAttribute((const void*)trunk_fwd, hipFuncAttributeMaxDynamicSharedMemorySize, LDS_BYTES);
        hipOccupancyMaxActiveBlocksPerMultiprocessor(&per_cu, (const void*)trunk_fwd, 512, LDS_BYTES);
        if (per_cu < 1) { fprintf(stderr, "kernel_launch: occupancy query says %d blocks per CU\n", per_cu); per_cu = 1; }
        (void)hipGetLastError();
        grid = cus;
    }
    if (grid < 0) return;
    Params p{};
    p.x = (const float*)d_in[0]; p.c = (const float*)d_in[1]; p.pos = (const int*)d_in[2]; p.mod_w = (const float*)d_in[3]; p.mod_b = (const float*)d_in[4]; p.norm_g = (const float*)d_in[5];
    p.ret_w_in = (const float*)d_in[6]; p.ret_w_out = (const float*)d_in[7]; p.fox_w_in = (const float*)d_in[8]; p.fox_b_f = (const float*)d_in[9]; p.fox_q_gain = (const float*)d_in[10]; p.fox_k_gain = (const float*)d_in[11];
    p.fox_w_out = (const float*)d_in[12]; p.gla_w_in = (const float*)d_in[13]; p.gla_w_gate2 = (const float*)d_in[14]; p.gla_b_gate = (const float*)d_in[15]; p.gla_w_out = (const float*)d_in[16]; p.final_g = (const float*)d_in[17];
    p.out = (float*)d_out; p.ws = (unsigned char*)d_ws;
    if (hipMemsetAsync(d_ws, 0, 16384, stream) != hipSuccess) { fprintf(stderr, "kernel_launch: memset failed\n"); return; }
    void* args[] = {&p};
    hipError_t e = hipLaunchCooperativeKernel((const void*)trunk_fwd, dim3(grid), dim3(512), args, LDS_BYTES, stream);
    if (e != hipSuccess) fprintf(stderr, "cooperative launch failed: %s (grid %d)\n", hipGetErrorString(e), grid);
}
```

```cpp
#include <hip/hip_runtime.h>
#include <hip/hip_cooperative_groups.h>
#include <cstdio>
#include <cstdint>
#include <cmath>
namespace cg = cooperative_groups;

#define LAS __attribute__((address_space(3)))
typedef unsigned short bf16_t;
typedef short bf16x8 __attribute__((ext_vector_type(8)));
typedef float f32x4 __attribute__((ext_vector_type(4)));
typedef float f32x2 __attribute__((ext_vector_type(2)));
typedef unsigned u32x4 __attribute__((ext_vector_type(4)));
typedef unsigned u32x2 __attribute__((ext_vector_type(2)));

constexpr int DM = 1024, NB = 4, SEQ = 4096, MT = NB * SEQ;
constexpr float EPS = 1e-6f;
constexpr int RET_IN = 6144, FOX_IN = 4112, GLA_IN = 3088;
constexpr float LOG2E = 1.4426950408889634f;

constexpr size_t MiB = 1u << 20;
constexpr size_t WS_MOD = 1 * MiB;
constexpr size_t WS_S16 = 2 * MiB;
constexpr size_t WS_CUM = 3 * MiB;
constexpr size_t WS_ROPE = 4 * MiB;
constexpr size_t WS_W = 12 * MiB;
constexpr size_t WS_WOUT = WS_W + 12 * MiB;
constexpr size_t WS_WGLA = 164 * MiB;
constexpr size_t WS_XN = 28 * MiB;
constexpr size_t WS_ACT = 60 * MiB;
constexpr size_t WS_END = 252 * MiB;

__device__ __forceinline__ unsigned f2bf(float f) { unsigned u = __builtin_bit_cast(unsigned, f); return (u + 0x7fffu + ((u >> 16) & 1u)) >> 16; }
typedef float f32x2_hw __attribute__((ext_vector_type(2))); typedef __bf16 bf16x2_hw __attribute__((ext_vector_type(2)));
__device__ __forceinline__ unsigned pk2(float lo, float hi) { f32x2_hw v = {lo, hi}; bf16x2_hw b = __builtin_convertvector(v, bf16x2_hw); return __builtin_bit_cast(unsigned, b); }
__device__ __forceinline__ float bf2f(unsigned h) { return __builtin_bit_cast(float, h << 16); }
__device__ __forceinline__ u32x2 pk4(f32x4 v) { u32x2 r; r.x = pk2(v[0], v[1]); r.y = pk2(v[2], v[3]); return r; }
__device__ __forceinline__ f32x4 unpk4(u32x2 w) { f32x4 r; r[0] = bf2f(w.x & 0xffffu); r[1] = bf2f(w.x >> 16); r[2] = bf2f(w.y & 0xffffu); r[3] = bf2f(w.y >> 16); return r; }
__device__ __forceinline__ float silu_f(float v) { return v * __builtin_amdgcn_rcpf(1.0f + __expf(-v)); }
__device__ __forceinline__ f32x4 silu4(f32x4 v) {
    const f32x4 t = v * (-1.4426950408889634f); f32x4 e, r;
#pragma unroll
    for (int j = 0; j < 4; ++j) e[j] = __builtin_amdgcn_exp2f(t[j]);
    e = e + 1.0f;
#pragma unroll
    for (int j = 0; j < 4; ++j) r[j] = __builtin_amdgcn_rcpf(e[j]);
    return v * r;
}
__device__ __forceinline__ float logsig_f(float v) { return fminf(v, 0.0f) - __logf(1.0f + __expf(-fabsf(v))); }
template <int CTRL> __device__ __forceinline__ float dpp_mov(float v) { return __builtin_bit_cast(float, __builtin_amdgcn_update_dpp(0, __builtin_bit_cast(int, v), CTRL, 0xf, 0xf, true)); }
__device__ __forceinline__ float swap32_sum(float x, float y) { auto r = __builtin_amdgcn_permlane32_swap(__builtin_bit_cast(unsigned, x), __builtin_bit_cast(unsigned, y), false, false); const unsigned r0 = r[0], r1 = r[1]; return __builtin_bit_cast(float, r0) + __builtin_bit_cast(float, r1); }
__device__ __forceinline__ float swap16_sum(float x, float y) { auto r = __builtin_amdgcn_permlane16_swap(__builtin_bit_cast(unsigned, x), __builtin_bit_cast(unsigned, y), false, false); const unsigned r0 = r[0], r1 = r[1]; return __builtin_bit_cast(float, r0) + __builtin_bit_cast(float, r1); }
__device__ __forceinline__ float row_sum16(float v) {
    v += dpp_mov<0xB1>(v);
    v += dpp_mov<0x4E>(v);
    v += dpp_mov<0x141>(v);
    v += dpp_mov<0x140>(v);
    return v;
}
__device__ __forceinline__ float xsum_16_32(float v) { v = swap16_sum(v, v); return swap32_sum(v, v); }
__device__ __forceinline__ float lane_perm(float v, int src) { return __builtin_bit_cast(float, __builtin_amdgcn_ds_bpermute(src << 2, __builtin_bit_cast(int, v))); }
__device__ __forceinline__ float wave_sum(float v) { return xsum_16_32(row_sum16(v)); }
__device__ __forceinline__ float reduce_scatter16(const float (&a)[16], int lane) {
    float b8[8], c4[4], d2[2], e1;
#pragma unroll
    for (int i = 0; i < 8; ++i) b8[i] = swap32_sum(a[i], a[i + 8]);
#pragma unroll
    for (int i = 0; i < 4; ++i) c4[i] = swap16_sum(b8[i], b8[i + 4]);
    { const bool hi = (lane & 8) != 0;
#pragma unroll
      for (int i = 0; i < 2; ++i) { const float snd = hi ? c4[i] : c4[i + 2], kp = hi ? c4[i + 2] : c4[i]; d2[i] = kp + dpp_mov<0x128>(snd); } }
    { const bool hi = (lane & 4) != 0; const float snd = hi ? d2[0] : d2[1], kp = hi ? d2[1] : d2[0]; e1 = kp + dpp_mov<0x1B>(dpp_mov<0x141>(snd)); }
    e1 += dpp_mov<0x4E>(e1); e1 += dpp_mov<0xB1>(e1);
    return e1;
}
#define LDS_WAIT() asm volatile("s_waitcnt lgkmcnt(0)" ::: "memory")

__device__ __forceinline__ f32x4 mma_rc(f32x4 acc, bf16x8 a_rows, bf16x8 b_cols) { return __builtin_amdgcn_mfma_f32_16x16x32_bf16(b_cols, a_rows, acc, 0, 0, 0); }
__device__ __forceinline__ f32x4 mma_cr(f32x4 acc, bf16x8 a_rows, bf16x8 b_cols) { return __builtin_amdgcn_mfma_f32_16x16x32_bf16(a_rows, b_cols, acc, 0, 0, 0); }
__device__ __forceinline__ bf16x8 gfrag(const bf16_t* base, int pitch, int lane) { return *(const bf16x8*)(base + (size_t)(lane & 15) * pitch + 8 * (lane >> 4)); }
__device__ __forceinline__ bf16x8 lfrag(const LAS bf16_t* base, int pitch, int lane) { return *(const LAS bf16x8*)(base + (lane & 15) * pitch + 8 * (lane >> 4)); }

namespace pg8 {
#define PG8_LAS __attribute__((address_space(3)))
constexpr int BM = 256, BK = 64, HALF = 128, HTB = HALF * BK * 2, STAGE_BYTES = 8 * HTB, NXCD = 8, WGM = 8;
__host__ __device__ __forceinline__ int lds_byte(int r, int c) { const int st = (r >> 4) * 2 + (c >> 5), rr = r & 15, cc = c & 31, ob = rr * 64 + cc * 2; return st * 1024 + (ob ^ (((ob >> 9) & 1) << 5)); }
__host__ __device__ __forceinline__ void stage_rc(int b, int& R, int& C) { const int st = b / 1024, sb = b % 1024, swz = sb ^ (((sb >> 9) & 1) << 5); R = (st >> 1) * 16 + swz / 64; C = (st & 1) * 32 + (swz % 64) / 2; }
__host__ __device__ __forceinline__ int perm32(int rho) { const int n = rho >> 4, i = rho & 15; return 8 * (i >> 2) + 4 * n + (i & 3); }

struct Unit { int pm, pn; };
struct Gemm { const bf16_t* A; const bf16_t* Bt; int M, N, K; };
struct StaticOrder {
    int nM, nN, nwg, G, c;
    __host__ __device__ void init(int M, int N, int G_, int c_) { nM = M / BM; nN = N / BM; nwg = nM * nN; G = G_; c = c_; }
    __host__ __device__ bool next(int i, Unit& u) const {
        const long L = (long)i * G + c; if (L >= nwg) return false;
        int wgid = (int)L; { const int q = nwg / NXCD, r = nwg % NXCD, xcd = wgid % NXCD, off = wgid / NXCD; wgid = (xcd < r ? xcd * (q + 1) : r * (q + 1) + (xcd - r) * q) + off; }
        const int nig = WGM * nN, gid = wgid / nig, fm = gid * WGM, gsz = (nM - fm) < WGM ? (nM - fm) : WGM;
        u.pm = fm + ((wgid % nig) % gsz); u.pn = (wgid % nig) / gsz; return true;
    }
    __device__ __forceinline__ void a_ready(const Unit&) const {}
    __device__ __forceinline__ void done(const Unit&) const {}
};

struct PairOrder {
    int G, c;
    __device__ __forceinline__ bool next(int i, Unit& u) const { const int pair = (i >> 1) * G + c; if (pair >= 256) return false; u.pm = pair >> 2; u.pn = 2 * (pair & 3) + (i & 1); return true; }
    __device__ __forceinline__ void a_ready(const Unit&) const {}
    __device__ __forceinline__ void done(const Unit&) const {}
};
template <class Epi, class Sched, bool ALIGN_EPI = false, bool SP2 = false>
__device__ __forceinline__ void gemm_phase(PG8_LAS unsigned char* lds, const Gemm g, const Sched& S, const Epi& E, int tid) {
    const int wid = __builtin_amdgcn_readfirstlane(tid >> 6), lane = tid & 63, wr = wid >> 2, wc = wid & 3, fr = lane & 15, fq = lane >> 4;
    const int K = g.K, nt = K / BK;
    unsigned voffA[2], voffB[2];
#pragma unroll
    for (int i = 0; i < 2; ++i) { int R, C; stage_rc(tid * 16 + i * 8192, R, C); const int Rb = Epi::PERM ? ((R & ~31) + perm32(R & 31)) : R;
        voffA[i] = (unsigned)(R * K + C) * 2u; voffB[i] = (unsigned)(Rb * K + C) * 2u; }
    const size_t kstep = (size_t)(BK * 2);
    const size_t hstep = (size_t)HALF * K * 2;
    const size_t tstep = 2 * hstep;
    const unsigned ldsw = (unsigned)wid * 1024u;
    const int aoff = lds_byte(wr * 64 + fr, fq * 8), boff = lds_byte(wc * 32 + fr, fq * 8);
#define PG8_SA(b, h) (((b) * 2 + (h)) * HTB)
#define PG8_SB(b, h) ((4 + (b) * 2 + (h)) * HTB)
#define PG8_STAGE(bufoff, gbase, voff) do { _Pragma("unroll") for (int _i = 0; _i < 2; ++_i) \
        __builtin_amdgcn_global_load_lds((const unsigned*)((const char*)(gbase) + (voff)[_i]), (PG8_LAS unsigned*)(lds + (bufoff) + ldsw + _i * 8192), 16, 0, 0); } while (0)
#define PG8_LDA(dst, b, h) do { _Pragma("unroll") for (int m = 0; m < 4; ++m) _Pragma("unroll") for (int k = 0; k < 2; ++k) dst[m][k] = *(const PG8_LAS bf16x8*)(lds + PG8_SA(b, h) + aoff + m * 2048 + k * 1024); } while (0)
#define PG8_LDB(dst, b, h) do { _Pragma("unroll") for (int n = 0; n < 2; ++n) _Pragma("unroll") for (int k = 0; k < 2; ++k) dst[n][k] = *(const PG8_LAS bf16x8*)(lds + PG8_SB(b, h) + boff + n * 2048 + k * 1024); } while (0)
#define PG8_MMA(ai, bj, At, Bt) do { __builtin_amdgcn_s_setprio(1); _Pragma("unroll") for (int m = 0; m < 4; ++m) _Pragma("unroll") for (int n = 0; n < 2; ++n) _Pragma("unroll") for (int k = 0; k < 2; ++k) \
        acc[ai][bj][m][n] = __builtin_amdgcn_mfma_f32_16x16x32_bf16(Bt[n][k], At[m][k], acc[ai][bj][m][n], 0, 0, 0); __builtin_amdgcn_s_setprio(0); } while (0)
#define PG8_WAIT_V(n) asm volatile("s_waitcnt vmcnt(" #n ")" ::: "memory")
#define PG8_WAIT_L(n) asm volatile("s_waitcnt lgkmcnt(" #n ")" ::: "memory")
#define PG8_BAR __builtin_amdgcn_s_barrier()
#define PG8_SCHED __builtin_amdgcn_sched_barrier(0)
    Unit cur, nxt; int ui = 0;
    if (!S.next(0, cur)) return;
    f32x4 acc[2][2][4][2];
#pragma unroll
    for (int a = 0; a < 2; ++a)
#pragma unroll
        for (int b = 0; b < 2; ++b)
#pragma unroll
            for (int m = 0; m < 4; ++m)
#pragma unroll
                for (int n = 0; n < 2; ++n) acc[a][b][m][n] = (f32x4){0.f, 0.f, 0.f, 0.f};
    bf16x8 At[4][2], B0[2][2], B1[2][2];
    const char* cA = (const char*)g.A + (size_t)cur.pm * tstep; const char* cB = (const char*)g.Bt + (size_t)cur.pn * tstep;
    S.a_ready(cur);
    if constexpr (SP2) {
        PG8_STAGE(PG8_SB(0, 0), cB, voffB); PG8_STAGE(PG8_SB(0, 1), cB + hstep, voffB); PG8_STAGE(PG8_SA(0, 0), cA, voffA); PG8_STAGE(PG8_SA(0, 1), cA + hstep, voffA);
        if (wr == 1) PG8_BAR;
        PG8_WAIT_V(2); PG8_BAR;
        PG8_STAGE(PG8_SB(1, 0), cB + kstep, voffB); PG8_STAGE(PG8_SA(1, 0), cA + kstep, voffA); PG8_STAGE(PG8_SB(1, 1), cB + hstep + kstep, voffB);
        PG8_WAIT_V(6); PG8_BAR;
    } else {
        PG8_STAGE(PG8_SB(0, 0), cB, voffB); PG8_STAGE(PG8_SA(0, 0), cA, voffA); PG8_STAGE(PG8_SB(0, 1), cB + hstep, voffB); PG8_STAGE(PG8_SA(0, 1), cA + hstep, voffA);
        if (wr == 1) PG8_BAR;
        PG8_WAIT_V(4); PG8_BAR;
        PG8_STAGE(PG8_SB(1, 0), cB + kstep, voffB); PG8_STAGE(PG8_SA(1, 0), cA + kstep, voffA); PG8_STAGE(PG8_SB(1, 1), cB + hstep + kstep, voffB);
        PG8_WAIT_V(6); PG8_BAR;
    }
    for (;;) {
        const bool has_next = S.next(ui + 1, nxt);
        const char* nA = has_next ? (const char*)g.A + (size_t)nxt.pm * tstep : cA; const char* nB = has_next ? (const char*)g.Bt + (size_t)nxt.pn * tstep : cB;
        for (int t = 0; t < nt; t += 2) {
            const bool last = (t == nt - 2);
            const char* a1 = cA + (size_t)(t + 1) * kstep;
            const char* a2 = last ? nA : cA + (size_t)(t + 2) * kstep; const char* b2 = last ? nB : cB + (size_t)(t + 2) * kstep;
            const char* a3 = a2 + kstep; const char* b3 = b2 + kstep;
            if (last && has_next) S.a_ready(nxt);
            if constexpr (SP2) {
            PG8_LDB(B0, 0, 0); PG8_LDB(B1, 0, 1); PG8_SCHED; PG8_LDA(At, 0, 0); PG8_STAGE(PG8_SA(1, 1), a1 + hstep, voffA);
            PG8_WAIT_V(8); PG8_WAIT_L(0); PG8_BAR; PG8_MMA(0, 0, At, B0); PG8_MMA(0, 1, At, B1); PG8_BAR; PG8_SCHED;
            PG8_LDA(At, 0, 1); PG8_STAGE(PG8_SB(0, 0), b2, voffB); PG8_STAGE(PG8_SB(0, 1), b2 + hstep, voffB); PG8_STAGE(PG8_SA(0, 0), a2, voffA);
            PG8_WAIT_V(8); PG8_WAIT_L(0); PG8_BAR; PG8_MMA(1, 0, At, B0); PG8_MMA(1, 1, At, B1); PG8_BAR; PG8_SCHED;
            PG8_LDB(B0, 1, 0); PG8_LDB(B1, 1, 1); PG8_SCHED; PG8_LDA(At, 1, 0); PG8_STAGE(PG8_SA(0, 1), a2 + hstep, voffA);
            PG8_WAIT_V(8); PG8_WAIT_L(0); PG8_BAR; PG8_MMA(0, 0, At, B0); PG8_MMA(0, 1, At, B1); PG8_BAR; PG8_SCHED;
            PG8_LDA(At, 1, 1); PG8_STAGE(PG8_SB(1, 0), b3, voffB); PG8_STAGE(PG8_SB(1, 1), b3 + hstep, voffB); PG8_STAGE(PG8_SA(1, 0), a3, voffA);
            PG8_WAIT_V(8); PG8_WAIT_L(0); PG8_BAR; PG8_MMA(1, 0, At, B0); PG8_MMA(1, 1, At, B1); PG8_BAR; PG8_SCHED;
            } else {
            PG8_LDB(B0, 0, 0); PG8_SCHED; PG8_LDA(At, 0, 0); PG8_STAGE(PG8_SA(1, 1), a1 + hstep, voffA);
            PG8_WAIT_L(8); PG8_BAR; PG8_WAIT_L(0); PG8_MMA(0, 0, At, B0); PG8_BAR; PG8_SCHED;
            PG8_LDB(B1, 0, 1); PG8_STAGE(PG8_SB(0, 0), b2, voffB);
            PG8_BAR; PG8_WAIT_L(0); PG8_MMA(0, 1, At, B1); PG8_BAR;
            PG8_LDA(At, 0, 1); PG8_STAGE(PG8_SA(0, 0), a2, voffA);
            PG8_BAR; PG8_WAIT_L(0); PG8_MMA(1, 0, At, B0); PG8_BAR; PG8_SCHED;
            PG8_STAGE(PG8_SB(0, 1), b2 + hstep, voffB);
            PG8_WAIT_V(6); PG8_BAR; PG8_MMA(1, 1, At, B1); PG8_BAR;
            PG8_LDB(B0, 1, 0); PG8_SCHED; PG8_LDA(At, 1, 0); PG8_STAGE(PG8_SA(0, 1), a2 + hstep, voffA);
            PG8_WAIT_L(8); PG8_BAR; PG8_WAIT_L(0); PG8_MMA(0, 0, At, B0); PG8_BAR; PG8_SCHED;
            PG8_LDB(B1, 1, 1); PG8_STAGE(PG8_SB(1, 0), b3, voffB);
            PG8_BAR; PG8_WAIT_L(0); PG8_MMA(0, 1, At, B1); PG8_BAR;
            PG8_LDA(At, 1, 1); PG8_STAGE(PG8_SA(1, 0), a3, voffA);
            PG8_BAR; PG8_WAIT_L(0); PG8_MMA(1, 0, At, B0); PG8_BAR; PG8_SCHED;
            PG8_STAGE(PG8_SB(1, 1), b3 + hstep, voffB);
            PG8_WAIT_V(6); PG8_BAR; PG8_MMA(1, 1, At, B1); PG8_BAR;
            }
        }
        if constexpr (ALIGN_EPI) { if (wr == 0) PG8_BAR; }
        E(acc, cur, wr, wc, fr, fq); S.done(cur);
        if (!has_next) break;
#pragma unroll
        for (int a = 0; a < 2; ++a)
#pragma unroll
            for (int b = 0; b < 2; ++b)
#pragma unroll
                for (int m = 0; m < 4; ++m)
#pragma unroll
                    for (int n = 0; n < 2; ++n) acc[a][b][m][n] = (f32x4){0.f, 0.f, 0.f, 0.f};
        cur = nxt; cA = nA; cB = nB; ++ui;
        if constexpr (ALIGN_EPI) { if (wr == 1) PG8_BAR; }
    }
    PG8_WAIT_V(0);
    if constexpr (!ALIGN_EPI) { if (wr == 0) PG8_BAR; }
    PG8_BAR;
#undef PG8_SA
#undef PG8_SB
#undef PG8_STAGE
#undef PG8_LDA
#undef PG8_LDB
#undef PG8_MMA
#undef PG8_WAIT_V
#undef PG8_WAIT_L
#undef PG8_BAR
#undef PG8_SCHED
}
}

struct Params {
    const float* x; const float* c; const int* pos; const float* mod_w; const float* mod_b; const float* norm_g;
    const float* ret_w_in; const float* ret_w_out; const float* fox_w_in; const float* fox_b_f; const float* fox_q_gain; const float* fox_k_gain; const float* fox_w_out;
    const float* gla_w_in; const float* gla_w_gate2; const float* gla_b_gate; const float* gla_w_out; const float* final_g;
    float* out; unsigned char* ws;
};

template <int DK> __device__ __forceinline__ size_t frag_img_off(int row, int head, int ch0) {
    const int b = row >> 12, tok = row & 4095;
    return (size_t)((b * 4 + head) * 64 + (tok >> 6)) * (64 * DK * 2) + (size_t)((((ch0 >> 5) * 4 + ((tok >> 4) & 3)) * 64 + 16 * ((ch0 >> 3) & 3) + (tok & 15)) * 16 + 2 * (ch0 & 7));
}
template <int HV> __device__ __forceinline__ size_t v_img_off(int row, int col) {
    const int b = row >> 12, tok = row & 4095, head = col / HV, e = col % HV;
    return ((size_t)((b * 4 + head) * (HV / 32) + (e >> 5)) * 4096 + tok) * 64 + (size_t)((e & 31) * 2);
}
struct EpiRetIn {
    static constexpr bool PERM = true;
    bf16_t* Q; bf16_t* Kb; bf16_t* V; const unsigned* rope;
    __device__ __forceinline__ void operator()(const f32x4 (&acc)[2][2][4][2], const pg8::Unit& u, int wr, int wc, int fr, int fq) const {
        const int pn = u.pn;
        if (pn < 8) {
            bf16_t* dst = (pn < 4) ? Q : Kb; const int head = pn & 3; const float sc = (pn < 4) ? 0.0625f : 1.0f;
#pragma unroll
            for (int ai = 0; ai < 2; ++ai) {
                u32x4 cs[4][2];
#pragma unroll
                for (int m = 0; m < 4; ++m)
#pragma unroll
                    for (int n = 0; n < 2; ++n) cs[m][n] = *(const u32x4*)(rope + ((size_t)(((((u.pm * 256 + ai * 128 + wr * 64 + m * 16) >> 4) * 4 + wc) * 2 + n) * 64 + 16 * fq + fr) << 2));
                asm volatile("" ::: "memory");
#pragma unroll
                for (int m = 0; m < 4; ++m) {
                    const int row = u.pm * 256 + ai * 128 + wr * 64 + m * 16 + fr;
                    u32x4 w1, w2;
#pragma unroll
                    for (int n = 0; n < 2; ++n) {
                        const f32x4 x1 = acc[ai][0][m][n], x2 = acc[ai][1][m][n]; f32x4 co, si;
#pragma unroll
                        for (int j = 0; j < 4; ++j) {
                            const unsigned w = cs[m][n][j];
                            co[j] = (float)__builtin_bit_cast(_Float16, (unsigned short)(w & 0xffffu)); si[j] = (float)__builtin_bit_cast(_Float16, (unsigned short)(w >> 16));
                        }
                        co = co * sc; si = si * sc;
                        const f32x4 o1 = x1 * co - x2 * si, o2 = x1 * si + x2 * co;
                        const u32x2 a1 = pk4(o1), a2 = pk4(o2);
                        if (n == 0) { w1.x = a1.x; w1.y = a1.y; w2.x = a2.x; w2.y = a2.y; } else { w1.z = a1.x; w1.w = a1.y; w2.z = a2.x; w2.w = a2.y; }
                    }
                    char* p = (char*)dst + frag_img_off<256>(row, head, wc * 32 + fq * 8);
                    *(u32x4*)p = w1; *(u32x4*)(p + 16384) = w2;
                }
            }
        } else {
            const int cbase = (pn - 8) * 256;
#pragma unroll
            for (int ai = 0; ai < 2; ++ai)
#pragma unroll
                for (int m = 0; m < 4; ++m) {
                    const int row = u.pm * 256 + ai * 128 + wr * 64 + m * 16 + fr;
#pragma unroll
                    for (int bj = 0; bj < 2; ++bj) { const u32x2 a0 = pk4(acc[ai][bj][m][0]), a1 = pk4(acc[ai][bj][m][1]);
                        *(u32x4*)((char*)V + v_img_off<512>(row, cbase + bj * 128 + wc * 32 + fq * 8)) = (u32x4){a0.x, a0.y, a1.x, a1.y}; }
                }
        }
    }
};
struct EpiSplit {
    static constexpr bool PERM = false;
    bf16_t* dst; int tpg; size_t gstride; int ldc; int silu_grp;
    __device__ __forceinline__ void operator()(const f32x4 (&acc)[2][2][4][2], const pg8::Unit& u, int wr, int wc, int fr, int fq) const {
        const int t = u.pn / tpg; bf16_t* base = dst + (size_t)t * gstride; const int cb = (u.pn - t * tpg) * 256; const bool act = (t == silu_grp);
#pragma unroll
        for (int ai = 0; ai < 2; ++ai)
#pragma unroll
            for (int m = 0; m < 4; ++m) {
                const int row = u.pm * 256 + ai * 128 + wr * 64 + m * 16 + fr;
#pragma unroll
                for (int bj = 0; bj < 2; ++bj)
#pragma unroll
                    for (int n = 0; n < 2; ++n) {
                        f32x4 a = acc[ai][bj][m][n];
                        if (act) {
#pragma unroll
                            for (int j = 0; j < 4; ++j) a[j] = silu_f(a[j]);
                        }
                        *(u32x2*)(base + (size_t)row * ldc + cb + bj * 128 + wc * 32 + n * 16 + fq * 4) = pk4(a);
                    }
            }
    }
};
struct EpiFoxIn {
    static constexpr bool PERM = true;
    bf16_t* dst; const float* qgain; const float* kgain; LAS float* tbl;
    __device__ __forceinline__ void operator()(const f32x4 (&acc)[2][2][4][2], const pg8::Unit& u, int wr, int wc, int fr, int fq) const {
        const int t = u.pn >> 2; bf16_t* base = dst + (size_t)t * ((size_t)16 * MiB); const int cb = (u.pn & 3) * 256;
        const bool rowmajor = (t == 0) || (t == 3);
        const unsigned lanep = rowmajor ? (unsigned)(fr * 2048 + fq * 16) : (t == 1) ? (unsigned)(fr * 16 + fq * 1024) : (unsigned)(fr * 64 + fq * 16);
        const int mstr = rowmajor ? 16 * 2048 : (t == 1) ? 256 : 1024, bjstr = rowmajor ? 256 : 2 * 64 * 8192;
        size_t ub[2];
#pragma unroll
        for (int ai = 0; ai < 2; ++ai)
            ub[ai] = rowmajor ? (size_t)(u.pm * 256 + ai * 128 + wr * 64) * 2048 + (size_t)((cb + wc * 32) * 2)
                              : ((size_t)((u.pm >> 4) * 16 + (u.pn & 3) * 4 + (wc >> 1)) * 64 + ((u.pm * 4 + ai * 2 + wr) & 63)) * 8192 + (size_t)((wc & 1) * 4096);
        if (t < 2) {
#pragma unroll
            for (int ai = 0; ai < 2; ++ai)
#pragma unroll
                for (int m = 0; m < 4; ++m)
#pragma unroll
                    for (int bj = 0; bj < 2; ++bj) {
                        float sq = 0.f;
#pragma unroll
                        for (int n = 0; n < 2; ++n) { const f32x4 a = acc[ai][bj][m][n]; sq += (a[0] * a[0] + a[1] * a[1]) + (a[2] * a[2] + a[3] * a[3]); }
                        sq = xsum_16_32(sq);
                        if (fq == 0) tbl[(((ai * 128 + wr * 64 + m * 16 + fr) * 4) + bj * 2 + (wc >> 1)) * 2 + (wc & 1)] = sq;
                    }
            asm volatile("s_waitcnt lgkmcnt(0)" ::: "memory"); __builtin_amdgcn_s_barrier(); asm volatile("" ::: "memory");
            const float* gn = (t == 0) ? qgain : kgain; const float sc = (t == 0) ? (0.125f * LOG2E) : 1.0f;
            f32x4 gv[2];
#pragma unroll
            for (int n = 0; n < 2; ++n) gv[n] = *(const f32x4*)(gn + (wc & 1) * 32 + fq * 8 + n * 4) * sc;
#pragma unroll
            for (int ai = 0; ai < 2; ++ai)
#pragma unroll
                for (int m = 0; m < 4; ++m) {
                    const int rl = ai * 128 + wr * 64 + m * 16 + fr; const int row = u.pm * 256 + rl;
#pragma unroll
                    for (int bj = 0; bj < 2; ++bj) {
                        const f32x2 pr = *(const LAS f32x2*)(tbl + ((rl * 4) + bj * 2 + (wc >> 1)) * 2);
                        const float rstd = __builtin_amdgcn_rsqf((pr.x + pr.y) * (1.0f / 64.0f) + EPS);
                        const u32x2 q0 = pk4(acc[ai][bj][m][0] * rstd * gv[0]), q1 = pk4(acc[ai][bj][m][1] * rstd * gv[1]);
                        *(u32x4*)((char*)base + ub[ai] + (size_t)(m * mstr + bj * bjstr) + lanep) = (u32x4){q0.x, q0.y, q1.x, q1.y};
                    }
                }
        } else {
            const bool act = (t == 3);
#pragma unroll
            for (int ai = 0; ai < 2; ++ai)
#pragma unroll
                for (int m = 0; m < 4; ++m) {
                    const int row = u.pm * 256 + ai * 128 + wr * 64 + m * 16 + fr;
#pragma unroll
                    for (int bj = 0; bj < 2; ++bj) {
                        f32x4 a0 = acc[ai][bj][m][0], a1 = acc[ai][bj][m][1];
                        if (act) {
#pragma unroll
                            for (int j = 0; j < 1; ++j) { a0 = silu4(a0); a1 = silu4(a1); }
                        }
                        const u32x2 q0 = pk4(a0), q1 = pk4(a1);
                        *(u32x4*)((char*)base + ub[ai] + (size_t)(m * mstr + bj * bjstr) + lanep) = (u32x4){q0.x, q0.y, q1.x, q1.y};
                    }
                }
        }
    }
};
struct EpiGlaIn {
    static constexpr bool PERM = true;
    bf16_t *QE, *QN, *KE, *KN, *V, *G; const bf16_t* CB;
    __device__ __forceinline__ void operator()(const f32x4 (&acc)[2][2][4][2], const pg8::Unit& u, int wr, int wc, int fr, int fq) const {
        const int pn = u.pn;
        if (pn < 4) {
            const float s = (pn < 2) ? 0.08838834764831845f : 1.0f;
            bf16_t* De = (pn < 2 ? QE : KE); bf16_t* Dn = (pn < 2 ? QN : KN);
#pragma unroll
            for (int ai = 0; ai < 2; ++ai) {
                u32x4 cbw[4][2];
#pragma unroll
                for (int mm = 0; mm < 4; ++mm)
#pragma unroll
                    for (int bj = 0; bj < 2; ++bj) cbw[mm][bj] = *(const u32x4*)(CB + (size_t)(u.pm * 256 + ai * 128 + wr * 64 + mm * 16 + fr) * 512 + (pn & 1) * 256 + bj * 128 + wc * 32 + fq * 8);
                asm volatile("" ::: "memory");
#pragma unroll
                for (int mm = 0; mm < 4; ++mm) {
                    const int m = mm; const int row = u.pm * 256 + ai * 128 + wr * 64 + m * 16 + fr;
#pragma unroll
                    for (int bj = 0; bj < 2; ++bj) {
                        u32x4 we, wn;
#pragma unroll
                        for (int n = 0; n < 2; ++n) {
                            const f32x4 as = acc[ai][bj][m][n] * s;
                            const f32x4 cbl = unpk4(n == 0 ? (u32x2){cbw[mm][bj].x, cbw[mm][bj].y} : (u32x2){cbw[mm][bj].z, cbw[mm][bj].w}) * LOG2E;
                            f32x4 ee, re;
#pragma unroll
                            for (int j = 0; j < 4; ++j) { ee[j] = __builtin_amdgcn_exp2f(cbl[j]); re[j] = __builtin_amdgcn_rcpf(ee[j]); }
                            const f32x4 e = as * ee, en = as * re;
                            const u32x2 a1 = pk4(e), a2 = pk4(en);
                            if (n == 0) { we.x = a1.x; we.y = a1.y; wn.x = a2.x; wn.y = a2.y; } else { we.z = a1.x; we.w = a1.y; wn.z = a2.x; wn.w = a2.y; }
                        }
                        const size_t io = frag_img_off<128>(row, (pn & 1) * 2 + bj, wc * 32 + fq * 8);
                        *(u32x4*)((char*)De + io) = we; *(u32x4*)((char*)Dn + io) = wn;
                    }
                }
                asm volatile("" ::: "memory");
            }
        } else {
#pragma unroll
            for (int ai = 0; ai < 2; ++ai)
#pragma unroll
                for (int m = 0; m < 4; ++m) {
                    const int row = u.pm * 256 + ai * 128 + wr * 64 + m * 16 + fr;
#pragma unroll
                    for (int bj = 0; bj < 2; ++bj) { const u32x2 a0 = pk4(acc[ai][bj][m][0]), a1 = pk4(acc[ai][bj][m][1]);
                        *(u32x4*)((char*)V + v_img_off<256>(row, (pn - 4) * 256 + bj * 128 + wc * 32 + fq * 8)) = (u32x4){a0.x, a0.y, a1.x, a1.y}; }
                }
        }
    }
};
struct EpiNone {
    static constexpr bool PERM = false; float* sink;
    __device__ __forceinline__ void operator()(const f32x4 (&acc)[2][2][4][2], const pg8::Unit& u, int wr, int wc, int fr, int fq) const {
        f32x4 t = acc[0][0][0][0];
#pragma unroll
        for (int ai = 0; ai < 2; ++ai)
#pragma unroll
            for (int bj = 0; bj < 2; ++bj)
#pragma unroll
                for (int m = 0; m < 4; ++m)
#pragma unroll
                    for (int n = 0; n < 2; ++n) t += acc[ai][bj][m][n];
        if (t[0] + t[1] + t[2] + t[3] == 12345.678f) sink[0] = t[0];
    }
};
template <bool XF32> struct EpiOut {
    static constexpr bool PERM = true;
    const void* xold; bf16_t* xnew; const float* gate;
    __device__ __forceinline__ void operator()(const f32x4 (&acc)[2][2][4][2], const pg8::Unit& u, int wr, int wc, int fr, int fq) const {
        const int b = (u.pm * 256) >> 12;
        const int c0 = u.pn * 256 + wc * 32 + fq * 8;
        f32x4 gv[2][2];
#pragma unroll
        for (int bj = 0; bj < 2; ++bj)
#pragma unroll
            for (int n = 0; n < 2; ++n) gv[bj][n] = *(const f32x4*)(gate + (size_t)b * 3072 + c0 + bj * 128 + n * 4);
        constexpr int MB = XF32 ? 2 : 4;
#pragma unroll
        for (int ai = 0; ai < 2; ++ai)
#pragma unroll
            for (int mh = 0; mh < 4 / MB; ++mh) {
                u32x4 xr[MB][2][XF32 ? 2 : 1];
#pragma unroll
                for (int mm = 0; mm < MB; ++mm)
#pragma unroll
                    for (int bj = 0; bj < 2; ++bj) { const size_t o = (size_t)(u.pm * 256 + ai * 128 + wr * 64 + (MB * mh + mm) * 16 + fr) * 1024 + c0 + bj * 128;
                        if (XF32) { xr[mm][bj][0] = *(const u32x4*)((const float*)xold + o); xr[mm][bj][XF32 ? 1 : 0] = *(const u32x4*)((const float*)xold + o + 4); }
                        else xr[mm][bj][0] = *(const u32x4*)((const bf16_t*)xold + o); }
                asm volatile("" ::: "memory");
#pragma unroll
                for (int mm = 0; mm < MB; ++mm)
#pragma unroll
                    for (int bj = 0; bj < 2; ++bj) {
                        f32x4 x0, x1;
                        if (XF32) { x0 = __builtin_bit_cast(f32x4, xr[mm][bj][0]); x1 = __builtin_bit_cast(f32x4, xr[mm][bj][XF32 ? 1 : 0]); }
                        else { const u32x4 w = xr[mm][bj][0]; x0 = unpk4((u32x2){w.x, w.y}); x1 = unpk4((u32x2){w.z, w.w}); }
                        const u32x2 q0 = pk4(x0 + gv[bj][0] * acc[ai][bj][MB * mh + mm][0]), q1 = pk4(x1 + gv[bj][1] * acc[ai][bj][MB * mh + mm][1]);
                        *(u32x4*)(xnew + (size_t)(u.pm * 256 + ai * 128 + wr * 64 + (MB * mh + mm) * 16 + fr) * 1024 + c0 + bj * 128) = (u32x4){q0.x, q0.y, q1.x, q1.y};
                    }
                asm volatile("" ::: "memory");
            }
    }
};

__device__ __forceinline__ void transpose_item(const float* W, int ldw, int K, int nblk, bf16_t* WT, LAS float* scr, int item, int lane) {
    const int kb = item / nblk, nb = item % nblk, k0 = 64 * kb, n0 = 32 * nb;
    {
        f32x4 wv[8];
#pragma unroll
        for (int i = 0; i < 8; ++i) wv[i] = *(const f32x4*)(W + (size_t)(k0 + 8 * i + (lane >> 3)) * ldw + n0 + 4 * (lane & 7));
#pragma unroll
        for (int i = 0; i < 8; ++i) { LAS float* d = scr + (8 * i + (lane >> 3)) * 33 + 4 * (lane & 7); d[0] = wv[i][0]; d[1] = wv[i][1]; d[2] = wv[i][2]; d[3] = wv[i][3]; }
    }
    LDS_WAIT(); asm volatile("" ::: "memory");
    const int c = lane & 7;
#pragma unroll
    for (int j = 0; j < 4; ++j) { const int n = (lane >> 3) + 8 * j; const LAS float* s = scr + (8 * c) * 33 + n;
        u32x4 o; o.x = pk2(s[0 * 33], s[1 * 33]); o.y = pk2(s[2 * 33], s[3 * 33]); o.z = pk2(s[4 * 33], s[5 * 33]); o.w = pk2(s[6 * 33], s[7 * 33]);
        *(u32x4*)(WT + (size_t)(n0 + n) * K + k0 + 8 * c) = o; }
    LDS_WAIT(); asm volatile("" ::: "memory");
}
__device__ __forceinline__ void conv_weights(const float* w_in, int ld_in, int n_in, const float* w_out, int k_out, unsigned char* wdst, LAS unsigned char* lds, int tid, int bid, int G) {
    const int lane = tid & 63, wave = tid >> 6;
    LAS float* scr = (LAS float*)(lds + wave * 16384);
    const int gw = bid * 8 + wave, NGW = G * 8;
    const int I_in = (1024 / 64) * (n_in / 32), I_out = (k_out / 64) * (1024 / 32);
    bf16_t* WinT = (bf16_t*)wdst; bf16_t* WoutT = (bf16_t*)(wdst + 12 * MiB);
    for (int it = gw; it < I_in + I_out; it += NGW) {
        if (it < I_in) transpose_item(w_in, ld_in, 1024, n_in / 32, WinT, scr, it, lane);
        else transpose_item(w_out, 1024, k_out, 32, WoutT, scr, it - I_in, lane);
    }
}
__device__ __forceinline__ void p0_mod(const Params& P, LAS unsigned char* lds, int tid, int bid, int G) {
    LAS float* sc = (LAS float*)lds;
    LAS float* red = sc + 4096;
    const int lane = tid & 63, wave = tid >> 6;
    float* MOD = (float*)(P.ws + WS_MOD);
    for (int i = tid; i < 4096; i += 512) sc[i] = silu_f(P.c[i]);
    __syncthreads();
    for (int it = bid; it < 192; it += G) {
        const int l = it / 48, cb = it % 48, n = cb * 64 + lane;
        const int c16 = lane & 15, r4 = lane >> 4, k0 = wave * 128 + r4;
        const float* W = P.mod_w + (size_t)l * 1024 * 3072 + cb * 64 + 4 * c16;
        f32x4 a[4];
#pragma unroll
        for (int b = 0; b < 4; ++b) a[b] = (f32x4){0.f, 0.f, 0.f, 0.f};
#pragma unroll 16
        for (int i = 0; i < 32; ++i) { const int k = k0 + 4 * i; const f32x4 w = *(const f32x4*)(W + (size_t)k * 3072);
#pragma unroll
            for (int b = 0; b < 4; ++b) a[b] += w * sc[b * 1024 + k]; }
#pragma unroll
        for (int b = 0; b < 4; ++b)
#pragma unroll
            for (int e = 0; e < 4; ++e) a[b][e] = xsum_16_32(a[b][e]);
        if (r4 == 0) {
#pragma unroll
            for (int b = 0; b < 4; ++b) *(LAS f32x4*)(red + (wave * 4 + b) * 64 + 4 * c16) = a[b]; }
        __syncthreads();
        if (wave < 4) { float s = 0.f;
#pragma unroll
            for (int w = 0; w < 8; ++w) s += red[(w * 4 + wave) * 64 + lane];
            MOD[(size_t)(l * 4 + wave) * 3072 + n] = s + P.mod_b[l * 3072 + n]; }
        __syncthreads();
    }
}
__device__ __forceinline__ void p0_rope(const Params& P, int tid, int bid, int G) {
    unsigned* rope = (unsigned*)(P.ws + WS_ROPE);
    const int gt = bid * 512 + tid, NT = G * 512;
    for (int idx = gt; idx < MT * 128; idx += NT) {
        const int row = idx >> 7, d = idx & 127;
        const float inv = powf(10000.0f, -(float)d * (1.0f / 128.0f));
        const float ang = (float)P.pos[row] * inv;
        double t = (double)ang * 0.15915494309189535; t -= rint(t);
        const float fr = (float)t;
        const float co = __builtin_amdgcn_cosf(fr), si = __builtin_amdgcn_sinf(fr);
        const unsigned lo = __builtin_bit_cast(unsigned short, (_Float16)co), hi = __builtin_bit_cast(unsigned short, (_Float16)si);
        rope[(((((row >> 4) * 4 + (d >> 5)) * 2 + ((d >> 2) & 1)) * 64 + 16 * ((d >> 3) & 3) + (row & 15)) << 2) + (d & 3)] = lo | (hi << 16);
    }
}

template <int KIND, bool XF32>
__device__ __forceinline__ void h_phase(const Params& P, int layer, const void* xin, LAS unsigned char* lds, int tid, int bid, int G) {
    const int lane = tid & 63, wave = tid >> 6;
    LAS float* WxT = (LAS float*)lds;
    LAS float* W2 = (LAS float*)(lds + 65536);
    LAS float* TOT = (LAS float*)(lds + 98304);
    const float* MOD = (const float*)(P.ws + WS_MOD);
    bf16_t* XN = (bf16_t*)(P.ws + WS_XN);
    if (KIND > 0) {
        const float* wsrc = (KIND == 1) ? (P.fox_w_in + 4096) : (P.gla_w_in + 3072); const int ldw = (KIND == 1) ? FOX_IN : GLA_IN;
        {
            float wv[32];
#pragma unroll
            for (int it = 0; it < 32; ++it) { const int idx = tid + 512 * it; wv[it] = wsrc[(size_t)(idx >> 4) * ldw + (idx & 15)]; }
#pragma unroll
            for (int it = 0; it < 32; ++it) { const int idx = tid + 512 * it; WxT[(idx & 15) * 1024 + (idx >> 4)] = wv[it]; }
        }
        if (KIND == 2) {
            float w2v[16];
#pragma unroll
            for (int it = 0; it < 16; ++it) w2v[it] = P.gla_w_gate2[tid + 512 * it];
#pragma unroll
            for (int it = 0; it < 16; ++it) W2[tid + 512 * it] = w2v[it];
        }
        __syncthreads();
    }
    for (int ci = bid; ci < MT / 64; ci += G) {
        const int b = ci >> 6;
        if (KIND != 1) ((float*)(P.ws + WS_S16))[ci * 512 + tid] = 0.f;
        const float* mod = MOD + (size_t)(layer * 4 + b) * 3072;
        f32x4 ga[4], sh[4];
#pragma unroll
        for (int j = 0; j < 4; ++j) { const int col = 4 * lane + 256 * j;
            const f32x4 g4 = *(const f32x4*)(P.norm_g + layer * 1024 + col), s4 = *(const f32x4*)(mod + 1024 + col);
            ga[j] = g4 * (s4 + 1.0f); sh[j] = *(const f32x4*)(mod + col); }
        float run[8]; f32x4 cbv[8][2];
        if (KIND == 2) {
#pragma unroll
            for (int c = 0; c < 8; ++c) run[c] = 0.f;
        }
        if constexpr (false) {
        constexpr int BS = (KIND == 2) ? 2 : 4;
#pragma unroll (KIND == 2 ? 8 / BS : 1)
        for (int rb = 0; rb < 8; rb += BS) {
            asm volatile("" ::: "memory");
            f32x4 xv[BS][4];
#pragma unroll
            for (int bb = 0; bb < BS; ++bb) { const size_t ro = (size_t)(ci * 64 + wave * 8 + rb + bb) * 1024;
                if (XF32) { const f32x4* xr = (const f32x4*)((const float*)xin + ro) + lane;
#pragma unroll
                    for (int j = 0; j < 4; ++j) xv[bb][j] = xr[64 * j]; }
                else { const u32x2* xr = (const u32x2*)((const bf16_t*)xin + ro) + lane;
#pragma unroll
                    for (int j = 0; j < 4; ++j) xv[bb][j] = unpk4(xr[64 * j]); } }
#pragma unroll
        for (int bb = 0; bb < BS; ++bb) {
            const int rr = rb + bb;
            asm volatile("" ::: "memory");
            const int row = ci * 64 + wave * 8 + rr;
            f32x4 v[4]; float ss = 0.f;
#pragma unroll
            for (int j = 0; j < 4; ++j) { v[j] = xv[bb][j]; ss += (v[j][0] * v[j][0] + v[j][1] * v[j][1]) + (v[j][2] * v[j][2] + v[j][3] * v[j][3]); }
            const float rstd = rsqrtf(wave_sum(ss) * (1.0f / 1024.0f) + EPS);
#pragma unroll
            for (int j = 0; j < 4; ++j) { v[j] = (v[j] * rstd) * ga[j] + sh[j]; *(u32x2*)(XN + (size_t)row * 1024 + 4 * lane + 256 * j) = pk4(v[j]); }
            if (KIND > 0) {
                float r[16];
#pragma unroll
                for (int i = 0; i < 16; ++i) { float a = 0.f;
#pragma unroll
                    for (int j = 0; j < 4; ++j) { const f32x4 w = *(const LAS f32x4*)(WxT + i * 1024 + 4 * lane + 256 * j); a += (v[j][0] * w[0] + v[j][1] * w[1]) + (v[j][2] * w[2] + v[j][3] * w[3]); }
                    r[i] = a; }
                if (KIND == 1) {
                    const float e1 = reduce_scatter16(r, lane);
                    const int idx = ((lane >> 5) & 1) * 8 + ((lane >> 4) & 1) * 4 + ((lane >> 3) & 1) * 2 + ((lane >> 2) & 1);
                    if ((lane & 3) == 0) ((float*)(P.ws + WS_S16))[(size_t)row * 16 + idx] = logsig_f(e1 + P.fox_b_f[idx]);
                } else {
                    f32x4 z0 = *(const f32x4*)(P.gla_b_gate + 8 * lane), z1 = *(const f32x4*)(P.gla_b_gate + 8 * lane + 4);
#pragma unroll
                    for (int i = 0; i < 16; ++i) { const f32x4 w0 = *(const LAS f32x4*)(W2 + i * 512 + 8 * lane), w1 = *(const LAS f32x4*)(W2 + i * 512 + 8 * lane + 4); z0 += w0 * r[i]; z1 += w1 * r[i]; }
#pragma unroll
                    for (int c = 0; c < 4; ++c) { run[c] += logsig_f(z0[c]) * 0.0625f; run[4 + c] += logsig_f(z1[c]) * 0.0625f; }
                    cbv[rr][0] = (f32x4){run[0], run[1], run[2], run[3]}; cbv[rr][1] = (f32x4){run[4], run[5], run[6], run[7]};
                }
            }
        }
        }
        } else {
        constexpr int BS = (KIND == 2) ? 2 : (KIND == 0) ? 8 : 4;
#pragma unroll (KIND != 0 ? 8 / BS : 1)
        for (int rb = 0; rb < 8; rb += BS) {
            asm volatile("" ::: "memory");
            f32x4 v[BS][4];
#pragma unroll
            for (int bb = 0; bb < BS; ++bb) { const size_t ro = (size_t)(ci * 64 + wave * 8 + rb + bb) * 1024;
                if (XF32) { const f32x4* xr = (const f32x4*)((const float*)xin + ro) + lane;
#pragma unroll
                    for (int j = 0; j < 4; ++j) v[bb][j] = xr[64 * j]; }
                else { const u32x2* xr = (const u32x2*)((const bf16_t*)xin + ro) + lane;
#pragma unroll
                    for (int j = 0; j < 4; ++j) v[bb][j] = unpk4(xr[64 * j]); } }
#pragma unroll
            for (int bb = 0; bb < BS; ++bb) {
                const int row = ci * 64 + wave * 8 + rb + bb; float ss = 0.f;
#pragma unroll
                for (int j = 0; j < 4; ++j) ss += (v[bb][j][0] * v[bb][j][0] + v[bb][j][1] * v[bb][j][1]) + (v[bb][j][2] * v[bb][j][2] + v[bb][j][3] * v[bb][j][3]);
                const float rstd = rsqrtf(wave_sum(ss) * (1.0f / 1024.0f) + EPS);
#pragma unroll
                for (int j = 0; j < 4; ++j) { v[bb][j] = (v[bb][j] * rstd) * ga[j] + sh[j]; *(u32x2*)(XN + (size_t)row * 1024 + 4 * lane + 256 * j) = pk4(v[bb][j]); }
            }
            if (KIND > 0) {
                float acc[BS][16];
#pragma unroll
                for (int i = 0; i < 16; ++i) {
                    f32x4 w[4];
#pragma unroll
                    for (int j = 0; j < 4; ++j) w[j] = *(const LAS f32x4*)(WxT + i * 1024 + 4 * lane + 256 * j);
#pragma unroll
                    for (int bb = 0; bb < BS; ++bb) { f32x4 t = v[bb][0] * w[0];
#pragma unroll
                        for (int j = 1; j < 4; ++j) t = v[bb][j] * w[j] + t;
                        acc[bb][i] = (t[0] + t[1]) + (t[2] + t[3]); }
                    if (i & 1) { __builtin_amdgcn_sched_barrier(0); asm volatile("" ::: "memory"); }
                }
#pragma unroll
                for (int bb = 0; bb < BS; ++bb) {
                    const int rr = rb + bb, row = ci * 64 + wave * 8 + rr;
                    asm volatile("" ::: "memory");
                    const float e1 = reduce_scatter16(acc[bb], lane);
                    if (KIND == 1) {
                        const int idx = ((lane >> 5) & 1) * 8 + ((lane >> 4) & 1) * 4 + ((lane >> 3) & 1) * 2 + ((lane >> 2) & 1);
                        ((float*)(P.ws + WS_S16))[(size_t)row * 16 + idx] = logsig_f(e1 + P.fox_b_f[idx]);
                    } else {
                        float r[16];
#pragma unroll
                        for (int i = 0; i < 16; ++i) r[i] = __builtin_bit_cast(float, __builtin_amdgcn_readlane(__builtin_bit_cast(int, e1), ((i >> 3) & 1) * 32 + ((i >> 2) & 1) * 16 + ((i >> 1) & 1) * 8 + (i & 1) * 4));
                        f32x4 z0 = *(const f32x4*)(P.gla_b_gate + 8 * lane), z1 = *(const f32x4*)(P.gla_b_gate + 8 * lane + 4);
#pragma unroll
                        for (int i = 0; i < 16; ++i) { const f32x4 w0 = *(const LAS f32x4*)(W2 + i * 512 + 8 * lane), w1 = *(const LAS f32x4*)(W2 + i * 512 + 8 * lane + 4); z0 += w0 * r[i]; z1 += w1 * r[i]; }
#pragma unroll
                        for (int c = 0; c < 4; ++c) { run[c] += logsig_f(z0[c]) * 0.0625f; run[4 + c] += logsig_f(z1[c]) * 0.0625f; }
                        cbv[rr][0] = (f32x4){run[0], run[1], run[2], run[3]}; cbv[rr][1] = (f32x4){run[4], run[5], run[6], run[7]};
                    }
                }
            }
        }
        }
        if (KIND == 2) {
            bf16_t* CB = (bf16_t*)(P.ws + WS_ACT + 160 * MiB);
            *(LAS f32x4*)(TOT + wave * 512 + 8 * lane) = (f32x4){run[0], run[1], run[2], run[3]};
            *(LAS f32x4*)(TOT + wave * 512 + 8 * lane + 4) = (f32x4){run[4], run[5], run[6], run[7]};
            __syncthreads();
            f32x4 o0 = (f32x4){0.f, 0.f, 0.f, 0.f}, o1 = o0;
            for (int w = 0; w < wave; ++w) { o0 += *(const LAS f32x4*)(TOT + w * 512 + 8 * lane); o1 += *(const LAS f32x4*)(TOT + w * 512 + 8 * lane + 4); }
#pragma unroll
            for (int rr = 0; rr < 8; ++rr) { const int row = ci * 64 + wave * 8 + rr;
                const u32x2 c0 = pk4(cbv[rr][0] + o0), c1 = pk4(cbv[rr][1] + o1); *(u32x4*)(CB + (size_t)row * 512 + 8 * lane) = (u32x4){c0.x, c0.y, c1.x, c1.y}; }
            __syncthreads();
        }
    }
}

template <int KIND> struct LinCfg {
    static constexpr int DK = KIND == 0 ? 256 : 128, QP = KIND == 0 ? 1024 : 512, VP = KIND == 0 ? 2048 : 1024, HV = KIND == 0 ? 512 : 256;
    static constexpr int NSL = HV / 32, NITEM = 16 * NSL, NKF = DK / 32, RW = DK / 8, NDT = RW / 16, KPITCH = DK * 2 + 32, STP = DK + 8, KCH = DK / 64;
    static constexpr int LDS_ST = 0, LDS_P = 2 * 32 * STP * 2, LDS_V = LDS_P + 2 * 8192, LDS_END = LDS_V + 2 * 2 * 4096;
    static constexpr int NA = DK / 16;
};
__device__ __forceinline__ float ret_log2g(int h) { return (h == 0) ? -0.045803689613124796f : (h == 1) ? -0.02272007650008353f : (h == 2) ? -0.011315313227834146f : -0.005646563141142062f; }

template <int KIND>
__device__ __forceinline__ void lin_pphase(const bf16_t* Qa, bf16_t* Ka, const bf16_t* Qb, const bf16_t* Kb2, bf16_t* Pimg, int tid, int bid, int G) {
    typedef LinCfg<KIND> C;
    const int lane = tid & 63, wave = __builtin_amdgcn_readfirstlane(tid >> 6);
    const int g4 = lane >> 4, i16 = lane & 15;
    bf16x8 idf[2];
#pragma unroll
    for (int sel = 0; sel < 2; ++sel)
#pragma unroll
        for (int j = 0; j < 8; ++j) idf[sel][j] = (short)((8 * g4 + j == i16 + 16 * sel) ? 0x3F80 : 0);
    for (int hw0 = bid * 8; hw0 < 2048; hw0 += G * 8) {
        const int hw = hw0 + wave;
        const int item = hw >> 1, half = hw & 1;
        const int bh = item >> 6, n = item & 63, b = bh >> 2, h = bh & 3;
        const size_t t0 = (size_t)b * SEQ + (size_t)n * 64;
        f32x4 pa[2][4], pb[2][4];
#pragma unroll
        for (int r = 0; r < 2; ++r)
#pragma unroll
            for (int c = 0; c < 4; ++c) { pa[r][c] = (f32x4){0.f, 0.f, 0.f, 0.f}; pb[r][c] = (f32x4){0.f, 0.f, 0.f, 0.f}; }
        constexpr size_t BLK = (size_t)64 * C::DK * 2;
        const char* qa = (const char*)Qa + (size_t)item * BLK + lane * 16; char* ka = (char*)Ka + (size_t)item * BLK + lane * 16;
        const char* qb = (const char*)Qb + (size_t)item * BLK + lane * 16; const char* kb = (const char*)Kb2 + (size_t)item * BLK + lane * 16;
        bf16x8 kall[C::NKF][4];
#pragma unroll
        for (int k = 0; k < C::NKF; ++k)
#pragma unroll
            for (int c = 0; c < 4; ++c) kall[k][c] = *(const bf16x8*)(ka + (k * 4 + c) * 1024);
#pragma unroll
        for (int k = 0; k < C::NKF; ++k) {
            bf16x8 af[2];
#pragma unroll
            for (int r = 0; r < 2; ++r) af[r] = *(const bf16x8*)(qa + (k * 4 + 2 * half + r) * 1024);
#pragma unroll
            for (int r = 0; r < 2; ++r)
#pragma unroll
                for (int c = 0; c < 4; ++c) pa[r][c] = mma_rc(pa[r][c], af[r], kall[k][c]);
            if (KIND == 1) {
                bf16x8 bfr[4];
#pragma unroll
                for (int r = 0; r < 2; ++r) af[r] = *(const bf16x8*)(qb + (k * 4 + 2 * half + r) * 1024);
#pragma unroll
                for (int c = 0; c < 4; ++c) bfr[c] = *(const bf16x8*)(kb + (k * 4 + c) * 1024);
#pragma unroll
                for (int r = 0; r < 2; ++r)
#pragma unroll
                    for (int c = 0; c < 4; ++c) pb[r][c] = mma_rc(pb[r][c], af[r], bfr[c]);
            }
        }
        const float l2g = (KIND == 0) ? ret_log2g(h) : 0.f;
#pragma unroll
        for (int r = 0; r < 2; ++r) {
            const int c = 32 * half + 16 * r + (lane & 15);
#pragma unroll
            for (int ct = 0; ct < 4; ++ct) {
                f32x4 p;
#pragma unroll
                for (int e = 0; e < 4; ++e) { const int mm = 16 * ct + 4 * g4 + e;
                    if (KIND == 0) { const int dd = c > mm ? c - mm : mm - c; p[e] = pa[r][ct][e] * exp2f(l2g * (float)dd); }
                    else p[e] = (c >= mm) ? pa[r][ct][e] : pb[r][ct][e]; }
                const int ks = ct >> 1, gg = 2 * (ct & 1) + (g4 & 1);
                const int off = c * 128 + (((4 * ks + gg) ^ (c & 7)) << 4) + 8 * (g4 >> 1);
                *(u32x2*)((char*)Pimg + (size_t)item * 8192 + off) = pk4(p);
            }
        }
        __syncthreads();
        {
            char* kdst = ka - lane * 16 + (16 * (g4 & 1) + i16) * 16 + 8 * (g4 >> 1);
#define PP_TR(HALF) _Pragma("unroll") for (int k = 0; k < C::NKF; ++k) _Pragma("unroll") for (int sel = 0; sel < 2; ++sel) _Pragma("unroll") for (int T = 0; T < 2; ++T) { \
                const f32x4 tr_ = mma_rc((f32x4){0.f, 0.f, 0.f, 0.f}, idf[sel], kall[k][2 * (HALF) + T]); \
                *(u32x2*)(kdst + ((HALF) * C::NA + 2 * k + sel) * 1024 + T * 512) = pk4(tr_); }
            if (half == 0) { PP_TR(0) } else { PP_TR(1) }
#undef PP_TR
        }
    }
}

typedef short v4i16_t __attribute__((ext_vector_type(4)));
__device__ __forceinline__ bf16x8 trfrag2(const LAS char* p0, int second_off) {
    const v4i16_t a = __builtin_amdgcn_ds_read_tr16_b64_v4i16((LAS v4i16_t*)p0);
    const v4i16_t b = __builtin_amdgcn_ds_read_tr16_b64_v4i16((LAS v4i16_t*)(p0 + second_off));
    return (bf16x8){a[0], a[1], a[2], a[3], b[0], b[1], b[2], b[3]};
}

template <int KIND> struct LsStage { u32x4 x[LinCfg<KIND>::NKF]; u32x4 p; u32x2 v; u32x2 dec[2]; };

template <int KIND, int VAR = 0>
__device__ __forceinline__ void lin_scan(const bf16_t* Qg, const bf16_t* Kg, const bf16_t* Vg, const bf16_t* Pimg, const bf16_t* CB, bf16_t* O, float* DUMMY, LAS unsigned char* lds, int tid, int bid, int G) {
    typedef LinCfg<KIND> C;
    const int nit = (G == 256) ? 1 : (C::NITEM + G - 1) / G;
    const int tid0 = tid;
    for (int it = 0; it < nit; ++it) {
        int tid = tid0; asm volatile("" : "+v"(tid));
        const int lane = tid & 63, wave = __builtin_amdgcn_readfirstlane(tid >> 6);
        const int g4 = lane >> 4, i16 = lane & 15, q4 = i16 >> 2, p4 = i16 & 3;
        int item;
        if (G == 256) { const int x = bid & 7, j = bid >> 3; if (KIND == 0) item = x * 32 + j; else { if (j >= 16) break; item = x * 16 + j; } }
        else { item = it * G + bid; if (item >= C::NITEM) break; }
        const int bh = item / C::NSL, dvs = item % C::NSL, b = bh >> 2, h = bh & 3;
        const size_t t0 = (size_t)b * SEQ;
        const int rt = wave & 3; const bool rdw = wave < 4;
        constexpr int RWU = C::DK / 4, NDU = RWU / 16;
        const float l2g = (KIND == 0) ? ret_log2g(h) : 0.f;
        const float qsc = (KIND == 0) ? exp2f(l2g * (float)(16 * rt + i16 + 1)) : 1.0f;
        const float sdec = (KIND == 0) ? exp2f(l2g * 64.0f) : 1.0f;
        const int vm = tid >> 3, vp8 = tid & 7;
        const float vsc = (KIND == 0) ? exp2f(l2g * (float)(63 - vm)) : 1.0f;
        constexpr size_t BLK = (size_t)64 * C::DK * 2;
        const char* xsb = (const char*)(rdw ? Qg : Kg) + (size_t)bh * 64 * BLK + (rdw ? rt * 1024 : NDU * rt * 1024);
        const unsigned xvo = (unsigned)(lane * 16);
        const char* vsb = (const char*)Vg + (size_t)(bh * C::NSL + dvs) * (4096 * 64);
        char* osb = (char*)O + (size_t)(bh * C::NSL + dvs) * (4096 * 64);
        const unsigned vio = (unsigned)(tid * 8);
        char* dmb = (char*)DUMMY + (size_t)bid * 4096;
        const char* psb = (const char*)Pimg + (size_t)bh * 64 * 8192; const unsigned pvo = (unsigned)(tid * 16);
        const char* dcb = (KIND == 1) ? (const char*)CB + ((t0 + 63) * 512 + h * 128 + RWU * rt) * 2 : nullptr; const unsigned dco = (unsigned)(g4 * 8);
        LAS bf16_t* ST = (LAS bf16_t*)(lds + C::LDS_ST);
        LAS char* PI = (LAS char*)(lds + C::LDS_P);
        LAS char* VI = (LAS char*)(lds + C::LDS_V);
        LAS char* OT = (LAS char*)(lds + C::LDS_END);
        const int trow = 16 * (g4 >> 1) + 4 * (g4 & 1) + q4;
        const int voff = trow * 32 + 8 * p4;
        const int poff_row = (16 * rt + i16) * 128, psw = (16 * rt + i16) & 7;

        LsStage<KIND> A, B;
#define LS_LOAD_PV(S, nn) do { const int n_ = (nn) < 64 ? (nn) : 63; \
            unsigned po_ = pvo, vo_ = vio, do_ = dco; asm volatile("" : "+v"(po_), "+v"(vo_), "+v"(do_)); \
            if (!((VAR & 2) && (nn) >= 2)) { S.p = *(const u32x4*)(psb + (size_t)n_ * 8192 + po_); \
            S.v = *(const u32x2*)(vsb + (size_t)n_ * 4096 + vo_); } \
            if (KIND == 1) { _Pragma("unroll") for (int a_ = 0; a_ < NDU; ++a_) S.dec[a_] = *(const u32x2*)(dcb + (size_t)n_ * (64 * 512 * 2) + 32 * a_ + do_); } } while (0)
#define LS_LOAD_X(S, nn) do { const int n_ = (nn) < 64 ? (nn) : 63; \
            if (!((VAR & 1) && (nn) >= 2)) { const char* xs_ = xsb + (size_t)n_ * BLK; unsigned xo_ = xvo; asm volatile("" : "+v"(xo_));        \
                _Pragma("unroll") for (int k_ = 0; k_ < C::NKF; ++k_) S.x[k_] = *(const u32x4*)(xs_ + (size_t)(rdw ? k_ * 4096 : ((k_ / NDU) * C::NA + (k_ % NDU)) * 1024) + xo_); } } while (0)
#define LS_LOAD(S, nn) do { LS_LOAD_PV(S, nn); LS_LOAD_X(S, nn); } while (0)
#define LS_WRITE(S, img) do { \
            *(LAS u32x4*)(PI + (img) * 8192 + tid * 16) = S.p; \
            { LAS char* vd_ = VI + (img) * 8192 + (vp8 >> 2) * 2048 + vm * 32 + (vp8 & 3) * 8; *(LAS u32x2*)vd_ = S.v; \
              if (KIND == 0) { u32x2 w_; w_.x = pk2(bf2f(S.v.x & 0xffffu) * vsc, bf2f(S.v.x >> 16) * vsc); w_.y = pk2(bf2f(S.v.y & 0xffffu) * vsc, bf2f(S.v.y >> 16) * vsc); *(LAS u32x2*)(vd_ + 4096) = w_; } } } while (0)

        for (int i = tid; i < 32 * C::STP / 2; i += 512) ((LAS unsigned*)ST)[i] = 0u;
        f32x4 s[NDU][2];
#pragma unroll
        for (int a = 0; a < NDU; ++a)
#pragma unroll
            for (int e = 0; e < 2; ++e) s[a][e] = (f32x4){0.f, 0.f, 0.f, 0.f};
        LS_LOAD(A, 0); LS_LOAD(B, 1);
        LS_WRITE(A, 0);
        __syncthreads();

#define LS_SB(k) s[1 + (k) / 2][(k) % 2]
#define LS_STEP(n, SC, SN) do { const int img_ = (n) & 1; \
            u32x2 dcur_[2]; if (KIND == 1) { _Pragma("unroll") for (int a_ = 0; a_ < NDU; ++a_) dcur_[a_] = SC.dec[a_]; } \
              \
            LS_LOAD_PV(SC, (n) + 2); \
            if (rdw) { \
                  \
                if (!(VAR & 16)) { \
                const LAS bf16_t* STc_ = ST + img_ * 32 * C::STP; \
                  \
                  \
                _Pragma("unroll") for (int ct_ = 0; ct_ < 2; ++ct_) { \
                    constexpr int HB_ = C::NKF / 2; bf16x8 pf_[2], vf_[2]; \
                    s[0][0] = (f32x4){0.f, 0.f, 0.f, 0.f}; s[0][1] = s[0][0]; \
                    _Pragma("unroll") for (int k_ = 0; k_ < HB_; ++k_) LS_SB(k_) = __builtin_bit_cast(f32x4, lfrag(STc_ + 16 * ct_ * C::STP + 32 * k_, C::STP, lane)); \
                    __builtin_amdgcn_sched_barrier(0); \
                    _Pragma("unroll") for (int k_ = 0; k_ < HB_; k_ += 2) { s[0][0] = mma_rc(s[0][0], __builtin_bit_cast(bf16x8, SC.x[k_]), __builtin_bit_cast(bf16x8, LS_SB(k_))); s[0][1] = mma_rc(s[0][1], __builtin_bit_cast(bf16x8, SC.x[k_ + 1]), __builtin_bit_cast(bf16x8, LS_SB(k_ + 1))); } \
                    __builtin_amdgcn_sched_barrier(0); \
                    _Pragma("unroll") for (int k_ = 0; k_ < HB_; ++k_) LS_SB(k_) = __builtin_bit_cast(f32x4, lfrag(STc_ + 16 * ct_ * C::STP + 32 * (HB_ + k_), C::STP, lane)); \
                    _Pragma("unroll") for (int ks_ = 0; ks_ < 2; ++ks_) { \
                        pf_[ks_] = *(const LAS bf16x8*)(PI + img_ * 8192 + poff_row + (((4 * ks_ + g4) ^ psw) << 4)); \
                        vf_[ks_] = trfrag2(VI + img_ * 8192 + ct_ * 2048 + ks_ * 1024 + voff, 256); } \
                    __builtin_amdgcn_sched_barrier(0); \
                    _Pragma("unroll") for (int k_ = 0; k_ < HB_; k_ += 2) { s[0][0] = mma_rc(s[0][0], __builtin_bit_cast(bf16x8, SC.x[HB_ + k_]), __builtin_bit_cast(bf16x8, LS_SB(k_))); s[0][1] = mma_rc(s[0][1], __builtin_bit_cast(bf16x8, SC.x[HB_ + k_ + 1]), __builtin_bit_cast(bf16x8, LS_SB(k_ + 1))); } \
                    f32x4 oa_ = (s[0][0] + s[0][1]) * qsc; \
                    _Pragma("unroll") for (int ks_ = 0; ks_ < 2; ++ks_) oa_ = mma_rc(oa_, pf_[ks_], vf_[ks_]); \
                    *(LAS u32x2*)(OT + img_ * 4608 + (16 * rt + i16) * 72 + (16 * ct_ + 4 * g4) * 2) = pk4(oa_); \
                    __builtin_amdgcn_sched_barrier(0); } } \
                  \
                LS_LOAD_X(SC, (n) + 2); \
            } else { \
                  \
                if (KIND == 0) { _Pragma("unroll") for (int a_ = 0; a_ < NDU; ++a_) _Pragma("unroll") for (int e_ = 0; e_ < 2; ++e_) s[a_][e_] = s[a_][e_] * sdec; } \
                if (!(VAR & 4)) { bf16x8 vf_[2][2]; \
                    _Pragma("unroll") for (int ks_ = 0; ks_ < 2; ++ks_) _Pragma("unroll") for (int e_ = 0; e_ < 2; ++e_) vf_[ks_][e_] = trfrag2(VI + img_ * 8192 + (KIND == 0 ? 4096 : 0) + e_ * 2048 + ks_ * 1024 + voff, 256); \
                    _Pragma("unroll") for (int ks_ = 0; ks_ < 2; ++ks_) _Pragma("unroll") for (int a_ = 0; a_ < NDU; ++a_) _Pragma("unroll") for (int e_ = 0; e_ < 2; ++e_) \
                        s[a_][e_] = mma_cr(s[a_][e_], __builtin_bit_cast(bf16x8, SC.x[ks_ * NDU + a_]), vf_[ks_][e_]); } \
                  \
                LS_LOAD_X(SC, (n) + 2); \
                if (KIND == 1) { _Pragma("unroll") for (int a_ = 0; a_ < NDU; ++a_) { const f32x4 du_ = unpk4(dcur_[a_]); f32x4 dc_; _Pragma("unroll") for (int r_ = 0; r_ < 4; ++r_) dc_[r_] = __expf(du_[r_]); \
                    _Pragma("unroll") for (int e_ = 0; e_ < 2; ++e_) s[a_][e_] = s[a_][e_] * dc_; } } \
                  \
                { LAS bf16_t* STn_ = ST + (img_ ^ 1) * 32 * C::STP; \
                  _Pragma("unroll") for (int a_ = 0; a_ < NDU; ++a_) _Pragma("unroll") for (int e_ = 0; e_ < 2; ++e_) \
                      *(LAS u32x2*)(STn_ + (16 * e_ + i16) * C::STP + RWU * rt + 16 * a_ + 4 * g4) = pk4(s[a_][e_]); } \
            } \
              \
            { const u32x2 ov_ = *(const LAS u32x2*)(OT + (img_ ^ 1) * 4608 + vm * 72 + vp8 * 8); \
              char* ob_ = (n) > 0 ? osb + (size_t)((n) - 1) * 4096 : dmb; unsigned oo_ = vio; asm volatile("" : "+v"(oo_)); \
              if (!((VAR & 8) && (n) >= 2)) *(u32x2*)(ob_ + oo_) = ov_; } \
              \
            LS_WRITE(SN, img_ ^ 1); \
            asm volatile("s_waitcnt lgkmcnt(0)" ::: "memory"); __builtin_amdgcn_s_barrier(); asm volatile("" ::: "memory"); } while (0)

#pragma nounroll
        for (int n = 0; n < 64; n += 2) { LS_STEP(n, A, B); LS_STEP(n + 1, B, A); }
        *(u32x2*)(osb + (size_t)63 * 4096 + vio) = *(const LAS u32x2*)(OT + 4608 + vm * 72 + vp8 * 8);
        __syncthreads();
#undef LS_LOAD
#undef LS_LOAD_PV
#undef LS_LOAD_X
#undef LS_WRITE
#undef LS_STEP
#undef LS_SB
    }
}


template <int KIND>
__device__ __forceinline__ void lin_stats(const bf16_t* O, float* STATS, int tid, int bid, int G) {
    const int lane = tid & 63, wave = tid >> 6;
    const int gw = bid * 8 + wave, NGW = G * 8;
    constexpr int NJ = KIND == 0 ? 4 : 2, PITCH = KIND == 0 ? 2048 : 1024, RB = 4;
    for (int row0 = gw; row0 < MT; row0 += RB * NGW) {
        u32x4 w[RB][NJ];
#pragma unroll
        for (int rb = 0; rb < RB; ++rb) { const int row = row0 + rb * NGW < MT ? row0 + rb * NGW : row0;
#pragma unroll
            for (int j = 0; j < NJ; ++j) w[rb][j] = *(const u32x4*)(O + (size_t)row * PITCH + 512 * j + 8 * lane); }
#pragma unroll
        for (int rb = 0; rb < RB; ++rb) { const int row = row0 + rb * NGW; if (row >= MT) break;
#pragma unroll
            for (int j = 0; j < NJ; ++j) {
                float sm = 0.f, sq = 0.f;
#pragma unroll
                for (int i = 0; i < 4; ++i) { const float a = bf2f(w[rb][j][i] & 0xffffu), b = bf2f(w[rb][j][i] >> 16); sm += a + b; sq += a * a + b * b; }
                if (KIND == 0) { sm = wave_sum(sm); sq = wave_sum(sq); if (lane == 0) *(f32x2*)(STATS + (size_t)row * 8 + 2 * j) = (f32x2){sm, sq}; }
                else {
#pragma unroll
                    for (int o = 1; o < 32; o <<= 1) sq += __shfl_xor(sq, o);
                    if ((lane & 31) == 0) *(f32x2*)(STATS + (size_t)row * 8 + 2 * (2 * j + (lane >> 5))) = (f32x2){0.f, sq}; }
            }
        }
    }
}

template <int KIND> struct EpiGateNorm {
    static constexpr bool PERM = true;
    const bf16_t* O; bf16_t* A; LAS float* tbl;
    __device__ __forceinline__ void operator()(const f32x4 (&acc)[2][2][4][2], const pg8::Unit& u, int wr, int wc, int fr, int fq) const {
        constexpr int N = KIND == 0 ? 2048 : 1024, HV = KIND == 0 ? 512 : 256; constexpr float INV = KIND == 0 ? 1.0f / 512.0f : 1.0f / 256.0f;
        const int c0 = u.pn * 256 + wc * 32 + fq * 8;
        if (KIND == 0) {
            u32x4 ov[2][4][2];
            if ((u.pn & 1) == 0) {
                LAS f32x2* tb2 = (LAS f32x2*)tbl;
#pragma unroll
                for (int ai = 0; ai < 2; ++ai) {
                    u32x4 w[4][4];
#pragma unroll
                    for (int m = 0; m < 4; ++m) { const int row = u.pm * 256 + ai * 128 + wr * 64 + m * 16 + fr;
#pragma unroll
                        for (int tt = 0; tt < 2; ++tt)
#pragma unroll
                            for (int bj = 0; bj < 2; ++bj) w[m][2 * tt + bj] = *(const u32x4*)((const char*)O + v_img_off<HV>(row, c0 + tt * 256 + bj * 128)); }
                    asm volatile("" ::: "memory");
#pragma unroll
                    for (int m = 0; m < 4; ++m) { const int rl = ai * 128 + wr * 64 + m * 16 + fr; float sm = 0.f, sq = 0.f;
#pragma unroll
                        for (int i = 0; i < 4; ++i) {
                            const f32x4 o0 = unpk4((u32x2){w[m][i].x, w[m][i].y}), o1 = unpk4((u32x2){w[m][i].z, w[m][i].w});
                            const f32x4 ss = o0 + o1, qq = o0 * o0 + o1 * o1;
                            sm += (ss[0] + ss[1]) + (ss[2] + ss[3]); sq += (qq[0] + qq[1]) + (qq[2] + qq[3]); }
                        sm = xsum_16_32(sm); sq = xsum_16_32(sq);
                        if (fq == 0) tb2[rl * 4 + wc] = (f32x2){sm, sq}; }
                    if (ai == 1) {
#pragma unroll
                        for (int m = 0; m < 4; ++m) { ov[1][m][0] = w[m][0]; ov[1][m][1] = w[m][1]; } }
                    asm volatile("" ::: "memory"); }
#pragma unroll
                for (int mm = 0; mm < 4; ++mm) { const int row = u.pm * 256 + wr * 64 + mm * 16 + fr;
#pragma unroll
                    for (int bj = 0; bj < 2; ++bj) ov[0][mm][bj] = *(const u32x4*)((const char*)O + v_img_off<HV>(row, c0 + bj * 128)); }
                asm volatile("s_waitcnt lgkmcnt(0)" ::: "memory"); __builtin_amdgcn_s_barrier(); asm volatile("" ::: "memory");
            }
#pragma unroll
            for (int ai = 0; ai < 2; ++ai) {
                if ((u.pn & 1) != 0) {
#pragma unroll
                    for (int mm = 0; mm < 4; ++mm) { const int row = u.pm * 256 + ai * 128 + wr * 64 + mm * 16 + fr;
#pragma unroll
                        for (int bj = 0; bj < 2; ++bj) ov[ai][mm][bj] = *(const u32x4*)((const char*)O + v_img_off<HV>(row, c0 + bj * 128)); }
                    asm volatile("" ::: "memory");
                }
#pragma unroll
                for (int mm = 0; mm < 4; ++mm) { const int m = mm; const int rl = ai * 128 + wr * 64 + m * 16 + fr; const int row = u.pm * 256 + rl;
                    const LAS f32x2* tb2 = (const LAS f32x2*)tbl + rl * 4;
                    const f32x2 p0 = tb2[0], p1 = tb2[1], p2 = tb2[2], p3 = tb2[3];
                    const float mean = ((p0.x + p1.x) + (p2.x + p3.x)) * INV, rstd = __builtin_amdgcn_rsqf(fmaxf(((p0.y + p1.y) + (p2.y + p3.y)) * INV - mean * mean, 0.f) + EPS);
#pragma unroll
                    for (int bj = 0; bj < 2; ++bj) {
                        const f32x4 o0 = unpk4((u32x2){ov[ai][mm][bj].x, ov[ai][mm][bj].y}), o1 = unpk4((u32x2){ov[ai][mm][bj].z, ov[ai][mm][bj].w}), a0 = acc[ai][bj][m][0], a1 = acc[ai][bj][m][1]; f32x4 r0, r1;
#pragma unroll
                        for (int j = 0; j < 1; ++j) { const float nm = -mean * rstd; r0 = (o0 * rstd + nm) * silu4(a0); r1 = (o1 * rstd + nm) * silu4(a1); }
                        const u32x2 q0 = pk4(r0), q1 = pk4(r1);
                        *(u32x4*)(A + (size_t)row * N + c0 + bj * 128) = (u32x4){q0.x, q0.y, q1.x, q1.y};
                    }
                }
                asm volatile("" ::: "memory");
            }
        } else {
#pragma unroll
            for (int ai = 0; ai < 2; ++ai) {
                u32x4 w[4][2];
#pragma unroll
                for (int m = 0; m < 4; ++m) { const int row = u.pm * 256 + ai * 128 + wr * 64 + m * 16 + fr;
#pragma unroll
                    for (int bj = 0; bj < 2; ++bj) w[m][bj] = *(const u32x4*)((const char*)O + v_img_off<HV>(row, c0 + bj * 128)); }
                asm volatile("" ::: "memory");
#pragma unroll
                for (int m = 0; m < 4; ++m) { const int rl = ai * 128 + wr * 64 + m * 16 + fr; float sq = 0.f;
#pragma unroll
                    for (int bj = 0; bj < 2; ++bj) { const f32x4 o0 = unpk4((u32x2){w[m][bj].x, w[m][bj].y}), o1 = unpk4((u32x2){w[m][bj].z, w[m][bj].w}); const f32x4 qq = o0 * o0 + o1 * o1; sq += (qq[0] + qq[1]) + (qq[2] + qq[3]); }
                    sq = xsum_16_32(sq);
                    if (fq == 0) tbl[rl * 4 + wc] = sq; } }
            asm volatile("s_waitcnt lgkmcnt(0)" ::: "memory"); __builtin_amdgcn_s_barrier(); asm volatile("" ::: "memory");
#pragma unroll
            for (int ai = 0; ai < 2; ++ai) {
                u32x4 ov[4][2];
#pragma unroll
                for (int m = 0; m < 4; ++m) { const int row = u.pm * 256 + ai * 128 + wr * 64 + m * 16 + fr;
#pragma unroll
                    for (int bj = 0; bj < 2; ++bj) ov[m][bj] = *(const u32x4*)((const char*)O + v_img_off<HV>(row, c0 + bj * 128)); }
                asm volatile("" ::: "memory");
#pragma unroll
                for (int m = 0; m < 4; ++m) { const int rl = ai * 128 + wr * 64 + m * 16 + fr; const int row = u.pm * 256 + rl;
                    const f32x4 pr = *(const LAS f32x4*)(tbl + rl * 4);
                    const float rstd = __builtin_amdgcn_rsqf(((pr[0] + pr[1]) + (pr[2] + pr[3])) * INV + EPS);
#pragma unroll
                    for (int bj = 0; bj < 2; ++bj) {
                        const f32x4 o0 = unpk4((u32x2){ov[m][bj].x, ov[m][bj].y}), o1 = unpk4((u32x2){ov[m][bj].z, ov[m][bj].w}), a0 = acc[ai][bj][m][0], a1 = acc[ai][bj][m][1]; f32x4 r0, r1;
#pragma unroll
                        for (int j = 0; j < 1; ++j) { r0 = o0 * rstd * silu4(a0); r1 = o1 * rstd * silu4(a1); }
                        const u32x2 q0 = pk4(r0), q1 = pk4(r1);
                        *(u32x4*)(A + (size_t)row * N + c0 + bj * 128) = (u32x4){q0.x, q0.y, q1.x, q1.y};
                    }
                }
                asm volatile("" ::: "memory");
            }
        }
    }
};
namespace attn_body {
using bf16=unsigned short;
using bf16x8=__attribute__((ext_vector_type(8)))short;
using s16x4=__attribute__((ext_vector_type(4)))short;
using f32x16=__attribute__((ext_vector_type(16)))float;
using u32x4=__attribute__((ext_vector_type(4)))unsigned;
constexpr int BATCH=4,NHEAD=16,SEQ=4096,D=64,DM=NHEAD*D;
constexpr int NW=8,QBLK=32,QB=QBLK*NW,KVBLK=64,NQB=SEQ/QB;
constexpr int ATTN_PITCH=DM, ATTN_UNIT_ROWS=QB;
__device__ __forceinline__ int crow(int r,int hi){return (r&3)+8*(r>>2)+4*hi;}
#define SBAR() __builtin_amdgcn_sched_barrier(0)
__device__ __forceinline__ void cmask(f32x16&p0,f32x16&p1,int jb,int qrel,int hi){
  const float NEG=-INFINITY; int kb=64*jb+4*hi;
  #pragma unroll
  for(int r=0;r<16;++r){int kv=kb+(r&3)+8*(r>>2); if(kv>qrel)p0[r]=NEG; if(kv+32>qrel)p1[r]=NEG;}
}

constexpr int NSLOT=3, SLOTB=8192;
constexpr int LDS_K=0, LDS_V=NSLOT*SLOTB, LDS_WS=2*NSLOT*SLOTB, LDS_OST=LDS_WS+NW*64*4, LDS_NC=LDS_OST+NW*4096, LDS_FT=LDS_NC+SEQ*4, LDS_RE=LDS_FT+256, LDS_BYTES=LDS_RE+256;
constexpr float C2=0.125f*1.4426950408889634f;
__device__ __forceinline__ void glds16(const void*gsrc,unsigned lds_dst){unsigned keep;
  asm volatile("s_mov_b32 %0, m0\n\ts_mov_b32 m0, %2\n\ts_nop 0\n\tglobal_load_lds_dwordx4 %1, off\n\ts_mov_b32 m0, %0":"=&s"(keep):"v"(gsrc),"s"(lds_dst):"memory");}
__device__ __forceinline__ float max3f(float a,float b,float c){float r;asm("v_max3_f32 %0, %1, %2, %3":"=v"(r):"v"(a),"v"(b),"v"(c));return r;}
__device__ __forceinline__ float max2f(float a,float b){float r;asm("v_max_f32_e32 %0, %1, %2":"=v"(r):"v"(a),"v"(b));return r;}
__device__ __forceinline__ float fadd_s(float a,float b){float r;asm("v_add_f32_e32 %0, %1, %2":"=v"(r):"v"(a),"v"(b));return r;}
__device__ __forceinline__ float fsub_s(float a,float b){float r;asm("v_sub_f32_e32 %0, %1, %2":"=v"(r):"v"(a),"v"(b));return r;}
typedef float f32x2_t __attribute__((ext_vector_type(2))); typedef __bf16 bf16x2_t __attribute__((ext_vector_type(2)));
__device__ __forceinline__ unsigned cvtpk_s(float lo,float hi){f32x2_t v={lo,hi};bf16x2_t b=__builtin_convertvector(v,bf16x2_t);return __builtin_bit_cast(unsigned,b);}
#define WAIT_BAR(N) asm volatile("s_waitcnt vmcnt(" #N ") lgkmcnt(0)\n\ts_barrier":::"memory")

__device__ __forceinline__ void qkt(f32x16&p0,f32x16&p1,const char*Kslot,const bf16x8*qr,const f32x16&negm,int r32,int hi){
  const char*kb=Kslot+hi*1024+r32*16;
  #pragma unroll
  for(int d0=0;d0<4;++d0){
    const bf16x8 b0=*reinterpret_cast<const bf16x8*>(kb+d0*2048);
    const bf16x8 b1=*reinterpret_cast<const bf16x8*>(kb+d0*2048+512);
    if(d0==0){p0=__builtin_amdgcn_mfma_f32_32x32x16_bf16(b0,qr[0],negm,0,0,0);p1=__builtin_amdgcn_mfma_f32_32x32x16_bf16(b1,qr[0],negm,0,0,0);}
    else{p0=__builtin_amdgcn_mfma_f32_32x32x16_bf16(b0,qr[d0],p0,0,0,0);p1=__builtin_amdgcn_mfma_f32_32x32x16_bf16(b1,qr[d0],p1,0,0,0);}}
}
typedef __attribute__((address_space(3))) const char* lds_cptr;
typedef short v4i16_t __attribute__((ext_vector_type(4)));
__device__ __forceinline__ void kload8(bf16x8*kf,lds_cptr kp){
  kf[0]=*(const __attribute__((address_space(3))) bf16x8*)(kp);      kf[1]=*(const __attribute__((address_space(3))) bf16x8*)(kp+512);
  kf[2]=*(const __attribute__((address_space(3))) bf16x8*)(kp+2048); kf[3]=*(const __attribute__((address_space(3))) bf16x8*)(kp+2560);
  kf[4]=*(const __attribute__((address_space(3))) bf16x8*)(kp+4096); kf[5]=*(const __attribute__((address_space(3))) bf16x8*)(kp+4608);
  kf[6]=*(const __attribute__((address_space(3))) bf16x8*)(kp+6144); kf[7]=*(const __attribute__((address_space(3))) bf16x8*)(kp+6656);
}
__device__ __forceinline__ void kload2(bf16x8*kf,lds_cptr kp,int j){ kf[2*j]=*(const __attribute__((address_space(3))) bf16x8*)(kp+j*2048); kf[2*j+1]=*(const __attribute__((address_space(3))) bf16x8*)(kp+j*2048+512); }
__device__ __forceinline__ s16x4 vtr(lds_cptr p){ return __builtin_bit_cast(s16x4,__builtin_amdgcn_ds_read_tr16_b64_v4i16((__attribute__((address_space(3))) v4i16_t*)p)); }
__device__ __forceinline__ float rowmax(const f32x16&p0,const f32x16&p1){
  float a=max3f(p0[0],p0[1],p1[0]),b=max3f(p0[2],p0[3],p1[1]);a=max3f(a,p1[2],p1[3]);
  #pragma unroll
  for(int r=4;r<16;r+=4){a=max3f(a,p0[r],p0[r+1]);b=max3f(b,p0[r+2],p0[r+3]);a=max3f(a,p1[r],p1[r+1]);b=max3f(b,p1[r+2],p1[r+3]);}
  const float m=max2f(a,b);
  auto rr=__builtin_amdgcn_permlane32_swap(__float_as_uint(m),__float_as_uint(m),false,false);
  return max2f(__uint_as_float(rr[0]),__uint_as_float(rr[1]));
}
__device__ __forceinline__ void pv(f32x16*o,int vb,bf16x8 pa0,bf16x8 pa1,bf16x8 pa2,bf16x8 pa3){
  #pragma unroll
  for(int d0=0;d0<2;++d0){s16x4 lo[4],hi[4];
    #pragma unroll
    for(int ks=0;ks<4;++ks){
      asm volatile("ds_read_b64_tr_b16 %0,%1 offset:%c2":"=&v"(lo[ks]):"v"(vb),"i"(d0*4096+ks*1024):"memory");
      asm volatile("ds_read_b64_tr_b16 %0,%1 offset:%c2":"=&v"(hi[ks]):"v"(vb),"i"(d0*4096+ks*1024+512):"memory");}
    asm volatile("s_waitcnt lgkmcnt(0)":::"memory");SBAR();
    #define PK(k) (bf16x8){lo[k][0],lo[k][1],lo[k][2],lo[k][3],hi[k][0],hi[k][1],hi[k][2],hi[k][3]}
    o[d0]=__builtin_amdgcn_mfma_f32_32x32x16_bf16(pa0,PK(0),o[d0],0,0,0);
    o[d0]=__builtin_amdgcn_mfma_f32_32x32x16_bf16(pa1,PK(1),o[d0],0,0,0);
    o[d0]=__builtin_amdgcn_mfma_f32_32x32x16_bf16(pa2,PK(2),o[d0],0,0,0);
    o[d0]=__builtin_amdgcn_mfma_f32_32x32x16_bf16(pa3,PK(3),o[d0],0,0,0);
    #undef PK
  }
}

#ifndef ATTN_STORE16
#define ATTN_STORE16(p,v) (*(u32x4*)(p)=(v))
#endif
template<int THRL> __device__ __forceinline__ void attn_unit(int b,int h,int qb,int ts,const bf16*Q,const bf16*__restrict__ K,const bf16*__restrict__ V,const bf16*__restrict__ Gt,bf16*O,char*shm,int tid){
  const int lane=tid&63,r32=lane&31,hi=lane>>5; const int wid=__builtin_amdgcn_readfirstlane(tid>>6);
  const long rowbase=(long)b*SEQ; const int q0=qb*QB;
  typedef __attribute__((address_space(3))) const float* lds_fptr; typedef float f32x4b __attribute__((ext_vector_type(4)));
  const lds_fptr ncum=(lds_fptr)((__attribute__((address_space(3))) const char*)shm+LDS_NC)+64*ts+4*hi;
  const lds_fptr ftp=(lds_fptr)((__attribute__((address_space(3))) const char*)shm+LDS_FT)+ts;
  const bf16*Qw=Q+(rowbase+q0+wid*QBLK)*DM+h*D;
  const bf16*Kh=K+((long)(b*NHEAD+h)*(SEQ/KVBLK)+ts)*4096,*Vh=V+((long)(b*NHEAD+h)*(SEQ/KVBLK)+ts)*4096;
  const unsigned lds0=(unsigned)(uintptr_t)shm;
  float*wsf=(float*)(shm+LDS_WS)+wid*64;
  const bf16*ksrc=Kh+wid*512+lane*8;
  const bf16*vsrc=Vh+wid*512+lane*8;
  const unsigned kdst=lds0+LDS_K+wid*1024, vdst=lds0+LDS_V+wid*1024;
  #define DMA_K(t,slot) glds16(ksrc+(long)(t)*4096,(unsigned)__builtin_amdgcn_readfirstlane(kdst+(slot)))
  #define DMA_V(t,slot) glds16(vsrc+(long)(t)*4096,(unsigned)__builtin_amdgcn_readfirstlane(vdst+(slot)))
  const int vb0=(int)(lds0+LDS_V)+((lane>>4)&1)*32+(lane&3)*8+(4*hi+((lane&15)>>2))*64;
  const char*Kbase=shm+LDS_K; bf16x8 kf[8];
  const lds_cptr shm3=(lds_cptr)shm; const lds_cptr kp0=shm3+LDS_K+hi*1024+r32*16; const lds_cptr vp0=shm3+LDS_V+((lane>>4)&1)*32+(lane&3)*8+(4*hi+((lane&15)>>2))*64;
  const int NT=(q0+QB)/KVBLK-ts;
  DMA_K(0,0);DMA_V(0,0);DMA_K(1,SLOTB);
  bf16x8 qr[4];
  #pragma unroll
  for(int d0=0;d0<4;++d0)qr[d0]=*reinterpret_cast<const bf16x8*>(&Qw[(long)r32*DM+d0*16+hi*8]);
  float l_reg=0.f,fcur=1.f;f32x16 o[2];o[0]=f32x16{};o[1]=f32x16{};const f32x16 negm=f32x16{};
  const int qrel=wid*QBLK+r32;
  #define CMASK(P0,P1,t) do{int jb_=(t)-(NT-4); if(jb_>=0)cmask(P0,P1,jb_,qrel,hi);}while(0)
  #define LDSF4(p) (*(const __attribute__((address_space(3))) f32x4b*)(p))
  #define BIAS(P0,P1,t) do{ const lds_fptr nb_=ncum+64*(t); \
      { const f32x4b a0_=LDSF4(nb_), a1_=LDSF4(nb_+8), a2_=LDSF4(nb_+16), a3_=LDSF4(nb_+24); \
        _Pragma("unroll") for(int j_=0;j_<4;++j_){ P0[j_]+=a0_[j_]; P0[4+j_]+=a1_[j_]; P0[8+j_]+=a2_[j_]; P0[12+j_]+=a3_[j_]; } } SBAR(); \
      { const f32x4b b0_=LDSF4(nb_+32), b1_=LDSF4(nb_+40), b2_=LDSF4(nb_+48), b3_=LDSF4(nb_+56); \
        _Pragma("unroll") for(int j_=0;j_<4;++j_){ P1[j_]+=b0_[j_]; P1[4+j_]+=b1_[j_]; P1[8+j_]+=b2_[j_]; P1[12+j_]+=b3_[j_]; } } SBAR(); }while(0)
  #define START(P0,P1) do{ _Pragma("unroll") for(int r=0;r<16;++r)P0[r]=__builtin_amdgcn_exp2f(P0[r]); }while(0)
  #define RESC() do{ _Pragma("unroll") for(int d_=0;d_<2;++d_) _Pragma("unroll") for(int r=0;r<16;++r)o[d_][r]*=fcur; }while(0)
  f32x16 pA0,pA1,pB0,pB1;
  int sl_prev=0,sl_cur=0,sl_next=SLOTB;
  #define ROT() do{sl_prev=sl_cur;sl_cur=sl_next;sl_next=(sl_next==(NSLOT-1)*SLOTB)?0:sl_next+SLOTB;}while(0)
  DMA_K(2,2*SLOTB);
  WAIT_BAR(3);
  qkt(pA0,pA1,Kbase,qr,negm,r32,hi);asm volatile("s_nop 15\n\ts_nop 7":"+v"(pA0),"+v"(pA1));BIAS(pA0,pA1,0);CMASK(pA0,pA1,0);
  START(pA0,pA1);
  _Pragma("unroll") for(int r=0;r<16;++r)pA1[r]=__builtin_amdgcn_exp2f(pA1[r]);
  WAIT_BAR(0);
  DMA_K(3,0);DMA_V(1,SLOTB);
  ROT();
  kload8(kf,kp0+sl_cur);
  WAIT_BAR(2);
  s16x4 vlo[8],vhi[8]; u32x4 pw0,pw1,pw2,pw3;
  #define PKW(P,B) cvtpk_s(P[B],P[B+1])
  #define PAF(k) __builtin_bit_cast(bf16x8,pw##k)
  #define VFR(i) (bf16x8){vlo[i][0],vlo[i][1],vlo[i][2],vlo[i][3],vhi[i][0],vhi[i][1],vhi[i][2],vhi[i][3]}
  #define PIN(x) asm volatile("":"+v"(x))
  #define MX3(a,b,c) __builtin_fmaxf(__builtin_fmaxf((a),(b)),(c))
  #define GAPA(MF,A0,A1,A2,A3,W0,W1,PW) do{ MF; sacc+=A0; sacc+=A1; sacc+=A2; sacc+=A3; PIN(sacc); W0; W1; PIN(PW); SBAR(); }while(0)
  #define EX(v) __builtin_amdgcn_exp2f(v)
  #define GAPB(MF,X,B) do{ MF; X[B]=EX(X[B]); X[B+1]=EX(X[B+1]); X[B+2]=EX(X[B+2]); X[B+3]=EX(X[B+3]); PIN(X); SBAR(); }while(0)
  #define VRD(i) do{ vlo[i]=vtr(vp_+(((i)>>2)*4096+((i)&3)*1024)); vhi[i]=vtr(vp_+(((i)>>2)*4096+((i)&3)*1024+512)); }while(0)
  #define KRD(G,j) do{ if(G){ kload2(kf,kp0+sl_next,j); SBAR(); } }while(0)
  #define STEP(C0,C1,P0,P1,t,GK,GV,GL) do{ SBAR(); \
    const lds_cptr vp_=vp0+sl_prev; \
    VRD(0); SBAR(); float sacc=(P0[0]+P0[1]); \
    GAPA(C0=__builtin_amdgcn_mfma_f32_32x32x16_bf16(kf[0],qr[0],negm,0,0,0), P0[2],P0[3],P0[4],P0[5],     pw0[0]=PKW(P0,0), pw0[1]=PKW(P0,2), pw0); \
    VRD(4); SBAR(); GAPA(C1=__builtin_amdgcn_mfma_f32_32x32x16_bf16(kf[1],qr[0],negm,0,0,0), P0[6],P0[7],P0[8],P0[9],     pw0[2]=PKW(P0,4), pw0[3]=PKW(P0,6), pw0); \
    VRD(1); SBAR(); GAPA(C0=__builtin_amdgcn_mfma_f32_32x32x16_bf16(kf[2],qr[1],C0,0,0,0),   P0[10],P0[11],P0[12],P0[13], pw1[0]=PKW(P0,8), pw1[1]=PKW(P0,10), pw1); \
    VRD(5); SBAR(); GAPA(C1=__builtin_amdgcn_mfma_f32_32x32x16_bf16(kf[3],qr[1],C1,0,0,0),   P0[14],P0[15],P1[0],P1[1],   pw1[2]=PKW(P0,12),pw1[3]=PKW(P0,14), pw1); \
    VRD(2); SBAR(); GAPA(C0=__builtin_amdgcn_mfma_f32_32x32x16_bf16(kf[4],qr[2],C0,0,0,0),   P1[2],P1[3],P1[4],P1[5],     pw2[0]=PKW(P1,0), pw2[1]=PKW(P1,2), pw2); \
    VRD(6); SBAR(); GAPA(C1=__builtin_amdgcn_mfma_f32_32x32x16_bf16(kf[5],qr[2],C1,0,0,0),   P1[6],P1[7],P1[8],P1[9],     pw2[2]=PKW(P1,4), pw2[3]=PKW(P1,6), pw2); \
    VRD(3); SBAR(); GAPA(C0=__builtin_amdgcn_mfma_f32_32x32x16_bf16(kf[6],qr[3],C0,0,0,0),   P1[10],P1[11],P1[12],P1[13], pw3[0]=PKW(P1,8), pw3[1]=PKW(P1,10), pw3); \
    VRD(7); SBAR(); GAPA(C1=__builtin_amdgcn_mfma_f32_32x32x16_bf16(kf[7],qr[3],C1,0,0,0),   P1[14],P1[15],0.f,0.f,       pw3[2]=PKW(P1,12),pw3[3]=PKW(P1,14), pw3); \
    l_reg+=sacc; \
    if(GK){DMA_K((t)+3,sl_cur);} if(GV){DMA_V((t)+1,sl_next);} \
    BIAS(C0,C1,t); CMASK(C0,C1,t); \
    { const int jb2_=2*((t)-(NT-4)); fcur=(jb2_>wid)?1.0f:ftp[(t)]; l_reg*=fcur; } \
    SBAR(); \
    GAPB(o[0]=__builtin_amdgcn_mfma_f32_32x32x16_bf16(PAF(0),VFR(0),o[0],0,0,0), C0,0); \
    GAPB(o[1]=__builtin_amdgcn_mfma_f32_32x32x16_bf16(PAF(0),VFR(4),o[1],0,0,0), C0,4); \
    KRD(GL,0); GAPB(o[0]=__builtin_amdgcn_mfma_f32_32x32x16_bf16(PAF(1),VFR(1),o[0],0,0,0), C0,8); \
    KRD(GL,1); GAPB(o[1]=__builtin_amdgcn_mfma_f32_32x32x16_bf16(PAF(1),VFR(5),o[1],0,0,0), C0,12); \
    KRD(GL,2); GAPB(o[0]=__builtin_amdgcn_mfma_f32_32x32x16_bf16(PAF(2),VFR(2),o[0],0,0,0), C1,0); \
    KRD(GL,3); GAPB(o[1]=__builtin_amdgcn_mfma_f32_32x32x16_bf16(PAF(2),VFR(6),o[1],0,0,0), C1,4); \
    GAPB(o[0]=__builtin_amdgcn_mfma_f32_32x32x16_bf16(PAF(3),VFR(3),o[0],0,0,0), C1,8); \
    GAPB(o[1]=__builtin_amdgcn_mfma_f32_32x32x16_bf16(PAF(3),VFR(7),o[1],0,0,0), C1,12); \
    }while(0)
  int t=1;
  #undef CMASK
  #define CMASK(P0,P1,t) do{}while(0)
  for(;t+5<NT;t+=2){
    STEP(pB0,pB1,pA0,pA1,t,true,true,true);     WAIT_BAR(2); RESC(); ROT();
    STEP(pA0,pA1,pB0,pB1,t+1,true,true,true);   WAIT_BAR(2); RESC(); ROT();
  }
  #undef CMASK
  int qrel_m=qrel,hi_m=hi; asm volatile("":"+v"(qrel_m),"+v"(hi_m));
  #define CMASK(P0,P1,t) do{int jb_=(t)-(NT-4); if(jb_>=0)cmask(P0,P1,jb_,qrel_m,hi_m);}while(0)
  #define ENDW(tt) do{ if((tt)+3<NT){WAIT_BAR(2);} else if((tt)+2<NT){WAIT_BAR(1);} else {WAIT_BAR(0);} }while(0)
  for(;t+1<NT;t+=2){
    STEP(pB0,pB1,pA0,pA1,t,(t+3<NT),(t+1<NT),(t+1<NT));       ENDW(t);   RESC(); ROT();
    STEP(pA0,pA1,pB0,pB1,t+1,(t+4<NT),(t+2<NT),(t+2<NT));     ENDW(t+1); RESC(); ROT();
  }
  STEP(pB0,pB1,pA0,pA1,NT-1,false,false,false); RESC();
  { float sacc=pB0[0]+pB0[1]; _Pragma("unroll") for(int r=2;r<16;++r)sacc+=pB0[r]; _Pragma("unroll") for(int r=0;r<16;++r)sacc+=pB1[r]; l_reg+=sacc;
    pw0=(u32x4){PKW(pB0,0),PKW(pB0,2),PKW(pB0,4),PKW(pB0,6)};pw1=(u32x4){PKW(pB0,8),PKW(pB0,10),PKW(pB0,12),PKW(pB0,14)};pw2=(u32x4){PKW(pB1,0),PKW(pB1,2),PKW(pB1,4),PKW(pB1,6)};pw3=(u32x4){PKW(pB1,8),PKW(pB1,10),PKW(pB1,12),PKW(pB1,14)};
    SBAR(); pv(o,vb0+sl_cur,PAF(0),PAF(1),PAF(2),PAF(3)); }
  #undef PKW
  #undef PAF
  #undef VFR
  #undef PIN
  #undef MX3
  #undef GAPA
  #undef GAPB
  #undef EX
  #undef VRD
  #undef KRD
  #undef STEP
  #undef ENDW
  {auto rr=__builtin_amdgcn_permlane32_swap(__float_as_uint(l_reg),__float_as_uint(l_reg),false,false);l_reg=__uint_as_float(rr[0])+__uint_as_float(rr[1]);}
  if(hi==0)wsf[32+r32]=l_reg;asm volatile("s_waitcnt lgkmcnt(0)":::"memory");
  float rli[16];
  #pragma unroll
  for(int r=0;r<16;++r)rli[r]=__builtin_amdgcn_rcpf(wsf[32+crow(r,hi)]);
  bf16*Ow=O+(rowbase+q0+wid*QBLK)*DM+h*D;
  { bf16*stg=(bf16*)(shm+LDS_OST)+wid*2048;
    { const bf16*Gw=Gt+(rowbase+q0+wid*QBLK)*DM+h*D; u32x4 gt4[4];
      #pragma unroll
      for(int i=0;i<4;++i){const int row=i*8+(lane>>3),ch=lane&7; gt4[i]=*(const u32x4*)(Gw+(long)row*DM+ch*8);}
      #pragma unroll
      for(int i=0;i<4;++i){const int row=i*8+(lane>>3),ch=lane&7; *(u32x4*)(stg+row*64+ch*8)=gt4[i];}
      asm volatile("s_waitcnt lgkmcnt(0)":::"memory"); }
    #pragma unroll
    for(int r=0;r<16;++r){const int orow=crow(r,hi);
      #pragma unroll
      for(int d0=0;d0<2;++d0){const float gv=__uint_as_float((unsigned)stg[orow*64+d0*32+r32]<<16); const float ov=o[d0][r]*rli[r]*gv; unsigned ub=__float_as_uint(ov); ub=(ub+0x7fffu+((ub>>16)&1u))>>16; stg[orow*64+d0*32+r32]=(bf16)ub;}}
    asm volatile("s_waitcnt lgkmcnt(0)":::"memory");
    #pragma unroll
    for(int i=0;i<4;++i){const int row=i*8+(lane>>3),ch=lane&7; const u32x4 v=*(const u32x4*)(stg+row*64+ch*8); ATTN_STORE16(Ow+(long)row*DM+ch*8,v);} }
  asm volatile("s_waitcnt lgkmcnt(0)\n\ts_barrier":::"memory");
  #undef DMA_K
  #undef DMA_V
  #undef CMASK
  #undef BIAS
  #undef LDSF4
  #undef START
  #undef RESC
  #undef ROT
}
constexpr int ATTN_LDS_BYTES=LDS_BYTES;
#undef SBAR
#undef WAIT_BAR
}

__device__ __forceinline__ void fox_attn2(const Params& P, char* shm, int tid, int bid, int G, unsigned short* Odst) {
    const int lane = tid & 63;
    unsigned short* Q = (unsigned short*)(P.ws + WS_ACT); const unsigned short* Kb = (const unsigned short*)(P.ws + WS_ACT + 32 * MiB); const unsigned short* V = (const unsigned short*)(P.ws + WS_ACT + 64 * MiB);
    const unsigned short* Gt = (const unsigned short*)(P.ws + WS_ACT + 96 * MiB);
    LAS float* nc = (LAS float*)((LAS char*)shm + attn_body::LDS_NC);
    LAS float* ft = (LAS float*)((LAS char*)shm + attn_body::LDS_FT);
    LAS float* re = (LAS float*)((LAS char*)shm + attn_body::LDS_RE);
    float gq = fabsf(P.fox_q_gain[lane]), gk = fabsf(P.fox_k_gain[lane]);
#pragma unroll
    for (int o = 1; o < 64; o <<= 1) { gq = fmaxf(gq, lane_perm(gq, lane ^ o)); gk = fmaxf(gk, lane_perm(gk, lane ^ o)); }
    const float Smax = 1.02f * (64.0f * gq * gk * 0.125f * LOG2E);
    const float T = 2.0f * Smax + 30.0f;
    const int vcu = (G % 8 == 0) ? (bid % 8) * (G / 8) + bid / 8 : bid;
    int last_bh = -1;
    for (int i = 0;; ++i) {
        int bh, qb;
        if (G == 256) { if (i >= 4) break; bh = vcu >> 2; const int s = vcu & 3; qb = (i == 0) ? s : (i == 1) ? 7 - s : (i == 2) ? 8 + s : 15 - s; }
        else { const int ui = i * G + bid; if (ui >= 1024) break; bh = ui >> 4; qb = ui & 15; }
        if (bh != last_bh) {
            const float* LF = (const float*)(P.ws + WS_S16) + ((size_t)(bh >> 4) * SEQ + 8 * tid) * 16 + (bh & 15);
            float v8[8]; float run = 0.f;
#pragma unroll
            for (int i2 = 0; i2 < 8; ++i2) { run += LF[(size_t)i2 * 16]; v8[i2] = run; }
            float inc = run;
#pragma unroll
            for (int o = 1; o < 64; o <<= 1) { const float tt = lane_perm(inc, (lane - o) & 63); if (lane >= o) inc += tt; }
            if (lane == 63) ft[tid >> 6] = inc;
            __syncthreads();
            float pre = inc - run;
            for (int w = 0; w < (tid >> 6); ++w) pre += ft[w];
            __syncthreads();
#pragma unroll
            for (int i2 = 0; i2 < 8; ++i2) nc[8 * tid + i2] = -(pre + v8[i2]) * LOG2E;
            __syncthreads();
            if (tid < 64) { const float e = nc[64 * tid + 63]; re[tid] = e; const float ep = (tid > 0) ? nc[64 * tid - 1] : e; ft[tid] = exp2f(ep - e); }
            __syncthreads();
#pragma unroll
            for (int i2 = 0; i2 < 8; ++i2) nc[8 * tid + i2] += -re[tid >> 3] - Smax + 40.0f;
            __syncthreads(); last_bh = bh;
        }
        const int ntf = 4 * qb + 4;
        const float thr = (qb > 0 ? re[4 * qb - 1] : 0.0f) - T;
        const bool pred = (lane < ntf) && (re[lane] < thr);
        int ts = __builtin_popcountll(__ballot(pred)) & ~1; ts = ts > ntf - 4 ? ntf - 4 : ts; ts = __builtin_amdgcn_readfirstlane(ts);
        int tid_u = tid; asm volatile("" : "+v"(tid_u));
        attn_body::attn_unit<8>(bh >> 4, bh & 15, qb, ts, Q, Kb, V, Gt, Odst ? Odst : Q, shm, tid_u);
    }
}

__device__ __forceinline__ void final_norm(const Params& P, const bf16_t* xin, int tid, int bid, int G) {
    const int lane = tid & 63, wave = tid >> 6;
    const int gw = bid * 8 + wave, NGW = G * 8;
    f32x4 g[4];
#pragma unroll
    for (int j = 0; j < 4; ++j) g[j] = *(const f32x4*)(P.final_g + 4 * lane + 256 * j);
    constexpr int RB = 8;
    for (int row0 = gw; row0 < MT; row0 += RB * NGW) {
        f32x4 v[RB][4];
#pragma unroll
        for (int rb = 0; rb < RB; ++rb) { const int row = row0 + rb * NGW < MT ? row0 + rb * NGW : row0; const u32x2* xr = (const u32x2*)(xin + (size_t)row * 1024) + lane;
#pragma unroll
            for (int j = 0; j < 4; ++j) v[rb][j] = unpk4(xr[64 * j]); }
#pragma unroll
        for (int rb = 0; rb < RB; ++rb) { const int row = row0 + rb * NGW; if (row >= MT) break;
            float ss = 0.f;
#pragma unroll
            for (int j = 0; j < 4; ++j) ss += (v[rb][j][0] * v[rb][j][0] + v[rb][j][1] * v[rb][j][1]) + (v[rb][j][2] * v[rb][j][2] + v[rb][j][3] * v[rb][j][3]);
            const float rstd = rsqrtf(wave_sum(ss) * (1.0f / 1024.0f) + EPS);
            f32x4* xw = (f32x4*)(P.out + (size_t)row * 1024) + lane;
#pragma unroll
            for (int j = 0; j < 4; ++j) xw[64 * j] = (v[rb][j] * rstd) * g[j];
        }
    }
}

#define XB_TMO      128
#define XB_XCNT(j)  (256  + 64 * (j))
#define XB_XSUB(j)  (1280 + 64 * (j))
#define XB_XGEN(j)  (2304 + 64 * (j))
#define XB_TOP      3328
#define XB_TOPGEN   3392
#define XCD_BAR_WORDS 3456
#define XB_DEPART   64
__device__ unsigned g_xbar[XCD_BAR_WORDS + 64];
#define XB_SPIN_CAP (1u << 20)
__device__ __forceinline__ unsigned xb_ld(unsigned* p)              { return __hip_atomic_load(p, __ATOMIC_RELAXED, __HIP_MEMORY_SCOPE_AGENT); }
__device__ __forceinline__ unsigned xb_add(unsigned* p, unsigned v) { return __hip_atomic_fetch_add(p, v, __ATOMIC_RELAXED, __HIP_MEMORY_SCOPE_AGENT); }
__device__ __forceinline__ unsigned xb_xcc_id() { return (unsigned)__builtin_amdgcn_s_getreg((3 << 11) | 20) & 0xFu; }
#define XB_SPIN(cond, bar) do { unsigned _sp = 0; while (cond) { __builtin_amdgcn_s_sleep(1); \
    if ((++_sp & 255u) == 0u) { if (xb_ld(&(bar)[XB_TMO])) break; if (_sp > XB_SPIN_CAP) { atomicAdd(&(bar)[XB_TMO], 1u); break; } } } } while (0)
struct XcdBarrier { unsigned* bar; unsigned x; volatile LAS unsigned* st; int wave_s; };
__device__ __forceinline__ int lane_id_asm() { int l; asm volatile("v_mbcnt_lo_u32_b32 %0, -1, 0\n\tv_mbcnt_hi_u32_b32 %0, -1, %0" : "=v"(l)); return l; }
__device__ __forceinline__ XcdBarrier xcd_barrier_post(unsigned* bar, volatile LAS unsigned* st, int wave_s) {
    XcdBarrier b; b.bar = bar; b.x = xb_xcc_id(); b.st = st; b.wave_s = wave_s;
    if (threadIdx.x == 0) (void)xb_add(&bar[XB_XCNT(b.x)], 1u);
    return b;
}
__device__ __forceinline__ void xcd_barrier_complete(unsigned* bar, unsigned x, unsigned& nloc, unsigned& nx) {
    const unsigned G = gridDim.x * gridDim.y * gridDim.z;
    asm volatile("" : "+s"(x));
    unsigned sum, cnt, mine, sp = 0u;
    for (;;) {
        sum = 0u; cnt = 0u; mine = 0u;
#pragma unroll
        for (unsigned j = 0; j < 16; ++j) { const unsigned c = xb_ld(&bar[XB_XCNT(j)]); sum += c; cnt += (c > 0u) ? 1u : 0u; mine = (j == x) ? c : mine; }
        if (sum == G) break;
        __builtin_amdgcn_s_sleep(1);
        if ((++sp & 255u) == 0u) { if (xb_ld(&bar[XB_TMO])) break; if (sp > XB_SPIN_CAP) { atomicAdd(&bar[XB_TMO], 1u); break; } }
    }
    nloc = mine > 0u ? mine : 1u; nx = cnt > 0u ? cnt : 1u;
}
__device__ __forceinline__ void xcd_barrier(const XcdBarrier& b) {
    asm volatile("s_waitcnt vmcnt(0)" ::: "memory");
    __syncthreads();
    unsigned bx = b.x; asm volatile("" : "+s"(bx));
    if (b.wave_s == 0 && lane_id_asm() == 0) {
        unsigned* bar = b.bar;
        __builtin_amdgcn_s_waitcnt(0);
        unsigned nloc = b.st[0], nx = b.st[1];
        if (nloc == 0u) { xcd_barrier_complete(bar, bx, nloc, nx); b.st[0] = nloc; b.st[1] = nx; }
        const unsigned k = b.st[2] + 1u; b.st[2] = k;
        const unsigned old = xb_add(&bar[XB_XSUB(bx)], 1u);
        if (old + 1u == k * nloc) {
            __builtin_amdgcn_fence(__ATOMIC_RELEASE, "agent");
            asm volatile("s_waitcnt vmcnt(0)" ::: "memory");
            (void)xb_add(&bar[XB_TOP], 1u);
            const unsigned target = k * nx;
            XB_SPIN(xb_ld(&bar[XB_TOP]) < target, bar);
            (void)xb_add(&bar[XB_XGEN(bx)], 1u);
        } else {
            XB_SPIN(xb_ld(&bar[XB_XGEN(bx)]) < k, bar);
        }
        __builtin_amdgcn_fence(__ATOMIC_ACQUIRE, "agent");
        asm volatile("s_waitcnt vmcnt(0)" ::: "memory");
    }
    __syncthreads();
}

constexpr int LDS_BYTES = 147456;
#ifndef PROBE
#define PROBE 0
#endif
#define FRESH() int tid = wave_s * 64 + lane_id_asm(), bid = blockIdx.x; asm volatile("" : "+s"(bid));
__global__ void __launch_bounds__(512, 2) trunk_fwd(Params P) {
    extern __shared__ __attribute__((aligned(16))) unsigned char lds_raw[];
    LAS unsigned char* lds = (LAS unsigned char*)lds_raw;
    cg::grid_group grid = cg::this_grid();
    if (P.ws == nullptr) grid.sync();
    const int G = gridDim.x;
    volatile LAS unsigned* MISC = (volatile LAS unsigned*)(lds + LDS_BYTES - 128);
    const int wave_s = __builtin_amdgcn_readfirstlane((int)threadIdx.x >> 6);
    if (threadIdx.x < 32) MISC[threadIdx.x] = 0u;
    __syncthreads();
    XcdBarrier xbar = xcd_barrier_post(g_xbar, MISC + 8, wave_s);
    unsigned char* ws = P.ws;
    const float* MOD = (const float*)(ws + WS_MOD);
    bf16_t* XN = (bf16_t*)(ws + WS_XN);
    bf16_t* ACT = (bf16_t*)(ws + WS_ACT);
#define SEAM_CAT(sm) ((sm) == 0 ? 0 : (sm) <= 16 ? (int)((0x6543216721654321ull >> (4 * ((sm) - 1))) & 15ull) : (int)((0x8654321ull >> (4 * ((sm) - 17))) & 15ull))
    unsigned long long tacc = 0, tlast = 0; int seam = 0;
#define SEAM_MARK() do { if (PROBE >= 300) { const unsigned long long now_ = __builtin_amdgcn_s_memrealtime(); if (SEAM_CAT(seam) == (PROBE >= 1000 ? PROBE / 1000 - 1 : PROBE - 300)) tacc += now_ - tlast; tlast = now_; ++seam; } } while (0)
#define GSYNC() do { xcd_barrier(xbar); SEAM_MARK(); } while (0)
    if (PROBE >= 300) tlast = __builtin_amdgcn_s_memrealtime();
    if (PROBE == 30) { { FRESH(); p0_mod(P, lds, tid, bid, G); } { FRESH(); p0_rope(P, tid, bid, G); } __syncthreads(); }
    if (PROBE == 31) { FRESH(); conv_weights(P.ret_w_in, RET_IN, 6144, P.ret_w_out, 2048, ws + WS_W, lds, tid, bid, G); __syncthreads(); }
    { FRESH(); p0_mod(P, lds, tid, bid, G); }
    { FRESH(); p0_rope(P, tid, bid, G); }
    { FRESH(); conv_weights(P.ret_w_in, RET_IN, 6144, P.ret_w_out, 2048, ws + WS_W, lds, tid, bid, G); }
    GSYNC();
#pragma unroll 1
    for (int layer = 0; layer < 4; ++layer) {
        const int kind = layer % 3, j = layer / 3;
        unsigned char* wbase = ws + ((kind == 2) ? WS_WGLA : WS_W);
        bf16_t* WinT = (bf16_t*)wbase; bf16_t* WoutT = (bf16_t*)(wbase + 12 * MiB);
        bf16_t* R0 = (bf16_t*)P.out; bf16_t* R1 = R0 + (size_t)MT * 1024;
        const void* xin = (layer == 0) ? (const void*)P.x : (layer == 2) ? (const void*)R1 : (const void*)R0;
        bf16_t* xout = (layer == 0 || layer == 2) ? R0 : (layer == 1) ? R1 : (bf16_t*)(ws + WS_ACT);
        if (layer > 0) {
            FRESH();
            if (kind == 0) { if (G != 256) conv_weights(P.ret_w_in + (size_t)j * 1024 * RET_IN, RET_IN, 6144, P.ret_w_out + (size_t)j * 2048 * 1024, 2048, ws + WS_W, lds, tid, bid, G); }
            else if (kind == 1) conv_weights(P.fox_w_in, FOX_IN, 4096, P.fox_w_out, 1024, ws + WS_W, lds, tid, bid, G);
            else conv_weights(P.gla_w_in, GLA_IN, 3072, P.gla_w_out, 1024, ws + WS_WGLA, lds, tid, bid, G);
            __syncthreads();
        }
        if (PROBE == 5 || (PROBE >= 50 && PROBE <= 53 && layer == PROBE - 50)) {
            if (layer == 0) { FRESH(); h_phase<0, true>(P, layer, xin, lds, tid, bid, G); }
            else if (kind == 0) { FRESH(); h_phase<0, false>(P, layer, xin, lds, tid, bid, G); }
            else if (kind == 1) { FRESH(); h_phase<1, false>(P, layer, xin, lds, tid, bid, G); }
            else { FRESH(); h_phase<2, false>(P, layer, xin, lds, tid, bid, G); }
            __syncthreads();
        }
        if (layer == 0) { FRESH(); h_phase<0, true>(P, layer, xin, lds, tid, bid, G); }
            else if (kind == 0) { FRESH(); h_phase<0, false>(P, layer, xin, lds, tid, bid, G); }
        else if (kind == 1) { FRESH(); h_phase<1, false>(P, layer, xin, lds, tid, bid, G); }
        else { FRESH(); h_phase<2, false>(P, layer, xin, lds, tid, bid, G); }
        GSYNC();
        const float* gate = MOD + (size_t)(layer * 4) * 3072 + 2048;
        if (kind == 0) {
            bf16_t* rQ = ACT; bf16_t* rK = (bf16_t*)(ws + WS_ACT + 32 * MiB); bf16_t* rV = (bf16_t*)(ws + WS_ACT + 64 * MiB); bf16_t* rO = (bf16_t*)(ws + WS_ACT + 128 * MiB);
            bf16_t* rP = WinT;
            float* STATS = (float*)(ws + WS_S16);
            {
                FRESH();
                pg8::Gemm g{XN, WinT, MT, 4096, 1024}; pg8::StaticOrder S; S.init(MT, 4096, G, bid);
                EpiRetIn E{rQ, rK, rV, (const unsigned*)(ws + WS_ROPE)};
                pg8::gemm_phase<EpiRetIn, pg8::StaticOrder, true, true>(lds, g, S, E, tid);
            }
            GSYNC();
            if (PROBE == 40) { FRESH();
                pg8::Gemm g{XN, WinT, MT, 4096, 1024}; pg8::StaticOrder S; S.init(MT, 4096, G, bid);
                EpiRetIn E{rQ, rK, rV, (const unsigned*)(ws + WS_ROPE)};
                pg8::gemm_phase<EpiRetIn, pg8::StaticOrder, true, true>(lds, g, S, E, tid); GSYNC(); }
            if (PROBE == 6) { FRESH();
                pg8::Gemm g{XN, WinT + (size_t)4096 * 1024, MT, 2048, 1024}; pg8::StaticOrder S; S.init(MT, 2048, G, bid);
                EpiSplit E{(bf16_t*)P.out, 8, 0, 2048, -1};
                if (layer == 0) { pg8::gemm_phase<EpiSplit, pg8::StaticOrder, true, true>(lds, g, S, E, tid); GSYNC(); } }
            if (PROBE == 62 && layer == 0) { FRESH();
                pg8::Gemm g{XN, WinT, MT, 4096, 1024}; pg8::StaticOrder S; S.init(MT, 4096, G, bid);
                EpiNone E{P.out};
                pg8::gemm_phase<EpiNone, pg8::StaticOrder, true, true>(lds, g, S, E, tid); GSYNC(); }
            if (PROBE == 60 && layer == 0) { FRESH();
                pg8::Gemm g{XN, WinT + (size_t)4096 * 1024, MT, 2048, 1024}; pg8::StaticOrder S; S.init(MT, 2048, G, bid);
                EpiNone E{P.out};
                pg8::gemm_phase<EpiNone, pg8::StaticOrder, true, true>(lds, g, S, E, tid); GSYNC(); }
            { FRESH(); lin_pphase<0>(rQ, rK, rQ, rK, rP, tid, bid, G); }
            GSYNC();
            if (PROBE == 2) { FRESH(); lin_scan<0>(rQ, rK, rV, rP, nullptr, rO, (float*)(ws + WS_CUM), lds, tid, bid, G); GSYNC(); }
            if (PROBE == 20 && layer == 0) { FRESH(); lin_scan<0, 1>(rQ, rK, rV, rP, nullptr, (bf16_t*)P.out, (float*)(ws + WS_CUM), lds, tid, bid, G); GSYNC(); }
            if (PROBE == 23 && layer == 0) { FRESH(); lin_scan<0, 4>(rQ, rK, rV, rP, nullptr, (bf16_t*)P.out, (float*)(ws + WS_CUM), lds, tid, bid, G); GSYNC(); }
            if (PROBE == 25 && layer == 0) { FRESH(); lin_scan<0, 16>(rQ, rK, rV, rP, nullptr, (bf16_t*)P.out, (float*)(ws + WS_CUM), lds, tid, bid, G); GSYNC(); }
            if (PROBE == 21 && layer == 0) { FRESH(); lin_scan<0, 2>(rQ, rK, rV, rP, nullptr, (bf16_t*)P.out, (float*)(ws + WS_CUM), lds, tid, bid, G); GSYNC(); }
            if (PROBE == 24 && layer == 0) { FRESH(); lin_scan<0, 8>(rQ, rK, rV, rP, nullptr, (bf16_t*)P.out, (float*)(ws + WS_CUM), lds, tid, bid, G); GSYNC(); }
            if (PROBE == 26 && layer == 0) { FRESH(); lin_scan<0, 3>(rQ, rK, rV, rP, nullptr, (bf16_t*)P.out, (float*)(ws + WS_CUM), lds, tid, bid, G); GSYNC(); }
            if (PROBE == 27 && layer == 0) { FRESH(); lin_scan<0, 11>(rQ, rK, rV, rP, nullptr, (bf16_t*)P.out, (float*)(ws + WS_CUM), lds, tid, bid, G); GSYNC(); }
            if (PROBE == 28 && layer == 0) { FRESH(); lin_scan<0, 31>(rQ, rK, rV, rP, nullptr, (bf16_t*)P.out, (float*)(ws + WS_CUM), lds, tid, bid, G); GSYNC(); }
            if (PROBE == 22 && layer == 0) { FRESH(); lin_scan<0, 0>(rQ, rK, rV, rP, nullptr, (bf16_t*)P.out, (float*)(ws + WS_CUM), lds, tid, bid, G); GSYNC(); }
            { FRESH(); lin_scan<0>(rQ, rK, rV, rP, nullptr, rO, (float*)(ws + WS_CUM), lds, tid, bid, G); }
            GSYNC();
            {
                FRESH();
                pg8::Gemm g{XN, WinT + (size_t)4096 * 1024, MT, 2048, 1024}; pg8::PairOrder S{G, (G % 8 == 0) ? (bid % 8) * (G / 8) + bid / 8 : bid};
                EpiGateNorm<0> E{rO, rV, (LAS float*)(lds + 131072)};
                pg8::gemm_phase<EpiGateNorm<0>, pg8::PairOrder, true, true>(lds, g, S, E, tid);
            }
            GSYNC();
            if (PROBE == 42 && layer == 0) { FRESH();
                pg8::Gemm g{rV, WoutT, MT, 1024, 2048}; pg8::StaticOrder S; S.init(MT, 1024, G, bid);
                EpiOut<true> E{xin, xout, gate};
                pg8::gemm_phase<EpiOut<true>, pg8::StaticOrder, true, true>(lds, g, S, E, tid); GSYNC(); }
            if (layer == 0) {
                FRESH();
                pg8::Gemm g{rV, WoutT, MT, 1024, 2048}; pg8::StaticOrder S; S.init(MT, 1024, G, bid);
                EpiOut<true> E{xin, xout, gate};
                pg8::gemm_phase<EpiOut<true>, pg8::StaticOrder, true, true>(lds, g, S, E, tid);
            } else {
                FRESH();
                pg8::Gemm g{rV, WoutT, MT, 1024, 2048}; pg8::StaticOrder S; S.init(MT, 1024, G, bid);
                EpiOut<false> E{xin, xout, gate};
                pg8::gemm_phase<EpiOut<false>, pg8::StaticOrder, true, true>(lds, g, S, E, tid);
            }
            GSYNC();
        } else if (kind == 1) {
            {
                FRESH();
                pg8::Gemm g{XN, WinT, MT, 4096, 1024}; pg8::StaticOrder S; S.init(MT, 4096, G, bid);
                EpiFoxIn E{ACT, P.fox_q_gain, P.fox_k_gain, (LAS float*)(lds + 131072)};
                pg8::gemm_phase<EpiFoxIn, pg8::StaticOrder, true, true>(lds, g, S, E, tid);
            }
            GSYNC();
            if (PROBE == 41) { FRESH();
                pg8::Gemm g{XN, WinT, MT, 4096, 1024}; pg8::StaticOrder S; S.init(MT, 4096, G, bid);
                EpiFoxIn E{ACT, P.fox_q_gain, P.fox_k_gain, (LAS float*)(lds + 131072)};
                pg8::gemm_phase<EpiFoxIn, pg8::StaticOrder, true, true>(lds, g, S, E, tid); GSYNC(); }
            if (PROBE == 1) { FRESH(); fox_attn2(P, (char*)lds_raw, tid, bid, G, XN); GSYNC(); }
            { FRESH(); fox_attn2(P, (char*)lds_raw, tid, bid, G, nullptr); }
            GSYNC();
            {
                FRESH();
                pg8::Gemm g{ACT, WoutT, MT, 1024, 1024}; pg8::StaticOrder S; S.init(MT, 1024, G, bid);
                EpiOut<false> E{xin, xout, gate};
                pg8::gemm_phase<EpiOut<false>, pg8::StaticOrder, true, true>(lds, g, S, E, tid);
            }
            GSYNC();
        } else {
            bf16_t* gQE = ACT; bf16_t* gQN = (bf16_t*)(ws + WS_ACT + 16 * MiB); bf16_t* gKE = (bf16_t*)(ws + WS_ACT + 32 * MiB); bf16_t* gKN = (bf16_t*)(ws + WS_ACT + 48 * MiB);
            bf16_t* gV = (bf16_t*)(ws + WS_ACT + 64 * MiB); bf16_t* gP = (bf16_t*)(ws + WS_ACT + 96 * MiB); bf16_t* gO = (bf16_t*)(ws + WS_ACT + 128 * MiB);
            const bf16_t* gCB = (const bf16_t*)(ws + WS_ACT + 160 * MiB);
            float* STATS = (float*)(ws + WS_S16);
            {
                FRESH();
                pg8::Gemm g{XN, WinT, MT, 2048, 1024}; pg8::StaticOrder S; S.init(MT, 2048, G, bid);
                EpiGlaIn E{gQE, gQN, gKE, gKN, gV, nullptr, gCB};
                pg8::gemm_phase<EpiGlaIn, pg8::StaticOrder, true, true>(lds, g, S, E, tid);
            }
            GSYNC();
            { FRESH(); lin_pphase<1>(gQE, gKN, gQN, gKE, gP, tid, bid, G); }
            GSYNC();
            if (PROBE == 3) { FRESH(); lin_scan<1>(gQE, gKN, gV, gP, gCB, gO, (float*)(ws + WS_CUM), lds, tid, bid, G); GSYNC(); }
            if (G == 256 && ((int)blockIdx.x >> 3) >= 16) {
                FRESH(); const int sub = (bid & 7) * 16 + ((bid >> 3) - 16);
                conv_weights(P.ret_w_in + (size_t)1 * 1024 * RET_IN, RET_IN, 6144, P.ret_w_out + (size_t)1 * 2048 * 1024, 2048, ws + WS_W, lds, tid, sub, 128);
            } else { FRESH(); lin_scan<1>(gQE, gKN, gV, gP, gCB, gO, (float*)(ws + WS_CUM), lds, tid, bid, G); }
            GSYNC();
            {
                FRESH();
                pg8::Gemm g{XN, WinT + (size_t)2048 * 1024, MT, 1024, 1024}; pg8::StaticOrder S; S.init(MT, 1024, G, bid);
                EpiGateNorm<1> E{gO, gV, (LAS float*)(lds + 131072)};
                pg8::gemm_phase<EpiGateNorm<1>, pg8::StaticOrder, true, true>(lds, g, S, E, tid);
            }
            GSYNC();
            {
                FRESH();
                pg8::Gemm g{gV, WoutT, MT, 1024, 1024}; pg8::StaticOrder S; S.init(MT, 1024, G, bid);
                EpiOut<false> E{xin, xout, gate};
                pg8::gemm_phase<EpiOut<false>, pg8::StaticOrder, true, true>(lds, g, S, E, tid);
            }
            GSYNC();
        }
    }
    if (PROBE == 70) { for (int i = 0; i < 10; ++i) GSYNC(); }
    { FRESH(); final_norm(P, (const bf16_t*)(ws + WS_ACT), tid, bid, G); }
    if (wave_s == 0) {
        const int l = lane_id_asm(); unsigned last = 0u;
        if (l == 0) last = (xb_add(&g_xbar[XB_DEPART], 1u) + 1u == (unsigned)G) ? 1u : 0u;
        last = (unsigned)__builtin_amdgcn_readfirstlane((int)last);
        if (last) {
            if (l < 16) { __hip_atomic_store(&g_xbar[XB_XCNT(l)], 0u, __ATOMIC_RELAXED, __HIP_MEMORY_SCOPE_AGENT); __hip_atomic_store(&g_xbar[XB_XSUB(l)], 0u, __ATOMIC_RELAXED, __HIP_MEMORY_SCOPE_AGENT);
                          __hip_atomic_store(&g_xbar[XB_XGEN(l)], 0u, __ATOMIC_RELAXED, __HIP_MEMORY_SCOPE_AGENT); }
            if (l == 16) { __hip_atomic_store(&g_xbar[XB_TOP], 0u, __ATOMIC_RELAXED, __HIP_MEMORY_SCOPE_AGENT); __hip_atomic_store(&g_xbar[XB_TOPGEN], 0u, __ATOMIC_RELAXED, __HIP_MEMORY_SCOPE_AGENT);
                           __hip_atomic_store(&g_xbar[XB_TMO], 0u, __ATOMIC_RELAXED, __HIP_MEMORY_SCOPE_AGENT); __hip_atomic_store(&g_xbar[XB_DEPART], 0u, __ATOMIC_RELAXED, __HIP_MEMORY_SCOPE_AGENT); }
        }
    }
    if (PROBE >= 300) { __syncthreads(); SEAM_MARK(); if (blockIdx.x == 0 && threadIdx.x == 0) P.out[0] += (PROBE >= 1000) ? (((float)tacc * 0.01f > (float)(PROBE % 1000)) ? 100.0f : 0.0f) : exp2f(rintf(log2f((float)tacc * 0.01f + 1.0f) * 16.0f) * 0.0625f); }
}

extern "C" void kernel_launch(void* const* d_in, const int* in_sizes, int n_in, void* d_out, int out_size, void* d_ws, size_t ws_size, hipStream_t stream) {
    static int grid = 0;
    if (grid == 0) {
        if (n_in != 18 || out_size != MT * DM || ws_size < WS_END) { fprintf(stderr, "kernel_launch: unexpected shapes (n_in %d out %d ws %zu)\n", n_in, out_size, ws_size); grid = -1; return; }
        int dev = 0, cus = 0, per_cu = 0;
        hipGetDevice(&dev);
        hipDeviceGetAttribute(&cus, hipDeviceAttributeMultiprocessorCount, dev);
        hipFuncSetAttribute((const void*)trunk_fwd, hipFuncAttributeMaxDynamicSharedMemorySize, LDS_BYTES);
        hipOccupancyMaxActiveBlocksPerMultiprocessor(&per_cu, (const void*)trunk_fwd, 512, LDS_BYTES);
        if (per_cu < 1) { fprintf(stderr, "kernel_launch: occupancy query says %d blocks per CU\n", per_cu); per_cu = 1; }
        (void)hipGetLastError();
        grid = cus;
    }
    if (grid < 0) return;
    Params p{};
    p.x = (const float*)d_in[0]; p.c = (const float*)d_in[1]; p.pos = (const int*)d_in[2]; p.mod_w = (const float*)d_in[3]; p.mod_b = (const float*)d_in[4]; p.norm_g = (const float*)d_in[5];
    p.ret_w_in = (const float*)d_in[6]; p.ret_w_out = (const float*)d_in[7]; p.fox_w_in = (const float*)d_in[8]; p.fox_b_f = (const float*)d_in[9]; p.fox_q_gain = (const float*)d_in[10]; p.fox_k_gain = (const float*)d_in[11];
    p.fox_w_out = (const float*)d_in[12]; p.gla_w_in = (const float*)d_in[13]; p.gla_w_gate2 = (const float*)d_in[14]; p.gla_b_gate = (const float*)d_in[15]; p.gla_w_out = (const float*)d_in[16]; p.final_g = (const float*)d_in[17];
    p.out = (float*)d_out; p.ws = (unsigned char*)d_ws;
    void* args[] = {&p};
    hipError_t e = hipLaunchCooperativeKernel((const void*)trunk_fwd, dim3(grid), dim3(512), args, LDS_BYTES, stream);
    if (e != hipSuccess) fprintf(stderr, "cooperative launch failed: %s (grid %d)\n", hipGetErrorString(e), grid);
}
```
